# Optimizing an MI355X kernel written in HIP

```python
import jax, jax.numpy as jnp
from jax import lax
import numpy as np

D_MODEL = 2048
BATCH = 1
SEQ = 16384
DEPTH = 1

D_MIX = D_MODEL
FOURIER_WIDTH = D_MIX // 2
N_FOURIER_GROUPS = 8
FOURIER_GROUP = FOURIER_WIDTH // N_FOURIER_GROUPS
RET_WIDTH = D_MIX - FOURIER_WIDTH
N_RET_HEADS = 4
RET_HEAD_DIM = RET_WIDTH // N_RET_HEADS
RET_CHUNK = 128
ROPE_BASE = 10000.0
D_IN = FOURIER_WIDTH + 4 * RET_WIDTH
N_EXPERTS = 32
TOP_K = 4
D_FF = D_MODEL
SWIGLU_LIMIT = 7.0
SWIGLU_ALPHA = 1.702
MOE_BLOCK = 128
LN_EPS = 1e-5
GN_EPS = 1e-6
DEEPNORM_ALPHA = (2.0 * DEPTH) ** 0.25
DEEPNORM_BETA = (8.0 * DEPTH) ** -0.25

kernel_name = "fnet_retnet_gptoss_deepnorm_hybrid"


def layer_norm(x, g, b, eps=LN_EPS):
    xf = x.astype(jnp.float32)
    mu = xf.mean(-1, keepdims=True)
    var = jnp.square(xf - mu).mean(-1, keepdims=True)
    return ((xf - mu) * lax.rsqrt(var + eps)).astype(x.dtype) * g + b


def fourier_mix(u):
    B, S, _ = u.shape
    ug = u.reshape(B, S, N_FOURIER_GROUPS, FOURIER_GROUP).astype(jnp.float32)
    y = jnp.fft.fftn(ug, axes=(1, 3), norm="ortho").real
    return y.reshape(B, S, FOURIER_WIDTH).astype(u.dtype)


def rotary(x, pos):
    half = x.shape[-1] // 2
    inv = ROPE_BASE ** (-jnp.arange(half, dtype=jnp.float32) / half)
    ang = pos.astype(jnp.float32)[:, None] * inv[None, :]
    cos = jnp.cos(ang)[None, :, None, :]
    sin = jnp.sin(ang)[None, :, None, :]
    x1 = x[..., :half].astype(jnp.float32)
    x2 = x[..., half:].astype(jnp.float32)
    return jnp.concatenate([x1 * cos - x2 * sin, x2 * cos + x1 * sin], -1).astype(x.dtype)


def chunk_retention(q, k, v, log_gamma, inclusive):
    B, H, S, Dk = q.shape
    Dv = v.shape[-1]
    C = RET_CHUNK
    N = S // C
    qc = q.reshape(B, H, N, C, Dk)
    kc = k.reshape(B, H, N, C, Dk)
    vc = v.reshape(B, H, N, C, Dv)
    idx = jnp.arange(C, dtype=jnp.float32)
    diff = idx[:, None] - idx[None, :]
    mask = (diff >= 0) if inclusive else (diff > 0)
    decay_intra = jnp.where(mask[None], jnp.exp(log_gamma[:, None, None] * jnp.maximum(diff, 0.0)[None]), 0.0)
    scores = jnp.einsum('bhnid,bhnjd->bhnij', qc, kc) * decay_intra[None, :, None].astype(q.dtype)
    intra = jnp.einsum('bhnij,bhnjd->bhnid', scores, vc)
    lg = log_gamma[:, None]
    k_to_end = jnp.exp(lg * (C - 1 - idx)[None])
    q_from_start = jnp.exp(lg * (idx + 1)[None])
    chunk_decay = jnp.exp(log_gamma * C)
    kv = jnp.einsum('bhncd,bhnce->bhnde', kc.astype(jnp.float32) * k_to_end[None, :, None, :, None],
                    vc.astype(jnp.float32))
    kv_t = jnp.moveaxis(kv, 2, 0)

    def step(state, kv_n):
        return state * chunk_decay[None, :, None, None] + kv_n, state

    _, states = lax.scan(step, jnp.zeros_like(kv_t[0]), kv_t)
    states = jnp.moveaxis(states, 0, 2)
    cross = jnp.einsum('bhncd,bhnde->bhnce', qc.astype(jnp.float32) * q_from_start[None, :, None, :, None], states)
    return (intra + cross.astype(intra.dtype)).reshape(B, H, S, Dv)


def retention_mix(uq, uk, uv, ug, log_g_fwd, log_g_bwd, gn_g, pos):
    B, S, _ = uq.shape
    heads = lambda t: t.reshape(B, S, N_RET_HEADS, RET_HEAD_DIM)
    q = rotary(heads(uq), pos)
    k = rotary(heads(uk), pos) * (RET_HEAD_DIM ** -0.5)
    v = heads(uv)
    q, k, v = (jnp.swapaxes(t, 1, 2) for t in (q, k, v))
    fwd = chunk_retention(q, k, v, log_g_fwd, True)
    flip = lambda t: jnp.flip(t, axis=2)
    bwd = flip(chunk_retention(flip(q), flip(k), flip(v), log_g_bwd, False))
    o = jnp.swapaxes(fwd + bwd, 1, 2)
    of = o.astype(jnp.float32)
    mu = of.mean(-1, keepdims=True)
    var = jnp.square(of - mu).mean(-1, keepdims=True)
    o = ((of - mu) * lax.rsqrt(var + GN_EPS)).astype(uq.dtype).reshape(B, S, RET_WIDTH) * gn_g
    return jax.nn.silu(ug) * o


def moe(h, layer, w_router, b_router, w_up, b_up, w_down, b_down):
    B, S, D = h.shape
    T = B * S
    xt = h.reshape(T, D)
    logits = (xt @ w_router[layer] + b_router[layer]).astype(jnp.float32)
    top_logit, top_idx = lax.top_k(logits, TOP_K)
    gates = jax.nn.softmax(top_logit, axis=-1)
    e_flat = top_idx.reshape(-1).astype(jnp.int32)
    tok_flat = jnp.repeat(jnp.arange(T, dtype=jnp.int32), TOP_K)
    g_flat = gates.reshape(-1)
    order = jnp.argsort(e_flat)
    e_sorted = e_flat[order]
    counts = jnp.bincount(e_flat, length=N_EXPERTS)
    start = jnp.cumsum(counts) - counts
    padded = (counts + MOE_BLOCK - 1) // MOE_BLOCK * MOE_BLOCK
    pad_end = jnp.cumsum(padded)
    pad_start = pad_end - padded
    dst = pad_start[e_sorted] + jnp.arange(T * TOP_K, dtype=jnp.int32) - start[e_sorted]
    R = T * TOP_K + N_EXPERTS * MOE_BLOCK
    NB = R // MOE_BLOCK
    row_tok = jnp.full((R,), T, jnp.int32).at[dst].set(tok_flat[order])
    row_gate = jnp.zeros((R,), jnp.float32).at[dst].set(g_flat[order])
    block_exp = jnp.minimum(jnp.searchsorted(pad_end, jnp.arange(NB) * MOE_BLOCK, side='right'),
                            N_EXPERTS - 1).astype(jnp.int32)
    x_pad = jnp.concatenate([xt, jnp.zeros((1, D), xt.dtype)], 0)

    def expert_block(args):
        toks, e = args
        xb = x_pad[toks]
        hc = xb @ w_up[layer, e] + b_up[layer, e]
        glu = jnp.minimum(hc[:, :D_FF], SWIGLU_LIMIT)
        lin = jnp.clip(hc[:, D_FF:], -SWIGLU_LIMIT, SWIGLU_LIMIT)
        act = glu * jax.nn.sigmoid(SWIGLU_ALPHA * glu) * (lin + 1.0)
        return act @ w_down[layer, e] + b_down[layer, e]

    y_rows = lax.map(expert_block, (row_tok.reshape(NB, MOE_BLOCK), block_exp))
    y_rows = y_rows.reshape(R, D) * row_gate[:, None].astype(xt.dtype)
    y = jax.ops.segment_sum(y_rows, row_tok, num_segments=T + 1)[:T]
    return y.reshape(B, S, D)


def setup_inputs(seed: int = 0) -> dict:
    key = jax.random.key(seed)
    ks = jax.random.split(key, 20)
    f32 = jnp.float32
    nrm = lambda k, shape, s: jax.random.normal(k, shape, f32) * s
    gain = lambda k, shape: 1.0 + 0.02 * jax.random.normal(k, shape, f32)
    x = jax.random.normal(ks[0], (BATCH, SEQ, D_MODEL), f32)
    ln0_g = gain(ks[1], (D_MODEL,))
    ln0_b = nrm(ks[2], (D_MODEL,), 0.02)
    w_in = nrm(ks[3], (DEPTH, D_MODEL, D_IN), D_MODEL ** -0.5)
    v_lo = FOURIER_WIDTH + 2 * RET_WIDTH
    col_scale = jnp.ones((D_IN,), f32).at[v_lo:v_lo + RET_WIDTH].set(DEEPNORM_BETA)
    w_in = w_in * col_scale
    gamma = 1.0 - 2.0 ** (-5.0 - np.arange(N_RET_HEADS, dtype=np.float32))
    base = jnp.asarray(np.log(-np.log(gamma)), f32)
    ret_decay_fwd = base[None] + nrm(ks[4], (DEPTH, N_RET_HEADS), 0.01)
    ret_decay_bwd = base[None] + nrm(ks[5], (DEPTH, N_RET_HEADS), 0.01)
    ret_gn_g = gain(ks[6], (DEPTH, RET_WIDTH))
    w_out = nrm(ks[7], (DEPTH, D_MIX, D_MODEL), DEEPNORM_BETA * D_MIX ** -0.5)
    ln1_g = gain(ks[8], (DEPTH, D_MODEL))
    ln1_b = nrm(ks[9], (DEPTH, D_MODEL), 0.02)
    w_router = nrm(ks[10], (DEPTH, D_MODEL, N_EXPERTS), D_MODEL ** -0.5)
    b_router = nrm(ks[11], (DEPTH, N_EXPERTS), 0.01)
    w_up = nrm(ks[12], (DEPTH, N_EXPERTS, D_MODEL, 2 * D_FF), DEEPNORM_BETA * D_MODEL ** -0.5)
    b_up = nrm(ks[13], (DEPTH, N_EXPERTS, 2 * D_FF), 0.01)
    w_down = nrm(ks[14], (DEPTH, N_EXPERTS, D_FF, D_MODEL), DEEPNORM_BETA * D_FF ** -0.5)
    b_down = nrm(ks[15], (DEPTH, N_EXPERTS, D_MODEL), 0.01)
    ln2_g = gain(ks[16], (DEPTH, D_MODEL))
    ln2_b = nrm(ks[17], (DEPTH, D_MODEL), 0.02)
    return {"x": x, "ln0_g": ln0_g, "ln0_b": ln0_b, "w_in": w_in,
            "ret_decay_fwd": ret_decay_fwd, "ret_decay_bwd": ret_decay_bwd, "ret_gn_g": ret_gn_g,
            "w_out": w_out, "ln1_g": ln1_g, "ln1_b": ln1_b,
            "w_router": w_router, "b_router": b_router, "w_up": w_up, "b_up": b_up,
            "w_down": w_down, "b_down": b_down, "ln2_g": ln2_g, "ln2_b": ln2_b}


def reference(x, ln0_g, ln0_b, w_in, ret_decay_fwd, ret_decay_bwd, ret_gn_g, w_out, ln1_g, ln1_b,
              w_router, b_router, w_up, b_up, w_down, b_down, ln2_g, ln2_b):
    B, S, D = x.shape
    pos = jnp.arange(S, dtype=jnp.int32)
    F, Rw = FOURIER_WIDTH, RET_WIDTH
    h = layer_norm(x, ln0_g, ln0_b)
    for l in range(DEPTH):
        u = h @ w_in[l]
        uf, uq, uk, uv, ug = jnp.split(u, [F, F + Rw, F + 2 * Rw, F + 3 * Rw], axis=-1)
        log_g_fwd = -jnp.exp(ret_decay_fwd[l].astype(jnp.float32))
        log_g_bwd = -jnp.exp(ret_decay_bwd[l].astype(jnp.float32))
        y_f = fourier_mix(uf)
        y_r = retention_mix(uq, uk, uv, ug, log_g_fwd, log_g_bwd, ret_gn_g[l], pos)
        mix = jnp.concatenate([y_f, y_r], axis=-1) @ w_out[l]
        h = layer_norm(DEEPNORM_ALPHA * h + mix, ln1_g[l], ln1_b[l])
        ffn = moe(h, l, w_router, b_router, w_up, b_up, w_down, b_down)
        h = layer_norm(DEEPNORM_ALPHA * h + ffn, ln2_g[l], ln2_b[l])
    return h
```

```cpp
#include <hip/hip_runtime.h>
#include <cstdio>
#include <cstdint>

#define GAS __attribute__((address_space(1)))
#define LAS __attribute__((address_space(3)))
typedef unsigned short bf16;
typedef unsigned v4u __attribute__((ext_vector_type(4)));
typedef unsigned v2u __attribute__((ext_vector_type(2)));
typedef float f32x4 __attribute__((ext_vector_type(4)));
typedef float f32x2 __attribute__((ext_vector_type(2)));
typedef short bf16x8 __attribute__((ext_vector_type(8)));
#define RLX_AGENT __ATOMIC_RELAXED, __HIP_MEMORY_SCOPE_AGENT
#define LDS_WAIT() asm volatile("s_waitcnt lgkmcnt(0)" ::: "memory")
#define VM_WAIT() asm volatile("s_waitcnt vmcnt(0)" ::: "memory")

constexpr int T = 16384, D = 2048, DIN = 5120, FW = 1024, RW = 1024, NH = 4, HD = 256, NE = 32, TOPK = 4, DFF = 2048;
constexpr int C2 = 256, NCH = T / C2;
constexpr int CAT = 768;
constexpr float LN_EPS = 1e-5f, GN_EPS = 1e-6f, ALPHA = 1.189207115002721f;
constexpr int RT_MAX = (T * TOPK) / 256 + NE;
constexpr int NWAVES = 8, NTHR = 512;

constexpr size_t MiB = 1u << 20;
constexpr size_t WS_CTL = 0, CTL_BYTES = 1 * MiB;
constexpr size_t WS_TAB = 1 * MiB;
constexpr size_t WS_WIN = 2 * MiB;
constexpr size_t WS_WOUT = WS_WIN + 20 * MiB;
constexpr size_t WS_WUP = WS_WOUT + 8 * MiB;
constexpr size_t WS_WDN = WS_WUP + 512 * MiB;
constexpr size_t WS_H0B = WS_WDN + 256 * MiB;
constexpr size_t WS_ST0 = WS_H0B + 64 * MiB;
constexpr size_t WS_UTT = WS_ST0 + 1 * MiB;
constexpr size_t WS_A1 = WS_UTT + 32 * MiB;
constexpr size_t WS_ZT = WS_A1 + 64 * MiB;
constexpr size_t WS_QS = WS_ZT + 64 * MiB;
constexpr size_t WS_KK = WS_QS + 32 * MiB;
constexpr size_t WS_GS = WS_KK + 32 * MiB;
constexpr size_t WS_ACAT = WS_GS + 32 * MiB;
constexpr size_t WS_BCAT = WS_ACAT + 96 * MiB;
constexpr size_t WS_KTW = WS_BCAT + 96 * MiB;
constexpr size_t WS_KVT = WS_KTW + 64 * MiB;
constexpr size_t WS_Y = WS_KVT + 128 * MiB;
constexpr size_t WS_Z1 = WS_Y + 64 * MiB;
constexpr size_t WS_H1B = WS_Z1 + 128 * MiB;
constexpr size_t WS_RT = WS_H1B + 64 * MiB;
constexpr size_t WS_ACT = WS_RT + 4 * MiB;
constexpr size_t WS_YR = WS_ACT + 288 * MiB;
constexpr size_t WS_END = WS_YR + 288 * MiB;
constexpr int CW_BAR = 1024;
constexpr int CW_CNT = 8192;

constexpr int LDS_STAGE = 131072, LDS_SCR = 16384, LDS_CTL_OFF = LDS_STAGE + LDS_SCR, LDS_BYTES = LDS_CTL_OFF + 512;

__device__ __forceinline__ unsigned cvt_pk_bf16(float lo, float hi) { unsigned r; asm volatile("v_cvt_pk_bf16_f32 %0, %1, %2" : "=v"(r) : "v"(lo), "v"(hi)); return r; }
__device__ __forceinline__ float bf_lo(unsigned u) { return __builtin_bit_cast(float, u << 16); }
__device__ __forceinline__ float bf_hi(unsigned u) { return __builtin_bit_cast(float, u & 0xffff0000u); }
__device__ __forceinline__ v4u pack8(const f32x4 a, const f32x4 b) { v4u w; w.x = cvt_pk_bf16(a[0], a[1]); w.y = cvt_pk_bf16(a[2], a[3]); w.z = cvt_pk_bf16(b[0], b[1]); w.w = cvt_pk_bf16(b[2], b[3]); return w; }
__device__ __forceinline__ float wave_sum(float v) {
#pragma unroll
    for (int o = 1; o < 64; o <<= 1) v += __shfl_xor(v, o);
    return v;
}
__device__ __forceinline__ float fexp(float x) { return __builtin_amdgcn_exp2f(x * 1.4426950408889634f); }
__device__ __forceinline__ void cs_rev(float rev, float& c, float& s) { const float f = __builtin_amdgcn_fractf(rev); c = __builtin_amdgcn_cosf(f); s = __builtin_amdgcn_sinf(f); }

#define XB_TMO      128
#define XB_XCNT(j)  (256  + 64 * (j))
#define XB_XSUB(j)  (1280 + 64 * (j))
#define XB_XGEN(j)  (2304 + 64 * (j))
#define XB_TOP      3328
#define XB_TOPGEN   3392
#define XCD_BAR_WORDS 3456
#define XB_SPIN_CAP (1u << 18)
__device__ __forceinline__ unsigned xb_ld(unsigned* p)              { return __hip_atomic_load(p, __ATOMIC_RELAXED, __HIP_MEMORY_SCOPE_AGENT); }
__device__ __forceinline__ unsigned xb_add(unsigned* p, unsigned v) { return __hip_atomic_fetch_add(p, v, __ATOMIC_RELAXED, __HIP_MEMORY_SCOPE_AGENT); }
__device__ __forceinline__ unsigned xb_xcc_id() { return (unsigned)__builtin_amdgcn_s_getreg((3 << 11) | 20) & 0xFu; }
#define XB_SPIN(cond, bar) do { unsigned _sp = 0; while (cond) { __builtin_amdgcn_s_sleep(1); \
    if ((++_sp & 255u) == 0u) { if (xb_ld(&(bar)[XB_TMO])) break; if (_sp > XB_SPIN_CAP) { atomicAdd(&(bar)[XB_TMO], 1u); break; } } } } while (0)
struct XcdBarrier { unsigned* bar; unsigned x; volatile LAS unsigned* st; };
__device__ __forceinline__ XcdBarrier xcd_barrier_post(unsigned* bar, volatile LAS unsigned* st) {
    XcdBarrier b; b.bar = bar; b.x = xb_xcc_id(); b.st = st;
    if (threadIdx.x == 0) (void)xb_add(&bar[XB_XCNT(b.x)], 1u);
    return b;
}
__device__ __forceinline__ void xcd_barrier_complete(unsigned* bar, unsigned x, unsigned& nloc, unsigned& nx) {
    const unsigned G = gridDim.x * gridDim.y * gridDim.z;
    unsigned sum, cnt, mine, sp = 0u;
    for (;;) {
        sum = 0u; cnt = 0u; mine = 0u;
#pragma unroll
        for (unsigned j = 0; j < 16; ++j) { const unsigned c = xb_ld(&bar[XB_XCNT(j)]); sum += c; cnt += (c > 0u) ? 1u : 0u; mine = (j == x) ? c : mine; }
        if (sum == G) break;
        __builtin_amdgcn_s_sleep(1);
        if ((++sp & 255u) == 0u) { if (xb_ld(&bar[XB_TMO])) break; if (sp > XB_SPIN_CAP) { atomicAdd(&bar[XB_TMO], 1u); break; } }
    }
    nloc = mine > 0u ? mine : 1u; nx = cnt > 0u ? cnt : 1u;
}
__device__ __forceinline__ void xcd_barrier(const XcdBarrier& b) {
    asm volatile("s_waitcnt vmcnt(0)" ::: "memory");
    __syncthreads();
    if (threadIdx.x == 0) {
        unsigned* bar = b.bar;
        __builtin_amdgcn_s_waitcnt(0);
        unsigned nloc = b.st[0], nx = b.st[1];
        if (nloc == 0u) { xcd_barrier_complete(bar, b.x, nloc, nx); b.st[0] = nloc; b.st[1] = nx; }
        const unsigned old = xb_add(&bar[XB_XSUB(b.x)], 1u);
        const unsigned gen = old / nloc;
        if (old + 1u == (gen + 1u) * nloc) {
            __builtin_amdgcn_fence(__ATOMIC_RELEASE, "agent");
            asm volatile("s_waitcnt vmcnt(0)" ::: "memory");
            const unsigned og = xb_add(&bar[XB_TOP], 1u);
            const unsigned tg = og / nx;
            if (og + 1u == (tg + 1u) * nx) xb_add(&bar[XB_TOPGEN], 1u);
            else XB_SPIN(xb_ld(&bar[XB_TOPGEN]) == tg, bar);
            __builtin_amdgcn_fence(__ATOMIC_ACQUIRE, "agent");
            xb_add(&bar[XB_XGEN(b.x)], 1u);
            asm volatile("s_waitcnt vmcnt(0)" ::: "memory");
        } else {
            XB_SPIN(xb_ld(&bar[XB_XGEN(b.x)]) == gen, bar);
            __builtin_amdgcn_fence(__ATOMIC_ACQUIRE, "agent");
            asm volatile("s_waitcnt vmcnt(0)" ::: "memory");
        }
    }
    __syncthreads();
}

namespace gm {
constexpr int BM = 256, BK = 64, HALF = 128, HTB = HALF * BK * 2, STAGE_BYTES = 8 * HTB;
__device__ __forceinline__ int lds_byte(int r, int c) { const int st = (r >> 4) * 2 + (c >> 5), rr = r & 15, cc = c & 31, ob = rr * 64 + cc * 2; return st * 1024 + (ob ^ (((ob >> 9) & 1) << 5)); }
__device__ __forceinline__ void stage_rc(int b, int& R, int& C) { const int st = b / 1024, sb = b % 1024, swz = sb ^ (((sb >> 9) & 1) << 5); R = (st >> 1) * 16 + swz / 64; C = (st & 1) * 32 + (swz % 64) / 2; }
__device__ __forceinline__ int perm32(int rho) { const int n = rho >> 4, i = rho & 15; return 8 * (i >> 2) + 4 * n + (i & 3); }

struct Unit { const char* a0; const char* a1; const char* b0; const char* b1; int p0, p1, p2, p3; };

__device__ __forceinline__ void tile_order(int L, int nM, int nN, int& pm, int& pn) {
    const int nwg = nM * nN; int wgid = L;
    { const int q = nwg / 8, r = nwg % 8, xcd = wgid % 8, off = wgid / 8; wgid = (xcd < r ? xcd * (q + 1) : r * (q + 1) + (xcd - r) * q) + off; }
    const int nig = 8 * nN, gid = wgid / nig, fm = gid * 8, gsz = (nM - fm) < 8 ? (nM - fm) : 8;
    pm = fm + ((wgid % nig) % gsz); pn = (wgid % nig) / gsz;
}

template <class Epi, class Sched, bool GATHER>
__device__ __forceinline__ void gemm_run(LAS unsigned char* lds, const Sched& S, const Epi& E) {
    const int tid = threadIdx.x, wid = __builtin_amdgcn_readfirstlane(tid >> 6), lane = tid & 63, wr = wid >> 2, wc = wid & 3, fr = lane & 15, fq = lane >> 4;
    int nt = S.nt; asm volatile("" : "+s"(nt));
    unsigned voffA[2], voffB[2], colA[2]; int rowA[2];
#pragma unroll
    for (int i = 0; i < 2; ++i) { int R, C; stage_rc(tid * 16 + i * 8192, R, C); const int Rb = Epi::PERM ? ((R & ~31) + perm32(R & 31)) : R;
        voffA[i] = (unsigned)(R * S.multA * S.pitchA + C) * 2u; voffB[i] = (unsigned)(Rb * S.multB * S.pitchB + C) * 2u; colA[i] = (unsigned)C * 2u; rowA[i] = R; }
    const size_t kstep = (size_t)(BK * 2);
    const unsigned ldsw = (unsigned)wid * 1024u;
    const int aoff = lds_byte(wr * 64 + fr, fq * 8), boff = lds_byte(wc * 32 + fr, fq * 8);
#define G_SA(b, h) (((b) * 2 + (h)) * HTB)
#define G_SB(b, h) ((4 + (b) * 2 + (h)) * HTB)
#define G_STAGE(bufoff, gbase, voff) do { _Pragma("unroll") for (int _i = 0; _i < 2; ++_i) \
        __builtin_amdgcn_global_load_lds((const unsigned*)((const char*)(gbase) + (voff)[_i]), (LAS unsigned*)(lds + (bufoff) + ldsw + _i * 8192), 16, 0, 0); } while (0)
#define G_LDA(dst, b, h) do { _Pragma("unroll") for (int m = 0; m < 4; ++m) _Pragma("unroll") for (int k = 0; k < 2; ++k) dst[m][k] = *(const LAS bf16x8*)(lds + G_SA(b, h) + aoff + m * 2048 + k * 1024); } while (0)
#define G_LDB(dst, b, h) do { _Pragma("unroll") for (int n = 0; n < 2; ++n) _Pragma("unroll") for (int k = 0; k < 2; ++k) dst[n][k] = *(const LAS bf16x8*)(lds + G_SB(b, h) + boff + n * 2048 + k * 1024); } while (0)
#define G_MMA(ai, bj, At, Bt) do { __builtin_amdgcn_s_setprio(1); _Pragma("unroll") for (int m = 0; m < 4; ++m) _Pragma("unroll") for (int n = 0; n < 2; ++n) _Pragma("unroll") for (int k = 0; k < 2; ++k) \
        acc[ai][bj][m][n] = __builtin_amdgcn_mfma_f32_16x16x32_bf16(Bt[n][k], At[m][k], acc[ai][bj][m][n], 0, 0, 0); __builtin_amdgcn_s_setprio(0); } while (0)
#define G_WAIT_V(n) asm volatile("s_waitcnt vmcnt(" #n ")" ::: "memory")
#define G_WAIT_L(n) asm volatile("s_waitcnt lgkmcnt(" #n ")" ::: "memory")
#define G_BAR __builtin_amdgcn_s_barrier()
#define G_SCHED __builtin_amdgcn_sched_barrier(0)
    Unit cur, nxt; int ui = 0;
    if (!S.next(0, cur)) return;
    f32x4 acc[2][2][4][2];
#pragma unroll
    for (int a = 0; a < 2; ++a)
#pragma unroll
        for (int b = 0; b < 2; ++b)
#pragma unroll
            for (int m = 0; m < 4; ++m)
#pragma unroll
                for (int n = 0; n < 2; ++n) acc[a][b][m][n] = (f32x4){0.f, 0.f, 0.f, 0.f};
    bf16x8 At[4][2], B0[2][2], B1[2][2];
    unsigned gc0[2], gc1[2];
    if constexpr (GATHER) {
#pragma unroll
        for (int i = 0; i < 2; ++i) { gc0[i] = S.row_off(cur, rowA[i]) + colA[i]; gc1[i] = S.row_off(cur, 128 + rowA[i]) + colA[i]; }
    }
#define vA0 (GATHER ? gc0 : voffA)
#define vA1 (GATHER ? gc1 : voffA)
    G_STAGE(G_SB(0, 0), cur.b0, voffB); G_STAGE(G_SB(0, 1), cur.b1, voffB); G_STAGE(G_SA(0, 0), cur.a0, vA0); G_STAGE(G_SA(0, 1), cur.a1, vA1);
    if (wr == 1) G_BAR;
    G_WAIT_V(2); G_BAR;
    G_STAGE(G_SB(1, 0), cur.b0 + kstep, voffB); G_STAGE(G_SA(1, 0), cur.a0 + kstep, vA0); G_STAGE(G_SB(1, 1), cur.b1 + kstep, voffB);
    G_WAIT_V(6); G_BAR;
    for (;;) {
        const bool has_next = S.next(ui + 1, nxt);
        if (!has_next) nxt = cur;
        for (int t = 0; t < nt; t += 2) {
            const bool last = (t == nt - 2);
            unsigned tn1[2] = {0u, 0u};
            if constexpr (GATHER) { if (last) { int tz = tid; asm volatile("" : "+v"(tz));
#pragma unroll
                for (int i = 0; i < 2; ++i) { int R, C; stage_rc(tz * 16 + i * 8192, R, C); gc0[i] = S.row_off(nxt, R) + (unsigned)C * 2u; tn1[i] = S.row_off(nxt, 128 + R) + (unsigned)C * 2u; } } }
            const char* a11 = cur.a1 + (size_t)(t + 1) * kstep;
            const char* a02 = last ? nxt.a0 : cur.a0 + (size_t)(t + 2) * kstep; const char* a12 = last ? nxt.a1 : cur.a1 + (size_t)(t + 2) * kstep;
            const char* b02 = last ? nxt.b0 : cur.b0 + (size_t)(t + 2) * kstep; const char* b12 = last ? nxt.b1 : cur.b1 + (size_t)(t + 2) * kstep;
            G_LDB(B0, 0, 0); G_LDB(B1, 0, 1); G_SCHED; G_LDA(At, 0, 0); G_STAGE(G_SA(1, 1), a11, vA1);
            if constexpr (GATHER) { if (last) { gc1[0] = tn1[0]; gc1[1] = tn1[1]; } }
            G_WAIT_V(8); G_WAIT_L(0); G_BAR; G_MMA(0, 0, At, B0); G_MMA(0, 1, At, B1); G_BAR; G_SCHED;
            G_LDA(At, 0, 1); G_STAGE(G_SB(0, 0), b02, voffB); G_STAGE(G_SB(0, 1), b12, voffB); G_STAGE(G_SA(0, 0), a02, vA0);
            G_WAIT_V(8); G_WAIT_L(0); G_BAR; G_MMA(1, 0, At, B0); G_MMA(1, 1, At, B1); G_BAR; G_SCHED;
            G_LDB(B0, 1, 0); G_LDB(B1, 1, 1); G_SCHED; G_LDA(At, 1, 0); G_STAGE(G_SA(0, 1), a12, vA1);
            G_WAIT_V(8); G_WAIT_L(0); G_BAR; G_MMA(0, 0, At, B0); G_MMA(0, 1, At, B1); G_BAR; G_SCHED;
            G_LDA(At, 1, 1); G_STAGE(G_SB(1, 0), b02 + kstep, voffB); G_STAGE(G_SB(1, 1), b12 + kstep, voffB); G_STAGE(G_SA(1, 0), a02 + kstep, vA0);
            G_WAIT_V(8); G_WAIT_L(0); G_BAR; G_MMA(1, 0, At, B0); G_MMA(1, 1, At, B1); G_BAR; G_SCHED;
        }
        if (wr == 0) G_BAR;
        { int fr2 = fr, fq2 = fq; asm volatile("" : "+v"(fr2), "+v"(fq2));
          E(acc, cur, lds, wr, wc, fr2, fq2); }
        if (!has_next) break;
#pragma unroll
        for (int a = 0; a < 2; ++a)
#pragma unroll
            for (int b = 0; b < 2; ++b)
#pragma unroll
                for (int m = 0; m < 4; ++m)
#pragma unroll
                    for (int n = 0; n < 2; ++n) acc[a][b][m][n] = (f32x4){0.f, 0.f, 0.f, 0.f};
        cur = nxt; ++ui;
        if (wr == 1) G_BAR;
    }
    G_WAIT_V(0);
    G_BAR;
#undef G_SA
#undef G_SB
#undef G_STAGE
#undef G_LDA
#undef G_LDB
#undef G_MMA
#undef G_WAIT_V
#undef G_WAIT_L
#undef G_BAR
#undef G_SCHED
#undef vA0
#undef vA1
}
}
using gm::Unit;
typedef f32x4 Acc[2][2][4][2];

struct Args { const float* in[18]; float* out; unsigned char* ws; int ph_lo, ph_hi; };
struct Frame {
    LAS unsigned char* lds; unsigned char* ws; unsigned* ctl;
    int tid, lane, wave, vcu, G;
    const float *x, *ln0_g, *ln0_b, *w_in, *dec_f, *dec_b, *gn_g, *w_out, *ln1_g, *ln1_b, *w_r, *b_r, *w_up, *b_up, *w_dn, *b_dn, *ln2_g, *ln2_b;
    float* out;
};
#define WSP(T_, off) ((T_*)(F.ws + (off)))

template <class ColMap>
__device__ __forceinline__ void transpose_item(const float* W, int K, int N, bf16* WT, LAS float* scr, int item, int lane, const ColMap& cm) {
    const int nblk = N / 64, kb = item / nblk, nb = item % nblk, k0 = 64 * kb, n0 = 64 * nb;
    const int s0 = cm(n0);
#pragma unroll 4
    for (int i = 0; i < 16; ++i) { const int kk = 4 * i + (lane >> 4), c4 = (lane & 15) * 4;
        const f32x4 v = *(const GAS f32x4*)(W + (size_t)(k0 + kk) * N + s0 + c4);
        LAS float* d = scr + kk * 65 + c4; d[0] = v[0]; d[1] = v[1]; d[2] = v[2]; d[3] = v[3]; }
    LDS_WAIT(); asm volatile("" ::: "memory");
    const int c = lane & 7;
#pragma unroll
    for (int j = 0; j < 8; ++j) { const int n = (lane >> 3) + 8 * j; const LAS float* s = scr + (8 * c) * 65 + n;
        v4u o; o.x = cvt_pk_bf16(s[0 * 65], s[1 * 65]); o.y = cvt_pk_bf16(s[2 * 65], s[3 * 65]); o.z = cvt_pk_bf16(s[4 * 65], s[5 * 65]); o.w = cvt_pk_bf16(s[6 * 65], s[7 * 65]);
        *(GAS v4u*)(WT + (size_t)(n0 + n) * K + k0 + 8 * c) = o; }
    LDS_WAIT(); asm volatile("" ::: "memory");
}
struct ColId { __device__ __forceinline__ int operator()(int n) const { return n; } };
struct ColUp { __device__ __forceinline__ int operator()(int n) const { return ((n >> 8) * 128 + (n & 127)) + ((n >> 7) & 1) * 2048; } };

__device__ __forceinline__ void p0_prologue(Frame& F) {
    const int gw = F.vcu * NWAVES + F.wave, NGW = F.G * NWAVES;
    {
        bf16* h0b = WSP(bf16, WS_H0B); float* st0 = WSP(float, WS_ST0);
        for (int m = gw; m < T; m += NGW) {
            const GAS f32x4* xr = (const GAS f32x4*)(F.x + (size_t)m * D) + F.lane;
            f32x4 v[8]; float s = 0.f;
#pragma unroll
            for (int j = 0; j < 8; ++j) { v[j] = xr[64 * j]; s += (v[j][0] + v[j][1]) + (v[j][2] + v[j][3]); }
            const float mean = wave_sum(s) * (1.f / D); float s2 = 0.f;
#pragma unroll
            for (int j = 0; j < 8; ++j) { v[j] = v[j] - mean; s2 += (v[j][0] * v[j][0] + v[j][1] * v[j][1]) + (v[j][2] * v[j][2] + v[j][3] * v[j][3]); }
            const float rstd = 1.f / sqrtf(wave_sum(s2) * (1.f / D) + LN_EPS);
            GAS v2u* o8 = (GAS v2u*)(h0b + (size_t)m * D) + F.lane;
#pragma unroll
            for (int j = 0; j < 8; ++j) { const f32x4 g = *((const GAS f32x4*)F.ln0_g + F.lane + 64 * j), b = *((const GAS f32x4*)F.ln0_b + F.lane + 64 * j);
                const f32x4 h = v[j] * rstd * g + b; v2u w; w.x = cvt_pk_bf16(h[0], h[1]); w.y = cvt_pk_bf16(h[2], h[3]); o8[64 * j] = w; }
            if (F.lane == 0) { st0[2 * m] = mean; st0[2 * m + 1] = rstd; }
        }
    }
    {
        bf16* tab = WSP(bf16, WS_TAB);
        for (int i = (F.vcu * NTHR + F.tid); i < 32768 + 65536 + 65536; i += F.G * NTHR) {
            float v;
            if (i < 32768) { const int r = i >> 7, a = i & 127, ri = r >> 7, k1 = r & 127; float c, s; cs_rev((float)((k1 * a) & 127) * (1.f / 128.f), c, s); v = ri ? -s : c; }
            else if (i < 32768 + 65536) { const int e = i - 32768, r = e >> 8, q = e & 255, ri = r >> 7, k2 = r & 127, rj = q >> 7, b = q & 127; float c, s; cs_rev((float)((k2 * b) & 127) * (1.f / 128.f), c, s);
                v = (ri == 0) ? (rj == 0 ? c : s) : (rj == 0 ? -s : c); }
            else { const int e = i - 32768 - 65536, l = e >> 8, q = e & 255, rj = q >> 7, cg = q & 127; float c, s; cs_rev((float)((l * cg) & 127) * (1.f / 128.f), c, s); v = (l < 128) ? (rj == 0 ? c : s) : 0.f; }
            tab[i] = (bf16)(cvt_pk_bf16(v, 0.f) & 0xffffu);
        }
    }
    {
        LAS float* scr = (LAS float*)(F.lds + F.wave * 18432);
        constexpr int I_IN = 32 * (DIN / 64), I_OUT = 32 * (D / 64), I_UP = 32 * (2 * DFF / 64), I_DN = 32 * (D / 64);
        constexpr int NIT = I_IN + I_OUT + NE * I_UP + NE * I_DN;
        for (int it = gw; it < NIT; it += NGW) {
            int r = it;
            if (r < I_IN) { transpose_item(F.w_in, D, DIN, WSP(bf16, WS_WIN), scr, r, F.lane, ColId()); continue; } r -= I_IN;
            if (r < I_OUT) { transpose_item(F.w_out, D, D, WSP(bf16, WS_WOUT), scr, r, F.lane, ColId()); continue; } r -= I_OUT;
            if (r < NE * I_UP) { const int e = r / I_UP; transpose_item(F.w_up + (size_t)e * D * 2 * DFF, D, 2 * DFF, WSP(bf16, WS_WUP) + (size_t)e * 2 * DFF * D, scr, r % I_UP, F.lane, ColUp()); continue; } r -= NE * I_UP;
            { const int e = r / I_DN; transpose_item(F.w_dn + (size_t)e * DFF * D, DFF, D, WSP(bf16, WS_WDN) + (size_t)e * D * DFF, scr, r % I_DN, F.lane, ColId()); }
        }
    }
}

struct SchedBase { int nt, pitchA, pitchB, multA, multB, G, c; };
struct SchedG1N : SchedBase {
    const char* A; const char* Bt;
    __device__ __forceinline__ bool next(int i, Unit& u) const { const int L = i * G + c; if (L >= 64 * 12) return false; int pm, pn; gm::tile_order(L, 64, 12, pm, pn);
        const int cb = pn < 4 ? 1024 + 256 * pn : (pn < 8 ? 2048 + 256 * (pn - 4) : 4096 + 256 * (pn - 8));
        u.a0 = A + (size_t)pm * 256 * D * 2; u.a1 = u.a0 + (size_t)128 * D * 2; u.b0 = Bt + (size_t)cb * D * 2; u.b1 = u.b0 + (size_t)128 * D * 2; u.p0 = pm; u.p1 = pn; u.p2 = 0; u.p3 = 0; return true; }
};
struct SchedG1SF : SchedBase {
    const char* A; const char* Bt;
    __device__ __forceinline__ bool next(int i, Unit& u) const { const int L = i * G + c; if (L >= 4 * 64) return false; int pm, pn; gm::tile_order(L, 4, 64, pm, pn);
        u.a0 = A + (size_t)pm * 256 * D * 2; u.a1 = u.a0 + (size_t)128 * D * 2; u.b0 = Bt + (size_t)(2 * pn) * D * 2; u.b1 = u.b0 + (size_t)D * 2; u.p0 = pm; u.p1 = pn; u.p2 = 0; u.p3 = 0; return true; }
};
struct SchedG1SKV : SchedBase {
    const char* A; const char* Bt;
    __device__ __forceinline__ bool next(int i, Unit& u) const { const int L = i * G + c; if (L >= 8 * 64) return false; int pm, pn; gm::tile_order(L, 8, 64, pm, pn);
        const int rb = pm < 4 ? 2048 + 256 * pm : 3072 + 256 * (pm - 4);
        u.a0 = A + (size_t)rb * D * 2; u.a1 = u.a0 + (size_t)128 * D * 2; u.b0 = Bt + (size_t)pn * 256 * D * 2; u.b1 = u.b0 + (size_t)128 * D * 2; u.p0 = pm; u.p1 = pn; u.p2 = 0; u.p3 = 0; return true; }
};
struct SchedFixA : SchedBase {
    const char* A; const char* Bt; int ncol;
    __device__ __forceinline__ bool next(int i, Unit& u) const { const int L = i * G + c; if (L >= ncol) return false;
        u.a0 = A; u.a1 = A + (size_t)128 * pitchA * 2; u.b0 = Bt + (size_t)L * 256 * pitchB * 2; u.b1 = u.b0 + (size_t)128 * pitchB * 2; u.p0 = 0; u.p1 = L; u.p2 = 0; u.p3 = 0; return true; }
};
struct SchedFixB : SchedBase {
    const char* A; const char* Bt; int nrow;
    __device__ __forceinline__ bool next(int i, Unit& u) const { const int L = i * G + c; if (L >= nrow) return false;
        u.a0 = A + (size_t)L * 256 * pitchA * 2; u.a1 = u.a0 + (size_t)128 * pitchA * 2; u.b0 = Bt; u.b1 = Bt + (size_t)128 * pitchB * 2; u.p0 = L; u.p1 = 0; u.p2 = 0; u.p3 = 0; return true; }
};
struct SchedScores : SchedBase {
    const char* Q; const char* Kk;
    __device__ __forceinline__ bool next(int i, Unit& u) const { const int L = i * G + c; if (L >= NH * NCH) return false; const int h = L & 3, n = L >> 2;
        u.a0 = Q + ((size_t)n * 256 * RW + h * HD) * 2; u.a1 = u.a0 + (size_t)128 * RW * 2; u.b0 = Kk + ((size_t)n * 256 * RW + h * HD) * 2; u.b1 = u.b0 + (size_t)128 * RW * 2; u.p0 = h; u.p1 = n; u.p2 = 0; u.p3 = 0; return true; }
};
struct SchedKV : SchedBase {
    const char* Bcat; const char* kTw;
    __device__ __forceinline__ bool next(int i, Unit& u) const { const int L = i * G + c; if (L >= 2 * NH * NCH) return false; const int dh = L & 7, n = L >> 3, dir = dh >> 2, h = dh & 3;
        u.a0 = Bcat + ((size_t)(h * NCH + n) * 256 * CAT) * 2; u.a1 = u.a0 + (size_t)128 * CAT * 2;
        u.b0 = kTw + (((size_t)dir * RW + h * HD) * T + (size_t)n * 256) * 2; u.b1 = u.b0 + (size_t)128 * T * 2; u.p0 = dh; u.p1 = n; u.p2 = 0; u.p3 = 0; return true; }
};
struct SchedOut : SchedBase {
    const char* Acat; const char* Bcat;
    __device__ __forceinline__ bool next(int i, Unit& u) const { const int L = i * G + c; if (L >= NH * NCH) return false; const int h = L & 3, n = L >> 2;
        u.a0 = Acat + ((size_t)h * T + (size_t)n * 256) * CAT * 2; u.a1 = u.a0 + (size_t)128 * CAT * 2; u.b0 = Bcat + ((size_t)(h * NCH + n) * 256 * CAT) * 2; u.b1 = u.b0 + (size_t)128 * CAT * 2; u.p0 = h; u.p1 = n; u.p2 = 0; u.p3 = 0; return true; }
};
struct Sched2D : SchedBase {
    const char* A; const char* Bt; int nM, nN;
    __device__ __forceinline__ bool next(int i, Unit& u) const { const int L = i * G + c; if (L >= nM * nN) return false; int pm, pn; gm::tile_order(L, nM, nN, pm, pn);
        u.a0 = A + (size_t)pm * 256 * pitchA * 2; u.a1 = u.a0 + (size_t)128 * pitchA * 2; u.b0 = Bt + (size_t)pn * 256 * pitchB * 2; u.b1 = u.b0 + (size_t)128 * pitchB * 2; u.p0 = pm; u.p1 = pn; u.p2 = 0; u.p3 = 0; return true; }
};
struct SchedMoE : SchedBase {
    const char* A; const char* Bt; const LAS int* tstart; const int* row_tok; const unsigned* cnt; int nN; size_t estride;
    __device__ __forceinline__ bool next(int i, Unit& u) const { const int RT = __builtin_amdgcn_readfirstlane(tstart[NE]); const int L = i * G + c; if (L >= RT * nN) return false; int rt, pn; gm::tile_order(L, RT, nN, rt, pn);
        int e = 0;
        for (int j = 1; j < NE; ++j) e += (__builtin_amdgcn_readfirstlane(tstart[j]) <= rt) ? 1 : 0;
        u.b0 = Bt + (size_t)e * estride + (size_t)pn * 256 * D * 2; u.b1 = u.b0 + (size_t)128 * D * 2;
        u.a0 = A; u.a1 = A;
        u.p0 = rt; u.p1 = pn; u.p2 = e; u.p3 = (rt - __builtin_amdgcn_readfirstlane(tstart[e])) * 256; return true; }
    __device__ __forceinline__ unsigned row_off(const Unit& u, int r) const { const int n = (int)cnt[64 * u.p2]; int pos = u.p3 + r; pos = pos < n ? pos : n - 1;
        const int tok = row_tok[(size_t)u.p2 * T + pos]; return (unsigned)tok * (unsigned)(D * 2); }
};
struct SchedMoEDown : SchedMoE {
    __device__ __forceinline__ bool next(int i, Unit& u) const { if (!SchedMoE::next(i, u)) return false; u.a0 = A + (size_t)u.p0 * 256 * DFF * 2; u.a1 = u.a0 + (size_t)128 * DFF * 2; return true; }
};

#define EPI_LOOP_AM for (int ai = 0; ai < 2; ++ai) _Pragma("unroll") for (int m = 0; m < 4; ++m)
#define EPI_FENCE __builtin_amdgcn_sched_barrier(0)
struct EpiG1N {
    static constexpr bool PERM = true;
    bf16 *qs, *kk, *gs, *Acat; const float *dec_f, *dec_b;
    __device__ __forceinline__ void operator()(Acc& acc, const Unit& u, LAS unsigned char*, int wr, int wc, int fr, int fq) const {
        const int pm = u.p0, pn = u.p1, c0 = wc * 32 + 8 * fq;
        if (pn < 8) {
            const int h = pn & 3; const bool isq = pn < 4;
            float inv[8];
#pragma unroll
            for (int e = 0; e < 8; ++e) inv[e] = __builtin_amdgcn_exp2f(-(float)(c0 + e) * (13.287712379549449f / 128.f)) * 0.15915494309189535f;
            const float lgf = -fexp(dec_f[h]), lgb = -fexp(dec_b[h]);
#pragma unroll
            EPI_LOOP_AM {
                const int r = 128 * ai + 64 * wr + 16 * m + fr, tok = pm * 256 + r; const float pos = (float)tok;
                f32x4 o1[2], o2[2];
#pragma unroll
                for (int n = 0; n < 2; ++n)
#pragma unroll
                    for (int j = 0; j < 4; ++j) { float c, s; cs_rev(pos * inv[4 * n + j], c, s); const float x1 = acc[ai][0][m][n][j], x2 = acc[ai][1][m][n][j]; o1[n][j] = x1 * c - x2 * s; o2[n][j] = x2 * c + x1 * s; }
                if (isq) {
                    bf16* q = qs + (size_t)tok * RW + h * HD + c0; *(GAS v4u*)q = pack8(o1[0], o1[1]); *(GAS v4u*)(q + 128) = pack8(o2[0], o2[1]);
                    const int il = r; const float wf = fexp(lgf * (float)(il + 1)), wb = fexp(lgb * (float)(255 - il));
                    bf16* a = Acat + ((size_t)h * T + tok) * CAT + c0;
                    *(GAS v4u*)(a + 256) = pack8(o1[0] * wf, o1[1] * wf); *(GAS v4u*)(a + 384) = pack8(o2[0] * wf, o2[1] * wf);
                    *(GAS v4u*)(a + 512) = pack8(o1[0] * wb, o1[1] * wb); *(GAS v4u*)(a + 640) = pack8(o2[0] * wb, o2[1] * wb);
                } else {
                    bf16* k = kk + (size_t)tok * RW + h * HD + c0; *(GAS v4u*)k = pack8(o1[0] * 0.0625f, o1[1] * 0.0625f); *(GAS v4u*)(k + 128) = pack8(o2[0] * 0.0625f, o2[1] * 0.0625f);
                }
            }
        } else {
#pragma unroll
            EPI_LOOP_AM {
                const int r = 128 * ai + 64 * wr + 16 * m + fr, tok = pm * 256 + r;
#pragma unroll
                for (int bj = 0; bj < 2; ++bj) { f32x4 v[2];
#pragma unroll
                    for (int n = 0; n < 2; ++n)
#pragma unroll
                        for (int j = 0; j < 4; ++j) { const float g = acc[ai][bj][m][n][j]; v[n][j] = g * __builtin_amdgcn_rcpf(1.f + fexp(-g)); }
                    *(GAS v4u*)(gs + (size_t)tok * RW + (pn - 8) * 256 + bj * 128 + c0) = pack8(v[0], v[1]); }
            }
        }
    }
};
struct EpiG1SF {
    static constexpr bool PERM = true;
    bf16* uTT;
    __device__ __forceinline__ void operator()(Acc& acc, const Unit& u, LAS unsigned char*, int wr, int wc, int fr, int fq) const {
        const int a0 = wc * 32 + 8 * fq;
#pragma unroll
        EPI_LOOP_AM { const int cch = u.p0 * 256 + 128 * ai + 64 * wr + 16 * m + fr;
#pragma unroll
            for (int bj = 0; bj < 2; ++bj) *(GAS v4u*)(uTT + ((size_t)cch * 128 + (2 * u.p1 + bj)) * 128 + a0) = pack8(acc[ai][bj][m][0], acc[ai][bj][m][1]); }
    }
};
struct EpiG1SKV {
    static constexpr bool PERM = true;
    bf16 *kTw, *Bcat; const float *dec_f, *dec_b;
    __device__ __forceinline__ void operator()(Acc& acc, const Unit& u, LAS unsigned char*, int wr, int wc, int fr, int fq) const {
        const int pm = u.p0, n_ch = u.p1, c0 = wc * 32 + 8 * fq;
        if (pm < 4) {
            const int h = pm; const float lgf = -fexp(dec_f[h]), lgb = -fexp(dec_b[h]);
#pragma unroll
            for (int m = 0; m < 4; ++m) {
                const int d = 64 * wr + 16 * m + fr;
                const float inv = __builtin_amdgcn_exp2f(-(float)d * (13.287712379549449f / 128.f)) * 0.15915494309189535f;
#pragma unroll
                for (int bj = 0; bj < 2; ++bj) {
                    f32x4 f1[2], f2[2], b1[2], b2[2];
#pragma unroll
                    for (int n = 0; n < 2; ++n)
#pragma unroll
                        for (int j = 0; j < 4; ++j) { const int il = 128 * bj + c0 + 4 * n + j; const float pos = (float)(n_ch * 256 + il); float c, s; cs_rev(pos * inv, c, s);
                            const float x1 = acc[0][bj][m][n][j], x2 = acc[1][bj][m][n][j]; const float o1 = (x1 * c - x2 * s) * 0.0625f, o2 = (x2 * c + x1 * s) * 0.0625f;
                            const float wf = fexp(lgf * (float)(255 - il)), wb = fexp(lgb * (float)(il + 1));
                            f1[n][j] = o1 * wf; f2[n][j] = o2 * wf; b1[n][j] = o1 * wb; b2[n][j] = o2 * wb; }
                    const size_t tcol = (size_t)n_ch * 256 + 128 * bj + c0;
                    bf16* pf = kTw + ((size_t)(h * HD + d)) * T + tcol; bf16* pb = pf + (size_t)RW * T;
                    *(GAS v4u*)pf = pack8(f1[0], f1[1]); *(GAS v4u*)(pf + (size_t)128 * T) = pack8(f2[0], f2[1]);
                    *(GAS v4u*)pb = pack8(b1[0], b1[1]); *(GAS v4u*)(pb + (size_t)128 * T) = pack8(b2[0], b2[1]);
                }
            }
        } else {
            const int h = pm - 4;
#pragma unroll
            EPI_LOOP_AM { const int dv = 128 * ai + 64 * wr + 16 * m + fr;
#pragma unroll
                for (int bj = 0; bj < 2; ++bj) *(GAS v4u*)(Bcat + ((size_t)(h * NCH + n_ch) * 256 + dv) * CAT + 128 * bj + c0) = pack8(acc[ai][bj][m][0], acc[ai][bj][m][1]); }
        }
    }
};
struct EpiS1 {
    static constexpr bool PERM = true;
    bf16* A1;
    __device__ __forceinline__ void operator()(Acc& acc, const Unit& u, LAS unsigned char*, int wr, int wc, int fr, int fq) const {
        const int b0 = wc * 32 + 8 * fq;
#pragma unroll
        for (int m = 0; m < 4; ++m) { const int k1 = 64 * wr + 16 * m + fr;
#pragma unroll
            for (int bj = 0; bj < 2; ++bj) { const int cch = 2 * u.p1 + bj; f32x4 re[2], im[2];
#pragma unroll
                for (int n = 0; n < 2; ++n)
#pragma unroll
                    for (int j = 0; j < 4; ++j) { const int b = b0 + 4 * n + j; float c, s; cs_rev((float)(k1 * b) * (1.f / 16384.f), c, s);
                        const float xr = acc[0][bj][m][n][j], xi = acc[1][bj][m][n][j]; re[n][j] = xr * c + xi * s; im[n][j] = xi * c - xr * s; }
                bf16* p = A1 + (((size_t)k1 * 1024 + cch) * 2) * 128 + b0;
                *(GAS v4u*)p = pack8(re[0], re[1]); *(GAS v4u*)(p + 128) = pack8(im[0], im[1]); EPI_FENCE; } }
    }
};
struct EpiS2 {
    static constexpr bool PERM = true;
    bf16* Zt;
    __device__ __forceinline__ void operator()(Acc& acc, const Unit& u, LAS unsigned char*, int wr, int wc, int fr, int fq) const {
        const int k1 = u.p1 >> 2, cb = (u.p1 & 3) * 256, c0 = wc * 32 + 8 * fq;
#pragma unroll
        EPI_LOOP_AM { const int k2 = 64 * wr + 16 * m + fr, k = k1 + 128 * k2;
#pragma unroll
            for (int bj = 0; bj < 2; ++bj) { const int cch = cb + 128 * bj + c0, g = cch >> 7, cg = cch & 127;
                *(GAS v4u*)(Zt + (size_t)k * 2048 + g * 256 + ai * 128 + cg) = pack8(acc[ai][bj][m][0], acc[ai][bj][m][1]); } }
    }
};
struct EpiChan {
    static constexpr bool PERM = true;
    bf16* y;
    __device__ __forceinline__ void operator()(Acc& acc, const Unit& u, LAS unsigned char*, int wr, int wc, int fr, int fq) const {
        const int l0 = wc * 32 + 8 * fq; const float norm = 6.9053396600248786e-4f;
#pragma unroll
        EPI_LOOP_AM { const int R = u.p0 * 256 + 128 * ai + 64 * wr + 16 * m + fr, k = R >> 3, g = R & 7;
            *(GAS v4u*)(y + (size_t)k * D + g * 128 + l0) = pack8(acc[ai][0][m][0] * norm, acc[ai][0][m][1] * norm); }
    }
};
struct EpiScores {
    static constexpr bool PERM = true;
    bf16* Acat; const float *dec_f, *dec_b;
    __device__ __forceinline__ void operator()(Acc& acc, const Unit& u, LAS unsigned char*, int wr, int wc, int fr, int fq) const {
        const int h = u.p0, n_ch = u.p1, c0 = wc * 32 + 8 * fq; const float lgf = -fexp(dec_f[h]), lgb = -fexp(dec_b[h]);
#pragma unroll
        EPI_LOOP_AM { const int i = 128 * ai + 64 * wr + 16 * m + fr;
#pragma unroll
            for (int bj = 0; bj < 2; ++bj) { f32x4 v[2];
#pragma unroll
                for (int n = 0; n < 2; ++n)
#pragma unroll
                    for (int j = 0; j < 4; ++j) { const int jc = 128 * bj + c0 + 4 * n + j; const float dd = (float)(i - jc); const float w = (jc <= i) ? fexp(lgf * dd) : fexp(-lgb * dd); v[n][j] = acc[ai][bj][m][n][j] * w; }
                *(GAS v4u*)(Acat + ((size_t)h * T + n_ch * 256 + i) * CAT + 128 * bj + c0) = pack8(v[0], v[1]); EPI_FENCE; } }
    }
};
struct EpiKV {
    static constexpr bool PERM = false;
    float* kvT;
    __device__ __forceinline__ void operator()(Acc& acc, const Unit& u, LAS unsigned char*, int wr, int wc, int fr, int fq) const {
#pragma unroll
        EPI_LOOP_AM { const int dv = 128 * ai + 64 * wr + 16 * m + fr; float* rowp = kvT + (((size_t)u.p0 * NCH + u.p1) * 256 + dv) * 256 + wc * 32 + 4 * fq;
#pragma unroll
            for (int bj = 0; bj < 2; ++bj)
#pragma unroll
                for (int n = 0; n < 2; ++n) *(GAS f32x4*)(rowp + bj * 128 + n * 16) = acc[ai][bj][m][n]; }
    }
};
struct EpiOut {
    static constexpr bool PERM = true;
    bf16* y; const bf16* gs; const float* gn_g;
    __device__ __forceinline__ void operator()(Acc& acc, const Unit& u, LAS unsigned char* lds, int wr, int wc, int fr, int fq) const {
        const int h = u.p0, n_ch = u.p1, c0 = wc * 32 + 8 * fq;
        LAS f32x2* P = (LAS f32x2*)(lds + LDS_STAGE);
#pragma unroll
        EPI_LOOP_AM {
            float s = 0.f;
#pragma unroll
            for (int bj = 0; bj < 2; ++bj)
#pragma unroll
                for (int n = 0; n < 2; ++n) { const f32x4 x = acc[ai][bj][m][n]; s += (x[0] + x[1]) + (x[2] + x[3]); }
            s += __shfl_xor(s, 16); s += __shfl_xor(s, 32);
            const float mw = s * (1.f / 64.f); float q = 0.f;
#pragma unroll
            for (int bj = 0; bj < 2; ++bj)
#pragma unroll
                for (int n = 0; n < 2; ++n) { const f32x4 d = acc[ai][bj][m][n] - mw; q += (d[0] * d[0] + d[1] * d[1]) + (d[2] * d[2] + d[3] * d[3]); }
            q += __shfl_xor(q, 16); q += __shfl_xor(q, 32);
            if (fq == 0) P[(128 * ai + 64 * wr + 16 * m + fr) * 4 + wc] = (f32x2){mw, q};
        }
        LDS_WAIT(); __builtin_amdgcn_s_barrier(); asm volatile("" ::: "memory");
#pragma unroll
        EPI_LOOP_AM {
            const int r = 128 * ai + 64 * wr + 16 * m + fr, tok = n_ch * 256 + r;
            const f32x2 a = P[r * 4 + 0], b = P[r * 4 + 1], c = P[r * 4 + 2], d = P[r * 4 + 3];
            const float mt = (a.x + b.x + c.x + d.x) * 0.25f; const float da = a.x - mt, db = b.x - mt, dc = c.x - mt, dd = d.x - mt;
            const float m2 = (a.y + b.y) + (c.y + d.y) + 64.f * ((da * da + db * db) + (dc * dc + dd * dd));
            const float rstd = 1.f / sqrtf(m2 * (1.f / 256.f) + GN_EPS);
#pragma unroll
            for (int bj = 0; bj < 2; ++bj) {
                const int col = h * HD + 128 * bj + c0; const v4u gv = *(const GAS v4u*)(gs + (size_t)tok * RW + col);
                const f32x4 g0 = *(const GAS f32x4*)(gn_g + col), g1 = *(const GAS f32x4*)(gn_g + col + 4);
                f32x4 o0 = (acc[ai][bj][m][0] - mt) * rstd * g0, o1 = (acc[ai][bj][m][1] - mt) * rstd * g1;
                o0[0] *= bf_lo(gv.x); o0[1] *= bf_hi(gv.x); o0[2] *= bf_lo(gv.y); o0[3] *= bf_hi(gv.y); o1[0] *= bf_lo(gv.z); o1[1] *= bf_hi(gv.z); o1[2] *= bf_lo(gv.w); o1[3] *= bf_hi(gv.w);
                *(GAS v4u*)(y + (size_t)tok * D + FW + col) = pack8(o0, o1); }
        }
        LDS_WAIT(); __builtin_amdgcn_s_barrier(); asm volatile("" ::: "memory");
    }
};
struct EpiWout {
    static constexpr bool PERM = false;
    float* z1; const float *x, *st0, *g0, *b0;
    __device__ __forceinline__ void operator()(Acc& acc, const Unit& u, LAS unsigned char*, int wr, int wc, int fr, int fq) const {
        const int colb = u.p1 * 256 + wc * 32 + 4 * fq;
#pragma unroll
        EPI_LOOP_AM { const int row = u.p0 * 256 + 128 * ai + 64 * wr + 16 * m + fr; const f32x2 st = *(const GAS f32x2*)(st0 + 2 * row);
#pragma unroll
            for (int bj = 0; bj < 2; ++bj)
#pragma unroll
                for (int n = 0; n < 2; ++n) { const int col = colb + bj * 128 + n * 16; const size_t off = (size_t)row * D + col;
                    const f32x4 xv = *(const GAS f32x4*)(x + off), g = *(const GAS f32x4*)(g0 + col), b = *(const GAS f32x4*)(b0 + col);
                    *(GAS f32x4*)(z1 + off) = ((xv - st.x) * st.y * g + b) * ALPHA + acc[ai][bj][m][n]; } }
    }
};
struct EpiUp {
    static constexpr bool PERM = true;
    bf16* act; const float* b_up;
    __device__ __forceinline__ void operator()(Acc& acc, const Unit& u, LAS unsigned char*, int wr, int wc, int fr, int fq) const {
        const int rt = u.p0, pn = u.p1, e = u.p2, c0 = pn * 128 + wc * 32 + 8 * fq;
#pragma unroll
        for (int n = 0; n < 2; ++n) {
            const float* bu = b_up + (size_t)e * 2 * DFF + c0 + 4 * n;
            const f32x4 bg = *(const GAS f32x4*)bu, bl = *(const GAS f32x4*)(bu + DFF);
#pragma unroll
            EPI_LOOP_AM { const int r = 128 * ai + 64 * wr + 16 * m + fr; f32x4 v;
#pragma unroll
                for (int j = 0; j < 4; ++j) { float gl = acc[ai][0][m][n][j] + bg[j], li = acc[ai][1][m][n][j] + bl[j];
                    gl = fminf(gl, 7.f); li = fminf(fmaxf(li, -7.f), 7.f); v[j] = gl * __builtin_amdgcn_rcpf(1.f + fexp(-1.702f * gl)) * (li + 1.f); }
                v2u w; w.x = cvt_pk_bf16(v[0], v[1]); w.y = cvt_pk_bf16(v[2], v[3]);
                *(GAS v2u*)(act + ((size_t)rt * 256 + r) * DFF + c0 + 4 * n) = w; }
        }
    }
};
struct EpiDown {
    static constexpr bool PERM = true;
    bf16* yr; const float* b_dn;
    __device__ __forceinline__ void operator()(Acc& acc, const Unit& u, LAS unsigned char*, int wr, int wc, int fr, int fq) const {
        const int rt = u.p0, pn = u.p1, e = u.p2, c0 = pn * 256 + wc * 32 + 8 * fq;
#pragma unroll
        for (int bj = 0; bj < 2; ++bj) { const float* bd = b_dn + (size_t)e * D + c0 + 128 * bj; const f32x4 b0 = *(const GAS f32x4*)bd, b1 = *(const GAS f32x4*)(bd + 4);
#pragma unroll
            EPI_LOOP_AM { const int r = 128 * ai + 64 * wr + 16 * m + fr;
                *(GAS v4u*)(yr + ((size_t)rt * 256 + r) * D + c0 + 128 * bj) = pack8(acc[ai][bj][m][0] + b0, acc[ai][bj][m][1] + b1); } }
    }
};

__device__ __forceinline__ void p3_scan(Frame& F) {
    const float* kvT = WSP(float, WS_KVT); bf16* Bcat = WSP(bf16, WS_BCAT);
    const int NQ = 2 * NH * 256 * 64;
    for (int q = F.vcu * NTHR + F.tid; q < NQ; q += F.G * NTHR) {
        const int dk4 = q & 63, dv = (q >> 6) & 255, dh = q >> 14, dir = dh >> 2, h = dh & 3;
        const float lg = -fexp((dir ? F.dec_b : F.dec_f)[h]); const float cd = fexp(lg * (float)C2);
        f32x4 S = (f32x4){0.f, 0.f, 0.f, 0.f};
        for (int s = 0; s < NCH; ++s) { const int n = dir ? (NCH - 1 - s) : s;
            const f32x4 kv = *(const GAS f32x4*)(kvT + (((size_t)dh * NCH + n) * 256 + dv) * 256 + dk4 * 4);
            v2u w; w.x = cvt_pk_bf16(S[0], S[1]); w.y = cvt_pk_bf16(S[2], S[3]);
            *(GAS v2u*)(Bcat + ((size_t)(h * NCH + n) * 256 + dv) * CAT + 256 + dir * 256 + dk4 * 4) = w;
            S = S * cd + kv; }
    }
}

__device__ __forceinline__ void p6_router(Frame& F) {
    const float* z1 = WSP(float, WS_Z1); bf16* h1b = WSP(bf16, WS_H1B); float* st1 = WSP(float, WS_ST0) + 2 * T;
    int* topi = WSP(int, WS_RT); float* gate = (float*)(topi + 4 * T); int* posb = (int*)(gate + 4 * T); int* row_tok = posb + 4 * T;
    LAS float* hc = (LAS float*)F.lds;
    LAS float* wrc = hc + 64 * 257;
    LAS float* stl = wrc + 256 * 32;
    LAS float* lg = stl + 128;
    LAS int* hist = (LAS int*)(lg + 64 * 33);
    for (int blk = F.vcu; blk < T / 64; blk += F.G) {
        const int t0 = blk * 64;
        for (int rr = 0; rr < 8; ++rr) { const int row = F.wave * 8 + rr, m = t0 + row;
            const GAS f32x4* xr = (const GAS f32x4*)(z1 + (size_t)m * D) + F.lane; f32x4 v[8]; float s = 0.f;
#pragma unroll
            for (int j = 0; j < 8; ++j) { v[j] = xr[64 * j]; s += (v[j][0] + v[j][1]) + (v[j][2] + v[j][3]); }
            const float mean = wave_sum(s) * (1.f / D); float s2 = 0.f;
#pragma unroll
            for (int j = 0; j < 8; ++j) { v[j] = v[j] - mean; s2 += (v[j][0] * v[j][0] + v[j][1] * v[j][1]) + (v[j][2] * v[j][2] + v[j][3] * v[j][3]); }
            const float rstd = 1.f / sqrtf(wave_sum(s2) * (1.f / D) + LN_EPS);
            GAS v2u* o8 = (GAS v2u*)(h1b + (size_t)m * D) + F.lane;
#pragma unroll
            for (int j = 0; j < 8; ++j) { const f32x4 g = *((const GAS f32x4*)F.ln1_g + F.lane + 64 * j), b = *((const GAS f32x4*)F.ln1_b + F.lane + 64 * j);
                const f32x4 hh = v[j] * rstd * g + b; v2u w; w.x = cvt_pk_bf16(hh[0], hh[1]); w.y = cvt_pk_bf16(hh[2], hh[3]); o8[64 * j] = w; }
            if (F.lane == 0) { st1[2 * m] = mean; st1[2 * m + 1] = rstd; stl[2 * row] = mean; stl[2 * row + 1] = rstd; }
        }
        if (F.tid < 64) hist[F.tid] = 0;
        __syncthreads();
        const int row = F.tid >> 3, e0 = (F.tid & 7) * 4; f32x4 accl = (f32x4){0.f, 0.f, 0.f, 0.f};
        for (int kc = 0; kc < 8; ++kc) {
            for (int i = F.tid; i < 64 * 64; i += NTHR) { const int r = i >> 6, c4 = (i & 63) * 4, col = kc * 256 + c4;
                const f32x4 zv = *(const GAS f32x4*)(z1 + (size_t)(t0 + r) * D + col), g = *(const GAS f32x4*)(F.ln1_g + col), b = *(const GAS f32x4*)(F.ln1_b + col);
                const f32x4 hh = (zv - stl[2 * r]) * stl[2 * r + 1] * g + b; LAS float* d = hc + r * 257 + c4; d[0] = hh[0]; d[1] = hh[1]; d[2] = hh[2]; d[3] = hh[3]; }
            for (int i = F.tid; i < 256 * 8; i += NTHR) { const int k = i >> 3, c4 = (i & 7) * 4; *(LAS f32x4*)(wrc + k * 32 + c4) = *(const GAS f32x4*)(F.w_r + (size_t)(kc * 256 + k) * NE + c4); }
            __syncthreads();
#pragma unroll 8
            for (int k = 0; k < 256; ++k) { const float hv = hc[row * 257 + k]; const f32x4 w = *(const LAS f32x4*)(wrc + k * 32 + e0); accl = accl + w * hv; }
            __syncthreads();
        }
        { const f32x4 br = *(const GAS f32x4*)(F.b_r + e0); LAS float* d = lg + row * 33 + e0; d[0] = accl[0] + br[0]; d[1] = accl[1] + br[1]; d[2] = accl[2] + br[2]; d[3] = accl[3] + br[3]; }
        __syncthreads();
        int ek[4] = {0, 0, 0, 0}, lp[4] = {0, 0, 0, 0}; float gk[4] = {0.f, 0.f, 0.f, 0.f};
        if (F.tid < 64) {
            float lv[4]; unsigned used = 0u;
#pragma unroll
            for (int k = 0; k < 4; ++k) { float best = -3.0e38f; int bi = 0;
                for (int e = 0; e < NE; ++e) { const float v = lg[F.tid * 33 + e]; const bool ok = !((used >> e) & 1u) && (v > best); best = ok ? v : best; bi = ok ? e : bi; }
                used |= 1u << bi; ek[k] = bi; lv[k] = best; }
            const float mx = lv[0]; float den = 0.f;
#pragma unroll
            for (int k = 0; k < 4; ++k) { gk[k] = fexp(lv[k] - mx); den += gk[k]; }
            const float rd = 1.f / den;
#pragma unroll
            for (int k = 0; k < 4; ++k) { gk[k] *= rd; lp[k] = __hip_atomic_fetch_add(&hist[ek[k]], 1, __ATOMIC_RELAXED, __HIP_MEMORY_SCOPE_WORKGROUP); }
        }
        __syncthreads();
        if (F.tid < NE) hist[32 + F.tid] = (int)__hip_atomic_fetch_add(F.ctl + CW_CNT + 64 * F.tid, (unsigned)hist[F.tid], RLX_AGENT);
        __syncthreads();
        if (F.tid < 64) { const int tok = t0 + F.tid;
#pragma unroll
            for (int k = 0; k < 4; ++k) { const int pos = hist[32 + ek[k]] + lp[k]; row_tok[(size_t)ek[k] * T + pos] = tok; topi[4 * tok + k] = ek[k]; gate[4 * tok + k] = gk[k]; posb[4 * tok + k] = pos; } }
        __syncthreads();
    }
}

__device__ __forceinline__ void build_tstart(Frame& F, LAS int* tstart) {
    if (F.tid == 0) { int s = 0; for (int e = 0; e < NE; ++e) { tstart[e] = s; const unsigned n = __hip_atomic_load(F.ctl + CW_CNT + 64 * e, RLX_AGENT); s += (int)((n + 255u) >> 8); } tstart[NE] = s; }
    __syncthreads();
}

__device__ __forceinline__ void p9_combine(Frame& F, const LAS int* tstart) {
    const float* z1 = WSP(float, WS_Z1); const float* st1 = WSP(float, WS_ST0) + 2 * T; const bf16* yr = WSP(bf16, WS_YR);
    const int* topi = WSP(int, WS_RT); const float* gate = (const float*)(topi + 4 * T); const int* posb = (const int*)(gate + 4 * T);
    const int gw = F.vcu * NWAVES + F.wave, NGW = F.G * NWAVES;
    for (int m = gw; m < T; m += NGW) {
        const float mean1 = st1[2 * m], rstd1 = st1[2 * m + 1];
        size_t ro[4]; float gk[4];
#pragma unroll
        for (int k = 0; k < 4; ++k) { const int e = topi[4 * m + k]; ro[k] = ((size_t)tstart[e] * 256 + posb[4 * m + k]) * D; gk[k] = gate[4 * m + k]; }
        f32x4 v[8]; float s = 0.f;
#pragma unroll
        for (int j = 0; j < 8; ++j) { const int col = 4 * F.lane + 256 * j;
            const f32x4 zv = *(const GAS f32x4*)(z1 + (size_t)m * D + col), g = *(const GAS f32x4*)(F.ln1_g + col), b = *(const GAS f32x4*)(F.ln1_b + col);
            f32x4 a = ((zv - mean1) * rstd1 * g + b) * ALPHA;
#pragma unroll
            for (int k = 0; k < 4; ++k) { const v2u w = *(const GAS v2u*)(yr + ro[k] + col); a[0] += gk[k] * bf_lo(w.x); a[1] += gk[k] * bf_hi(w.x); a[2] += gk[k] * bf_lo(w.y); a[3] += gk[k] * bf_hi(w.y); }
            v[j] = a; s += (a[0] + a[1]) + (a[2] + a[3]); }
        const float mean = wave_sum(s) * (1.f / D); float s2 = 0.f;
#pragma unroll
        for (int j = 0; j < 8; ++j) { v[j] = v[j] - mean; s2 += (v[j][0] * v[j][0] + v[j][1] * v[j][1]) + (v[j][2] * v[j][2] + v[j][3] * v[j][3]); }
        const float rstd = 1.f / sqrtf(wave_sum(s2) * (1.f / D) + LN_EPS);
#pragma unroll
        for (int j = 0; j < 8; ++j) { const int col = 4 * F.lane + 256 * j; const f32x4 g = *(const GAS f32x4*)(F.ln2_g + col), b = *(const GAS f32x4*)(F.ln2_b + col);
            *(GAS f32x4*)(F.out + (size_t)m * D + col) = v[j] * rstd * g + b; }
    }
}

constexpr int NPH = 10;
__global__ void __launch_bounds__(NTHR, 2) fwd(Args args) {
    extern __shared__ __attribute__((aligned(16))) unsigned char lds_raw[];
    Frame F;
    F.lds = (LAS unsigned char*)lds_raw; F.ws = args.ws; F.ctl = (unsigned*)(args.ws + WS_CTL);
    F.tid = threadIdx.x; F.lane = F.tid & 63; F.wave = __builtin_amdgcn_readfirstlane(F.tid >> 6);
    F.G = gridDim.x; { const int bx = blockIdx.x; F.vcu = (F.G % 8 == 0) ? (bx % 8) * (F.G / 8) + bx / 8 : bx; }
    F.x = args.in[0]; F.ln0_g = args.in[1]; F.ln0_b = args.in[2]; F.w_in = args.in[3]; F.dec_f = args.in[4]; F.dec_b = args.in[5]; F.gn_g = args.in[6]; F.w_out = args.in[7];
    F.ln1_g = args.in[8]; F.ln1_b = args.in[9]; F.w_r = args.in[10]; F.b_r = args.in[11]; F.w_up = args.in[12]; F.b_up = args.in[13]; F.w_dn = args.in[14]; F.b_dn = args.in[15];
    F.ln2_g = args.in[16]; F.ln2_b = args.in[17]; F.out = args.out;
    volatile LAS unsigned* lctl = (volatile LAS unsigned*)(F.lds + LDS_CTL_OFF);
    LAS int* tstart = (LAS int*)(F.lds + LDS_CTL_OFF + 64);
    for (int u = F.tid; u < 128; u += NTHR) lctl[u] = 0u;
    __syncthreads();
    const int lo = args.ph_lo, hi = args.ph_hi;
    const bool single = (hi - lo) > 1;
    XcdBarrier bar; bar.bar = F.ctl + CW_BAR; bar.x = 0; bar.st = lctl;
    if (single) bar = xcd_barrier_post(F.ctl + CW_BAR, lctl);
#ifndef PH_MASK
#define PH_MASK 0x3ff
#endif
#define IN(k) (((PH_MASK >> (k)) & 1) && lo <= (k) && (k) < hi)
#ifndef SUB_MASK
#define SUB_MASK 0xff
#endif
#define SUB(n) ((SUB_MASK >> (n)) & 1)
#define SEAM(k) do { if (IN(k) && IN((k) + 1)) xcd_barrier(bar); } while (0)
    const int bc = (int)blockIdx.x;

    if (IN(0)) { p0_prologue(F); __syncthreads(); }
    SEAM(0);
    if (IN(1)) {
        if (SUB(0)) { SchedG1N S; S.nt = D / 64; S.pitchA = D; S.pitchB = D; S.multA = 1; S.multB = 1; S.G = F.G; S.c = bc; S.A = (const char*)WSP(bf16, WS_H0B); S.Bt = (const char*)WSP(bf16, WS_WIN);
          EpiG1N E{WSP(bf16, WS_QS), WSP(bf16, WS_KK), WSP(bf16, WS_GS), WSP(bf16, WS_ACAT), F.dec_f, F.dec_b};
          gm::gemm_run<EpiG1N, SchedG1N, false>(F.lds, S, E); }
        if (SUB(1)) { SchedG1SF S; S.nt = D / 64; S.pitchA = D; S.pitchB = D; S.multA = 1; S.multB = 128; S.G = F.G; S.c = bc; S.A = (const char*)WSP(bf16, WS_WIN); S.Bt = (const char*)WSP(bf16, WS_H0B);
          EpiG1SF E{WSP(bf16, WS_UTT)};
          gm::gemm_run<EpiG1SF, SchedG1SF, false>(F.lds, S, E); }
        if (SUB(2)) { SchedG1SKV S; S.nt = D / 64; S.pitchA = D; S.pitchB = D; S.multA = 1; S.multB = 1; S.G = F.G; S.c = bc; S.A = (const char*)WSP(bf16, WS_WIN); S.Bt = (const char*)WSP(bf16, WS_H0B);
          EpiG1SKV E{WSP(bf16, WS_KTW), WSP(bf16, WS_BCAT), F.dec_f, F.dec_b};
          gm::gemm_run<EpiG1SKV, SchedG1SKV, false>(F.lds, S, E); }
    }
    SEAM(1);
    if (IN(2)) {
        if (SUB(3)) { SchedFixA S; S.nt = 2; S.pitchA = 128; S.pitchB = 128; S.multA = 1; S.multB = 1; S.G = F.G; S.c = bc; S.A = (const char*)WSP(bf16, WS_TAB); S.Bt = (const char*)WSP(bf16, WS_UTT); S.ncol = 512;
          EpiS1 E{WSP(bf16, WS_A1)};
          gm::gemm_run<EpiS1, SchedFixA, false>(F.lds, S, E); }
        if (SUB(4)) { SchedScores S; S.nt = 4; S.pitchA = RW; S.pitchB = RW; S.multA = 1; S.multB = 1; S.G = F.G; S.c = bc; S.Q = (const char*)WSP(bf16, WS_QS); S.Kk = (const char*)WSP(bf16, WS_KK);
          EpiScores E{WSP(bf16, WS_ACAT), F.dec_f, F.dec_b};
          gm::gemm_run<EpiScores, SchedScores, false>(F.lds, S, E); }
        if (SUB(5)) { SchedKV S; S.nt = 4; S.pitchA = CAT; S.pitchB = T; S.multA = 1; S.multB = 1; S.G = F.G; S.c = bc; S.Bcat = (const char*)WSP(bf16, WS_BCAT); S.kTw = (const char*)WSP(bf16, WS_KTW);
          EpiKV E{WSP(float, WS_KVT)};
          gm::gemm_run<EpiKV, SchedKV, false>(F.lds, S, E); }
    }
    SEAM(2);
    if (IN(3)) {
        { SchedFixA S; S.nt = 4; S.pitchA = 256; S.pitchB = 256; S.multA = 1; S.multB = 1; S.G = F.G; S.c = bc; S.A = (const char*)(WSP(bf16, WS_TAB) + 32768); S.Bt = (const char*)WSP(bf16, WS_A1); S.ncol = 512;
          EpiS2 E{WSP(bf16, WS_ZT)};
          gm::gemm_run<EpiS2, SchedFixA, false>(F.lds, S, E); }
        p3_scan(F);
    }
    SEAM(3);
    if (IN(4)) {
        { SchedFixB S; S.nt = 4; S.pitchA = 256; S.pitchB = 256; S.multA = 1; S.multB = 1; S.G = F.G; S.c = bc; S.A = (const char*)WSP(bf16, WS_ZT); S.Bt = (const char*)(WSP(bf16, WS_TAB) + 32768 + 65536); S.nrow = 512;
          EpiChan E{WSP(bf16, WS_Y)};
          gm::gemm_run<EpiChan, SchedFixB, false>(F.lds, S, E); }
        { SchedOut S; S.nt = CAT / 64; S.pitchA = CAT; S.pitchB = CAT; S.multA = 1; S.multB = 1; S.G = F.G; S.c = bc; S.Acat = (const char*)WSP(bf16, WS_ACAT); S.Bcat = (const char*)WSP(bf16, WS_BCAT);
          EpiOut E{WSP(bf16, WS_Y), WSP(bf16, WS_GS), F.gn_g};
          gm::gemm_run<EpiOut, SchedOut, false>(F.lds, S, E); }
    }
    SEAM(4);
    if (IN(5)) {
        Sched2D S; S.nt = D / 64; S.pitchA = D; S.pitchB = D; S.multA = 1; S.multB = 1; S.G = F.G; S.c = bc; S.A = (const char*)WSP(bf16, WS_Y); S.Bt = (const char*)WSP(bf16, WS_WOUT); S.nM = 64; S.nN = 8;
        EpiWout E{WSP(float, WS_Z1), F.x, WSP(float, WS_ST0), F.ln0_g, F.ln0_b};
        gm::gemm_run<EpiWout, Sched2D, false>(F.lds, S, E);
    }
    SEAM(5);
    if (IN(6)) { p6_router(F); }
    SEAM(6);
    if (IN(7) || IN(8) || IN(9)) build_tstart(F, tstart);
    if (IN(7)) {
        SchedMoE S; S.nt = D / 64; S.pitchA = D; S.pitchB = D; S.multA = 1; S.multB = 1; S.G = F.G; S.c = bc; S.A = (const char*)WSP(bf16, WS_H1B); S.Bt = (const char*)WSP(bf16, WS_WUP);
        S.tstart = tstart; S.row_tok = WSP(int, WS_RT) + 12 * T; S.cnt = F.ctl + CW_CNT; S.nN = 16; S.estride = (size_t)2 * DFF * D * 2;
        EpiUp E{WSP(bf16, WS_ACT), F.b_up};
        gm::gemm_run<EpiUp, SchedMoE, true>(F.lds, S, E);
    }
    SEAM(7);
    if (IN(8)) {
        SchedMoEDown S; S.nt = DFF / 64; S.pitchA = DFF; S.pitchB = DFF; S.multA = 1; S.multB = 1; S.G = F.G; S.c = bc; S.A = (const char*)WSP(bf16, WS_ACT); S.Bt = (const char*)WSP(bf16, WS_WDN);
        S.tstart = tstart; S.row_tok = nullptr; S.cnt = F.ctl + CW_CNT; S.nN = 8; S.estride = (size_t)D * DFF * 2;
        EpiDown E{WSP(bf16, WS_YR), F.b_dn};
        gm::gemm_run<EpiDown, SchedMoEDown, false>(F.lds, S, E);
    }
    SEAM(8);
    if (IN(9)) { p9_combine(F, tstart); }
#undef IN
#undef SEAM
}

#ifndef MK_SPLIT
#define MK_SPLIT 1
#endif
extern "C" void kernel_launch(void* const* d_in, const int* in_sizes, int n_in, void* d_out, int out_size, void* d_ws, size_t ws_size, hipStream_t stream) {
    static int grid = 0;
    if (grid == 0) {
        if (n_in != 18 || out_size != T * D || ws_size < WS_END) { fprintf(stderr, "kernel_launch: unexpected problem: n_in %d out %d ws %zu (need %zu)\n", n_in, out_size, ws_size, (size_t)WS_END); grid = -1; return; }
        int dev = 0, cus = 0, per_cu = 0;
        if (hipGetDevice(&dev) != hipSuccess || hipDeviceGetAttribute(&cus, hipDeviceAttributeMultiprocessorCount, dev) != hipSuccess) { grid = -1; return; }
        if (hipFuncSetAttribute((const void*)fwd, hipFuncAttributeMaxDynamicSharedMemorySize, LDS_BYTES) != hipSuccess) { fprintf(stderr, "kernel_launch: hipFuncSetAttribute failed\n"); grid = -1; return; }
        if (hipOccupancyMaxActiveBlocksPerMultiprocessor(&per_cu, (const void*)fwd, NTHR, LDS_BYTES) != hipSuccess || per_cu < 1) { fprintf(stderr, "kernel_launch: occupancy query reports %d\n", per_cu); }
        (void)hipGetLastError();
        grid = cus;
    }
    if (grid < 0) return;
    (void)hipMemsetAsync((char*)d_ws + WS_CTL, 0, CTL_BYTES, stream);
    Args a{};
    for (int i = 0; i < 18; ++i) a.in[i] = (const float*)d_in[i];
    a.out = (float*)d_out; a.ws = (unsigned char*)d_ws;
#if MK_SPLIT
    for (int p = 0; p < NPH; ++p) { a.ph_lo = p; a.ph_hi = p + 1; hipLaunchKernelGGL(fwd, dim3(grid), dim3(NTHR), LDS_BYTES, stream, a); }
#else
    a.ph_lo = 0; a.ph_hi = NPH; hipLaunchKernelGGL(fwd, dim3(grid), dim3(NTHR), LDS_BYTES, stream, a);
#endif
}
```

```cpp
#include <hip/hip_runtime.h>
#include <cstdio>
#include <cstdint>

#define GAS __attribute__((address_space(1)))
#define LAS __attribute__((address_space(3)))
typedef unsigned short bf16;
typedef unsigned v4u __attribute__((ext_vector_type(4)));
typedef unsigned v2u __attribute__((ext_vector_type(2)));
typedef float f32x4 __attribute__((ext_vector_type(4)));
typedef float f32x2 __attribute__((ext_vector_type(2)));
typedef short bf16x8 __attribute__((ext_vector_type(8)));
#define RLX_AGENT __ATOMIC_RELAXED, __HIP_MEMORY_SCOPE_AGENT
#define LDS_WAIT() asm volatile("s_waitcnt lgkmcnt(0)" ::: "memory")
#define VM_WAIT() asm volatile("s_waitcnt vmcnt(0)" ::: "memory")

constexpr int T = 16384, D = 2048, DIN = 5120, FW = 1024, RW = 1024, NH = 4, HD = 256, NE = 32, TOPK = 4, DFF = 2048;
constexpr int C2 = 256, NCH = T / C2;
constexpr int CAT = 768;
constexpr float LN_EPS = 1e-5f, GN_EPS = 1e-6f, ALPHA = 1.189207115002721f;
constexpr int RT_MAX = (T * TOPK) / 256 + NE;
constexpr int NWAVES = 8, NTHR = 512;

constexpr size_t MiB = 1u << 20;
constexpr size_t WS_CTL = 0, CTL_BYTES = 1 * MiB;
constexpr size_t WS_TAB = 1 * MiB;
constexpr size_t WS_WIN = 2 * MiB;
constexpr size_t WS_WOUT = WS_WIN + 20 * MiB;
constexpr size_t WS_WUP = WS_WOUT + 8 * MiB;
constexpr size_t WS_WDN = WS_WUP + 512 * MiB;
constexpr size_t WS_H0B = WS_WDN + 256 * MiB;
constexpr size_t WS_ST0 = WS_H0B + 64 * MiB;
constexpr size_t WS_UTT = WS_ST0 + 1 * MiB;
constexpr size_t WS_A1 = WS_UTT + 32 * MiB;
constexpr size_t WS_ZT = WS_A1 + 64 * MiB;
constexpr size_t WS_QS = WS_ZT + 64 * MiB;
constexpr size_t WS_KK = WS_QS + 32 * MiB;
constexpr size_t WS_GS = WS_KK + 32 * MiB;
constexpr size_t WS_ACAT = WS_GS + 32 * MiB;
constexpr size_t WS_BCAT = WS_ACAT + 96 * MiB;
constexpr size_t WS_KTW = WS_BCAT + 96 * MiB;
constexpr size_t WS_KVT = WS_KTW + 64 * MiB;
constexpr size_t WS_Y = WS_KVT + 128 * MiB;
constexpr size_t WS_Z1 = WS_Y + 64 * MiB;
constexpr size_t WS_H1B = WS_Z1 + 128 * MiB;
constexpr size_t WS_RT = WS_H1B + 64 * MiB;
constexpr size_t WS_ACT = WS_RT + 4 * MiB;
constexpr size_t WS_YR = WS_ACT + 288 * MiB;
constexpr size_t WS_END = WS_YR + 288 * MiB;
constexpr int CW_BAR = 1024;
constexpr int CW_CNT = 8192;

constexpr int LDS_STAGE = 131072, LDS_SCR = 16384, LDS_CTL_OFF = LDS_STAGE + LDS_SCR, LDS_BYTES = LDS_CTL_OFF + 512;

__device__ __forceinline__ unsigned cvt_pk_bf16(float lo, float hi) { unsigned r; asm volatile("v_cvt_pk_bf16_f32 %0, %1, %2" : "=v"(r) : "v"(lo), "v"(hi)); return r; }
__device__ __forceinline__ float bf_lo(unsigned u) { return __builtin_bit_cast(float, u << 16); }
__device__ __forceinline__ float bf_hi(unsigned u) { return __builtin_bit_cast(float, u & 0xffff0000u); }
__device__ __forceinline__ v4u pack8(const f32x4 a, const f32x4 b) { v4u w; w.x = cvt_pk_bf16(a[0], a[1]); w.y = cvt_pk_bf16(a[2], a[3]); w.z = cvt_pk_bf16(b[0], b[1]); w.w = cvt_pk_bf16(b[2], b[3]); return w; }
__device__ __forceinline__ float wave_sum(float v) {
#pragma unroll
    for (int o = 1; o < 64; o <<= 1) v += __shfl_xor(v, o);
    return v;
}
__device__ __forceinline__ float fexp(float x) { return __builtin_amdgcn_exp2f(x * 1.4426950408889634f); }
__device__ __forceinline__ void cs_rev(float rev, float& c, float& s) { const float f = __builtin_amdgcn_fractf(rev); c = __builtin_amdgcn_cosf(f); s = __builtin_amdgcn_sinf(f); }

#define XB_TMO      128
#define XB_XCNT(j)  (256  + 64 * (j))
#define XB_XSUB(j)  (1280 + 64 * (j))
#define XB_XGEN(j)  (2304 + 64 * (j))
#define XB_TOP      3328
#define XB_TOPGEN   3392
#define XCD_BAR_WORDS 3456
#define XB_SPIN_CAP (1u << 18)
__device__ __forceinline__ unsigned xb_ld(unsigned* p)              { return __hip_atomic_load(p, __ATOMIC_RELAXED, __HIP_MEMORY_SCOPE_AGENT); }
__device__ __forceinline__ unsigned xb_add(unsigned* p, unsigned v) { return __hip_atomic_fetch_add(p, v, __ATOMIC_RELAXED, __HIP_MEMORY_SCOPE_AGENT); }
__device__ __forceinline__ unsigned xb_xcc_id() { return (unsigned)__builtin_amdgcn_s_getreg((3 << 11) | 20) & 0xFu; }
#define XB_SPIN(cond, bar) do { unsigned _sp = 0; while (cond) { __builtin_amdgcn_s_sleep(1); \
    if ((++_sp & 255u) == 0u) { if (xb_ld(&(bar)[XB_TMO])) break; if (_sp > XB_SPIN_CAP) { atomicAdd(&(bar)[XB_TMO], 1u); break; } } } } while (0)
struct XcdBarrier { unsigned* bar; unsigned x; volatile LAS unsigned* st; };
__device__ __forceinline__ XcdBarrier xcd_barrier_post(unsigned* bar, volatile LAS unsigned* st) {
    XcdBarrier b; b.bar = bar; b.x = xb_xcc_id(); b.st = st;
    if (threadIdx.x == 0) (void)xb_add(&bar[XB_XCNT(b.x)], 1u);
    return b;
}
__device__ __forceinline__ void xcd_barrier_complete(unsigned* bar, unsigned x, unsigned& nloc, unsigned& nx) {
    const unsigned G = gridDim.x * gridDim.y * gridDim.z;
    unsigned sum, cnt, mine, sp = 0u;
    for (;;) {
        sum = 0u; cnt = 0u; mine = 0u;
#pragma unroll
        for (unsigned j = 0; j < 16; ++j) { const unsigned c = xb_ld(&bar[XB_XCNT(j)]); sum += c; cnt += (c > 0u) ? 1u : 0u; mine = (j == x) ? c : mine; }
        if (sum == G) break;
        __builtin_amdgcn_s_sleep(1);
        if ((++sp & 255u) == 0u) { if (xb_ld(&bar[XB_TMO])) break; if (sp > XB_SPIN_CAP) { atomicAdd(&bar[XB_TMO], 1u); break; } }
    }
    nloc = mine > 0u ? mine : 1u; nx = cnt > 0u ? cnt : 1u;
}
__device__ __forceinline__ void xcd_barrier(const XcdBarrier& b) {
    asm volatile("s_waitcnt vmcnt(0)" ::: "memory");
    __syncthreads();
    if (threadIdx.x == 0) {
        unsigned* bar = b.bar;
        __builtin_amdgcn_s_waitcnt(0);
        unsigned nloc = b.st[0], nx = b.st[1];
        if (nloc == 0u) { xcd_barrier_complete(bar, b.x, nloc, nx); b.st[0] = nloc; b.st[1] = nx; }
        const unsigned old = xb_add(&bar[XB_XSUB(b.x)], 1u);
        const unsigned gen = old / nloc;
        if (old + 1u == (gen + 1u) * nloc) {
            __builtin_amdgcn_fence(__ATOMIC_RELEASE, "agent");
            asm volatile("s_waitcnt vmcnt(0)" ::: "memory");
            const unsigned og = xb_add(&bar[XB_TOP], 1u);
            const unsigned tg = og / nx;
            if (og + 1u == (tg + 1u) * nx) xb_add(&bar[XB_TOPGEN], 1u);
            else XB_SPIN(xb_ld(&bar[XB_TOPGEN]) == tg, bar);
            __builtin_amdgcn_fence(__ATOMIC_ACQUIRE, "agent");
            xb_add(&bar[XB_XGEN(b.x)], 1u);
            asm volatile("s_waitcnt vmcnt(0)" ::: "memory");
        } else {
            XB_SPIN(xb_ld(&bar[XB_XGEN(b.x)]) == gen, bar);
            __builtin_amdgcn_fence(__ATOMIC_ACQUIRE, "agent");
            asm volatile("s_waitcnt vmcnt(0)" ::: "memory");
        }
    }
    __syncthreads();
}

namespace gm {
constexpr int BM = 256, BK = 64, HALF = 128, HTB = HALF * BK * 2, STAGE_BYTES = 8 * HTB;
__device__ __forceinline__ int lds_byte(int r, int c) { const int st = (r >> 4) * 2 + (c >> 5), rr = r & 15, cc = c & 31, ob = rr * 64 + cc * 2; return st * 1024 + (ob ^ (((ob >> 9) & 1) << 5)); }
__device__ __forceinline__ void stage_rc(int b, int& R, int& C) { const int st = b / 1024, sb = b % 1024, swz = sb ^ (((sb >> 9) & 1) << 5); R = (st >> 1) * 16 + swz / 64; C = (st & 1) * 32 + (swz % 64) / 2; }
__device__ __forceinline__ int perm32(int rho) { const int n = rho >> 4, i = rho & 15; return 8 * (i >> 2) + 4 * n + (i & 3); }

struct Unit { const char* a0; const char* a1; const char* b0; const char* b1; int p0, p1, p2, p3; };

__device__ __forceinline__ void tile_order(int L, int nM, int nN, int& pm, int& pn) {
    const int nwg = nM * nN; int wgid = L;
    { const int q = nwg / 8, r = nwg % 8, xcd = wgid % 8, off = wgid / 8; wgid = (xcd < r ? xcd * (q + 1) : r * (q + 1) + (xcd - r) * q) + off; }
    const int nig = 8 * nN, gid = wgid / nig, fm = gid * 8, gsz = (nM - fm) < 8 ? (nM - fm) : 8;
    pm = fm + ((wgid % nig) % gsz); pn = (wgid % nig) / gsz;
}

template <class Epi, class Sched, bool GATHER>
__device__ __forceinline__ void gemm_run(LAS unsigned char* lds, const Sched& S, const Epi& E) {
    const int tid = threadIdx.x, wid = __builtin_amdgcn_readfirstlane(tid >> 6), lane = tid & 63, wr = wid >> 2, wc = wid & 3, fr = lane & 15, fq = lane >> 4;
    int nt = S.nt; asm volatile("" : "+s"(nt));
    unsigned voffA[2], voffB[2], colA[2]; int rowA[2];
#pragma unroll
    for (int i = 0; i < 2; ++i) { int R, C; stage_rc(tid * 16 + i * 8192, R, C); const int Rb = Epi::PERM ? ((R & ~31) + perm32(R & 31)) : R;
        voffA[i] = (unsigned)(R * S.multA * S.pitchA + C) * 2u; voffB[i] = (unsigned)(Rb * S.multB * S.pitchB + C) * 2u; colA[i] = (unsigned)C * 2u; rowA[i] = R; }
    const size_t kstep = (size_t)(BK * 2);
    const unsigned ldsw = (unsigned)wid * 1024u;
    const int aoff = lds_byte(wr * 64 + fr, fq * 8), boff = lds_byte(wc * 32 + fr, fq * 8);
#define G_SA(b, h) (((b) * 2 + (h)) * HTB)
#define G_SB(b, h) ((4 + (b) * 2 + (h)) * HTB)
#define G_STAGE(bufoff, gbase, voff) do { _Pragma("unroll") for (int _i = 0; _i < 2; ++_i) \
        __builtin_amdgcn_global_load_lds((const unsigned*)((const char*)(gbase) + (voff)[_i]), (LAS unsigned*)(lds + (bufoff) + ldsw + _i * 8192), 16, 0, 0); } while (0)
#define G_LDA(dst, b, h) do { _Pragma("unroll") for (int m = 0; m < 4; ++m) _Pragma("unroll") for (int k = 0; k < 2; ++k) dst[m][k] = *(const LAS bf16x8*)(lds + G_SA(b, h) + aoff + m * 2048 + k * 1024); } while (0)
#define G_LDB(dst, b, h) do { _Pragma("unroll") for (int n = 0; n < 2; ++n) _Pragma("unroll") for (int k = 0; k < 2; ++k) dst[n][k] = *(const LAS bf16x8*)(lds + G_SB(b, h) + boff + n * 2048 + k * 1024); } while (0)
#define G_MMA(ai, bj, At, Bt) do { __builtin_amdgcn_s_setprio(1); _Pragma("unroll") for (int m = 0; m < 4; ++m) _Pragma("unroll") for (int n = 0; n < 2; ++n) _Pragma("unroll") for (int k = 0; k < 2; ++k) \
        acc[ai][bj][m][n] = __builtin_amdgcn_mfma_f32_16x16x32_bf16(Bt[n][k], At[m][k], acc[ai][bj][m][n], 0, 0, 0); __builtin_amdgcn_s_setprio(0); } while (0)
#define G_WAIT_V(n) asm volatile("s_waitcnt vmcnt(" #n ")" ::: "memory")
#define G_WAIT_L(n) asm volatile("s_waitcnt lgkmcnt(" #n ")" ::: "memory")
#define G_BAR __builtin_amdgcn_s_barrier()
#define G_SCHED __builtin_amdgcn_sched_barrier(0)
    Unit cur, nxt; int ui = 0;
    if (!S.next(0, cur)) return;
    f32x4 acc[2][2][4][2];
#pragma unroll
    for (int a = 0; a < 2; ++a)
#pragma unroll
        for (int b = 0; b < 2; ++b)
#pragma unroll
            for (int m = 0; m < 4; ++m)
#pragma unroll
                for (int n = 0; n < 2; ++n) acc[a][b][m][n] = (f32x4){0.f, 0.f, 0.f, 0.f};
    bf16x8 At[4][2], B0[2][2], B1[2][2];
    unsigned gc0[2], gc1[2];
    if constexpr (GATHER) {
#pragma unroll
        for (int i = 0; i < 2; ++i) { gc0[i] = S.row_off(cur, rowA[i]) + colA[i]; gc1[i] = S.row_off(cur, 128 + rowA[i]) + colA[i]; }
    }
#define vA0 (GATHER ? gc0 : voffA)
#define vA1 (GATHER ? gc1 : voffA)
    G_STAGE(G_SB(0, 0), cur.b0, voffB); G_STAGE(G_SB(0, 1), cur.b1, voffB); G_STAGE(G_SA(0, 0), cur.a0, vA0); G_STAGE(G_SA(0, 1), cur.a1, vA1);
    if (wr == 1) G_BAR;
    G_WAIT_V(2); G_BAR;
    G_STAGE(G_SB(1, 0), cur.b0 + kstep, voffB); G_STAGE(G_SA(1, 0), cur.a0 + kstep, vA0); G_STAGE(G_SB(1, 1), cur.b1 + kstep, voffB);
    G_WAIT_V(6); G_BAR;
    for (;;) {
        const bool has_next = S.next(ui + 1, nxt);
        if (!has_next) nxt = cur;
        for (int t = 0; t < nt; t += 2) {
            const bool last = (t == nt - 2);
            unsigned tn1[2] = {0u, 0u};
            if constexpr (GATHER) { if (last) { int tz = tid; asm volatile("" : "+v"(tz));
#pragma unroll
                for (int i = 0; i < 2; ++i) { int R, C; stage_rc(tz * 16 + i * 8192, R, C); gc0[i] = S.row_off(nxt, R) + (unsigned)C * 2u; tn1[i] = S.row_off(nxt, 128 + R) + (unsigned)C * 2u; } } }
            const char* a11 = cur.a1 + (size_t)(t + 1) * kstep;
            const char* a02 = last ? nxt.a0 : cur.a0 + (size_t)(t + 2) * kstep; const char* a12 = last ? nxt.a1 : cur.a1 + (size_t)(t + 2) * kstep;
            const char* b02 = last ? nxt.b0 : cur.b0 + (size_t)(t + 2) * kstep; const char* b12 = last ? nxt.b1 : cur.b1 + (size_t)(t + 2) * kstep;
            G_LDB(B0, 0, 0); G_LDB(B1, 0, 1); G_SCHED; G_LDA(At, 0, 0); G_STAGE(G_SA(1, 1), a11, vA1);
            if constexpr (GATHER) { if (last) { gc1[0] = tn1[0]; gc1[1] = tn1[1]; } }
            G_WAIT_V(8); G_WAIT_L(0); G_BAR; G_MMA(0, 0, At, B0); G_MMA(0, 1, At, B1); G_BAR; G_SCHED;
            G_LDA(At, 0, 1); G_STAGE(G_SB(0, 0), b02, voffB); G_STAGE(G_SB(0, 1), b12, voffB); G_STAGE(G_SA(0, 0), a02, vA0);
            G_WAIT_V(8); G_WAIT_L(0); G_BAR; G_MMA(1, 0, At, B0); G_MMA(1, 1, At, B1); G_BAR; G_SCHED;
            G_LDB(B0, 1, 0); G_LDB(B1, 1, 1); G_SCHED; G_LDA(At, 1, 0); G_STAGE(G_SA(0, 1), a12, vA1);
            G_WAIT_V(8); G_WAIT_L(0); G_BAR; G_MMA(0, 0, At, B0); G_MMA(0, 1, At, B1); G_BAR; G_SCHED;
            G_LDA(At, 1, 1); G_STAGE(G_SB(1, 0), b02 + kstep, voffB); G_STAGE(G_SB(1, 1), b12 + kstep, voffB); G_STAGE(G_SA(1, 0), a02 + kstep, vA0);
            G_WAIT_V(8); G_WAIT_L(0); G_BAR; G_MMA(1, 0, At, B0); G_MMA(1, 1, At, B1); G_BAR; G_SCHED;
        }
        if (wr == 0) G_BAR;
        { int fr2 = fr, fq2 = fq; asm volatile("" : "+v"(fr2), "+v"(fq2));
          E(acc, cur, lds, wr, wc, fr2, fq2); }
        if (!has_next) break;
#pragma unroll
        for (int a = 0; a < 2; ++a)
#pragma unroll
            for (int b = 0; b < 2; ++b)
#pragma unroll
                for (int m = 0; m < 4; ++m)
#pragma unroll
                    for (int n = 0; n < 2; ++n) acc[a][b][m][n] = (f32x4){0.f, 0.f, 0.f, 0.f};
        cur = nxt; ++ui;
        if (wr == 1) G_BAR;
    }
    G_WAIT_V(0);
    G_BAR;
#undef G_SA
#undef G_SB
#undef G_STAGE
#undef G_LDA
#undef G_LDB
#undef G_MMA
#undef G_WAIT_V
#undef G_WAIT_L
#undef G_BAR
#undef G_SCHED
#undef vA0
#undef vA1
}
}
using gm::Unit;
typedef f32x4 Acc[2][2][4][2];

struct Args { const float* in[18]; float* out; unsigned char* ws; int ph_lo, ph_hi; };
struct Frame {
    LAS unsigned char* lds; unsigned char* ws; unsigned* ctl;
    int tid, lane, wave, vcu, G;
    const float *x, *ln0_g, *ln0_b, *w_in, *dec_f, *dec_b, *gn_g, *w_out, *ln1_g, *ln1_b, *w_r, *b_r, *w_up, *b_up, *w_dn, *b_dn, *ln2_g, *ln2_b;
    float* out;
};
#define WSP(T_, off) ((T_*)(F.ws + (off)))

template <class ColMap>
__device__ __forceinline__ void transpose_item(const float* W, int K, int N, bf16* WT, LAS float* scr, int item, int lane, const ColMap& cm) {
    const int nblk = N / 64, kb = item / nblk, nb = item % nblk, k0 = 64 * kb, n0 = 64 * nb;
    const int s0 = cm(n0);
#pragma unroll 4
    for (int i = 0; i < 16; ++i) { const int kk = 4 * i + (lane >> 4), c4 = (lane & 15) * 4;
        const f32x4 v = *(const GAS f32x4*)(W + (size_t)(k0 + kk) * N + s0 + c4);
        LAS float* d = scr + kk * 65 + c4; d[0] = v[0]; d[1] = v[1]; d[2] = v[2]; d[3] = v[3]; }
    LDS_WAIT(); asm volatile("" ::: "memory");
    const int c = lane & 7;
#pragma unroll
    for (int j = 0; j < 8; ++j) { const int n = (lane >> 3) + 8 * j; const LAS float* s = scr + (8 * c) * 65 + n;
        v4u o; o.x = cvt_pk_bf16(s[0 * 65], s[1 * 65]); o.y = cvt_pk_bf16(s[2 * 65], s[3 * 65]); o.z = cvt_pk_bf16(s[4 * 65], s[5 * 65]); o.w = cvt_pk_bf16(s[6 * 65], s[7 * 65]);
        *(GAS v4u*)(WT + (size_t)(n0 + n) * K + k0 + 8 * c) = o; }
    LDS_WAIT(); asm volatile("" ::: "memory");
}
struct ColId { __device__ __forceinline__ int operator()(int n) const { return n; } };
struct ColUp { __device__ __forceinline__ int operator()(int n) const { return ((n >> 8) * 128 + (n & 127)) + ((n >> 7) & 1) * 2048; } };

__device__ __forceinline__ void p0_prologue(Frame& F) {
    const int gw = F.vcu * NWAVES + F.wave, NGW = F.G * NWAVES;
    {
        bf16* h0b = WSP(bf16, WS_H0B); float* st0 = WSP(float, WS_ST0);
        for (int m = gw; m < T; m += NGW) {
            const GAS f32x4* xr = (const GAS f32x4*)(F.x + (size_t)m * D) + F.lane;
            f32x4 v[8]; float s = 0.f;
#pragma unroll
            for (int j = 0; j < 8; ++j) { v[j] = xr[64 * j]; s += (v[j][0] + v[j][1]) + (v[j][2] + v[j][3]); }
            const float mean = wave_sum(s) * (1.f / D); float s2 = 0.f;
#pragma unroll
            for (int j = 0; j < 8; ++j) { v[j] = v[j] - mean; s2 += (v[j][0] * v[j][0] + v[j][1] * v[j][1]) + (v[j][2] * v[j][2] + v[j][3] * v[j][3]); }
            const float rstd = 1.f / sqrtf(wave_sum(s2) * (1.f / D) + LN_EPS);
            GAS v2u* o8 = (GAS v2u*)(h0b + (size_t)m * D) + F.lane;
#pragma unroll
            for (int j = 0; j < 8; ++j) { const f32x4 g = *((const GAS f32x4*)F.ln0_g + F.lane + 64 * j), b = *((const GAS f32x4*)F.ln0_b + F.lane + 64 * j);
                const f32x4 h = v[j] * rstd * g + b; v2u w; w.x = cvt_pk_bf16(h[0], h[1]); w.y = cvt_pk_bf16(h[2], h[3]); o8[64 * j] = w; }
            if (F.lane == 0) { st0[2 * m] = mean; st0[2 * m + 1] = rstd; }
        }
    }
    {
        bf16* tab = WSP(bf16, WS_TAB);
        for (int i = (F.vcu * NTHR + F.tid); i < 32768 + 65536 + 65536; i += F.G * NTHR) {
            float v;
            if (i < 32768) { const int r = i >> 7, a = i & 127, ri = r >> 7, k1 = r & 127; float c, s; cs_rev((float)((k1 * a) & 127) * (1.f / 128.f), c, s); v = ri ? -s : c; }
            else if (i < 32768 + 65536) { const int e = i - 32768, r = e >> 8, q = e & 255, ri = r >> 7, k2 = r & 127, rj = q >> 7, b = q & 127; float c, s; cs_rev((float)((k2 * b) & 127) * (1.f / 128.f), c, s);
                v = (ri == 0) ? (rj == 0 ? c : s) : (rj == 0 ? -s : c); }
            else { const int e = i - 32768 - 65536, l = e >> 8, q = e & 255, rj = q >> 7, cg = q & 127; float c, s; cs_rev((float)((l * cg) & 127) * (1.f / 128.f), c, s); v = (l < 128) ? (rj == 0 ? c : s) : 0.f; }
            tab[i] = (bf16)(cvt_pk_bf16(v, 0.f) & 0xffffu);
        }
    }
    {
        LAS float* scr = (LAS float*)(F.lds + F.wave * 18432);
        constexpr int I_IN = 32 * (DIN / 64), I_OUT = 32 * (D / 64), I_UP = 32 * (2 * DFF / 64), I_DN = 32 * (D / 64);
        constexpr int NIT = I_IN + I_OUT + NE * I_UP + NE * I_DN;
        for (int it = gw; it < NIT; it += NGW) {
            int r = it;
            if (r < I_IN) { transpose_item(F.w_in, D, DIN, WSP(bf16, WS_WIN), scr, r, F.lane, ColId()); continue; } r -= I_IN;
            if (r < I_OUT) { transpose_item(F.w_out, D, D, WSP(bf16, WS_WOUT), scr, r, F.lane, ColId()); continue; } r -= I_OUT;
            if (r < NE * I_UP) { const int e = r / I_UP; transpose_item(F.w_up + (size_t)e * D * 2 * DFF, D, 2 * DFF, WSP(bf16, WS_WUP) + (size_t)e * 2 * DFF * D, scr, r % I_UP, F.lane, ColUp()); continue; } r -= NE * I_UP;
            { const int e = r / I_DN; transpose_item(F.w_dn + (size_t)e * DFF * D, DFF, D, WSP(bf16, WS_WDN) + (size_t)e * D * DFF, scr, r % I_DN, F.lane, ColId()); }
        }
    }
}

struct SchedBase { int nt, pitchA, pitchB, multA, multB, G, c; };
struct SchedG1N : SchedBase {
    const char* A; const char* Bt;
    __device__ __forceinline__ bool next(int i, Unit& u) const { const int L = i * G + c; if (L >= 64 * 12) return false; int pm, pn; gm::tile_order(L, 64, 12, pm, pn);
        const int cb = pn < 4 ? 1024 + 256 * pn : (pn < 8 ? 2048 + 256 * (pn - 4) : 4096 + 256 * (pn - 8));
        u.a0 = A + (size_t)pm * 256 * D * 2; u.a1 = u.a0 + (size_t)128 * D * 2; u.b0 = Bt + (size_t)cb * D * 2; u.b1 = u.b0 + (size_t)128 * D * 2; u.p0 = pm; u.p1 = pn; u.p2 = 0; u.p3 = 0; return true; }
};
struct SchedG1SF : SchedBase {
    const char* A; const char* Bt;
    __device__ __forceinline__ bool next(int i, Unit& u) const { const int L = i * G + c; if (L >= 4 * 64) return false; int pm, pn; gm::tile_order(L, 4, 64, pm, pn);
        u.a0 = A + (size_t)pm * 256 * D * 2; u.a1 = u.a0 + (size_t)128 * D * 2; u.b0 = Bt + (size_t)(2 * pn) * D * 2; u.b1 = u.b0 + (size_t)D * 2; u.p0 = pm; u.p1 = pn; u.p2 = 0; u.p3 = 0; return true; }
};
struct SchedG1SKV : SchedBase {
    const char* A; const char* Bt;
    __device__ __forceinline__ bool next(int i, Unit& u) const { const int L = i * G + c; if (L >= 8 * 64) return false; int pm, pn; gm::tile_order(L, 8, 64, pm, pn);
        const int rb = pm < 4 ? 2048 + 256 * pm : 3072 + 256 * (pm - 4);
        u.a0 = A + (size_t)rb * D * 2; u.a1 = u.a0 + (size_t)128 * D * 2; u.b0 = Bt + (size_t)pn * 256 * D * 2; u.b1 = u.b0 + (size_t)128 * D * 2; u.p0 = pm; u.p1 = pn; u.p2 = 0; u.p3 = 0; return true; }
};
struct SchedFixA : SchedBase {
    const char* A; const char* Bt; int ncol;
    __device__ __forceinline__ bool next(int i, Unit& u) const { const int L = i * G + c; if (L >= ncol) return false;
        u.a0 = A; u.a1 = A + (size_t)128 * pitchA * 2; u.b0 = Bt + (size_t)L * 256 * pitchB * 2; u.b1 = u.b0 + (size_t)128 * pitchB * 2; u.p0 = 0; u.p1 = L; u.p2 = 0; u.p3 = 0; return true; }
};
struct SchedFixB : SchedBase {
    const char* A; const char* Bt; int nrow;
    __device__ __forceinline__ bool next(int i, Unit& u) const { const int L = i * G + c; if (L >= nrow) return false;
        u.a0 = A + (size_t)L * 256 * pitchA * 2; u.a1 = u.a0 + (size_t)128 * pitchA * 2; u.b0 = Bt; u.b1 = Bt + (size_t)128 * pitchB * 2; u.p0 = L; u.p1 = 0; u.p2 = 0; u.p3 = 0; return true; }
};
struct SchedScores : SchedBase {
    const char* Q; const char* Kk;
    __device__ __forceinline__ bool next(int i, Unit& u) const { const int L = i * G + c; if (L >= NH * NCH) return false; const int h = L & 3, n = L >> 2;
        u.a0 = Q + ((size_t)n * 256 * RW + h * HD) * 2; u.a1 = u.a0 + (size_t)128 * RW * 2; u.b0 = Kk + ((size_t)n * 256 * RW + h * HD) * 2; u.b1 = u.b0 + (size_t)128 * RW * 2; u.p0 = h; u.p1 = n; u.p2 = 0; u.p3 = 0; return true; }
};
struct SchedKV : SchedBase {
    const char* Bcat; const char* kTw;
    __device__ __forceinline__ bool next(int i, Unit& u) const { const int L = i * G + c; if (L >= 2 * NH * NCH) return false; const int dh = L & 7, n = L >> 3, dir = dh >> 2, h = dh & 3;
        u.a0 = Bcat + ((size_t)(h * NCH + n) * 256 * CAT) * 2; u.a1 = u.a0 + (size_t)128 * CAT * 2;
        u.b0 = kTw + (((size_t)dir * RW + h * HD) * T + (size_t)n * 256) * 2; u.b1 = u.b0 + (size_t)128 * T * 2; u.p0 = dh; u.p1 = n; u.p2 = 0; u.p3 = 0; return true; }
};
struct SchedOut : SchedBase {
    const char* Acat; const char* Bcat;
    __device__ __forceinline__ bool next(int i, Unit& u) const { const int L = i * G + c; if (L >= NH * NCH) return false; const int h = L & 3, n = L >> 2;
        u.a0 = Acat + ((size_t)h * T + (size_t)n * 256) * CAT * 2; u.a1 = u.a0 + (size_t)128 * CAT * 2; u.b0 = Bcat + ((size_t)(h * NCH + n) * 256 * CAT) * 2; u.b1 = u.b0 + (size_t)128 * CAT * 2; u.p0 = h; u.p1 = n; u.p2 = 0; u.p3 = 0; return true; }
};
struct Sched2D : SchedBase {
    const char* A; const char* Bt; int nM, nN;
    __device__ __forceinline__ bool next(int i, Unit& u) const { const int L = i * G + c; if (L >= nM * nN) return false; int pm, pn; gm::tile_order(L, nM, nN, pm, pn);
        u.a0 = A + (size_t)pm * 256 * pitchA * 2; u.a1 = u.a0 + (size_t)128 * pitchA * 2; u.b0 = Bt + (size_t)pn * 256 * pitchB * 2; u.b1 = u.b0 + (size_t)128 * pitchB * 2; u.p0 = pm; u.p1 = pn; u.p2 = 0; u.p3 = 0; return true; }
};
struct SchedMoE : SchedBase {
    const char* A; const char* Bt; const LAS int* tstart; const int* row_tok; const unsigned* cnt; int nN; size_t estride;
    __device__ __forceinline__ bool next(int i, Unit& u) const { const int RT = __builtin_amdgcn_readfirstlane(tstart[NE]); const int L = i * G + c; if (L >= RT * nN) return false; int rt, pn; gm::tile_order(L, RT, nN, rt, pn);
        int e = 0;
        for (int j = 1; j < NE; ++j) e += (__builtin_amdgcn_readfirstlane(tstart[j]) <= rt) ? 1 : 0;
        u.b0 = Bt + (size_t)e * estride + (size_t)pn * 256 * D * 2; u.b1 = u.b0 + (size_t)128 * D * 2;
        u.a0 = A; u.a1 = A;
        u.p0 = rt; u.p1 = pn; u.p2 = e; u.p3 = (rt - __builtin_amdgcn_readfirstlane(tstart[e])) * 256; return true; }
    __device__ __forceinline__ unsigned row_off(const Unit& u, int r) const { const int n = (int)cnt[64 * u.p2]; int pos = u.p3 + r; pos = pos < n ? pos : n - 1;
        const int tok = row_tok[(size_t)u.p2 * T + pos]; return (unsigned)tok * (unsigned)(D * 2); }
};
struct SchedMoEDown : SchedMoE {
    __device__ __forceinline__ bool next(int i, Unit& u) const { if (!SchedMoE::next(i, u)) return false; u.a0 = A + (size_t)u.p0 * 256 * DFF * 2; u.a1 = u.a0 + (size_t)128 * DFF * 2; return true; }
};

#define EPI_LOOP_AM for (int ai = 0; ai < 2; ++ai) _Pragma("unroll") for (int m = 0; m < 4; ++m)
#define EPI_FENCE __builtin_amdgcn_sched_barrier(0)
struct EpiG1N {
    static constexpr bool PERM = true;
    bf16 *qs, *kk, *gs, *Acat; const float *dec_f, *dec_b;
    __device__ __forceinline__ void operator()(Acc& acc, const Unit& u, LAS unsigned char*, int wr, int wc, int fr, int fq) const {
        const int pm = u.p0, pn = u.p1, c0 = wc * 32 + 8 * fq;
        if (pn < 8) {
            const int h = pn & 3; const bool isq = pn < 4;
            float inv[8];
#pragma unroll
            for (int e = 0; e < 8; ++e) inv[e] = __builtin_amdgcn_exp2f(-(float)(c0 + e) * (13.287712379549449f / 128.f)) * 0.15915494309189535f;
            const float lgf = -fexp(dec_f[h]), lgb = -fexp(dec_b[h]);
#pragma unroll
            EPI_LOOP_AM {
                const int r = 128 * ai + 64 * wr + 16 * m + fr, tok = pm * 256 + r; const float pos = (float)tok;
                f32x4 o1[2], o2[2];
#pragma unroll
                for (int n = 0; n < 2; ++n)
#pragma unroll
                    for (int j = 0; j < 4; ++j) { float c, s; cs_rev(pos * inv[4 * n + j], c, s); const float x1 = acc[ai][0][m][n][j], x2 = acc[ai][1][m][n][j]; o1[n][j] = x1 * c - x2 * s; o2[n][j] = x2 * c + x1 * s; }
                if (isq) {
                    bf16* q = qs + (size_t)tok * RW + h * HD + c0; *(GAS v4u*)q = pack8(o1[0], o1[1]); *(GAS v4u*)(q + 128) = pack8(o2[0], o2[1]);
                    const int il = r; const float wf = fexp(lgf * (float)(il + 1)), wb = fexp(lgb * (float)(255 - il));
                    bf16* a = Acat + ((size_t)h * T + tok) * CAT + c0;
                    *(GAS v4u*)(a + 256) = pack8(o1[0] * wf, o1[1] * wf); *(GAS v4u*)(a + 384) = pack8(o2[0] * wf, o2[1] * wf);
                    *(GAS v4u*)(a + 512) = pack8(o1[0] * wb, o1[1] * wb); *(GAS v4u*)(a + 640) = pack8(o2[0] * wb, o2[1] * wb);
                } else {
                    bf16* k = kk + (size_t)tok * RW + h * HD + c0; *(GAS v4u*)k = pack8(o1[0] * 0.0625f, o1[1] * 0.0625f); *(GAS v4u*)(k + 128) = pack8(o2[0] * 0.0625f, o2[1] * 0.0625f);
                }
            }
        } else {
#pragma unroll
            EPI_LOOP_AM {
                const int r = 128 * ai + 64 * wr + 16 * m + fr, tok = pm * 256 + r;
#pragma unroll
                for (int bj = 0; bj < 2; ++bj) { f32x4 v[2];
#pragma unroll
                    for (int n = 0; n < 2; ++n)
#pragma unroll
                        for (int j = 0; j < 4; ++j) { const float g = acc[ai][bj][m][n][j]; v[n][j] = g * __builtin_amdgcn_rcpf(1.f + fexp(-g)); }
                    *(GAS v4u*)(gs + (size_t)tok * RW + (pn - 8) * 256 + bj * 128 + c0) = pack8(v[0], v[1]); }
            }
        }
    }
};
struct EpiG1SF {
    static constexpr bool PERM = true;
    bf16* uTT;
    __device__ __forceinline__ void operator()(Acc& acc, const Unit& u, LAS unsigned char*, int wr, int wc, int fr, int fq) const {
        const int a0 = wc * 32 + 8 * fq;
#pragma unroll
        EPI_LOOP_AM { const int cch = u.p0 * 256 + 128 * ai + 64 * wr + 16 * m + fr;
#pragma unroll
            for (int bj = 0; bj < 2; ++bj) *(GAS v4u*)(uTT + ((size_t)cch * 128 + (2 * u.p1 + bj)) * 128 + a0) = pack8(acc[ai][bj][m][0], acc[ai][bj][m][1]); }
    }
};
struct EpiG1SKV {
    static constexpr bool PERM = true;
    bf16 *kTw, *Bcat; const float *dec_f, *dec_b;
    __device__ __forceinline__ void operator()(Acc& acc, const Unit& u, LAS unsigned char*, int wr, int wc, int fr, int fq) const {
        const int pm = u.p0, n_ch = u.p1, c0 = wc * 32 + 8 * fq;
        if (pm < 4) {
            const int h = pm; const float lgf = -fexp(dec_f[h]), lgb = -fexp(dec_b[h]);
#pragma unroll
            for (int m = 0; m < 4; ++m) {
                const int d = 64 * wr + 16 * m + fr;
                const float inv = __builtin_amdgcn_exp2f(-(float)d * (13.287712379549449f / 128.f)) * 0.15915494309189535f;
#pragma unroll
                for (int bj = 0; bj < 2; ++bj) {
                    f32x4 f1[2], f2[2], b1[2], b2[2];
#pragma unroll
                    for (int n = 0; n < 2; ++n)
#pragma unroll
                        for (int j = 0; j < 4; ++j) { const int il = 128 * bj + c0 + 4 * n + j; const float pos = (float)(n_ch * 256 + il); float c, s; cs_rev(pos * inv, c, s);
                            const float x1 = acc[0][bj][m][n][j], x2 = acc[1][bj][m][n][j]; const float o1 = (x1 * c - x2 * s) * 0.0625f, o2 = (x2 * c + x1 * s) * 0.0625f;
                            const float wf = fexp(lgf * (float)(255 - il)), wb = fexp(lgb * (float)(il + 1));
                            f1[n][j] = o1 * wf; f2[n][j] = o2 * wf; b1[n][j] = o1 * wb; b2[n][j] = o2 * wb; }
                    const size_t tcol = (size_t)n_ch * 256 + 128 * bj + c0;
                    bf16* pf = kTw + ((size_t)(h * HD + d)) * T + tcol; bf16* pb = pf + (size_t)RW * T;
                    *(GAS v4u*)pf = pack8(f1[0], f1[1]); *(GAS v4u*)(pf + (size_t)128 * T) = pack8(f2[0], f2[1]);
                    *(GAS v4u*)pb = pack8(b1[0], b1[1]); *(GAS v4u*)(pb + (size_t)128 * T) = pack8(b2[0], b2[1]);
                }
            }
        } else {
            const int h = pm - 4;
#pragma unroll
            EPI_LOOP_AM { const int dv = 128 * ai + 64 * wr + 16 * m + fr;
#pragma unroll
                for (int bj = 0; bj < 2; ++bj) *(GAS v4u*)(Bcat + ((size_t)(h * NCH + n_ch) * 256 + dv) * CAT + 128 * bj + c0) = pack8(acc[ai][bj][m][0], acc[ai][bj][m][1]); }
        }
    }
};
struct EpiS1 {
    static constexpr bool PERM = true;
    bf16* A1;
    __device__ __forceinline__ void operator()(Acc& acc, const Unit& u, LAS unsigned char*, int wr, int wc, int fr, int fq) const {
        const int b0 = wc * 32 + 8 * fq;
#pragma unroll
        for (int m = 0; m < 4; ++m) { const int k1 = 64 * wr + 16 * m + fr;
#pragma unroll
            for (int bj = 0; bj < 2; ++bj) { const int cch = 2 * u.p1 + bj; f32x4 re[2], im[2];
#pragma unroll
                for (int n = 0; n < 2; ++n)
#pragma unroll
                    for (int j = 0; j < 4; ++j) { const int b = b0 + 4 * n + j; float c, s; cs_rev((float)(k1 * b) * (1.f / 16384.f), c, s);
                        const float xr = acc[0][bj][m][n][j], xi = acc[1][bj][m][n][j]; re[n][j] = xr * c + xi * s; im[n][j] = xi * c - xr * s; }
                bf16* p = A1 + (((size_t)k1 * 1024 + cch) * 2) * 128 + b0;
                *(GAS v4u*)p = pack8(re[0], re[1]); *(GAS v4u*)(p + 128) = pack8(im[0], im[1]); EPI_FENCE; } }
    }
};
struct EpiS2 {
    static constexpr bool PERM = true;
    bf16* Zt;
    __device__ __forceinline__ void operator()(Acc& acc, const Unit& u, LAS unsigned char*, int wr, int wc, int fr, int fq) const {
        const int k1 = u.p1 >> 2, cb = (u.p1 & 3) * 256, c0 = wc * 32 + 8 * fq;
#pragma unroll
        EPI_LOOP_AM { const int k2 = 64 * wr + 16 * m + fr, k = k1 + 128 * k2;
#pragma unroll
            for (int bj = 0; bj < 2; ++bj) { const int cch = cb + 128 * bj + c0, g = cch >> 7, cg = cch & 127;
                *(GAS v4u*)(Zt + (size_t)k * 2048 + g * 256 + ai * 128 + cg) = pack8(acc[ai][bj][m][0], acc[ai][bj][m][1]); } }
    }
};
struct EpiChan {
    static constexpr bool PERM = true;
    bf16* y;
    __device__ __forceinline__ void operator()(Acc& acc, const Unit& u, LAS unsigned char*, int wr, int wc, int fr, int fq) const {
        const int l0 = wc * 32 + 8 * fq; const float norm = 6.9053396600248786e-4f;
#pragma unroll
        EPI_LOOP_AM { const int R = u.p0 * 256 + 128 * ai + 64 * wr + 16 * m + fr, k = R >> 3, g = R & 7;
            *(GAS v4u*)(y + (size_t)k * D + g * 128 + l0) = pack8(acc[ai][0][m][0] * norm, acc[ai][0][m][1] * norm); }
    }
};
struct EpiScores {
    static constexpr bool PERM = true;
    bf16* Acat; const float *dec_f, *dec_b;
    __device__ __forceinline__ void operator()(Acc& acc, const Unit& u, LAS unsigned char*, int wr, int wc, int fr, int fq) const {
        const int h = u.p0, n_ch = u.p1, c0 = wc * 32 + 8 * fq; const float lgf = -fexp(dec_f[h]), lgb = -fexp(dec_b[h]);
#pragma unroll
        EPI_LOOP_AM { const int i = 128 * ai + 64 * wr + 16 * m + fr;
#pragma unroll
            for (int bj = 0; bj < 2; ++bj) { f32x4 v[2];
#pragma unroll
                for (int n = 0; n < 2; ++n)
#pragma unroll
                    for (int j = 0; j < 4; ++j) { const int jc = 128 * bj + c0 + 4 * n + j; const float dd = (float)(i - jc); const float w = (jc <= i) ? fexp(lgf * dd) : fexp(-lgb * dd); v[n][j] = acc[ai][bj][m][n][j] * w; }
                *(GAS v4u*)(Acat + ((size_t)h * T + n_ch * 256 + i) * CAT + 128 * bj + c0) = pack8(v[0], v[1]); EPI_FENCE; } }
    }
};
struct EpiKV {
    static constexpr bool PERM = false;
    float* kvT;
    __device__ __forceinline__ void operator()(Acc& acc, const Unit& u, LAS unsigned char*, int wr, int wc, int fr, int fq) const {
#pragma unroll
        EPI_LOOP_AM { const int dv = 128 * ai + 64 * wr + 16 * m + fr; float* rowp = kvT + (((size_t)u.p0 * NCH + u.p1) * 256 + dv) * 256 + wc * 32 + 4 * fq;
#pragma unroll
            for (int bj = 0; bj < 2; ++bj)
#pragma unroll
                for (int n = 0; n < 2; ++n) *(GAS f32x4*)(rowp + bj * 128 + n * 16) = acc[ai][bj][m][n]; }
    }
};
struct EpiOut {
    static constexpr bool PERM = true;
    bf16* y; const bf16* gs; const float* gn_g;
    __device__ __forceinline__ void operator()(Acc& acc, const Unit& u, LAS unsigned char* lds, int wr, int wc, int fr, int fq) const {
        const int h = u.p0, n_ch = u.p1, c0 = wc * 32 + 8 * fq;
        LAS f32x2* P = (LAS f32x2*)(lds + LDS_STAGE);
#pragma unroll
        EPI_LOOP_AM {
            float s = 0.f;
#pragma unroll
            for (int bj = 0; bj < 2; ++bj)
#pragma unroll
                for (int n = 0; n < 2; ++n) { const f32x4 x = acc[ai][bj][m][n]; s += (x[0] + x[1]) + (x[2] + x[3]); }
            s += __shfl_xor(s, 16); s += __shfl_xor(s, 32);
            const float mw = s * (1.f / 64.f); float q = 0.f;
#pragma unroll
            for (int bj = 0; bj < 2; ++bj)
#pragma unroll
                for (int n = 0; n < 2; ++n) { const f32x4 d = acc[ai][bj][m][n] - mw; q += (d[0] * d[0] + d[1] * d[1]) + (d[2] * d[2] + d[3] * d[3]); }
            q += __shfl_xor(q, 16); q += __shfl_xor(q, 32);
            if (fq == 0) P[(128 * ai + 64 * wr + 16 * m + fr) * 4 + wc] = (f32x2){mw, q};
        }
        LDS_WAIT(); __builtin_amdgcn_s_barrier(); asm volatile("" ::: "memory");
#pragma unroll
        EPI_LOOP_AM {
            const int r = 128 * ai + 64 * wr + 16 * m + fr, tok = n_ch * 256 + r;
            const f32x2 a = P[r * 4 + 0], b = P[r * 4 + 1], c = P[r * 4 + 2], d = P[r * 4 + 3];
            const float mt = (a.x + b.x + c.x + d.x) * 0.25f; const float da = a.x - mt, db = b.x - mt, dc = c.x - mt, dd = d.x - mt;
            const float m2 = (a.y + b.y) + (c.y + d.y) + 64.f * ((da * da + db * db) + (dc * dc + dd * dd));
            const float rstd = 1.f / sqrtf(m2 * (1.f / 256.f) + GN_EPS);
#pragma unroll
            for (int bj = 0; bj < 2; ++bj) {
                const int col = h * HD + 128 * bj + c0; const v4u gv = *(const GAS v4u*)(gs + (size_t)tok * RW + col);
                const f32x4 g0 = *(const GAS f32x4*)(gn_g + col), g1 = *(const GAS f32x4*)(gn_g + col + 4);
                f32x4 o0 = (acc[ai][bj][m][0] - mt) * rstd * g0, o1 = (acc[ai][bj][m][1] - mt) * rstd * g1;
                o0[0] *= bf_lo(gv.x); o0[1] *= bf_hi(gv.x); o0[2] *= bf_lo(gv.y); o0[3] *= bf_hi(gv.y); o1[0] *= bf_lo(gv.z); o1[1] *= bf_hi(gv.z); o1[2] *= bf_lo(gv.w); o1[3] *= bf_hi(gv.w);
                *(GAS v4u*)(y + (size_t)tok * D + FW + col) = pack8(o0, o1); }
        }
        LDS_WAIT(); __builtin_amdgcn_s_barrier(); asm volatile("" ::: "memory");
    }
};
struct EpiWout {
    static constexpr bool PERM = false;
    float* z1; const float *x, *st0, *g0, *b0;
    __device__ __forceinline__ void operator()(Acc& acc, const Unit& u, LAS unsigned char*, int wr, int wc, int fr, int fq) const {
        const int colb = u.p1 * 256 + wc * 32 + 4 * fq;
#pragma unroll
        EPI_LOOP_AM { const int row = u.p0 * 256 + 128 * ai + 64 * wr + 16 * m + fr; const f32x2 st = *(const GAS f32x2*)(st0 + 2 * row);
#pragma unroll
            for (int bj = 0; bj < 2; ++bj)
#pragma unroll
                for (int n = 0; n < 2; ++n) { const int col = colb + bj * 128 + n * 16; const size_t off = (size_t)row * D + col;
                    const f32x4 xv = *(const GAS f32x4*)(x + off), g = *(const GAS f32x4*)(g0 + col), b = *(const GAS f32x4*)(b0 + col);
                    *(GAS f32x4*)(z1 + off) = ((xv - st.x) * st.y * g + b) * ALPHA + acc[ai][bj][m][n]; } }
    }
};
struct EpiUp {
    static constexpr bool PERM = true;
    bf16* act; const float* b_up;
    __device__ __forceinline__ void operator()(Acc& acc, const Unit& u, LAS unsigned char*, int wr, int wc, int fr, int fq) const {
        const int rt = u.p0, pn = u.p1, e = u.p2, c0 = pn * 128 + wc * 32 + 8 * fq;
#pragma unroll
        for (int n = 0; n < 2; ++n) {
            const float* bu = b_up + (size_t)e * 2 * DFF + c0 + 4 * n;
            const f32x4 bg = *(const GAS f32x4*)bu, bl = *(const GAS f32x4*)(bu + DFF);
#pragma unroll
            EPI_LOOP_AM { const int r = 128 * ai + 64 * wr + 16 * m + fr; f32x4 v;
#pragma unroll
                for (int j = 0; j < 4; ++j) { float gl = acc[ai][0][m][n][j] + bg[j], li = acc[ai][1][m][n][j] + bl[j];
                    gl = fminf(gl, 7.f); li = fminf(fmaxf(li, -7.f), 7.f); v[j] = gl * __builtin_amdgcn_rcpf(1.f + fexp(-1.702f * gl)) * (li + 1.f); }
                v2u w; w.x = cvt_pk_bf16(v[0], v[1]); w.y = cvt_pk_bf16(v[2], v[3]);
                *(GAS v2u*)(act + ((size_t)rt * 256 + r) * DFF + c0 + 4 * n) = w; }
        }
    }
};
struct EpiDown {
    static constexpr bool PERM = true;
    bf16* yr; const float* b_dn;
    __device__ __forceinline__ void operator()(Acc& acc, const Unit& u, LAS unsigned char*, int wr, int wc, int fr, int fq) const {
        const int rt = u.p0, pn = u.p1, e = u.p2, c0 = pn * 256 + wc * 32 + 8 * fq;
#pragma unroll
        for (int bj = 0; bj < 2; ++bj) { const float* bd = b_dn + (size_t)e * D + c0 + 128 * bj; const f32x4 b0 = *(const GAS f32x4*)bd, b1 = *(const GAS f32x4*)(bd + 4);
#pragma unroll
            EPI_LOOP_AM { const int r = 128 * ai + 64 * wr + 16 * m + fr;
                *(GAS v4u*)(yr + ((size_t)rt * 256 + r) * D + c0 + 128 * bj) = pack8(acc[ai][bj][m][0] + b0, acc[ai][bj][m][1] + b1); } }
    }
};

__device__ __forceinline__ void p3_scan(Frame& F) {
    const float* kvT = WSP(float, WS_KVT); bf16* Bcat = WSP(bf16, WS_BCAT);
    const int NQ = 2 * NH * 256 * 64;
    for (int q = F.vcu * NTHR + F.tid; q < NQ; q += F.G * NTHR) {
        const int dk4 = q & 63, dv = (q >> 6) & 255, dh = q >> 14, dir = dh >> 2, h = dh & 3;
        const float lg = -fexp((dir ? F.dec_b : F.dec_f)[h]); const float cd = fexp(lg * (float)C2);
        f32x4 S = (f32x4){0.f, 0.f, 0.f, 0.f};
        for (int s = 0; s < NCH; ++s) { const int n = dir ? (NCH - 1 - s) : s;
            const f32x4 kv = *(const GAS f32x4*)(kvT + (((size_t)dh * NCH + n) * 256 + dv) * 256 + dk4 * 4);
            v2u w; w.x = cvt_pk_bf16(S[0], S[1]); w.y = cvt_pk_bf16(S[2], S[3]);
            *(GAS v2u*)(Bcat + ((size_t)(h * NCH + n) * 256 + dv) * CAT + 256 + dir * 256 + dk4 * 4) = w;
            S = S * cd + kv; }
    }
}

__device__ __forceinline__ void p6_router(Frame& F) {
    const float* z1 = WSP(float, WS_Z1); bf16* h1b = WSP(bf16, WS_H1B); float* st1 = WSP(float, WS_ST0) + 2 * T;
    int* topi = WSP(int, WS_RT); float* gate = (float*)(topi + 4 * T); int* posb = (int*)(gate + 4 * T); int* row_tok = posb + 4 * T;
    LAS float* hc = (LAS float*)F.lds;
    LAS float* wrc = hc + 64 * 257;
    LAS float* stl = wrc + 256 * 32;
    LAS float* lg = stl + 128;
    LAS int* hist = (LAS int*)(lg + 64 * 33);
    for (int blk = F.vcu; blk < T / 64; blk += F.G) {
        const int t0 = blk * 64;
        for (int rr = 0; rr < 8; ++rr) { const int row = F.wave * 8 + rr, m = t0 + row;
            const GAS f32x4* xr = (const GAS f32x4*)(z1 + (size_t)m * D) + F.lane; f32x4 v[8]; float s = 0.f;
#pragma unroll
            for (int j = 0; j < 8; ++j) { v[j] = xr[64 * j]; s += (v[j][0] + v[j][1]) + (v[j][2] + v[j][3]); }
            const float mean = wave_sum(s) * (1.f / D); float s2 = 0.f;
#pragma unroll
            for (int j = 0; j < 8; ++j) { v[j] = v[j] - mean; s2 += (v[j][0] * v[j][0] + v[j][1] * v[j][1]) + (v[j][2] * v[j][2] + v[j][3] * v[j][3]); }
            const float rstd = 1.f / sqrtf(wave_sum(s2) * (1.f / D) + LN_EPS);
            GAS v2u* o8 = (GAS v2u*)(h1b + (size_t)m * D) + F.lane;
#pragma unroll
            for (int j = 0; j < 8; ++j) { const f32x4 g = *((const GAS f32x4*)F.ln1_g + F.lane + 64 * j), b = *((const GAS f32x4*)F.ln1_b + F.lane + 64 * j);
                const f32x4 hh = v[j] * rstd * g + b; v2u w; w.x = cvt_pk_bf16(hh[0], hh[1]); w.y = cvt_pk_bf16(hh[2], hh[3]); o8[64 * j] = w; }
            if (F.lane == 0) { st1[2 * m] = mean; st1[2 * m + 1] = rstd; stl[2 * row] = mean; stl[2 * row + 1] = rstd; }
        }
        if (F.tid < 64) hist[F.tid] = 0;
        __syncthreads();
        const int row = F.tid >> 3, e0 = (F.tid & 7) * 4; f32x4 accl = (f32x4){0.f, 0.f, 0.f, 0.f};
        for (int kc = 0; kc < 8; ++kc) {
            for (int i = F.tid; i < 64 * 64; i += NTHR) { const int r = i >> 6, c4 = (i & 63) * 4, col = kc * 256 + c4;
                const f32x4 zv = *(const GAS f32x4*)(z1 + (size_t)(t0 + r) * D + col), g = *(const GAS f32x4*)(F.ln1_g + col), b = *(const GAS f32x4*)(F.ln1_b + col);
                const f32x4 hh = (zv - stl[2 * r]) * stl[2 * r + 1] * g + b; LAS float* d = hc + r * 257 + c4; d[0] = hh[0]; d[1] = hh[1]; d[2] = hh[2]; d[3] = hh[3]; }
            for (int i = F.tid; i < 256 * 8; i += NTHR) { const int k = i >> 3, c4 = (i & 7) * 4; *(LAS f32x4*)(wrc + k * 32 + c4) = *(const GAS f32x4*)(F.w_r + (size_t)(kc * 256 + k) * NE + c4); }
            __syncthreads();
#pragma unroll 8
            for (int k = 0; k < 256; ++k) { const float hv = hc[row * 257 + k]; const f32x4 w = *(const LAS f32x4*)(wrc + k * 32 + e0); accl = accl + w * hv; }
            __syncthreads();
        }
        { const f32x4 br = *(const GAS f32x4*)(F.b_r + e0); LAS float* d = lg + row * 33 + e0; d[0] = accl[0] + br[0]; d[1] = accl[1] + br[1]; d[2] = accl[2] + br[2]; d[3] = accl[3] + br[3]; }
        __syncthreads();
        int ek[4] = {0, 0, 0, 0}, lp[4] = {0, 0, 0, 0}; float gk[4] = {0.f, 0.f, 0.f, 0.f};
        if (F.tid < 64) {
            float lv[4]; unsigned used = 0u;
#pragma unroll
            for (int k = 0; k < 4; ++k) { float best = -3.0e38f; int bi = 0;
                for (int e = 0; e < NE; ++e) { const float v = lg[F.tid * 33 + e]; const bool ok = !((used >> e) & 1u) && (v > best); best = ok ? v : best; bi = ok ? e : bi; }
                used |= 1u << bi; ek[k] = bi; lv[k] = best; }
            const float mx = lv[0]; float den = 0.f;
#pragma unroll
            for (int k = 0; k < 4; ++k) { gk[k] = fexp(lv[k] - mx); den += gk[k]; }
            const float rd = 1.f / den;
#pragma unroll
            for (int k = 0; k < 4; ++k) { gk[k] *= rd; lp[k] = __hip_atomic_fetch_add(&hist[ek[k]], 1, __ATOMIC_RELAXED, __HIP_MEMORY_SCOPE_WORKGROUP); }
        }
        __syncthreads();
        if (F.tid < NE) hist[32 + F.tid] = (int)__hip_atomic_fetch_add(F.ctl + CW_CNT + 64 * F.tid, (unsigned)hist[F.tid], RLX_AGENT);
        __syncthreads();
        if (F.tid < 64) { const int tok = t0 + F.tid;
#pragma unroll
            for (int k = 0; k < 4; ++k) { const int pos = hist[32 + ek[k]] + lp[k]; row_tok[(size_t)ek[k] * T + pos] = tok; topi[4 * tok + k] = ek[k]; gate[4 * tok + k] = gk[k]; posb[4 * tok + k] = pos; } }
        __syncthreads();
    }
}

__device__ __forceinline__ void build_tstart(Frame& F, LAS int* tstart) {
    if (F.tid == 0) { int s = 0; for (int e = 0; e < NE; ++e) { tstart[e] = s; const unsigned n = __hip_atomic_load(F.ctl + CW_CNT + 64 * e, RLX_AGENT); s += (int)((n + 255u) >> 8); } tstart[NE] = s; }
    __syncthreads();
}

__device__ __forceinline__ void p9_combine(Frame& F, const LAS int* tstart) {
    const float* z1 = WSP(float, WS_Z1); const float* st1 = WSP(float, WS_ST0) + 2 * T; const bf16* yr = WSP(bf16, WS_YR);
    const int* topi = WSP(int, WS_RT); const float* gate = (const float*)(topi + 4 * T); const int* posb = (const int*)(gate + 4 * T);
    const int gw = F.vcu * NWAVES + F.wave, NGW = F.G * NWAVES;
    for (int m = gw; m < T; m += NGW) {
        const float mean1 = st1[2 * m], rstd1 = st1[2 * m + 1];
        size_t ro[4]; float gk[4];
#pragma unroll
        for (int k = 0; k < 4; ++k) { const int e = topi[4 * m + k]; ro[k] = ((size_t)tstart[e] * 256 + posb[4 * m + k]) * D; gk[k] = gate[4 * m + k]; }
        f32x4 v[8]; float s = 0.f;
#pragma unroll
        for (int j = 0; j < 8; ++j) { const int col = 4 * F.lane + 256 * j;
            const f32x4 zv = *(const GAS f32x4*)(z1 + (size_t)m * D + col), g = *(const GAS f32x4*)(F.ln1_g + col), b = *(const GAS f32x4*)(F.ln1_b + col);
            f32x4 a = ((zv - mean1) * rstd1 * g + b) * ALPHA;
#pragma unroll
            for (int k = 0; k < 4; ++k) { const v2u w = *(const GAS v2u*)(yr + ro[k] + col); a[0] += gk[k] * bf_lo(w.x); a[1] += gk[k] * bf_hi(w.x); a[2] += gk[k] * bf_lo(w.y); a[3] += gk[k] * bf_hi(w.y); }
            v[j] = a; s += (a[0] + a[1]) + (a[2] + a[3]); }
        const float mean = wave_sum(s) * (1.f / D); float s2 = 0.f;
#pragma unroll
        for (int j = 0; j < 8; ++j) { v[j] = v[j] - mean; s2 += (v[j][0] * v[j][0] + v[j][1] * v[j][1]) + (v[j][2] * v[j][2] + v[j][3] * v[j][3]); }
        const float rstd = 1.f / sqrtf(wave_sum(s2) * (1.f / D) + LN_EPS);
#pragma unroll
        for (int j = 0; j < 8; ++j) { const int col = 4 * F.lane + 256 * j; const f32x4 g = *(const GAS f32x4*)(F.ln2_g + col), b = *(const GAS f32x4*)(F.ln2_b + col);
            *(GAS f32x4*)(F.out + (size_t)m * D + col) = v[j] * rstd * g + b; }
    }
}

constexpr int NPH = 10;
__global__ void __launch_bounds__(NTHR, 2) fwd(Args args) {
    extern __shared__ __attribute__((aligned(16))) unsigned char lds_raw[];
    Frame F;
    F.lds = (LAS unsigned char*)lds_raw; F.ws = args.ws; F.ctl = (unsigned*)(args.ws + WS_CTL);
    F.tid = threadIdx.x; F.lane = F.tid & 63; F.wave = __builtin_amdgcn_readfirstlane(F.tid >> 6);
    F.G = gridDim.x; { const int bx = blockIdx.x; F.vcu = (F.G % 8 == 0) ? (bx % 8) * (F.G / 8) + bx / 8 : bx; }
    F.x = args.in[0]; F.ln0_g = args.in[1]; F.ln0_b = args.in[2]; F.w_in = args.in[3]; F.dec_f = args.in[4]; F.dec_b = args.in[5]; F.gn_g = args.in[6]; F.w_out = args.in[7];
    F.ln1_g = args.in[8]; F.ln1_b = args.in[9]; F.w_r = args.in[10]; F.b_r = args.in[11]; F.w_up = args.in[12]; F.b_up = args.in[13]; F.w_dn = args.in[14]; F.b_dn = args.in[15];
    F.ln2_g = args.in[16]; F.ln2_b = args.in[17]; F.out = args.out;
    volatile LAS unsigned* lctl = (volatile LAS unsigned*)(F.lds + LDS_CTL_OFF);
    LAS int* tstart = (LAS int*)(F.lds + LDS_CTL_OFF + 64);
    for (int u = F.tid; u < 128; u += NTHR) lctl[u] = 0u;
    __syncthreads();
    const int lo = args.ph_lo, hi = args.ph_hi;
    const bool single = (hi - lo) > 1;
    XcdBarrier bar; bar.bar = F.ctl + CW_BAR; bar.x = 0; bar.st = lctl;
    if (single) bar = xcd_barrier_post(F.ctl + CW_BAR, lctl);
#ifndef PH_MASK
#define PH_MASK 0x3ff
#endif
#define IN(k) (((PH_MASK >> (k)) & 1) && lo <= (k) && (k) < hi)
#ifndef SUB_MASK
#define SUB_MASK 0xff
#endif
#define SUB(n) ((SUB_MASK >> (n)) & 1)
#define SEAM(k) do { if (IN(k) && IN((k) + 1)) xcd_barrier(bar); } while (0)
    const int bc = (int)blockIdx.x;

    if (IN(0)) { p0_prologue(F); __syncthreads(); }
    SEAM(0);
    if (IN(1)) {
        if (SUB(0)) { SchedG1N S; S.nt = D / 64; S.pitchA = D; S.pitchB = D; S.multA = 1; S.multB = 1; S.G = F.G; S.c = bc; S.A = (const char*)WSP(bf16, WS_H0B); S.Bt = (const char*)WSP(bf16, WS_WIN);
          EpiG1N E{WSP(bf16, WS_QS), WSP(bf16, WS_KK), WSP(bf16, WS_GS), WSP(bf16, WS_ACAT), F.dec_f, F.dec_b};
          gm::gemm_run<EpiG1N, SchedG1N, false>(F.lds, S, E); }
        if (SUB(1)) { SchedG1SF S; S.nt = D / 64; S.pitchA = D; S.pitchB = D; S.multA = 1; S.multB = 128; S.G = F.G; S.c = bc; S.A = (const char*)WSP(bf16, WS_WIN); S.Bt = (const char*)WSP(bf16, WS_H0B);
          EpiG1SF E{WSP(bf16, WS_UTT)};
          gm::gemm_run<EpiG1SF, SchedG1SF, false>(F.lds, S, E); }
        if (SUB(2)) { SchedG1SKV S; S.nt = D / 64; S.pitchA = D; S.pitchB = D; S.multA = 1; S.multB = 1; S.G = F.G; S.c = bc; S.A = (const char*)WSP(bf16, WS_WIN); S.Bt = (const char*)WSP(bf16, WS_H0B);
          EpiG1SKV E{WSP(bf16, WS_KTW), WSP(bf16, WS_BCAT), F.dec_f, F.dec_b};
          gm::gemm_run<EpiG1SKV, SchedG1SKV, false>(F.lds, S, E); }
    }
    SEAM(1);
    if (IN(2)) {
        if (SUB(3)) { SchedFixA S; S.nt = 2; S.pitchA = 128; S.pitchB = 128; S.multA = 1; S.multB = 1; S.G = F.G; S.c = bc; S.A = (const char*)WSP(bf16, WS_TAB); S.Bt = (const char*)WSP(bf16, WS_UTT); S.ncol = 512;
          EpiS1 E{WSP(bf16, WS_A1)};
          gm::gemm_run<EpiS1, SchedFixA, false>(F.lds, S, E); }
        if (SUB(4)) { SchedScores S; S.nt = 4; S.pitchA = RW; S.pitchB = RW; S.multA = 1; S.multB = 1; S.G = F.G; S.c = bc; S.Q = (const char*)WSP(bf16, WS_QS); S.Kk = (const char*)WSP(bf16, WS_KK);
          EpiScores E{WSP(bf16, WS_ACAT), F.dec_f, F.dec_b};
          gm::gemm_run<EpiScores, SchedScores, false>(F.lds, S, E); }
        if (SUB(5)) { SchedKV S; S.nt = 4; S.pitchA = CAT; S.pitchB = T; S.multA = 1; S.multB = 1; S.G = F.G; S.c = bc; S.Bcat = (const char*)WSP(bf16, WS_BCAT); S.kTw = (const char*)WSP(bf16, WS_KTW);
          EpiKV E{WSP(float, WS_KVT)};
          gm::gemm_run<EpiKV, SchedKV, false>(F.lds, S, E); }
    }
    SEAM(2);
    if (IN(3)) {
        { SchedFixA S; S.nt = 4; S.pitchA = 256; S.pitchB = 256; S.multA = 1; S.multB = 1; S.G = F.G; S.c = bc; S.A = (const char*)(WSP(bf16, WS_TAB) + 32768); S.Bt = (const char*)WSP(bf16, WS_A1); S.ncol = 512;
          EpiS2 E{WSP(bf16, WS_ZT)};
          gm::gemm_run<EpiS2, SchedFixA, false>(F.lds, S, E); }
        p3_scan(F);
    }
    SEAM(3);
    if (IN(4)) {
        { SchedFixB S; S.nt = 4; S.pitchA = 256; S.pitchB = 256; S.multA = 1; S.multB = 1; S.G = F.G; S.c = bc; S.A = (const char*)WSP(bf16, WS_ZT); S.Bt = (const char*)(WSP(bf16, WS_TAB) + 32768 + 65536); S.nrow = 512;
          EpiChan E{WSP(bf16, WS_Y)};
          gm::gemm_run<EpiChan, SchedFixB, false>(F.lds, S, E); }
        { SchedOut S; S.nt = CAT / 64; S.pitchA = CAT; S.pitchB = CAT; S.multA = 1; S.multB = 1; S.G = F.G; S.c = bc; S.Acat = (const char*)WSP(bf16, WS_ACAT); S.Bcat = (const char*)WSP(bf16, WS_BCAT);
          EpiOut E{WSP(bf16, WS_Y), WSP(bf16, WS_GS), F.gn_g};
          gm::gemm_run<EpiOut, SchedOut, false>(F.lds, S, E); }
    }
    SEAM(4);
    if (IN(5)) {
        Sched2D S; S.nt = D / 64; S.pitchA = D; S.pitchB = D; S.multA = 1; S.multB = 1; S.G = F.G; S.c = bc; S.A = (const char*)WSP(bf16, WS_Y); S.Bt = (const char*)WSP(bf16, WS_WOUT); S.nM = 64; S.nN = 8;
        EpiWout E{WSP(float, WS_Z1), F.x, WSP(float, WS_ST0), F.ln0_g, F.ln0_b};
        gm::gemm_run<EpiWout, Sched2D, false>(F.lds, S, E);
    }
    SEAM(5);
    if (IN(6)) { p6_router(F); }
    SEAM(6);
    if (IN(7) || IN(8) || IN(9)) build_tstart(F, tstart);
    if (IN(7)) {
        SchedMoE S; S.nt = D / 64; S.pitchA = D; S.pitchB = D; S.multA = 1; S.multB = 1; S.G = F.G; S.c = bc; S.A = (const char*)WSP(bf16, WS_H1B); S.Bt = (const char*)WSP(bf16, WS_WUP);
        S.tstart = tstart; S.row_tok = WSP(int, WS_RT) + 12 * T; S.cnt = F.ctl + CW_CNT; S.nN = 16; S.estride = (size_t)2 * DFF * D * 2;
        EpiUp E{WSP(bf16, WS_ACT), F.b_up};
        gm::gemm_run<EpiUp, SchedMoE, true>(F.lds, S, E);
    }
    SEAM(7);
    if (IN(8)) {
        SchedMoEDown S; S.nt = DFF / 64; S.pitchA = DFF; S.pitchB = DFF; S.multA = 1; S.multB = 1; S.G = F.G; S.c = bc; S.A = (const char*)WSP(bf16, WS_ACT); S.Bt = (const char*)WSP(bf16, WS_WDN);
        S.tstart = tstart; S.row_tok = nullptr; S.cnt = F.ctl + CW_CNT; S.nN = 8; S.estride = (size_t)D * DFF * 2;
        EpiDown E{WSP(bf16, WS_YR), F.b_dn};
        gm::gemm_run<EpiDown, SchedMoEDown, false>(F.lds, S, E);
    }
    SEAM(8);
    if (IN(9)) { p9_combine(F, tstart); }
#undef IN
#undef SEAM
}

#ifndef MK_SPLIT
#define MK_SPLIT 0
#endif
extern "C" void kernel_launch(void* const* d_in, const int* in_sizes, int n_in, void* d_out, int out_size, void* d_ws, size_t ws_size, hipStream_t stream) {
    static int grid = 0;
    if (grid == 0) {
        if (n_in != 18 || out_size != T * D || ws_size < WS_END) { fprintf(stderr, "kernel_launch: unexpected problem: n_in %d out %d ws %zu (need %zu)\n", n_in, out_size, ws_size, (size_t)WS_END); grid = -1; return; }
        int dev = 0, cus = 0, per_cu = 0;
        if (hipGetDevice(&dev) != hipSuccess || hipDeviceGetAttribute(&cus, hipDeviceAttributeMultiprocessorCount, dev) != hipSuccess) { grid = -1; return; }
        if (hipFuncSetAttribute((const void*)fwd, hipFuncAttributeMaxDynamicSharedMemorySize, LDS_BYTES) != hipSuccess) { fprintf(stderr, "kernel_launch: hipFuncSetAttribute failed\n"); grid = -1; return; }
        if (hipOccupancyMaxActiveBlocksPerMultiprocessor(&per_cu, (const void*)fwd, NTHR, LDS_BYTES) != hipSuccess || per_cu < 1) { fprintf(stderr, "kernel_launch: occupancy query reports %d\n", per_cu); }
        (void)hipGetLastError();
        grid = cus;
    }
    if (grid < 0) return;
    (void)hipMemsetAsync((char*)d_ws + WS_CTL, 0, CTL_BYTES, stream);
    Args a{};
    for (int i = 0; i < 18; ++i) a.in[i] = (const float*)d_in[i];
    a.out = (float*)d_out; a.ws = (unsigned char*)d_ws;
#if MK_SPLIT
    for (int p = 0; p < NPH; ++p) { a.ph_lo = p; a.ph_hi = p + 1; hipLaunchKernelGGL(fwd, dim3(grid), dim3(NTHR), LDS_BYTES, stream, a); }
#else
    a.ph_lo = 0; a.ph_hi = NPH; hipLaunchKernelGGL(fwd, dim3(grid), dim3(NTHR), LDS_BYTES, stream, a);
#endif
}
```

```cpp
#include <hip/hip_runtime.h>
#include <cstdio>
#include <cstdint>

#define GAS __attribute__((address_space(1)))
#define LAS __attribute__((address_space(3)))
typedef unsigned short bf16;
typedef unsigned v4u __attribute__((ext_vector_type(4)));
typedef unsigned v2u __attribute__((ext_vector_type(2)));
typedef float f32x4 __attribute__((ext_vector_type(4)));
typedef float f32x2 __attribute__((ext_vector_type(2)));
typedef short bf16x8 __attribute__((ext_vector_type(8)));
typedef int i32x4 __attribute__((ext_vector_type(4)));
#define RLX_AGENT __ATOMIC_RELAXED, __HIP_MEMORY_SCOPE_AGENT
#define LDS_WAIT() asm volatile("s_waitcnt lgkmcnt(0)" ::: "memory")
#define VM_WAIT() asm volatile("s_waitcnt vmcnt(0)" ::: "memory")

constexpr int T = 16384, D = 2048, DIN = 5120, FW = 1024, RW = 1024, NH = 4, HD = 256, NE = 32, TOPK = 4, DFF = 2048;
constexpr int C2 = 256, NCH = T / C2;
constexpr int CAT = 768;
constexpr float LN_EPS = 1e-5f, GN_EPS = 1e-6f, ALPHA = 1.189207115002721f;
constexpr int RT_MAX = (T * TOPK) / 256 + NE;
constexpr int NWAVES = 8, NTHR = 512;

constexpr size_t MiB = 1u << 20;
constexpr size_t WS_CTL = 0, CTL_BYTES = 1 * MiB;
constexpr size_t WS_TAB = 1 * MiB;
constexpr size_t WS_WIN = 2 * MiB;
constexpr size_t WS_WOUT = WS_WIN + 20 * MiB;
constexpr size_t WS_WUP = WS_WOUT + 8 * MiB;
constexpr size_t WS_WDN = WS_WUP + 512 * MiB;
constexpr size_t WS_H0B = WS_WDN + 256 * MiB;
constexpr size_t WS_ST0 = WS_H0B + 64 * MiB;
constexpr size_t WS_UTT = WS_ST0 + 1 * MiB;
constexpr size_t WS_A1 = WS_UTT + 32 * MiB;
constexpr size_t WS_ZT = WS_A1 + 64 * MiB;
constexpr size_t WS_QS = WS_ZT + 64 * MiB;
constexpr size_t WS_KK = WS_QS + 32 * MiB;
constexpr size_t WS_GS = WS_KK + 32 * MiB;
constexpr size_t WS_ACAT = WS_GS + 32 * MiB;
constexpr size_t WS_BCAT = WS_ACAT + 96 * MiB;
constexpr size_t WS_KTW = WS_BCAT + 96 * MiB;
constexpr size_t WS_KVT = WS_KTW + 64 * MiB;
constexpr size_t WS_Y = WS_KVT + 128 * MiB;
constexpr size_t WS_Z1 = WS_Y + 64 * MiB;
constexpr size_t WS_H1B = WS_Z1 + 128 * MiB;
constexpr size_t WS_RT = WS_H1B + 64 * MiB;
constexpr size_t WS_ACT = WS_RT + 4 * MiB;
constexpr size_t WS_YR = WS_ACT + 288 * MiB;
constexpr size_t WS_END = WS_YR + 288 * MiB;
constexpr size_t WS_SWUP = WS_TAB + 512 * 1024;
constexpr size_t WS_H1Q = WS_H1B;
constexpr size_t WS_SX = WS_H1B + 32 * MiB, WS_RSC = WS_H1B + 40 * MiB;
constexpr int CW_BAR = 1024;
constexpr int CW_CNT = 8192;

constexpr int LDS_STAGE = 131072, LDS_SCR = 16384, LDS_CTL_OFF = LDS_STAGE + LDS_SCR, LDS_BYTES = LDS_CTL_OFF + 512;

__device__ __forceinline__ unsigned cvt_pk_bf16(float lo, float hi) { unsigned r; asm volatile("v_cvt_pk_bf16_f32 %0, %1, %2" : "=v"(r) : "v"(lo), "v"(hi)); return r; }
__device__ __forceinline__ float bf_lo(unsigned u) { return __builtin_bit_cast(float, u << 16); }
__device__ __forceinline__ float bf_hi(unsigned u) { return __builtin_bit_cast(float, u & 0xffff0000u); }
__device__ __forceinline__ v4u pack8(const f32x4 a, const f32x4 b) { v4u w; w.x = cvt_pk_bf16(a[0], a[1]); w.y = cvt_pk_bf16(a[2], a[3]); w.z = cvt_pk_bf16(b[0], b[1]); w.w = cvt_pk_bf16(b[2], b[3]); return w; }
__device__ __forceinline__ float wave_sum(float v) {
#pragma unroll
    for (int o = 1; o < 64; o <<= 1) v += __shfl_xor(v, o);
    return v;
}
__device__ __forceinline__ float fexp(float x) { return __builtin_amdgcn_exp2f(x * 1.4426950408889634f); }
__device__ __forceinline__ void cs_rev(float rev, float& c, float& s) { const float f = __builtin_amdgcn_fractf(rev); c = __builtin_amdgcn_cosf(f); s = __builtin_amdgcn_sinf(f); }

#define XB_TMO      128
#define XB_XCNT(j)  (256  + 64 * (j))
#define XB_XSUB(j)  (1280 + 64 * (j))
#define XB_XGEN(j)  (2304 + 64 * (j))
#define XB_TOP      3328
#define XB_TOPGEN   3392
#define XCD_BAR_WORDS 3456
#define XB_SPIN_CAP (1u << 18)
__device__ __forceinline__ unsigned xb_ld(unsigned* p)              { return __hip_atomic_load(p, __ATOMIC_RELAXED, __HIP_MEMORY_SCOPE_AGENT); }
__device__ __forceinline__ unsigned xb_add(unsigned* p, unsigned v) { return __hip_atomic_fetch_add(p, v, __ATOMIC_RELAXED, __HIP_MEMORY_SCOPE_AGENT); }
__device__ __forceinline__ unsigned xb_xcc_id() { return (unsigned)__builtin_amdgcn_s_getreg((3 << 11) | 20) & 0xFu; }
#define XB_SPIN(cond, bar) do { unsigned _sp = 0; while (cond) { __builtin_amdgcn_s_sleep(1); \
    if ((++_sp & 255u) == 0u) { if (xb_ld(&(bar)[XB_TMO])) break; if (_sp > XB_SPIN_CAP) { atomicAdd(&(bar)[XB_TMO], 1u); break; } } } } while (0)
struct XcdBarrier { unsigned* bar; unsigned x; volatile LAS unsigned* st; };
__device__ __forceinline__ XcdBarrier xcd_barrier_post(unsigned* bar, volatile LAS unsigned* st) {
    XcdBarrier b; b.bar = bar; b.x = xb_xcc_id(); b.st = st;
    if (threadIdx.x == 0) (void)xb_add(&bar[XB_XCNT(b.x)], 1u);
    return b;
}
__device__ __forceinline__ void xcd_barrier_complete(unsigned* bar, unsigned x, unsigned& nloc, unsigned& nx) {
    const unsigned G = gridDim.x * gridDim.y * gridDim.z;
    unsigned sum, cnt, mine, sp = 0u;
    for (;;) {
        sum = 0u; cnt = 0u; mine = 0u;
#pragma unroll
        for (unsigned j = 0; j < 16; ++j) { const unsigned c = xb_ld(&bar[XB_XCNT(j)]); sum += c; cnt += (c > 0u) ? 1u : 0u; mine = (j == x) ? c : mine; }
        if (sum == G) break;
        __builtin_amdgcn_s_sleep(1);
        if ((++sp & 255u) == 0u) { if (xb_ld(&bar[XB_TMO])) break; if (sp > XB_SPIN_CAP) { atomicAdd(&bar[XB_TMO], 1u); break; } }
    }
    nloc = mine > 0u ? mine : 1u; nx = cnt > 0u ? cnt : 1u;
}
__device__ __forceinline__ void xcd_barrier(const XcdBarrier& b) {
    asm volatile("s_waitcnt vmcnt(0)" ::: "memory");
    __syncthreads();
    if (threadIdx.x == 0) {
        unsigned* bar = b.bar;
        __builtin_amdgcn_s_waitcnt(0);
        unsigned nloc = b.st[0], nx = b.st[1];
        if (nloc == 0u) { xcd_barrier_complete(bar, b.x, nloc, nx); b.st[0] = nloc; b.st[1] = nx; }
        const unsigned old = xb_add(&bar[XB_XSUB(b.x)], 1u);
        const unsigned gen = old / nloc;
        if (old + 1u == (gen + 1u) * nloc) {
            __builtin_amdgcn_fence(__ATOMIC_RELEASE, "agent");
            asm volatile("s_waitcnt vmcnt(0)" ::: "memory");
            const unsigned og = xb_add(&bar[XB_TOP], 1u);
            const unsigned tg = og / nx;
            if (og + 1u == (tg + 1u) * nx) xb_add(&bar[XB_TOPGEN], 1u);
            else XB_SPIN(xb_ld(&bar[XB_TOPGEN]) == tg, bar);
            __builtin_amdgcn_fence(__ATOMIC_ACQUIRE, "agent");
            xb_add(&bar[XB_XGEN(b.x)], 1u);
            asm volatile("s_waitcnt vmcnt(0)" ::: "memory");
        } else {
            XB_SPIN(xb_ld(&bar[XB_XGEN(b.x)]) == gen, bar);
            __builtin_amdgcn_fence(__ATOMIC_ACQUIRE, "agent");
            asm volatile("s_waitcnt vmcnt(0)" ::: "memory");
        }
    }
    __syncthreads();
}

namespace gm {
constexpr int BM = 256, BK = 64, HALF = 128, HTB = HALF * BK * 2, STAGE_BYTES = 8 * HTB;
__device__ __forceinline__ int lds_byte(int r, int c) { const int st = (r >> 4) * 2 + (c >> 5), rr = r & 15, cc = c & 31, ob = rr * 64 + cc * 2; return st * 1024 + (ob ^ (((ob >> 9) & 1) << 5)); }
__device__ __forceinline__ void stage_rc(int b, int& R, int& C) { const int st = b / 1024, sb = b % 1024, swz = sb ^ (((sb >> 9) & 1) << 5); R = (st >> 1) * 16 + swz / 64; C = (st & 1) * 32 + (swz % 64) / 2; }
__device__ __forceinline__ int perm32(int rho) { const int n = rho >> 4, i = rho & 15; return 8 * (i >> 2) + 4 * n + (i & 3); }

struct Unit { const char* a0; const char* a1; const char* b0; const char* b1; int p0, p1, p2, p3; };

__device__ __forceinline__ void tile_order(int L, int nM, int nN, int& pm, int& pn) {
    const int nwg = nM * nN; int wgid = L;
    { const int q = nwg / 8, r = nwg % 8, xcd = wgid % 8, off = wgid / 8; wgid = (xcd < r ? xcd * (q + 1) : r * (q + 1) + (xcd - r) * q) + off; }
    const int nig = 8 * nN, gid = wgid / nig, fm = gid * 8, gsz = (nM - fm) < 8 ? (nM - fm) : 8;
    pm = fm + ((wgid % nig) % gsz); pn = (wgid % nig) / gsz;
}

template <bool I8> struct AccSel { typedef f32x4 type; };
template <> struct AccSel<true> { typedef i32x4 type; };
template <class Epi, class Sched, bool GATHER, bool I8 = false>
__device__ __forceinline__ void gemm_run(LAS unsigned char* lds, const Sched& S, const Epi& E) {
    const int tid = threadIdx.x, wid = __builtin_amdgcn_readfirstlane(tid >> 6), lane = tid & 63, wr = wid >> 2, wc = wid & 3, fr = lane & 15, fq = lane >> 4;
    int nt = S.nt; asm volatile("" : "+s"(nt));
    unsigned voffA[2], voffB[2], colA[2]; int rowA[2];
#pragma unroll
    for (int i = 0; i < 2; ++i) { int R, C; stage_rc(tid * 16 + i * 8192, R, C); const int Rb = Epi::PERM ? ((R & ~31) + perm32(R & 31)) : R;
        voffA[i] = (unsigned)(R * S.multA * S.pitchA + C) * 2u; voffB[i] = (unsigned)(Rb * S.multB * S.pitchB + C) * 2u; colA[i] = (unsigned)C * 2u; rowA[i] = R; }
    const size_t kstep = (size_t)(BK * 2);
    const unsigned ldsw = (unsigned)wid * 1024u;
    const int aoff = lds_byte(wr * 64 + fr, fq * 8), boff = lds_byte(wc * 32 + fr, fq * 8);
#define G_SA(b, h) (((b) * 2 + (h)) * HTB)
#define G_SB(b, h) ((4 + (b) * 2 + (h)) * HTB)
#define G_STAGE(bufoff, gbase, voff) do { _Pragma("unroll") for (int _i = 0; _i < 2; ++_i) \
        __builtin_amdgcn_global_load_lds((const unsigned*)((const char*)(gbase) + (voff)[_i]), (LAS unsigned*)(lds + (bufoff) + ldsw + _i * 8192), 16, 0, 0); } while (0)
#define G_LDA(dst, b, h) do { _Pragma("unroll") for (int m = 0; m < 4; ++m) _Pragma("unroll") for (int k = 0; k < 2; ++k) dst[m][k] = *(const LAS bf16x8*)(lds + G_SA(b, h) + aoff + m * 2048 + k * 1024); } while (0)
#define G_LDB(dst, b, h) do { _Pragma("unroll") for (int n = 0; n < 2; ++n) _Pragma("unroll") for (int k = 0; k < 2; ++k) dst[n][k] = *(const LAS bf16x8*)(lds + G_SB(b, h) + boff + n * 2048 + k * 1024); } while (0)
#define G_MMA(ai, bj, At, Bt) do { __builtin_amdgcn_s_setprio(1); _Pragma("unroll") for (int m = 0; m < 4; ++m) _Pragma("unroll") for (int n = 0; n < 2; ++n) _Pragma("unroll") for (int k = 0; k < 2; ++k) \
        { if constexpr (I8) acc[ai][bj][m][n] = __builtin_amdgcn_mfma_i32_16x16x64_i8(__builtin_bit_cast(i32x4, Bt[n][k]), __builtin_bit_cast(i32x4, At[m][k]), acc[ai][bj][m][n], 0, 0, 0); \
          else acc[ai][bj][m][n] = __builtin_amdgcn_mfma_f32_16x16x32_bf16(Bt[n][k], At[m][k], acc[ai][bj][m][n], 0, 0, 0); } __builtin_amdgcn_s_setprio(0); } while (0)
#define G_WAIT_V(n) asm volatile("s_waitcnt vmcnt(" #n ")" ::: "memory")
#define G_WAIT_L(n) asm volatile("s_waitcnt lgkmcnt(" #n ")" ::: "memory")
#define G_BAR __builtin_amdgcn_s_barrier()
#define G_SCHED __builtin_amdgcn_sched_barrier(0)
    Unit cur, nxt; int ui = 0;
    if (!S.next(0, cur)) return;
    typedef typename AccSel<I8>::type acc_t;
    acc_t acc[2][2][4][2];
#pragma unroll
    for (int a = 0; a < 2; ++a)
#pragma unroll
        for (int b = 0; b < 2; ++b)
#pragma unroll
            for (int m = 0; m < 4; ++m)
#pragma unroll
                for (int n = 0; n < 2; ++n) acc[a][b][m][n] = (acc_t){0, 0, 0, 0};
    bf16x8 At[4][2], B0[2][2], B1[2][2];
    unsigned gc0[2], gc1[2];
    if constexpr (GATHER) {
#pragma unroll
        for (int i = 0; i < 2; ++i) { gc0[i] = S.row_off(cur, rowA[i]) + colA[i]; gc1[i] = S.row_off(cur, 128 + rowA[i]) + colA[i]; }
    }
#define vA0 (GATHER ? gc0 : voffA)
#define vA1 (GATHER ? gc1 : voffA)
    G_STAGE(G_SB(0, 0), cur.b0, voffB); G_STAGE(G_SB(0, 1), cur.b1, voffB); G_STAGE(G_SA(0, 0), cur.a0, vA0); G_STAGE(G_SA(0, 1), cur.a1, vA1);
    if (wr == 1) G_BAR;
    G_WAIT_V(2); G_BAR;
    G_STAGE(G_SB(1, 0), cur.b0 + kstep, voffB); G_STAGE(G_SA(1, 0), cur.a0 + kstep, vA0); G_STAGE(G_SB(1, 1), cur.b1 + kstep, voffB);
    G_WAIT_V(6); G_BAR;
    for (;;) {
        const bool has_next = S.next(ui + 1, nxt);
        if (!has_next) nxt = cur;
        for (int t = 0; t < nt; t += 2) {
            const bool last = (t == nt - 2);
            unsigned tn1[2] = {0u, 0u};
            if constexpr (GATHER) { if (last) { int tz = tid; asm volatile("" : "+v"(tz));
#pragma unroll
                for (int i = 0; i < 2; ++i) { int R, C; stage_rc(tz * 16 + i * 8192, R, C); gc0[i] = S.row_off(nxt, R) + (unsigned)C * 2u; tn1[i] = S.row_off(nxt, 128 + R) + (unsigned)C * 2u; } } }
            const char* a11 = cur.a1 + (size_t)(t + 1) * kstep;
            const char* a02 = last ? nxt.a0 : cur.a0 + (size_t)(t + 2) * kstep; const char* a12 = last ? nxt.a1 : cur.a1 + (size_t)(t + 2) * kstep;
            const char* b02 = last ? nxt.b0 : cur.b0 + (size_t)(t + 2) * kstep; const char* b12 = last ? nxt.b1 : cur.b1 + (size_t)(t + 2) * kstep;
            G_LDB(B0, 0, 0); G_LDB(B1, 0, 1); G_SCHED; G_LDA(At, 0, 0); G_STAGE(G_SA(1, 1), a11, vA1);
            if constexpr (GATHER) { if (last) { gc1[0] = tn1[0]; gc1[1] = tn1[1]; } }
            G_WAIT_V(8); G_WAIT_L(0); G_BAR; G_MMA(0, 0, At, B0); G_MMA(0, 1, At, B1); G_BAR; G_SCHED;
            G_LDA(At, 0, 1); G_STAGE(G_SB(0, 0), b02, voffB); G_STAGE(G_SB(0, 1), b12, voffB); G_STAGE(G_SA(0, 0), a02, vA0);
            G_WAIT_V(8); G_WAIT_L(0); G_BAR; G_MMA(1, 0, At, B0); G_MMA(1, 1, At, B1); G_BAR; G_SCHED;
            G_LDB(B0, 1, 0); G_LDB(B1, 1, 1); G_SCHED; G_LDA(At, 1, 0); G_STAGE(G_SA(0, 1), a12, vA1);
            G_WAIT_V(8); G_WAIT_L(0); G_BAR; G_MMA(0, 0, At, B0); G_MMA(0, 1, At, B1); G_BAR; G_SCHED;
            G_LDA(At, 1, 1); G_STAGE(G_SB(1, 0), b02 + kstep, voffB); G_STAGE(G_SB(1, 1), b12 + kstep, voffB); G_STAGE(G_SA(1, 0), a02 + kstep, vA0);
            G_WAIT_V(8); G_WAIT_L(0); G_BAR; G_MMA(1, 0, At, B0); G_MMA(1, 1, At, B1); G_BAR; G_SCHED;
        }
        if (wr == 0) G_BAR;
        { int fr2 = fr, fq2 = fq; asm volatile("" : "+v"(fr2), "+v"(fq2));
          E(acc, cur, lds, wr, wc, fr2, fq2); }
        if (!has_next) break;
#pragma unroll
        for (int a = 0; a < 2; ++a)
#pragma unroll
            for (int b = 0; b < 2; ++b)
#pragma unroll
                for (int m = 0; m < 4; ++m)
#pragma unroll
                    for (int n = 0; n < 2; ++n) acc[a][b][m][n] = (acc_t){0, 0, 0, 0};
        cur = nxt; ++ui;
        if (wr == 1) G_BAR;
    }
    G_WAIT_V(0);
    G_BAR;
#undef G_SA
#undef G_SB
#undef G_STAGE
#undef G_LDA
#undef G_LDB
#undef G_MMA
#undef G_WAIT_V
#undef G_WAIT_L
#undef G_BAR
#undef G_SCHED
#undef vA0
#undef vA1
}
}
using gm::Unit;
typedef f32x4 Acc[2][2][4][2];
typedef i32x4 AccI[2][2][4][2];

struct Args { const float* in[18]; float* out; unsigned char* ws; int ph_lo, ph_hi; };
struct Frame {
    LAS unsigned char* lds; unsigned char* ws; unsigned* ctl;
    int tid, lane, wave, vcu, G;
    const float *x, *ln0_g, *ln0_b, *w_in, *dec_f, *dec_b, *gn_g, *w_out, *ln1_g, *ln1_b, *w_r, *b_r, *w_up, *b_up, *w_dn, *b_dn, *ln2_g, *ln2_b;
    float* out;
};
#define WSP(T_, off) ((T_*)(F.ws + (off)))

template <class ColMap>
__device__ __forceinline__ void transpose_item(const float* W, int K, int N, bf16* WT, LAS float* scr, int item, int lane, const ColMap& cm) {
    const int nblk = N / 64, kb = item / nblk, nb = item % nblk, k0 = 64 * kb, n0 = 64 * nb;
    const int s0 = cm(n0);
#pragma unroll 4
    for (int i = 0; i < 16; ++i) { const int kk = 4 * i + (lane >> 4), c4 = (lane & 15) * 4;
        const f32x4 v = *(const GAS f32x4*)(W + (size_t)(k0 + kk) * N + s0 + c4);
        LAS float* d = scr + kk * 65 + c4; d[0] = v[0]; d[1] = v[1]; d[2] = v[2]; d[3] = v[3]; }
    LDS_WAIT(); asm volatile("" ::: "memory");
    const int c = lane & 7;
#pragma unroll
    for (int j = 0; j < 8; ++j) { const int n = (lane >> 3) + 8 * j; const LAS float* s = scr + (8 * c) * 65 + n;
        v4u o; o.x = cvt_pk_bf16(s[0 * 65], s[1 * 65]); o.y = cvt_pk_bf16(s[2 * 65], s[3 * 65]); o.z = cvt_pk_bf16(s[4 * 65], s[5 * 65]); o.w = cvt_pk_bf16(s[6 * 65], s[7 * 65]);
        *(GAS v4u*)(WT + (size_t)(n0 + n) * K + k0 + 8 * c) = o; }
    LDS_WAIT(); asm volatile("" ::: "memory");
}
struct ColId { __device__ __forceinline__ int operator()(int n) const { return n; } };
struct ColUp { __device__ __forceinline__ int operator()(int n) const { return ((n >> 8) * 128 + (n & 127)) + ((n >> 7) & 1) * 2048; } };

__device__ __forceinline__ void p0_prologue(Frame& F) {
    const int gw = F.vcu * NWAVES + F.wave, NGW = F.G * NWAVES;
    {
        bf16* h0b = WSP(bf16, WS_H0B); float* st0 = WSP(float, WS_ST0);
        for (int m = gw; m < T; m += NGW) {
            const GAS f32x4* xr = (const GAS f32x4*)(F.x + (size_t)m * D) + F.lane;
            f32x4 v[8]; float s = 0.f;
#pragma unroll
            for (int j = 0; j < 8; ++j) { v[j] = xr[64 * j]; s += (v[j][0] + v[j][1]) + (v[j][2] + v[j][3]); }
            const float mean = wave_sum(s) * (1.f / D); float s2 = 0.f;
#pragma unroll
            for (int j = 0; j < 8; ++j) { v[j] = v[j] - mean; s2 += (v[j][0] * v[j][0] + v[j][1] * v[j][1]) + (v[j][2] * v[j][2] + v[j][3] * v[j][3]); }
            const float rstd = 1.f / sqrtf(wave_sum(s2) * (1.f / D) + LN_EPS);
            GAS v2u* o8 = (GAS v2u*)(h0b + (size_t)m * D) + F.lane;
#pragma unroll
            for (int j = 0; j < 8; ++j) { const f32x4 g = *((const GAS f32x4*)F.ln0_g + F.lane + 64 * j), b = *((const GAS f32x4*)F.ln0_b + F.lane + 64 * j);
                const f32x4 h = v[j] * rstd * g + b; v2u w; w.x = cvt_pk_bf16(h[0], h[1]); w.y = cvt_pk_bf16(h[2], h[3]); o8[64 * j] = w; }
            if (F.lane == 0) { st0[2 * m] = mean; st0[2 * m + 1] = rstd; }
        }
    }
    {
        bf16* tab = WSP(bf16, WS_TAB);
        for (int i = (F.vcu * NTHR + F.tid); i < 32768 + 65536 + 65536; i += F.G * NTHR) {
            float v;
            if (i < 32768) { const int r = i >> 7, a = i & 127, ri = r >> 7, k1 = r & 127; float c, s; cs_rev((float)((k1 * a) & 127) * (1.f / 128.f), c, s); v = ri ? -s : c; }
            else if (i < 32768 + 65536) { const int e = i - 32768, r = e >> 8, q = e & 255, ri = r >> 7, k2 = r & 127, rj = q >> 7, b = q & 127; float c, s; cs_rev((float)((k2 * b) & 127) * (1.f / 128.f), c, s);
                v = (ri == 0) ? (rj == 0 ? c : s) : (rj == 0 ? -s : c); }
            else { const int e = i - 32768 - 65536, l = e >> 8, q = e & 255, rj = q >> 7, cg = q & 127; float c, s; cs_rev((float)((l * cg) & 127) * (1.f / 128.f), c, s); v = (l < 128) ? (rj == 0 ? c : s) : 0.f; }
            tab[i] = (bf16)(cvt_pk_bf16(v, 0.f) & 0xffffu);
        }
    }
    {
        LAS float* scr = (LAS float*)(F.lds + F.wave * 18432);
        constexpr int I_IN = 32 * (DIN / 64), I_OUT = 32 * (D / 64), I_UP = 32 * (2 * DFF / 64), I_DN = 32 * (D / 64);
        constexpr int NIT = I_IN + I_OUT + NE * I_UP + NE * I_DN;
        for (int it = gw; it < NIT; it += NGW) {
            int r = it;
            if (r < I_IN) { transpose_item(F.w_in, D, DIN, WSP(bf16, WS_WIN), scr, r, F.lane, ColId()); continue; } r -= I_IN;
            if (r < I_OUT) { transpose_item(F.w_out, D, D, WSP(bf16, WS_WOUT), scr, r, F.lane, ColId()); continue; } r -= I_OUT;
            if (r < NE * I_UP) continue; r -= NE * I_UP;
            { const int e = r / I_DN; transpose_item(F.w_dn + (size_t)e * DFF * D, DFF, D, WSP(bf16, WS_WDN) + (size_t)e * D * DFF, scr, r % I_DN, F.lane, ColId()); }
        }
    }
}

__device__ __forceinline__ void p0_quant_up(Frame& F) {
    constexpr int PITCH = 2056;
    LAS bf16* slab = (LAS bf16*)F.lds;
    LAS float* red = (LAS float*)(F.lds + 32 * PITCH * 2);
    signed char* WQ = (signed char*)WSP(bf16, WS_WUP); float* sw = WSP(float, WS_SWUP);
    for (int sl = F.vcu; sl < NE * 128; sl += F.G) {
        const int e = sl >> 7, n0 = (sl & 127) * 32, s0 = ColUp()(n0);
        const float* W = F.w_up + (size_t)e * D * 2 * DFF + s0;
        const int kq = F.lane >> 3, c4 = (F.lane & 7) * 4;
        f32x4 mx = (f32x4){0.f, 0.f, 0.f, 0.f};
#pragma unroll 8
        for (int i = 0; i < 32; ++i) { const int k = F.wave * 256 + i * 8 + kq; const f32x4 v = *(const GAS f32x4*)(W + (size_t)k * (2 * DFF) + c4);
            mx[0] = fmaxf(mx[0], fabsf(v[0])); mx[1] = fmaxf(mx[1], fabsf(v[1])); mx[2] = fmaxf(mx[2], fabsf(v[2])); mx[3] = fmaxf(mx[3], fabsf(v[3]));
            const unsigned p01 = cvt_pk_bf16(v[0], v[1]), p23 = cvt_pk_bf16(v[2], v[3]);
            slab[(c4 + 0) * PITCH + k] = (bf16)(p01 & 0xffffu); slab[(c4 + 1) * PITCH + k] = (bf16)(p01 >> 16); slab[(c4 + 2) * PITCH + k] = (bf16)(p23 & 0xffffu); slab[(c4 + 3) * PITCH + k] = (bf16)(p23 >> 16); }
#pragma unroll
        for (int j = 0; j < 4; ++j) { float m = mx[j]; m = fmaxf(m, __shfl_xor(m, 8)); m = fmaxf(m, __shfl_xor(m, 16)); m = fmaxf(m, __shfl_xor(m, 32)); mx[j] = m; }
        if (F.lane < 8) { LAS float* d = red + F.wave * 32 + c4; d[0] = mx[0]; d[1] = mx[1]; d[2] = mx[2]; d[3] = mx[3]; }
        __syncthreads();
        if (F.tid < 32) { float m = 0.f;
#pragma unroll
            for (int w = 0; w < 8; ++w) m = fmaxf(m, red[w * 32 + F.tid]);
            const float sc = m > 0.f ? m * (1.f / 127.f) : 1.f; sw[(size_t)e * 2 * DFF + n0 + F.tid] = sc; red[256 + F.tid] = 1.f / sc; }
        __syncthreads();
#pragma unroll 2
        for (int i = 0; i < 8; ++i) { const int q = F.tid + NTHR * i, n = q >> 7, kc = q & 127; const float inv = red[256 + n];
            const v4u a = *(const LAS v4u*)(slab + n * PITCH + kc * 16), b = *(const LAS v4u*)(slab + n * PITCH + kc * 16 + 8);
            const unsigned src[8] = {a.x, a.y, a.z, a.w, b.x, b.y, b.z, b.w}; unsigned o[4];
#pragma unroll
            for (int d = 0; d < 4; ++d) { unsigned w = 0u;
#pragma unroll
                for (int h2 = 0; h2 < 2; ++h2) { const unsigned u2 = src[2 * d + h2]; const int q0 = (int)__builtin_rintf(bf_lo(u2) * inv), q1 = (int)__builtin_rintf(bf_hi(u2) * inv);
                    w |= ((unsigned)(q0 & 0xff) << (16 * h2)) | ((unsigned)(q1 & 0xff) << (16 * h2 + 8)); }
                o[d] = w; }
            *(GAS v4u*)(WQ + ((size_t)e * 2 * DFF + n0 + n) * D + kc * 16) = (v4u){o[0], o[1], o[2], o[3]}; }
        __syncthreads();
    }
}

struct SchedBase { int nt, pitchA, pitchB, multA, multB, G, c; };
struct SchedG1N : SchedBase {
    const char* A; const char* Bt;
    __device__ __forceinline__ bool next(int i, Unit& u) const { const int L = i * G + c; if (L >= 64 * 12) return false; int pm, pn; gm::tile_order(L, 64, 12, pm, pn);
        const int cb = pn < 4 ? 1024 + 256 * pn : (pn < 8 ? 2048 + 256 * (pn - 4) : 4096 + 256 * (pn - 8));
        u.a0 = A + (size_t)pm * 256 * D * 2; u.a1 = u.a0 + (size_t)128 * D * 2; u.b0 = Bt + (size_t)cb * D * 2; u.b1 = u.b0 + (size_t)128 * D * 2; u.p0 = pm; u.p1 = pn; u.p2 = 0; u.p3 = 0; return true; }
};
struct SchedG1SF : SchedBase {
    const char* A; const char* Bt;
    __device__ __forceinline__ bool next(int i, Unit& u) const { const int L = i * G + c; if (L >= 4 * 64) return false; int pm, pn; gm::tile_order(L, 4, 64, pm, pn);
        u.a0 = A + (size_t)pm * 256 * D * 2; u.a1 = u.a0 + (size_t)128 * D * 2; u.b0 = Bt + (size_t)(2 * pn) * D * 2; u.b1 = u.b0 + (size_t)D * 2; u.p0 = pm; u.p1 = pn; u.p2 = 0; u.p3 = 0; return true; }
};
struct SchedG1SKV : SchedBase {
    const char* A; const char* Bt;
    __device__ __forceinline__ bool next(int i, Unit& u) const { const int L = i * G + c; if (L >= 8 * 64) return false; int pm, pn; gm::tile_order(L, 8, 64, pm, pn);
        const int rb = pm < 4 ? 2048 + 256 * pm : 3072 + 256 * (pm - 4);
        u.a0 = A + (size_t)rb * D * 2; u.a1 = u.a0 + (size_t)128 * D * 2; u.b0 = Bt + (size_t)pn * 256 * D * 2; u.b1 = u.b0 + (size_t)128 * D * 2; u.p0 = pm; u.p1 = pn; u.p2 = 0; u.p3 = 0; return true; }
};
struct SchedFixA : SchedBase {
    const char* A; const char* Bt; int ncol;
    __device__ __forceinline__ bool next(int i, Unit& u) const { const int L = i * G + c; if (L >= ncol) return false;
        u.a0 = A; u.a1 = A + (size_t)128 * pitchA * 2; u.b0 = Bt + (size_t)L * 256 * pitchB * 2; u.b1 = u.b0 + (size_t)128 * pitchB * 2; u.p0 = 0; u.p1 = L; u.p2 = 0; u.p3 = 0; return true; }
};
struct SchedFixB : SchedBase {
    const char* A; const char* Bt; int nrow;
    __device__ __forceinline__ bool next(int i, Unit& u) const { const int L = i * G + c; if (L >= nrow) return false;
        u.a0 = A + (size_t)L * 256 * pitchA * 2; u.a1 = u.a0 + (size_t)128 * pitchA * 2; u.b0 = Bt; u.b1 = Bt + (size_t)128 * pitchB * 2; u.p0 = L; u.p1 = 0; u.p2 = 0; u.p3 = 0; return true; }
};
struct SchedScores : SchedBase {
    const char* Q; const char* Kk;
    __device__ __forceinline__ bool next(int i, Unit& u) const { const int L = i * G + c; if (L >= NH * NCH) return false; const int h = L & 3, n = L >> 2;
        u.a0 = Q + ((size_t)n * 256 * RW + h * HD) * 2; u.a1 = u.a0 + (size_t)128 * RW * 2; u.b0 = Kk + ((size_t)n * 256 * RW + h * HD) * 2; u.b1 = u.b0 + (size_t)128 * RW * 2; u.p0 = h; u.p1 = n; u.p2 = 0; u.p3 = 0; return true; }
};
struct SchedKV : SchedBase {
    const char* Bcat; const char* kTw;
    __device__ __forceinline__ bool next(int i, Unit& u) const { const int L = i * G + c; if (L >= 2 * NH * NCH) return false; const int dh = L & 7, n = L >> 3, dir = dh >> 2, h = dh & 3;
        u.a0 = Bcat + ((size_t)(h * NCH + n) * 256 * CAT) * 2; u.a1 = u.a0 + (size_t)128 * CAT * 2;
        u.b0 = kTw + (((size_t)dir * RW + h * HD) * T + (size_t)n * 256) * 2; u.b1 = u.b0 + (size_t)128 * T * 2; u.p0 = dh; u.p1 = n; u.p2 = 0; u.p3 = 0; return true; }
};
struct SchedOut : SchedBase {
    const char* Acat; const char* Bcat;
    __device__ __forceinline__ bool next(int i, Unit& u) const { const int L = i * G + c; if (L >= NH * NCH) return false; const int h = L & 3, n = L >> 2;
        u.a0 = Acat + ((size_t)h * T + (size_t)n * 256) * CAT * 2; u.a1 = u.a0 + (size_t)128 * CAT * 2; u.b0 = Bcat + ((size_t)(h * NCH + n) * 256 * CAT) * 2; u.b1 = u.b0 + (size_t)128 * CAT * 2; u.p0 = h; u.p1 = n; u.p2 = 0; u.p3 = 0; return true; }
};
struct Sched2D : SchedBase {
    const char* A; const char* Bt; int nM, nN;
    __device__ __forceinline__ bool next(int i, Unit& u) const { const int L = i * G + c; if (L >= nM * nN) return false; int pm, pn; gm::tile_order(L, nM, nN, pm, pn);
        u.a0 = A + (size_t)pm * 256 * pitchA * 2; u.a1 = u.a0 + (size_t)128 * pitchA * 2; u.b0 = Bt + (size_t)pn * 256 * pitchB * 2; u.b1 = u.b0 + (size_t)128 * pitchB * 2; u.p0 = pm; u.p1 = pn; u.p2 = 0; u.p3 = 0; return true; }
};
struct SchedMoE : SchedBase {
    const char* A; const char* Bt; const LAS int* tstart; const int* row_tok; const unsigned* cnt; int nN, rowbytes; size_t estride;
    __device__ __forceinline__ bool next(int i, Unit& u) const { const int RT = __builtin_amdgcn_readfirstlane(tstart[NE]); const int L = i * G + c; if (L >= RT * nN) return false; int rt, pn; gm::tile_order(L, RT, nN, rt, pn);
        int e = 0;
        for (int j = 1; j < NE; ++j) e += (__builtin_amdgcn_readfirstlane(tstart[j]) <= rt) ? 1 : 0;
        u.b0 = Bt + (size_t)e * estride + (size_t)pn * 256 * rowbytes; u.b1 = u.b0 + (size_t)128 * rowbytes;
        u.a0 = A; u.a1 = A;
        u.p0 = rt; u.p1 = pn; u.p2 = e; u.p3 = (rt - __builtin_amdgcn_readfirstlane(tstart[e])) * 256; return true; }
    __device__ __forceinline__ unsigned row_off(const Unit& u, int r) const { const int n = (int)cnt[64 * u.p2]; int pos = u.p3 + r; pos = pos < n ? pos : n - 1;
        const int tok = row_tok[(size_t)u.p2 * T + pos]; return (unsigned)tok * (unsigned)rowbytes; }
};
struct SchedMoEDown : SchedMoE {
    __device__ __forceinline__ bool next(int i, Unit& u) const { if (!SchedMoE::next(i, u)) return false; u.a0 = A + (size_t)u.p0 * 256 * DFF * 2; u.a1 = u.a0 + (size_t)128 * DFF * 2; return true; }
};

#define EPI_LOOP_AM for (int ai = 0; ai < 2; ++ai) _Pragma("unroll") for (int m = 0; m < 4; ++m)
#define EPI_FENCE __builtin_amdgcn_sched_barrier(0)
struct EpiG1N {
    static constexpr bool PERM = true;
    bf16 *qs, *kk, *gs, *Acat; const float *dec_f, *dec_b;
    __device__ __forceinline__ void operator()(Acc& acc, const Unit& u, LAS unsigned char*, int wr, int wc, int fr, int fq) const {
        const int pm = u.p0, pn = u.p1, c0 = wc * 32 + 8 * fq;
        if (pn < 8) {
            const int h = pn & 3; const bool isq = pn < 4;
            float inv[8];
#pragma unroll
            for (int e = 0; e < 8; ++e) inv[e] = __builtin_amdgcn_exp2f(-(float)(c0 + e) * (13.287712379549449f / 128.f)) * 0.15915494309189535f;
            const float lgf = -fexp(dec_f[h]), lgb = -fexp(dec_b[h]);
#pragma unroll
            EPI_LOOP_AM {
                const int r = 128 * ai + 64 * wr + 16 * m + fr, tok = pm * 256 + r; const float pos = (float)tok;
                f32x4 o1[2], o2[2];
#pragma unroll
                for (int n = 0; n < 2; ++n)
#pragma unroll
                    for (int j = 0; j < 4; ++j) { float c, s; cs_rev(pos * inv[4 * n + j], c, s); const float x1 = acc[ai][0][m][n][j], x2 = acc[ai][1][m][n][j]; o1[n][j] = x1 * c - x2 * s; o2[n][j] = x2 * c + x1 * s; }
                if (isq) {
                    bf16* q = qs + (size_t)tok * RW + h * HD + c0; *(GAS v4u*)q = pack8(o1[0], o1[1]); *(GAS v4u*)(q + 128) = pack8(o2[0], o2[1]);
                    const int il = r; const float wf = fexp(lgf * (float)(il + 1)), wb = fexp(lgb * (float)(255 - il));
                    bf16* a = Acat + ((size_t)h * T + tok) * CAT + c0;
                    *(GAS v4u*)(a + 256) = pack8(o1[0] * wf, o1[1] * wf); *(GAS v4u*)(a + 384) = pack8(o2[0] * wf, o2[1] * wf);
                    *(GAS v4u*)(a + 512) = pack8(o1[0] * wb, o1[1] * wb); *(GAS v4u*)(a + 640) = pack8(o2[0] * wb, o2[1] * wb);
                } else {
                    bf16* k = kk + (size_t)tok * RW + h * HD + c0; *(GAS v4u*)k = pack8(o1[0] * 0.0625f, o1[1] * 0.0625f); *(GAS v4u*)(k + 128) = pack8(o2[0] * 0.0625f, o2[1] * 0.0625f);
                }
            }
        } else {
#pragma unroll
            EPI_LOOP_AM {
                const int r = 128 * ai + 64 * wr + 16 * m + fr, tok = pm * 256 + r;
#pragma unroll
                for (int bj = 0; bj < 2; ++bj) { f32x4 v[2];
#pragma unroll
                    for (int n = 0; n < 2; ++n)
#pragma unroll
                        for (int j = 0; j < 4; ++j) { const float g = acc[ai][bj][m][n][j]; v[n][j] = g * __builtin_amdgcn_rcpf(1.f + fexp(-g)); }
                    *(GAS v4u*)(gs + (size_t)tok * RW + (pn - 8) * 256 + bj * 128 + c0) = pack8(v[0], v[1]); }
            }
        }
    }
};
struct EpiG1SF {
    static constexpr bool PERM = true;
    bf16* uTT;
    __device__ __forceinline__ void operator()(Acc& acc, const Unit& u, LAS unsigned char*, int wr, int wc, int fr, int fq) const {
        const int a0 = wc * 32 + 8 * fq;
#pragma unroll
        EPI_LOOP_AM { const int cch = u.p0 * 256 + 128 * ai + 64 * wr + 16 * m + fr;
#pragma unroll
            for (int bj = 0; bj < 2; ++bj) *(GAS v4u*)(uTT + ((size_t)cch * 128 + (2 * u.p1 + bj)) * 128 + a0) = pack8(acc[ai][bj][m][0], acc[ai][bj][m][1]); }
    }
};
struct EpiG1SKV {
    static constexpr bool PERM = true;
    bf16 *kTw, *Bcat; const float *dec_f, *dec_b;
    __device__ __forceinline__ void operator()(Acc& acc, const Unit& u, LAS unsigned char*, int wr, int wc, int fr, int fq) const {
        const int pm = u.p0, n_ch = u.p1, c0 = wc * 32 + 8 * fq;
        if (pm < 4) {
            const int h = pm; const float lgf = -fexp(dec_f[h]), lgb = -fexp(dec_b[h]);
#pragma unroll
            for (int m = 0; m < 4; ++m) {
                const int d = 64 * wr + 16 * m + fr;
                const float inv = __builtin_amdgcn_exp2f(-(float)d * (13.287712379549449f / 128.f)) * 0.15915494309189535f;
#pragma unroll
                for (int bj = 0; bj < 2; ++bj) {
                    f32x4 f1[2], f2[2], b1[2], b2[2];
#pragma unroll
                    for (int n = 0; n < 2; ++n)
#pragma unroll
                        for (int j = 0; j < 4; ++j) { const int il = 128 * bj + c0 + 4 * n + j; const float pos = (float)(n_ch * 256 + il); float c, s; cs_rev(pos * inv, c, s);
                            const float x1 = acc[0][bj][m][n][j], x2 = acc[1][bj][m][n][j]; const float o1 = (x1 * c - x2 * s) * 0.0625f, o2 = (x2 * c + x1 * s) * 0.0625f;
                            const float wf = fexp(lgf * (float)(255 - il)), wb = fexp(lgb * (float)(il + 1));
                            f1[n][j] = o1 * wf; f2[n][j] = o2 * wf; b1[n][j] = o1 * wb; b2[n][j] = o2 * wb; }
                    const size_t tcol = (size_t)n_ch * 256 + 128 * bj + c0;
                    bf16* pf = kTw + ((size_t)(h * HD + d)) * T + tcol; bf16* pb = pf + (size_t)RW * T;
                    *(GAS v4u*)pf = pack8(f1[0], f1[1]); *(GAS v4u*)(pf + (size_t)128 * T) = pack8(f2[0], f2[1]);
                    *(GAS v4u*)pb = pack8(b1[0], b1[1]); *(GAS v4u*)(pb + (size_t)128 * T) = pack8(b2[0], b2[1]);
                }
            }
        } else {
            const int h = pm - 4;
#pragma unroll
            EPI_LOOP_AM { const int dv = 128 * ai + 64 * wr + 16 * m + fr;
#pragma unroll
                for (int bj = 0; bj < 2; ++bj) *(GAS v4u*)(Bcat + ((size_t)(h * NCH + n_ch) * 256 + dv) * CAT + 128 * bj + c0) = pack8(acc[ai][bj][m][0], acc[ai][bj][m][1]); }
        }
    }
};
struct EpiS1 {
    static constexpr bool PERM = true;
    bf16* A1;
    __device__ __forceinline__ void operator()(Acc& acc, const Unit& u, LAS unsigned char*, int wr, int wc, int fr, int fq) const {
        const int b0 = wc * 32 + 8 * fq;
#pragma unroll
        for (int m = 0; m < 4; ++m) { const int k1 = 64 * wr + 16 * m + fr;
#pragma unroll
            for (int bj = 0; bj < 2; ++bj) { const int cch = 2 * u.p1 + bj; f32x4 re[2], im[2];
#pragma unroll
                for (int n = 0; n < 2; ++n)
#pragma unroll
                    for (int j = 0; j < 4; ++j) { const int b = b0 + 4 * n + j; float c, s; cs_rev((float)(k1 * b) * (1.f / 16384.f), c, s);
                        const float xr = acc[0][bj][m][n][j], xi = acc[1][bj][m][n][j]; re[n][j] = xr * c + xi * s; im[n][j] = xi * c - xr * s; }
                bf16* p = A1 + (((size_t)k1 * 1024 + cch) * 2) * 128 + b0;
                *(GAS v4u*)p = pack8(re[0], re[1]); *(GAS v4u*)(p + 128) = pack8(im[0], im[1]); EPI_FENCE; } }
    }
};
struct EpiS2 {
    static constexpr bool PERM = true;
    bf16* Zt;
    __device__ __forceinline__ void operator()(Acc& acc, const Unit& u, LAS unsigned char*, int wr, int wc, int fr, int fq) const {
        const int k1 = u.p1 >> 2, cb = (u.p1 & 3) * 256, c0 = wc * 32 + 8 * fq;
#pragma unroll
        EPI_LOOP_AM { const int k2 = 64 * wr + 16 * m + fr, k = k1 + 128 * k2;
#pragma unroll
            for (int bj = 0; bj < 2; ++bj) { const int cch = cb + 128 * bj + c0, g = cch >> 7, cg = cch & 127;
                *(GAS v4u*)(Zt + (size_t)k * 2048 + g * 256 + ai * 128 + cg) = pack8(acc[ai][bj][m][0], acc[ai][bj][m][1]); } }
    }
};
struct EpiChan {
    static constexpr bool PERM = true;
    bf16* y;
    __device__ __forceinline__ void operator()(Acc& acc, const Unit& u, LAS unsigned char*, int wr, int wc, int fr, int fq) const {
        const int l0 = wc * 32 + 8 * fq; const float norm = 6.9053396600248786e-4f;
#pragma unroll
        EPI_LOOP_AM { const int R = u.p0 * 256 + 128 * ai + 64 * wr + 16 * m + fr, k = R >> 3, g = R & 7;
            *(GAS v4u*)(y + (size_t)k * D + g * 128 + l0) = pack8(acc[ai][0][m][0] * norm, acc[ai][0][m][1] * norm); }
    }
};
struct EpiScores {
    static constexpr bool PERM = true;
    bf16* Acat; const float *dec_f, *dec_b;
    __device__ __forceinline__ void operator()(Acc& acc, const Unit& u, LAS unsigned char*, int wr, int wc, int fr, int fq) const {
        const int h = u.p0, n_ch = u.p1, c0 = wc * 32 + 8 * fq; const float lgf = -fexp(dec_f[h]), lgb = -fexp(dec_b[h]);
#pragma unroll
        EPI_LOOP_AM { const int i = 128 * ai + 64 * wr + 16 * m + fr;
#pragma unroll
            for (int bj = 0; bj < 2; ++bj) { f32x4 v[2];
#pragma unroll
                for (int n = 0; n < 2; ++n)
#pragma unroll
                    for (int j = 0; j < 4; ++j) { const int jc = 128 * bj + c0 + 4 * n + j; const float dd = (float)(i - jc); const float w = (jc <= i) ? fexp(lgf * dd) : fexp(-lgb * dd); v[n][j] = acc[ai][bj][m][n][j] * w; }
                *(GAS v4u*)(Acat + ((size_t)h * T + n_ch * 256 + i) * CAT + 128 * bj + c0) = pack8(v[0], v[1]); EPI_FENCE; } }
    }
};
struct EpiKV {
    static constexpr bool PERM = false;
    float* kvT;
    __device__ __forceinline__ void operator()(Acc& acc, const Unit& u, LAS unsigned char*, int wr, int wc, int fr, int fq) const {
#pragma unroll
        EPI_LOOP_AM { const int dv = 128 * ai + 64 * wr + 16 * m + fr; float* rowp = kvT + (((size_t)u.p0 * NCH + u.p1) * 256 + dv) * 256 + wc * 32 + 4 * fq;
#pragma unroll
            for (int bj = 0; bj < 2; ++bj)
#pragma unroll
                for (int n = 0; n < 2; ++n) *(GAS f32x4*)(rowp + bj * 128 + n * 16) = acc[ai][bj][m][n]; }
    }
};
struct EpiOut {
    static constexpr bool PERM = true;
    bf16* y; const bf16* gs; const float* gn_g;
    __device__ __forceinline__ void operator()(Acc& acc, const Unit& u, LAS unsigned char* lds, int wr, int wc, int fr, int fq) const {
        const int h = u.p0, n_ch = u.p1, c0 = wc * 32 + 8 * fq;
        LAS f32x2* P = (LAS f32x2*)(lds + LDS_STAGE);
#pragma unroll
        EPI_LOOP_AM {
            float s = 0.f;
#pragma unroll
            for (int bj = 0; bj < 2; ++bj)
#pragma unroll
                for (int n = 0; n < 2; ++n) { const f32x4 x = acc[ai][bj][m][n]; s += (x[0] + x[1]) + (x[2] + x[3]); }
            s += __shfl_xor(s, 16); s += __shfl_xor(s, 32);
            const float mw = s * (1.f / 64.f); float q = 0.f;
#pragma unroll
            for (int bj = 0; bj < 2; ++bj)
#pragma unroll
                for (int n = 0; n < 2; ++n) { const f32x4 d = acc[ai][bj][m][n] - mw; q += (d[0] * d[0] + d[1] * d[1]) + (d[2] * d[2] + d[3] * d[3]); }
            q += __shfl_xor(q, 16); q += __shfl_xor(q, 32);
            if (fq == 0) P[(128 * ai + 64 * wr + 16 * m + fr) * 4 + wc] = (f32x2){mw, q};
        }
        LDS_WAIT(); __builtin_amdgcn_s_barrier(); asm volatile("" ::: "memory");
#pragma unroll
        EPI_LOOP_AM {
            const int r = 128 * ai + 64 * wr + 16 * m + fr, tok = n_ch * 256 + r;
            const f32x2 a = P[r * 4 + 0], b = P[r * 4 + 1], c = P[r * 4 + 2], d = P[r * 4 + 3];
            const float mt = (a.x + b.x + c.x + d.x) * 0.25f; const float da = a.x - mt, db = b.x - mt, dc = c.x - mt, dd = d.x - mt;
            const float m2 = (a.y + b.y) + (c.y + d.y) + 64.f * ((da * da + db * db) + (dc * dc + dd * dd));
            const float rstd = 1.f / sqrtf(m2 * (1.f / 256.f) + GN_EPS);
#pragma unroll
            for (int bj = 0; bj < 2; ++bj) {
                const int col = h * HD + 128 * bj + c0; const v4u gv = *(const GAS v4u*)(gs + (size_t)tok * RW + col);
                const f32x4 g0 = *(const GAS f32x4*)(gn_g + col), g1 = *(const GAS f32x4*)(gn_g + col + 4);
                f32x4 o0 = (acc[ai][bj][m][0] - mt) * rstd * g0, o1 = (acc[ai][bj][m][1] - mt) * rstd * g1;
                o0[0] *= bf_lo(gv.x); o0[1] *= bf_hi(gv.x); o0[2] *= bf_lo(gv.y); o0[3] *= bf_hi(gv.y); o1[0] *= bf_lo(gv.z); o1[1] *= bf_hi(gv.z); o1[2] *= bf_lo(gv.w); o1[3] *= bf_hi(gv.w);
                *(GAS v4u*)(y + (size_t)tok * D + FW + col) = pack8(o0, o1); }
        }
        LDS_WAIT(); __builtin_amdgcn_s_barrier(); asm volatile("" ::: "memory");
    }
};
struct EpiWout {
    static constexpr bool PERM = false;
    float* z1; const float *x, *st0, *g0, *b0;
    __device__ __forceinline__ void operator()(Acc& acc, const Unit& u, LAS unsigned char*, int wr, int wc, int fr, int fq) const {
        const int colb = u.p1 * 256 + wc * 32 + 4 * fq;
#pragma unroll
        EPI_LOOP_AM { const int row = u.p0 * 256 + 128 * ai + 64 * wr + 16 * m + fr; const f32x2 st = *(const GAS f32x2*)(st0 + 2 * row);
#pragma unroll
            for (int bj = 0; bj < 2; ++bj)
#pragma unroll
                for (int n = 0; n < 2; ++n) { const int col = colb + bj * 128 + n * 16; const size_t off = (size_t)row * D + col;
                    const f32x4 xv = *(const GAS f32x4*)(x + off), g = *(const GAS f32x4*)(g0 + col), b = *(const GAS f32x4*)(b0 + col);
                    *(GAS f32x4*)(z1 + off) = ((xv - st.x) * st.y * g + b) * ALPHA + acc[ai][bj][m][n]; } }
    }
};
struct EpiUp {
    static constexpr bool PERM = true;
    bf16* act; const float *b_up, *swup, *rsc; const unsigned* cnt;
    __device__ __forceinline__ void operator()(AccI& acc, const Unit& u, LAS unsigned char*, int wr, int wc, int fr, int fq) const {
        const int rt = u.p0, pn = u.p1, e = u.p2, c0 = pn * 128 + wc * 32 + 8 * fq; const int ne = (int)cnt[64 * e];
        float sx[2][4];
#pragma unroll
        EPI_LOOP_AM { int pos = u.p3 + 128 * ai + 64 * wr + 16 * m + fr; pos = pos < ne ? pos : ne - 1; sx[ai][m] = rsc[(size_t)e * T + pos]; }
#pragma unroll
        for (int n = 0; n < 2; ++n) {
            const float* bu = b_up + (size_t)e * 2 * DFF + c0 + 4 * n; const float* sw = swup + (size_t)e * 2 * DFF + pn * 256 + wc * 32 + 8 * fq + 4 * n;
            const f32x4 bg = *(const GAS f32x4*)bu, bl = *(const GAS f32x4*)(bu + DFF), sg = *(const GAS f32x4*)sw, sl = *(const GAS f32x4*)(sw + 128);
#pragma unroll
            EPI_LOOP_AM { const int r = 128 * ai + 64 * wr + 16 * m + fr; f32x4 v;
#pragma unroll
                for (int j = 0; j < 4; ++j) { float gl = (float)acc[ai][0][m][n][j] * (sx[ai][m] * sg[j]) + bg[j], li = (float)acc[ai][1][m][n][j] * (sx[ai][m] * sl[j]) + bl[j];
                    gl = fminf(gl, 7.f); li = fminf(fmaxf(li, -7.f), 7.f); v[j] = gl * __builtin_amdgcn_rcpf(1.f + fexp(-1.702f * gl)) * (li + 1.f); }
                v2u w; w.x = cvt_pk_bf16(v[0], v[1]); w.y = cvt_pk_bf16(v[2], v[3]);
                *(GAS v2u*)(act + ((size_t)rt * 256 + r) * DFF + c0 + 4 * n) = w; }
        }
    }
};
struct EpiDown {
    static constexpr bool PERM = true;
    bf16* yr; const float* b_dn;
    __device__ __forceinline__ void operator()(Acc& acc, const Unit& u, LAS unsigned char*, int wr, int wc, int fr, int fq) const {
        const int rt = u.p0, pn = u.p1, e = u.p2, c0 = pn * 256 + wc * 32 + 8 * fq;
#pragma unroll
        for (int bj = 0; bj < 2; ++bj) { const float* bd = b_dn + (size_t)e * D + c0 + 128 * bj; const f32x4 b0 = *(const GAS f32x4*)bd, b1 = *(const GAS f32x4*)(bd + 4);
#pragma unroll
            EPI_LOOP_AM { const int r = 128 * ai + 64 * wr + 16 * m + fr;
                *(GAS v4u*)(yr + ((size_t)rt * 256 + r) * D + c0 + 128 * bj) = pack8(acc[ai][bj][m][0] + b0, acc[ai][bj][m][1] + b1); } }
    }
};

__device__ __forceinline__ void p3_scan(Frame& F) {
    const float* kvT = WSP(float, WS_KVT); bf16* Bcat = WSP(bf16, WS_BCAT);
    const int NQ = 2 * NH * 256 * 64;
    for (int q = F.vcu * NTHR + F.tid; q < NQ; q += F.G * NTHR) {
        const int dk4 = q & 63, dv = (q >> 6) & 255, dh = q >> 14, dir = dh >> 2, h = dh & 3;
        const float lg = -fexp((dir ? F.dec_b : F.dec_f)[h]); const float cd = fexp(lg * (float)C2);
        f32x4 S = (f32x4){0.f, 0.f, 0.f, 0.f};
        for (int s = 0; s < NCH; ++s) { const int n = dir ? (NCH - 1 - s) : s;
            const f32x4 kv = *(const GAS f32x4*)(kvT + (((size_t)dh * NCH + n) * 256 + dv) * 256 + dk4 * 4);
            v2u w; w.x = cvt_pk_bf16(S[0], S[1]); w.y = cvt_pk_bf16(S[2], S[3]);
            *(GAS v2u*)(Bcat + ((size_t)(h * NCH + n) * 256 + dv) * CAT + 256 + dir * 256 + dk4 * 4) = w;
            S = S * cd + kv; }
    }
}

__device__ __forceinline__ void p6_router(Frame& F) {
    const float* z1 = WSP(float, WS_Z1); unsigned* h1q = WSP(unsigned, WS_H1Q); float* sxg = WSP(float, WS_SX); float* rsc = WSP(float, WS_RSC); float* st1 = WSP(float, WS_ST0) + 2 * T;
    int* topi = WSP(int, WS_RT); float* gate = (float*)(topi + 4 * T); int* posb = (int*)(gate + 4 * T); int* row_tok = posb + 4 * T;
    LAS float* hc = (LAS float*)F.lds;
    LAS float* wrc = hc + 64 * 257;
    LAS float* stl = wrc + 256 * 32;
    LAS float* lg = stl + 128;
    LAS int* hist = (LAS int*)(lg + 64 * 33);
    LAS float* sxl = (LAS float*)(hist + 64);
    for (int blk = F.vcu; blk < T / 64; blk += F.G) {
        const int t0 = blk * 64;
        for (int rr = 0; rr < 8; ++rr) { const int row = F.wave * 8 + rr, m = t0 + row;
            const GAS f32x4* xr = (const GAS f32x4*)(z1 + (size_t)m * D) + F.lane; f32x4 v[8]; float s = 0.f;
#pragma unroll
            for (int j = 0; j < 8; ++j) { v[j] = xr[64 * j]; s += (v[j][0] + v[j][1]) + (v[j][2] + v[j][3]); }
            const float mean = wave_sum(s) * (1.f / D); float s2 = 0.f;
#pragma unroll
            for (int j = 0; j < 8; ++j) { v[j] = v[j] - mean; s2 += (v[j][0] * v[j][0] + v[j][1] * v[j][1]) + (v[j][2] * v[j][2] + v[j][3] * v[j][3]); }
            const float rstd = 1.f / sqrtf(wave_sum(s2) * (1.f / D) + LN_EPS);
            float am = 0.f;
#pragma unroll
            for (int j = 0; j < 8; ++j) { const f32x4 g = *((const GAS f32x4*)F.ln1_g + F.lane + 64 * j), b = *((const GAS f32x4*)F.ln1_b + F.lane + 64 * j);
                v[j] = v[j] * rstd * g + b; am = fmaxf(am, fmaxf(fmaxf(fabsf(v[j][0]), fabsf(v[j][1])), fmaxf(fabsf(v[j][2]), fabsf(v[j][3])))); }
#pragma unroll
            for (int o = 1; o < 64; o <<= 1) am = fmaxf(am, __shfl_xor(am, o));
            const float sc = am > 0.f ? am * (1.f / 127.f) : 1.f, inv = 1.f / sc;
#pragma unroll
            for (int j = 0; j < 8; ++j) { const int q0 = (int)__builtin_rintf(v[j][0] * inv), q1 = (int)__builtin_rintf(v[j][1] * inv), q2 = (int)__builtin_rintf(v[j][2] * inv), q3 = (int)__builtin_rintf(v[j][3] * inv);
                h1q[(size_t)m * (D / 4) + F.lane + 64 * j] = (unsigned)(q0 & 0xff) | ((unsigned)(q1 & 0xff) << 8) | ((unsigned)(q2 & 0xff) << 16) | ((unsigned)(q3 & 0xff) << 24); }
            if (F.lane == 0) { st1[2 * m] = mean; st1[2 * m + 1] = rstd; stl[2 * row] = mean; stl[2 * row + 1] = rstd; sxg[m] = sc; sxl[row] = sc; }
        }
        if (F.tid < 64) hist[F.tid] = 0;
        __syncthreads();
        const int row = F.tid >> 3, e0 = (F.tid & 7) * 4; f32x4 accl = (f32x4){0.f, 0.f, 0.f, 0.f};
        for (int kc = 0; kc < 8; ++kc) {
            for (int i = F.tid; i < 64 * 64; i += NTHR) { const int r = i >> 6, c4 = (i & 63) * 4, col = kc * 256 + c4;
                const f32x4 zv = *(const GAS f32x4*)(z1 + (size_t)(t0 + r) * D + col), g = *(const GAS f32x4*)(F.ln1_g + col), b = *(const GAS f32x4*)(F.ln1_b + col);
                const f32x4 hh = (zv - stl[2 * r]) * stl[2 * r + 1] * g + b; LAS float* d = hc + r * 257 + c4; d[0] = hh[0]; d[1] = hh[1]; d[2] = hh[2]; d[3] = hh[3]; }
            for (int i = F.tid; i < 256 * 8; i += NTHR) { const int k = i >> 3, c4 = (i & 7) * 4; *(LAS f32x4*)(wrc + k * 32 + c4) = *(const GAS f32x4*)(F.w_r + (size_t)(kc * 256 + k) * NE + c4); }
            __syncthreads();
#pragma unroll 8
            for (int k = 0; k < 256; ++k) { const float hv = hc[row * 257 + k]; const f32x4 w = *(const LAS f32x4*)(wrc + k * 32 + e0); accl = accl + w * hv; }
            __syncthreads();
        }
        { const f32x4 br = *(const GAS f32x4*)(F.b_r + e0); LAS float* d = lg + row * 33 + e0; d[0] = accl[0] + br[0]; d[1] = accl[1] + br[1]; d[2] = accl[2] + br[2]; d[3] = accl[3] + br[3]; }
        __syncthreads();
        int ek[4] = {0, 0, 0, 0}, lp[4] = {0, 0, 0, 0}; float gk[4] = {0.f, 0.f, 0.f, 0.f};
        if (F.tid < 64) {
            float lv[4]; unsigned used = 0u;
#pragma unroll
            for (int k = 0; k < 4; ++k) { float best = -3.0e38f; int bi = 0;
                for (int e = 0; e < NE; ++e) { const float v = lg[F.tid * 33 + e]; const bool ok = !((used >> e) & 1u) && (v > best); best = ok ? v : best; bi = ok ? e : bi; }
                used |= 1u << bi; ek[k] = bi; lv[k] = best; }
            const float mx = lv[0]; float den = 0.f;
#pragma unroll
            for (int k = 0; k < 4; ++k) { gk[k] = fexp(lv[k] - mx); den += gk[k]; }
            const float rd = 1.f / den;
#pragma unroll
            for (int k = 0; k < 4; ++k) { gk[k] *= rd; lp[k] = __hip_atomic_fetch_add(&hist[ek[k]], 1, __ATOMIC_RELAXED, __HIP_MEMORY_SCOPE_WORKGROUP); }
        }
        __syncthreads();
        if (F.tid < NE) hist[32 + F.tid] = (int)__hip_atomic_fetch_add(F.ctl + CW_CNT + 64 * F.tid, (unsigned)hist[F.tid], RLX_AGENT);
        __syncthreads();
        if (F.tid < 64) { const int tok = t0 + F.tid;
#pragma unroll
            for (int k = 0; k < 4; ++k) { const int pos = hist[32 + ek[k]] + lp[k]; row_tok[(size_t)ek[k] * T + pos] = tok; rsc[(size_t)ek[k] * T + pos] = sxl[F.tid]; topi[4 * tok + k] = ek[k]; gate[4 * tok + k] = gk[k]; posb[4 * tok + k] = pos; } }
        __syncthreads();
    }
}

__device__ __forceinline__ void build_tstart(Frame& F, LAS int* tstart) {
    if (F.tid == 0) { int s = 0; for (int e = 0; e < NE; ++e) { tstart[e] = s; const unsigned n = __hip_atomic_load(F.ctl + CW_CNT + 64 * e, RLX_AGENT); s += (int)((n + 255u) >> 8); } tstart[NE] = s; }
    __syncthreads();
}

__device__ __forceinline__ void p9_combine(Frame& F, const LAS int* tstart) {
    const float* z1 = WSP(float, WS_Z1); const float* st1 = WSP(float, WS_ST0) + 2 * T; const bf16* yr = WSP(bf16, WS_YR);
    const int* topi = WSP(int, WS_RT); const float* gate = (const float*)(topi + 4 * T); const int* posb = (const int*)(gate + 4 * T);
    const int gw = F.vcu * NWAVES + F.wave, NGW = F.G * NWAVES;
    for (int m = gw; m < T; m += NGW) {
        const float mean1 = st1[2 * m], rstd1 = st1[2 * m + 1];
        size_t ro[4]; float gk[4];
#pragma unroll
        for (int k = 0; k < 4; ++k) { const int e = topi[4 * m + k]; ro[k] = ((size_t)tstart[e] * 256 + posb[4 * m + k]) * D; gk[k] = gate[4 * m + k]; }
        f32x4 v[8]; float s = 0.f;
#pragma unroll
        for (int j = 0; j < 8; ++j) { const int col = 4 * F.lane + 256 * j;
            const f32x4 zv = *(const GAS f32x4*)(z1 + (size_t)m * D + col), g = *(const GAS f32x4*)(F.ln1_g + col), b = *(const GAS f32x4*)(F.ln1_b + col);
            f32x4 a = ((zv - mean1) * rstd1 * g + b) * ALPHA;
#pragma unroll
            for (int k = 0; k < 4; ++k) { const v2u w = *(const GAS v2u*)(yr + ro[k] + col); a[0] += gk[k] * bf_lo(w.x); a[1] += gk[k] * bf_hi(w.x); a[2] += gk[k] * bf_lo(w.y); a[3] += gk[k] * bf_hi(w.y); }
            v[j] = a; s += (a[0] + a[1]) + (a[2] + a[3]); }
        const float mean = wave_sum(s) * (1.f / D); float s2 = 0.f;
#pragma unroll
        for (int j = 0; j < 8; ++j) { v[j] = v[j] - mean; s2 += (v[j][0] * v[j][0] + v[j][1] * v[j][1]) + (v[j][2] * v[j][2] + v[j][3] * v[j][3]); }
        const float rstd = 1.f / sqrtf(wave_sum(s2) * (1.f / D) + LN_EPS);
#pragma unroll
        for (int j = 0; j < 8; ++j) { const int col = 4 * F.lane + 256 * j; const f32x4 g = *(const GAS f32x4*)(F.ln2_g + col), b = *(const GAS f32x4*)(F.ln2_b + col);
            *(GAS f32x4*)(F.out + (size_t)m * D + col) = v[j] * rstd * g + b; }
    }
}

constexpr int NPH = 10;
__global__ void __launch_bounds__(NTHR, 2) fwd(Args args) {
    extern __shared__ __attribute__((aligned(16))) unsigned char lds_raw[];
    Frame F;
    F.lds = (LAS unsigned char*)lds_raw; F.ws = args.ws; F.ctl = (unsigned*)(args.ws + WS_CTL);
    F.tid = threadIdx.x; F.lane = F.tid & 63; F.wave = __builtin_amdgcn_readfirstlane(F.tid >> 6);
    F.G = gridDim.x; { const int bx = blockIdx.x; F.vcu = (F.G % 8 == 0) ? (bx % 8) * (F.G / 8) + bx / 8 : bx; }
    F.x = args.in[0]; F.ln0_g = args.in[1]; F.ln0_b = args.in[2]; F.w_in = args.in[3]; F.dec_f = args.in[4]; F.dec_b = args.in[5]; F.gn_g = args.in[6]; F.w_out = args.in[7];
    F.ln1_g = args.in[8]; F.ln1_b = args.in[9]; F.w_r = args.in[10]; F.b_r = args.in[11]; F.w_up = args.in[12]; F.b_up = args.in[13]; F.w_dn = args.in[14]; F.b_dn = args.in[15];
    F.ln2_g = args.in[16]; F.ln2_b = args.in[17]; F.out = args.out;
    volatile LAS unsigned* lctl = (volatile LAS unsigned*)(F.lds + LDS_CTL_OFF);
    LAS int* tstart = (LAS int*)(F.lds + LDS_CTL_OFF + 64);
    for (int u = F.tid; u < 128; u += NTHR) lctl[u] = 0u;
    __syncthreads();
    const int lo = args.ph_lo, hi = args.ph_hi;
    const bool single = (hi - lo) > 1;
    XcdBarrier bar; bar.bar = F.ctl + CW_BAR; bar.x = 0; bar.st = lctl;
    if (single) bar = xcd_barrier_post(F.ctl + CW_BAR, lctl);
#ifndef PH_MASK
#define PH_MASK 0x3ff
#endif
#define IN(k) (((PH_MASK >> (k)) & 1) && lo <= (k) && (k) < hi)
#ifndef SUB_MASK
#define SUB_MASK 0xff
#endif
#define SUB(n) ((SUB_MASK >> (n)) & 1)
#define SEAM(k) do { if (IN(k) && IN((k) + 1)) xcd_barrier(bar); } while (0)
    const int bc = (int)blockIdx.x;

    if (IN(0)) { p0_prologue(F); __syncthreads(); p0_quant_up(F); }
    SEAM(0);
    if (IN(1)) {
        if (SUB(0)) { SchedG1N S; S.nt = D / 64; S.pitchA = D; S.pitchB = D; S.multA = 1; S.multB = 1; S.G = F.G; S.c = bc; S.A = (const char*)WSP(bf16, WS_H0B); S.Bt = (const char*)WSP(bf16, WS_WIN);
          EpiG1N E{WSP(bf16, WS_QS), WSP(bf16, WS_KK), WSP(bf16, WS_GS), WSP(bf16, WS_ACAT), F.dec_f, F.dec_b};
          gm::gemm_run<EpiG1N, SchedG1N, false>(F.lds, S, E); }
        if (SUB(1)) { SchedG1SF S; S.nt = D / 64; S.pitchA = D; S.pitchB = D; S.multA = 1; S.multB = 128; S.G = F.G; S.c = bc; S.A = (const char*)WSP(bf16, WS_WIN); S.Bt = (const char*)WSP(bf16, WS_H0B);
          EpiG1SF E{WSP(bf16, WS_UTT)};
          gm::gemm_run<EpiG1SF, SchedG1SF, false>(F.lds, S, E); }
        if (SUB(2)) { SchedG1SKV S; S.nt = D / 64; S.pitchA = D; S.pitchB = D; S.multA = 1; S.multB = 1; S.G = F.G; S.c = bc; S.A = (const char*)WSP(bf16, WS_WIN); S.Bt = (const char*)WSP(bf16, WS_H0B);
          EpiG1SKV E{WSP(bf16, WS_KTW), WSP(bf16, WS_BCAT), F.dec_f, F.dec_b};
          gm::gemm_run<EpiG1SKV, SchedG1SKV, false>(F.lds, S, E); }
    }
    SEAM(1);
    if (IN(2)) {
        if (SUB(3)) { SchedFixA S; S.nt = 2; S.pitchA = 128; S.pitchB = 128; S.multA = 1; S.multB = 1; S.G = F.G; S.c = bc; S.A = (const char*)WSP(bf16, WS_TAB); S.Bt = (const char*)WSP(bf16, WS_UTT); S.ncol = 512;
          EpiS1 E{WSP(bf16, WS_A1)};
          gm::gemm_run<EpiS1, SchedFixA, false>(F.lds, S, E); }
        if (SUB(4)) { SchedScores S; S.nt = 4; S.pitchA = RW; S.pitchB = RW; S.multA = 1; S.multB = 1; S.G = F.G; S.c = bc; S.Q = (const char*)WSP(bf16, WS_QS); S.Kk = (const char*)WSP(bf16, WS_KK);
          EpiScores E{WSP(bf16, WS_ACAT), F.dec_f, F.dec_b};
          gm::gemm_run<EpiScores, SchedScores, false>(F.lds, S, E); }
        if (SUB(5)) { SchedKV S; S.nt = 4; S.pitchA = CAT; S.pitchB = T; S.multA = 1; S.multB = 1; S.G = F.G; S.c = bc; S.Bcat = (const char*)WSP(bf16, WS_BCAT); S.kTw = (const char*)WSP(bf16, WS_KTW);
          EpiKV E{WSP(float, WS_KVT)};
          gm::gemm_run<EpiKV, SchedKV, false>(F.lds, S, E); }
    }
    SEAM(2);
    if (IN(3)) {
        { SchedFixA S; S.nt = 4; S.pitchA = 256; S.pitchB = 256; S.multA = 1; S.multB = 1; S.G = F.G; S.c = bc; S.A = (const char*)(WSP(bf16, WS_TAB) + 32768); S.Bt = (const char*)WSP(bf16, WS_A1); S.ncol = 512;
          EpiS2 E{WSP(bf16, WS_ZT)};
          gm::gemm_run<EpiS2, SchedFixA, false>(F.lds, S, E); }
        p3_scan(F);
    }
    SEAM(3);
    if (IN(4)) {
        { SchedFixB S; S.nt = 4; S.pitchA = 256; S.pitchB = 256; S.multA = 1; S.multB = 1; S.G = F.G; S.c = bc; S.A = (const char*)WSP(bf16, WS_ZT); S.Bt = (const char*)(WSP(bf16, WS_TAB) + 32768 + 65536); S.nrow = 512;
          EpiChan E{WSP(bf16, WS_Y)};
          gm::gemm_run<EpiChan, SchedFixB, false>(F.lds, S, E); }
        { SchedOut S; S.nt = CAT / 64; S.pitchA = CAT; S.pitchB = CAT; S.multA = 1; S.multB = 1; S.G = F.G; S.c = bc; S.Acat = (const char*)WSP(bf16, WS_ACAT); S.Bcat = (const char*)WSP(bf16, WS_BCAT);
          EpiOut E{WSP(bf16, WS_Y), WSP(bf16, WS_GS), F.gn_g};
          gm::gemm_run<EpiOut, SchedOut, false>(F.lds, S, E); }
    }
    SEAM(4);
    if (IN(5)) {
        Sched2D S; S.nt = D / 64; S.pitchA = D; S.pitchB = D; S.multA = 1; S.multB = 1; S.G = F.G; S.c = bc; S.A = (const char*)WSP(bf16, WS_Y); S.Bt = (const char*)WSP(bf16, WS_WOUT); S.nM = 64; S.nN = 8;
        EpiWout E{WSP(float, WS_Z1), F.x, WSP(float, WS_ST0), F.ln0_g, F.ln0_b};
        gm::gemm_run<EpiWout, Sched2D, false>(F.lds, S, E);
    }
    SEAM(5);
    if (IN(6)) { p6_router(F); }
    SEAM(6);
    if (IN(7) || IN(8) || IN(9)) build_tstart(F, tstart);
    if (IN(7)) {
        SchedMoE S; S.nt = D / 128; S.pitchA = D / 2; S.pitchB = D / 2; S.multA = 1; S.multB = 1; S.G = F.G; S.c = bc; S.A = (const char*)WSP(char, WS_H1Q); S.Bt = (const char*)WSP(char, WS_WUP);
        S.tstart = tstart; S.row_tok = WSP(int, WS_RT) + 12 * T; S.cnt = F.ctl + CW_CNT; S.nN = 16; S.rowbytes = D; S.estride = (size_t)2 * DFF * D;
        EpiUp E{WSP(bf16, WS_ACT), F.b_up, WSP(float, WS_SWUP), WSP(float, WS_RSC), F.ctl + CW_CNT};
        gm::gemm_run<EpiUp, SchedMoE, true, true>(F.lds, S, E);
    }
    SEAM(7);
    if (IN(8)) {
        SchedMoEDown S; S.nt = DFF / 64; S.pitchA = DFF; S.pitchB = DFF; S.multA = 1; S.multB = 1; S.G = F.G; S.c = bc; S.A = (const char*)WSP(bf16, WS_ACT); S.Bt = (const char*)WSP(bf16, WS_WDN);
        S.tstart = tstart; S.row_tok = nullptr; S.cnt = F.ctl + CW_CNT; S.nN = 8; S.rowbytes = DFF * 2; S.estride = (size_t)D * DFF * 2;
        EpiDown E{WSP(bf16, WS_YR), F.b_dn};
        gm::gemm_run<EpiDown, SchedMoEDown, false>(F.lds, S, E);
    }
    SEAM(8);
    if (IN(9)) { p9_combine(F, tstart); }
#undef IN
#undef SEAM
}

#ifndef MK_SPLIT
#define MK_SPLIT 0
#endif
extern "C" void kernel_launch(void* const* d_in, const int* in_sizes, int n_in, void* d_out, int out_size, void* d_ws, size_t ws_size, hipStream_t stream) {
    static int grid = 0;
    if (grid == 0) {
        if (n_in != 18 || out_size != T * D || ws_size < WS_END) { fprintf(stderr, "kernel_launch: unexpected problem: n_in %d out %d ws %zu (need %zu)\n", n_in, out_size, ws_size, (size_t)WS_END); grid = -1; return; }
        int dev = 0, cus = 0, per_cu = 0;
        if (hipGetDevice(&dev) != hipSuccess || hipDeviceGetAttribute(&cus, hipDeviceAttributeMultiprocessorCount, dev) != hipSuccess) { grid = -1; return; }
        if (hipFuncSetAttribute((const void*)fwd, hipFuncAttributeMaxDynamicSharedMemorySize, LDS_BYTES) != hipSuccess) { fprintf(stderr, "kernel_launch: hipFuncSetAttribute failed\n"); grid = -1; return; }
        if (hipOccupancyMaxActiveBlocksPerMultiprocessor(&per_cu, (const void*)fwd, NTHR, LDS_BYTES) != hipSuccess || per_cu < 1) { fprintf(stderr, "kernel_launch: occupancy query reports %d\n", per_cu); }
        (void)hipGetLastError();
        grid = cus;
    }
    if (grid < 0) return;
    (void)hipMemsetAsync((char*)d_ws + WS_CTL, 0, CTL_BYTES, stream);
    Args a{};
    for (int i = 0; i < 18; ++i) a.in[i] = (const float*)d_in[i];
    a.out = (float*)d_out; a.ws = (unsigned char*)d_ws;
#if MK_SPLIT
    for (int p = 0; p < NPH; ++p) { a.ph_lo = p; a.ph_hi = p + 1; hipLaunchKernelGGL(fwd, dim3(grid), dim3(NTHR), LDS_BYTES, stream, a); }
#else
    a.ph_lo = 0; a.ph_hi = NPH; hipLaunchKernelGGL(fwd, dim3(grid), dim3(NTHR), LDS_BYTES, stream, a);
#endif
}
```

```cpp
#include <hip/hip_runtime.h>
#include <cstdio>
#include <cstdint>

#define GAS __attribute__((address_space(1)))
#define LAS __attribute__((address_space(3)))
typedef unsigned short bf16;
typedef unsigned v4u __attribute__((ext_vector_type(4)));
typedef unsigned v2u __attribute__((ext_vector_type(2)));
typedef float f32x4 __attribute__((ext_vector_type(4)));
typedef float f32x2 __attribute__((ext_vector_type(2)));
typedef short bf16x8 __attribute__((ext_vector_type(8)));
typedef int i32x4 __attribute__((ext_vector_type(4)));
#define RLX_AGENT __ATOMIC_RELAXED, __HIP_MEMORY_SCOPE_AGENT
#define LDS_WAIT() asm volatile("s_waitcnt lgkmcnt(0)" ::: "memory")
#define VM_WAIT() asm volatile("s_waitcnt vmcnt(0)" ::: "memory")

constexpr int T = 16384, D = 2048, DIN = 5120, FW = 1024, RW = 1024, NH = 4, HD = 256, NE = 32, TOPK = 4, DFF = 2048;
constexpr int C2 = 256, NCH = T / C2;
constexpr int CAT = 768;
constexpr float LN_EPS = 1e-5f, GN_EPS = 1e-6f, ALPHA = 1.189207115002721f;
constexpr int RT_MAX = (T * TOPK) / 256 + NE;
constexpr int NWAVES = 8, NTHR = 512;

constexpr size_t MiB = 1u << 20;
constexpr size_t WS_CTL = 0, CTL_BYTES = 1 * MiB;
constexpr size_t WS_TAB = 1 * MiB;
constexpr size_t WS_WIN = 2 * MiB;
constexpr size_t WS_WOUT = WS_WIN + 20 * MiB;
constexpr size_t WS_WUP = WS_WOUT + 8 * MiB;
constexpr size_t WS_WDN = WS_WUP + 512 * MiB;
constexpr size_t WS_H0B = WS_WDN + 256 * MiB;
constexpr size_t WS_ST0 = WS_H0B + 64 * MiB;
constexpr size_t WS_UTT = WS_ST0 + 1 * MiB;
constexpr size_t WS_A1 = WS_UTT + 32 * MiB;
constexpr size_t WS_ZT = WS_A1 + 64 * MiB;
constexpr size_t WS_QS = WS_ZT + 64 * MiB;
constexpr size_t WS_KK = WS_QS + 32 * MiB;
constexpr size_t WS_GS = WS_KK + 32 * MiB;
constexpr size_t WS_ACAT = WS_GS + 32 * MiB;
constexpr size_t WS_BCAT = WS_ACAT + 96 * MiB;
constexpr size_t WS_KTW = WS_BCAT + 96 * MiB;
constexpr size_t WS_KVT = WS_KTW + 64 * MiB;
constexpr size_t WS_Y = WS_KVT + 128 * MiB;
constexpr size_t WS_Z1 = WS_Y + 64 * MiB;
constexpr size_t WS_H1B = WS_Z1 + 128 * MiB;
constexpr size_t WS_RT = WS_H1B + 64 * MiB;
constexpr size_t WS_ACT = WS_RT + 4 * MiB;
constexpr size_t WS_YR = WS_ACT + 288 * MiB;
constexpr size_t WS_END = WS_YR + 288 * MiB;
constexpr size_t WS_SWUP = WS_TAB + 512 * 1024;
constexpr size_t WS_H1Q = WS_H1B;
constexpr size_t WS_SX = WS_H1B + 32 * MiB, WS_RSC = WS_H1B + 40 * MiB, WS_SA = WS_H1B + 44 * MiB;
constexpr size_t WS_SWDN = WS_ST0 + 512 * 1024;
constexpr size_t WS_ACTQ = WS_END;
constexpr size_t WS_END2 = WS_ACTQ + 144 * MiB;
constexpr int CW_RMAX = 16384;
constexpr int CW_BAR = 1024;
constexpr int CW_CNT = 8192;

constexpr int LDS_STAGE = 131072, LDS_SCR = 16384, LDS_CTL_OFF = LDS_STAGE + LDS_SCR, LDS_BYTES = LDS_CTL_OFF + 512;

__device__ __forceinline__ unsigned cvt_pk_bf16(float lo, float hi) { unsigned r; asm volatile("v_cvt_pk_bf16_f32 %0, %1, %2" : "=v"(r) : "v"(lo), "v"(hi)); return r; }
__device__ __forceinline__ float bf_lo(unsigned u) { return __builtin_bit_cast(float, u << 16); }
__device__ __forceinline__ float bf_hi(unsigned u) { return __builtin_bit_cast(float, u & 0xffff0000u); }
__device__ __forceinline__ v4u pack8(const f32x4 a, const f32x4 b) { v4u w; w.x = cvt_pk_bf16(a[0], a[1]); w.y = cvt_pk_bf16(a[2], a[3]); w.z = cvt_pk_bf16(b[0], b[1]); w.w = cvt_pk_bf16(b[2], b[3]); return w; }
__device__ __forceinline__ float wave_sum(float v) {
#pragma unroll
    for (int o = 1; o < 64; o <<= 1) v += __shfl_xor(v, o);
    return v;
}
__device__ __forceinline__ float fexp(float x) { return __builtin_amdgcn_exp2f(x * 1.4426950408889634f); }
__device__ __forceinline__ void cs_rev(float rev, float& c, float& s) { const float f = __builtin_amdgcn_fractf(rev); c = __builtin_amdgcn_cosf(f); s = __builtin_amdgcn_sinf(f); }

#define XB_TMO      128
#define XB_XCNT(j)  (256  + 64 * (j))
#define XB_XSUB(j)  (1280 + 64 * (j))
#define XB_XGEN(j)  (2304 + 64 * (j))
#define XB_TOP      3328
#define XB_TOPGEN   3392
#define XCD_BAR_WORDS 3456
#define XB_SPIN_CAP (1u << 18)
__device__ __forceinline__ unsigned xb_ld(unsigned* p)              { return __hip_atomic_load(p, __ATOMIC_RELAXED, __HIP_MEMORY_SCOPE_AGENT); }
__device__ __forceinline__ unsigned xb_add(unsigned* p, unsigned v) { return __hip_atomic_fetch_add(p, v, __ATOMIC_RELAXED, __HIP_MEMORY_SCOPE_AGENT); }
__device__ __forceinline__ unsigned xb_xcc_id() { return (unsigned)__builtin_amdgcn_s_getreg((3 << 11) | 20) & 0xFu; }
#define XB_SPIN(cond, bar) do { unsigned _sp = 0; while (cond) { __builtin_amdgcn_s_sleep(1); \
    if ((++_sp & 255u) == 0u) { if (xb_ld(&(bar)[XB_TMO])) break; if (_sp > XB_SPIN_CAP) { atomicAdd(&(bar)[XB_TMO], 1u); break; } } } } while (0)
struct XcdBarrier { unsigned* bar; unsigned x; volatile LAS unsigned* st; };
__device__ __forceinline__ XcdBarrier xcd_barrier_post(unsigned* bar, volatile LAS unsigned* st) {
    XcdBarrier b; b.bar = bar; b.x = xb_xcc_id(); b.st = st;
    if (threadIdx.x == 0) (void)xb_add(&bar[XB_XCNT(b.x)], 1u);
    return b;
}
__device__ __forceinline__ void xcd_barrier_complete(unsigned* bar, unsigned x, unsigned& nloc, unsigned& nx) {
    const unsigned G = gridDim.x * gridDim.y * gridDim.z;
    unsigned sum, cnt, mine, sp = 0u;
    for (;;) {
        sum = 0u; cnt = 0u; mine = 0u;
#pragma unroll
        for (unsigned j = 0; j < 16; ++j) { const unsigned c = xb_ld(&bar[XB_XCNT(j)]); sum += c; cnt += (c > 0u) ? 1u : 0u; mine = (j == x) ? c : mine; }
        if (sum == G) break;
        __builtin_amdgcn_s_sleep(1);
        if ((++sp & 255u) == 0u) { if (xb_ld(&bar[XB_TMO])) break; if (sp > XB_SPIN_CAP) { atomicAdd(&bar[XB_TMO], 1u); break; } }
    }
    nloc = mine > 0u ? mine : 1u; nx = cnt > 0u ? cnt : 1u;
}
__device__ __forceinline__ void xcd_barrier(const XcdBarrier& b) {
    asm volatile("s_waitcnt vmcnt(0)" ::: "memory");
    __syncthreads();
    if (threadIdx.x == 0) {
        unsigned* bar = b.bar;
        __builtin_amdgcn_s_waitcnt(0);
        unsigned nloc = b.st[0], nx = b.st[1];
        if (nloc == 0u) { xcd_barrier_complete(bar, b.x, nloc, nx); b.st[0] = nloc; b.st[1] = nx; }
        const unsigned old = xb_add(&bar[XB_XSUB(b.x)], 1u);
        const unsigned gen = old / nloc;
        if (old + 1u == (gen + 1u) * nloc) {
            __builtin_amdgcn_fence(__ATOMIC_RELEASE, "agent");
            asm volatile("s_waitcnt vmcnt(0)" ::: "memory");
            const unsigned og = xb_add(&bar[XB_TOP], 1u);
            const unsigned tg = og / nx;
            if (og + 1u == (tg + 1u) * nx) xb_add(&bar[XB_TOPGEN], 1u);
            else XB_SPIN(xb_ld(&bar[XB_TOPGEN]) == tg, bar);
            __builtin_amdgcn_fence(__ATOMIC_ACQUIRE, "agent");
            xb_add(&bar[XB_XGEN(b.x)], 1u);
            asm volatile("s_waitcnt vmcnt(0)" ::: "memory");
        } else {
            XB_SPIN(xb_ld(&bar[XB_XGEN(b.x)]) == gen, bar);
            __builtin_amdgcn_fence(__ATOMIC_ACQUIRE, "agent");
            asm volatile("s_waitcnt vmcnt(0)" ::: "memory");
        }
    }
    __syncthreads();
}

namespace gm {
constexpr int BM = 256, BK = 64, HALF = 128, HTB = HALF * BK * 2, STAGE_BYTES = 8 * HTB;
__device__ __forceinline__ int lds_byte(int r, int c) { const int st = (r >> 4) * 2 + (c >> 5), rr = r & 15, cc = c & 31, ob = rr * 64 + cc * 2; return st * 1024 + (ob ^ (((ob >> 9) & 1) << 5)); }
__device__ __forceinline__ void stage_rc(int b, int& R, int& C) { const int st = b / 1024, sb = b % 1024, swz = sb ^ (((sb >> 9) & 1) << 5); R = (st >> 1) * 16 + swz / 64; C = (st & 1) * 32 + (swz % 64) / 2; }
__device__ __forceinline__ int perm32(int rho) { const int n = rho >> 4, i = rho & 15; return 8 * (i >> 2) + 4 * n + (i & 3); }

struct Unit { const char* a0; const char* a1; const char* b0; const char* b1; int p0, p1, p2, p3; };

__device__ __forceinline__ void tile_order(int L, int nM, int nN, int& pm, int& pn) {
    const int nwg = nM * nN; int wgid = L;
    { const int q = nwg / 8, r = nwg % 8, xcd = wgid % 8, off = wgid / 8; wgid = (xcd < r ? xcd * (q + 1) : r * (q + 1) + (xcd - r) * q) + off; }
    const int nig = 8 * nN, gid = wgid / nig, fm = gid * 8, gsz = (nM - fm) < 8 ? (nM - fm) : 8;
    pm = fm + ((wgid % nig) % gsz); pn = (wgid % nig) / gsz;
}

template <bool I8> struct AccSel { typedef f32x4 type; };
template <> struct AccSel<true> { typedef i32x4 type; };
template <class Epi, class Sched, bool GATHER, bool I8 = false>
__device__ __forceinline__ void gemm_run(LAS unsigned char* lds, const Sched& S, const Epi& E) {
    const int tid = threadIdx.x, wid = __builtin_amdgcn_readfirstlane(tid >> 6), lane = tid & 63, wr = wid >> 2, wc = wid & 3, fr = lane & 15, fq = lane >> 4;
    int nt = S.nt; asm volatile("" : "+s"(nt));
    unsigned voffA[2], voffB[2], colA[2]; int rowA[2];
#pragma unroll
    for (int i = 0; i < 2; ++i) { int R, C; stage_rc(tid * 16 + i * 8192, R, C); const int Rb = Epi::PERM ? ((R & ~31) + perm32(R & 31)) : R;
        voffA[i] = (unsigned)(R * S.multA * S.pitchA + C) * 2u; voffB[i] = (unsigned)(Rb * S.multB * S.pitchB + C) * 2u; colA[i] = (unsigned)C * 2u; rowA[i] = R; }
    const size_t kstep = (size_t)(BK * 2);
    const unsigned ldsw = (unsigned)wid * 1024u;
    const int aoff = lds_byte(wr * 64 + fr, fq * 8), boff = lds_byte(wc * 32 + fr, fq * 8);
#define G_SA(b, h) (((b) * 2 + (h)) * HTB)
#define G_SB(b, h) ((4 + (b) * 2 + (h)) * HTB)
#define G_STAGE(bufoff, gbase, voff) do { _Pragma("unroll") for (int _i = 0; _i < 2; ++_i) \
        __builtin_amdgcn_global_load_lds((const unsigned*)((const char*)(gbase) + (voff)[_i]), (LAS unsigned*)(lds + (bufoff) + ldsw + _i * 8192), 16, 0, 0); } while (0)
#define G_LDA(dst, b, h) do { _Pragma("unroll") for (int m = 0; m < 4; ++m) _Pragma("unroll") for (int k = 0; k < 2; ++k) dst[m][k] = *(const LAS bf16x8*)(lds + G_SA(b, h) + aoff + m * 2048 + k * 1024); } while (0)
#define G_LDB(dst, b, h) do { _Pragma("unroll") for (int n = 0; n < 2; ++n) _Pragma("unroll") for (int k = 0; k < 2; ++k) dst[n][k] = *(const LAS bf16x8*)(lds + G_SB(b, h) + boff + n * 2048 + k * 1024); } while (0)
#define G_MMA(ai, bj, At, Bt) do { __builtin_amdgcn_s_setprio(1); _Pragma("unroll") for (int m = 0; m < 4; ++m) _Pragma("unroll") for (int n = 0; n < 2; ++n) _Pragma("unroll") for (int k = 0; k < 2; ++k) \
        { if constexpr (I8) acc[ai][bj][m][n] = __builtin_amdgcn_mfma_i32_16x16x64_i8(__builtin_bit_cast(i32x4, Bt[n][k]), __builtin_bit_cast(i32x4, At[m][k]), acc[ai][bj][m][n], 0, 0, 0); \
          else acc[ai][bj][m][n] = __builtin_amdgcn_mfma_f32_16x16x32_bf16(Bt[n][k], At[m][k], acc[ai][bj][m][n], 0, 0, 0); } __builtin_amdgcn_s_setprio(0); } while (0)
#define G_WAIT_V(n) asm volatile("s_waitcnt vmcnt(" #n ")" ::: "memory")
#define G_WAIT_L(n) asm volatile("s_waitcnt lgkmcnt(" #n ")" ::: "memory")
#define G_BAR __builtin_amdgcn_s_barrier()
#define G_SCHED __builtin_amdgcn_sched_barrier(0)
    Unit cur, nxt; int ui = 0;
    if (!S.next(0, cur)) return;
    typedef typename AccSel<I8>::type acc_t;
    acc_t acc[2][2][4][2];
#pragma unroll
    for (int a = 0; a < 2; ++a)
#pragma unroll
        for (int b = 0; b < 2; ++b)
#pragma unroll
            for (int m = 0; m < 4; ++m)
#pragma unroll
                for (int n = 0; n < 2; ++n) acc[a][b][m][n] = (acc_t){0, 0, 0, 0};
    bf16x8 At[4][2], B0[2][2], B1[2][2];
    unsigned gc0[2], gc1[2];
    if constexpr (GATHER) {
#pragma unroll
        for (int i = 0; i < 2; ++i) { gc0[i] = S.row_off(cur, rowA[i]) + colA[i]; gc1[i] = S.row_off(cur, 128 + rowA[i]) + colA[i]; }
    }
#define vA0 (GATHER ? gc0 : voffA)
#define vA1 (GATHER ? gc1 : voffA)
    G_STAGE(G_SB(0, 0), cur.b0, voffB); G_STAGE(G_SB(0, 1), cur.b1, voffB); G_STAGE(G_SA(0, 0), cur.a0, vA0); G_STAGE(G_SA(0, 1), cur.a1, vA1);
    if (wr == 1) G_BAR;
    G_WAIT_V(2); G_BAR;
    G_STAGE(G_SB(1, 0), cur.b0 + kstep, voffB); G_STAGE(G_SA(1, 0), cur.a0 + kstep, vA0); G_STAGE(G_SB(1, 1), cur.b1 + kstep, voffB);
    G_WAIT_V(6); G_BAR;
    for (;;) {
        const bool has_next = S.next(ui + 1, nxt);
        if (!has_next) nxt = cur;
        for (int t = 0; t < nt; t += 2) {
            const bool last = (t == nt - 2);
            unsigned tn1[2] = {0u, 0u};
            if constexpr (GATHER) { if (last) { int tz = tid; asm volatile("" : "+v"(tz));
#pragma unroll
                for (int i = 0; i < 2; ++i) { int R, C; stage_rc(tz * 16 + i * 8192, R, C); gc0[i] = S.row_off(nxt, R) + (unsigned)C * 2u; tn1[i] = S.row_off(nxt, 128 + R) + (unsigned)C * 2u; } } }
            const char* a11 = cur.a1 + (size_t)(t + 1) * kstep;
            const char* a02 = last ? nxt.a0 : cur.a0 + (size_t)(t + 2) * kstep; const char* a12 = last ? nxt.a1 : cur.a1 + (size_t)(t + 2) * kstep;
            const char* b02 = last ? nxt.b0 : cur.b0 + (size_t)(t + 2) * kstep; const char* b12 = last ? nxt.b1 : cur.b1 + (size_t)(t + 2) * kstep;
            G_LDB(B0, 0, 0); G_LDB(B1, 0, 1); G_SCHED; G_LDA(At, 0, 0); G_STAGE(G_SA(1, 1), a11, vA1);
            if constexpr (GATHER) { if (last) { gc1[0] = tn1[0]; gc1[1] = tn1[1]; } }
            G_WAIT_V(8); G_WAIT_L(0); G_BAR; G_MMA(0, 0, At, B0); G_MMA(0, 1, At, B1); G_BAR; G_SCHED;
            G_LDA(At, 0, 1); G_STAGE(G_SB(0, 0), b02, voffB); G_STAGE(G_SB(0, 1), b12, voffB); G_STAGE(G_SA(0, 0), a02, vA0);
            G_WAIT_V(8); G_WAIT_L(0); G_BAR; G_MMA(1, 0, At, B0); G_MMA(1, 1, At, B1); G_BAR; G_SCHED;
            G_LDB(B0, 1, 0); G_LDB(B1, 1, 1); G_SCHED; G_LDA(At, 1, 0); G_STAGE(G_SA(0, 1), a12, vA1);
            G_WAIT_V(8); G_WAIT_L(0); G_BAR; G_MMA(0, 0, At, B0); G_MMA(0, 1, At, B1); G_BAR; G_SCHED;
            G_LDA(At, 1, 1); G_STAGE(G_SB(1, 0), b02 + kstep, voffB); G_STAGE(G_SB(1, 1), b12 + kstep, voffB); G_STAGE(G_SA(1, 0), a02 + kstep, vA0);
            G_WAIT_V(8); G_WAIT_L(0); G_BAR; G_MMA(1, 0, At, B0); G_MMA(1, 1, At, B1); G_BAR; G_SCHED;
        }
        if (wr == 0) G_BAR;
        { int fr2 = fr, fq2 = fq; asm volatile("" : "+v"(fr2), "+v"(fq2));
          E(acc, cur, lds, wr, wc, fr2, fq2); }
        if (!has_next) break;
#pragma unroll
        for (int a = 0; a < 2; ++a)
#pragma unroll
            for (int b = 0; b < 2; ++b)
#pragma unroll
                for (int m = 0; m < 4; ++m)
#pragma unroll
                    for (int n = 0; n < 2; ++n) acc[a][b][m][n] = (acc_t){0, 0, 0, 0};
        cur = nxt; ++ui;
        if (wr == 1) G_BAR;
    }
    G_WAIT_V(0);
    G_BAR;
#undef G_SA
#undef G_SB
#undef G_STAGE
#undef G_LDA
#undef G_LDB
#undef G_MMA
#undef G_WAIT_V
#undef G_WAIT_L
#undef G_BAR
#undef G_SCHED
#undef vA0
#undef vA1
}
}
using gm::Unit;
typedef f32x4 Acc[2][2][4][2];
typedef i32x4 AccI[2][2][4][2];

struct Args { const float* in[18]; float* out; unsigned char* ws; int ph_lo, ph_hi; };
struct Frame {
    LAS unsigned char* lds; unsigned char* ws; unsigned* ctl;
    int tid, lane, wave, vcu, G;
    const float *x, *ln0_g, *ln0_b, *w_in, *dec_f, *dec_b, *gn_g, *w_out, *ln1_g, *ln1_b, *w_r, *b_r, *w_up, *b_up, *w_dn, *b_dn, *ln2_g, *ln2_b;
    float* out;
};
#define WSP(T_, off) ((T_*)(F.ws + (off)))

template <class ColMap>
__device__ __forceinline__ void transpose_item(const float* W, int K, int N, bf16* WT, LAS float* scr, int item, int lane, const ColMap& cm) {
    const int nblk = N / 64, kb = item / nblk, nb = item % nblk, k0 = 64 * kb, n0 = 64 * nb;
    const int s0 = cm(n0);
#pragma unroll 4
    for (int i = 0; i < 16; ++i) { const int kk = 4 * i + (lane >> 4), c4 = (lane & 15) * 4;
        const f32x4 v = *(const GAS f32x4*)(W + (size_t)(k0 + kk) * N + s0 + c4);
        LAS float* d = scr + kk * 65 + c4; d[0] = v[0]; d[1] = v[1]; d[2] = v[2]; d[3] = v[3]; }
    LDS_WAIT(); asm volatile("" ::: "memory");
    const int c = lane & 7;
#pragma unroll
    for (int j = 0; j < 8; ++j) { const int n = (lane >> 3) + 8 * j; const LAS float* s = scr + (8 * c) * 65 + n;
        v4u o; o.x = cvt_pk_bf16(s[0 * 65], s[1 * 65]); o.y = cvt_pk_bf16(s[2 * 65], s[3 * 65]); o.z = cvt_pk_bf16(s[4 * 65], s[5 * 65]); o.w = cvt_pk_bf16(s[6 * 65], s[7 * 65]);
        *(GAS v4u*)(WT + (size_t)(n0 + n) * K + k0 + 8 * c) = o; }
    LDS_WAIT(); asm volatile("" ::: "memory");
}
struct ColId { __device__ __forceinline__ int operator()(int n) const { return n; } };
struct ColUp { __device__ __forceinline__ int operator()(int n) const { return ((n >> 8) * 128 + (n & 127)) + ((n >> 7) & 1) * 2048; } };

__device__ __forceinline__ void p0_prologue(Frame& F) {
    const int gw = F.vcu * NWAVES + F.wave, NGW = F.G * NWAVES;
    {
        bf16* h0b = WSP(bf16, WS_H0B); float* st0 = WSP(float, WS_ST0);
        for (int m = gw; m < T; m += NGW) {
            const GAS f32x4* xr = (const GAS f32x4*)(F.x + (size_t)m * D) + F.lane;
            f32x4 v[8]; float s = 0.f;
#pragma unroll
            for (int j = 0; j < 8; ++j) { v[j] = xr[64 * j]; s += (v[j][0] + v[j][1]) + (v[j][2] + v[j][3]); }
            const float mean = wave_sum(s) * (1.f / D); float s2 = 0.f;
#pragma unroll
            for (int j = 0; j < 8; ++j) { v[j] = v[j] - mean; s2 += (v[j][0] * v[j][0] + v[j][1] * v[j][1]) + (v[j][2] * v[j][2] + v[j][3] * v[j][3]); }
            const float rstd = 1.f / sqrtf(wave_sum(s2) * (1.f / D) + LN_EPS);
            GAS v2u* o8 = (GAS v2u*)(h0b + (size_t)m * D) + F.lane;
#pragma unroll
            for (int j = 0; j < 8; ++j) { const f32x4 g = *((const GAS f32x4*)F.ln0_g + F.lane + 64 * j), b = *((const GAS f32x4*)F.ln0_b + F.lane + 64 * j);
                const f32x4 h = v[j] * rstd * g + b; v2u w; w.x = cvt_pk_bf16(h[0], h[1]); w.y = cvt_pk_bf16(h[2], h[3]); o8[64 * j] = w; }
            if (F.lane == 0) { st0[2 * m] = mean; st0[2 * m + 1] = rstd; }
        }
    }
    {
        bf16* tab = WSP(bf16, WS_TAB);
        for (int i = (F.vcu * NTHR + F.tid); i < 32768 + 65536 + 65536; i += F.G * NTHR) {
            float v;
            if (i < 32768) { const int r = i >> 7, a = i & 127, ri = r >> 7, k1 = r & 127; float c, s; cs_rev((float)((k1 * a) & 127) * (1.f / 128.f), c, s); v = ri ? -s : c; }
            else if (i < 32768 + 65536) { const int e = i - 32768, r = e >> 8, q = e & 255, ri = r >> 7, k2 = r & 127, rj = q >> 7, b = q & 127; float c, s; cs_rev((float)((k2 * b) & 127) * (1.f / 128.f), c, s);
                v = (ri == 0) ? (rj == 0 ? c : s) : (rj == 0 ? -s : c); }
            else { const int e = i - 32768 - 65536, l = e >> 8, q = e & 255, rj = q >> 7, cg = q & 127; float c, s; cs_rev((float)((l * cg) & 127) * (1.f / 128.f), c, s); v = (l < 128) ? (rj == 0 ? c : s) : 0.f; }
            tab[i] = (bf16)(cvt_pk_bf16(v, 0.f) & 0xffffu);
        }
    }
    {
        LAS float* scr = (LAS float*)(F.lds + F.wave * 18432);
        constexpr int I_IN = 32 * (DIN / 64), I_OUT = 32 * (D / 64), I_UP = 32 * (2 * DFF / 64), I_DN = 32 * (D / 64);
        constexpr int NIT = I_IN + I_OUT;
        for (int it = gw; it < NIT; it += NGW) {
            int r = it;
            if (r < I_IN) { transpose_item(F.w_in, D, DIN, WSP(bf16, WS_WIN), scr, r, F.lane, ColId()); continue; } r -= I_IN;
            { transpose_item(F.w_out, D, D, WSP(bf16, WS_WOUT), scr, r, F.lane, ColId()); }
        }
    }
}

template <class ColMap>
__device__ __forceinline__ void p0_quant(Frame& F, const float* Wsrc, int NS  , signed char* WQ, float* sw, const ColMap& cm) {
    constexpr int PITCH = 2056;
    LAS bf16* slab = (LAS bf16*)F.lds;
    LAS float* red = (LAS float*)(F.lds + 32 * PITCH * 2);
    const int spe = NS / 32;
    for (int sl = F.vcu; sl < NE * spe; sl += F.G) {
        const int e = sl / spe, n0 = (sl % spe) * 32, s0 = cm(n0);
        const float* W = Wsrc + (size_t)e * D * NS + s0;
        const int kq = F.lane >> 3, c4 = (F.lane & 7) * 4;
        f32x4 mx = (f32x4){0.f, 0.f, 0.f, 0.f};
#pragma unroll 8
        for (int i = 0; i < 32; ++i) { const int k = F.wave * 256 + i * 8 + kq; const f32x4 v = *(const GAS f32x4*)(W + (size_t)k * NS + c4);
            mx[0] = fmaxf(mx[0], fabsf(v[0])); mx[1] = fmaxf(mx[1], fabsf(v[1])); mx[2] = fmaxf(mx[2], fabsf(v[2])); mx[3] = fmaxf(mx[3], fabsf(v[3]));
            const unsigned p01 = cvt_pk_bf16(v[0], v[1]), p23 = cvt_pk_bf16(v[2], v[3]);
            slab[(c4 + 0) * PITCH + k] = (bf16)(p01 & 0xffffu); slab[(c4 + 1) * PITCH + k] = (bf16)(p01 >> 16); slab[(c4 + 2) * PITCH + k] = (bf16)(p23 & 0xffffu); slab[(c4 + 3) * PITCH + k] = (bf16)(p23 >> 16); }
#pragma unroll
        for (int j = 0; j < 4; ++j) { float m = mx[j]; m = fmaxf(m, __shfl_xor(m, 8)); m = fmaxf(m, __shfl_xor(m, 16)); m = fmaxf(m, __shfl_xor(m, 32)); mx[j] = m; }
        if (F.lane < 8) { LAS float* d = red + F.wave * 32 + c4; d[0] = mx[0]; d[1] = mx[1]; d[2] = mx[2]; d[3] = mx[3]; }
        __syncthreads();
        if (F.tid < 32) { float m = 0.f;
#pragma unroll
            for (int w = 0; w < 8; ++w) m = fmaxf(m, red[w * 32 + F.tid]);
            const float sc = m > 0.f ? m * (1.f / 127.f) : 1.f; sw[(size_t)e * NS + n0 + F.tid] = sc; red[256 + F.tid] = 1.f / sc; }
        __syncthreads();
#pragma unroll 2
        for (int i = 0; i < 8; ++i) { const int q = F.tid + NTHR * i, n = q >> 7, kc = q & 127; const float inv = red[256 + n];
            const v4u a = *(const LAS v4u*)(slab + n * PITCH + kc * 16), b = *(const LAS v4u*)(slab + n * PITCH + kc * 16 + 8);
            const unsigned src[8] = {a.x, a.y, a.z, a.w, b.x, b.y, b.z, b.w}; unsigned o[4];
#pragma unroll
            for (int d = 0; d < 4; ++d) { unsigned w = 0u;
#pragma unroll
                for (int h2 = 0; h2 < 2; ++h2) { const unsigned u2 = src[2 * d + h2]; const int q0 = (int)__builtin_rintf(bf_lo(u2) * inv), q1 = (int)__builtin_rintf(bf_hi(u2) * inv);
                    w |= ((unsigned)(q0 & 0xff) << (16 * h2)) | ((unsigned)(q1 & 0xff) << (16 * h2 + 8)); }
                o[d] = w; }
            *(GAS v4u*)(WQ + ((size_t)e * NS + n0 + n) * D + kc * 16) = (v4u){o[0], o[1], o[2], o[3]}; }
        __syncthreads();
    }
}

struct SchedBase { int nt, pitchA, pitchB, multA, multB, G, c; };
struct SchedG1N : SchedBase {
    const char* A; const char* Bt;
    __device__ __forceinline__ bool next(int i, Unit& u) const { const int L = i * G + c; if (L >= 64 * 12) return false; int pm, pn; gm::tile_order(L, 64, 12, pm, pn);
        const int cb = pn < 4 ? 1024 + 256 * pn : (pn < 8 ? 2048 + 256 * (pn - 4) : 4096 + 256 * (pn - 8));
        u.a0 = A + (size_t)pm * 256 * D * 2; u.a1 = u.a0 + (size_t)128 * D * 2; u.b0 = Bt + (size_t)cb * D * 2; u.b1 = u.b0 + (size_t)128 * D * 2; u.p0 = pm; u.p1 = pn; u.p2 = 0; u.p3 = 0; return true; }
};
struct SchedG1SF : SchedBase {
    const char* A; const char* Bt;
    __device__ __forceinline__ bool next(int i, Unit& u) const { const int L = i * G + c; if (L >= 4 * 64) return false; int pm, pn; gm::tile_order(L, 4, 64, pm, pn);
        u.a0 = A + (size_t)pm * 256 * D * 2; u.a1 = u.a0 + (size_t)128 * D * 2; u.b0 = Bt + (size_t)(2 * pn) * D * 2; u.b1 = u.b0 + (size_t)D * 2; u.p0 = pm; u.p1 = pn; u.p2 = 0; u.p3 = 0; return true; }
};
struct SchedG1SKV : SchedBase {
    const char* A; const char* Bt;
    __device__ __forceinline__ bool next(int i, Unit& u) const { const int L = i * G + c; if (L >= 8 * 64) return false; int pm, pn; gm::tile_order(L, 8, 64, pm, pn);
        const int rb = pm < 4 ? 2048 + 256 * pm : 3072 + 256 * (pm - 4);
        u.a0 = A + (size_t)rb * D * 2; u.a1 = u.a0 + (size_t)128 * D * 2; u.b0 = Bt + (size_t)pn * 256 * D * 2; u.b1 = u.b0 + (size_t)128 * D * 2; u.p0 = pm; u.p1 = pn; u.p2 = 0; u.p3 = 0; return true; }
};
struct SchedFixA : SchedBase {
    const char* A; const char* Bt; int ncol;
    __device__ __forceinline__ bool next(int i, Unit& u) const { const int L = i * G + c; if (L >= ncol) return false;
        u.a0 = A; u.a1 = A + (size_t)128 * pitchA * 2; u.b0 = Bt + (size_t)L * 256 * pitchB * 2; u.b1 = u.b0 + (size_t)128 * pitchB * 2; u.p0 = 0; u.p1 = L; u.p2 = 0; u.p3 = 0; return true; }
};
struct SchedFixB : SchedBase {
    const char* A; const char* Bt; int nrow;
    __device__ __forceinline__ bool next(int i, Unit& u) const { const int L = i * G + c; if (L >= nrow) return false;
        u.a0 = A + (size_t)L * 256 * pitchA * 2; u.a1 = u.a0 + (size_t)128 * pitchA * 2; u.b0 = Bt; u.b1 = Bt + (size_t)128 * pitchB * 2; u.p0 = L; u.p1 = 0; u.p2 = 0; u.p3 = 0; return true; }
};
struct SchedScores : SchedBase {
    const char* Q; const char* Kk;
    __device__ __forceinline__ bool next(int i, Unit& u) const { const int L = i * G + c; if (L >= NH * NCH) return false; const int h = L & 3, n = L >> 2;
        u.a0 = Q + ((size_t)n * 256 * RW + h * HD) * 2; u.a1 = u.a0 + (size_t)128 * RW * 2; u.b0 = Kk + ((size_t)n * 256 * RW + h * HD) * 2; u.b1 = u.b0 + (size_t)128 * RW * 2; u.p0 = h; u.p1 = n; u.p2 = 0; u.p3 = 0; return true; }
};
struct SchedKV : SchedBase {
    const char* Bcat; const char* kTw;
    __device__ __forceinline__ bool next(int i, Unit& u) const { const int L = i * G + c; if (L >= 2 * NH * NCH) return false; const int dh = L & 7, n = L >> 3, dir = dh >> 2, h = dh & 3;
        u.a0 = Bcat + ((size_t)(h * NCH + n) * 256 * CAT) * 2; u.a1 = u.a0 + (size_t)128 * CAT * 2;
        u.b0 = kTw + (((size_t)dir * RW + h * HD) * T + (size_t)n * 256) * 2; u.b1 = u.b0 + (size_t)128 * T * 2; u.p0 = dh; u.p1 = n; u.p2 = 0; u.p3 = 0; return true; }
};
struct SchedOut : SchedBase {
    const char* Acat; const char* Bcat;
    __device__ __forceinline__ bool next(int i, Unit& u) const { const int L = i * G + c; if (L >= NH * NCH) return false; const int h = L & 3, n = L >> 2;
        u.a0 = Acat + ((size_t)h * T + (size_t)n * 256) * CAT * 2; u.a1 = u.a0 + (size_t)128 * CAT * 2; u.b0 = Bcat + ((size_t)(h * NCH + n) * 256 * CAT) * 2; u.b1 = u.b0 + (size_t)128 * CAT * 2; u.p0 = h; u.p1 = n; u.p2 = 0; u.p3 = 0; return true; }
};
struct Sched2D : SchedBase {
    const char* A; const char* Bt; int nM, nN;
    __device__ __forceinline__ bool next(int i, Unit& u) const { const int L = i * G + c; if (L >= nM * nN) return false; int pm, pn; gm::tile_order(L, nM, nN, pm, pn);
        u.a0 = A + (size_t)pm * 256 * pitchA * 2; u.a1 = u.a0 + (size_t)128 * pitchA * 2; u.b0 = Bt + (size_t)pn * 256 * pitchB * 2; u.b1 = u.b0 + (size_t)128 * pitchB * 2; u.p0 = pm; u.p1 = pn; u.p2 = 0; u.p3 = 0; return true; }
};
struct SchedMoE : SchedBase {
    const char* A; const char* Bt; const LAS int* tstart; const int* row_tok; const unsigned* cnt; int nN, rowbytes; size_t estride;
    __device__ __forceinline__ bool next(int i, Unit& u) const { const int RT = __builtin_amdgcn_readfirstlane(tstart[NE]); const int L = i * G + c; if (L >= RT * nN) return false; int rt, pn; gm::tile_order(L, RT, nN, rt, pn);
        int e = 0;
        for (int j = 1; j < NE; ++j) e += (__builtin_amdgcn_readfirstlane(tstart[j]) <= rt) ? 1 : 0;
        u.b0 = Bt + (size_t)e * estride + (size_t)pn * 256 * rowbytes; u.b1 = u.b0 + (size_t)128 * rowbytes;
        u.a0 = A; u.a1 = A;
        u.p0 = rt; u.p1 = pn; u.p2 = e; u.p3 = (rt - __builtin_amdgcn_readfirstlane(tstart[e])) * 256; return true; }
    __device__ __forceinline__ unsigned row_off(const Unit& u, int r) const { const int n = (int)cnt[64 * u.p2]; int pos = u.p3 + r; pos = pos < n ? pos : n - 1;
        const int tok = row_tok[(size_t)u.p2 * T + pos]; return (unsigned)tok * (unsigned)rowbytes; }
};
struct SchedMoEDown : SchedMoE {
    __device__ __forceinline__ bool next(int i, Unit& u) const { if (!SchedMoE::next(i, u)) return false; u.a0 = A + (size_t)u.p0 * 256 * rowbytes; u.a1 = u.a0 + (size_t)128 * rowbytes; return true; }
};

#define EPI_LOOP_AM for (int ai = 0; ai < 2; ++ai) _Pragma("unroll") for (int m = 0; m < 4; ++m)
#define EPI_FENCE __builtin_amdgcn_sched_barrier(0)
struct EpiG1N {
    static constexpr bool PERM = true;
    bf16 *qs, *kk, *gs, *Acat; const float *dec_f, *dec_b;
    __device__ __forceinline__ void operator()(Acc& acc, const Unit& u, LAS unsigned char*, int wr, int wc, int fr, int fq) const {
        const int pm = u.p0, pn = u.p1, c0 = wc * 32 + 8 * fq;
        if (pn < 8) {
            const int h = pn & 3; const bool isq = pn < 4;
            float inv[8];
#pragma unroll
            for (int e = 0; e < 8; ++e) inv[e] = __builtin_amdgcn_exp2f(-(float)(c0 + e) * (13.287712379549449f / 128.f)) * 0.15915494309189535f;
            const float lgf = -fexp(dec_f[h]), lgb = -fexp(dec_b[h]);
#pragma unroll
            EPI_LOOP_AM {
                const int r = 128 * ai + 64 * wr + 16 * m + fr, tok = pm * 256 + r; const float pos = (float)tok;
                f32x4 o1[2], o2[2];
#pragma unroll
                for (int n = 0; n < 2; ++n)
#pragma unroll
                    for (int j = 0; j < 4; ++j) { float c, s; cs_rev(pos * inv[4 * n + j], c, s); const float x1 = acc[ai][0][m][n][j], x2 = acc[ai][1][m][n][j]; o1[n][j] = x1 * c - x2 * s; o2[n][j] = x2 * c + x1 * s; }
                if (isq) {
                    bf16* q = qs + (size_t)tok * RW + h * HD + c0; *(GAS v4u*)q = pack8(o1[0], o1[1]); *(GAS v4u*)(q + 128) = pack8(o2[0], o2[1]);
                    const int il = r; const float wf = fexp(lgf * (float)(il + 1)), wb = fexp(lgb * (float)(255 - il));
                    bf16* a = Acat + ((size_t)h * T + tok) * CAT + c0;
                    *(GAS v4u*)(a + 256) = pack8(o1[0] * wf, o1[1] * wf); *(GAS v4u*)(a + 384) = pack8(o2[0] * wf, o2[1] * wf);
                    *(GAS v4u*)(a + 512) = pack8(o1[0] * wb, o1[1] * wb); *(GAS v4u*)(a + 640) = pack8(o2[0] * wb, o2[1] * wb);
                } else {
                    bf16* k = kk + (size_t)tok * RW + h * HD + c0; *(GAS v4u*)k = pack8(o1[0] * 0.0625f, o1[1] * 0.0625f); *(GAS v4u*)(k + 128) = pack8(o2[0] * 0.0625f, o2[1] * 0.0625f);
                }
            }
        } else {
#pragma unroll
            EPI_LOOP_AM {
                const int r = 128 * ai + 64 * wr + 16 * m + fr, tok = pm * 256 + r;
#pragma unroll
                for (int bj = 0; bj < 2; ++bj) { f32x4 v[2];
#pragma unroll
                    for (int n = 0; n < 2; ++n)
#pragma unroll
                        for (int j = 0; j < 4; ++j) { const float g = acc[ai][bj][m][n][j]; v[n][j] = g * __builtin_amdgcn_rcpf(1.f + fexp(-g)); }
                    *(GAS v4u*)(gs + (size_t)tok * RW + (pn - 8) * 256 + bj * 128 + c0) = pack8(v[0], v[1]); }
            }
        }
    }
};
struct EpiG1SF {
    static constexpr bool PERM = true;
    bf16* uTT;
    __device__ __forceinline__ void operator()(Acc& acc, const Unit& u, LAS unsigned char*, int wr, int wc, int fr, int fq) const {
        const int a0 = wc * 32 + 8 * fq;
#pragma unroll
        EPI_LOOP_AM { const int cch = u.p0 * 256 + 128 * ai + 64 * wr + 16 * m + fr;
#pragma unroll
            for (int bj = 0; bj < 2; ++bj) *(GAS v4u*)(uTT + ((size_t)cch * 128 + (2 * u.p1 + bj)) * 128 + a0) = pack8(acc[ai][bj][m][0], acc[ai][bj][m][1]); }
    }
};
struct EpiG1SKV {
    static constexpr bool PERM = true;
    bf16 *kTw, *Bcat; const float *dec_f, *dec_b;
    __device__ __forceinline__ void operator()(Acc& acc, const Unit& u, LAS unsigned char*, int wr, int wc, int fr, int fq) const {
        const int pm = u.p0, n_ch = u.p1, c0 = wc * 32 + 8 * fq;
        if (pm < 4) {
            const int h = pm; const float lgf = -fexp(dec_f[h]), lgb = -fexp(dec_b[h]);
#pragma unroll
            for (int m = 0; m < 4; ++m) {
                const int d = 64 * wr + 16 * m + fr;
                const float inv = __builtin_amdgcn_exp2f(-(float)d * (13.287712379549449f / 128.f)) * 0.15915494309189535f;
#pragma unroll
                for (int bj = 0; bj < 2; ++bj) {
                    f32x4 f1[2], f2[2], b1[2], b2[2];
#pragma unroll
                    for (int n = 0; n < 2; ++n)
#pragma unroll
                        for (int j = 0; j < 4; ++j) { const int il = 128 * bj + c0 + 4 * n + j; const float pos = (float)(n_ch * 256 + il); float c, s; cs_rev(pos * inv, c, s);
                            const float x1 = acc[0][bj][m][n][j], x2 = acc[1][bj][m][n][j]; const float o1 = (x1 * c - x2 * s) * 0.0625f, o2 = (x2 * c + x1 * s) * 0.0625f;
                            const float wf = fexp(lgf * (float)(255 - il)), wb = fexp(lgb * (float)(il + 1));
                            f1[n][j] = o1 * wf; f2[n][j] = o2 * wf; b1[n][j] = o1 * wb; b2[n][j] = o2 * wb; }
                    const size_t tcol = (size_t)n_ch * 256 + 128 * bj + c0;
                    bf16* pf = kTw + ((size_t)(h * HD + d)) * T + tcol; bf16* pb = pf + (size_t)RW * T;
                    *(GAS v4u*)pf = pack8(f1[0], f1[1]); *(GAS v4u*)(pf + (size_t)128 * T) = pack8(f2[0], f2[1]);
                    *(GAS v4u*)pb = pack8(b1[0], b1[1]); *(GAS v4u*)(pb + (size_t)128 * T) = pack8(b2[0], b2[1]);
                }
            }
        } else {
            const int h = pm - 4;
#pragma unroll
            EPI_LOOP_AM { const int dv = 128 * ai + 64 * wr + 16 * m + fr;
#pragma unroll
                for (int bj = 0; bj < 2; ++bj) *(GAS v4u*)(Bcat + ((size_t)(h * NCH + n_ch) * 256 + dv) * CAT + 128 * bj + c0) = pack8(acc[ai][bj][m][0], acc[ai][bj][m][1]); }
        }
    }
};
struct EpiS1 {
    static constexpr bool PERM = true;
    bf16* A1;
    __device__ __forceinline__ void operator()(Acc& acc, const Unit& u, LAS unsigned char*, int wr, int wc, int fr, int fq) const {
        const int b0 = wc * 32 + 8 * fq;
#pragma unroll
        for (int m = 0; m < 4; ++m) { const int k1 = 64 * wr + 16 * m + fr;
#pragma unroll
            for (int bj = 0; bj < 2; ++bj) { const int cch = 2 * u.p1 + bj; f32x4 re[2], im[2];
#pragma unroll
                for (int n = 0; n < 2; ++n)
#pragma unroll
                    for (int j = 0; j < 4; ++j) { const int b = b0 + 4 * n + j; float c, s; cs_rev((float)(k1 * b) * (1.f / 16384.f), c, s);
                        const float xr = acc[0][bj][m][n][j], xi = acc[1][bj][m][n][j]; re[n][j] = xr * c + xi * s; im[n][j] = xi * c - xr * s; }
                bf16* p = A1 + (((size_t)k1 * 1024 + cch) * 2) * 128 + b0;
                *(GAS v4u*)p = pack8(re[0], re[1]); *(GAS v4u*)(p + 128) = pack8(im[0], im[1]); EPI_FENCE; } }
    }
};
struct EpiS2 {
    static constexpr bool PERM = true;
    bf16* Zt;
    __device__ __forceinline__ void operator()(Acc& acc, const Unit& u, LAS unsigned char*, int wr, int wc, int fr, int fq) const {
        const int k1 = u.p1 >> 2, cb = (u.p1 & 3) * 256, c0 = wc * 32 + 8 * fq;
#pragma unroll
        EPI_LOOP_AM { const int k2 = 64 * wr + 16 * m + fr, k = k1 + 128 * k2;
#pragma unroll
            for (int bj = 0; bj < 2; ++bj) { const int cch = cb + 128 * bj + c0, g = cch >> 7, cg = cch & 127;
                *(GAS v4u*)(Zt + (size_t)k * 2048 + g * 256 + ai * 128 + cg) = pack8(acc[ai][bj][m][0], acc[ai][bj][m][1]); } }
    }
};
struct EpiChan {
    static constexpr bool PERM = true;
    bf16* y;
    __device__ __forceinline__ void operator()(Acc& acc, const Unit& u, LAS unsigned char*, int wr, int wc, int fr, int fq) const {
        const int l0 = wc * 32 + 8 * fq; const float norm = 6.9053396600248786e-4f;
#pragma unroll
        EPI_LOOP_AM { const int R = u.p0 * 256 + 128 * ai + 64 * wr + 16 * m + fr, k = R >> 3, g = R & 7;
            *(GAS v4u*)(y + (size_t)k * D + g * 128 + l0) = pack8(acc[ai][0][m][0] * norm, acc[ai][0][m][1] * norm); }
    }
};
struct EpiScores {
    static constexpr bool PERM = true;
    bf16* Acat; const float *dec_f, *dec_b;
    __device__ __forceinline__ void operator()(Acc& acc, const Unit& u, LAS unsigned char*, int wr, int wc, int fr, int fq) const {
        const int h = u.p0, n_ch = u.p1, c0 = wc * 32 + 8 * fq; const float lgf = -fexp(dec_f[h]), lgb = -fexp(dec_b[h]);
#pragma unroll
        EPI_LOOP_AM { const int i = 128 * ai + 64 * wr + 16 * m + fr;
#pragma unroll
            for (int bj = 0; bj < 2; ++bj) { f32x4 v[2];
#pragma unroll
                for (int n = 0; n < 2; ++n)
#pragma unroll
                    for (int j = 0; j < 4; ++j) { const int jc = 128 * bj + c0 + 4 * n + j; const float dd = (float)(i - jc); const float w = (jc <= i) ? fexp(lgf * dd) : fexp(-lgb * dd); v[n][j] = acc[ai][bj][m][n][j] * w; }
                *(GAS v4u*)(Acat + ((size_t)h * T + n_ch * 256 + i) * CAT + 128 * bj + c0) = pack8(v[0], v[1]); EPI_FENCE; } }
    }
};
struct EpiKV {
    static constexpr bool PERM = false;
    float* kvT;
    __device__ __forceinline__ void operator()(Acc& acc, const Unit& u, LAS unsigned char*, int wr, int wc, int fr, int fq) const {
#pragma unroll
        EPI_LOOP_AM { const int dv = 128 * ai + 64 * wr + 16 * m + fr; float* rowp = kvT + (((size_t)u.p0 * NCH + u.p1) * 256 + dv) * 256 + wc * 32 + 4 * fq;
#pragma unroll
            for (int bj = 0; bj < 2; ++bj)
#pragma unroll
                for (int n = 0; n < 2; ++n) *(GAS f32x4*)(rowp + bj * 128 + n * 16) = acc[ai][bj][m][n]; }
    }
};
struct EpiOut {
    static constexpr bool PERM = true;
    bf16* y; const bf16* gs; const float* gn_g;
    __device__ __forceinline__ void operator()(Acc& acc, const Unit& u, LAS unsigned char* lds, int wr, int wc, int fr, int fq) const {
        const int h = u.p0, n_ch = u.p1, c0 = wc * 32 + 8 * fq;
        LAS f32x2* P = (LAS f32x2*)(lds + LDS_STAGE);
#pragma unroll
        EPI_LOOP_AM {
            float s = 0.f;
#pragma unroll
            for (int bj = 0; bj < 2; ++bj)
#pragma unroll
                for (int n = 0; n < 2; ++n) { const f32x4 x = acc[ai][bj][m][n]; s += (x[0] + x[1]) + (x[2] + x[3]); }
            s += __shfl_xor(s, 16); s += __shfl_xor(s, 32);
            const float mw = s * (1.f / 64.f); float q = 0.f;
#pragma unroll
            for (int bj = 0; bj < 2; ++bj)
#pragma unroll
                for (int n = 0; n < 2; ++n) { const f32x4 d = acc[ai][bj][m][n] - mw; q += (d[0] * d[0] + d[1] * d[1]) + (d[2] * d[2] + d[3] * d[3]); }
            q += __shfl_xor(q, 16); q += __shfl_xor(q, 32);
            if (fq == 0) P[(128 * ai + 64 * wr + 16 * m + fr) * 4 + wc] = (f32x2){mw, q};
        }
        LDS_WAIT(); __builtin_amdgcn_s_barrier(); asm volatile("" ::: "memory");
#pragma unroll
        EPI_LOOP_AM {
            const int r = 128 * ai + 64 * wr + 16 * m + fr, tok = n_ch * 256 + r;
            const f32x2 a = P[r * 4 + 0], b = P[r * 4 + 1], c = P[r * 4 + 2], d = P[r * 4 + 3];
            const float mt = (a.x + b.x + c.x + d.x) * 0.25f; const float da = a.x - mt, db = b.x - mt, dc = c.x - mt, dd = d.x - mt;
            const float m2 = (a.y + b.y) + (c.y + d.y) + 64.f * ((da * da + db * db) + (dc * dc + dd * dd));
            const float rstd = 1.f / sqrtf(m2 * (1.f / 256.f) + GN_EPS);
#pragma unroll
            for (int bj = 0; bj < 2; ++bj) {
                const int col = h * HD + 128 * bj + c0; const v4u gv = *(const GAS v4u*)(gs + (size_t)tok * RW + col);
                const f32x4 g0 = *(const GAS f32x4*)(gn_g + col), g1 = *(const GAS f32x4*)(gn_g + col + 4);
                f32x4 o0 = (acc[ai][bj][m][0] - mt) * rstd * g0, o1 = (acc[ai][bj][m][1] - mt) * rstd * g1;
                o0[0] *= bf_lo(gv.x); o0[1] *= bf_hi(gv.x); o0[2] *= bf_lo(gv.y); o0[3] *= bf_hi(gv.y); o1[0] *= bf_lo(gv.z); o1[1] *= bf_hi(gv.z); o1[2] *= bf_lo(gv.w); o1[3] *= bf_hi(gv.w);
                *(GAS v4u*)(y + (size_t)tok * D + FW + col) = pack8(o0, o1); }
        }
        LDS_WAIT(); __builtin_amdgcn_s_barrier(); asm volatile("" ::: "memory");
    }
};
struct EpiWout {
    static constexpr bool PERM = false;
    float* z1; const float *x, *st0, *g0, *b0;
    __device__ __forceinline__ void operator()(Acc& acc, const Unit& u, LAS unsigned char*, int wr, int wc, int fr, int fq) const {
        const int colb = u.p1 * 256 + wc * 32 + 4 * fq;
#pragma unroll
        EPI_LOOP_AM { const int row = u.p0 * 256 + 128 * ai + 64 * wr + 16 * m + fr; const f32x2 st = *(const GAS f32x2*)(st0 + 2 * row);
#pragma unroll
            for (int bj = 0; bj < 2; ++bj)
#pragma unroll
                for (int n = 0; n < 2; ++n) { const int col = colb + bj * 128 + n * 16; const size_t off = (size_t)row * D + col;
                    const f32x4 xv = *(const GAS f32x4*)(x + off), g = *(const GAS f32x4*)(g0 + col), b = *(const GAS f32x4*)(b0 + col);
                    *(GAS f32x4*)(z1 + off) = ((xv - st.x) * st.y * g + b) * ALPHA + acc[ai][bj][m][n]; } }
    }
};
struct EpiUp {
    static constexpr bool PERM = true;
    bf16* act; const float *b_up, *swup, *rsc; const unsigned* cnt; unsigned* rmax;
    __device__ __forceinline__ void operator()(AccI& acc, const Unit& u, LAS unsigned char*, int wr, int wc, int fr, int fq) const {
        const int rt = u.p0, pn = u.p1, e = u.p2, c0 = pn * 128 + wc * 32 + 8 * fq; const int ne = (int)cnt[64 * e];
        float sx[2][4], rm[2][4];
#pragma unroll
        for (int a2 = 0; a2 < 2; ++a2)
#pragma unroll
            for (int m2 = 0; m2 < 4; ++m2) rm[a2][m2] = 0.f;
#pragma unroll
        EPI_LOOP_AM { int pos = u.p3 + 128 * ai + 64 * wr + 16 * m + fr; pos = pos < ne ? pos : ne - 1; sx[ai][m] = rsc[(size_t)e * T + pos]; }
#pragma unroll
        for (int n = 0; n < 2; ++n) {
            const float* bu = b_up + (size_t)e * 2 * DFF + c0 + 4 * n; const float* sw = swup + (size_t)e * 2 * DFF + pn * 256 + wc * 32 + 8 * fq + 4 * n;
            const f32x4 bg = *(const GAS f32x4*)bu, bl = *(const GAS f32x4*)(bu + DFF), sg = *(const GAS f32x4*)sw, sl = *(const GAS f32x4*)(sw + 128);
#pragma unroll
            EPI_LOOP_AM { const int r = 128 * ai + 64 * wr + 16 * m + fr; f32x4 v;
#pragma unroll
                for (int j = 0; j < 4; ++j) { float gl = (float)acc[ai][0][m][n][j] * (sx[ai][m] * sg[j]) + bg[j], li = (float)acc[ai][1][m][n][j] * (sx[ai][m] * sl[j]) + bl[j];
                    gl = fminf(gl, 7.f); li = fminf(fmaxf(li, -7.f), 7.f); v[j] = gl * __builtin_amdgcn_rcpf(1.f + fexp(-1.702f * gl)) * (li + 1.f); }
                rm[ai][m] = fmaxf(rm[ai][m], fmaxf(fmaxf(fabsf(v[0]), fabsf(v[1])), fmaxf(fabsf(v[2]), fabsf(v[3]))));
                v2u w; w.x = cvt_pk_bf16(v[0], v[1]); w.y = cvt_pk_bf16(v[2], v[3]);
                *(GAS v2u*)(act + ((size_t)rt * 256 + r) * DFF + c0 + 4 * n) = w; }
        }
#pragma unroll
        EPI_LOOP_AM { float q = rm[ai][m]; q = fmaxf(q, __shfl_xor(q, 16)); q = fmaxf(q, __shfl_xor(q, 32));
            if (fq == 0) __hip_atomic_fetch_max(rmax + rt * 256 + 128 * ai + 64 * wr + 16 * m + fr, __float_as_uint(q), RLX_AGENT); }
    }
};
struct EpiDown {
    static constexpr bool PERM = true;
    bf16* yr; const float *b_dn, *swdn, *sa;
    __device__ __forceinline__ void operator()(AccI& acc, const Unit& u, LAS unsigned char*, int wr, int wc, int fr, int fq) const {
        const int rt = u.p0, pn = u.p1, e = u.p2, c0 = pn * 256 + wc * 32 + 8 * fq;
        float sr[2][4];
#pragma unroll
        EPI_LOOP_AM sr[ai][m] = sa[rt * 256 + 128 * ai + 64 * wr + 16 * m + fr];
#pragma unroll
        for (int bj = 0; bj < 2; ++bj) { const float* bd = b_dn + (size_t)e * D + c0 + 128 * bj; const float* sw = swdn + (size_t)e * D + c0 + 128 * bj;
            const f32x4 b0 = *(const GAS f32x4*)bd, b1 = *(const GAS f32x4*)(bd + 4), w0 = *(const GAS f32x4*)sw, w1 = *(const GAS f32x4*)(sw + 4);
#pragma unroll
            EPI_LOOP_AM { const int r = 128 * ai + 64 * wr + 16 * m + fr; f32x4 o0, o1;
#pragma unroll
                for (int j = 0; j < 4; ++j) { o0[j] = (float)acc[ai][bj][m][0][j] * (sr[ai][m] * w0[j]) + b0[j]; o1[j] = (float)acc[ai][bj][m][1][j] * (sr[ai][m] * w1[j]) + b1[j]; }
                *(GAS v4u*)(yr + ((size_t)rt * 256 + r) * D + c0 + 128 * bj) = pack8(o0, o1); } }
    }
};

__device__ __forceinline__ void p3_scan(Frame& F) {
    const float* kvT = WSP(float, WS_KVT); bf16* Bcat = WSP(bf16, WS_BCAT);
    const int NQ = 2 * NH * 256 * 64;
    for (int q = F.vcu * NTHR + F.tid; q < NQ; q += F.G * NTHR) {
        const int dk4 = q & 63, dv = (q >> 6) & 255, dh = q >> 14, dir = dh >> 2, h = dh & 3;
        const float lg = -fexp((dir ? F.dec_b : F.dec_f)[h]); const float cd = fexp(lg * (float)C2);
        f32x4 S = (f32x4){0.f, 0.f, 0.f, 0.f};
        for (int s = 0; s < NCH; ++s) { const int n = dir ? (NCH - 1 - s) : s;
            const f32x4 kv = *(const GAS f32x4*)(kvT + (((size_t)dh * NCH + n) * 256 + dv) * 256 + dk4 * 4);
            v2u w; w.x = cvt_pk_bf16(S[0], S[1]); w.y = cvt_pk_bf16(S[2], S[3]);
            *(GAS v2u*)(Bcat + ((size_t)(h * NCH + n) * 256 + dv) * CAT + 256 + dir * 256 + dk4 * 4) = w;
            S = S * cd + kv; }
    }
}

__device__ __forceinline__ void p6_router(Frame& F) {
    const float* z1 = WSP(float, WS_Z1); unsigned* h1q = WSP(unsigned, WS_H1Q); float* sxg = WSP(float, WS_SX); float* rsc = WSP(float, WS_RSC); float* st1 = WSP(float, WS_ST0) + 2 * T;
    int* topi = WSP(int, WS_RT); float* gate = (float*)(topi + 4 * T); int* posb = (int*)(gate + 4 * T); int* row_tok = posb + 4 * T;
    LAS float* hc = (LAS float*)F.lds;
    LAS float* wrc = hc + 64 * 257;
    LAS float* stl = wrc + 256 * 32;
    LAS float* lg = stl + 128;
    LAS int* hist = (LAS int*)(lg + 64 * 33);
    LAS float* sxl = (LAS float*)(hist + 64);
    for (int blk = F.vcu; blk < T / 64; blk += F.G) {
        const int t0 = blk * 64;
        for (int rr = 0; rr < 8; ++rr) { const int row = F.wave * 8 + rr, m = t0 + row;
            const GAS f32x4* xr = (const GAS f32x4*)(z1 + (size_t)m * D) + F.lane; f32x4 v[8]; float s = 0.f;
#pragma unroll
            for (int j = 0; j < 8; ++j) { v[j] = xr[64 * j]; s += (v[j][0] + v[j][1]) + (v[j][2] + v[j][3]); }
            const float mean = wave_sum(s) * (1.f / D); float s2 = 0.f;
#pragma unroll
            for (int j = 0; j < 8; ++j) { v[j] = v[j] - mean; s2 += (v[j][0] * v[j][0] + v[j][1] * v[j][1]) + (v[j][2] * v[j][2] + v[j][3] * v[j][3]); }
            const float rstd = 1.f / sqrtf(wave_sum(s2) * (1.f / D) + LN_EPS);
            float am = 0.f;
#pragma unroll
            for (int j = 0; j < 8; ++j) { const f32x4 g = *((const GAS f32x4*)F.ln1_g + F.lane + 64 * j), b = *((const GAS f32x4*)F.ln1_b + F.lane + 64 * j);
                v[j] = v[j] * rstd * g + b; am = fmaxf(am, fmaxf(fmaxf(fabsf(v[j][0]), fabsf(v[j][1])), fmaxf(fabsf(v[j][2]), fabsf(v[j][3])))); }
#pragma unroll
            for (int o = 1; o < 64; o <<= 1) am = fmaxf(am, __shfl_xor(am, o));
            const float sc = am > 0.f ? am * (1.f / 127.f) : 1.f, inv = 1.f / sc;
#pragma unroll
            for (int j = 0; j < 8; ++j) { const int q0 = (int)__builtin_rintf(v[j][0] * inv), q1 = (int)__builtin_rintf(v[j][1] * inv), q2 = (int)__builtin_rintf(v[j][2] * inv), q3 = (int)__builtin_rintf(v[j][3] * inv);
                h1q[(size_t)m * (D / 4) + F.lane + 64 * j] = (unsigned)(q0 & 0xff) | ((unsigned)(q1 & 0xff) << 8) | ((unsigned)(q2 & 0xff) << 16) | ((unsigned)(q3 & 0xff) << 24); }
            if (F.lane == 0) { st1[2 * m] = mean; st1[2 * m + 1] = rstd; stl[2 * row] = mean; stl[2 * row + 1] = rstd; sxg[m] = sc; sxl[row] = sc; }
        }
        if (F.tid < 64) hist[F.tid] = 0;
        __syncthreads();
        const int row = F.tid >> 3, e0 = (F.tid & 7) * 4; f32x4 accl = (f32x4){0.f, 0.f, 0.f, 0.f};
        for (int kc = 0; kc < 8; ++kc) {
            for (int i = F.tid; i < 64 * 64; i += NTHR) { const int r = i >> 6, c4 = (i & 63) * 4, col = kc * 256 + c4;
                const f32x4 zv = *(const GAS f32x4*)(z1 + (size_t)(t0 + r) * D + col), g = *(const GAS f32x4*)(F.ln1_g + col), b = *(const GAS f32x4*)(F.ln1_b + col);
                const f32x4 hh = (zv - stl[2 * r]) * stl[2 * r + 1] * g + b; LAS float* d = hc + r * 257 + c4; d[0] = hh[0]; d[1] = hh[1]; d[2] = hh[2]; d[3] = hh[3]; }
            for (int i = F.tid; i < 256 * 8; i += NTHR) { const int k = i >> 3, c4 = (i & 7) * 4; *(LAS f32x4*)(wrc + k * 32 + c4) = *(const GAS f32x4*)(F.w_r + (size_t)(kc * 256 + k) * NE + c4); }
            __syncthreads();
#pragma unroll 8
            for (int k = 0; k < 256; ++k) { const float hv = hc[row * 257 + k]; const f32x4 w = *(const LAS f32x4*)(wrc + k * 32 + e0); accl = accl + w * hv; }
            __syncthreads();
        }
        { const f32x4 br = *(const GAS f32x4*)(F.b_r + e0); LAS float* d = lg + row * 33 + e0; d[0] = accl[0] + br[0]; d[1] = accl[1] + br[1]; d[2] = accl[2] + br[2]; d[3] = accl[3] + br[3]; }
        __syncthreads();
        int ek[4] = {0, 0, 0, 0}, lp[4] = {0, 0, 0, 0}; float gk[4] = {0.f, 0.f, 0.f, 0.f};
        if (F.tid < 64) {
            float lv[4]; unsigned used = 0u;
#pragma unroll
            for (int k = 0; k < 4; ++k) { float best = -3.0e38f; int bi = 0;
                for (int e = 0; e < NE; ++e) { const float v = lg[F.tid * 33 + e]; const bool ok = !((used >> e) & 1u) && (v > best); best = ok ? v : best; bi = ok ? e : bi; }
                used |= 1u << bi; ek[k] = bi; lv[k] = best; }
            const float mx = lv[0]; float den = 0.f;
#pragma unroll
            for (int k = 0; k < 4; ++k) { gk[k] = fexp(lv[k] - mx); den += gk[k]; }
            const float rd = 1.f / den;
#pragma unroll
            for (int k = 0; k < 4; ++k) { gk[k] *= rd; lp[k] = __hip_atomic_fetch_add(&hist[ek[k]], 1, __ATOMIC_RELAXED, __HIP_MEMORY_SCOPE_WORKGROUP); }
        }
        __syncthreads();
        if (F.tid < NE) hist[32 + F.tid] = (int)__hip_atomic_fetch_add(F.ctl + CW_CNT + 64 * F.tid, (unsigned)hist[F.tid], RLX_AGENT);
        __syncthreads();
        if (F.tid < 64) { const int tok = t0 + F.tid;
#pragma unroll
            for (int k = 0; k < 4; ++k) { const int pos = hist[32 + ek[k]] + lp[k]; row_tok[(size_t)ek[k] * T + pos] = tok; rsc[(size_t)ek[k] * T + pos] = sxl[F.tid]; topi[4 * tok + k] = ek[k]; gate[4 * tok + k] = gk[k]; posb[4 * tok + k] = pos; } }
        __syncthreads();
    }
}

__device__ __forceinline__ void p8_requant(Frame& F, const LAS int* tstart) {
    const bf16* act = WSP(bf16, WS_ACT); unsigned* aq = WSP(unsigned, WS_ACTQ); float* sa = WSP(float, WS_SA); const unsigned* rmax = F.ctl + CW_RMAX;
    const int R = tstart[NE] * 256, gw = F.vcu * NWAVES + F.wave, NGW = F.G * NWAVES;
    for (int row = gw; row < R; row += NGW) {
        const float mx = __uint_as_float(rmax[row]); const float sc = mx > 0.f ? mx * (1.f / 127.f) : 1.f, inv = 1.f / sc;
#pragma unroll
        for (int j = 0; j < 2; ++j) { const int col = 16 * F.lane + 1024 * j;
            const v4u a = *(const GAS v4u*)(act + (size_t)row * DFF + col), b = *(const GAS v4u*)(act + (size_t)row * DFF + col + 8);
            const unsigned src[8] = {a.x, a.y, a.z, a.w, b.x, b.y, b.z, b.w}; unsigned o[4];
#pragma unroll
            for (int d = 0; d < 4; ++d) { unsigned w = 0u;
#pragma unroll
                for (int h2 = 0; h2 < 2; ++h2) { const unsigned u2 = src[2 * d + h2]; int q0 = (int)__builtin_rintf(bf_lo(u2) * inv), q1 = (int)__builtin_rintf(bf_hi(u2) * inv);
                    q0 = q0 > 127 ? 127 : (q0 < -127 ? -127 : q0); q1 = q1 > 127 ? 127 : (q1 < -127 ? -127 : q1);
                    w |= ((unsigned)(q0 & 0xff) << (16 * h2)) | ((unsigned)(q1 & 0xff) << (16 * h2 + 8)); }
                o[d] = w; }
            *(GAS v4u*)(aq + ((size_t)row * DFF + col) / 4) = (v4u){o[0], o[1], o[2], o[3]}; }
        if (F.lane == 0) sa[row] = sc;
    }
}

__device__ __forceinline__ void build_tstart(Frame& F, LAS int* tstart) {
    if (F.tid == 0) { int s = 0; for (int e = 0; e < NE; ++e) { tstart[e] = s; const unsigned n = __hip_atomic_load(F.ctl + CW_CNT + 64 * e, RLX_AGENT); s += (int)((n + 255u) >> 8); } tstart[NE] = s; }
    __syncthreads();
}

__device__ __forceinline__ void p9_combine(Frame& F, const LAS int* tstart) {
    const float* z1 = WSP(float, WS_Z1); const float* st1 = WSP(float, WS_ST0) + 2 * T; const bf16* yr = WSP(bf16, WS_YR);
    const int* topi = WSP(int, WS_RT); const float* gate = (const float*)(topi + 4 * T); const int* posb = (const int*)(gate + 4 * T);
    const int gw = F.vcu * NWAVES + F.wave, NGW = F.G * NWAVES;
    for (int m = gw; m < T; m += NGW) {
        const float mean1 = st1[2 * m], rstd1 = st1[2 * m + 1];
        size_t ro[4]; float gk[4];
#pragma unroll
        for (int k = 0; k < 4; ++k) { const int e = topi[4 * m + k]; ro[k] = ((size_t)tstart[e] * 256 + posb[4 * m + k]) * D; gk[k] = gate[4 * m + k]; }
        f32x4 v[8]; float s = 0.f;
#pragma unroll
        for (int j = 0; j < 8; ++j) { const int col = 4 * F.lane + 256 * j;
            const f32x4 zv = *(const GAS f32x4*)(z1 + (size_t)m * D + col), g = *(const GAS f32x4*)(F.ln1_g + col), b = *(const GAS f32x4*)(F.ln1_b + col);
            f32x4 a = ((zv - mean1) * rstd1 * g + b) * ALPHA;
#pragma unroll
            for (int k = 0; k < 4; ++k) { const v2u w = *(const GAS v2u*)(yr + ro[k] + col); a[0] += gk[k] * bf_lo(w.x); a[1] += gk[k] * bf_hi(w.x); a[2] += gk[k] * bf_lo(w.y); a[3] += gk[k] * bf_hi(w.y); }
            v[j] = a; s += (a[0] + a[1]) + (a[2] + a[3]); }
        const float mean = wave_sum(s) * (1.f / D); float s2 = 0.f;
#pragma unroll
        for (int j = 0; j < 8; ++j) { v[j] = v[j] - mean; s2 += (v[j][0] * v[j][0] + v[j][1] * v[j][1]) + (v[j][2] * v[j][2] + v[j][3] * v[j][3]); }
        const float rstd = 1.f / sqrtf(wave_sum(s2) * (1.f / D) + LN_EPS);
#pragma unroll
        for (int j = 0; j < 8; ++j) { const int col = 4 * F.lane + 256 * j; const f32x4 g = *(const GAS f32x4*)(F.ln2_g + col), b = *(const GAS f32x4*)(F.ln2_b + col);
            *(GAS f32x4*)(F.out + (size_t)m * D + col) = v[j] * rstd * g + b; }
    }
}

constexpr int NPH = 11;
__global__ void __launch_bounds__(NTHR, 2) fwd(Args args) {
    extern __shared__ __attribute__((aligned(16))) unsigned char lds_raw[];
    Frame F;
    F.lds = (LAS unsigned char*)lds_raw; F.ws = args.ws; F.ctl = (unsigned*)(args.ws + WS_CTL);
    F.tid = threadIdx.x; F.lane = F.tid & 63; F.wave = __builtin_amdgcn_readfirstlane(F.tid >> 6);
    F.G = gridDim.x; { const int bx = blockIdx.x; F.vcu = (F.G % 8 == 0) ? (bx % 8) * (F.G / 8) + bx / 8 : bx; }
    F.x = args.in[0]; F.ln0_g = args.in[1]; F.ln0_b = args.in[2]; F.w_in = args.in[3]; F.dec_f = args.in[4]; F.dec_b = args.in[5]; F.gn_g = args.in[6]; F.w_out = args.in[7];
    F.ln1_g = args.in[8]; F.ln1_b = args.in[9]; F.w_r = args.in[10]; F.b_r = args.in[11]; F.w_up = args.in[12]; F.b_up = args.in[13]; F.w_dn = args.in[14]; F.b_dn = args.in[15];
    F.ln2_g = args.in[16]; F.ln2_b = args.in[17]; F.out = args.out;
    volatile LAS unsigned* lctl = (volatile LAS unsigned*)(F.lds + LDS_CTL_OFF);
    LAS int* tstart = (LAS int*)(F.lds + LDS_CTL_OFF + 64);
    for (int u = F.tid; u < 128; u += NTHR) lctl[u] = 0u;
    __syncthreads();
    const int lo = args.ph_lo, hi = args.ph_hi;
    const bool single = (hi - lo) > 1;
    XcdBarrier bar; bar.bar = F.ctl + CW_BAR; bar.x = 0; bar.st = lctl;
    if (single) bar = xcd_barrier_post(F.ctl + CW_BAR, lctl);
#ifndef PH_MASK
#define PH_MASK 0x7ff
#endif
#define IN(k) (((PH_MASK >> (k)) & 1) && lo <= (k) && (k) < hi)
#ifndef SUB_MASK
#define SUB_MASK 0xff
#endif
#define SUB(n) ((SUB_MASK >> (n)) & 1)
#define SEAM(k) do { if (IN(k) && IN((k) + 1)) xcd_barrier(bar); } while (0)
    const int bc = (int)blockIdx.x;

    if (IN(0)) { p0_prologue(F); __syncthreads();
        p0_quant(F, F.w_up, 2 * DFF, (signed char*)WSP(char, WS_WUP), WSP(float, WS_SWUP), ColUp());
        p0_quant(F, F.w_dn, D, (signed char*)WSP(char, WS_WDN), WSP(float, WS_SWDN), ColId()); }
    SEAM(0);
    if (IN(1)) {
        if (SUB(0)) { SchedG1N S; S.nt = D / 64; S.pitchA = D; S.pitchB = D; S.multA = 1; S.multB = 1; S.G = F.G; S.c = bc; S.A = (const char*)WSP(bf16, WS_H0B); S.Bt = (const char*)WSP(bf16, WS_WIN);
          EpiG1N E{WSP(bf16, WS_QS), WSP(bf16, WS_KK), WSP(bf16, WS_GS), WSP(bf16, WS_ACAT), F.dec_f, F.dec_b};
          gm::gemm_run<EpiG1N, SchedG1N, false>(F.lds, S, E); }
        if (SUB(1)) { SchedG1SF S; S.nt = D / 64; S.pitchA = D; S.pitchB = D; S.multA = 1; S.multB = 128; S.G = F.G; S.c = bc; S.A = (const char*)WSP(bf16, WS_WIN); S.Bt = (const char*)WSP(bf16, WS_H0B);
          EpiG1SF E{WSP(bf16, WS_UTT)};
          gm::gemm_run<EpiG1SF, SchedG1SF, false>(F.lds, S, E); }
        if (SUB(2)) { SchedG1SKV S; S.nt = D / 64; S.pitchA = D; S.pitchB = D; S.multA = 1; S.multB = 1; S.G = F.G; S.c = bc; S.A = (const char*)WSP(bf16, WS_WIN); S.Bt = (const char*)WSP(bf16, WS_H0B);
          EpiG1SKV E{WSP(bf16, WS_KTW), WSP(bf16, WS_BCAT), F.dec_f, F.dec_b};
          gm::gemm_run<EpiG1SKV, SchedG1SKV, false>(F.lds, S, E); }
    }
    SEAM(1);
    if (IN(2)) {
        if (SUB(3)) { SchedFixA S; S.nt = 2; S.pitchA = 128; S.pitchB = 128; S.multA = 1; S.multB = 1; S.G = F.G; S.c = bc; S.A = (const char*)WSP(bf16, WS_TAB); S.Bt = (const char*)WSP(bf16, WS_UTT); S.ncol = 512;
          EpiS1 E{WSP(bf16, WS_A1)};
          gm::gemm_run<EpiS1, SchedFixA, false>(F.lds, S, E); }
        if (SUB(4)) { SchedScores S; S.nt = 4; S.pitchA = RW; S.pitchB = RW; S.multA = 1; S.multB = 1; S.G = F.G; S.c = bc; S.Q = (const char*)WSP(bf16, WS_QS); S.Kk = (const char*)WSP(bf16, WS_KK);
          EpiScores E{WSP(bf16, WS_ACAT), F.dec_f, F.dec_b};
          gm::gemm_run<EpiScores, SchedScores, false>(F.lds, S, E); }
        if (SUB(5)) { SchedKV S; S.nt = 4; S.pitchA = CAT; S.pitchB = T; S.multA = 1; S.multB = 1; S.G = F.G; S.c = bc; S.Bcat = (const char*)WSP(bf16, WS_BCAT); S.kTw = (const char*)WSP(bf16, WS_KTW);
          EpiKV E{WSP(float, WS_KVT)};
          gm::gemm_run<EpiKV, SchedKV, false>(F.lds, S, E); }
    }
    SEAM(2);
    if (IN(3)) {
        { SchedFixA S; S.nt = 4; S.pitchA = 256; S.pitchB = 256; S.multA = 1; S.multB = 1; S.G = F.G; S.c = bc; S.A = (const char*)(WSP(bf16, WS_TAB) + 32768); S.Bt = (const char*)WSP(bf16, WS_A1); S.ncol = 512;
          EpiS2 E{WSP(bf16, WS_ZT)};
          gm::gemm_run<EpiS2, SchedFixA, false>(F.lds, S, E); }
        p3_scan(F);
    }
    SEAM(3);
    if (IN(4)) {
        { SchedFixB S; S.nt = 4; S.pitchA = 256; S.pitchB = 256; S.multA = 1; S.multB = 1; S.G = F.G; S.c = bc; S.A = (const char*)WSP(bf16, WS_ZT); S.Bt = (const char*)(WSP(bf16, WS_TAB) + 32768 + 65536); S.nrow = 512;
          EpiChan E{WSP(bf16, WS_Y)};
          gm::gemm_run<EpiChan, SchedFixB, false>(F.lds, S, E); }
        { SchedOut S; S.nt = CAT / 64; S.pitchA = CAT; S.pitchB = CAT; S.multA = 1; S.multB = 1; S.G = F.G; S.c = bc; S.Acat = (const char*)WSP(bf16, WS_ACAT); S.Bcat = (const char*)WSP(bf16, WS_BCAT);
          EpiOut E{WSP(bf16, WS_Y), WSP(bf16, WS_GS), F.gn_g};
          gm::gemm_run<EpiOut, SchedOut, false>(F.lds, S, E); }
    }
    SEAM(4);
    if (IN(5)) {
        Sched2D S; S.nt = D / 64; S.pitchA = D; S.pitchB = D; S.multA = 1; S.multB = 1; S.G = F.G; S.c = bc; S.A = (const char*)WSP(bf16, WS_Y); S.Bt = (const char*)WSP(bf16, WS_WOUT); S.nM = 64; S.nN = 8;
        EpiWout E{WSP(float, WS_Z1), F.x, WSP(float, WS_ST0), F.ln0_g, F.ln0_b};
        gm::gemm_run<EpiWout, Sched2D, false>(F.lds, S, E);
    }
    SEAM(5);
    if (IN(6)) { p6_router(F); }
    SEAM(6);
    if (IN(7) || IN(8) || IN(9) || IN(10)) build_tstart(F, tstart);
    if (IN(7)) {
        SchedMoE S; S.nt = D / 128; S.pitchA = D / 2; S.pitchB = D / 2; S.multA = 1; S.multB = 1; S.G = F.G; S.c = bc; S.A = (const char*)WSP(char, WS_H1Q); S.Bt = (const char*)WSP(char, WS_WUP);
        S.tstart = tstart; S.row_tok = WSP(int, WS_RT) + 12 * T; S.cnt = F.ctl + CW_CNT; S.nN = 16; S.rowbytes = D; S.estride = (size_t)2 * DFF * D;
        EpiUp E{WSP(bf16, WS_ACT), F.b_up, WSP(float, WS_SWUP), WSP(float, WS_RSC), F.ctl + CW_CNT, F.ctl + CW_RMAX};
        gm::gemm_run<EpiUp, SchedMoE, true, true>(F.lds, S, E);
    }
    SEAM(7);
    if (IN(8)) { p8_requant(F, tstart); }
    SEAM(8);
    if (IN(9)) {
        SchedMoEDown S; S.nt = DFF / 128; S.pitchA = DFF / 2; S.pitchB = DFF / 2; S.multA = 1; S.multB = 1; S.G = F.G; S.c = bc; S.A = (const char*)WSP(char, WS_ACTQ); S.Bt = (const char*)WSP(char, WS_WDN);
        S.tstart = tstart; S.row_tok = nullptr; S.cnt = F.ctl + CW_CNT; S.nN = 8; S.rowbytes = DFF; S.estride = (size_t)D * DFF;
        EpiDown E{WSP(bf16, WS_YR), F.b_dn, WSP(float, WS_SWDN), WSP(float, WS_SA)};
        gm::gemm_run<EpiDown, SchedMoEDown, false, true>(F.lds, S, E);
    }
    SEAM(9);
    if (IN(10)) { p9_combine(F, tstart); }
#undef IN
#undef SEAM
}

#ifndef MK_SPLIT
#define MK_SPLIT 0
#endif
extern "C" void kernel_launch(void* const* d_in, const int* in_sizes, int n_in, void* d_out, int out_size, void* d_ws, size_t ws_size, hipStream_t stream) {
    static int grid = 0;
    if (grid == 0) {
        if (n_in != 18 || out_size != T * D || ws_size < WS_END2) { fprintf(stderr, "kernel_launch: unexpected problem: n_in %d out %d ws %zu (need %zu)\n", n_in, out_size, ws_size, (size_t)WS_END2); grid = -1; return; }
        int dev = 0, cus = 0, per_cu = 0;
        if (hipGetDevice(&dev) != hipSuccess || hipDeviceGetAttribute(&cus, hipDeviceAttributeMultiprocessorCount, dev) != hipSuccess) { grid = -1; return; }
        if (hipFuncSetAttribute((const void*)fwd, hipFuncAttributeMaxDynamicSharedMemorySize, LDS_BYTES) != hipSuccess) { fprintf(stderr, "kernel_launch: hipFuncSetAttribute failed\n"); grid = -1; return; }
        if (hipOccupancyMaxActiveBlocksPerMultiprocessor(&per_cu, (const void*)fwd, NTHR, LDS_BYTES) != hipSuccess || per_cu < 1) { fprintf(stderr, "kernel_launch: occupancy query reports %d\n", per_cu); }
        (void)hipGetLastError();
        grid = cus;
    }
    if (grid < 0) return;
    (void)hipMemsetAsync((char*)d_ws + WS_CTL, 0, CTL_BYTES, stream);
    Args a{};
    for (int i = 0; i < 18; ++i) a.in[i] = (const float*)d_in[i];
    a.out = (float*)d_out; a.ws = (unsigned char*)d_ws;
#if MK_SPLIT
    for (int p = 0; p < NPH; ++p) { a.ph_lo = p; a.ph_hi = p + 1; hipLaunchKernelGGL(fwd, dim3(grid), dim3(NTHR), LDS_BYTES, stream, a); }
#else
    a.ph_lo = 0; a.ph_hi = NPH; hipLaunchKernelGGL(fwd, dim3(grid), dim3(NTHR), LDS_BYTES, stream, a);
#endif
}
```

```cpp
#include <hip/hip_runtime.h>
#include <cstdio>
#include <cstdint>

#define GAS __attribute__((address_space(1)))
#define LAS __attribute__((address_space(3)))
typedef unsigned short bf16;
typedef unsigned v4u __attribute__((ext_vector_type(4)));
typedef unsigned v2u __attribute__((ext_vector_type(2)));
typedef float f32x4 __attribute__((ext_vector_type(4)));
typedef float f32x2 __attribute__((ext_vector_type(2)));
typedef short bf16x8 __attribute__((ext_vector_type(8)));
typedef int i32x4 __attribute__((ext_vector_type(4)));
#define RLX_AGENT __ATOMIC_RELAXED, __HIP_MEMORY_SCOPE_AGENT
#define LDS_WAIT() asm volatile("s_waitcnt lgkmcnt(0)" ::: "memory")
#define VM_WAIT() asm volatile("s_waitcnt vmcnt(0)" ::: "memory")

constexpr int T = 16384, D = 2048, DIN = 5120, FW = 1024, RW = 1024, NH = 4, HD = 256, NE = 32, TOPK = 4, DFF = 2048;
constexpr int C2 = 256, NCH = T / C2;
constexpr int CAT = 768;
constexpr float LN_EPS = 1e-5f, GN_EPS = 1e-6f, ALPHA = 1.189207115002721f;
constexpr int RT_MAX = (T * TOPK) / 256 + NE;
constexpr int NWAVES = 8, NTHR = 512;

constexpr size_t MiB = 1u << 20;
constexpr size_t WS_CTL = 0, CTL_BYTES = 1 * MiB;
constexpr size_t WS_TAB = 1 * MiB;
constexpr size_t WS_WIN = 2 * MiB;
constexpr size_t WS_WOUT = WS_WIN + 20 * MiB;
constexpr size_t WS_WUP = WS_WOUT + 8 * MiB;
constexpr size_t WS_WDN = WS_WUP + 512 * MiB;
constexpr size_t WS_H0B = WS_WDN + 256 * MiB;
constexpr size_t WS_ST0 = WS_H0B + 64 * MiB;
constexpr size_t WS_UTT = WS_ST0 + 1 * MiB;
constexpr size_t WS_A1 = WS_UTT + 32 * MiB;
constexpr size_t WS_ZT = WS_A1 + 64 * MiB;
constexpr size_t WS_QS = WS_ZT + 64 * MiB;
constexpr size_t WS_KK = WS_QS + 32 * MiB;
constexpr size_t WS_GS = WS_KK + 32 * MiB;
constexpr size_t WS_ACAT = WS_GS + 32 * MiB;
constexpr size_t WS_BCAT = WS_ACAT + 96 * MiB;
constexpr size_t WS_KTW = WS_BCAT + 96 * MiB;
constexpr size_t WS_KVT = WS_KTW + 64 * MiB;
constexpr size_t WS_Y = WS_KVT + 128 * MiB;
constexpr size_t WS_Z1 = WS_Y + 64 * MiB;
constexpr size_t WS_H1B = WS_Z1 + 128 * MiB;
constexpr size_t WS_RT = WS_H1B + 64 * MiB;
constexpr size_t WS_ACT = WS_RT + 4 * MiB;
constexpr size_t WS_YR = WS_ACT + 288 * MiB;
constexpr size_t WS_END = WS_YR + 288 * MiB;
constexpr size_t WS_SWUP = WS_TAB + 512 * 1024;
constexpr size_t WS_H1Q = WS_H1B;
constexpr size_t WS_SX = WS_H1B + 32 * MiB, WS_RSC = WS_H1B + 40 * MiB, WS_SA = WS_H1B + 44 * MiB;
constexpr size_t WS_SWDN = WS_ST0 + 512 * 1024;
constexpr size_t WS_ACTQ = WS_END;
constexpr size_t WS_END2 = WS_ACTQ + 144 * MiB;
constexpr int CW_RMAX = 16384;
constexpr int CW_BAR = 1024;
constexpr int CW_CNT = 8192;

constexpr int LDS_STAGE = 131072, LDS_SCR = 16384, LDS_CTL_OFF = LDS_STAGE + LDS_SCR, LDS_BYTES = LDS_CTL_OFF + 512;

__device__ __forceinline__ unsigned cvt_pk_bf16(float lo, float hi) { unsigned r; asm volatile("v_cvt_pk_bf16_f32 %0, %1, %2" : "=v"(r) : "v"(lo), "v"(hi)); return r; }
__device__ __forceinline__ float bf_lo(unsigned u) { return __builtin_bit_cast(float, u << 16); }
__device__ __forceinline__ float bf_hi(unsigned u) { return __builtin_bit_cast(float, u & 0xffff0000u); }
__device__ __forceinline__ v4u pack8(const f32x4 a, const f32x4 b) { v4u w; w.x = cvt_pk_bf16(a[0], a[1]); w.y = cvt_pk_bf16(a[2], a[3]); w.z = cvt_pk_bf16(b[0], b[1]); w.w = cvt_pk_bf16(b[2], b[3]); return w; }
__device__ __forceinline__ float wave_sum(float v) {
#pragma unroll
    for (int o = 1; o < 64; o <<= 1) v += __shfl_xor(v, o);
    return v;
}
__device__ __forceinline__ float fexp(float x) { return __builtin_amdgcn_exp2f(x * 1.4426950408889634f); }
__device__ __forceinline__ void cs_rev(float rev, float& c, float& s) { const float f = __builtin_amdgcn_fractf(rev); c = __builtin_amdgcn_cosf(f); s = __builtin_amdgcn_sinf(f); }

#define XB_TMO      128
#define XB_XCNT(j)  (256  + 64 * (j))
#define XB_XSUB(j)  (1280 + 64 * (j))
#define XB_XGEN(j)  (2304 + 64 * (j))
#define XB_TOP      3328
#define XB_TOPGEN   3392
#define XCD_BAR_WORDS 3456
#define XB_SPIN_CAP (1u << 18)
__device__ __forceinline__ unsigned xb_ld(unsigned* p)              { return __hip_atomic_load(p, __ATOMIC_RELAXED, __HIP_MEMORY_SCOPE_AGENT); }
__device__ __forceinline__ unsigned xb_add(unsigned* p, unsigned v) { return __hip_atomic_fetch_add(p, v, __ATOMIC_RELAXED, __HIP_MEMORY_SCOPE_AGENT); }
__device__ __forceinline__ unsigned xb_xcc_id() { return (unsigned)__builtin_amdgcn_s_getreg((3 << 11) | 20) & 0xFu; }
#define XB_SPIN(cond, bar) do { unsigned _sp = 0; while (cond) { __builtin_amdgcn_s_sleep(1); \
    if ((++_sp & 255u) == 0u) { if (xb_ld(&(bar)[XB_TMO])) break; if (_sp > XB_SPIN_CAP) { atomicAdd(&(bar)[XB_TMO], 1u); break; } } } } while (0)
struct XcdBarrier { unsigned* bar; unsigned x; volatile LAS unsigned* st; };
__device__ __forceinline__ XcdBarrier xcd_barrier_post(unsigned* bar, volatile LAS unsigned* st) {
    XcdBarrier b; b.bar = bar; b.x = xb_xcc_id(); b.st = st;
    if (threadIdx.x == 0) (void)xb_add(&bar[XB_XCNT(b.x)], 1u);
    return b;
}
__device__ __forceinline__ void xcd_barrier_complete(unsigned* bar, unsigned x, unsigned& nloc, unsigned& nx) {
    const unsigned G = gridDim.x * gridDim.y * gridDim.z;
    unsigned sum, cnt, mine, sp = 0u;
    for (;;) {
        sum = 0u; cnt = 0u; mine = 0u;
#pragma unroll
        for (unsigned j = 0; j < 16; ++j) { const unsigned c = xb_ld(&bar[XB_XCNT(j)]); sum += c; cnt += (c > 0u) ? 1u : 0u; mine = (j == x) ? c : mine; }
        if (sum == G) break;
        __builtin_amdgcn_s_sleep(1);
        if ((++sp & 255u) == 0u) { if (xb_ld(&bar[XB_TMO])) break; if (sp > XB_SPIN_CAP) { atomicAdd(&bar[XB_TMO], 1u); break; } }
    }
    nloc = mine > 0u ? mine : 1u; nx = cnt > 0u ? cnt : 1u;
}
__device__ __forceinline__ void xcd_barrier(const XcdBarrier& b) {
    asm volatile("s_waitcnt vmcnt(0)" ::: "memory");
    __syncthreads();
    if (threadIdx.x == 0) {
        unsigned* bar = b.bar;
        __builtin_amdgcn_s_waitcnt(0);
        unsigned nloc = b.st[0], nx = b.st[1];
        if (nloc == 0u) { xcd_barrier_complete(bar, b.x, nloc, nx); b.st[0] = nloc; b.st[1] = nx; }
        const unsigned old = xb_add(&bar[XB_XSUB(b.x)], 1u);
        const unsigned gen = old / nloc;
        if (old + 1u == (gen + 1u) * nloc) {
            __builtin_amdgcn_fence(__ATOMIC_RELEASE, "agent");
            asm volatile("s_waitcnt vmcnt(0)" ::: "memory");
            const unsigned og = xb_add(&bar[XB_TOP], 1u);
            const unsigned tg = og / nx;
            if (og + 1u == (tg + 1u) * nx) xb_add(&bar[XB_TOPGEN], 1u);
            else XB_SPIN(xb_ld(&bar[XB_TOPGEN]) == tg, bar);
            __builtin_amdgcn_fence(__ATOMIC_ACQUIRE, "agent");
            xb_add(&bar[XB_XGEN(b.x)], 1u);
            asm volatile("s_waitcnt vmcnt(0)" ::: "memory");
        } else {
            XB_SPIN(xb_ld(&bar[XB_XGEN(b.x)]) == gen, bar);
            __builtin_amdgcn_fence(__ATOMIC_ACQUIRE, "agent");
            asm volatile("s_waitcnt vmcnt(0)" ::: "memory");
        }
    }
    __syncthreads();
}

namespace gm {
constexpr int BM = 256, BK = 64, HALF = 128, HTB = HALF * BK * 2, STAGE_BYTES = 8 * HTB;
__device__ __forceinline__ int lds_byte(int r, int c) { const int st = (r >> 4) * 2 + (c >> 5), rr = r & 15, cc = c & 31, ob = rr * 64 + cc * 2; return st * 1024 + (ob ^ (((ob >> 9) & 1) << 5)); }
__device__ __forceinline__ void stage_rc(int b, int& R, int& C) { const int st = b / 1024, sb = b % 1024, swz = sb ^ (((sb >> 9) & 1) << 5); R = (st >> 1) * 16 + swz / 64; C = (st & 1) * 32 + (swz % 64) / 2; }
__device__ __forceinline__ int perm32(int rho) { const int n = rho >> 4, i = rho & 15; return 8 * (i >> 2) + 4 * n + (i & 3); }

struct Unit { const char* a0; const char* a1; const char* b0; const char* b1; int p0, p1, p2, p3; };

__device__ __forceinline__ void tile_order(int L, int nM, int nN, int& pm, int& pn) {
    const int nwg = nM * nN; int wgid = L;
    { const int q = nwg / 8, r = nwg % 8, xcd = wgid % 8, off = wgid / 8; wgid = (xcd < r ? xcd * (q + 1) : r * (q + 1) + (xcd - r) * q) + off; }
    const int nig = 8 * nN, gid = wgid / nig, fm = gid * 8, gsz = (nM - fm) < 8 ? (nM - fm) : 8;
    pm = fm + ((wgid % nig) % gsz); pn = (wgid % nig) / gsz;
}

template <bool I8> struct AccSel { typedef f32x4 type; };
template <> struct AccSel<true> { typedef i32x4 type; };
template <class Epi, class Sched, bool GATHER, bool I8 = false>
__device__ __forceinline__ void gemm_run(LAS unsigned char* lds, const Sched& S, const Epi& E) {
    const int tid = threadIdx.x, wid = __builtin_amdgcn_readfirstlane(tid >> 6), lane = tid & 63, wr = wid >> 2, wc = wid & 3, fr = lane & 15, fq = lane >> 4;
    int nt = S.nt; asm volatile("" : "+s"(nt));
    unsigned voffA[2], voffB[2], colA[2]; int rowA[2];
#pragma unroll
    for (int i = 0; i < 2; ++i) { int R, C; stage_rc(tid * 16 + i * 8192, R, C); const int Rb = Epi::PERM ? ((R & ~31) + perm32(R & 31)) : R;
        voffA[i] = (unsigned)(R * S.multA * S.pitchA + C) * 2u; voffB[i] = (unsigned)(Rb * S.multB * S.pitchB + C) * 2u; colA[i] = (unsigned)C * 2u; rowA[i] = R; }
    const size_t kstep = (size_t)(BK * 2);
    const unsigned ldsw = (unsigned)wid * 1024u;
    const int aoff = lds_byte(wr * 64 + fr, fq * 8), boff = lds_byte(wc * 32 + fr, fq * 8);
#define G_SA(b, h) (((b) * 2 + (h)) * HTB)
#define G_SB(b, h) ((4 + (b) * 2 + (h)) * HTB)
#define G_STAGE(bufoff, gbase, voff) do { _Pragma("unroll") for (int _i = 0; _i < 2; ++_i) \
        __builtin_amdgcn_global_load_lds((const unsigned*)((const char*)(gbase) + (voff)[_i]), (LAS unsigned*)(lds + (bufoff) + ldsw + _i * 8192), 16, 0, 0); } while (0)
#define G_LDA(dst, b, h) do { _Pragma("unroll") for (int m = 0; m < 4; ++m) _Pragma("unroll") for (int k = 0; k < 2; ++k) dst[m][k] = *(const LAS bf16x8*)(lds + G_SA(b, h) + aoff + m * 2048 + k * 1024); } while (0)
#define G_LDB(dst, b, h) do { _Pragma("unroll") for (int n = 0; n < 2; ++n) _Pragma("unroll") for (int k = 0; k < 2; ++k) dst[n][k] = *(const LAS bf16x8*)(lds + G_SB(b, h) + boff + n * 2048 + k * 1024); } while (0)
#define G_MMA(ai, bj, At, Bt) do { __builtin_amdgcn_s_setprio(1); _Pragma("unroll") for (int m = 0; m < 4; ++m) _Pragma("unroll") for (int n = 0; n < 2; ++n) _Pragma("unroll") for (int k = 0; k < 2; ++k) \
        { if constexpr (I8) acc[ai][bj][m][n] = __builtin_amdgcn_mfma_i32_16x16x64_i8(__builtin_bit_cast(i32x4, Bt[n][k]), __builtin_bit_cast(i32x4, At[m][k]), acc[ai][bj][m][n], 0, 0, 0); \
          else acc[ai][bj][m][n] = __builtin_amdgcn_mfma_f32_16x16x32_bf16(Bt[n][k], At[m][k], acc[ai][bj][m][n], 0, 0, 0); } __builtin_amdgcn_s_setprio(0); } while (0)
#define G_WAIT_V(n) asm volatile("s_waitcnt vmcnt(" #n ")" ::: "memory")
#define G_WAIT_L(n) asm volatile("s_waitcnt lgkmcnt(" #n ")" ::: "memory")
#define G_BAR __builtin_amdgcn_s_barrier()
#define G_SCHED __builtin_amdgcn_sched_barrier(0)
    Unit cur, nxt; int ui = 0;
    if (!S.next(0, cur)) return;
    typedef typename AccSel<I8>::type acc_t;
    acc_t acc[2][2][4][2];
#pragma unroll
    for (int a = 0; a < 2; ++a)
#pragma unroll
        for (int b = 0; b < 2; ++b)
#pragma unroll
            for (int m = 0; m < 4; ++m)
#pragma unroll
                for (int n = 0; n < 2; ++n) acc[a][b][m][n] = (acc_t){0, 0, 0, 0};
    bf16x8 At[4][2], B0[2][2], B1[2][2];
    unsigned gc0[2], gc1[2];
    if constexpr (GATHER) {
#pragma unroll
        for (int i = 0; i < 2; ++i) { gc0[i] = S.row_off(cur, rowA[i]) + colA[i]; gc1[i] = S.row_off(cur, 128 + rowA[i]) + colA[i]; }
    }
#define vA0 (GATHER ? gc0 : voffA)
#define vA1 (GATHER ? gc1 : voffA)
    G_STAGE(G_SB(0, 0), cur.b0, voffB); G_STAGE(G_SB(0, 1), cur.b1, voffB); G_STAGE(G_SA(0, 0), cur.a0, vA0); G_STAGE(G_SA(0, 1), cur.a1, vA1);
    if (wr == 1) G_BAR;
    G_WAIT_V(2); G_BAR;
    G_STAGE(G_SB(1, 0), cur.b0 + kstep, voffB); G_STAGE(G_SA(1, 0), cur.a0 + kstep, vA0); G_STAGE(G_SB(1, 1), cur.b1 + kstep, voffB);
    G_WAIT_V(6); G_BAR;
    for (;;) {
        const bool has_next = S.next(ui + 1, nxt);
        if (!has_next) nxt = cur;
        for (int t = 0; t < nt; t += 2) {
            const bool last = (t == nt - 2);
            unsigned tn1[2] = {0u, 0u};
            if constexpr (GATHER) { if (last) { int tz = tid; asm volatile("" : "+v"(tz));
#pragma unroll
                for (int i = 0; i < 2; ++i) { int R, C; stage_rc(tz * 16 + i * 8192, R, C); gc0[i] = S.row_off(nxt, R) + (unsigned)C * 2u; tn1[i] = S.row_off(nxt, 128 + R) + (unsigned)C * 2u; } } }
            const char* a11 = cur.a1 + (size_t)(t + 1) * kstep;
            const char* a02 = last ? nxt.a0 : cur.a0 + (size_t)(t + 2) * kstep; const char* a12 = last ? nxt.a1 : cur.a1 + (size_t)(t + 2) * kstep;
            const char* b02 = last ? nxt.b0 : cur.b0 + (size_t)(t + 2) * kstep; const char* b12 = last ? nxt.b1 : cur.b1 + (size_t)(t + 2) * kstep;
            G_LDB(B0, 0, 0); G_LDB(B1, 0, 1); G_SCHED; G_LDA(At, 0, 0); G_STAGE(G_SA(1, 1), a11, vA1);
            if constexpr (GATHER) { if (last) { gc1[0] = tn1[0]; gc1[1] = tn1[1]; } }
            G_WAIT_V(8); G_WAIT_L(0); G_BAR; G_MMA(0, 0, At, B0); G_MMA(0, 1, At, B1); G_BAR; G_SCHED;
            G_LDA(At, 0, 1); G_STAGE(G_SB(0, 0), b02, voffB); G_STAGE(G_SB(0, 1), b12, voffB); G_STAGE(G_SA(0, 0), a02, vA0);
            G_WAIT_V(8); G_WAIT_L(0); G_BAR; G_MMA(1, 0, At, B0); G_MMA(1, 1, At, B1); G_BAR; G_SCHED;
            G_LDB(B0, 1, 0); G_LDB(B1, 1, 1); G_SCHED; G_LDA(At, 1, 0); G_STAGE(G_SA(0, 1), a12, vA1);
            G_WAIT_V(8); G_WAIT_L(0); G_BAR; G_MMA(0, 0, At, B0); G_MMA(0, 1, At, B1); G_BAR; G_SCHED;
            G_LDA(At, 1, 1); G_STAGE(G_SB(1, 0), b02 + kstep, voffB); G_STAGE(G_SB(1, 1), b12 + kstep, voffB); G_STAGE(G_SA(1, 0), a02 + kstep, vA0);
            G_WAIT_V(8); G_WAIT_L(0); G_BAR; G_MMA(1, 0, At, B0); G_MMA(1, 1, At, B1); G_BAR; G_SCHED;
        }
        if (wr == 0) G_BAR;
        { int fr2 = fr, fq2 = fq; asm volatile("" : "+v"(fr2), "+v"(fq2));
          E(acc, cur, lds, wr, wc, fr2, fq2); }
        if (!has_next) break;
#pragma unroll
        for (int a = 0; a < 2; ++a)
#pragma unroll
            for (int b = 0; b < 2; ++b)
#pragma unroll
                for (int m = 0; m < 4; ++m)
#pragma unroll
                    for (int n = 0; n < 2; ++n) acc[a][b][m][n] = (acc_t){0, 0, 0, 0};
        cur = nxt; ++ui;
        if (wr == 1) G_BAR;
    }
    G_WAIT_V(0);
    G_BAR;
#undef G_SA
#undef G_SB
#undef G_STAGE
#undef G_LDA
#undef G_LDB
#undef G_MMA
#undef G_WAIT_V
#undef G_WAIT_L
#undef G_BAR
#undef G_SCHED
#undef vA0
#undef vA1
}
}
using gm::Unit;
typedef f32x4 Acc[2][2][4][2];
typedef i32x4 AccI[2][2][4][2];

struct Args { const float* in[18]; float* out; unsigned char* ws; int ph_lo, ph_hi; };
struct Frame {
    LAS unsigned char* lds; unsigned char* ws; unsigned* ctl;
    int tid, lane, wave, vcu, G;
    const float *x, *ln0_g, *ln0_b, *w_in, *dec_f, *dec_b, *gn_g, *w_out, *ln1_g, *ln1_b, *w_r, *b_r, *w_up, *b_up, *w_dn, *b_dn, *ln2_g, *ln2_b;
    float* out;
};
#define WSP(T_, off) ((T_*)(F.ws + (off)))

template <class ColMap>
__device__ __forceinline__ void transpose_item(const float* W, int K, int N, bf16* WT, LAS float* scr, int item, int lane, const ColMap& cm) {
    const int nblk = N / 64, kb = item / nblk, nb = item % nblk, k0 = 64 * kb, n0 = 64 * nb;
    const int s0 = cm(n0);
#pragma unroll 4
    for (int i = 0; i < 16; ++i) { const int kk = 4 * i + (lane >> 4), c4 = (lane & 15) * 4;
        const f32x4 v = *(const GAS f32x4*)(W + (size_t)(k0 + kk) * N + s0 + c4);
        LAS float* d = scr + kk * 65 + c4; d[0] = v[0]; d[1] = v[1]; d[2] = v[2]; d[3] = v[3]; }
    LDS_WAIT(); asm volatile("" ::: "memory");
    const int c = lane & 7;
#pragma unroll
    for (int j = 0; j < 8; ++j) { const int n = (lane >> 3) + 8 * j; const LAS float* s = scr + (8 * c) * 65 + n;
        v4u o; o.x = cvt_pk_bf16(s[0 * 65], s[1 * 65]); o.y = cvt_pk_bf16(s[2 * 65], s[3 * 65]); o.z = cvt_pk_bf16(s[4 * 65], s[5 * 65]); o.w = cvt_pk_bf16(s[6 * 65], s[7 * 65]);
        *(GAS v4u*)(WT + (size_t)(n0 + n) * K + k0 + 8 * c) = o; }
    LDS_WAIT(); asm volatile("" ::: "memory");
}
struct ColId { __device__ __forceinline__ int operator()(int n) const { return n; } };
struct ColUp { __device__ __forceinline__ int operator()(int n) const { return ((n >> 8) * 128 + (n & 127)) + ((n >> 7) & 1) * 2048; } };

__device__ __forceinline__ void p0_prologue(Frame& F) {
    const int gw = F.vcu * NWAVES + F.wave, NGW = F.G * NWAVES;
    {
        bf16* h0b = WSP(bf16, WS_H0B); float* st0 = WSP(float, WS_ST0);
        for (int m = gw; m < T; m += NGW) {
            const GAS f32x4* xr = (const GAS f32x4*)(F.x + (size_t)m * D) + F.lane;
            f32x4 v[8]; float s = 0.f;
#pragma unroll
            for (int j = 0; j < 8; ++j) { v[j] = xr[64 * j]; s += (v[j][0] + v[j][1]) + (v[j][2] + v[j][3]); }
            const float mean = wave_sum(s) * (1.f / D); float s2 = 0.f;
#pragma unroll
            for (int j = 0; j < 8; ++j) { v[j] = v[j] - mean; s2 += (v[j][0] * v[j][0] + v[j][1] * v[j][1]) + (v[j][2] * v[j][2] + v[j][3] * v[j][3]); }
            const float rstd = 1.f / sqrtf(wave_sum(s2) * (1.f / D) + LN_EPS);
            GAS v2u* o8 = (GAS v2u*)(h0b + (size_t)m * D) + F.lane;
#pragma unroll
            for (int j = 0; j < 8; ++j) { const f32x4 g = *((const GAS f32x4*)F.ln0_g + F.lane + 64 * j), b = *((const GAS f32x4*)F.ln0_b + F.lane + 64 * j);
                const f32x4 h = v[j] * rstd * g + b; v2u w; w.x = cvt_pk_bf16(h[0], h[1]); w.y = cvt_pk_bf16(h[2], h[3]); o8[64 * j] = w; }
            if (F.lane == 0) { st0[2 * m] = mean; st0[2 * m + 1] = rstd; }
        }
    }
    {
        bf16* tab = WSP(bf16, WS_TAB);
        for (int i = (F.vcu * NTHR + F.tid); i < 32768 + 65536 + 65536; i += F.G * NTHR) {
            float v;
            if (i < 32768) { const int r = i >> 7, a = i & 127, ri = r >> 7, k1 = r & 127; float c, s; cs_rev((float)((k1 * a) & 127) * (1.f / 128.f), c, s); v = ri ? -s : c; }
            else if (i < 32768 + 65536) { const int e = i - 32768, r = e >> 8, q = e & 255, ri = r >> 7, k2 = r & 127, rj = q >> 7, b = q & 127; float c, s; cs_rev((float)((k2 * b) & 127) * (1.f / 128.f), c, s);
                v = (ri == 0) ? (rj == 0 ? c : s) : (rj == 0 ? -s : c); }
            else { const int e = i - 32768 - 65536, l = e >> 8, q = e & 255, rj = q >> 7, cg = q & 127; float c, s; cs_rev((float)((l * cg) & 127) * (1.f / 128.f), c, s); v = (l < 128) ? (rj == 0 ? c : s) : 0.f; }
            tab[i] = (bf16)(cvt_pk_bf16(v, 0.f) & 0xffffu);
        }
    }
    {
        LAS float* scr = (LAS float*)(F.lds + F.wave * 18432);
        constexpr int I_IN = 32 * (DIN / 64), I_OUT = 32 * (D / 64), I_UP = 32 * (2 * DFF / 64), I_DN = 32 * (D / 64);
        constexpr int NIT = I_IN + I_OUT;
        for (int it = gw; it < NIT; it += NGW) {
            int r = it;
            if (r < I_IN) { transpose_item(F.w_in, D, DIN, WSP(bf16, WS_WIN), scr, r, F.lane, ColId()); continue; } r -= I_IN;
            { transpose_item(F.w_out, D, D, WSP(bf16, WS_WOUT), scr, r, F.lane, ColId()); }
        }
    }
}

struct SlabDesc { const float* W; signed char* WQ; float* sw; int NS, e, n0, valid; };
struct QF { unsigned char* ws; const float* w_up; const float* w_dn; int vcu, G; };
__device__ __forceinline__ SlabDesc slab_desc(const QF& F, int j) {
    const int nU = (NE * 128 + F.G - 1) / F.G; SlabDesc d;
    if (j < nU) { const int sl = F.vcu + j * F.G; d.valid = sl < NE * 128; d.NS = 2 * DFF; d.e = sl >> 7; d.n0 = (sl & 127) * 32; d.W = F.w_up + (size_t)d.e * D * 2 * DFF + ColUp()(d.n0); d.WQ = (signed char*)WSP(char, WS_WUP); d.sw = WSP(float, WS_SWUP); }
    else { const int sl = F.vcu + (j - nU) * F.G; d.valid = sl < NE * 64; d.NS = D; d.e = sl >> 6; d.n0 = (sl & 63) * 32; d.W = F.w_dn + (size_t)d.e * DFF * D + d.n0; d.WQ = (signed char*)WSP(char, WS_WDN); d.sw = WSP(float, WS_SWDN); }
    return d;
}
#define SLAB_LOAD(dsc, v) do { if ((dsc).valid) { const GAS char* b_ = (const GAS char*)(dsc).W; unsigned o_ = (unsigned)((wave * 256 + kq) * (dsc).NS + c4) * 4u; const unsigned st_ = (unsigned)(dsc).NS * 32u; \
    _Pragma("unroll") for (int i_ = 0; i_ < 32; ++i_) { v[i_] = __builtin_nontemporal_load((const GAS f32x4*)(b_ + o_)); o_ += st_; } } } while (0)
__device__ __forceinline__ void do_slabs_impl(LAS unsigned char* lds, unsigned char* ws, const float* w_up, const float* w_dn, int vcu, int G, int j0, int j1) {
    if (j0 >= j1) return;
    QF F; F.ws = ws; F.w_up = w_up; F.w_dn = w_dn; F.vcu = vcu; F.G = G;
    const int tid = threadIdx.x, lane = tid & 63, wave = __builtin_amdgcn_readfirstlane(tid >> 6);
    constexpr int PITCH = 2056;
    LAS bf16* slab = (LAS bf16*)lds;
    LAS float* red = (LAS float*)(lds + 32 * PITCH * 2);
    const int kq = lane >> 3, c4 = (lane & 7) * 4;
    f32x4 v[32];
    SlabDesc cur = slab_desc(F, j0);
    SLAB_LOAD(cur, v);
    for (int j = j0; j < j1; ++j) {
        if (cur.valid) {
            f32x4 mx = (f32x4){0.f, 0.f, 0.f, 0.f};
#pragma unroll
            for (int i = 0; i < 32; ++i) { const int k = wave * 256 + i * 8 + kq; const f32x4 x = v[i];
                mx[0] = fmaxf(mx[0], fabsf(x[0])); mx[1] = fmaxf(mx[1], fabsf(x[1])); mx[2] = fmaxf(mx[2], fabsf(x[2])); mx[3] = fmaxf(mx[3], fabsf(x[3]));
                const unsigned p01 = cvt_pk_bf16(x[0], x[1]), p23 = cvt_pk_bf16(x[2], x[3]);
                slab[(c4 + 0) * PITCH + k] = (bf16)(p01 & 0xffffu); slab[(c4 + 1) * PITCH + k] = (bf16)(p01 >> 16); slab[(c4 + 2) * PITCH + k] = (bf16)(p23 & 0xffffu); slab[(c4 + 3) * PITCH + k] = (bf16)(p23 >> 16); }
#pragma unroll
            for (int q = 0; q < 4; ++q) { float m = mx[q]; m = fmaxf(m, __shfl_xor(m, 8)); m = fmaxf(m, __shfl_xor(m, 16)); m = fmaxf(m, __shfl_xor(m, 32)); mx[q] = m; }
            if (lane < 8) { LAS float* d = red + wave * 32 + c4; d[0] = mx[0]; d[1] = mx[1]; d[2] = mx[2]; d[3] = mx[3]; }
        }
        __syncthreads();
        if (cur.valid && tid < 32) { float m = 0.f;
#pragma unroll
            for (int w = 0; w < 8; ++w) m = fmaxf(m, red[w * 32 + tid]);
            const float sc = m > 0.f ? m * (1.f / 127.f) : 1.f; cur.sw[(size_t)cur.e * cur.NS + cur.n0 + tid] = sc; red[256 + tid] = 1.f / sc; }
        __syncthreads();
        const SlabDesc done = cur;
        if (j + 1 < j1) { cur = slab_desc(F, j + 1); SLAB_LOAD(cur, v); }
        if (done.valid) {
#pragma unroll 2
            for (int i = 0; i < 8; ++i) { const int q = tid + NTHR * i, n = q >> 7, kc = q & 127; const float inv = red[256 + n];
                const v4u a = *(const LAS v4u*)(slab + n * PITCH + kc * 16), b = *(const LAS v4u*)(slab + n * PITCH + kc * 16 + 8);
                const unsigned src[8] = {a.x, a.y, a.z, a.w, b.x, b.y, b.z, b.w}; unsigned o[4];
#pragma unroll
                for (int d = 0; d < 4; ++d) { unsigned w = 0u;
#pragma unroll
                    for (int h2 = 0; h2 < 2; ++h2) { const unsigned u2 = src[2 * d + h2]; const int q0 = (int)__builtin_rintf(bf_lo(u2) * inv), q1 = (int)__builtin_rintf(bf_hi(u2) * inv);
                        w |= ((unsigned)(q0 & 0xff) << (16 * h2)) | ((unsigned)(q1 & 0xff) << (16 * h2 + 8)); }
                    o[d] = w; }
                *(GAS v4u*)(done.WQ + ((size_t)done.e * done.NS + done.n0 + n) * D + kc * 16) = (v4u){o[0], o[1], o[2], o[3]}; }
        }
        __syncthreads();
    }
}

__device__ __forceinline__ void do_slabs(Frame& F, int j0, int j1) { do_slabs_impl(F.lds, F.ws, F.w_up, F.w_dn, F.vcu, F.G, j0, j1); }

struct SchedBase { int nt, pitchA, pitchB, multA, multB, G, c; };
struct SchedG1N : SchedBase {
    const char* A; const char* Bt;
    __device__ __forceinline__ bool next(int i, Unit& u) const { const int L = i * G + c; if (L >= 64 * 12) return false; int pm, pn; gm::tile_order(L, 64, 12, pm, pn);
        const int cb = pn < 4 ? 1024 + 256 * pn : (pn < 8 ? 2048 + 256 * (pn - 4) : 4096 + 256 * (pn - 8));
        u.a0 = A + (size_t)pm * 256 * D * 2; u.a1 = u.a0 + (size_t)128 * D * 2; u.b0 = Bt + (size_t)cb * D * 2; u.b1 = u.b0 + (size_t)128 * D * 2; u.p0 = pm; u.p1 = pn; u.p2 = 0; u.p3 = 0; return true; }
};
struct SchedG1SF : SchedBase {
    const char* A; const char* Bt;
    __device__ __forceinline__ bool next(int i, Unit& u) const { const int L = i * G + c; if (L >= 4 * 64) return false; int pm, pn; gm::tile_order(L, 4, 64, pm, pn);
        u.a0 = A + (size_t)pm * 256 * D * 2; u.a1 = u.a0 + (size_t)128 * D * 2; u.b0 = Bt + (size_t)(2 * pn) * D * 2; u.b1 = u.b0 + (size_t)D * 2; u.p0 = pm; u.p1 = pn; u.p2 = 0; u.p3 = 0; return true; }
};
struct SchedG1SKV : SchedBase {
    const char* A; const char* Bt;
    __device__ __forceinline__ bool next(int i, Unit& u) const { const int L = i * G + c; if (L >= 8 * 64) return false; int pm, pn; gm::tile_order(L, 8, 64, pm, pn);
        const int rb = pm < 4 ? 2048 + 256 * pm : 3072 + 256 * (pm - 4);
        u.a0 = A + (size_t)rb * D * 2; u.a1 = u.a0 + (size_t)128 * D * 2; u.b0 = Bt + (size_t)pn * 256 * D * 2; u.b1 = u.b0 + (size_t)128 * D * 2; u.p0 = pm; u.p1 = pn; u.p2 = 0; u.p3 = 0; return true; }
};
struct SchedFixA : SchedBase {
    const char* A; const char* Bt; int ncol;
    __device__ __forceinline__ bool next(int i, Unit& u) const { const int L = i * G + c; if (L >= ncol) return false;
        u.a0 = A; u.a1 = A + (size_t)128 * pitchA * 2; u.b0 = Bt + (size_t)L * 256 * pitchB * 2; u.b1 = u.b0 + (size_t)128 * pitchB * 2; u.p0 = 0; u.p1 = L; u.p2 = 0; u.p3 = 0; return true; }
};
struct SchedFixB : SchedBase {
    const char* A; const char* Bt; int nrow;
    __device__ __forceinline__ bool next(int i, Unit& u) const { const int L = i * G + c; if (L >= nrow) return false;
        u.a0 = A + (size_t)L * 256 * pitchA * 2; u.a1 = u.a0 + (size_t)128 * pitchA * 2; u.b0 = Bt; u.b1 = Bt + (size_t)128 * pitchB * 2; u.p0 = L; u.p1 = 0; u.p2 = 0; u.p3 = 0; return true; }
};
struct SchedScores : SchedBase {
    const char* Q; const char* Kk;
    __device__ __forceinline__ bool next(int i, Unit& u) const { const int L = i * G + c; if (L >= NH * NCH) return false; const int h = L & 3, n = L >> 2;
        u.a0 = Q + ((size_t)n * 256 * RW + h * HD) * 2; u.a1 = u.a0 + (size_t)128 * RW * 2; u.b0 = Kk + ((size_t)n * 256 * RW + h * HD) * 2; u.b1 = u.b0 + (size_t)128 * RW * 2; u.p0 = h; u.p1 = n; u.p2 = 0; u.p3 = 0; return true; }
};
struct SchedKV : SchedBase {
    const char* Bcat; const char* kTw;
    __device__ __forceinline__ bool next(int i, Unit& u) const { const int L = i * G + c; if (L >= 2 * NH * NCH) return false; const int dh = L & 7, n = L >> 3, dir = dh >> 2, h = dh & 3;
        u.a0 = Bcat + ((size_t)(h * NCH + n) * 256 * CAT) * 2; u.a1 = u.a0 + (size_t)128 * CAT * 2;
        u.b0 = kTw + (((size_t)dir * RW + h * HD) * T + (size_t)n * 256) * 2; u.b1 = u.b0 + (size_t)128 * T * 2; u.p0 = dh; u.p1 = n; u.p2 = 0; u.p3 = 0; return true; }
};
struct SchedOut : SchedBase {
    const char* Acat; const char* Bcat;
    __device__ __forceinline__ bool next(int i, Unit& u) const { const int L = i * G + c; if (L >= NH * NCH) return false; const int h = L & 3, n = L >> 2;
        u.a0 = Acat + ((size_t)h * T + (size_t)n * 256) * CAT * 2; u.a1 = u.a0 + (size_t)128 * CAT * 2; u.b0 = Bcat + ((size_t)(h * NCH + n) * 256 * CAT) * 2; u.b1 = u.b0 + (size_t)128 * CAT * 2; u.p0 = h; u.p1 = n; u.p2 = 0; u.p3 = 0; return true; }
};
struct Sched2D : SchedBase {
    const char* A; const char* Bt; int nM, nN;
    __device__ __forceinline__ bool next(int i, Unit& u) const { const int L = i * G + c; if (L >= nM * nN) return false; int pm, pn; gm::tile_order(L, nM, nN, pm, pn);
        u.a0 = A + (size_t)pm * 256 * pitchA * 2; u.a1 = u.a0 + (size_t)128 * pitchA * 2; u.b0 = Bt + (size_t)pn * 256 * pitchB * 2; u.b1 = u.b0 + (size_t)128 * pitchB * 2; u.p0 = pm; u.p1 = pn; u.p2 = 0; u.p3 = 0; return true; }
};
struct SchedMoE : SchedBase {
    const char* A; const char* Bt; const LAS int* tstart; const int* row_tok; const unsigned* cnt; int nN, rowbytes; size_t estride;
    __device__ __forceinline__ bool next(int i, Unit& u) const { const int RT = __builtin_amdgcn_readfirstlane(tstart[NE]); const int L = i * G + c; if (L >= RT * nN) return false; int rt, pn; gm::tile_order(L, RT, nN, rt, pn);
        int e = 0;
        for (int j = 1; j < NE; ++j) e += (__builtin_amdgcn_readfirstlane(tstart[j]) <= rt) ? 1 : 0;
        u.b0 = Bt + (size_t)e * estride + (size_t)pn * 256 * rowbytes; u.b1 = u.b0 + (size_t)128 * rowbytes;
        u.a0 = A; u.a1 = A;
        u.p0 = rt; u.p1 = pn; u.p2 = e; u.p3 = (rt - __builtin_amdgcn_readfirstlane(tstart[e])) * 256; return true; }
    __device__ __forceinline__ unsigned row_off(const Unit& u, int r) const { const int n = (int)cnt[64 * u.p2]; int pos = u.p3 + r; pos = pos < n ? pos : n - 1;
        const int tok = row_tok[(size_t)u.p2 * T + pos]; return (unsigned)tok * (unsigned)rowbytes; }
};
struct SchedMoEDown : SchedMoE {
    __device__ __forceinline__ bool next(int i, Unit& u) const { if (!SchedMoE::next(i, u)) return false; u.a0 = A + (size_t)u.p0 * 256 * rowbytes; u.a1 = u.a0 + (size_t)128 * rowbytes; return true; }
};

#define EPI_LOOP_AM for (int ai = 0; ai < 2; ++ai) _Pragma("unroll") for (int m = 0; m < 4; ++m)
#define EPI_FENCE __builtin_amdgcn_sched_barrier(0)
struct EpiG1N {
    static constexpr bool PERM = true;
    bf16 *qs, *kk, *gs, *Acat; const float *dec_f, *dec_b;
    __device__ __forceinline__ void operator()(Acc& acc, const Unit& u, LAS unsigned char*, int wr, int wc, int fr, int fq) const {
        const int pm = u.p0, pn = u.p1, c0 = wc * 32 + 8 * fq;
        if (pn < 8) {
            const int h = pn & 3; const bool isq = pn < 4;
            float inv[8];
#pragma unroll
            for (int e = 0; e < 8; ++e) inv[e] = __builtin_amdgcn_exp2f(-(float)(c0 + e) * (13.287712379549449f / 128.f)) * 0.15915494309189535f;
            const float lgf = -fexp(dec_f[h]), lgb = -fexp(dec_b[h]);
#pragma unroll
            EPI_LOOP_AM {
                const int r = 128 * ai + 64 * wr + 16 * m + fr, tok = pm * 256 + r; const float pos = (float)tok;
                f32x4 o1[2], o2[2];
#pragma unroll
                for (int n = 0; n < 2; ++n)
#pragma unroll
                    for (int j = 0; j < 4; ++j) { float c, s; cs_rev(pos * inv[4 * n + j], c, s); const float x1 = acc[ai][0][m][n][j], x2 = acc[ai][1][m][n][j]; o1[n][j] = x1 * c - x2 * s; o2[n][j] = x2 * c + x1 * s; }
                if (isq) {
                    bf16* q = qs + (size_t)tok * RW + h * HD + c0; *(GAS v4u*)q = pack8(o1[0], o1[1]); *(GAS v4u*)(q + 128) = pack8(o2[0], o2[1]);
                    const int il = r; const float wf = fexp(lgf * (float)(il + 1)), wb = fexp(lgb * (float)(255 - il));
                    bf16* a = Acat + ((size_t)h * T + tok) * CAT + c0;
                    *(GAS v4u*)(a + 256) = pack8(o1[0] * wf, o1[1] * wf); *(GAS v4u*)(a + 384) = pack8(o2[0] * wf, o2[1] * wf);
                    *(GAS v4u*)(a + 512) = pack8(o1[0] * wb, o1[1] * wb); *(GAS v4u*)(a + 640) = pack8(o2[0] * wb, o2[1] * wb);
                } else {
                    bf16* k = kk + (size_t)tok * RW + h * HD + c0; *(GAS v4u*)k = pack8(o1[0] * 0.0625f, o1[1] * 0.0625f); *(GAS v4u*)(k + 128) = pack8(o2[0] * 0.0625f, o2[1] * 0.0625f);
                }
            }
        } else {
#pragma unroll
            EPI_LOOP_AM {
                const int r = 128 * ai + 64 * wr + 16 * m + fr, tok = pm * 256 + r;
#pragma unroll
                for (int bj = 0; bj < 2; ++bj) { f32x4 v[2];
#pragma unroll
                    for (int n = 0; n < 2; ++n)
#pragma unroll
                        for (int j = 0; j < 4; ++j) { const float g = acc[ai][bj][m][n][j]; v[n][j] = g * __builtin_amdgcn_rcpf(1.f + fexp(-g)); }
                    *(GAS v4u*)(gs + (size_t)tok * RW + (pn - 8) * 256 + bj * 128 + c0) = pack8(v[0], v[1]); }
            }
        }
    }
};
struct EpiG1SF {
    static constexpr bool PERM = true;
    bf16* uTT;
    __device__ __forceinline__ void operator()(Acc& acc, const Unit& u, LAS unsigned char*, int wr, int wc, int fr, int fq) const {
        const int a0 = wc * 32 + 8 * fq;
#pragma unroll
        EPI_LOOP_AM { const int cch = u.p0 * 256 + 128 * ai + 64 * wr + 16 * m + fr;
#pragma unroll
            for (int bj = 0; bj < 2; ++bj) *(GAS v4u*)(uTT + ((size_t)cch * 128 + (2 * u.p1 + bj)) * 128 + a0) = pack8(acc[ai][bj][m][0], acc[ai][bj][m][1]); }
    }
};
struct EpiG1SKV {
    static constexpr bool PERM = true;
    bf16 *kTw, *Bcat; const float *dec_f, *dec_b;
    __device__ __forceinline__ void operator()(Acc& acc, const Unit& u, LAS unsigned char*, int wr, int wc, int fr, int fq) const {
        const int pm = u.p0, n_ch = u.p1, c0 = wc * 32 + 8 * fq;
        if (pm < 4) {
            const int h = pm; const float lgf = -fexp(dec_f[h]), lgb = -fexp(dec_b[h]);
#pragma unroll
            for (int m = 0; m < 4; ++m) {
                const int d = 64 * wr + 16 * m + fr;
                const float inv = __builtin_amdgcn_exp2f(-(float)d * (13.287712379549449f / 128.f)) * 0.15915494309189535f;
#pragma unroll
                for (int bj = 0; bj < 2; ++bj) {
                    f32x4 f1[2], f2[2], b1[2], b2[2];
#pragma unroll
                    for (int n = 0; n < 2; ++n)
#pragma unroll
                        for (int j = 0; j < 4; ++j) { const int il = 128 * bj + c0 + 4 * n + j; const float pos = (float)(n_ch * 256 + il); float c, s; cs_rev(pos * inv, c, s);
                            const float x1 = acc[0][bj][m][n][j], x2 = acc[1][bj][m][n][j]; const float o1 = (x1 * c - x2 * s) * 0.0625f, o2 = (x2 * c + x1 * s) * 0.0625f;
                            const float wf = fexp(lgf * (float)(255 - il)), wb = fexp(lgb * (float)(il + 1));
                            f1[n][j] = o1 * wf; f2[n][j] = o2 * wf; b1[n][j] = o1 * wb; b2[n][j] = o2 * wb; }
                    const size_t tcol = (size_t)n_ch * 256 + 128 * bj + c0;
                    bf16* pf = kTw + ((size_t)(h * HD + d)) * T + tcol; bf16* pb = pf + (size_t)RW * T;
                    *(GAS v4u*)pf = pack8(f1[0], f1[1]); *(GAS v4u*)(pf + (size_t)128 * T) = pack8(f2[0], f2[1]);
                    *(GAS v4u*)pb = pack8(b1[0], b1[1]); *(GAS v4u*)(pb + (size_t)128 * T) = pack8(b2[0], b2[1]);
                }
            }
        } else {
            const int h = pm - 4;
#pragma unroll
            EPI_LOOP_AM { const int dv = 128 * ai + 64 * wr + 16 * m + fr;
#pragma unroll
                for (int bj = 0; bj < 2; ++bj) *(GAS v4u*)(Bcat + ((size_t)(h * NCH + n_ch) * 256 + dv) * CAT + 128 * bj + c0) = pack8(acc[ai][bj][m][0], acc[ai][bj][m][1]); }
        }
    }
};
struct EpiS1 {
    static constexpr bool PERM = true;
    bf16* A1;
    __device__ __forceinline__ void operator()(Acc& acc, const Unit& u, LAS unsigned char*, int wr, int wc, int fr, int fq) const {
        const int b0 = wc * 32 + 8 * fq;
#pragma unroll
        for (int m = 0; m < 4; ++m) { const int k1 = 64 * wr + 16 * m + fr;
#pragma unroll
            for (int bj = 0; bj < 2; ++bj) { const int cch = 2 * u.p1 + bj; f32x4 re[2], im[2];
#pragma unroll
                for (int n = 0; n < 2; ++n)
#pragma unroll
                    for (int j = 0; j < 4; ++j) { const int b = b0 + 4 * n + j; float c, s; cs_rev((float)(k1 * b) * (1.f / 16384.f), c, s);
                        const float xr = acc[0][bj][m][n][j], xi = acc[1][bj][m][n][j]; re[n][j] = xr * c + xi * s; im[n][j] = xi * c - xr * s; }
                bf16* p = A1 + (((size_t)k1 * 1024 + cch) * 2) * 128 + b0;
                *(GAS v4u*)p = pack8(re[0], re[1]); *(GAS v4u*)(p + 128) = pack8(im[0], im[1]); EPI_FENCE; } }
    }
};
struct EpiS2 {
    static constexpr bool PERM = true;
    bf16* Zt;
    __device__ __forceinline__ void operator()(Acc& acc, const Unit& u, LAS unsigned char*, int wr, int wc, int fr, int fq) const {
        const int k1 = u.p1 >> 2, cb = (u.p1 & 3) * 256, c0 = wc * 32 + 8 * fq;
#pragma unroll
        EPI_LOOP_AM { const int k2 = 64 * wr + 16 * m + fr, k = k1 + 128 * k2;
#pragma unroll
            for (int bj = 0; bj < 2; ++bj) { const int cch = cb + 128 * bj + c0, g = cch >> 7, cg = cch & 127;
                *(GAS v4u*)(Zt + (size_t)k * 2048 + g * 256 + ai * 128 + cg) = pack8(acc[ai][bj][m][0], acc[ai][bj][m][1]); } }
    }
};
struct EpiChan {
    static constexpr bool PERM = true;
    bf16* y;
    __device__ __forceinline__ void operator()(Acc& acc, const Unit& u, LAS unsigned char*, int wr, int wc, int fr, int fq) const {
        const int l0 = wc * 32 + 8 * fq; const float norm = 6.9053396600248786e-4f;
#pragma unroll
        EPI_LOOP_AM { const int R = u.p0 * 256 + 128 * ai + 64 * wr + 16 * m + fr, k = R >> 3, g = R & 7;
            *(GAS v4u*)(y + (size_t)k * D + g * 128 + l0) = pack8(acc[ai][0][m][0] * norm, acc[ai][0][m][1] * norm); }
    }
};
struct EpiScores {
    static constexpr bool PERM = true;
    bf16* Acat; const float *dec_f, *dec_b;
    __device__ __forceinline__ void operator()(Acc& acc, const Unit& u, LAS unsigned char*, int wr, int wc, int fr, int fq) const {
        const int h = u.p0, n_ch = u.p1, c0 = wc * 32 + 8 * fq; const float lgf = -fexp(dec_f[h]), lgb = -fexp(dec_b[h]);
#pragma unroll
        EPI_LOOP_AM { const int i = 128 * ai + 64 * wr + 16 * m + fr;
#pragma unroll
            for (int bj = 0; bj < 2; ++bj) { f32x4 v[2];
#pragma unroll
                for (int n = 0; n < 2; ++n)
#pragma unroll
                    for (int j = 0; j < 4; ++j) { const int jc = 128 * bj + c0 + 4 * n + j; const float dd = (float)(i - jc); const float w = (jc <= i) ? fexp(lgf * dd) : fexp(-lgb * dd); v[n][j] = acc[ai][bj][m][n][j] * w; }
                *(GAS v4u*)(Acat + ((size_t)h * T + n_ch * 256 + i) * CAT + 128 * bj + c0) = pack8(v[0], v[1]); EPI_FENCE; } }
    }
};
struct EpiKV {
    static constexpr bool PERM = false;
    float* kvT;
    __device__ __forceinline__ void operator()(Acc& acc, const Unit& u, LAS unsigned char*, int wr, int wc, int fr, int fq) const {
#pragma unroll
        EPI_LOOP_AM { const int dv = 128 * ai + 64 * wr + 16 * m + fr; float* rowp = kvT + (((size_t)u.p0 * NCH + u.p1) * 256 + dv) * 256 + wc * 32 + 4 * fq;
#pragma unroll
            for (int bj = 0; bj < 2; ++bj)
#pragma unroll
                for (int n = 0; n < 2; ++n) *(GAS f32x4*)(rowp + bj * 128 + n * 16) = acc[ai][bj][m][n]; }
    }
};
struct EpiOut {
    static constexpr bool PERM = true;
    bf16* y; const bf16* gs; const float* gn_g;
    __device__ __forceinline__ void operator()(Acc& acc, const Unit& u, LAS unsigned char* lds, int wr, int wc, int fr, int fq) const {
        const int h = u.p0, n_ch = u.p1, c0 = wc * 32 + 8 * fq;
        LAS f32x2* P = (LAS f32x2*)(lds + LDS_STAGE);
#pragma unroll
        EPI_LOOP_AM {
            float s = 0.f;
#pragma unroll
            for (int bj = 0; bj < 2; ++bj)
#pragma unroll
                for (int n = 0; n < 2; ++n) { const f32x4 x = acc[ai][bj][m][n]; s += (x[0] + x[1]) + (x[2] + x[3]); }
            s += __shfl_xor(s, 16); s += __shfl_xor(s, 32);
            const float mw = s * (1.f / 64.f); float q = 0.f;
#pragma unroll
            for (int bj = 0; bj < 2; ++bj)
#pragma unroll
                for (int n = 0; n < 2; ++n) { const f32x4 d = acc[ai][bj][m][n] - mw; q += (d[0] * d[0] + d[1] * d[1]) + (d[2] * d[2] + d[3] * d[3]); }
            q += __shfl_xor(q, 16); q += __shfl_xor(q, 32);
            if (fq == 0) P[(128 * ai + 64 * wr + 16 * m + fr) * 4 + wc] = (f32x2){mw, q};
        }
        LDS_WAIT(); __builtin_amdgcn_s_barrier(); asm volatile("" ::: "memory");
#pragma unroll
        EPI_LOOP_AM {
            const int r = 128 * ai + 64 * wr + 16 * m + fr, tok = n_ch * 256 + r;
            const f32x2 a = P[r * 4 + 0], b = P[r * 4 + 1], c = P[r * 4 + 2], d = P[r * 4 + 3];
            const float mt = (a.x + b.x + c.x + d.x) * 0.25f; const float da = a.x - mt, db = b.x - mt, dc = c.x - mt, dd = d.x - mt;
            const float m2 = (a.y + b.y) + (c.y + d.y) + 64.f * ((da * da + db * db) + (dc * dc + dd * dd));
            const float rstd = 1.f / sqrtf(m2 * (1.f / 256.f) + GN_EPS);
#pragma unroll
            for (int bj = 0; bj < 2; ++bj) {
                const int col = h * HD + 128 * bj + c0; const v4u gv = *(const GAS v4u*)(gs + (size_t)tok * RW + col);
                const f32x4 g0 = *(const GAS f32x4*)(gn_g + col), g1 = *(const GAS f32x4*)(gn_g + col + 4);
                f32x4 o0 = (acc[ai][bj][m][0] - mt) * rstd * g0, o1 = (acc[ai][bj][m][1] - mt) * rstd * g1;
                o0[0] *= bf_lo(gv.x); o0[1] *= bf_hi(gv.x); o0[2] *= bf_lo(gv.y); o0[3] *= bf_hi(gv.y); o1[0] *= bf_lo(gv.z); o1[1] *= bf_hi(gv.z); o1[2] *= bf_lo(gv.w); o1[3] *= bf_hi(gv.w);
                *(GAS v4u*)(y + (size_t)tok * D + FW + col) = pack8(o0, o1); }
        }
        LDS_WAIT(); __builtin_amdgcn_s_barrier(); asm volatile("" ::: "memory");
    }
};
struct EpiWout {
    static constexpr bool PERM = false;
    float* z1; const float *x, *st0, *g0, *b0;
    __device__ __forceinline__ void operator()(Acc& acc, const Unit& u, LAS unsigned char*, int wr, int wc, int fr, int fq) const {
        const int colb = u.p1 * 256 + wc * 32 + 4 * fq;
#pragma unroll
        EPI_LOOP_AM { const int row = u.p0 * 256 + 128 * ai + 64 * wr + 16 * m + fr; const f32x2 st = *(const GAS f32x2*)(st0 + 2 * row);
#pragma unroll
            for (int bj = 0; bj < 2; ++bj)
#pragma unroll
                for (int n = 0; n < 2; ++n) { const int col = colb + bj * 128 + n * 16; const size_t off = (size_t)row * D + col;
                    const f32x4 xv = *(const GAS f32x4*)(x + off), g = *(const GAS f32x4*)(g0 + col), b = *(const GAS f32x4*)(b0 + col);
                    *(GAS f32x4*)(z1 + off) = ((xv - st.x) * st.y * g + b) * ALPHA + acc[ai][bj][m][n]; } }
    }
};
struct EpiUp {
    static constexpr bool PERM = true;
    bf16* act; const float *b_up, *swup, *rsc; const unsigned* cnt; unsigned* rmax;
    __device__ __forceinline__ void operator()(AccI& acc, const Unit& u, LAS unsigned char*, int wr, int wc, int fr, int fq) const {
        const int rt = u.p0, pn = u.p1, e = u.p2, c0 = pn * 128 + wc * 32 + 8 * fq; const int ne = (int)cnt[64 * e];
        float sx[2][4], rm[2][4];
#pragma unroll
        for (int a2 = 0; a2 < 2; ++a2)
#pragma unroll
            for (int m2 = 0; m2 < 4; ++m2) rm[a2][m2] = 0.f;
#pragma unroll
        EPI_LOOP_AM { int pos = u.p3 + 128 * ai + 64 * wr + 16 * m + fr; pos = pos < ne ? pos : ne - 1; sx[ai][m] = rsc[(size_t)e * T + pos]; }
#pragma unroll
        for (int n = 0; n < 2; ++n) {
            const float* bu = b_up + (size_t)e * 2 * DFF + c0 + 4 * n; const float* sw = swup + (size_t)e * 2 * DFF + pn * 256 + wc * 32 + 8 * fq + 4 * n;
            const f32x4 bg = *(const GAS f32x4*)bu, bl = *(const GAS f32x4*)(bu + DFF), sg = *(const GAS f32x4*)sw, sl = *(const GAS f32x4*)(sw + 128);
#pragma unroll
            EPI_LOOP_AM { const int r = 128 * ai + 64 * wr + 16 * m + fr; f32x4 v;
#pragma unroll
                for (int j = 0; j < 4; ++j) { float gl = (float)acc[ai][0][m][n][j] * (sx[ai][m] * sg[j]) + bg[j], li = (float)acc[ai][1][m][n][j] * (sx[ai][m] * sl[j]) + bl[j];
                    gl = fminf(gl, 7.f); li = fminf(fmaxf(li, -7.f), 7.f); v[j] = gl * __builtin_amdgcn_rcpf(1.f + fexp(-1.702f * gl)) * (li + 1.f); }
                rm[ai][m] = fmaxf(rm[ai][m], fmaxf(fmaxf(fabsf(v[0]), fabsf(v[1])), fmaxf(fabsf(v[2]), fabsf(v[3]))));
                v2u w; w.x = cvt_pk_bf16(v[0], v[1]); w.y = cvt_pk_bf16(v[2], v[3]);
                *(GAS v2u*)(act + ((size_t)rt * 256 + r) * DFF + c0 + 4 * n) = w; }
        }
#pragma unroll
        EPI_LOOP_AM { float q = rm[ai][m]; q = fmaxf(q, __shfl_xor(q, 16)); q = fmaxf(q, __shfl_xor(q, 32));
            if (fq == 0) __hip_atomic_fetch_max(rmax + rt * 256 + 128 * ai + 64 * wr + 16 * m + fr, __float_as_uint(q), RLX_AGENT); }
    }
};
struct EpiDown {
    static constexpr bool PERM = true;
    bf16* yr; const float *b_dn, *swdn, *sa;
    __device__ __forceinline__ void operator()(AccI& acc, const Unit& u, LAS unsigned char*, int wr, int wc, int fr, int fq) const {
        const int rt = u.p0, pn = u.p1, e = u.p2, c0 = pn * 256 + wc * 32 + 8 * fq;
        float sr[2][4];
#pragma unroll
        EPI_LOOP_AM sr[ai][m] = sa[rt * 256 + 128 * ai + 64 * wr + 16 * m + fr];
#pragma unroll
        for (int bj = 0; bj < 2; ++bj) { const float* bd = b_dn + (size_t)e * D + c0 + 128 * bj; const float* sw = swdn + (size_t)e * D + c0 + 128 * bj;
            const f32x4 b0 = *(const GAS f32x4*)bd, b1 = *(const GAS f32x4*)(bd + 4), w0 = *(const GAS f32x4*)sw, w1 = *(const GAS f32x4*)(sw + 4);
#pragma unroll
            EPI_LOOP_AM { const int r = 128 * ai + 64 * wr + 16 * m + fr; f32x4 o0, o1;
#pragma unroll
                for (int j = 0; j < 4; ++j) { o0[j] = (float)acc[ai][bj][m][0][j] * (sr[ai][m] * w0[j]) + b0[j]; o1[j] = (float)acc[ai][bj][m][1][j] * (sr[ai][m] * w1[j]) + b1[j]; }
                *(GAS v4u*)(yr + ((size_t)rt * 256 + r) * D + c0 + 128 * bj) = pack8(o0, o1); } }
    }
};

__device__ __forceinline__ void p3_scan(Frame& F) {
    const float* kvT = WSP(float, WS_KVT); bf16* Bcat = WSP(bf16, WS_BCAT);
    const int NQ = 2 * NH * 256 * 64;
    for (int q = F.vcu * NTHR + F.tid; q < NQ; q += F.G * NTHR) {
        const int dk4 = q & 63, dv = (q >> 6) & 255, dh = q >> 14, dir = dh >> 2, h = dh & 3;
        const float lg = -fexp((dir ? F.dec_b : F.dec_f)[h]); const float cd = fexp(lg * (float)C2);
        f32x4 S = (f32x4){0.f, 0.f, 0.f, 0.f};
        for (int s = 0; s < NCH; ++s) { const int n = dir ? (NCH - 1 - s) : s;
            const f32x4 kv = *(const GAS f32x4*)(kvT + (((size_t)dh * NCH + n) * 256 + dv) * 256 + dk4 * 4);
            v2u w; w.x = cvt_pk_bf16(S[0], S[1]); w.y = cvt_pk_bf16(S[2], S[3]);
            *(GAS v2u*)(Bcat + ((size_t)(h * NCH + n) * 256 + dv) * CAT + 256 + dir * 256 + dk4 * 4) = w;
            S = S * cd + kv; }
    }
}

__device__ __forceinline__ void p6_router(Frame& F) {
    const float* z1 = WSP(float, WS_Z1); unsigned* h1q = WSP(unsigned, WS_H1Q); float* sxg = WSP(float, WS_SX); float* rsc = WSP(float, WS_RSC); float* st1 = WSP(float, WS_ST0) + 2 * T;
    int* topi = WSP(int, WS_RT); float* gate = (float*)(topi + 4 * T); int* posb = (int*)(gate + 4 * T); int* row_tok = posb + 4 * T;
    LAS float* hc = (LAS float*)F.lds;
    LAS float* wrc = hc + 64 * 257;
    LAS float* stl = wrc + 256 * 32;
    LAS float* lg = stl + 128;
    LAS int* hist = (LAS int*)(lg + 64 * 33);
    LAS float* sxl = (LAS float*)(hist + 64);
    for (int blk = F.vcu; blk < T / 64; blk += F.G) {
        const int t0 = blk * 64;
        for (int rr = 0; rr < 8; ++rr) { const int row = F.wave * 8 + rr, m = t0 + row;
            const GAS f32x4* xr = (const GAS f32x4*)(z1 + (size_t)m * D) + F.lane; f32x4 v[8]; float s = 0.f;
#pragma unroll
            for (int j = 0; j < 8; ++j) { v[j] = xr[64 * j]; s += (v[j][0] + v[j][1]) + (v[j][2] + v[j][3]); }
            const float mean = wave_sum(s) * (1.f / D); float s2 = 0.f;
#pragma unroll
            for (int j = 0; j < 8; ++j) { v[j] = v[j] - mean; s2 += (v[j][0] * v[j][0] + v[j][1] * v[j][1]) + (v[j][2] * v[j][2] + v[j][3] * v[j][3]); }
            const float rstd = 1.f / sqrtf(wave_sum(s2) * (1.f / D) + LN_EPS);
            float am = 0.f;
#pragma unroll
            for (int j = 0; j < 8; ++j) { const f32x4 g = *((const GAS f32x4*)F.ln1_g + F.lane + 64 * j), b = *((const GAS f32x4*)F.ln1_b + F.lane + 64 * j);
                v[j] = v[j] * rstd * g + b; am = fmaxf(am, fmaxf(fmaxf(fabsf(v[j][0]), fabsf(v[j][1])), fmaxf(fabsf(v[j][2]), fabsf(v[j][3])))); }
#pragma unroll
            for (int o = 1; o < 64; o <<= 1) am = fmaxf(am, __shfl_xor(am, o));
            const float sc = am > 0.f ? am * (1.f / 127.f) : 1.f, inv = 1.f / sc;
#pragma unroll
            for (int j = 0; j < 8; ++j) { const int q0 = (int)__builtin_rintf(v[j][0] * inv), q1 = (int)__builtin_rintf(v[j][1] * inv), q2 = (int)__builtin_rintf(v[j][2] * inv), q3 = (int)__builtin_rintf(v[j][3] * inv);
                h1q[(size_t)m * (D / 4) + F.lane + 64 * j] = (unsigned)(q0 & 0xff) | ((unsigned)(q1 & 0xff) << 8) | ((unsigned)(q2 & 0xff) << 16) | ((unsigned)(q3 & 0xff) << 24); }
            if (F.lane == 0) { st1[2 * m] = mean; st1[2 * m + 1] = rstd; stl[2 * row] = mean; stl[2 * row + 1] = rstd; sxg[m] = sc; sxl[row] = sc; }
        }
        if (F.tid < 64) hist[F.tid] = 0;
        __syncthreads();
        const int row = F.tid >> 3, e0 = (F.tid & 7) * 4; f32x4 accl = (f32x4){0.f, 0.f, 0.f, 0.f};
        for (int kc = 0; kc < 8; ++kc) {
            for (int i = F.tid; i < 64 * 64; i += NTHR) { const int r = i >> 6, c4 = (i & 63) * 4, col = kc * 256 + c4;
                const f32x4 zv = *(const GAS f32x4*)(z1 + (size_t)(t0 + r) * D + col), g = *(const GAS f32x4*)(F.ln1_g + col), b = *(const GAS f32x4*)(F.ln1_b + col);
                const f32x4 hh = (zv - stl[2 * r]) * stl[2 * r + 1] * g + b; LAS float* d = hc + r * 257 + c4; d[0] = hh[0]; d[1] = hh[1]; d[2] = hh[2]; d[3] = hh[3]; }
            for (int i = F.tid; i < 256 * 8; i += NTHR) { const int k = i >> 3, c4 = (i & 7) * 4; *(LAS f32x4*)(wrc + k * 32 + c4) = *(const GAS f32x4*)(F.w_r + (size_t)(kc * 256 + k) * NE + c4); }
            __syncthreads();
#pragma unroll 8
            for (int k = 0; k < 256; ++k) { const float hv = hc[row * 257 + k]; const f32x4 w = *(const LAS f32x4*)(wrc + k * 32 + e0); accl = accl + w * hv; }
            __syncthreads();
        }
        { const f32x4 br = *(const GAS f32x4*)(F.b_r + e0); LAS float* d = lg + row * 33 + e0; d[0] = accl[0] + br[0]; d[1] = accl[1] + br[1]; d[2] = accl[2] + br[2]; d[3] = accl[3] + br[3]; }
        __syncthreads();
        int ek[4] = {0, 0, 0, 0}, lp[4] = {0, 0, 0, 0}; float gk[4] = {0.f, 0.f, 0.f, 0.f};
        if (F.tid < 64) {
            float lv[4]; unsigned used = 0u;
#pragma unroll
            for (int k = 0; k < 4; ++k) { float best = -3.0e38f; int bi = 0;
                for (int e = 0; e < NE; ++e) { const float v = lg[F.tid * 33 + e]; const bool ok = !((used >> e) & 1u) && (v > best); best = ok ? v : best; bi = ok ? e : bi; }
                used |= 1u << bi; ek[k] = bi; lv[k] = best; }
            const float mx = lv[0]; float den = 0.f;
#pragma unroll
            for (int k = 0; k < 4; ++k) { gk[k] = fexp(lv[k] - mx); den += gk[k]; }
            const float rd = 1.f / den;
#pragma unroll
            for (int k = 0; k < 4; ++k) { gk[k] *= rd; lp[k] = __hip_atomic_fetch_add(&hist[ek[k]], 1, __ATOMIC_RELAXED, __HIP_MEMORY_SCOPE_WORKGROUP); }
        }
        __syncthreads();
        if (F.tid < NE) hist[32 + F.tid] = (int)__hip_atomic_fetch_add(F.ctl + CW_CNT + 64 * F.tid, (unsigned)hist[F.tid], RLX_AGENT);
        __syncthreads();
        if (F.tid < 64) { const int tok = t0 + F.tid;
#pragma unroll
            for (int k = 0; k < 4; ++k) { const int pos = hist[32 + ek[k]] + lp[k]; row_tok[(size_t)ek[k] * T + pos] = tok; rsc[(size_t)ek[k] * T + pos] = sxl[F.tid]; topi[4 * tok + k] = ek[k]; gate[4 * tok + k] = gk[k]; posb[4 * tok + k] = pos; } }
        __syncthreads();
    }
}

__device__ __forceinline__ void p8_requant(Frame& F, const LAS int* tstart) {
    const bf16* act = WSP(bf16, WS_ACT); unsigned* aq = WSP(unsigned, WS_ACTQ); float* sa = WSP(float, WS_SA); const unsigned* rmax = F.ctl + CW_RMAX;
    const int R = tstart[NE] * 256, gw = F.vcu * NWAVES + F.wave, NGW = F.G * NWAVES;
    for (int row = gw; row < R; row += NGW) {
        const float mx = __uint_as_float(rmax[row]); const float sc = mx > 0.f ? mx * (1.f / 127.f) : 1.f, inv = 1.f / sc;
#pragma unroll
        for (int j = 0; j < 2; ++j) { const int col = 16 * F.lane + 1024 * j;
            const v4u a = *(const GAS v4u*)(act + (size_t)row * DFF + col), b = *(const GAS v4u*)(act + (size_t)row * DFF + col + 8);
            const unsigned src[8] = {a.x, a.y, a.z, a.w, b.x, b.y, b.z, b.w}; unsigned o[4];
#pragma unroll
            for (int d = 0; d < 4; ++d) { unsigned w = 0u;
#pragma unroll
                for (int h2 = 0; h2 < 2; ++h2) { const unsigned u2 = src[2 * d + h2]; int q0 = (int)__builtin_rintf(bf_lo(u2) * inv), q1 = (int)__builtin_rintf(bf_hi(u2) * inv);
                    q0 = q0 > 127 ? 127 : (q0 < -127 ? -127 : q0); q1 = q1 > 127 ? 127 : (q1 < -127 ? -127 : q1);
                    w |= ((unsigned)(q0 & 0xff) << (16 * h2)) | ((unsigned)(q1 & 0xff) << (16 * h2 + 8)); }
                o[d] = w; }
            *(GAS v4u*)(aq + ((size_t)row * DFF + col) / 4) = (v4u){o[0], o[1], o[2], o[3]}; }
        if (F.lane == 0) sa[row] = sc;
    }
}

__device__ __forceinline__ void build_tstart(Frame& F, LAS int* tstart) {
    if (F.tid == 0) { int s = 0; for (int e = 0; e < NE; ++e) { tstart[e] = s; const unsigned n = __hip_atomic_load(F.ctl + CW_CNT + 64 * e, RLX_AGENT); s += (int)((n + 255u) >> 8); } tstart[NE] = s; }
    __syncthreads();
}

__device__ __forceinline__ void p9_combine(Frame& F, const LAS int* tstart) {
    const float* z1 = WSP(float, WS_Z1); const float* st1 = WSP(float, WS_ST0) + 2 * T; const bf16* yr = WSP(bf16, WS_YR);
    const int* topi = WSP(int, WS_RT); const float* gate = (const float*)(topi + 4 * T); const int* posb = (const int*)(gate + 4 * T);
    const int gw = F.vcu * NWAVES + F.wave, NGW = F.G * NWAVES;
    for (int m = gw; m < T; m += NGW) {
        const float mean1 = st1[2 * m], rstd1 = st1[2 * m + 1];
        size_t ro[4]; float gk[4];
#pragma unroll
        for (int k = 0; k < 4; ++k) { const int e = topi[4 * m + k]; ro[k] = ((size_t)tstart[e] * 256 + posb[4 * m + k]) * D; gk[k] = gate[4 * m + k]; }
        f32x4 v[8]; float s = 0.f;
#pragma unroll
        for (int j = 0; j < 8; ++j) { const int col = 4 * F.lane + 256 * j;
            const f32x4 zv = *(const GAS f32x4*)(z1 + (size_t)m * D + col), g = *(const GAS f32x4*)(F.ln1_g + col), b = *(const GAS f32x4*)(F.ln1_b + col);
            f32x4 a = ((zv - mean1) * rstd1 * g + b) * ALPHA;
#pragma unroll
            for (int k = 0; k < 4; ++k) { const v2u w = *(const GAS v2u*)(yr + ro[k] + col); a[0] += gk[k] * bf_lo(w.x); a[1] += gk[k] * bf_hi(w.x); a[2] += gk[k] * bf_lo(w.y); a[3] += gk[k] * bf_hi(w.y); }
            v[j] = a; s += (a[0] + a[1]) + (a[2] + a[3]); }
        const float mean = wave_sum(s) * (1.f / D); float s2 = 0.f;
#pragma unroll
        for (int j = 0; j < 8; ++j) { v[j] = v[j] - mean; s2 += (v[j][0] * v[j][0] + v[j][1] * v[j][1]) + (v[j][2] * v[j][2] + v[j][3] * v[j][3]); }
        const float rstd = 1.f / sqrtf(wave_sum(s2) * (1.f / D) + LN_EPS);
#pragma unroll
        for (int j = 0; j < 8; ++j) { const int col = 4 * F.lane + 256 * j; const f32x4 g = *(const GAS f32x4*)(F.ln2_g + col), b = *(const GAS f32x4*)(F.ln2_b + col);
            *(GAS f32x4*)(F.out + (size_t)m * D + col) = v[j] * rstd * g + b; }
    }
}

constexpr int NPH = 11;
__global__ void __launch_bounds__(NTHR, 2) fwd(Args args) {
    extern __shared__ __attribute__((aligned(16))) unsigned char lds_raw[];
    Frame F;
    F.lds = (LAS unsigned char*)lds_raw; F.ws = args.ws; F.ctl = (unsigned*)(args.ws + WS_CTL);
    F.tid = threadIdx.x; F.lane = F.tid & 63; F.wave = __builtin_amdgcn_readfirstlane(F.tid >> 6);
    F.G = gridDim.x; { const int bx = blockIdx.x; F.vcu = (F.G % 8 == 0) ? (bx % 8) * (F.G / 8) + bx / 8 : bx; }
    F.x = args.in[0]; F.ln0_g = args.in[1]; F.ln0_b = args.in[2]; F.w_in = args.in[3]; F.dec_f = args.in[4]; F.dec_b = args.in[5]; F.gn_g = args.in[6]; F.w_out = args.in[7];
    F.ln1_g = args.in[8]; F.ln1_b = args.in[9]; F.w_r = args.in[10]; F.b_r = args.in[11]; F.w_up = args.in[12]; F.b_up = args.in[13]; F.w_dn = args.in[14]; F.b_dn = args.in[15];
    F.ln2_g = args.in[16]; F.ln2_b = args.in[17]; F.out = args.out;
    volatile LAS unsigned* lctl = (volatile LAS unsigned*)(F.lds + LDS_CTL_OFF);
    LAS int* tstart = (LAS int*)(F.lds + LDS_CTL_OFF + 64);
    for (int u = F.tid; u < 128; u += NTHR) lctl[u] = 0u;
    __syncthreads();
    const int lo = args.ph_lo, hi = args.ph_hi;
    const bool single = (hi - lo) > 1;
    XcdBarrier bar; bar.bar = F.ctl + CW_BAR; bar.x = 0; bar.st = lctl;
    if (single) bar = xcd_barrier_post(F.ctl + CW_BAR, lctl);
#ifndef PH_MASK
#define PH_MASK 0x7ff
#endif
#define IN(k) (((PH_MASK >> (k)) & 1) && lo <= (k) && (k) < hi)
#ifndef SUB_MASK
#define SUB_MASK 0xff
#endif
#define SUB(n) ((SUB_MASK >> (n)) & 1)
#define SEAM(k) do { if (IN(k) && IN((k) + 1)) xcd_barrier(bar); } while (0)
    const int bc = (int)blockIdx.x;

    const int nS = (NE * 128 + F.G - 1) / F.G + (NE * 64 + F.G - 1) / F.G; int sdone = 0; const bool qpre = (blockIdx.x & 1) != 0;
#define QSLOT(k24) do { const int e_ = sdone + (nS * (k24) + 23) / 24; do_slabs(F, sdone, e_ < nS ? e_ : nS); sdone = e_; } while (0)
#define QPRE(k24) do { if (qpre) QSLOT(k24); } while (0)
#define QPOST(k24) do { if (!qpre) QSLOT(k24); } while (0)
    if (IN(0)) { p0_prologue(F); __syncthreads(); }
    SEAM(0);
    if (IN(1)) {
        QPRE(4);
        if (SUB(0)) { SchedG1N S; S.nt = D / 64; S.pitchA = D; S.pitchB = D; S.multA = 1; S.multB = 1; S.G = F.G; S.c = bc; S.A = (const char*)WSP(bf16, WS_H0B); S.Bt = (const char*)WSP(bf16, WS_WIN);
          EpiG1N E{WSP(bf16, WS_QS), WSP(bf16, WS_KK), WSP(bf16, WS_GS), WSP(bf16, WS_ACAT), F.dec_f, F.dec_b};
          gm::gemm_run<EpiG1N, SchedG1N, false>(F.lds, S, E); }
        QPOST(4); QPRE(4);
        if (SUB(1)) { SchedG1SF S; S.nt = D / 64; S.pitchA = D; S.pitchB = D; S.multA = 1; S.multB = 128; S.G = F.G; S.c = bc; S.A = (const char*)WSP(bf16, WS_WIN); S.Bt = (const char*)WSP(bf16, WS_H0B);
          EpiG1SF E{WSP(bf16, WS_UTT)};
          gm::gemm_run<EpiG1SF, SchedG1SF, false>(F.lds, S, E); }
        QPOST(4); QPRE(4);
        if (SUB(2)) { SchedG1SKV S; S.nt = D / 64; S.pitchA = D; S.pitchB = D; S.multA = 1; S.multB = 1; S.G = F.G; S.c = bc; S.A = (const char*)WSP(bf16, WS_WIN); S.Bt = (const char*)WSP(bf16, WS_H0B);
          EpiG1SKV E{WSP(bf16, WS_KTW), WSP(bf16, WS_BCAT), F.dec_f, F.dec_b};
          gm::gemm_run<EpiG1SKV, SchedG1SKV, false>(F.lds, S, E); }
        QPOST(4);
    }
    SEAM(1);
    if (IN(2)) {
        QPRE(2);
        if (SUB(3)) { SchedFixA S; S.nt = 2; S.pitchA = 128; S.pitchB = 128; S.multA = 1; S.multB = 1; S.G = F.G; S.c = bc; S.A = (const char*)WSP(bf16, WS_TAB); S.Bt = (const char*)WSP(bf16, WS_UTT); S.ncol = 512;
          EpiS1 E{WSP(bf16, WS_A1)};
          gm::gemm_run<EpiS1, SchedFixA, false>(F.lds, S, E); }
        QPOST(2); QPRE(2);
        if (SUB(4)) { SchedScores S; S.nt = 4; S.pitchA = RW; S.pitchB = RW; S.multA = 1; S.multB = 1; S.G = F.G; S.c = bc; S.Q = (const char*)WSP(bf16, WS_QS); S.Kk = (const char*)WSP(bf16, WS_KK);
          EpiScores E{WSP(bf16, WS_ACAT), F.dec_f, F.dec_b};
          gm::gemm_run<EpiScores, SchedScores, false>(F.lds, S, E); }
        QPOST(2); QPRE(2);
        if (SUB(5)) { SchedKV S; S.nt = 4; S.pitchA = CAT; S.pitchB = T; S.multA = 1; S.multB = 1; S.G = F.G; S.c = bc; S.Bcat = (const char*)WSP(bf16, WS_BCAT); S.kTw = (const char*)WSP(bf16, WS_KTW);
          EpiKV E{WSP(float, WS_KVT)};
          gm::gemm_run<EpiKV, SchedKV, false>(F.lds, S, E); }
        QPOST(2);
    }
    SEAM(2);
    if (IN(3)) {
        QPRE(2);
        { SchedFixA S; S.nt = 4; S.pitchA = 256; S.pitchB = 256; S.multA = 1; S.multB = 1; S.G = F.G; S.c = bc; S.A = (const char*)(WSP(bf16, WS_TAB) + 32768); S.Bt = (const char*)WSP(bf16, WS_A1); S.ncol = 512;
          EpiS2 E{WSP(bf16, WS_ZT)};
          gm::gemm_run<EpiS2, SchedFixA, false>(F.lds, S, E); }
        QPOST(2);
        p3_scan(F);
    }
    SEAM(3);
    if (IN(4)) {
        QPRE(2);
        { SchedFixB S; S.nt = 4; S.pitchA = 256; S.pitchB = 256; S.multA = 1; S.multB = 1; S.G = F.G; S.c = bc; S.A = (const char*)WSP(bf16, WS_ZT); S.Bt = (const char*)(WSP(bf16, WS_TAB) + 32768 + 65536); S.nrow = 512;
          EpiChan E{WSP(bf16, WS_Y)};
          gm::gemm_run<EpiChan, SchedFixB, false>(F.lds, S, E); }
        QPOST(2); QPRE(2);
        { SchedOut S; S.nt = CAT / 64; S.pitchA = CAT; S.pitchB = CAT; S.multA = 1; S.multB = 1; S.G = F.G; S.c = bc; S.Acat = (const char*)WSP(bf16, WS_ACAT); S.Bcat = (const char*)WSP(bf16, WS_BCAT);
          EpiOut E{WSP(bf16, WS_Y), WSP(bf16, WS_GS), F.gn_g};
          gm::gemm_run<EpiOut, SchedOut, false>(F.lds, S, E); }
        QPOST(2);
        do_slabs(F, sdone < nS ? sdone : nS, nS);
    }
    SEAM(4);
    if (IN(5)) {
        Sched2D S; S.nt = D / 64; S.pitchA = D; S.pitchB = D; S.multA = 1; S.multB = 1; S.G = F.G; S.c = bc; S.A = (const char*)WSP(bf16, WS_Y); S.Bt = (const char*)WSP(bf16, WS_WOUT); S.nM = 64; S.nN = 8;
        EpiWout E{WSP(float, WS_Z1), F.x, WSP(float, WS_ST0), F.ln0_g, F.ln0_b};
        gm::gemm_run<EpiWout, Sched2D, false>(F.lds, S, E);
    }
    SEAM(5);
    if (IN(6)) { p6_router(F); }
    SEAM(6);
    if (IN(7) || IN(8) || IN(9) || IN(10)) build_tstart(F, tstart);
    if (IN(7)) {
        SchedMoE S; S.nt = D / 128; S.pitchA = D / 2; S.pitchB = D / 2; S.multA = 1; S.multB = 1; S.G = F.G; S.c = bc; S.A = (const char*)WSP(char, WS_H1Q); S.Bt = (const char*)WSP(char, WS_WUP);
        S.tstart = tstart; S.row_tok = WSP(int, WS_RT) + 12 * T; S.cnt = F.ctl + CW_CNT; S.nN = 16; S.rowbytes = D; S.estride = (size_t)2 * DFF * D;
        EpiUp E{WSP(bf16, WS_ACT), F.b_up, WSP(float, WS_SWUP), WSP(float, WS_RSC), F.ctl + CW_CNT, F.ctl + CW_RMAX};
        gm::gemm_run<EpiUp, SchedMoE, true, true>(F.lds, S, E);
    }
    SEAM(7);
    if (IN(8)) { p8_requant(F, tstart); }
    SEAM(8);
    if (IN(9)) {
        SchedMoEDown S; S.nt = DFF / 128; S.pitchA = DFF / 2; S.pitchB = DFF / 2; S.multA = 1; S.multB = 1; S.G = F.G; S.c = bc; S.A = (const char*)WSP(char, WS_ACTQ); S.Bt = (const char*)WSP(char, WS_WDN);
        S.tstart = tstart; S.row_tok = nullptr; S.cnt = F.ctl + CW_CNT; S.nN = 8; S.rowbytes = DFF; S.estride = (size_t)D * DFF;
        EpiDown E{WSP(bf16, WS_YR), F.b_dn, WSP(float, WS_SWDN), WSP(float, WS_SA)};
        gm::gemm_run<EpiDown, SchedMoEDown, false, true>(F.lds, S, E);
    }
    SEAM(9);
    if (IN(10)) { p9_combine(F, tstart); }
#undef IN
#undef SEAM
}

#ifndef MK_SPLIT
#define MK_SPLIT 0
#endif
extern "C" void kernel_launch(void* const* d_in, const int* in_sizes, int n_in, void* d_out, int out_size, void* d_ws, size_t ws_size, hipStream_t stream) {
    static int grid = 0;
    if (grid == 0) {
        if (n_in != 18 || out_size != T * D || ws_size < WS_END2) { fprintf(stderr, "kernel_launch: unexpected problem: n_in %d out %d ws %zu (need %zu)\n", n_in, out_size, ws_size, (size_t)WS_END2); grid = -1; return; }
        int dev = 0, cus = 0, per_cu = 0;
        if (hipGetDevice(&dev) != hipSuccess || hipDeviceGetAttribute(&cus, hipDeviceAttributeMultiprocessorCount, dev) != hipSuccess) { grid = -1; return; }
        if (hipFuncSetAttribute((const void*)fwd, hipFuncAttributeMaxDynamicSharedMemorySize, LDS_BYTES) != hipSuccess) { fprintf(stderr, "kernel_launch: hipFuncSetAttribute failed\n"); grid = -1; return; }
        if (hipOccupancyMaxActiveBlocksPerMultiprocessor(&per_cu, (const void*)fwd, NTHR, LDS_BYTES) != hipSuccess || per_cu < 1) { fprintf(stderr, "kernel_launch: occupancy query reports %d\n", per_cu); }
        (void)hipGetLastError();
        grid = cus;
    }
    if (grid < 0) return;
    (void)hipMemsetAsync((char*)d_ws + WS_CTL, 0, CTL_BYTES, stream);
    Args a{};
    for (int i = 0; i < 18; ++i) a.in[i] = (const float*)d_in[i];
    a.out = (float*)d_out; a.ws = (unsigned char*)d_ws;
#if MK_SPLIT
    for (int p = 0; p < NPH; ++p) { a.ph_lo = p; a.ph_hi = p + 1; hipLaunchKernelGGL(fwd, dim3(grid), dim3(NTHR), LDS_BYTES, stream, a); }
#else
    a.ph_lo = 0; a.ph_hi = NPH; hipLaunchKernelGGL(fwd, dim3(grid), dim3(NTHR), LDS_BYTES, stream, a);
#endif
}
```

```cpp
#include <hip/hip_runtime.h>
#include <cstdio>
#include <cstdint>

#define GAS __attribute__((address_space(1)))
#define LAS __attribute__((address_space(3)))
typedef unsigned short bf16;
typedef unsigned v4u __attribute__((ext_vector_type(4)));
typedef unsigned v2u __attribute__((ext_vector_type(2)));
typedef float f32x4 __attribute__((ext_vector_type(4)));
typedef float f32x2 __attribute__((ext_vector_type(2)));
typedef short bf16x8 __attribute__((ext_vector_type(8)));
typedef int i32x4 __attribute__((ext_vector_type(4)));
#define RLX_AGENT __ATOMIC_RELAXED, __HIP_MEMORY_SCOPE_AGENT
#define LDS_WAIT() asm volatile("s_waitcnt lgkmcnt(0)" ::: "memory")
#define VM_WAIT() asm volatile("s_waitcnt vmcnt(0)" ::: "memory")

constexpr int T = 16384, D = 2048, DIN = 5120, FW = 1024, RW = 1024, NH = 4, HD = 256, NE = 32, TOPK = 4, DFF = 2048;
constexpr int C2 = 256, NCH = T / C2;
constexpr int CAT = 768;
constexpr float LN_EPS = 1e-5f, GN_EPS = 1e-6f, ALPHA = 1.189207115002721f;
constexpr int RT_MAX = (T * TOPK) / 256 + NE;
constexpr int NWAVES = 8, NTHR = 512;

constexpr size_t MiB = 1u << 20;
constexpr size_t WS_CTL = 0, CTL_BYTES = 1 * MiB;
constexpr size_t WS_TAB = 1 * MiB;
constexpr size_t WS_WIN = 2 * MiB;
constexpr size_t WS_WOUT = WS_WIN + 20 * MiB;
constexpr size_t WS_WUP = WS_WOUT + 8 * MiB;
constexpr size_t WS_WDN = WS_WUP + 512 * MiB;
constexpr size_t WS_H0B = WS_WDN + 256 * MiB;
constexpr size_t WS_ST0 = WS_H0B + 64 * MiB;
constexpr size_t WS_UTT = WS_ST0 + 1 * MiB;
constexpr size_t WS_A1 = WS_UTT + 32 * MiB;
constexpr size_t WS_ZT = WS_A1 + 64 * MiB;
constexpr size_t WS_QS = WS_ZT + 64 * MiB;
constexpr size_t WS_KK = WS_QS + 32 * MiB;
constexpr size_t WS_GS = WS_KK + 32 * MiB;
constexpr size_t WS_ACAT = WS_GS + 32 * MiB;
constexpr size_t WS_BCAT = WS_ACAT + 96 * MiB;
constexpr size_t WS_KTW = WS_BCAT + 96 * MiB;
constexpr size_t WS_KVT = WS_KTW + 64 * MiB;
constexpr size_t WS_Y = WS_KVT + 128 * MiB;
constexpr size_t WS_Z1 = WS_Y + 64 * MiB;
constexpr size_t WS_H1B = WS_Z1 + 128 * MiB;
constexpr size_t WS_RT = WS_H1B + 64 * MiB;
constexpr size_t WS_ACT = WS_RT + 4 * MiB;
constexpr size_t WS_YR = WS_ACT + 288 * MiB;
constexpr size_t WS_END = WS_YR + 288 * MiB;
constexpr size_t WS_SWUP = WS_TAB + 512 * 1024;
constexpr size_t WS_H1Q = WS_H1B;
constexpr size_t WS_SX = WS_H1B + 32 * MiB, WS_RSC = WS_H1B + 40 * MiB, WS_SA = WS_H1B + 44 * MiB;
constexpr size_t WS_SWDN = WS_ST0 + 512 * 1024;
constexpr size_t WS_ACTQ = WS_END;
constexpr size_t WS_END2 = WS_ACTQ + 144 * MiB;
constexpr int CW_RMAX = 16384;
constexpr int CW_BAR = 1024;
constexpr int CW_CNT = 8192;

constexpr int LDS_STAGE = 131072, LDS_SCR = 16384, LDS_CTL_OFF = LDS_STAGE + LDS_SCR, LDS_BYTES = LDS_CTL_OFF + 2048;

__device__ __forceinline__ unsigned cvt_pk_bf16(float lo, float hi) { unsigned r; asm volatile("v_cvt_pk_bf16_f32 %0, %1, %2" : "=v"(r) : "v"(lo), "v"(hi)); return r; }
__device__ __forceinline__ float bf_lo(unsigned u) { return __builtin_bit_cast(float, u << 16); }
__device__ __forceinline__ float bf_hi(unsigned u) { return __builtin_bit_cast(float, u & 0xffff0000u); }
__device__ __forceinline__ v4u pack8(const f32x4 a, const f32x4 b) { v4u w; w.x = cvt_pk_bf16(a[0], a[1]); w.y = cvt_pk_bf16(a[2], a[3]); w.z = cvt_pk_bf16(b[0], b[1]); w.w = cvt_pk_bf16(b[2], b[3]); return w; }
__device__ __forceinline__ float wave_sum(float v) {
#pragma unroll
    for (int o = 1; o < 64; o <<= 1) v += __shfl_xor(v, o);
    return v;
}
__device__ __forceinline__ float fexp(float x) { return __builtin_amdgcn_exp2f(x * 1.4426950408889634f); }
__device__ __forceinline__ void cs_rev(float rev, float& c, float& s) { const float f = __builtin_amdgcn_fractf(rev); c = __builtin_amdgcn_cosf(f); s = __builtin_amdgcn_sinf(f); }

#define XB_TMO      128
#define XB_XCNT(j)  (256  + 64 * (j))
#define XB_XSUB(j)  (1280 + 64 * (j))
#define XB_XGEN(j)  (2304 + 64 * (j))
#define XB_TOP      3328
#define XB_TOPGEN   3392
#define XCD_BAR_WORDS 3456
#define XB_SPIN_CAP (1u << 18)
__device__ __forceinline__ unsigned xb_ld(unsigned* p)              { return __hip_atomic_load(p, __ATOMIC_RELAXED, __HIP_MEMORY_SCOPE_AGENT); }
__device__ __forceinline__ unsigned xb_add(unsigned* p, unsigned v) { return __hip_atomic_fetch_add(p, v, __ATOMIC_RELAXED, __HIP_MEMORY_SCOPE_AGENT); }
__device__ __forceinline__ unsigned xb_xcc_id() { return (unsigned)__builtin_amdgcn_s_getreg((3 << 11) | 20) & 0xFu; }
#define XB_SPIN(cond, bar) do { unsigned _sp = 0; while (cond) { __builtin_amdgcn_s_sleep(1); \
    if ((++_sp & 255u) == 0u) { if (xb_ld(&(bar)[XB_TMO])) break; if (_sp > XB_SPIN_CAP) { atomicAdd(&(bar)[XB_TMO], 1u); break; } } } } while (0)
struct XcdBarrier { unsigned* bar; unsigned x; volatile LAS unsigned* st; };
__device__ __forceinline__ XcdBarrier xcd_barrier_post(unsigned* bar, volatile LAS unsigned* st) {
    XcdBarrier b; b.bar = bar; b.x = xb_xcc_id(); b.st = st;
    if (threadIdx.x == 0) (void)xb_add(&bar[XB_XCNT(b.x)], 1u);
    return b;
}
__device__ __forceinline__ void xcd_barrier_complete(unsigned* bar, unsigned x, unsigned& nloc, unsigned& nx) {
    const unsigned G = gridDim.x * gridDim.y * gridDim.z;
    unsigned sum, cnt, mine, sp = 0u;
    for (;;) {
        sum = 0u; cnt = 0u; mine = 0u;
#pragma unroll
        for (unsigned j = 0; j < 16; ++j) { const unsigned c = xb_ld(&bar[XB_XCNT(j)]); sum += c; cnt += (c > 0u) ? 1u : 0u; mine = (j == x) ? c : mine; }
        if (sum == G) break;
        __builtin_amdgcn_s_sleep(1);
        if ((++sp & 255u) == 0u) { if (xb_ld(&bar[XB_TMO])) break; if (sp > XB_SPIN_CAP) { atomicAdd(&bar[XB_TMO], 1u); break; } }
    }
    nloc = mine > 0u ? mine : 1u; nx = cnt > 0u ? cnt : 1u;
}
__device__ __forceinline__ void xcd_barrier(const XcdBarrier& b) {
    asm volatile("s_waitcnt vmcnt(0)" ::: "memory");
    __syncthreads();
    if (threadIdx.x == 0) {
        unsigned* bar = b.bar;
        __builtin_amdgcn_s_waitcnt(0);
        unsigned nloc = b.st[0], nx = b.st[1];
        if (nloc == 0u) { xcd_barrier_complete(bar, b.x, nloc, nx); b.st[0] = nloc; b.st[1] = nx; }
        const unsigned old = xb_add(&bar[XB_XSUB(b.x)], 1u);
        const unsigned gen = old / nloc;
        if (old + 1u == (gen + 1u) * nloc) {
            __builtin_amdgcn_fence(__ATOMIC_RELEASE, "agent");
            asm volatile("s_waitcnt vmcnt(0)" ::: "memory");
            const unsigned og = xb_add(&bar[XB_TOP], 1u);
            const unsigned tg = og / nx;
            if (og + 1u == (tg + 1u) * nx) xb_add(&bar[XB_TOPGEN], 1u);
            else XB_SPIN(xb_ld(&bar[XB_TOPGEN]) == tg, bar);
            __builtin_amdgcn_fence(__ATOMIC_ACQUIRE, "agent");
            xb_add(&bar[XB_XGEN(b.x)], 1u);
            asm volatile("s_waitcnt vmcnt(0)" ::: "memory");
        } else {
            XB_SPIN(xb_ld(&bar[XB_XGEN(b.x)]) == gen, bar);
            __builtin_amdgcn_fence(__ATOMIC_ACQUIRE, "agent");
            asm volatile("s_waitcnt vmcnt(0)" ::: "memory");
        }
    }
    __syncthreads();
}

namespace gm {
constexpr int BM = 256, BK = 64, HALF = 128, HTB = HALF * BK * 2, STAGE_BYTES = 8 * HTB;
__device__ __forceinline__ int lds_byte(int r, int c) { const int st = (r >> 4) * 2 + (c >> 5), rr = r & 15, cc = c & 31, ob = rr * 64 + cc * 2; return st * 1024 + (ob ^ (((ob >> 9) & 1) << 5)); }
__device__ __forceinline__ void stage_rc(int b, int& R, int& C) { const int st = b / 1024, sb = b % 1024, swz = sb ^ (((sb >> 9) & 1) << 5); R = (st >> 1) * 16 + swz / 64; C = (st & 1) * 32 + (swz % 64) / 2; }
__device__ __forceinline__ int perm32(int rho) { const int n = rho >> 4, i = rho & 15; return 8 * (i >> 2) + 4 * n + (i & 3); }

struct Unit { const char* a0; const char* a1; const char* b0; const char* b1; int p0, p1, p2, p3, q; };

__device__ __forceinline__ void tile_order(int L, int nM, int nN, int& pm, int& pn) {
    const int nwg = nM * nN; int wgid = L;
    { const int q = nwg / 8, r = nwg % 8, xcd = wgid % 8, off = wgid / 8; wgid = (xcd < r ? xcd * (q + 1) : r * (q + 1) + (xcd - r) * q) + off; }
    const int nig = 8 * nN, gid = wgid / nig, fm = gid * 8, gsz = (nM - fm) < 8 ? (nM - fm) : 8;
    pm = fm + ((wgid % nig) % gsz); pn = (wgid % nig) / gsz;
}

template <bool I8> struct AccSel { typedef f32x4 type; };
template <> struct AccSel<true> { typedef i32x4 type; };
template <class Epi, class Sched, bool GATHER, bool I8 = false, bool PREF = false>
__device__ __forceinline__ void gemm_run(LAS unsigned char* lds, const Sched& S, const Epi& E) {
    const int tid = threadIdx.x, wid = __builtin_amdgcn_readfirstlane(tid >> 6), lane = tid & 63, wr = wid >> 2, wc = wid & 3, fr = lane & 15, fq = lane >> 4;
    int nt = S.nt; asm volatile("" : "+s"(nt));
    unsigned voffA[2], voffB[2], colA[2]; int rowA[2];
#pragma unroll
    for (int i = 0; i < 2; ++i) { int R, C; stage_rc(tid * 16 + i * 8192, R, C); const int Rb = Epi::PERM ? ((R & ~31) + perm32(R & 31)) : R;
        voffA[i] = (unsigned)(R * S.multA * S.pitchA + C) * 2u; voffB[i] = (unsigned)(Rb * S.multB * S.pitchB + C) * 2u; colA[i] = (unsigned)C * 2u; rowA[i] = R; }
    const size_t kstep = (size_t)(BK * 2);
    const unsigned ldsw = (unsigned)wid * 1024u;
    const int aoff = lds_byte(wr * 64 + fr, fq * 8), boff = lds_byte(wc * 32 + fr, fq * 8);
#define G_SA(b, h) (((b) * 2 + (h)) * HTB)
#define G_SB(b, h) ((4 + (b) * 2 + (h)) * HTB)
#define G_STAGE(bufoff, gbase, voff) do { _Pragma("unroll") for (int _i = 0; _i < 2; ++_i) \
        __builtin_amdgcn_global_load_lds((const unsigned*)((const char*)(gbase) + (voff)[_i]), (LAS unsigned*)(lds + (bufoff) + ldsw + _i * 8192), 16, 0, 0); } while (0)
#define G_LDA(dst, b, h) do { _Pragma("unroll") for (int m = 0; m < 4; ++m) _Pragma("unroll") for (int k = 0; k < 2; ++k) dst[m][k] = *(const LAS bf16x8*)(lds + G_SA(b, h) + aoff + m * 2048 + k * 1024); } while (0)
#define G_LDB(dst, b, h) do { _Pragma("unroll") for (int n = 0; n < 2; ++n) _Pragma("unroll") for (int k = 0; k < 2; ++k) dst[n][k] = *(const LAS bf16x8*)(lds + G_SB(b, h) + boff + n * 2048 + k * 1024); } while (0)
#define G_MMA(ai, bj, At, Bt) do { __builtin_amdgcn_s_setprio(1); _Pragma("unroll") for (int m = 0; m < 4; ++m) _Pragma("unroll") for (int n = 0; n < 2; ++n) _Pragma("unroll") for (int k = 0; k < 2; ++k) \
        { if constexpr (I8) acc[ai][bj][m][n] = __builtin_amdgcn_mfma_i32_16x16x64_i8(__builtin_bit_cast(i32x4, Bt[n][k]), __builtin_bit_cast(i32x4, At[m][k]), acc[ai][bj][m][n], 0, 0, 0); \
          else acc[ai][bj][m][n] = __builtin_amdgcn_mfma_f32_16x16x32_bf16(Bt[n][k], At[m][k], acc[ai][bj][m][n], 0, 0, 0); } __builtin_amdgcn_s_setprio(0); } while (0)
#define G_WAIT_V(n) asm volatile("s_waitcnt vmcnt(" #n ")" ::: "memory")
#define G_WAIT_L(n) asm volatile("s_waitcnt lgkmcnt(" #n ")" ::: "memory")
#define G_BAR __builtin_amdgcn_s_barrier()
#define G_SCHED __builtin_amdgcn_sched_barrier(0)
    Unit cur, nxt; int ui = 0;
    if (!S.next(0, cur)) return;
    cur.q = 0;
    if constexpr (PREF) { S.prefetch(cur, lds); G_WAIT_V(0); G_BAR; }
    typedef typename AccSel<I8>::type acc_t;
    acc_t acc[2][2][4][2];
#pragma unroll
    for (int a = 0; a < 2; ++a)
#pragma unroll
        for (int b = 0; b < 2; ++b)
#pragma unroll
            for (int m = 0; m < 4; ++m)
#pragma unroll
                for (int n = 0; n < 2; ++n) acc[a][b][m][n] = (acc_t){0, 0, 0, 0};
    bf16x8 At[4][2], B0[2][2], B1[2][2];
    unsigned gc0[2], gc1[2];
    if constexpr (GATHER) {
#pragma unroll
        for (int i = 0; i < 2; ++i) { gc0[i] = S.row_off(cur, rowA[i], lds) + colA[i]; gc1[i] = S.row_off(cur, 128 + rowA[i], lds) + colA[i]; }
    }
#define vA0 (GATHER ? gc0 : voffA)
#define vA1 (GATHER ? gc1 : voffA)
    G_STAGE(G_SB(0, 0), cur.b0, voffB); G_STAGE(G_SB(0, 1), cur.b1, voffB); G_STAGE(G_SA(0, 0), cur.a0, vA0); G_STAGE(G_SA(0, 1), cur.a1, vA1);
    if (wr == 1) G_BAR;
    G_WAIT_V(2); G_BAR;
    G_STAGE(G_SB(1, 0), cur.b0 + kstep, voffB); G_STAGE(G_SA(1, 0), cur.a0 + kstep, vA0); G_STAGE(G_SB(1, 1), cur.b1 + kstep, voffB);
    G_WAIT_V(6); G_BAR;
    for (;;) {
        const bool has_next = S.next(ui + 1, nxt);
        if (!has_next) nxt = cur;
        nxt.q = (ui + 1) & 1;
        for (int t = 0; t < nt; t += 2) {
            const bool last = (t == nt - 2);
            if constexpr (PREF) { if (t == nt - 4) S.prefetch(nxt, lds); }
            const char* a11 = cur.a1 + (size_t)(t + 1) * kstep;
            const char* a02 = last ? nxt.a0 : cur.a0 + (size_t)(t + 2) * kstep; const char* a12 = last ? nxt.a1 : cur.a1 + (size_t)(t + 2) * kstep;
            const char* b02 = last ? nxt.b0 : cur.b0 + (size_t)(t + 2) * kstep; const char* b12 = last ? nxt.b1 : cur.b1 + (size_t)(t + 2) * kstep;
            G_LDB(B0, 0, 0); G_LDB(B1, 0, 1); G_SCHED; G_LDA(At, 0, 0); G_STAGE(G_SA(1, 1), a11, vA1);
            if constexpr (GATHER) { if (last) { int tz = tid; asm volatile("" : "+v"(tz));
#pragma unroll
                for (int i = 0; i < 2; ++i) { int R, C; stage_rc(tz * 16 + i * 8192, R, C); gc0[i] = S.row_off(nxt, R, lds) + (unsigned)C * 2u; gc1[i] = S.row_off(nxt, 128 + R, lds) + (unsigned)C * 2u; } } }
            G_WAIT_V(8); G_WAIT_L(0); G_BAR; G_MMA(0, 0, At, B0); G_MMA(0, 1, At, B1); G_BAR; G_SCHED;
            G_LDA(At, 0, 1); G_STAGE(G_SB(0, 0), b02, voffB); G_STAGE(G_SB(0, 1), b12, voffB); G_STAGE(G_SA(0, 0), a02, vA0);
            G_WAIT_V(8); G_WAIT_L(0); G_BAR; G_MMA(1, 0, At, B0); G_MMA(1, 1, At, B1); G_BAR; G_SCHED;
            G_LDB(B0, 1, 0); G_LDB(B1, 1, 1); G_SCHED; G_LDA(At, 1, 0); G_STAGE(G_SA(0, 1), a12, vA1);
            G_WAIT_V(8); G_WAIT_L(0); G_BAR; G_MMA(0, 0, At, B0); G_MMA(0, 1, At, B1); G_BAR; G_SCHED;
            G_LDA(At, 1, 1); G_STAGE(G_SB(1, 0), b02 + kstep, voffB); G_STAGE(G_SB(1, 1), b12 + kstep, voffB); G_STAGE(G_SA(1, 0), a02 + kstep, vA0);
            G_WAIT_V(8); G_WAIT_L(0); G_BAR; G_MMA(1, 0, At, B0); G_MMA(1, 1, At, B1); G_BAR; G_SCHED;
        }
        if (wr == 0) G_BAR;
        { int fr2 = fr, fq2 = fq; asm volatile("" : "+v"(fr2), "+v"(fq2));
          E(acc, cur, lds, wr, wc, fr2, fq2); }
        if (!has_next) break;
#pragma unroll
        for (int a = 0; a < 2; ++a)
#pragma unroll
            for (int b = 0; b < 2; ++b)
#pragma unroll
                for (int m = 0; m < 4; ++m)
#pragma unroll
                    for (int n = 0; n < 2; ++n) acc[a][b][m][n] = (acc_t){0, 0, 0, 0};
        cur = nxt; ++ui;
        if (wr == 1) G_BAR;
    }
    G_WAIT_V(0);
    G_BAR;
#undef G_SA
#undef G_SB
#undef G_STAGE
#undef G_LDA
#undef G_LDB
#undef G_MMA
#undef G_WAIT_V
#undef G_WAIT_L
#undef G_BAR
#undef G_SCHED
#undef vA0
#undef vA1
}
}
using gm::Unit;
typedef f32x4 Acc[2][2][4][2];
typedef i32x4 AccI[2][2][4][2];

struct Args { const float* in[18]; float* out; unsigned char* ws; int ph_lo, ph_hi; };
struct Frame {
    LAS unsigned char* lds; unsigned char* ws; unsigned* ctl;
    int tid, lane, wave, vcu, G;
    const float *x, *ln0_g, *ln0_b, *w_in, *dec_f, *dec_b, *gn_g, *w_out, *ln1_g, *ln1_b, *w_r, *b_r, *w_up, *b_up, *w_dn, *b_dn, *ln2_g, *ln2_b;
    float* out;
};
#define WSP(T_, off) ((T_*)(F.ws + (off)))

template <class ColMap>
__device__ __forceinline__ void transpose_item(const float* W, int K, int N, bf16* WT, LAS float* scr, int item, int lane, const ColMap& cm) {
    const int nblk = N / 64, kb = item / nblk, nb = item % nblk, k0 = 64 * kb, n0 = 64 * nb;
    const int s0 = cm(n0);
#pragma unroll 4
    for (int i = 0; i < 16; ++i) { const int kk = 4 * i + (lane >> 4), c4 = (lane & 15) * 4;
        const f32x4 v = *(const GAS f32x4*)(W + (size_t)(k0 + kk) * N + s0 + c4);
        LAS float* d = scr + kk * 65 + c4; d[0] = v[0]; d[1] = v[1]; d[2] = v[2]; d[3] = v[3]; }
    LDS_WAIT(); asm volatile("" ::: "memory");
    const int c = lane & 7;
#pragma unroll
    for (int j = 0; j < 8; ++j) { const int n = (lane >> 3) + 8 * j; const LAS float* s = scr + (8 * c) * 65 + n;
        v4u o; o.x = cvt_pk_bf16(s[0 * 65], s[1 * 65]); o.y = cvt_pk_bf16(s[2 * 65], s[3 * 65]); o.z = cvt_pk_bf16(s[4 * 65], s[5 * 65]); o.w = cvt_pk_bf16(s[6 * 65], s[7 * 65]);
        *(GAS v4u*)(WT + (size_t)(n0 + n) * K + k0 + 8 * c) = o; }
    LDS_WAIT(); asm volatile("" ::: "memory");
}
struct ColId { __device__ __forceinline__ int operator()(int n) const { return n; } };
struct ColUp { __device__ __forceinline__ int operator()(int n) const { return ((n >> 8) * 128 + (n & 127)) + ((n >> 7) & 1) * 2048; } };

__device__ __forceinline__ void p0_prologue(Frame& F) {
    const int gw = F.vcu * NWAVES + F.wave, NGW = F.G * NWAVES;
    {
        bf16* h0b = WSP(bf16, WS_H0B); float* st0 = WSP(float, WS_ST0);
        for (int m = gw; m < T; m += NGW) {
            const GAS f32x4* xr = (const GAS f32x4*)(F.x + (size_t)m * D) + F.lane;
            f32x4 v[8]; float s = 0.f;
#pragma unroll
            for (int j = 0; j < 8; ++j) { v[j] = xr[64 * j]; s += (v[j][0] + v[j][1]) + (v[j][2] + v[j][3]); }
            const float mean = wave_sum(s) * (1.f / D); float s2 = 0.f;
#pragma unroll
            for (int j = 0; j < 8; ++j) { v[j] = v[j] - mean; s2 += (v[j][0] * v[j][0] + v[j][1] * v[j][1]) + (v[j][2] * v[j][2] + v[j][3] * v[j][3]); }
            const float rstd = 1.f / sqrtf(wave_sum(s2) * (1.f / D) + LN_EPS);
            GAS v2u* o8 = (GAS v2u*)(h0b + (size_t)m * D) + F.lane;
#pragma unroll
            for (int j = 0; j < 8; ++j) { const f32x4 g = *((const GAS f32x4*)F.ln0_g + F.lane + 64 * j), b = *((const GAS f32x4*)F.ln0_b + F.lane + 64 * j);
                const f32x4 h = v[j] * rstd * g + b; v2u w; w.x = cvt_pk_bf16(h[0], h[1]); w.y = cvt_pk_bf16(h[2], h[3]); o8[64 * j] = w; }
            if (F.lane == 0) { st0[2 * m] = mean; st0[2 * m + 1] = rstd; }
        }
    }
    {
        bf16* tab = WSP(bf16, WS_TAB);
        for (int i = (F.vcu * NTHR + F.tid); i < 32768 + 65536 + 65536; i += F.G * NTHR) {
            float v;
            if (i < 32768) { const int r = i >> 7, a = i & 127, ri = r >> 7, k1 = r & 127; float c, s; cs_rev((float)((k1 * a) & 127) * (1.f / 128.f), c, s); v = ri ? -s : c; }
            else if (i < 32768 + 65536) { const int e = i - 32768, r = e >> 8, q = e & 255, ri = r >> 7, k2 = r & 127, rj = q >> 7, b = q & 127; float c, s; cs_rev((float)((k2 * b) & 127) * (1.f / 128.f), c, s);
                v = (ri == 0) ? (rj == 0 ? c : s) : (rj == 0 ? -s : c); }
            else { const int e = i - 32768 - 65536, l = e >> 8, q = e & 255, rj = q >> 7, cg = q & 127; float c, s; cs_rev((float)((l * cg) & 127) * (1.f / 128.f), c, s); v = (l < 128) ? (rj == 0 ? c : s) : 0.f; }
            tab[i] = (bf16)(cvt_pk_bf16(v, 0.f) & 0xffffu);
        }
    }
    {
        LAS float* scr = (LAS float*)(F.lds + F.wave * 18432);
        constexpr int I_IN = 32 * (DIN / 64), I_OUT = 32 * (D / 64), I_UP = 32 * (2 * DFF / 64), I_DN = 32 * (D / 64);
        constexpr int NIT = I_IN + I_OUT;
        for (int it = gw; it < NIT; it += NGW) {
            int r = it;
            if (r < I_IN) { transpose_item(F.w_in, D, DIN, WSP(bf16, WS_WIN), scr, r, F.lane, ColId()); continue; } r -= I_IN;
            { transpose_item(F.w_out, D, D, WSP(bf16, WS_WOUT), scr, r, F.lane, ColId()); }
        }
    }
}

struct SlabDesc { const float* W; signed char* WQ; float* sw; int NS, e, n0, valid; };
struct QF { unsigned char* ws; const float* w_up; const float* w_dn; int vcu, G; };
__device__ __forceinline__ SlabDesc slab_desc(const QF& F, int j) {
    const int nU = (NE * 128 + F.G - 1) / F.G; SlabDesc d;
    if (j < nU) { const int sl = F.vcu + j * F.G; d.valid = sl < NE * 128; d.NS = 2 * DFF; d.e = sl >> 7; d.n0 = (sl & 127) * 32; d.W = F.w_up + (size_t)d.e * D * 2 * DFF + ColUp()(d.n0); d.WQ = (signed char*)WSP(char, WS_WUP); d.sw = WSP(float, WS_SWUP); }
    else { const int sl = F.vcu + (j - nU) * F.G; d.valid = sl < NE * 64; d.NS = D; d.e = sl >> 6; d.n0 = (sl & 63) * 32; d.W = F.w_dn + (size_t)d.e * DFF * D + d.n0; d.WQ = (signed char*)WSP(char, WS_WDN); d.sw = WSP(float, WS_SWDN); }
    return d;
}
#define SLAB_LOAD(dsc, v) do { if ((dsc).valid) { const GAS char* b_ = (const GAS char*)(dsc).W; unsigned o_ = (unsigned)((wave * 256 + kq) * (dsc).NS + c4) * 4u; const unsigned st_ = (unsigned)(dsc).NS * 32u; \
    _Pragma("unroll") for (int i_ = 0; i_ < 32; ++i_) { v[i_] = __builtin_nontemporal_load((const GAS f32x4*)(b_ + o_)); o_ += st_; } } } while (0)
__device__ __forceinline__ void do_slabs_impl(LAS unsigned char* lds, unsigned char* ws, const float* w_up, const float* w_dn, int vcu, int G, int j0, int j1) {
    if (j0 >= j1) return;
    QF F; F.ws = ws; F.w_up = w_up; F.w_dn = w_dn; F.vcu = vcu; F.G = G;
    const int tid = threadIdx.x, lane = tid & 63, wave = __builtin_amdgcn_readfirstlane(tid >> 6);
    constexpr int PITCH = 2056;
    LAS bf16* slab = (LAS bf16*)lds;
    LAS float* red = (LAS float*)(lds + 32 * PITCH * 2);
    const int kq = lane >> 3, c4 = (lane & 7) * 4;
    f32x4 v[32];
    SlabDesc cur = slab_desc(F, j0);
    SLAB_LOAD(cur, v);
    for (int j = j0; j < j1; ++j) {
        if (cur.valid) {
            f32x4 mx = (f32x4){0.f, 0.f, 0.f, 0.f};
#pragma unroll
            for (int i = 0; i < 32; ++i) { const int k = wave * 256 + i * 8 + kq; const f32x4 x = v[i];
                mx[0] = fmaxf(mx[0], fabsf(x[0])); mx[1] = fmaxf(mx[1], fabsf(x[1])); mx[2] = fmaxf(mx[2], fabsf(x[2])); mx[3] = fmaxf(mx[3], fabsf(x[3]));
                const unsigned p01 = cvt_pk_bf16(x[0], x[1]), p23 = cvt_pk_bf16(x[2], x[3]);
                const int ks = k ^ (((c4 >> 3) & 3) << 3);
                slab[(c4 + 0) * PITCH + ks] = (bf16)(p01 & 0xffffu); slab[(c4 + 1) * PITCH + ks] = (bf16)(p01 >> 16); slab[(c4 + 2) * PITCH + ks] = (bf16)(p23 & 0xffffu); slab[(c4 + 3) * PITCH + ks] = (bf16)(p23 >> 16); }
#pragma unroll
            for (int q = 0; q < 4; ++q) { float m = mx[q]; m = fmaxf(m, __shfl_xor(m, 8)); m = fmaxf(m, __shfl_xor(m, 16)); m = fmaxf(m, __shfl_xor(m, 32)); mx[q] = m; }
            if (lane < 8) { LAS float* d = red + wave * 32 + c4; d[0] = mx[0]; d[1] = mx[1]; d[2] = mx[2]; d[3] = mx[3]; }
        }
        const SlabDesc done = cur;
        if (j + 1 < j1) { cur = slab_desc(F, j + 1); SLAB_LOAD(cur, v); }
        __syncthreads();
        if (done.valid && tid < 32) { float m = 0.f;
#pragma unroll
            for (int w = 0; w < 8; ++w) m = fmaxf(m, red[w * 32 + tid]);
            const float sc = m > 0.f ? m * (1.f / 127.f) : 1.f; done.sw[(size_t)done.e * done.NS + done.n0 + tid] = sc; red[256 + tid] = 1.f / sc; }
        __syncthreads();
        if (done.valid) {
#pragma unroll 2
            for (int i = 0; i < 8; ++i) { const int q = tid + NTHR * i, n = q >> 7, kc = q & 127; const float inv = red[256 + n];
                const int sx_ = ((n >> 3) & 3) << 3;
                const v4u a = *(const LAS v4u*)(slab + n * PITCH + ((kc * 16) ^ sx_)), b = *(const LAS v4u*)(slab + n * PITCH + ((kc * 16 + 8) ^ sx_));
                const unsigned src[8] = {a.x, a.y, a.z, a.w, b.x, b.y, b.z, b.w}; unsigned o[4];
#pragma unroll
                for (int d = 0; d < 4; ++d) { unsigned w = 0u;
#pragma unroll
                    for (int h2 = 0; h2 < 2; ++h2) { const unsigned u2 = src[2 * d + h2]; const int q0 = (int)__builtin_rintf(bf_lo(u2) * inv), q1 = (int)__builtin_rintf(bf_hi(u2) * inv);
                        w |= ((unsigned)(q0 & 0xff) << (16 * h2)) | ((unsigned)(q1 & 0xff) << (16 * h2 + 8)); }
                    o[d] = w; }
                *(GAS v4u*)(done.WQ + ((size_t)done.e * done.NS + done.n0 + n) * D + kc * 16) = (v4u){o[0], o[1], o[2], o[3]}; }
        }
        __syncthreads();
    }
}

__device__ __forceinline__ void do_slabs(Frame& F, int j0, int j1) { do_slabs_impl(F.lds, F.ws, F.w_up, F.w_dn, F.vcu, F.G, j0, j1); }

struct SchedBase { int nt, pitchA, pitchB, multA, multB, G, c; };
struct SchedG1N : SchedBase {
    const char* A; const char* Bt;
    __device__ __forceinline__ bool next(int i, Unit& u) const { const int L = i * G + c; if (L >= 64 * 12) return false; int pm, pn; gm::tile_order(L, 64, 12, pm, pn);
        const int cb = pn < 4 ? 1024 + 256 * pn : (pn < 8 ? 2048 + 256 * (pn - 4) : 4096 + 256 * (pn - 8));
        u.a0 = A + (size_t)pm * 256 * D * 2; u.a1 = u.a0 + (size_t)128 * D * 2; u.b0 = Bt + (size_t)cb * D * 2; u.b1 = u.b0 + (size_t)128 * D * 2; u.p0 = pm; u.p1 = pn; u.p2 = 0; u.p3 = 0; return true; }
};
struct SchedG1SF : SchedBase {
    const char* A; const char* Bt;
    __device__ __forceinline__ bool next(int i, Unit& u) const { const int L = i * G + c; if (L >= 4 * 64) return false; int pm, pn; gm::tile_order(L, 4, 64, pm, pn);
        u.a0 = A + (size_t)pm * 256 * D * 2; u.a1 = u.a0 + (size_t)128 * D * 2; u.b0 = Bt + (size_t)(2 * pn) * D * 2; u.b1 = u.b0 + (size_t)D * 2; u.p0 = pm; u.p1 = pn; u.p2 = 0; u.p3 = 0; return true; }
};
struct SchedG1SKV : SchedBase {
    const char* A; const char* Bt;
    __device__ __forceinline__ bool next(int i, Unit& u) const { const int L = i * G + c; if (L >= 8 * 64) return false; int pm, pn; gm::tile_order(L, 8, 64, pm, pn);
        const int rb = pm < 4 ? 2048 + 256 * pm : 3072 + 256 * (pm - 4);
        u.a0 = A + (size_t)rb * D * 2; u.a1 = u.a0 + (size_t)128 * D * 2; u.b0 = Bt + (size_t)pn * 256 * D * 2; u.b1 = u.b0 + (size_t)128 * D * 2; u.p0 = pm; u.p1 = pn; u.p2 = 0; u.p3 = 0; return true; }
};
struct SchedFixA : SchedBase {
    const char* A; const char* Bt; int ncol;
    __device__ __forceinline__ bool next(int i, Unit& u) const { const int L = i * G + c; if (L >= ncol) return false;
        u.a0 = A; u.a1 = A + (size_t)128 * pitchA * 2; u.b0 = Bt + (size_t)L * 256 * pitchB * 2; u.b1 = u.b0 + (size_t)128 * pitchB * 2; u.p0 = 0; u.p1 = L; u.p2 = 0; u.p3 = 0; return true; }
};
struct SchedFixB : SchedBase {
    const char* A; const char* Bt; int nrow;
    __device__ __forceinline__ bool next(int i, Unit& u) const { const int L = i * G + c; if (L >= nrow) return false;
        u.a0 = A + (size_t)L * 256 * pitchA * 2; u.a1 = u.a0 + (size_t)128 * pitchA * 2; u.b0 = Bt; u.b1 = Bt + (size_t)128 * pitchB * 2; u.p0 = L; u.p1 = 0; u.p2 = 0; u.p3 = 0; return true; }
};
struct SchedScores : SchedBase {
    const char* Q; const char* Kk;
    __device__ __forceinline__ bool next(int i, Unit& u) const { const int L = i * G + c; if (L >= NH * NCH) return false; const int h = L & 3, n = L >> 2;
        u.a0 = Q + ((size_t)n * 256 * RW + h * HD) * 2; u.a1 = u.a0 + (size_t)128 * RW * 2; u.b0 = Kk + ((size_t)n * 256 * RW + h * HD) * 2; u.b1 = u.b0 + (size_t)128 * RW * 2; u.p0 = h; u.p1 = n; u.p2 = 0; u.p3 = 0; return true; }
};
struct SchedKV : SchedBase {
    const char* Bcat; const char* kTw;
    __device__ __forceinline__ bool next(int i, Unit& u) const { const int L = i * G + c; if (L >= 2 * NH * NCH) return false; const int dh = L & 7, n = L >> 3, dir = dh >> 2, h = dh & 3;
        u.a0 = Bcat + ((size_t)(h * NCH + n) * 256 * CAT) * 2; u.a1 = u.a0 + (size_t)128 * CAT * 2;
        u.b0 = kTw + (((size_t)dir * RW + h * HD) * T + (size_t)n * 256) * 2; u.b1 = u.b0 + (size_t)128 * T * 2; u.p0 = dh; u.p1 = n; u.p2 = 0; u.p3 = 0; return true; }
};
struct SchedOut : SchedBase {
    const char* Acat; const char* Bcat;
    __device__ __forceinline__ bool next(int i, Unit& u) const { const int L = i * G + c; if (L >= NH * NCH) return false; const int h = L & 3, n = L >> 2;
        u.a0 = Acat + ((size_t)h * T + (size_t)n * 256) * CAT * 2; u.a1 = u.a0 + (size_t)128 * CAT * 2; u.b0 = Bcat + ((size_t)(h * NCH + n) * 256 * CAT) * 2; u.b1 = u.b0 + (size_t)128 * CAT * 2; u.p0 = h; u.p1 = n; u.p2 = 0; u.p3 = 0; return true; }
};
struct Sched2D : SchedBase {
    const char* A; const char* Bt; int nM, nN;
    __device__ __forceinline__ bool next(int i, Unit& u) const { const int L = i * G + c; if (L >= nM * nN) return false; int pm, pn; gm::tile_order(L, nM, nN, pm, pn);
        u.a0 = A + (size_t)pm * 256 * pitchA * 2; u.a1 = u.a0 + (size_t)128 * pitchA * 2; u.b0 = Bt + (size_t)pn * 256 * pitchB * 2; u.b1 = u.b0 + (size_t)128 * pitchB * 2; u.p0 = pm; u.p1 = pn; u.p2 = 0; u.p3 = 0; return true; }
};
struct SchedMoE : SchedBase {
    const char* A; const char* Bt; const LAS int* tstart; const int* row_tok; const unsigned* cnt; int nN, rowbytes; size_t estride;
    __device__ __forceinline__ bool next(int i, Unit& u) const { const int RT = __builtin_amdgcn_readfirstlane(tstart[NE]); const int L = i * G + c; if (L >= RT * nN) return false; int rt, pn; gm::tile_order(L, RT, nN, rt, pn);
        const int e = __builtin_amdgcn_readfirstlane(tstart[40 + rt]);
        u.b0 = Bt + (size_t)e * estride + (size_t)pn * 256 * rowbytes; u.b1 = u.b0 + (size_t)128 * rowbytes;
        u.a0 = A; u.a1 = A;
        u.p0 = rt; u.p1 = pn; u.p2 = e; u.p3 = (rt - __builtin_amdgcn_readfirstlane(tstart[e])) * 256; return true; }
    const float *rsc, *swup, *b_up;
    __device__ __forceinline__ void prefetch(const Unit& u, LAS unsigned char* lds) const {
        LAS unsigned char* blk = lds + LDS_STAGE + u.q * 4096;
        const int wid = __builtin_amdgcn_readfirstlane(threadIdx.x >> 6), lane = threadIdx.x & 63, e = u.p2;
        const int n = (int)cnt[64 * e]; int pos = u.p3 + (wid & 3) * 64 + lane; pos = pos < n ? pos : n - 1;
        if (wid < 4) __builtin_amdgcn_global_load_lds((const unsigned*)(row_tok + (size_t)e * T + pos), (LAS unsigned*)(blk + wid * 256), 4, 0, 0);
        else __builtin_amdgcn_global_load_lds((const unsigned*)(rsc + (size_t)e * T + pos), (LAS unsigned*)(blk + 1024 + (wid - 4) * 256), 4, 0, 0);
        if (wid == 0) __builtin_amdgcn_global_load_lds((const unsigned*)(swup + (size_t)e * 2 * DFF + u.p1 * 256 + lane * 4), (LAS unsigned*)(blk + 2048), 16, 0, 0);
        if (wid == 1) __builtin_amdgcn_global_load_lds((const unsigned*)(b_up + (size_t)e * 2 * DFF + u.p1 * 128 + (lane & 31) * 4 + (lane >> 5) * DFF), (LAS unsigned*)(blk + 3072), 16, 0, 0);
    }
    __device__ __forceinline__ unsigned row_off(const Unit& u, int r, LAS unsigned char* lds) const { return (unsigned)((const LAS int*)(lds + LDS_STAGE + u.q * 4096))[r] * (unsigned)rowbytes; }
};
struct SchedMoEDown : SchedMoE {
    const float *sa, *swdn, *b_dn;
    __device__ __forceinline__ bool next(int i, Unit& u) const { if (!SchedMoE::next(i, u)) return false; u.a0 = A + (size_t)u.p0 * 256 * rowbytes; u.a1 = u.a0 + (size_t)128 * rowbytes; return true; }
    __device__ __forceinline__ void prefetch(const Unit& u, LAS unsigned char* lds) const {
        LAS unsigned char* blk = lds + LDS_STAGE + u.q * 4096;
        const int wid = __builtin_amdgcn_readfirstlane(threadIdx.x >> 6), lane = threadIdx.x & 63, e = u.p2;
        if (wid == 0) __builtin_amdgcn_global_load_lds((const unsigned*)(sa + (size_t)u.p0 * 256 + lane * 4), (LAS unsigned*)(blk), 16, 0, 0);
        if (wid == 1) __builtin_amdgcn_global_load_lds((const unsigned*)(swdn + (size_t)e * D + u.p1 * 256 + lane * 4), (LAS unsigned*)(blk + 1024), 16, 0, 0);
        if (wid == 2) __builtin_amdgcn_global_load_lds((const unsigned*)(b_dn + (size_t)e * D + u.p1 * 256 + lane * 4), (LAS unsigned*)(blk + 2048), 16, 0, 0);
    }
};

#define EPI_LOOP_AM for (int ai = 0; ai < 2; ++ai) _Pragma("unroll") for (int m = 0; m < 4; ++m)
#define EPI_FENCE __builtin_amdgcn_sched_barrier(0)
struct EpiG1N {
    static constexpr bool PERM = true;
    bf16 *qs, *kk, *gs, *Acat; const float *dec_f, *dec_b;
    __device__ __forceinline__ void operator()(Acc& acc, const Unit& u, LAS unsigned char*, int wr, int wc, int fr, int fq) const {
        const int pm = u.p0, pn = u.p1, c0 = wc * 32 + 8 * fq;
        if (pn < 8) {
            const int h = pn & 3; const bool isq = pn < 4;
            float inv[8];
#pragma unroll
            for (int e = 0; e < 8; ++e) inv[e] = __builtin_amdgcn_exp2f(-(float)(c0 + e) * (13.287712379549449f / 128.f)) * 0.15915494309189535f;
            const float lgf = -fexp(dec_f[h]), lgb = -fexp(dec_b[h]);
#pragma unroll
            EPI_LOOP_AM {
                const int r = 128 * ai + 64 * wr + 16 * m + fr, tok = pm * 256 + r; const float pos = (float)tok;
                f32x4 o1[2], o2[2];
#pragma unroll
                for (int n = 0; n < 2; ++n)
#pragma unroll
                    for (int j = 0; j < 4; ++j) { float c, s; cs_rev(pos * inv[4 * n + j], c, s); const float x1 = acc[ai][0][m][n][j], x2 = acc[ai][1][m][n][j]; o1[n][j] = x1 * c - x2 * s; o2[n][j] = x2 * c + x1 * s; }
                if (isq) {
                    bf16* q = qs + (size_t)tok * RW + h * HD + c0; *(GAS v4u*)q = pack8(o1[0], o1[1]); *(GAS v4u*)(q + 128) = pack8(o2[0], o2[1]);
                    const int il = r; const float wf = fexp(lgf * (float)(il + 1)), wb = fexp(lgb * (float)(255 - il));
                    bf16* a = Acat + ((size_t)h * T + tok) * CAT + c0;
                    *(GAS v4u*)(a + 256) = pack8(o1[0] * wf, o1[1] * wf); *(GAS v4u*)(a + 384) = pack8(o2[0] * wf, o2[1] * wf);
                    *(GAS v4u*)(a + 512) = pack8(o1[0] * wb, o1[1] * wb); *(GAS v4u*)(a + 640) = pack8(o2[0] * wb, o2[1] * wb);
                } else {
                    bf16* k = kk + (size_t)tok * RW + h * HD + c0; *(GAS v4u*)k = pack8(o1[0] * 0.0625f, o1[1] * 0.0625f); *(GAS v4u*)(k + 128) = pack8(o2[0] * 0.0625f, o2[1] * 0.0625f);
                }
            }
        } else {
#pragma unroll
            EPI_LOOP_AM {
                const int r = 128 * ai + 64 * wr + 16 * m + fr, tok = pm * 256 + r;
#pragma unroll
                for (int bj = 0; bj < 2; ++bj) { f32x4 v[2];
#pragma unroll
                    for (int n = 0; n < 2; ++n)
#pragma unroll
                        for (int j = 0; j < 4; ++j) { const float g = acc[ai][bj][m][n][j]; v[n][j] = g * __builtin_amdgcn_rcpf(1.f + fexp(-g)); }
                    *(GAS v4u*)(gs + (size_t)tok * RW + (pn - 8) * 256 + bj * 128 + c0) = pack8(v[0], v[1]); }
            }
        }
    }
};
struct EpiG1SF {
    static constexpr bool PERM = true;
    bf16* uTT;
    __device__ __forceinline__ void operator()(Acc& acc, const Unit& u, LAS unsigned char*, int wr, int wc, int fr, int fq) const {
        const int a0 = wc * 32 + 8 * fq;
#pragma unroll
        EPI_LOOP_AM { const int cch = u.p0 * 256 + 128 * ai + 64 * wr + 16 * m + fr;
#pragma unroll
            for (int bj = 0; bj < 2; ++bj) *(GAS v4u*)(uTT + ((size_t)cch * 128 + (2 * u.p1 + bj)) * 128 + a0) = pack8(acc[ai][bj][m][0], acc[ai][bj][m][1]); }
    }
};
struct EpiG1SKV {
    static constexpr bool PERM = true;
    bf16 *kTw, *Bcat; const float *dec_f, *dec_b;
    __device__ __forceinline__ void operator()(Acc& acc, const Unit& u, LAS unsigned char*, int wr, int wc, int fr, int fq) const {
        const int pm = u.p0, n_ch = u.p1, c0 = wc * 32 + 8 * fq;
        if (pm < 4) {
            const int h = pm; const float lgf = -fexp(dec_f[h]), lgb = -fexp(dec_b[h]);
#pragma unroll
            for (int m = 0; m < 4; ++m) {
                const int d = 64 * wr + 16 * m + fr;
                const float inv = __builtin_amdgcn_exp2f(-(float)d * (13.287712379549449f / 128.f)) * 0.15915494309189535f;
#pragma unroll
                for (int bj = 0; bj < 2; ++bj) {
                    f32x4 f1[2], f2[2], b1[2], b2[2];
#pragma unroll
                    for (int n = 0; n < 2; ++n)
#pragma unroll
                        for (int j = 0; j < 4; ++j) { const int il = 128 * bj + c0 + 4 * n + j; const float pos = (float)(n_ch * 256 + il); float c, s; cs_rev(pos * inv, c, s);
                            const float x1 = acc[0][bj][m][n][j], x2 = acc[1][bj][m][n][j]; const float o1 = (x1 * c - x2 * s) * 0.0625f, o2 = (x2 * c + x1 * s) * 0.0625f;
                            const float wf = fexp(lgf * (float)(255 - il)), wb = fexp(lgb * (float)(il + 1));
                            f1[n][j] = o1 * wf; f2[n][j] = o2 * wf; b1[n][j] = o1 * wb; b2[n][j] = o2 * wb; }
                    const size_t tcol = (size_t)n_ch * 256 + 128 * bj + c0;
                    bf16* pf = kTw + ((size_t)(h * HD + d)) * T + tcol; bf16* pb = pf + (size_t)RW * T;
                    *(GAS v4u*)pf = pack8(f1[0], f1[1]); *(GAS v4u*)(pf + (size_t)128 * T) = pack8(f2[0], f2[1]);
                    *(GAS v4u*)pb = pack8(b1[0], b1[1]); *(GAS v4u*)(pb + (size_t)128 * T) = pack8(b2[0], b2[1]);
                }
            }
        } else {
            const int h = pm - 4;
#pragma unroll
            EPI_LOOP_AM { const int dv = 128 * ai + 64 * wr + 16 * m + fr;
#pragma unroll
                for (int bj = 0; bj < 2; ++bj) *(GAS v4u*)(Bcat + ((size_t)(h * NCH + n_ch) * 256 + dv) * CAT + 128 * bj + c0) = pack8(acc[ai][bj][m][0], acc[ai][bj][m][1]); }
        }
    }
};
struct EpiS1 {
    static constexpr bool PERM = true;
    bf16* A1;
    __device__ __forceinline__ void operator()(Acc& acc, const Unit& u, LAS unsigned char*, int wr, int wc, int fr, int fq) const {
        const int b0 = wc * 32 + 8 * fq;
#pragma unroll
        for (int m = 0; m < 4; ++m) { const int k1 = 64 * wr + 16 * m + fr;
#pragma unroll
            for (int bj = 0; bj < 2; ++bj) { const int cch = 2 * u.p1 + bj; f32x4 re[2], im[2];
#pragma unroll
                for (int n = 0; n < 2; ++n)
#pragma unroll
                    for (int j = 0; j < 4; ++j) { const int b = b0 + 4 * n + j; float c, s; cs_rev((float)(k1 * b) * (1.f / 16384.f), c, s);
                        const float xr = acc[0][bj][m][n][j], xi = acc[1][bj][m][n][j]; re[n][j] = xr * c + xi * s; im[n][j] = xi * c - xr * s; }
                bf16* p = A1 + (((size_t)k1 * 1024 + cch) * 2) * 128 + b0;
                *(GAS v4u*)p = pack8(re[0], re[1]); *(GAS v4u*)(p + 128) = pack8(im[0], im[1]); EPI_FENCE; } }
    }
};
struct EpiS2 {
    static constexpr bool PERM = true;
    bf16* Zt;
    __device__ __forceinline__ void operator()(Acc& acc, const Unit& u, LAS unsigned char*, int wr, int wc, int fr, int fq) const {
        const int k1 = u.p1 >> 2, cb = (u.p1 & 3) * 256, c0 = wc * 32 + 8 * fq;
#pragma unroll
        EPI_LOOP_AM { const int k2 = 64 * wr + 16 * m + fr, k = k1 + 128 * k2;
#pragma unroll
            for (int bj = 0; bj < 2; ++bj) { const int cch = cb + 128 * bj + c0, g = cch >> 7, cg = cch & 127;
                *(GAS v4u*)(Zt + (size_t)k * 2048 + g * 256 + ai * 128 + cg) = pack8(acc[ai][bj][m][0], acc[ai][bj][m][1]); } }
    }
};
struct EpiChan {
    static constexpr bool PERM = true;
    bf16* y;
    __device__ __forceinline__ void operator()(Acc& acc, const Unit& u, LAS unsigned char*, int wr, int wc, int fr, int fq) const {
        const int l0 = wc * 32 + 8 * fq; const float norm = 6.9053396600248786e-4f;
#pragma unroll
        EPI_LOOP_AM { const int R = u.p0 * 256 + 128 * ai + 64 * wr + 16 * m + fr, k = R >> 3, g = R & 7;
            *(GAS v4u*)(y + (size_t)k * D + g * 128 + l0) = pack8(acc[ai][0][m][0] * norm, acc[ai][0][m][1] * norm); }
    }
};
struct EpiScores {
    static constexpr bool PERM = true;
    bf16* Acat; const float *dec_f, *dec_b;
    __device__ __forceinline__ void operator()(Acc& acc, const Unit& u, LAS unsigned char*, int wr, int wc, int fr, int fq) const {
        const int h = u.p0, n_ch = u.p1, c0 = wc * 32 + 8 * fq; const float lgf = -fexp(dec_f[h]), lgb = -fexp(dec_b[h]);
#pragma unroll
        EPI_LOOP_AM { const int i = 128 * ai + 64 * wr + 16 * m + fr;
#pragma unroll
            for (int bj = 0; bj < 2; ++bj) { f32x4 v[2];
#pragma unroll
                for (int n = 0; n < 2; ++n)
#pragma unroll
                    for (int j = 0; j < 4; ++j) { const int jc = 128 * bj + c0 + 4 * n + j; const float dd = (float)(i - jc); const float w = (jc <= i) ? fexp(lgf * dd) : fexp(-lgb * dd); v[n][j] = acc[ai][bj][m][n][j] * w; }
                *(GAS v4u*)(Acat + ((size_t)h * T + n_ch * 256 + i) * CAT + 128 * bj + c0) = pack8(v[0], v[1]); EPI_FENCE; } }
    }
};
struct EpiKV {
    static constexpr bool PERM = false;
    float* kvT;
    __device__ __forceinline__ void operator()(Acc& acc, const Unit& u, LAS unsigned char*, int wr, int wc, int fr, int fq) const {
#pragma unroll
        EPI_LOOP_AM { const int dv = 128 * ai + 64 * wr + 16 * m + fr; float* rowp = kvT + (((size_t)u.p0 * NCH + u.p1) * 256 + dv) * 256 + wc * 32 + 4 * fq;
#pragma unroll
            for (int bj = 0; bj < 2; ++bj)
#pragma unroll
                for (int n = 0; n < 2; ++n) *(GAS f32x4*)(rowp + bj * 128 + n * 16) = acc[ai][bj][m][n]; }
    }
};
struct EpiOut {
    static constexpr bool PERM = true;
    bf16* y; const bf16* gs; const float* gn_g;
    __device__ __forceinline__ void operator()(Acc& acc, const Unit& u, LAS unsigned char* lds, int wr, int wc, int fr, int fq) const {
        const int h = u.p0, n_ch = u.p1, c0 = wc * 32 + 8 * fq;
        LAS f32x2* P = (LAS f32x2*)(lds + LDS_STAGE);
#pragma unroll
        EPI_LOOP_AM {
            float s = 0.f;
#pragma unroll
            for (int bj = 0; bj < 2; ++bj)
#pragma unroll
                for (int n = 0; n < 2; ++n) { const f32x4 x = acc[ai][bj][m][n]; s += (x[0] + x[1]) + (x[2] + x[3]); }
            s += __shfl_xor(s, 16); s += __shfl_xor(s, 32);
            const float mw = s * (1.f / 64.f); float q = 0.f;
#pragma unroll
            for (int bj = 0; bj < 2; ++bj)
#pragma unroll
                for (int n = 0; n < 2; ++n) { const f32x4 d = acc[ai][bj][m][n] - mw; q += (d[0] * d[0] + d[1] * d[1]) + (d[2] * d[2] + d[3] * d[3]); }
            q += __shfl_xor(q, 16); q += __shfl_xor(q, 32);
            if (fq == 0) P[(128 * ai + 64 * wr + 16 * m + fr) * 4 + wc] = (f32x2){mw, q};
        }
        LDS_WAIT(); __builtin_amdgcn_s_barrier(); asm volatile("" ::: "memory");
#pragma unroll
        EPI_LOOP_AM {
            const int r = 128 * ai + 64 * wr + 16 * m + fr, tok = n_ch * 256 + r;
            const f32x2 a = P[r * 4 + 0], b = P[r * 4 + 1], c = P[r * 4 + 2], d = P[r * 4 + 3];
            const float mt = (a.x + b.x + c.x + d.x) * 0.25f; const float da = a.x - mt, db = b.x - mt, dc = c.x - mt, dd = d.x - mt;
            const float m2 = (a.y + b.y) + (c.y + d.y) + 64.f * ((da * da + db * db) + (dc * dc + dd * dd));
            const float rstd = 1.f / sqrtf(m2 * (1.f / 256.f) + GN_EPS);
#pragma unroll
            for (int bj = 0; bj < 2; ++bj) {
                const int col = h * HD + 128 * bj + c0; const v4u gv = *(const GAS v4u*)(gs + (size_t)tok * RW + col);
                const f32x4 g0 = *(const GAS f32x4*)(gn_g + col), g1 = *(const GAS f32x4*)(gn_g + col + 4);
                f32x4 o0 = (acc[ai][bj][m][0] - mt) * rstd * g0, o1 = (acc[ai][bj][m][1] - mt) * rstd * g1;
                o0[0] *= bf_lo(gv.x); o0[1] *= bf_hi(gv.x); o0[2] *= bf_lo(gv.y); o0[3] *= bf_hi(gv.y); o1[0] *= bf_lo(gv.z); o1[1] *= bf_hi(gv.z); o1[2] *= bf_lo(gv.w); o1[3] *= bf_hi(gv.w);
                *(GAS v4u*)(y + (size_t)tok * D + FW + col) = pack8(o0, o1); }
        }
        LDS_WAIT(); __builtin_amdgcn_s_barrier(); asm volatile("" ::: "memory");
    }
};
struct EpiWout {
    static constexpr bool PERM = false;
    float* z1; const float *x, *st0, *g0, *b0;
    __device__ __forceinline__ void operator()(Acc& acc, const Unit& u, LAS unsigned char*, int wr, int wc, int fr, int fq) const {
        const int colb = u.p1 * 256 + wc * 32 + 4 * fq;
#pragma unroll
        EPI_LOOP_AM { const int row = u.p0 * 256 + 128 * ai + 64 * wr + 16 * m + fr; const f32x2 st = *(const GAS f32x2*)(st0 + 2 * row);
#pragma unroll
            for (int bj = 0; bj < 2; ++bj)
#pragma unroll
                for (int n = 0; n < 2; ++n) { const int col = colb + bj * 128 + n * 16; const size_t off = (size_t)row * D + col;
                    const f32x4 xv = *(const GAS f32x4*)(x + off), g = *(const GAS f32x4*)(g0 + col), b = *(const GAS f32x4*)(b0 + col);
                    *(GAS f32x4*)(z1 + off) = ((xv - st.x) * st.y * g + b) * ALPHA + acc[ai][bj][m][n]; } }
    }
};
struct EpiUp {
    static constexpr bool PERM = true;
    bf16* act; unsigned* rmax;
    __device__ __forceinline__ void operator()(AccI& acc, const Unit& u, LAS unsigned char* lds, int wr, int wc, int fr, int fq) const {
        const int rt = u.p0, pn = u.p1, c0 = pn * 128 + wc * 32 + 8 * fq;
        const LAS float* blk = (const LAS float*)(lds + LDS_STAGE + u.q * 4096);
        float sx[2][4], rm[2][4];
#pragma unroll
        EPI_LOOP_AM { sx[ai][m] = blk[256 + 128 * ai + 64 * wr + 16 * m + fr]; rm[ai][m] = 0.f; }
#pragma unroll
        for (int n = 0; n < 2; ++n) {
            const int cc = wc * 32 + 8 * fq + 4 * n;
            const f32x4 sg = *(const LAS f32x4*)(blk + 512 + cc), sl = *(const LAS f32x4*)(blk + 512 + 128 + cc), bg = *(const LAS f32x4*)(blk + 768 + cc), bl = *(const LAS f32x4*)(blk + 768 + 128 + cc);
#pragma unroll
            EPI_LOOP_AM { const int r = 128 * ai + 64 * wr + 16 * m + fr; f32x4 v;
#pragma unroll
                for (int j = 0; j < 4; ++j) { float gl = (float)acc[ai][0][m][n][j] * (sx[ai][m] * sg[j]) + bg[j], li = (float)acc[ai][1][m][n][j] * (sx[ai][m] * sl[j]) + bl[j];
                    gl = fminf(gl, 7.f); li = fminf(fmaxf(li, -7.f), 7.f); v[j] = gl * __builtin_amdgcn_rcpf(1.f + fexp(-1.702f * gl)) * (li + 1.f); }
                rm[ai][m] = fmaxf(rm[ai][m], fmaxf(fmaxf(fabsf(v[0]), fabsf(v[1])), fmaxf(fabsf(v[2]), fabsf(v[3]))));
                v2u w; w.x = cvt_pk_bf16(v[0], v[1]); w.y = cvt_pk_bf16(v[2], v[3]);
                *(GAS v2u*)(act + ((size_t)rt * 256 + r) * DFF + c0 + 4 * n) = w; }
        }
#pragma unroll
        EPI_LOOP_AM { float q = rm[ai][m]; q = fmaxf(q, __shfl_xor(q, 16)); q = fmaxf(q, __shfl_xor(q, 32));
            if (fq == 0) __hip_atomic_fetch_max(rmax + rt * 256 + 128 * ai + 64 * wr + 16 * m + fr, __float_as_uint(q), RLX_AGENT); }
    }
};
struct EpiDown {
    static constexpr bool PERM = true;
    bf16* yr;
    __device__ __forceinline__ void operator()(AccI& acc, const Unit& u, LAS unsigned char* lds, int wr, int wc, int fr, int fq) const {
        const int rt = u.p0, pn = u.p1, c0 = pn * 256 + wc * 32 + 8 * fq;
        const LAS float* blk = (const LAS float*)(lds + LDS_STAGE + u.q * 4096);
        float sr[2][4];
#pragma unroll
        EPI_LOOP_AM sr[ai][m] = blk[128 * ai + 64 * wr + 16 * m + fr];
#pragma unroll
        for (int bj = 0; bj < 2; ++bj) { const int cc = 128 * bj + wc * 32 + 8 * fq;
            const f32x4 w0 = *(const LAS f32x4*)(blk + 256 + cc), w1 = *(const LAS f32x4*)(blk + 256 + cc + 4), b0 = *(const LAS f32x4*)(blk + 512 + cc), b1 = *(const LAS f32x4*)(blk + 512 + cc + 4);
#pragma unroll
            EPI_LOOP_AM { const int r = 128 * ai + 64 * wr + 16 * m + fr; f32x4 o0, o1;
#pragma unroll
                for (int j = 0; j < 4; ++j) { o0[j] = (float)acc[ai][bj][m][0][j] * (sr[ai][m] * w0[j]) + b0[j]; o1[j] = (float)acc[ai][bj][m][1][j] * (sr[ai][m] * w1[j]) + b1[j]; }
                *(GAS v4u*)(yr + ((size_t)rt * 256 + r) * D + c0 + 128 * bj) = pack8(o0, o1); } }
    }
};

__device__ __forceinline__ void p3_scan(Frame& F) {
    const float* kvT = WSP(float, WS_KVT); bf16* Bcat = WSP(bf16, WS_BCAT);
    const int NQ = 2 * NH * 256 * 64;
    for (int q = F.vcu * NTHR + F.tid; q < NQ; q += F.G * NTHR) {
        const int dk4 = q & 63, dv = (q >> 6) & 255, dh = q >> 14, dir = dh >> 2, h = dh & 3;
        const float lg = -fexp((dir ? F.dec_b : F.dec_f)[h]); const float cd = fexp(lg * (float)C2);
        f32x4 S = (f32x4){0.f, 0.f, 0.f, 0.f};
        for (int s = 0; s < NCH; ++s) { const int n = dir ? (NCH - 1 - s) : s;
            const f32x4 kv = *(const GAS f32x4*)(kvT + (((size_t)dh * NCH + n) * 256 + dv) * 256 + dk4 * 4);
            v2u w; w.x = cvt_pk_bf16(S[0], S[1]); w.y = cvt_pk_bf16(S[2], S[3]);
            *(GAS v2u*)(Bcat + ((size_t)(h * NCH + n) * 256 + dv) * CAT + 256 + dir * 256 + dk4 * 4) = w;
            S = S * cd + kv; }
    }
}

__device__ __forceinline__ void p6_router(Frame& F) {
    const float* z1 = WSP(float, WS_Z1); unsigned* h1q = WSP(unsigned, WS_H1Q); float* sxg = WSP(float, WS_SX); float* rsc = WSP(float, WS_RSC); float* st1 = WSP(float, WS_ST0) + 2 * T;
    int* topi = WSP(int, WS_RT); float* gate = (float*)(topi + 4 * T); int* posb = (int*)(gate + 4 * T); int* row_tok = posb + 4 * T;
    LAS float* hc = (LAS float*)F.lds;
    LAS float* wrc = hc + 64 * 257;
    LAS float* stl = wrc + 256 * 32;
    LAS float* lg = stl + 128;
    LAS int* hist = (LAS int*)(lg + 64 * 33);
    LAS float* sxl = (LAS float*)(hist + 64);
    for (int blk = F.vcu; blk < T / 64; blk += F.G) {
        const int t0 = blk * 64;
        for (int rr = 0; rr < 8; ++rr) { const int row = F.wave * 8 + rr, m = t0 + row;
            const GAS f32x4* xr = (const GAS f32x4*)(z1 + (size_t)m * D) + F.lane; f32x4 v[8]; float s = 0.f;
#pragma unroll
            for (int j = 0; j < 8; ++j) { v[j] = xr[64 * j]; s += (v[j][0] + v[j][1]) + (v[j][2] + v[j][3]); }
            const float mean = wave_sum(s) * (1.f / D); float s2 = 0.f;
#pragma unroll
            for (int j = 0; j < 8; ++j) { v[j] = v[j] - mean; s2 += (v[j][0] * v[j][0] + v[j][1] * v[j][1]) + (v[j][2] * v[j][2] + v[j][3] * v[j][3]); }
            const float rstd = 1.f / sqrtf(wave_sum(s2) * (1.f / D) + LN_EPS);
            float am = 0.f;
#pragma unroll
            for (int j = 0; j < 8; ++j) { const f32x4 g = *((const GAS f32x4*)F.ln1_g + F.lane + 64 * j), b = *((const GAS f32x4*)F.ln1_b + F.lane + 64 * j);
                v[j] = v[j] * rstd * g + b; am = fmaxf(am, fmaxf(fmaxf(fabsf(v[j][0]), fabsf(v[j][1])), fmaxf(fabsf(v[j][2]), fabsf(v[j][3])))); }
#pragma unroll
            for (int o = 1; o < 64; o <<= 1) am = fmaxf(am, __shfl_xor(am, o));
            const float sc = am > 0.f ? am * (1.f / 127.f) : 1.f, inv = 1.f / sc;
#pragma unroll
            for (int j = 0; j < 8; ++j) { const int q0 = (int)__builtin_rintf(v[j][0] * inv), q1 = (int)__builtin_rintf(v[j][1] * inv), q2 = (int)__builtin_rintf(v[j][2] * inv), q3 = (int)__builtin_rintf(v[j][3] * inv);
                h1q[(size_t)m * (D / 4) + F.lane + 64 * j] = (unsigned)(q0 & 0xff) | ((unsigned)(q1 & 0xff) << 8) | ((unsigned)(q2 & 0xff) << 16) | ((unsigned)(q3 & 0xff) << 24); }
            if (F.lane == 0) { st1[2 * m] = mean; st1[2 * m + 1] = rstd; stl[2 * row] = mean; stl[2 * row + 1] = rstd; sxg[m] = sc; sxl[row] = sc; }
        }
        if (F.tid < 64) hist[F.tid] = 0;
        __syncthreads();
        const int row = F.tid >> 3, e0 = (F.tid & 7) * 4; f32x4 accl = (f32x4){0.f, 0.f, 0.f, 0.f};
        for (int kc = 0; kc < 8; ++kc) {
            for (int i = F.tid; i < 64 * 64; i += NTHR) { const int r = i >> 6, c4 = (i & 63) * 4, col = kc * 256 + c4;
                const f32x4 zv = *(const GAS f32x4*)(z1 + (size_t)(t0 + r) * D + col), g = *(const GAS f32x4*)(F.ln1_g + col), b = *(const GAS f32x4*)(F.ln1_b + col);
                const f32x4 hh = (zv - stl[2 * r]) * stl[2 * r + 1] * g + b; LAS float* d = hc + r * 257 + c4; d[0] = hh[0]; d[1] = hh[1]; d[2] = hh[2]; d[3] = hh[3]; }
            for (int i = F.tid; i < 256 * 8; i += NTHR) { const int k = i >> 3, c4 = (i & 7) * 4; *(LAS f32x4*)(wrc + k * 32 + c4) = *(const GAS f32x4*)(F.w_r + (size_t)(kc * 256 + k) * NE + c4); }
            __syncthreads();
#pragma unroll 8
            for (int k = 0; k < 256; ++k) { const float hv = hc[row * 257 + k]; const f32x4 w = *(const LAS f32x4*)(wrc + k * 32 + e0); accl = accl + w * hv; }
            __syncthreads();
        }
        { const f32x4 br = *(const GAS f32x4*)(F.b_r + e0); LAS float* d = lg + row * 33 + e0; d[0] = accl[0] + br[0]; d[1] = accl[1] + br[1]; d[2] = accl[2] + br[2]; d[3] = accl[3] + br[3]; }
        __syncthreads();
        int ek[4] = {0, 0, 0, 0}, lp[4] = {0, 0, 0, 0}; float gk[4] = {0.f, 0.f, 0.f, 0.f};
        if (F.tid < 64) {
            float lv[4]; unsigned used = 0u;
#pragma unroll
            for (int k = 0; k < 4; ++k) { float best = -3.0e38f; int bi = 0;
                for (int e = 0; e < NE; ++e) { const float v = lg[F.tid * 33 + e]; const bool ok = !((used >> e) & 1u) && (v > best); best = ok ? v : best; bi = ok ? e : bi; }
                used |= 1u << bi; ek[k] = bi; lv[k] = best; }
            const float mx = lv[0]; float den = 0.f;
#pragma unroll
            for (int k = 0; k < 4; ++k) { gk[k] = fexp(lv[k] - mx); den += gk[k]; }
            const float rd = 1.f / den;
#pragma unroll
            for (int k = 0; k < 4; ++k) { gk[k] *= rd; lp[k] = __hip_atomic_fetch_add(&hist[ek[k]], 1, __ATOMIC_RELAXED, __HIP_MEMORY_SCOPE_WORKGROUP); }
        }
        __syncthreads();
        if (F.tid < NE) hist[32 + F.tid] = (int)__hip_atomic_fetch_add(F.ctl + CW_CNT + 64 * F.tid, (unsigned)hist[F.tid], RLX_AGENT);
        __syncthreads();
        if (F.tid < 64) { const int tok = t0 + F.tid;
#pragma unroll
            for (int k = 0; k < 4; ++k) { const int pos = hist[32 + ek[k]] + lp[k]; row_tok[(size_t)ek[k] * T + pos] = tok; rsc[(size_t)ek[k] * T + pos] = sxl[F.tid]; topi[4 * tok + k] = ek[k]; gate[4 * tok + k] = gk[k]; posb[4 * tok + k] = pos; } }
        __syncthreads();
    }
}

__device__ __forceinline__ void p8_requant(Frame& F, const LAS int* tstart) {
    const bf16* act = WSP(bf16, WS_ACT); unsigned* aq = WSP(unsigned, WS_ACTQ); float* sa = WSP(float, WS_SA); const unsigned* rmax = F.ctl + CW_RMAX;
    const int R = tstart[NE] * 256, gw = F.vcu * NWAVES + F.wave, NGW = F.G * NWAVES;
    for (int row = gw; row < R; row += NGW) {
        const float mx = __uint_as_float(rmax[row]); const float sc = mx > 0.f ? mx * (1.f / 127.f) : 1.f, inv = 1.f / sc;
#pragma unroll
        for (int j = 0; j < 2; ++j) { const int col = 16 * F.lane + 1024 * j;
            const v4u a = *(const GAS v4u*)(act + (size_t)row * DFF + col), b = *(const GAS v4u*)(act + (size_t)row * DFF + col + 8);
            const unsigned src[8] = {a.x, a.y, a.z, a.w, b.x, b.y, b.z, b.w}; unsigned o[4];
#pragma unroll
            for (int d = 0; d < 4; ++d) { unsigned w = 0u;
#pragma unroll
                for (int h2 = 0; h2 < 2; ++h2) { const unsigned u2 = src[2 * d + h2]; int q0 = (int)__builtin_rintf(bf_lo(u2) * inv), q1 = (int)__builtin_rintf(bf_hi(u2) * inv);
                    q0 = q0 > 127 ? 127 : (q0 < -127 ? -127 : q0); q1 = q1 > 127 ? 127 : (q1 < -127 ? -127 : q1);
                    w |= ((unsigned)(q0 & 0xff) << (16 * h2)) | ((unsigned)(q1 & 0xff) << (16 * h2 + 8)); }
                o[d] = w; }
            *(GAS v4u*)(aq + ((size_t)row * DFF + col) / 4) = (v4u){o[0], o[1], o[2], o[3]}; }
        if (F.lane == 0) sa[row] = sc;
    }
}

__device__ __forceinline__ void build_tstart(Frame& F, LAS int* tstart) {
    if (F.tid == 0) { int s = 0; for (int e = 0; e < NE; ++e) { tstart[e] = s; const unsigned n = __hip_atomic_load(F.ctl + CW_CNT + 64 * e, RLX_AGENT); s += (int)((n + 255u) >> 8); } tstart[NE] = s; }
    __syncthreads();
    for (int rt = F.tid; rt < RT_MAX; rt += NTHR) { int e = 0; for (int j = 1; j < NE; ++j) e += (tstart[j] <= rt) ? 1 : 0; tstart[40 + rt] = e; }
    __syncthreads();
}

__device__ __forceinline__ void p9_combine(Frame& F, const LAS int* tstart) {
    const float* z1 = WSP(float, WS_Z1); const float* st1 = WSP(float, WS_ST0) + 2 * T; const bf16* yr = WSP(bf16, WS_YR);
    const int* topi = WSP(int, WS_RT); const float* gate = (const float*)(topi + 4 * T); const int* posb = (const int*)(gate + 4 * T);
    const int gw = F.vcu * NWAVES + F.wave, NGW = F.G * NWAVES;
    for (int m = gw; m < T; m += NGW) {
        const float mean1 = st1[2 * m], rstd1 = st1[2 * m + 1];
        size_t ro[4]; float gk[4];
#pragma unroll
        for (int k = 0; k < 4; ++k) { const int e = topi[4 * m + k]; ro[k] = ((size_t)tstart[e] * 256 + posb[4 * m + k]) * D; gk[k] = gate[4 * m + k]; }
        f32x4 v[8]; float s = 0.f;
#pragma unroll
        for (int j = 0; j < 8; ++j) { const int col = 4 * F.lane + 256 * j;
            const f32x4 zv = *(const GAS f32x4*)(z1 + (size_t)m * D + col), g = *(const GAS f32x4*)(F.ln1_g + col), b = *(const GAS f32x4*)(F.ln1_b + col);
            f32x4 a = ((zv - mean1) * rstd1 * g + b) * ALPHA;
#pragma unroll
            for (int k = 0; k < 4; ++k) { const v2u w = *(const GAS v2u*)(yr + ro[k] + col); a[0] += gk[k] * bf_lo(w.x); a[1] += gk[k] * bf_hi(w.x); a[2] += gk[k] * bf_lo(w.y); a[3] += gk[k] * bf_hi(w.y); }
            v[j] = a; s += (a[0] + a[1]) + (a[2] + a[3]); }
        const float mean = wave_sum(s) * (1.f / D); float s2 = 0.f;
#pragma unroll
        for (int j = 0; j < 8; ++j) { v[j] = v[j] - mean; s2 += (v[j][0] * v[j][0] + v[j][1] * v[j][1]) + (v[j][2] * v[j][2] + v[j][3] * v[j][3]); }
        const float rstd = 1.f / sqrtf(wave_sum(s2) * (1.f / D) + LN_EPS);
#pragma unroll
        for (int j = 0; j < 8; ++j) { const int col = 4 * F.lane + 256 * j; const f32x4 g = *(const GAS f32x4*)(F.ln2_g + col), b = *(const GAS f32x4*)(F.ln2_b + col);
            *(GAS f32x4*)(F.out + (size_t)m * D + col) = v[j] * rstd * g + b; }
    }
}

constexpr int NPH = 11;
__global__ void __launch_bounds__(NTHR, 2) fwd(Args args) {
    extern __shared__ __attribute__((aligned(16))) unsigned char lds_raw[];
    Frame F;
    F.lds = (LAS unsigned char*)lds_raw; F.ws = args.ws; F.ctl = (unsigned*)(args.ws + WS_CTL);
    F.tid = threadIdx.x; F.lane = F.tid & 63; F.wave = __builtin_amdgcn_readfirstlane(F.tid >> 6);
    F.G = gridDim.x; { const int bx = blockIdx.x; F.vcu = (F.G % 8 == 0) ? (bx % 8) * (F.G / 8) + bx / 8 : bx; }
    F.x = args.in[0]; F.ln0_g = args.in[1]; F.ln0_b = args.in[2]; F.w_in = args.in[3]; F.dec_f = args.in[4]; F.dec_b = args.in[5]; F.gn_g = args.in[6]; F.w_out = args.in[7];
    F.ln1_g = args.in[8]; F.ln1_b = args.in[9]; F.w_r = args.in[10]; F.b_r = args.in[11]; F.w_up = args.in[12]; F.b_up = args.in[13]; F.w_dn = args.in[14]; F.b_dn = args.in[15];
    F.ln2_g = args.in[16]; F.ln2_b = args.in[17]; F.out = args.out;
    volatile LAS unsigned* lctl = (volatile LAS unsigned*)(F.lds + LDS_CTL_OFF);
    LAS int* tstart = (LAS int*)(F.lds + LDS_CTL_OFF + 64);
    for (int u = F.tid; u < 128; u += NTHR) lctl[u] = 0u;
    __syncthreads();
    const int lo = args.ph_lo, hi = args.ph_hi;
    const bool single = (hi - lo) > 1;
    XcdBarrier bar; bar.bar = F.ctl + CW_BAR; bar.x = 0; bar.st = lctl;
    if (single) bar = xcd_barrier_post(F.ctl + CW_BAR, lctl);
#ifndef PH_MASK
#define PH_MASK 0x7ff
#endif
#define IN(k) (((PH_MASK >> (k)) & 1) && lo <= (k) && (k) < hi)
#ifndef SUB_MASK
#define SUB_MASK 0xff
#endif
#define SUB(n) ((SUB_MASK >> (n)) & 1)
#define SEAM(k) do { if (IN(k) && IN((k) + 1)) xcd_barrier(bar); } while (0)
    const int bc = (int)blockIdx.x;

    const int nS = (NE * 128 + F.G - 1) / F.G + (NE * 64 + F.G - 1) / F.G; int sdone = 0; const int qgrp = (int)(blockIdx.x >> 3);
#define QSLOT(k24) do { const int e_ = sdone + (nS * (k24) + 23) / 24; do_slabs(F, sdone, e_ < nS ? e_ : nS); sdone = e_; } while (0)
#define QG(slot, nslots, k24) do { if (qgrp % (nslots) == (slot)) QSLOT(k24); } while (0)
    if (IN(0)) { p0_prologue(F); __syncthreads(); }
    SEAM(0);
    if (IN(1)) {
        QG(0, 4, 9);
        if (SUB(0)) { SchedG1N S; S.nt = D / 64; S.pitchA = D; S.pitchB = D; S.multA = 1; S.multB = 1; S.G = F.G; S.c = bc; S.A = (const char*)WSP(bf16, WS_H0B); S.Bt = (const char*)WSP(bf16, WS_WIN);
          EpiG1N E{WSP(bf16, WS_QS), WSP(bf16, WS_KK), WSP(bf16, WS_GS), WSP(bf16, WS_ACAT), F.dec_f, F.dec_b};
          gm::gemm_run<EpiG1N, SchedG1N, false>(F.lds, S, E); }
        QG(1, 4, 9);
        if (SUB(1)) { SchedG1SF S; S.nt = D / 64; S.pitchA = D; S.pitchB = D; S.multA = 1; S.multB = 128; S.G = F.G; S.c = bc; S.A = (const char*)WSP(bf16, WS_WIN); S.Bt = (const char*)WSP(bf16, WS_H0B);
          EpiG1SF E{WSP(bf16, WS_UTT)};
          gm::gemm_run<EpiG1SF, SchedG1SF, false>(F.lds, S, E); }
        QG(2, 4, 9);
        if (SUB(2)) { SchedG1SKV S; S.nt = D / 64; S.pitchA = D; S.pitchB = D; S.multA = 1; S.multB = 1; S.G = F.G; S.c = bc; S.A = (const char*)WSP(bf16, WS_WIN); S.Bt = (const char*)WSP(bf16, WS_H0B);
          EpiG1SKV E{WSP(bf16, WS_KTW), WSP(bf16, WS_BCAT), F.dec_f, F.dec_b};
          gm::gemm_run<EpiG1SKV, SchedG1SKV, false>(F.lds, S, E); }
        QG(3, 4, 9);
    }
    SEAM(1);
    if (IN(2)) {
        QG(0, 4, 6);
        if (SUB(3)) { SchedFixA S; S.nt = 2; S.pitchA = 128; S.pitchB = 128; S.multA = 1; S.multB = 1; S.G = F.G; S.c = bc; S.A = (const char*)WSP(bf16, WS_TAB); S.Bt = (const char*)WSP(bf16, WS_UTT); S.ncol = 512;
          EpiS1 E{WSP(bf16, WS_A1)};
          gm::gemm_run<EpiS1, SchedFixA, false>(F.lds, S, E); }
        QG(1, 4, 6);
        if (SUB(4)) { SchedScores S; S.nt = 4; S.pitchA = RW; S.pitchB = RW; S.multA = 1; S.multB = 1; S.G = F.G; S.c = bc; S.Q = (const char*)WSP(bf16, WS_QS); S.Kk = (const char*)WSP(bf16, WS_KK);
          EpiScores E{WSP(bf16, WS_ACAT), F.dec_f, F.dec_b};
          gm::gemm_run<EpiScores, SchedScores, false>(F.lds, S, E); }
        QG(2, 4, 6);
        if (SUB(5)) { SchedKV S; S.nt = 4; S.pitchA = CAT; S.pitchB = T; S.multA = 1; S.multB = 1; S.G = F.G; S.c = bc; S.Bcat = (const char*)WSP(bf16, WS_BCAT); S.kTw = (const char*)WSP(bf16, WS_KTW);
          EpiKV E{WSP(float, WS_KVT)};
          gm::gemm_run<EpiKV, SchedKV, false>(F.lds, S, E); }
        QG(3, 4, 6);
    }
    SEAM(2);
    if (IN(3)) {
        QG(0, 3, 2);
        { SchedFixA S; S.nt = 4; S.pitchA = 256; S.pitchB = 256; S.multA = 1; S.multB = 1; S.G = F.G; S.c = bc; S.A = (const char*)(WSP(bf16, WS_TAB) + 32768); S.Bt = (const char*)WSP(bf16, WS_A1); S.ncol = 512;
          EpiS2 E{WSP(bf16, WS_ZT)};
          gm::gemm_run<EpiS2, SchedFixA, false>(F.lds, S, E); }
        QG(1, 3, 2);
        p3_scan(F);
        QG(2, 3, 2);
    }
    SEAM(3);
    if (IN(4)) {
        QG(0, 3, 4);
        { SchedFixB S; S.nt = 4; S.pitchA = 256; S.pitchB = 256; S.multA = 1; S.multB = 1; S.G = F.G; S.c = bc; S.A = (const char*)WSP(bf16, WS_ZT); S.Bt = (const char*)(WSP(bf16, WS_TAB) + 32768 + 65536); S.nrow = 512;
          EpiChan E{WSP(bf16, WS_Y)};
          gm::gemm_run<EpiChan, SchedFixB, false>(F.lds, S, E); }
        QG(1, 3, 4);
        { SchedOut S; S.nt = CAT / 64; S.pitchA = CAT; S.pitchB = CAT; S.multA = 1; S.multB = 1; S.G = F.G; S.c = bc; S.Acat = (const char*)WSP(bf16, WS_ACAT); S.Bcat = (const char*)WSP(bf16, WS_BCAT);
          EpiOut E{WSP(bf16, WS_Y), WSP(bf16, WS_GS), F.gn_g};
          gm::gemm_run<EpiOut, SchedOut, false>(F.lds, S, E); }
        QG(2, 3, 4);

    }
    SEAM(4);
    if (IN(5)) {
        QG(0, 2, 3);
        Sched2D S; S.nt = D / 64; S.pitchA = D; S.pitchB = D; S.multA = 1; S.multB = 1; S.G = F.G; S.c = bc; S.A = (const char*)WSP(bf16, WS_Y); S.Bt = (const char*)WSP(bf16, WS_WOUT); S.nM = 64; S.nN = 8;
        EpiWout E{WSP(float, WS_Z1), F.x, WSP(float, WS_ST0), F.ln0_g, F.ln0_b};
        gm::gemm_run<EpiWout, Sched2D, false>(F.lds, S, E);
        QG(1, 2, 3);
        do_slabs(F, sdone < nS ? sdone : nS, nS);
    }
    SEAM(5);
    if (IN(6)) { p6_router(F); }
    SEAM(6);
    if (IN(7) || IN(8) || IN(9) || IN(10)) build_tstart(F, tstart);
    if (IN(7)) {
        SchedMoE S; S.nt = D / 128; S.pitchA = D / 2; S.pitchB = D / 2; S.multA = 1; S.multB = 1; S.G = F.G; S.c = bc; S.A = (const char*)WSP(char, WS_H1Q); S.Bt = (const char*)WSP(char, WS_WUP);
        S.tstart = tstart; S.row_tok = WSP(int, WS_RT) + 12 * T; S.cnt = F.ctl + CW_CNT; S.nN = 16; S.rowbytes = D; S.estride = (size_t)2 * DFF * D;
        S.rsc = WSP(float, WS_RSC); S.swup = WSP(float, WS_SWUP); S.b_up = F.b_up;
        EpiUp E{WSP(bf16, WS_ACT), F.ctl + CW_RMAX};
        gm::gemm_run<EpiUp, SchedMoE, true, true, true>(F.lds, S, E);
    }
    SEAM(7);
    if (IN(8)) { p8_requant(F, tstart); }
    SEAM(8);
    if (IN(9)) {
        SchedMoEDown S; S.nt = DFF / 128; S.pitchA = DFF / 2; S.pitchB = DFF / 2; S.multA = 1; S.multB = 1; S.G = F.G; S.c = bc; S.A = (const char*)WSP(char, WS_ACTQ); S.Bt = (const char*)WSP(char, WS_WDN);
        S.tstart = tstart; S.row_tok = nullptr; S.cnt = F.ctl + CW_CNT; S.nN = 8; S.rowbytes = DFF; S.estride = (size_t)D * DFF;
        S.sa = WSP(float, WS_SA); S.swdn = WSP(float, WS_SWDN); S.b_dn = F.b_dn; S.rsc = nullptr; S.swup = nullptr; S.b_up = nullptr;
        EpiDown E{WSP(bf16, WS_YR)};
        gm::gemm_run<EpiDown, SchedMoEDown, false, true, true>(F.lds, S, E);
    }
    SEAM(9);
    if (IN(10)) { p9_combine(F, tstart); }
#undef IN
#undef SEAM
}

#ifndef MK_SPLIT
#define MK_SPLIT 0
#endif
extern "C" void kernel_launch(void* const* d_in, const int* in_sizes, int n_in, void* d_out, int out_size, void* d_ws, size_t ws_size, hipStream_t stream) {
    static int grid = 0;
    if (grid == 0) {
        if (n_in != 18 || out_size != T * D || ws_size < WS_END2) { fprintf(stderr, "kernel_launch: unexpected problem: n_in %d out %d ws %zu (need %zu)\n", n_in, out_size, ws_size, (size_t)WS_END2); grid = -1; return; }
        int dev = 0, cus = 0, per_cu = 0;
        if (hipGetDevice(&dev) != hipSuccess || hipDeviceGetAttribute(&cus, hipDeviceAttributeMultiprocessorCount, dev) != hipSuccess) { grid = -1; return; }
        if (hipFuncSetAttribute((const void*)fwd, hipFuncAttributeMaxDynamicSharedMemorySize, LDS_BYTES) != hipSuccess) { fprintf(stderr, "kernel_launch: hipFuncSetAttribute failed\n"); grid = -1; return; }
        if (hipOccupancyMaxActiveBlocksPerMultiprocessor(&per_cu, (const void*)fwd, NTHR, LDS_BYTES) != hipSuccess || per_cu < 1) { fprintf(stderr, "kernel_launch: occupancy query reports %d\n", per_cu); }
        (void)hipGetLastError();
        grid = cus;
    }
    if (grid < 0) return;
    (void)hipMemsetAsync((char*)d_ws + WS_CTL, 0, CTL_BYTES, stream);
    Args a{};
    for (int i = 0; i < 18; ++i) a.in[i] = (const float*)d_in[i];
    a.out = (float*)d_out; a.ws = (unsigned char*)d_ws;
#if MK_SPLIT
    for (int p = 0; p < NPH; ++p) { a.ph_lo = p; a.ph_hi = p + 1; hipLaunchKernelGGL(fwd, dim3(grid), dim3(NTHR), LDS_BYTES, stream, a); }
#else
    a.ph_lo = 0; a.ph_hi = NPH; hipLaunchKernelGGL(fwd, dim3(grid), dim3(NTHR), LDS_BYTES, stream, a);
#endif
}
```

```cpp
#include <hip/hip_runtime.h>
#include <cstdio>
#include <cstdint>

#define GAS __attribute__((address_space(1)))
#define LAS __attribute__((address_space(3)))
typedef unsigned short bf16;
typedef unsigned v4u __attribute__((ext_vector_type(4)));
typedef unsigned v2u __attribute__((ext_vector_type(2)));
typedef float f32x4 __attribute__((ext_vector_type(4)));
typedef float f32x2 __attribute__((ext_vector_type(2)));
typedef short bf16x8 __attribute__((ext_vector_type(8)));
typedef int i32x4 __attribute__((ext_vector_type(4)));
#define RLX_AGENT __ATOMIC_RELAXED, __HIP_MEMORY_SCOPE_AGENT
#define LDS_WAIT() asm volatile("s_waitcnt lgkmcnt(0)" ::: "memory")
#define VM_WAIT() asm volatile("s_waitcnt vmcnt(0)" ::: "memory")

constexpr int T = 16384, D = 2048, DIN = 5120, FW = 1024, RW = 1024, NH = 4, HD = 256, NE = 32, TOPK = 4, DFF = 2048;
constexpr int C2 = 256, NCH = T / C2;
constexpr int CAT = 768;
constexpr float LN_EPS = 1e-5f, GN_EPS = 1e-6f, ALPHA = 1.189207115002721f;
constexpr int RT_MAX = (T * TOPK) / 256 + NE;
constexpr int NWAVES = 8, NTHR = 512;

constexpr size_t MiB = 1u << 20;
constexpr size_t WS_CTL = 0, CTL_BYTES = 1 * MiB;
constexpr size_t WS_TAB = 1 * MiB;
constexpr size_t WS_WIN = 2 * MiB;
constexpr size_t WS_WOUT = WS_WIN + 20 * MiB;
constexpr size_t WS_WUP = WS_WOUT + 8 * MiB;
constexpr size_t WS_WDN = WS_WUP + 512 * MiB;
constexpr size_t WS_H0B = WS_WDN + 256 * MiB;
constexpr size_t WS_ST0 = WS_H0B + 64 * MiB;
constexpr size_t WS_UTT = WS_ST0 + 1 * MiB;
constexpr size_t WS_A1 = WS_UTT + 32 * MiB;
constexpr size_t WS_ZT = WS_A1 + 64 * MiB;
constexpr size_t WS_QS = WS_ZT + 64 * MiB;
constexpr size_t WS_KK = WS_QS + 32 * MiB;
constexpr size_t WS_GS = WS_KK + 32 * MiB;
constexpr size_t WS_ACAT = WS_GS + 32 * MiB;
constexpr size_t WS_BCAT = WS_ACAT + 96 * MiB;
constexpr size_t WS_KTW = WS_BCAT + 96 * MiB;
constexpr size_t WS_KVT = WS_KTW + 64 * MiB;
constexpr size_t WS_Y = WS_KVT + 128 * MiB;
constexpr size_t WS_Z1 = WS_Y + 64 * MiB;
constexpr size_t WS_H1B = WS_Z1 + 128 * MiB;
constexpr size_t WS_RT = WS_H1B + 64 * MiB;
constexpr size_t WS_ACT = WS_RT + 4 * MiB;
constexpr size_t WS_YR = WS_ACT + 288 * MiB;
constexpr size_t WS_END = WS_YR + 288 * MiB;
constexpr size_t WS_SWUP = WS_TAB + 512 * 1024;
constexpr size_t WS_H1Q = WS_H1B;
constexpr size_t WS_SX = WS_H1B + 32 * MiB, WS_RSC = WS_H1B + 40 * MiB, WS_SA = WS_H1B + 44 * MiB;
constexpr size_t WS_SWDN = WS_ST0 + 512 * 1024;
constexpr size_t WS_SWIN = WS_ST0 + 768 * 1024;
constexpr size_t WS_SX0 = WS_H0B + 40 * MiB;
constexpr size_t WS_ACTQ = WS_END;
constexpr size_t WS_END2 = WS_ACTQ + 144 * MiB;
constexpr int CW_RMAX = 16384;
constexpr int CW_BAR = 1024;
constexpr int CW_CNT = 8192;

constexpr int LDS_STAGE = 131072, LDS_SCR = 16384, LDS_CTL_OFF = LDS_STAGE + LDS_SCR, LDS_BYTES = LDS_CTL_OFF + 2048;

__device__ __forceinline__ unsigned cvt_pk_bf16(float lo, float hi) { unsigned r; asm volatile("v_cvt_pk_bf16_f32 %0, %1, %2" : "=v"(r) : "v"(lo), "v"(hi)); return r; }
__device__ __forceinline__ float bf_lo(unsigned u) { return __builtin_bit_cast(float, u << 16); }
__device__ __forceinline__ float bf_hi(unsigned u) { return __builtin_bit_cast(float, u & 0xffff0000u); }
__device__ __forceinline__ v4u pack8(const f32x4 a, const f32x4 b) { v4u w; w.x = cvt_pk_bf16(a[0], a[1]); w.y = cvt_pk_bf16(a[2], a[3]); w.z = cvt_pk_bf16(b[0], b[1]); w.w = cvt_pk_bf16(b[2], b[3]); return w; }
__device__ __forceinline__ float wave_sum(float v) {
#pragma unroll
    for (int o = 1; o < 64; o <<= 1) v += __shfl_xor(v, o);
    return v;
}
__device__ __forceinline__ float fexp(float x) { return __builtin_amdgcn_exp2f(x * 1.4426950408889634f); }
__device__ __forceinline__ void cs_rev(float rev, float& c, float& s) { const float f = __builtin_amdgcn_fractf(rev); c = __builtin_amdgcn_cosf(f); s = __builtin_amdgcn_sinf(f); }

#define XB_TMO      128
#define XB_XCNT(j)  (256  + 64 * (j))
#define XB_XSUB(j)  (1280 + 64 * (j))
#define XB_XGEN(j)  (2304 + 64 * (j))
#define XB_TOP      3328
#define XB_TOPGEN   3392
#define XCD_BAR_WORDS 3456
#define XB_SPIN_CAP (1u << 18)
__device__ __forceinline__ unsigned xb_ld(unsigned* p)              { return __hip_atomic_load(p, __ATOMIC_RELAXED, __HIP_MEMORY_SCOPE_AGENT); }
__device__ __forceinline__ unsigned xb_add(unsigned* p, unsigned v) { return __hip_atomic_fetch_add(p, v, __ATOMIC_RELAXED, __HIP_MEMORY_SCOPE_AGENT); }
__device__ __forceinline__ unsigned xb_xcc_id() { return (unsigned)__builtin_amdgcn_s_getreg((3 << 11) | 20) & 0xFu; }
#define XB_SPIN(cond, bar) do { unsigned _sp = 0; while (cond) { __builtin_amdgcn_s_sleep(1); \
    if ((++_sp & 255u) == 0u) { if (xb_ld(&(bar)[XB_TMO])) break; if (_sp > XB_SPIN_CAP) { atomicAdd(&(bar)[XB_TMO], 1u); break; } } } } while (0)
struct XcdBarrier { unsigned* bar; unsigned x; volatile LAS unsigned* st; };
__device__ __forceinline__ XcdBarrier xcd_barrier_post(unsigned* bar, volatile LAS unsigned* st) {
    XcdBarrier b; b.bar = bar; b.x = xb_xcc_id(); b.st = st;
    if (threadIdx.x == 0) (void)xb_add(&bar[XB_XCNT(b.x)], 1u);
    return b;
}
__device__ __forceinline__ void xcd_barrier_complete(unsigned* bar, unsigned x, unsigned& nloc, unsigned& nx) {
    const unsigned G = gridDim.x * gridDim.y * gridDim.z;
    unsigned sum, cnt, mine, sp = 0u;
    for (;;) {
        sum = 0u; cnt = 0u; mine = 0u;
#pragma unroll
        for (unsigned j = 0; j < 16; ++j) { const unsigned c = xb_ld(&bar[XB_XCNT(j)]); sum += c; cnt += (c > 0u) ? 1u : 0u; mine = (j == x) ? c : mine; }
        if (sum == G) break;
        __builtin_amdgcn_s_sleep(1);
        if ((++sp & 255u) == 0u) { if (xb_ld(&bar[XB_TMO])) break; if (sp > XB_SPIN_CAP) { atomicAdd(&bar[XB_TMO], 1u); break; } }
    }
    nloc = mine > 0u ? mine : 1u; nx = cnt > 0u ? cnt : 1u;
}
__device__ __forceinline__ void xcd_barrier(const XcdBarrier& b) {
    asm volatile("s_waitcnt vmcnt(0)" ::: "memory");
    __syncthreads();
    if (threadIdx.x == 0) {
        unsigned* bar = b.bar;
        __builtin_amdgcn_s_waitcnt(0);
        unsigned nloc = b.st[0], nx = b.st[1];
        if (nloc == 0u) { xcd_barrier_complete(bar, b.x, nloc, nx); b.st[0] = nloc; b.st[1] = nx; }
        const unsigned old = xb_add(&bar[XB_XSUB(b.x)], 1u);
        const unsigned gen = old / nloc;
        if (old + 1u == (gen + 1u) * nloc) {
            __builtin_amdgcn_fence(__ATOMIC_RELEASE, "agent");
            asm volatile("s_waitcnt vmcnt(0)" ::: "memory");
            const unsigned og = xb_add(&bar[XB_TOP], 1u);
            const unsigned tg = og / nx;
            if (og + 1u == (tg + 1u) * nx) xb_add(&bar[XB_TOPGEN], 1u);
            else XB_SPIN(xb_ld(&bar[XB_TOPGEN]) == tg, bar);
            __builtin_amdgcn_fence(__ATOMIC_ACQUIRE, "agent");
            xb_add(&bar[XB_XGEN(b.x)], 1u);
            asm volatile("s_waitcnt vmcnt(0)" ::: "memory");
        } else {
            XB_SPIN(xb_ld(&bar[XB_XGEN(b.x)]) == gen, bar);
            __builtin_amdgcn_fence(__ATOMIC_ACQUIRE, "agent");
            asm volatile("s_waitcnt vmcnt(0)" ::: "memory");
        }
    }
    __syncthreads();
}

namespace gm {
constexpr int BM = 256, BK = 64, HALF = 128, HTB = HALF * BK * 2, STAGE_BYTES = 8 * HTB;
__device__ __forceinline__ int lds_byte(int r, int c) { const int st = (r >> 4) * 2 + (c >> 5), rr = r & 15, cc = c & 31, ob = rr * 64 + cc * 2; return st * 1024 + (ob ^ (((ob >> 9) & 1) << 5)); }
__device__ __forceinline__ void stage_rc(int b, int& R, int& C) { const int st = b / 1024, sb = b % 1024, swz = sb ^ (((sb >> 9) & 1) << 5); R = (st >> 1) * 16 + swz / 64; C = (st & 1) * 32 + (swz % 64) / 2; }
__device__ __forceinline__ int perm32(int rho) { const int n = rho >> 4, i = rho & 15; return 8 * (i >> 2) + 4 * n + (i & 3); }

struct Unit { const char* a0; const char* a1; const char* b0; const char* b1; int p0, p1, p2, p3, q; };

__device__ __forceinline__ void tile_order(int L, int nM, int nN, int& pm, int& pn) {
    const int nwg = nM * nN; int wgid = L;
    { const int q = nwg / 8, r = nwg % 8, xcd = wgid % 8, off = wgid / 8; wgid = (xcd < r ? xcd * (q + 1) : r * (q + 1) + (xcd - r) * q) + off; }
    const int nig = 8 * nN, gid = wgid / nig, fm = gid * 8, gsz = (nM - fm) < 8 ? (nM - fm) : 8;
    pm = fm + ((wgid % nig) % gsz); pn = (wgid % nig) / gsz;
}

template <bool I8> struct AccSel { typedef f32x4 type; };
template <> struct AccSel<true> { typedef i32x4 type; };
template <class Epi, class Sched, bool GATHER, bool I8 = false, bool PREF = false>
__device__ __forceinline__ void gemm_run(LAS unsigned char* lds, const Sched& S, const Epi& E) {
    const int tid = threadIdx.x, wid = __builtin_amdgcn_readfirstlane(tid >> 6), lane = tid & 63, wr = wid >> 2, wc = wid & 3, fr = lane & 15, fq = lane >> 4;
    int nt = S.nt; asm volatile("" : "+s"(nt));
    unsigned voffA[2], voffB[2], colA[2]; int rowA[2];
#pragma unroll
    for (int i = 0; i < 2; ++i) { int R, C; stage_rc(tid * 16 + i * 8192, R, C); const int Rb = Epi::PERM ? ((R & ~31) + perm32(R & 31)) : R;
        voffA[i] = (unsigned)(R * S.multA * S.pitchA + C) * 2u; voffB[i] = (unsigned)(Rb * S.multB * S.pitchB + C) * 2u; colA[i] = (unsigned)C * 2u; rowA[i] = R; }
    const size_t kstep = (size_t)(BK * 2);
    const unsigned ldsw = (unsigned)wid * 1024u;
    const int aoff = lds_byte(wr * 64 + fr, fq * 8), boff = lds_byte(wc * 32 + fr, fq * 8);
#define G_SA(b, h) (((b) * 2 + (h)) * HTB)
#define G_SB(b, h) ((4 + (b) * 2 + (h)) * HTB)
#define G_STAGE(bufoff, gbase, voff) do { _Pragma("unroll") for (int _i = 0; _i < 2; ++_i) \
        __builtin_amdgcn_global_load_lds((const unsigned*)((const char*)(gbase) + (voff)[_i]), (LAS unsigned*)(lds + (bufoff) + ldsw + _i * 8192), 16, 0, 0); } while (0)
#define G_LDA(dst, b, h) do { _Pragma("unroll") for (int m = 0; m < 4; ++m) _Pragma("unroll") for (int k = 0; k < 2; ++k) dst[m][k] = *(const LAS bf16x8*)(lds + G_SA(b, h) + aoff + m * 2048 + k * 1024); } while (0)
#define G_LDB(dst, b, h) do { _Pragma("unroll") for (int n = 0; n < 2; ++n) _Pragma("unroll") for (int k = 0; k < 2; ++k) dst[n][k] = *(const LAS bf16x8*)(lds + G_SB(b, h) + boff + n * 2048 + k * 1024); } while (0)
#define G_MMA(ai, bj, At, Bt) do { __builtin_amdgcn_s_setprio(1); _Pragma("unroll") for (int m = 0; m < 4; ++m) _Pragma("unroll") for (int n = 0; n < 2; ++n) _Pragma("unroll") for (int k = 0; k < 2; ++k) \
        { if constexpr (I8) acc[ai][bj][m][n] = __builtin_amdgcn_mfma_i32_16x16x64_i8(__builtin_bit_cast(i32x4, Bt[n][k]), __builtin_bit_cast(i32x4, At[m][k]), acc[ai][bj][m][n], 0, 0, 0); \
          else acc[ai][bj][m][n] = __builtin_amdgcn_mfma_f32_16x16x32_bf16(Bt[n][k], At[m][k], acc[ai][bj][m][n], 0, 0, 0); } __builtin_amdgcn_s_setprio(0); } while (0)
#define G_WAIT_V(n) asm volatile("s_waitcnt vmcnt(" #n ")" ::: "memory")
#define G_WAIT_L(n) asm volatile("s_waitcnt lgkmcnt(" #n ")" ::: "memory")
#define G_BAR __builtin_amdgcn_s_barrier()
#define G_SCHED __builtin_amdgcn_sched_barrier(0)
    Unit cur, nxt; int ui = 0;
    if (!S.next(0, cur)) return;
    cur.q = 0;
    if constexpr (PREF) { S.prefetch(cur, lds); G_WAIT_V(0); G_BAR; }
    typedef typename AccSel<I8>::type acc_t;
    acc_t acc[2][2][4][2];
#pragma unroll
    for (int a = 0; a < 2; ++a)
#pragma unroll
        for (int b = 0; b < 2; ++b)
#pragma unroll
            for (int m = 0; m < 4; ++m)
#pragma unroll
                for (int n = 0; n < 2; ++n) acc[a][b][m][n] = (acc_t){0, 0, 0, 0};
    bf16x8 At[4][2], B0[2][2], B1[2][2];
    unsigned gc0[2], gc1[2];
    if constexpr (GATHER) {
#pragma unroll
        for (int i = 0; i < 2; ++i) { gc0[i] = S.row_off(cur, rowA[i], lds) + colA[i]; gc1[i] = S.row_off(cur, 128 + rowA[i], lds) + colA[i]; }
    }
#define vA0 (GATHER ? gc0 : voffA)
#define vA1 (GATHER ? gc1 : voffA)
    G_STAGE(G_SB(0, 0), cur.b0, voffB); G_STAGE(G_SB(0, 1), cur.b1, voffB); G_STAGE(G_SA(0, 0), cur.a0, vA0); G_STAGE(G_SA(0, 1), cur.a1, vA1);
    if (wr == 1) G_BAR;
    G_WAIT_V(2); G_BAR;
    G_STAGE(G_SB(1, 0), cur.b0 + kstep, voffB); G_STAGE(G_SA(1, 0), cur.a0 + kstep, vA0); G_STAGE(G_SB(1, 1), cur.b1 + kstep, voffB);
    G_WAIT_V(6); G_BAR;
    for (;;) {
        const bool has_next = S.next(ui + 1, nxt);
        if (!has_next) nxt = cur;
        nxt.q = (ui + 1) & 1;
        for (int t = 0; t < nt; t += 2) {
            const bool last = (t == nt - 2);
            if constexpr (PREF) { if (t == nt - 4) S.prefetch(nxt, lds); }
            const char* a11 = cur.a1 + (size_t)(t + 1) * kstep;
            const char* a02 = last ? nxt.a0 : cur.a0 + (size_t)(t + 2) * kstep; const char* a12 = last ? nxt.a1 : cur.a1 + (size_t)(t + 2) * kstep;
            const char* b02 = last ? nxt.b0 : cur.b0 + (size_t)(t + 2) * kstep; const char* b12 = last ? nxt.b1 : cur.b1 + (size_t)(t + 2) * kstep;
            G_LDB(B0, 0, 0); G_LDB(B1, 0, 1); G_SCHED; G_LDA(At, 0, 0); G_STAGE(G_SA(1, 1), a11, vA1);
            if constexpr (GATHER) { if (last) { int tz = tid; asm volatile("" : "+v"(tz));
#pragma unroll
                for (int i = 0; i < 2; ++i) { int R, C; stage_rc(tz * 16 + i * 8192, R, C); gc0[i] = S.row_off(nxt, R, lds) + (unsigned)C * 2u; gc1[i] = S.row_off(nxt, 128 + R, lds) + (unsigned)C * 2u; } } }
            G_WAIT_V(8); G_WAIT_L(0); G_BAR; G_MMA(0, 0, At, B0); G_MMA(0, 1, At, B1); G_BAR; G_SCHED;
            G_LDA(At, 0, 1); G_STAGE(G_SB(0, 0), b02, voffB); G_STAGE(G_SB(0, 1), b12, voffB); G_STAGE(G_SA(0, 0), a02, vA0);
            G_WAIT_V(8); G_WAIT_L(0); G_BAR; G_MMA(1, 0, At, B0); G_MMA(1, 1, At, B1); G_BAR; G_SCHED;
            G_LDB(B0, 1, 0); G_LDB(B1, 1, 1); G_SCHED; G_LDA(At, 1, 0); G_STAGE(G_SA(0, 1), a12, vA1);
            G_WAIT_V(8); G_WAIT_L(0); G_BAR; G_MMA(0, 0, At, B0); G_MMA(0, 1, At, B1); G_BAR; G_SCHED;
            G_LDA(At, 1, 1); G_STAGE(G_SB(1, 0), b02 + kstep, voffB); G_STAGE(G_SB(1, 1), b12 + kstep, voffB); G_STAGE(G_SA(1, 0), a02 + kstep, vA0);
            G_WAIT_V(8); G_WAIT_L(0); G_BAR; G_MMA(1, 0, At, B0); G_MMA(1, 1, At, B1); G_BAR; G_SCHED;
        }
        if (wr == 0) G_BAR;
        { int fr2 = fr, fq2 = fq; asm volatile("" : "+v"(fr2), "+v"(fq2));
          E(acc, cur, lds, wr, wc, fr2, fq2); }
        if (!has_next) break;
#pragma unroll
        for (int a = 0; a < 2; ++a)
#pragma unroll
            for (int b = 0; b < 2; ++b)
#pragma unroll
                for (int m = 0; m < 4; ++m)
#pragma unroll
                    for (int n = 0; n < 2; ++n) acc[a][b][m][n] = (acc_t){0, 0, 0, 0};
        cur = nxt; ++ui;
        if (wr == 1) G_BAR;
    }
    G_WAIT_V(0);
    G_BAR;
#undef G_SA
#undef G_SB
#undef G_STAGE
#undef G_LDA
#undef G_LDB
#undef G_MMA
#undef G_WAIT_V
#undef G_WAIT_L
#undef G_BAR
#undef G_SCHED
#undef vA0
#undef vA1
}
}
using gm::Unit;
typedef f32x4 Acc[2][2][4][2];
typedef i32x4 AccI[2][2][4][2];

struct Args { const float* in[18]; float* out; unsigned char* ws; int ph_lo, ph_hi; };
struct Frame {
    LAS unsigned char* lds; unsigned char* ws; unsigned* ctl;
    int tid, lane, wave, vcu, G;
    const float *x, *ln0_g, *ln0_b, *w_in, *dec_f, *dec_b, *gn_g, *w_out, *ln1_g, *ln1_b, *w_r, *b_r, *w_up, *b_up, *w_dn, *b_dn, *ln2_g, *ln2_b;
    float* out;
};
#define WSP(T_, off) ((T_*)(F.ws + (off)))

template <class ColMap>
__device__ __forceinline__ void transpose_item(const float* W, int K, int N, bf16* WT, LAS float* scr, int item, int lane, const ColMap& cm) {
    const int nblk = N / 64, kb = item / nblk, nb = item % nblk, k0 = 64 * kb, n0 = 64 * nb;
    const int s0 = cm(n0);
#pragma unroll 4
    for (int i = 0; i < 16; ++i) { const int kk = 4 * i + (lane >> 4), c4 = (lane & 15) * 4;
        const f32x4 v = *(const GAS f32x4*)(W + (size_t)(k0 + kk) * N + s0 + c4);
        LAS float* d = scr + kk * 65 + c4; d[0] = v[0]; d[1] = v[1]; d[2] = v[2]; d[3] = v[3]; }
    LDS_WAIT(); asm volatile("" ::: "memory");
    const int c = lane & 7;
#pragma unroll
    for (int j = 0; j < 8; ++j) { const int n = (lane >> 3) + 8 * j; const LAS float* s = scr + (8 * c) * 65 + n;
        v4u o; o.x = cvt_pk_bf16(s[0 * 65], s[1 * 65]); o.y = cvt_pk_bf16(s[2 * 65], s[3 * 65]); o.z = cvt_pk_bf16(s[4 * 65], s[5 * 65]); o.w = cvt_pk_bf16(s[6 * 65], s[7 * 65]);
        *(GAS v4u*)(WT + (size_t)(n0 + n) * K + k0 + 8 * c) = o; }
    LDS_WAIT(); asm volatile("" ::: "memory");
}
struct ColId { __device__ __forceinline__ int operator()(int n) const { return n; } };
struct ColUp { __device__ __forceinline__ int operator()(int n) const { return ((n >> 8) * 128 + (n & 127)) + ((n >> 7) & 1) * 2048; } };

__device__ __forceinline__ void p0_prologue(Frame& F) {
    const int gw = F.vcu * NWAVES + F.wave, NGW = F.G * NWAVES;
    {
        unsigned* h0q = WSP(unsigned, WS_H0B); float* st0 = WSP(float, WS_ST0); float* sx0 = WSP(float, WS_SX0);
        for (int m = gw; m < T; m += NGW) {
            const GAS f32x4* xr = (const GAS f32x4*)(F.x + (size_t)m * D) + F.lane;
            f32x4 v[8]; float s = 0.f;
#pragma unroll
            for (int j = 0; j < 8; ++j) { v[j] = xr[64 * j]; s += (v[j][0] + v[j][1]) + (v[j][2] + v[j][3]); }
            const float mean = wave_sum(s) * (1.f / D); float s2 = 0.f;
#pragma unroll
            for (int j = 0; j < 8; ++j) { v[j] = v[j] - mean; s2 += (v[j][0] * v[j][0] + v[j][1] * v[j][1]) + (v[j][2] * v[j][2] + v[j][3] * v[j][3]); }
            const float rstd = 1.f / sqrtf(wave_sum(s2) * (1.f / D) + LN_EPS); float am = 0.f;
#pragma unroll
            for (int j = 0; j < 8; ++j) { const f32x4 g = *((const GAS f32x4*)F.ln0_g + F.lane + 64 * j), b = *((const GAS f32x4*)F.ln0_b + F.lane + 64 * j);
                v[j] = v[j] * rstd * g + b; am = fmaxf(am, fmaxf(fmaxf(fabsf(v[j][0]), fabsf(v[j][1])), fmaxf(fabsf(v[j][2]), fabsf(v[j][3])))); }
#pragma unroll
            for (int o = 1; o < 64; o <<= 1) am = fmaxf(am, __shfl_xor(am, o));
            const float sc = am > 0.f ? am * (1.f / 127.f) : 1.f, inv = 1.f / sc;
#pragma unroll
            for (int j = 0; j < 8; ++j) { const int q0 = (int)__builtin_rintf(v[j][0] * inv), q1 = (int)__builtin_rintf(v[j][1] * inv), q2 = (int)__builtin_rintf(v[j][2] * inv), q3 = (int)__builtin_rintf(v[j][3] * inv);
                h0q[(size_t)m * (D / 4) + F.lane + 64 * j] = (unsigned)(q0 & 0xff) | ((unsigned)(q1 & 0xff) << 8) | ((unsigned)(q2 & 0xff) << 16) | ((unsigned)(q3 & 0xff) << 24); }
            if (F.lane == 0) { st0[2 * m] = mean; st0[2 * m + 1] = rstd; sx0[m] = sc; }
        }
    }
    {
        bf16* tab = WSP(bf16, WS_TAB);
        for (int i = (F.vcu * NTHR + F.tid); i < 32768 + 65536 + 65536; i += F.G * NTHR) {
            float v;
            if (i < 32768) { const int r = i >> 7, a = i & 127, ri = r >> 7, k1 = r & 127; float c, s; cs_rev((float)((k1 * a) & 127) * (1.f / 128.f), c, s); v = ri ? -s : c; }
            else if (i < 32768 + 65536) { const int e = i - 32768, r = e >> 8, q = e & 255, ri = r >> 7, k2 = r & 127, rj = q >> 7, b = q & 127; float c, s; cs_rev((float)((k2 * b) & 127) * (1.f / 128.f), c, s);
                v = (ri == 0) ? (rj == 0 ? c : s) : (rj == 0 ? -s : c); }
            else { const int e = i - 32768 - 65536, l = e >> 8, q = e & 255, rj = q >> 7, cg = q & 127; float c, s; cs_rev((float)((l * cg) & 127) * (1.f / 128.f), c, s); v = (l < 128) ? (rj == 0 ? c : s) : 0.f; }
            tab[i] = (bf16)(cvt_pk_bf16(v, 0.f) & 0xffffu);
        }
    }
    {
        LAS float* scr = (LAS float*)(F.lds + F.wave * 18432);
        constexpr int I_IN = 32 * (DIN / 64), I_OUT = 32 * (D / 64), I_UP = 32 * (2 * DFF / 64), I_DN = 32 * (D / 64);
        constexpr int NIT = I_OUT;
        for (int it = gw; it < NIT; it += NGW) {
            int r = it;
            { transpose_item(F.w_out, D, D, WSP(bf16, WS_WOUT), scr, r, F.lane, ColId()); }
        }
    }
}

struct SlabDesc { const float* W; signed char* WQ; float* sw; int NS, e, n0, valid; };
struct QF { unsigned char* ws; const float* w_up; const float* w_dn; const float* w_in; int vcu, G; };
__device__ __forceinline__ SlabDesc slab_desc(const QF& F, int j) {
    const int nU = (NE * 128 + F.G - 1) / F.G; SlabDesc d;
    if (j < 0) { const int sl = F.vcu + (-1 - j) * F.G; d.valid = sl < DIN / 32; d.NS = DIN; d.e = 0; d.n0 = sl * 32; d.W = F.w_in + d.n0; d.WQ = (signed char*)WSP(char, WS_WIN); d.sw = WSP(float, WS_SWIN); }
    else if (j < nU) { const int sl = F.vcu + j * F.G; d.valid = sl < NE * 128; d.NS = 2 * DFF; d.e = sl >> 7; d.n0 = (sl & 127) * 32; d.W = F.w_up + (size_t)d.e * D * 2 * DFF + ColUp()(d.n0); d.WQ = (signed char*)WSP(char, WS_WUP); d.sw = WSP(float, WS_SWUP); }
    else { const int sl = F.vcu + (j - nU) * F.G; d.valid = sl < NE * 64; d.NS = D; d.e = sl >> 6; d.n0 = (sl & 63) * 32; d.W = F.w_dn + (size_t)d.e * DFF * D + d.n0; d.WQ = (signed char*)WSP(char, WS_WDN); d.sw = WSP(float, WS_SWDN); }
    return d;
}
#define SLAB_LOAD(dsc, v) do { if ((dsc).valid) { const GAS char* b_ = (const GAS char*)(dsc).W; unsigned o_ = (unsigned)((wave * 256 + kq) * (dsc).NS + c4) * 4u; const unsigned st_ = (unsigned)(dsc).NS * 32u; \
    _Pragma("unroll") for (int i_ = 0; i_ < 32; ++i_) { v[i_] = __builtin_nontemporal_load((const GAS f32x4*)(b_ + o_)); o_ += st_; } } } while (0)
__device__ __forceinline__ void do_slabs_impl(LAS unsigned char* lds, unsigned char* ws, const float* w_up, const float* w_dn, const float* w_in, int vcu, int G, int j0, int j1) {
    if (j0 >= j1) return;
    QF F; F.ws = ws; F.w_up = w_up; F.w_dn = w_dn; F.w_in = w_in; F.vcu = vcu; F.G = G;
    const int tid = threadIdx.x, lane = tid & 63, wave = __builtin_amdgcn_readfirstlane(tid >> 6);
    constexpr int PITCH = 2056;
    LAS bf16* slab = (LAS bf16*)lds;
    LAS float* red = (LAS float*)(lds + 32 * PITCH * 2);
    const int kq = lane >> 3, c4 = (lane & 7) * 4;
    f32x4 v[32];
    SlabDesc cur = slab_desc(F, j0);
    SLAB_LOAD(cur, v);
    for (int j = j0; j < j1; ++j) {
        if (cur.valid) {
            f32x4 mx = (f32x4){0.f, 0.f, 0.f, 0.f};
#pragma unroll
            for (int i = 0; i < 32; ++i) { const int k = wave * 256 + i * 8 + kq; const f32x4 x = v[i];
                mx[0] = fmaxf(mx[0], fabsf(x[0])); mx[1] = fmaxf(mx[1], fabsf(x[1])); mx[2] = fmaxf(mx[2], fabsf(x[2])); mx[3] = fmaxf(mx[3], fabsf(x[3]));
                const unsigned p01 = cvt_pk_bf16(x[0], x[1]), p23 = cvt_pk_bf16(x[2], x[3]);
                const int ks = k ^ (((c4 >> 3) & 3) << 3);
                slab[(c4 + 0) * PITCH + ks] = (bf16)(p01 & 0xffffu); slab[(c4 + 1) * PITCH + ks] = (bf16)(p01 >> 16); slab[(c4 + 2) * PITCH + ks] = (bf16)(p23 & 0xffffu); slab[(c4 + 3) * PITCH + ks] = (bf16)(p23 >> 16); }
#pragma unroll
            for (int q = 0; q < 4; ++q) { float m = mx[q]; m = fmaxf(m, __shfl_xor(m, 8)); m = fmaxf(m, __shfl_xor(m, 16)); m = fmaxf(m, __shfl_xor(m, 32)); mx[q] = m; }
            if (lane < 8) { LAS float* d = red + wave * 32 + c4; d[0] = mx[0]; d[1] = mx[1]; d[2] = mx[2]; d[3] = mx[3]; }
        }
        const SlabDesc done = cur;
        if (j + 1 < j1) { cur = slab_desc(F, j + 1); SLAB_LOAD(cur, v); }
        __syncthreads();
        if (done.valid && tid < 32) { float m = 0.f;
#pragma unroll
            for (int w = 0; w < 8; ++w) m = fmaxf(m, red[w * 32 + tid]);
            const float sc = m > 0.f ? m * (1.f / 127.f) : 1.f; done.sw[(size_t)done.e * done.NS + done.n0 + tid] = sc; red[256 + tid] = 1.f / sc; }
        __syncthreads();
        if (done.valid) {
#pragma unroll 2
            for (int i = 0; i < 8; ++i) { const int q = tid + NTHR * i, n = q >> 7, kc = q & 127; const float inv = red[256 + n];
                const int sx_ = ((n >> 3) & 3) << 3;
                const v4u a = *(const LAS v4u*)(slab + n * PITCH + ((kc * 16) ^ sx_)), b = *(const LAS v4u*)(slab + n * PITCH + ((kc * 16 + 8) ^ sx_));
                const unsigned src[8] = {a.x, a.y, a.z, a.w, b.x, b.y, b.z, b.w}; unsigned o[4];
#pragma unroll
                for (int d = 0; d < 4; ++d) { unsigned w = 0u;
#pragma unroll
                    for (int h2 = 0; h2 < 2; ++h2) { const unsigned u2 = src[2 * d + h2]; const int q0 = (int)__builtin_rintf(bf_lo(u2) * inv), q1 = (int)__builtin_rintf(bf_hi(u2) * inv);
                        w |= ((unsigned)(q0 & 0xff) << (16 * h2)) | ((unsigned)(q1 & 0xff) << (16 * h2 + 8)); }
                    o[d] = w; }
                *(GAS v4u*)(done.WQ + ((size_t)done.e * done.NS + done.n0 + n) * D + kc * 16) = (v4u){o[0], o[1], o[2], o[3]}; }
        }
        __syncthreads();
    }
}

__device__ __forceinline__ void do_slabs(Frame& F, int j0, int j1) { do_slabs_impl(F.lds, F.ws, F.w_up, F.w_dn, F.w_in, F.vcu, F.G, j0, j1); }

struct SchedBase { int nt, pitchA, pitchB, multA, multB, G, c; };
struct SchedG1N : SchedBase {
    const char* A; const char* Bt;
    __device__ __forceinline__ bool next(int i, Unit& u) const { const int L = i * G + c; if (L >= 64 * 12) return false; int pm, pn; gm::tile_order(L, 64, 12, pm, pn);
        const int cb = pn < 4 ? 1024 + 256 * pn : (pn < 8 ? 2048 + 256 * (pn - 4) : 4096 + 256 * (pn - 8));
        u.a0 = A + (size_t)pm * 256 * D; u.a1 = u.a0 + (size_t)128 * D; u.b0 = Bt + (size_t)cb * D; u.b1 = u.b0 + (size_t)128 * D; u.p0 = pm; u.p1 = pn; u.p2 = cb; u.p3 = 0; return true; }
};
struct SchedG1SF : SchedBase {
    const char* A; const char* Bt;
    __device__ __forceinline__ bool next(int i, Unit& u) const { const int L = i * G + c; if (L >= 4 * 64) return false; int pm, pn; gm::tile_order(L, 4, 64, pm, pn);
        u.a0 = A + (size_t)pm * 256 * D; u.a1 = u.a0 + (size_t)128 * D; u.b0 = Bt + (size_t)(2 * pn) * D; u.b1 = u.b0 + (size_t)D; u.p0 = pm; u.p1 = pn; u.p2 = 0; u.p3 = 0; return true; }
};
struct SchedG1SKV : SchedBase {
    const char* A; const char* Bt;
    __device__ __forceinline__ bool next(int i, Unit& u) const { const int L = i * G + c; if (L >= 8 * 64) return false; int pm, pn; gm::tile_order(L, 8, 64, pm, pn);
        const int rb = pm < 4 ? 2048 + 256 * pm : 3072 + 256 * (pm - 4);
        u.a0 = A + (size_t)rb * D; u.a1 = u.a0 + (size_t)128 * D; u.b0 = Bt + (size_t)pn * 256 * D; u.b1 = u.b0 + (size_t)128 * D; u.p0 = pm; u.p1 = pn; u.p2 = rb; u.p3 = 0; return true; }
};
struct SchedFixA : SchedBase {
    const char* A; const char* Bt; int ncol;
    __device__ __forceinline__ bool next(int i, Unit& u) const { const int L = i * G + c; if (L >= ncol) return false;
        u.a0 = A; u.a1 = A + (size_t)128 * pitchA * 2; u.b0 = Bt + (size_t)L * 256 * pitchB * 2; u.b1 = u.b0 + (size_t)128 * pitchB * 2; u.p0 = 0; u.p1 = L; u.p2 = 0; u.p3 = 0; return true; }
};
struct SchedFixB : SchedBase {
    const char* A; const char* Bt; int nrow;
    __device__ __forceinline__ bool next(int i, Unit& u) const { const int L = i * G + c; if (L >= nrow) return false;
        u.a0 = A + (size_t)L * 256 * pitchA * 2; u.a1 = u.a0 + (size_t)128 * pitchA * 2; u.b0 = Bt; u.b1 = Bt + (size_t)128 * pitchB * 2; u.p0 = L; u.p1 = 0; u.p2 = 0; u.p3 = 0; return true; }
};
struct SchedScores : SchedBase {
    const char* Q; const char* Kk;
    __device__ __forceinline__ bool next(int i, Unit& u) const { const int L = i * G + c; if (L >= NH * NCH) return false; const int h = L & 3, n = L >> 2;
        u.a0 = Q + ((size_t)n * 256 * RW + h * HD) * 2; u.a1 = u.a0 + (size_t)128 * RW * 2; u.b0 = Kk + ((size_t)n * 256 * RW + h * HD) * 2; u.b1 = u.b0 + (size_t)128 * RW * 2; u.p0 = h; u.p1 = n; u.p2 = 0; u.p3 = 0; return true; }
};
struct SchedKV : SchedBase {
    const char* Bcat; const char* kTw;
    __device__ __forceinline__ bool next(int i, Unit& u) const { const int L = i * G + c; if (L >= 2 * NH * NCH) return false; const int dh = L & 7, n = L >> 3, dir = dh >> 2, h = dh & 3;
        u.a0 = Bcat + ((size_t)(h * NCH + n) * 256 * CAT) * 2; u.a1 = u.a0 + (size_t)128 * CAT * 2;
        u.b0 = kTw + (((size_t)dir * RW + h * HD) * T + (size_t)n * 256) * 2; u.b1 = u.b0 + (size_t)128 * T * 2; u.p0 = dh; u.p1 = n; u.p2 = 0; u.p3 = 0; return true; }
};
struct SchedOut : SchedBase {
    const char* Acat; const char* Bcat;
    __device__ __forceinline__ bool next(int i, Unit& u) const { const int L = i * G + c; if (L >= NH * NCH) return false; const int h = L & 3, n = L >> 2;
        u.a0 = Acat + ((size_t)h * T + (size_t)n * 256) * CAT * 2; u.a1 = u.a0 + (size_t)128 * CAT * 2; u.b0 = Bcat + ((size_t)(h * NCH + n) * 256 * CAT) * 2; u.b1 = u.b0 + (size_t)128 * CAT * 2; u.p0 = h; u.p1 = n; u.p2 = 0; u.p3 = 0; return true; }
};
struct Sched2D : SchedBase {
    const char* A; const char* Bt; int nM, nN;
    __device__ __forceinline__ bool next(int i, Unit& u) const { const int L = i * G + c; if (L >= nM * nN) return false; int pm, pn; gm::tile_order(L, nM, nN, pm, pn);
        u.a0 = A + (size_t)pm * 256 * pitchA * 2; u.a1 = u.a0 + (size_t)128 * pitchA * 2; u.b0 = Bt + (size_t)pn * 256 * pitchB * 2; u.b1 = u.b0 + (size_t)128 * pitchB * 2; u.p0 = pm; u.p1 = pn; u.p2 = 0; u.p3 = 0; return true; }
};
struct SchedMoE : SchedBase {
    const char* A; const char* Bt; const LAS int* tstart; const int* row_tok; const unsigned* cnt; int nN, rowbytes; size_t estride;
    __device__ __forceinline__ bool next(int i, Unit& u) const { const int RT = __builtin_amdgcn_readfirstlane(tstart[NE]); const int L = i * G + c; if (L >= RT * nN) return false; int rt, pn; gm::tile_order(L, RT, nN, rt, pn);
        const int e = __builtin_amdgcn_readfirstlane(tstart[40 + rt]);
        u.b0 = Bt + (size_t)e * estride + (size_t)pn * 256 * rowbytes; u.b1 = u.b0 + (size_t)128 * rowbytes;
        u.a0 = A; u.a1 = A;
        u.p0 = rt; u.p1 = pn; u.p2 = e; u.p3 = (rt - __builtin_amdgcn_readfirstlane(tstart[e])) * 256; return true; }
    const float *rsc, *swup, *b_up;
    __device__ __forceinline__ void prefetch(const Unit& u, LAS unsigned char* lds) const {
        LAS unsigned char* blk = lds + LDS_STAGE + u.q * 4096;
        const int wid = __builtin_amdgcn_readfirstlane(threadIdx.x >> 6), lane = threadIdx.x & 63, e = u.p2;
        const int n = (int)cnt[64 * e]; int pos = u.p3 + (wid & 3) * 64 + lane; pos = pos < n ? pos : n - 1;
        if (wid < 4) __builtin_amdgcn_global_load_lds((const unsigned*)(row_tok + (size_t)e * T + pos), (LAS unsigned*)(blk + wid * 256), 4, 0, 0);
        else __builtin_amdgcn_global_load_lds((const unsigned*)(rsc + (size_t)e * T + pos), (LAS unsigned*)(blk + 1024 + (wid - 4) * 256), 4, 0, 0);
        if (wid == 0) __builtin_amdgcn_global_load_lds((const unsigned*)(swup + (size_t)e * 2 * DFF + u.p1 * 256 + lane * 4), (LAS unsigned*)(blk + 2048), 16, 0, 0);
        if (wid == 1) __builtin_amdgcn_global_load_lds((const unsigned*)(b_up + (size_t)e * 2 * DFF + u.p1 * 128 + (lane & 31) * 4 + (lane >> 5) * DFF), (LAS unsigned*)(blk + 3072), 16, 0, 0);
    }
    __device__ __forceinline__ unsigned row_off(const Unit& u, int r, LAS unsigned char* lds) const { return (unsigned)((const LAS int*)(lds + LDS_STAGE + u.q * 4096))[r] * (unsigned)rowbytes; }
};
struct SchedMoEDown : SchedMoE {
    const float *sa, *swdn, *b_dn;
    __device__ __forceinline__ bool next(int i, Unit& u) const { if (!SchedMoE::next(i, u)) return false; u.a0 = A + (size_t)u.p0 * 256 * rowbytes; u.a1 = u.a0 + (size_t)128 * rowbytes; return true; }
    __device__ __forceinline__ void prefetch(const Unit& u, LAS unsigned char* lds) const {
        LAS unsigned char* blk = lds + LDS_STAGE + u.q * 4096;
        const int wid = __builtin_amdgcn_readfirstlane(threadIdx.x >> 6), lane = threadIdx.x & 63, e = u.p2;
        if (wid == 0) __builtin_amdgcn_global_load_lds((const unsigned*)(sa + (size_t)u.p0 * 256 + lane * 4), (LAS unsigned*)(blk), 16, 0, 0);
        if (wid == 1) __builtin_amdgcn_global_load_lds((const unsigned*)(swdn + (size_t)e * D + u.p1 * 256 + lane * 4), (LAS unsigned*)(blk + 1024), 16, 0, 0);
        if (wid == 2) __builtin_amdgcn_global_load_lds((const unsigned*)(b_dn + (size_t)e * D + u.p1 * 256 + lane * 4), (LAS unsigned*)(blk + 2048), 16, 0, 0);
    }
};

#define EPI_LOOP_AM for (int ai = 0; ai < 2; ++ai) _Pragma("unroll") for (int m = 0; m < 4; ++m)
#define EPI_FENCE __builtin_amdgcn_sched_barrier(0)
struct EpiG1N {
    static constexpr bool PERM = true;
    bf16 *qs, *kk, *gs, *Acat; const float *dec_f, *dec_b, *sx0, *swin;
    __device__ __forceinline__ void operator()(AccI& acci, const Unit& u, LAS unsigned char*, int wr, int wc, int fr, int fq) const {
        const int pm = u.p0, pn = u.p1, c0 = wc * 32 + 8 * fq;
        f32x4 swc[2][2];
#pragma unroll
        for (int bj = 0; bj < 2; ++bj)
#pragma unroll
            for (int n = 0; n < 2; ++n) swc[bj][n] = *(const GAS f32x4*)(swin + u.p2 + 128 * bj + c0 + 4 * n);
#define ACCF(ai_, bj_, m_, n_, j_) ((float)acci[ai_][bj_][m_][n_][j_] * (sxr * swc[bj_][n_][j_]))
        if (pn < 8) {
            const int h = pn & 3; const bool isq = pn < 4;
            float inv[8];
#pragma unroll
            for (int e = 0; e < 8; ++e) inv[e] = __builtin_amdgcn_exp2f(-(float)(c0 + e) * (13.287712379549449f / 128.f)) * 0.15915494309189535f;
            const float lgf = -fexp(dec_f[h]), lgb = -fexp(dec_b[h]);
#pragma unroll
            EPI_LOOP_AM {
                const int r = 128 * ai + 64 * wr + 16 * m + fr, tok = pm * 256 + r; const float pos = (float)tok; const float sxr = sx0[tok];
                f32x4 o1[2], o2[2];
#pragma unroll
                for (int n = 0; n < 2; ++n)
#pragma unroll
                    for (int j = 0; j < 4; ++j) { float c, s; cs_rev(pos * inv[4 * n + j], c, s); const float x1 = ACCF(ai, 0, m, n, j), x2 = ACCF(ai, 1, m, n, j); o1[n][j] = x1 * c - x2 * s; o2[n][j] = x2 * c + x1 * s; }
                if (isq) {
                    bf16* q = qs + (size_t)tok * RW + h * HD + c0; *(GAS v4u*)q = pack8(o1[0], o1[1]); *(GAS v4u*)(q + 128) = pack8(o2[0], o2[1]);
                    const int il = r; const float wf = fexp(lgf * (float)(il + 1)), wb = fexp(lgb * (float)(255 - il));
                    bf16* a = Acat + ((size_t)h * T + tok) * CAT + c0;
                    *(GAS v4u*)(a + 256) = pack8(o1[0] * wf, o1[1] * wf); *(GAS v4u*)(a + 384) = pack8(o2[0] * wf, o2[1] * wf);
                    *(GAS v4u*)(a + 512) = pack8(o1[0] * wb, o1[1] * wb); *(GAS v4u*)(a + 640) = pack8(o2[0] * wb, o2[1] * wb);
                } else {
                    bf16* k = kk + (size_t)tok * RW + h * HD + c0; *(GAS v4u*)k = pack8(o1[0] * 0.0625f, o1[1] * 0.0625f); *(GAS v4u*)(k + 128) = pack8(o2[0] * 0.0625f, o2[1] * 0.0625f);
                }
            }
        } else {
#pragma unroll
            EPI_LOOP_AM {
                const int r = 128 * ai + 64 * wr + 16 * m + fr, tok = pm * 256 + r; const float sxr = sx0[tok];
#pragma unroll
                for (int bj = 0; bj < 2; ++bj) { f32x4 v[2];
#pragma unroll
                    for (int n = 0; n < 2; ++n)
#pragma unroll
                        for (int j = 0; j < 4; ++j) { const float g = ACCF(ai, bj, m, n, j); v[n][j] = g * __builtin_amdgcn_rcpf(1.f + fexp(-g)); }
                    *(GAS v4u*)(gs + (size_t)tok * RW + (pn - 8) * 256 + bj * 128 + c0) = pack8(v[0], v[1]); }
            }
        }
    }
};
#undef ACCF
struct EpiG1SF {
    static constexpr bool PERM = true;
    bf16* uTT; const float *sx0, *swin;
    __device__ __forceinline__ void operator()(AccI& acc, const Unit& u, LAS unsigned char*, int wr, int wc, int fr, int fq) const {
        const int a0 = wc * 32 + 8 * fq;
        float sxc[2][8];
#pragma unroll
        for (int bj = 0; bj < 2; ++bj)
#pragma unroll
            for (int e = 0; e < 8; ++e) sxc[bj][e] = sx0[128 * (a0 + e) + 2 * u.p1 + bj];
#pragma unroll
        EPI_LOOP_AM { const int cch = u.p0 * 256 + 128 * ai + 64 * wr + 16 * m + fr; const float swr = swin[cch];
#pragma unroll
            for (int bj = 0; bj < 2; ++bj) { f32x4 v0, v1;
#pragma unroll
                for (int j = 0; j < 4; ++j) { v0[j] = (float)acc[ai][bj][m][0][j] * (swr * sxc[bj][j]); v1[j] = (float)acc[ai][bj][m][1][j] * (swr * sxc[bj][4 + j]); }
                *(GAS v4u*)(uTT + ((size_t)cch * 128 + (2 * u.p1 + bj)) * 128 + a0) = pack8(v0, v1); } }
    }
};
struct EpiG1SKV {
    static constexpr bool PERM = true;
    bf16 *kTw, *Bcat; const float *dec_f, *dec_b, *sx0, *swin;
    __device__ __forceinline__ void operator()(AccI& acc, const Unit& u, LAS unsigned char*, int wr, int wc, int fr, int fq) const {
        const int pm = u.p0, n_ch = u.p1, c0 = wc * 32 + 8 * fq;
        f32x4 sxc[2][2];
#pragma unroll
        for (int bj = 0; bj < 2; ++bj)
#pragma unroll
            for (int n = 0; n < 2; ++n) sxc[bj][n] = *(const GAS f32x4*)(sx0 + n_ch * 256 + 128 * bj + c0 + 4 * n);
        if (pm < 4) {
            const int h = pm; const float lgf = -fexp(dec_f[h]), lgb = -fexp(dec_b[h]);
#pragma unroll
            for (int m = 0; m < 4; ++m) {
                const int d = 64 * wr + 16 * m + fr;
                const float sw1 = swin[u.p2 + d], sw2 = swin[u.p2 + 128 + d];
                const float inv = __builtin_amdgcn_exp2f(-(float)d * (13.287712379549449f / 128.f)) * 0.15915494309189535f;
#pragma unroll
                for (int bj = 0; bj < 2; ++bj) {
                    f32x4 f1[2], f2[2], b1[2], b2[2];
#pragma unroll
                    for (int n = 0; n < 2; ++n)
#pragma unroll
                        for (int j = 0; j < 4; ++j) { const int il = 128 * bj + c0 + 4 * n + j; const float pos = (float)(n_ch * 256 + il); float c, s; cs_rev(pos * inv, c, s);
                            const float x1 = (float)acc[0][bj][m][n][j] * (sw1 * sxc[bj][n][j]), x2 = (float)acc[1][bj][m][n][j] * (sw2 * sxc[bj][n][j]); const float o1 = (x1 * c - x2 * s) * 0.0625f, o2 = (x2 * c + x1 * s) * 0.0625f;
                            const float wf = fexp(lgf * (float)(255 - il)), wb = fexp(lgb * (float)(il + 1));
                            f1[n][j] = o1 * wf; f2[n][j] = o2 * wf; b1[n][j] = o1 * wb; b2[n][j] = o2 * wb; }
                    const size_t tcol = (size_t)n_ch * 256 + 128 * bj + c0;
                    bf16* pf = kTw + ((size_t)(h * HD + d)) * T + tcol; bf16* pb = pf + (size_t)RW * T;
                    *(GAS v4u*)pf = pack8(f1[0], f1[1]); *(GAS v4u*)(pf + (size_t)128 * T) = pack8(f2[0], f2[1]);
                    *(GAS v4u*)pb = pack8(b1[0], b1[1]); *(GAS v4u*)(pb + (size_t)128 * T) = pack8(b2[0], b2[1]);
                }
            }
        } else {
            const int h = pm - 4;
#pragma unroll
            EPI_LOOP_AM { const int dv = 128 * ai + 64 * wr + 16 * m + fr; const float swr = swin[u.p2 + dv];
#pragma unroll
                for (int bj = 0; bj < 2; ++bj) { f32x4 v0, v1;
#pragma unroll
                    for (int j = 0; j < 4; ++j) { v0[j] = (float)acc[ai][bj][m][0][j] * (swr * sxc[bj][0][j]); v1[j] = (float)acc[ai][bj][m][1][j] * (swr * sxc[bj][1][j]); }
                    *(GAS v4u*)(Bcat + ((size_t)(h * NCH + n_ch) * 256 + dv) * CAT + 128 * bj + c0) = pack8(v0, v1); } }
        }
    }
};
struct EpiS1 {
    static constexpr bool PERM = true;
    bf16* A1;
    __device__ __forceinline__ void operator()(Acc& acc, const Unit& u, LAS unsigned char*, int wr, int wc, int fr, int fq) const {
        const int b0 = wc * 32 + 8 * fq;
#pragma unroll
        for (int m = 0; m < 4; ++m) { const int k1 = 64 * wr + 16 * m + fr;
#pragma unroll
            for (int bj = 0; bj < 2; ++bj) { const int cch = 2 * u.p1 + bj; f32x4 re[2], im[2];
#pragma unroll
                for (int n = 0; n < 2; ++n)
#pragma unroll
                    for (int j = 0; j < 4; ++j) { const int b = b0 + 4 * n + j; float c, s; cs_rev((float)(k1 * b) * (1.f / 16384.f), c, s);
                        const float xr = acc[0][bj][m][n][j], xi = acc[1][bj][m][n][j]; re[n][j] = xr * c + xi * s; im[n][j] = xi * c - xr * s; }
                bf16* p = A1 + (((size_t)k1 * 1024 + cch) * 2) * 128 + b0;
                *(GAS v4u*)p = pack8(re[0], re[1]); *(GAS v4u*)(p + 128) = pack8(im[0], im[1]); EPI_FENCE; } }
    }
};
struct EpiS2 {
    static constexpr bool PERM = true;
    bf16* Zt;
    __device__ __forceinline__ void operator()(Acc& acc, const Unit& u, LAS unsigned char*, int wr, int wc, int fr, int fq) const {
        const int k1 = u.p1 >> 2, cb = (u.p1 & 3) * 256, c0 = wc * 32 + 8 * fq;
#pragma unroll
        EPI_LOOP_AM { const int k2 = 64 * wr + 16 * m + fr, k = k1 + 128 * k2;
#pragma unroll
            for (int bj = 0; bj < 2; ++bj) { const int cch = cb + 128 * bj + c0, g = cch >> 7, cg = cch & 127;
                *(GAS v4u*)(Zt + (size_t)k * 2048 + g * 256 + ai * 128 + cg) = pack8(acc[ai][bj][m][0], acc[ai][bj][m][1]); } }
    }
};
struct EpiChan {
    static constexpr bool PERM = true;
    bf16* y;
    __device__ __forceinline__ void operator()(Acc& acc, const Unit& u, LAS unsigned char*, int wr, int wc, int fr, int fq) const {
        const int l0 = wc * 32 + 8 * fq; const float norm = 6.9053396600248786e-4f;
#pragma unroll
        EPI_LOOP_AM { const int R = u.p0 * 256 + 128 * ai + 64 * wr + 16 * m + fr, k = R >> 3, g = R & 7;
            *(GAS v4u*)(y + (size_t)k * D + g * 128 + l0) = pack8(acc[ai][0][m][0] * norm, acc[ai][0][m][1] * norm); }
    }
};
struct EpiScores {
    static constexpr bool PERM = true;
    bf16* Acat; const float *dec_f, *dec_b;
    __device__ __forceinline__ void operator()(Acc& acc, const Unit& u, LAS unsigned char*, int wr, int wc, int fr, int fq) const {
        const int h = u.p0, n_ch = u.p1, c0 = wc * 32 + 8 * fq; const float lgf = -fexp(dec_f[h]), lgb = -fexp(dec_b[h]);
#pragma unroll
        EPI_LOOP_AM { const int i = 128 * ai + 64 * wr + 16 * m + fr;
#pragma unroll
            for (int bj = 0; bj < 2; ++bj) { f32x4 v[2];
#pragma unroll
                for (int n = 0; n < 2; ++n)
#pragma unroll
                    for (int j = 0; j < 4; ++j) { const int jc = 128 * bj + c0 + 4 * n + j; const float dd = (float)(i - jc); const float w = (jc <= i) ? fexp(lgf * dd) : fexp(-lgb * dd); v[n][j] = acc[ai][bj][m][n][j] * w; }
                *(GAS v4u*)(Acat + ((size_t)h * T + n_ch * 256 + i) * CAT + 128 * bj + c0) = pack8(v[0], v[1]); EPI_FENCE; } }
    }
};
struct EpiKV {
    static constexpr bool PERM = false;
    float* kvT;
    __device__ __forceinline__ void operator()(Acc& acc, const Unit& u, LAS unsigned char*, int wr, int wc, int fr, int fq) const {
#pragma unroll
        EPI_LOOP_AM { const int dv = 128 * ai + 64 * wr + 16 * m + fr; float* rowp = kvT + (((size_t)u.p0 * NCH + u.p1) * 256 + dv) * 256 + wc * 32 + 4 * fq;
#pragma unroll
            for (int bj = 0; bj < 2; ++bj)
#pragma unroll
                for (int n = 0; n < 2; ++n) *(GAS f32x4*)(rowp + bj * 128 + n * 16) = acc[ai][bj][m][n]; }
    }
};
struct EpiOut {
    static constexpr bool PERM = true;
    bf16* y; const bf16* gs; const float* gn_g;
    __device__ __forceinline__ void operator()(Acc& acc, const Unit& u, LAS unsigned char* lds, int wr, int wc, int fr, int fq) const {
        const int h = u.p0, n_ch = u.p1, c0 = wc * 32 + 8 * fq;
        LAS f32x2* P = (LAS f32x2*)(lds + LDS_STAGE);
#pragma unroll
        EPI_LOOP_AM {
            float s = 0.f;
#pragma unroll
            for (int bj = 0; bj < 2; ++bj)
#pragma unroll
                for (int n = 0; n < 2; ++n) { const f32x4 x = acc[ai][bj][m][n]; s += (x[0] + x[1]) + (x[2] + x[3]); }
            s += __shfl_xor(s, 16); s += __shfl_xor(s, 32);
            const float mw = s * (1.f / 64.f); float q = 0.f;
#pragma unroll
            for (int bj = 0; bj < 2; ++bj)
#pragma unroll
                for (int n = 0; n < 2; ++n) { const f32x4 d = acc[ai][bj][m][n] - mw; q += (d[0] * d[0] + d[1] * d[1]) + (d[2] * d[2] + d[3] * d[3]); }
            q += __shfl_xor(q, 16); q += __shfl_xor(q, 32);
            if (fq == 0) P[(128 * ai + 64 * wr + 16 * m + fr) * 4 + wc] = (f32x2){mw, q};
        }
        LDS_WAIT(); __builtin_amdgcn_s_barrier(); asm volatile("" ::: "memory");
#pragma unroll
        EPI_LOOP_AM {
            const int r = 128 * ai + 64 * wr + 16 * m + fr, tok = n_ch * 256 + r;
            const f32x2 a = P[r * 4 + 0], b = P[r * 4 + 1], c = P[r * 4 + 2], d = P[r * 4 + 3];
            const float mt = (a.x + b.x + c.x + d.x) * 0.25f; const float da = a.x - mt, db = b.x - mt, dc = c.x - mt, dd = d.x - mt;
            const float m2 = (a.y + b.y) + (c.y + d.y) + 64.f * ((da * da + db * db) + (dc * dc + dd * dd));
            const float rstd = 1.f / sqrtf(m2 * (1.f / 256.f) + GN_EPS);
#pragma unroll
            for (int bj = 0; bj < 2; ++bj) {
                const int col = h * HD + 128 * bj + c0; const v4u gv = *(const GAS v4u*)(gs + (size_t)tok * RW + col);
                const f32x4 g0 = *(const GAS f32x4*)(gn_g + col), g1 = *(const GAS f32x4*)(gn_g + col + 4);
                f32x4 o0 = (acc[ai][bj][m][0] - mt) * rstd * g0, o1 = (acc[ai][bj][m][1] - mt) * rstd * g1;
                o0[0] *= bf_lo(gv.x); o0[1] *= bf_hi(gv.x); o0[2] *= bf_lo(gv.y); o0[3] *= bf_hi(gv.y); o1[0] *= bf_lo(gv.z); o1[1] *= bf_hi(gv.z); o1[2] *= bf_lo(gv.w); o1[3] *= bf_hi(gv.w);
                *(GAS v4u*)(y + (size_t)tok * D + FW + col) = pack8(o0, o1); }
        }
        LDS_WAIT(); __builtin_amdgcn_s_barrier(); asm volatile("" ::: "memory");
    }
};
struct EpiWout {
    static constexpr bool PERM = false;
    float* z1; const float *x, *st0, *g0, *b0;
    __device__ __forceinline__ void operator()(Acc& acc, const Unit& u, LAS unsigned char*, int wr, int wc, int fr, int fq) const {
        const int colb = u.p1 * 256 + wc * 32 + 4 * fq;
#pragma unroll
        EPI_LOOP_AM { const int row = u.p0 * 256 + 128 * ai + 64 * wr + 16 * m + fr; const f32x2 st = *(const GAS f32x2*)(st0 + 2 * row);
#pragma unroll
            for (int bj = 0; bj < 2; ++bj)
#pragma unroll
                for (int n = 0; n < 2; ++n) { const int col = colb + bj * 128 + n * 16; const size_t off = (size_t)row * D + col;
                    const f32x4 xv = *(const GAS f32x4*)(x + off), g = *(const GAS f32x4*)(g0 + col), b = *(const GAS f32x4*)(b0 + col);
                    *(GAS f32x4*)(z1 + off) = ((xv - st.x) * st.y * g + b) * ALPHA + acc[ai][bj][m][n]; } }
    }
};
struct EpiUp {
    static constexpr bool PERM = true;
    bf16* act; unsigned* rmax;
    __device__ __forceinline__ void operator()(AccI& acc, const Unit& u, LAS unsigned char* lds, int wr, int wc, int fr, int fq) const {
        const int rt = u.p0, pn = u.p1, c0 = pn * 128 + wc * 32 + 8 * fq;
        const LAS float* blk = (const LAS float*)(lds + LDS_STAGE + u.q * 4096);
        float sx[2][4], rm[2][4];
#pragma unroll
        EPI_LOOP_AM { sx[ai][m] = blk[256 + 128 * ai + 64 * wr + 16 * m + fr]; rm[ai][m] = 0.f; }
#pragma unroll
        for (int n = 0; n < 2; ++n) {
            const int cc = wc * 32 + 8 * fq + 4 * n;
            const f32x4 sg = *(const LAS f32x4*)(blk + 512 + cc), sl = *(const LAS f32x4*)(blk + 512 + 128 + cc), bg = *(const LAS f32x4*)(blk + 768 + cc), bl = *(const LAS f32x4*)(blk + 768 + 128 + cc);
#pragma unroll
            EPI_LOOP_AM { const int r = 128 * ai + 64 * wr + 16 * m + fr; f32x4 v;
#pragma unroll
                for (int j = 0; j < 4; ++j) { float gl = (float)acc[ai][0][m][n][j] * (sx[ai][m] * sg[j]) + bg[j], li = (float)acc[ai][1][m][n][j] * (sx[ai][m] * sl[j]) + bl[j];
                    gl = fminf(gl, 7.f); li = fminf(fmaxf(li, -7.f), 7.f); v[j] = gl * __builtin_amdgcn_rcpf(1.f + fexp(-1.702f * gl)) * (li + 1.f); }
                rm[ai][m] = fmaxf(rm[ai][m], fmaxf(fmaxf(fabsf(v[0]), fabsf(v[1])), fmaxf(fabsf(v[2]), fabsf(v[3]))));
                v2u w; w.x = cvt_pk_bf16(v[0], v[1]); w.y = cvt_pk_bf16(v[2], v[3]);
                *(GAS v2u*)(act + ((size_t)rt * 256 + r) * DFF + c0 + 4 * n) = w; }
        }
#pragma unroll
        EPI_LOOP_AM { float q = rm[ai][m]; q = fmaxf(q, __shfl_xor(q, 16)); q = fmaxf(q, __shfl_xor(q, 32));
            if (fq == 0) __hip_atomic_fetch_max(rmax + rt * 256 + 128 * ai + 64 * wr + 16 * m + fr, __float_as_uint(q), RLX_AGENT); }
    }
};
struct EpiDown {
    static constexpr bool PERM = true;
    bf16* yr;
    __device__ __forceinline__ void operator()(AccI& acc, const Unit& u, LAS unsigned char* lds, int wr, int wc, int fr, int fq) const {
        const int rt = u.p0, pn = u.p1, c0 = pn * 256 + wc * 32 + 8 * fq;
        const LAS float* blk = (const LAS float*)(lds + LDS_STAGE + u.q * 4096);
        float sr[2][4];
#pragma unroll
        EPI_LOOP_AM sr[ai][m] = blk[128 * ai + 64 * wr + 16 * m + fr];
#pragma unroll
        for (int bj = 0; bj < 2; ++bj) { const int cc = 128 * bj + wc * 32 + 8 * fq;
            const f32x4 w0 = *(const LAS f32x4*)(blk + 256 + cc), w1 = *(const LAS f32x4*)(blk + 256 + cc + 4), b0 = *(const LAS f32x4*)(blk + 512 + cc), b1 = *(const LAS f32x4*)(blk + 512 + cc + 4);
#pragma unroll
            EPI_LOOP_AM { const int r = 128 * ai + 64 * wr + 16 * m + fr; f32x4 o0, o1;
#pragma unroll
                for (int j = 0; j < 4; ++j) { o0[j] = (float)acc[ai][bj][m][0][j] * (sr[ai][m] * w0[j]) + b0[j]; o1[j] = (float)acc[ai][bj][m][1][j] * (sr[ai][m] * w1[j]) + b1[j]; }
                *(GAS v4u*)(yr + ((size_t)rt * 256 + r) * D + c0 + 128 * bj) = pack8(o0, o1); } }
    }
};

__device__ __forceinline__ void p3_scan(Frame& F) {
    const float* kvT = WSP(float, WS_KVT); bf16* Bcat = WSP(bf16, WS_BCAT);
    const int NQ = 2 * NH * 256 * 64;
    for (int q = F.vcu * NTHR + F.tid; q < NQ; q += F.G * NTHR) {
        const int dk4 = q & 63, dv = (q >> 6) & 255, dh = q >> 14, dir = dh >> 2, h = dh & 3;
        const float lg = -fexp((dir ? F.dec_b : F.dec_f)[h]); const float cd = fexp(lg * (float)C2);
        f32x4 S = (f32x4){0.f, 0.f, 0.f, 0.f};
        for (int s = 0; s < NCH; ++s) { const int n = dir ? (NCH - 1 - s) : s;
            const f32x4 kv = *(const GAS f32x4*)(kvT + (((size_t)dh * NCH + n) * 256 + dv) * 256 + dk4 * 4);
            v2u w; w.x = cvt_pk_bf16(S[0], S[1]); w.y = cvt_pk_bf16(S[2], S[3]);
            *(GAS v2u*)(Bcat + ((size_t)(h * NCH + n) * 256 + dv) * CAT + 256 + dir * 256 + dk4 * 4) = w;
            S = S * cd + kv; }
    }
}

__device__ __forceinline__ void p6_router(Frame& F) {
    const float* z1 = WSP(float, WS_Z1); unsigned* h1q = WSP(unsigned, WS_H1Q); float* sxg = WSP(float, WS_SX); float* rsc = WSP(float, WS_RSC); float* st1 = WSP(float, WS_ST0) + 2 * T;
    int* topi = WSP(int, WS_RT); float* gate = (float*)(topi + 4 * T); int* posb = (int*)(gate + 4 * T); int* row_tok = posb + 4 * T;
    LAS float* hc = (LAS float*)F.lds;
    LAS float* wrc = hc + 64 * 257;
    LAS float* stl = wrc + 256 * 32;
    LAS float* lg = stl + 128;
    LAS int* hist = (LAS int*)(lg + 64 * 33);
    LAS float* sxl = (LAS float*)(hist + 64);
    for (int blk = F.vcu; blk < T / 64; blk += F.G) {
        const int t0 = blk * 64;
        for (int rr = 0; rr < 8; ++rr) { const int row = F.wave * 8 + rr, m = t0 + row;
            const GAS f32x4* xr = (const GAS f32x4*)(z1 + (size_t)m * D) + F.lane; f32x4 v[8]; float s = 0.f;
#pragma unroll
            for (int j = 0; j < 8; ++j) { v[j] = xr[64 * j]; s += (v[j][0] + v[j][1]) + (v[j][2] + v[j][3]); }
            const float mean = wave_sum(s) * (1.f / D); float s2 = 0.f;
#pragma unroll
            for (int j = 0; j < 8; ++j) { v[j] = v[j] - mean; s2 += (v[j][0] * v[j][0] + v[j][1] * v[j][1]) + (v[j][2] * v[j][2] + v[j][3] * v[j][3]); }
            const float rstd = 1.f / sqrtf(wave_sum(s2) * (1.f / D) + LN_EPS);
            float am = 0.f;
#pragma unroll
            for (int j = 0; j < 8; ++j) { const f32x4 g = *((const GAS f32x4*)F.ln1_g + F.lane + 64 * j), b = *((const GAS f32x4*)F.ln1_b + F.lane + 64 * j);
                v[j] = v[j] * rstd * g + b; am = fmaxf(am, fmaxf(fmaxf(fabsf(v[j][0]), fabsf(v[j][1])), fmaxf(fabsf(v[j][2]), fabsf(v[j][3])))); }
#pragma unroll
            for (int o = 1; o < 64; o <<= 1) am = fmaxf(am, __shfl_xor(am, o));
            const float sc = am > 0.f ? am * (1.f / 127.f) : 1.f, inv = 1.f / sc;
#pragma unroll
            for (int j = 0; j < 8; ++j) { const int q0 = (int)__builtin_rintf(v[j][0] * inv), q1 = (int)__builtin_rintf(v[j][1] * inv), q2 = (int)__builtin_rintf(v[j][2] * inv), q3 = (int)__builtin_rintf(v[j][3] * inv);
                h1q[(size_t)m * (D / 4) + F.lane + 64 * j] = (unsigned)(q0 & 0xff) | ((unsigned)(q1 & 0xff) << 8) | ((unsigned)(q2 & 0xff) << 16) | ((unsigned)(q3 & 0xff) << 24); }
            if (F.lane == 0) { st1[2 * m] = mean; st1[2 * m + 1] = rstd; stl[2 * row] = mean; stl[2 * row + 1] = rstd; sxg[m] = sc; sxl[row] = sc; }
        }
        if (F.tid < 64) hist[F.tid] = 0;
        __syncthreads();
        const int row = F.tid >> 3, e0 = (F.tid & 7) * 4; f32x4 accl = (f32x4){0.f, 0.f, 0.f, 0.f};
        for (int kc = 0; kc < 8; ++kc) {
            for (int i = F.tid; i < 64 * 64; i += NTHR) { const int r = i >> 6, c4 = (i & 63) * 4, col = kc * 256 + c4;
                const f32x4 zv = *(const GAS f32x4*)(z1 + (size_t)(t0 + r) * D + col), g = *(const GAS f32x4*)(F.ln1_g + col), b = *(const GAS f32x4*)(F.ln1_b + col);
                const f32x4 hh = (zv - stl[2 * r]) * stl[2 * r + 1] * g + b; LAS float* d = hc + r * 257 + c4; d[0] = hh[0]; d[1] = hh[1]; d[2] = hh[2]; d[3] = hh[3]; }
            for (int i = F.tid; i < 256 * 8; i += NTHR) { const int k = i >> 3, c4 = (i & 7) * 4; *(LAS f32x4*)(wrc + k * 32 + c4) = *(const GAS f32x4*)(F.w_r + (size_t)(kc * 256 + k) * NE + c4); }
            __syncthreads();
#pragma unroll 8
            for (int k = 0; k < 256; ++k) { const float hv = hc[row * 257 + k]; const f32x4 w = *(const LAS f32x4*)(wrc + k * 32 + e0); accl = accl + w * hv; }
            __syncthreads();
        }
        { const f32x4 br = *(const GAS f32x4*)(F.b_r + e0); LAS float* d = lg + row * 33 + e0; d[0] = accl[0] + br[0]; d[1] = accl[1] + br[1]; d[2] = accl[2] + br[2]; d[3] = accl[3] + br[3]; }
        __syncthreads();
        int ek[4] = {0, 0, 0, 0}, lp[4] = {0, 0, 0, 0}; float gk[4] = {0.f, 0.f, 0.f, 0.f};
        if (F.tid < 64) {
            float lv[4]; unsigned used = 0u;
#pragma unroll
            for (int k = 0; k < 4; ++k) { float best = -3.0e38f; int bi = 0;
                for (int e = 0; e < NE; ++e) { const float v = lg[F.tid * 33 + e]; const bool ok = !((used >> e) & 1u) && (v > best); best = ok ? v : best; bi = ok ? e : bi; }
                used |= 1u << bi; ek[k] = bi; lv[k] = best; }
            const float mx = lv[0]; float den = 0.f;
#pragma unroll
            for (int k = 0; k < 4; ++k) { gk[k] = fexp(lv[k] - mx); den += gk[k]; }
            const float rd = 1.f / den;
#pragma unroll
            for (int k = 0; k < 4; ++k) { gk[k] *= rd; lp[k] = __hip_atomic_fetch_add(&hist[ek[k]], 1, __ATOMIC_RELAXED, __HIP_MEMORY_SCOPE_WORKGROUP); }
        }
        __syncthreads();
        if (F.tid < NE) hist[32 + F.tid] = (int)__hip_atomic_fetch_add(F.ctl + CW_CNT + 64 * F.tid, (unsigned)hist[F.tid], RLX_AGENT);
        __syncthreads();
        if (F.tid < 64) { const int tok = t0 + F.tid;
#pragma unroll
            for (int k = 0; k < 4; ++k) { const int pos = hist[32 + ek[k]] + lp[k]; row_tok[(size_t)ek[k] * T + pos] = tok; rsc[(size_t)ek[k] * T + pos] = sxl[F.tid]; topi[4 * tok + k] = ek[k]; gate[4 * tok + k] = gk[k]; posb[4 * tok + k] = pos; } }
        __syncthreads();
    }
}

__device__ __forceinline__ void p8_requant(Frame& F, const LAS int* tstart) {
    const bf16* act = WSP(bf16, WS_ACT); unsigned* aq = WSP(unsigned, WS_ACTQ); float* sa = WSP(float, WS_SA); const unsigned* rmax = F.ctl + CW_RMAX;
    const int R = tstart[NE] * 256, gw = F.vcu * NWAVES + F.wave, NGW = F.G * NWAVES;
    for (int row = gw; row < R; row += NGW) {
        const float mx = __uint_as_float(rmax[row]); const float sc = mx > 0.f ? mx * (1.f / 127.f) : 1.f, inv = 1.f / sc;
#pragma unroll
        for (int j = 0; j < 2; ++j) { const int col = 16 * F.lane + 1024 * j;
            const v4u a = *(const GAS v4u*)(act + (size_t)row * DFF + col), b = *(const GAS v4u*)(act + (size_t)row * DFF + col + 8);
            const unsigned src[8] = {a.x, a.y, a.z, a.w, b.x, b.y, b.z, b.w}; unsigned o[4];
#pragma unroll
            for (int d = 0; d < 4; ++d) { unsigned w = 0u;
#pragma unroll
                for (int h2 = 0; h2 < 2; ++h2) { const unsigned u2 = src[2 * d + h2]; int q0 = (int)__builtin_rintf(bf_lo(u2) * inv), q1 = (int)__builtin_rintf(bf_hi(u2) * inv);
                    q0 = q0 > 127 ? 127 : (q0 < -127 ? -127 : q0); q1 = q1 > 127 ? 127 : (q1 < -127 ? -127 : q1);
                    w |= ((unsigned)(q0 & 0xff) << (16 * h2)) | ((unsigned)(q1 & 0xff) << (16 * h2 + 8)); }
                o[d] = w; }
            *(GAS v4u*)(aq + ((size_t)row * DFF + col) / 4) = (v4u){o[0], o[1], o[2], o[3]}; }
        if (F.lane == 0) sa[row] = sc;
    }
}

__device__ __forceinline__ void build_tstart(Frame& F, LAS int* tstart) {
    if (F.tid == 0) { int s = 0; for (int e = 0; e < NE; ++e) { tstart[e] = s; const unsigned n = __hip_atomic_load(F.ctl + CW_CNT + 64 * e, RLX_AGENT); s += (int)((n + 255u) >> 8); } tstart[NE] = s; }
    __syncthreads();
    for (int rt = F.tid; rt < RT_MAX; rt += NTHR) { int e = 0; for (int j = 1; j < NE; ++j) e += (tstart[j] <= rt) ? 1 : 0; tstart[40 + rt] = e; }
    __syncthreads();
}

__device__ __forceinline__ void p9_combine(Frame& F, const LAS int* tstart) {
    const float* z1 = WSP(float, WS_Z1); const float* st1 = WSP(float, WS_ST0) + 2 * T; const bf16* yr = WSP(bf16, WS_YR);
    const int* topi = WSP(int, WS_RT); const float* gate = (const float*)(topi + 4 * T); const int* posb = (const int*)(gate + 4 * T);
    const int gw = F.vcu * NWAVES + F.wave, NGW = F.G * NWAVES;
    for (int m = gw; m < T; m += NGW) {
        const float mean1 = st1[2 * m], rstd1 = st1[2 * m + 1];
        size_t ro[4]; float gk[4];
#pragma unroll
        for (int k = 0; k < 4; ++k) { const int e = topi[4 * m + k]; ro[k] = ((size_t)tstart[e] * 256 + posb[4 * m + k]) * D; gk[k] = gate[4 * m + k]; }
        f32x4 v[8]; float s = 0.f;
#pragma unroll
        for (int j = 0; j < 8; ++j) { const int col = 4 * F.lane + 256 * j;
            const f32x4 zv = *(const GAS f32x4*)(z1 + (size_t)m * D + col), g = *(const GAS f32x4*)(F.ln1_g + col), b = *(const GAS f32x4*)(F.ln1_b + col);
            f32x4 a = ((zv - mean1) * rstd1 * g + b) * ALPHA;
#pragma unroll
            for (int k = 0; k < 4; ++k) { const v2u w = *(const GAS v2u*)(yr + ro[k] + col); a[0] += gk[k] * bf_lo(w.x); a[1] += gk[k] * bf_hi(w.x); a[2] += gk[k] * bf_lo(w.y); a[3] += gk[k] * bf_hi(w.y); }
            v[j] = a; s += (a[0] + a[1]) + (a[2] + a[3]); }
        const float mean = wave_sum(s) * (1.f / D); float s2 = 0.f;
#pragma unroll
        for (int j = 0; j < 8; ++j) { v[j] = v[j] - mean; s2 += (v[j][0] * v[j][0] + v[j][1] * v[j][1]) + (v[j][2] * v[j][2] + v[j][3] * v[j][3]); }
        const float rstd = 1.f / sqrtf(wave_sum(s2) * (1.f / D) + LN_EPS);
#pragma unroll
        for (int j = 0; j < 8; ++j) { const int col = 4 * F.lane + 256 * j; const f32x4 g = *(const GAS f32x4*)(F.ln2_g + col), b = *(const GAS f32x4*)(F.ln2_b + col);
            *(GAS f32x4*)(F.out + (size_t)m * D + col) = v[j] * rstd * g + b; }
    }
}

constexpr int NPH = 11;
__global__ void __launch_bounds__(NTHR, 2) fwd(Args args) {
    extern __shared__ __attribute__((aligned(16))) unsigned char lds_raw[];
    Frame F;
    F.lds = (LAS unsigned char*)lds_raw; F.ws = args.ws; F.ctl = (unsigned*)(args.ws + WS_CTL);
    F.tid = threadIdx.x; F.lane = F.tid & 63; F.wave = __builtin_amdgcn_readfirstlane(F.tid >> 6);
    F.G = gridDim.x; { const int bx = blockIdx.x; F.vcu = (F.G % 8 == 0) ? (bx % 8) * (F.G / 8) + bx / 8 : bx; }
    F.x = args.in[0]; F.ln0_g = args.in[1]; F.ln0_b = args.in[2]; F.w_in = args.in[3]; F.dec_f = args.in[4]; F.dec_b = args.in[5]; F.gn_g = args.in[6]; F.w_out = args.in[7];
    F.ln1_g = args.in[8]; F.ln1_b = args.in[9]; F.w_r = args.in[10]; F.b_r = args.in[11]; F.w_up = args.in[12]; F.b_up = args.in[13]; F.w_dn = args.in[14]; F.b_dn = args.in[15];
    F.ln2_g = args.in[16]; F.ln2_b = args.in[17]; F.out = args.out;
    volatile LAS unsigned* lctl = (volatile LAS unsigned*)(F.lds + LDS_CTL_OFF);
    LAS int* tstart = (LAS int*)(F.lds + LDS_CTL_OFF + 64);
    for (int u = F.tid; u < 128; u += NTHR) lctl[u] = 0u;
    __syncthreads();
    const int lo = args.ph_lo, hi = args.ph_hi;
    const bool single = (hi - lo) > 1;
    XcdBarrier bar; bar.bar = F.ctl + CW_BAR; bar.x = 0; bar.st = lctl;
    if (single) bar = xcd_barrier_post(F.ctl + CW_BAR, lctl);
#ifndef PH_MASK
#define PH_MASK 0x7ff
#endif
#define IN(k) (((PH_MASK >> (k)) & 1) && lo <= (k) && (k) < hi)
#ifndef SUB_MASK
#define SUB_MASK 0xff
#endif
#define SUB(n) ((SUB_MASK >> (n)) & 1)
#define SEAM(k) do { if (IN(k) && IN((k) + 1)) xcd_barrier(bar); } while (0)
    const int bc = (int)blockIdx.x;

    const int nS = (NE * 128 + F.G - 1) / F.G + (NE * 64 + F.G - 1) / F.G; int sdone = 0; const int qgrp = (int)(blockIdx.x >> 3);
#define QSLOT(k24) do { const int e_ = sdone + (nS * (k24) + 23) / 24; do_slabs(F, sdone, e_ < nS ? e_ : nS); sdone = e_; } while (0)
#define QG(slot, nslots, k24) do { if (qgrp % (nslots) == (slot)) QSLOT(k24); } while (0)
    if (IN(0)) { p0_prologue(F); __syncthreads(); { const int nW = (DIN / 32 + F.G - 1) / F.G; do_slabs(F, -nW, 0); } }
    SEAM(0);
    if (IN(1)) {
        QG(0, 4, 9);
        if (SUB(0)) { SchedG1N S; S.nt = D / 128; S.pitchA = D / 2; S.pitchB = D / 2; S.multA = 1; S.multB = 1; S.G = F.G; S.c = bc; S.A = (const char*)WSP(bf16, WS_H0B); S.Bt = (const char*)WSP(bf16, WS_WIN);
          EpiG1N E{WSP(bf16, WS_QS), WSP(bf16, WS_KK), WSP(bf16, WS_GS), WSP(bf16, WS_ACAT), F.dec_f, F.dec_b, WSP(float, WS_SX0), WSP(float, WS_SWIN)};
          gm::gemm_run<EpiG1N, SchedG1N, false, true>(F.lds, S, E); }
        QG(1, 4, 9);
        if (SUB(1)) { SchedG1SF S; S.nt = D / 128; S.pitchA = D / 2; S.pitchB = D / 2; S.multA = 1; S.multB = 128; S.G = F.G; S.c = bc; S.A = (const char*)WSP(bf16, WS_WIN); S.Bt = (const char*)WSP(bf16, WS_H0B);
          EpiG1SF E{WSP(bf16, WS_UTT), WSP(float, WS_SX0), WSP(float, WS_SWIN)};
          gm::gemm_run<EpiG1SF, SchedG1SF, false, true>(F.lds, S, E); }
        QG(2, 4, 9);
        if (SUB(2)) { SchedG1SKV S; S.nt = D / 128; S.pitchA = D / 2; S.pitchB = D / 2; S.multA = 1; S.multB = 1; S.G = F.G; S.c = bc; S.A = (const char*)WSP(bf16, WS_WIN); S.Bt = (const char*)WSP(bf16, WS_H0B);
          EpiG1SKV E{WSP(bf16, WS_KTW), WSP(bf16, WS_BCAT), F.dec_f, F.dec_b, WSP(float, WS_SX0), WSP(float, WS_SWIN)};
          gm::gemm_run<EpiG1SKV, SchedG1SKV, false, true>(F.lds, S, E); }
        QG(3, 4, 9);
    }
    SEAM(1);
    if (IN(2)) {
        QG(0, 4, 6);
        if (SUB(3)) { SchedFixA S; S.nt = 2; S.pitchA = 128; S.pitchB = 128; S.multA = 1; S.multB = 1; S.G = F.G; S.c = bc; S.A = (const char*)WSP(bf16, WS_TAB); S.Bt = (const char*)WSP(bf16, WS_UTT); S.ncol = 512;
          EpiS1 E{WSP(bf16, WS_A1)};
          gm::gemm_run<EpiS1, SchedFixA, false>(F.lds, S, E); }
        QG(1, 4, 6);
        if (SUB(4)) { SchedScores S; S.nt = 4; S.pitchA = RW; S.pitchB = RW; S.multA = 1; S.multB = 1; S.G = F.G; S.c = bc; S.Q = (const char*)WSP(bf16, WS_QS); S.Kk = (const char*)WSP(bf16, WS_KK);
          EpiScores E{WSP(bf16, WS_ACAT), F.dec_f, F.dec_b};
          gm::gemm_run<EpiScores, SchedScores, false>(F.lds, S, E); }
        QG(2, 4, 6);
        if (SUB(5)) { SchedKV S; S.nt = 4; S.pitchA = CAT; S.pitchB = T; S.multA = 1; S.multB = 1; S.G = F.G; S.c = bc; S.Bcat = (const char*)WSP(bf16, WS_BCAT); S.kTw = (const char*)WSP(bf16, WS_KTW);
          EpiKV E{WSP(float, WS_KVT)};
          gm::gemm_run<EpiKV, SchedKV, false>(F.lds, S, E); }
        QG(3, 4, 6);
    }
    SEAM(2);
    if (IN(3)) {
        QG(0, 3, 2);
        { SchedFixA S; S.nt = 4; S.pitchA = 256; S.pitchB = 256; S.multA = 1; S.multB = 1; S.G = F.G; S.c = bc; S.A = (const char*)(WSP(bf16, WS_TAB) + 32768); S.Bt = (const char*)WSP(bf16, WS_A1); S.ncol = 512;
          EpiS2 E{WSP(bf16, WS_ZT)};
          gm::gemm_run<EpiS2, SchedFixA, false>(F.lds, S, E); }
        QG(1, 3, 2);
        p3_scan(F);
        QG(2, 3, 2);
    }
    SEAM(3);
    if (IN(4)) {
        QG(0, 3, 4);
        { SchedFixB S; S.nt = 4; S.pitchA = 256; S.pitchB = 256; S.multA = 1; S.multB = 1; S.G = F.G; S.c = bc; S.A = (const char*)WSP(bf16, WS_ZT); S.Bt = (const char*)(WSP(bf16, WS_TAB) + 32768 + 65536); S.nrow = 512;
          EpiChan E{WSP(bf16, WS_Y)};
          gm::gemm_run<EpiChan, SchedFixB, false>(F.lds, S, E); }
        QG(1, 3, 4);
        { SchedOut S; S.nt = CAT / 64; S.pitchA = CAT; S.pitchB = CAT; S.multA = 1; S.multB = 1; S.G = F.G; S.c = bc; S.Acat = (const char*)WSP(bf16, WS_ACAT); S.Bcat = (const char*)WSP(bf16, WS_BCAT);
          EpiOut E{WSP(bf16, WS_Y), WSP(bf16, WS_GS), F.gn_g};
          gm::gemm_run<EpiOut, SchedOut, false>(F.lds, S, E); }
        QG(2, 3, 4);

    }
    SEAM(4);
    if (IN(5)) {
        QG(0, 2, 3);
        Sched2D S; S.nt = D / 64; S.pitchA = D; S.pitchB = D; S.multA = 1; S.multB = 1; S.G = F.G; S.c = bc; S.A = (const char*)WSP(bf16, WS_Y); S.Bt = (const char*)WSP(bf16, WS_WOUT); S.nM = 64; S.nN = 8;
        EpiWout E{WSP(float, WS_Z1), F.x, WSP(float, WS_ST0), F.ln0_g, F.ln0_b};
        gm::gemm_run<EpiWout, Sched2D, false>(F.lds, S, E);
        QG(1, 2, 3);
        do_slabs(F, sdone < nS ? sdone : nS, nS);
    }
    SEAM(5);
    if (IN(6)) { p6_router(F); }
    SEAM(6);
    if (IN(7) || IN(8) || IN(9) || IN(10)) build_tstart(F, tstart);
    if (IN(7)) {
        SchedMoE S; S.nt = D / 128; S.pitchA = D / 2; S.pitchB = D / 2; S.multA = 1; S.multB = 1; S.G = F.G; S.c = bc; S.A = (const char*)WSP(char, WS_H1Q); S.Bt = (const char*)WSP(char, WS_WUP);
        S.tstart = tstart; S.row_tok = WSP(int, WS_RT) + 12 * T; S.cnt = F.ctl + CW_CNT; S.nN = 16; S.rowbytes = D; S.estride = (size_t)2 * DFF * D;
        S.rsc = WSP(float, WS_RSC); S.swup = WSP(float, WS_SWUP); S.b_up = F.b_up;
        EpiUp E{WSP(bf16, WS_ACT), F.ctl + CW_RMAX};
        gm::gemm_run<EpiUp, SchedMoE, true, true, true>(F.lds, S, E);
    }
    SEAM(7);
    if (IN(8)) { p8_requant(F, tstart); }
    SEAM(8);
    if (IN(9)) {
        SchedMoEDown S; S.nt = DFF / 128; S.pitchA = DFF / 2; S.pitchB = DFF / 2; S.multA = 1; S.multB = 1; S.G = F.G; S.c = bc; S.A = (const char*)WSP(char, WS_ACTQ); S.Bt = (const char*)WSP(char, WS_WDN);
        S.tstart = tstart; S.row_tok = nullptr; S.cnt = F.ctl + CW_CNT; S.nN = 8; S.rowbytes = DFF; S.estride = (size_t)D * DFF;
        S.sa = WSP(float, WS_SA); S.swdn = WSP(float, WS_SWDN); S.b_dn = F.b_dn; S.rsc = nullptr; S.swup = nullptr; S.b_up = nullptr;
        EpiDown E{WSP(bf16, WS_YR)};
        gm::gemm_run<EpiDown, SchedMoEDown, false, true, true>(F.lds, S, E);
    }
    SEAM(9);
    if (IN(10)) { p9_combine(F, tstart); }
#undef IN
#undef SEAM
}

#ifndef MK_SPLIT
#define MK_SPLIT 0
#endif
extern "C" void kernel_launch(void* const* d_in, const int* in_sizes, int n_in, void* d_out, int out_size, void* d_ws, size_t ws_size, hipStream_t stream) {
    static int grid = 0;
    if (grid == 0) {
        if (n_in != 18 || out_size != T * D || ws_size < WS_END2) { fprintf(stderr, "kernel_launch: unexpected problem: n_in %d out %d ws %zu (need %zu)\n", n_in, out_size, ws_size, (size_t)WS_END2); grid = -1; return; }
        int dev = 0, cus = 0, per_cu = 0;
        if (hipGetDevice(&dev) != hipSuccess || hipDeviceGetAttribute(&cus, hipDeviceAttributeMultiprocessorCount, dev) != hipSuccess) { grid = -1; return; }
        if (hipFuncSetAttribute((const void*)fwd, hipFuncAttributeMaxDynamicSharedMemorySize, LDS_BYTES) != hipSuccess) { fprintf(stderr, "kernel_launch: hipFuncSetAttribute failed\n"); grid = -1; return; }
        if (hipOccupancyMaxActiveBlocksPerMultiprocessor(&per_cu, (const void*)fwd, NTHR, LDS_BYTES) != hipSuccess || per_cu < 1) { fprintf(stderr, "kernel_launch: occupancy query reports %d\n", per_cu); }
        (void)hipGetLastError();
        grid = cus;
    }
    if (grid < 0) return;
    (void)hipMemsetAsync((char*)d_ws + WS_CTL, 0, CTL_BYTES, stream);
    Args a{};
    for (int i = 0; i < 18; ++i) a.in[i] = (const float*)d_in[i];
    a.out = (float*)d_out; a.ws = (unsigned char*)d_ws;
#if MK_SPLIT
    for (int p = 0; p < NPH; ++p) { a.ph_lo = p; a.ph_hi = p + 1; hipLaunchKernelGGL(fwd, dim3(grid), dim3(NTHR), LDS_BYTES, stream, a); }
#else
    a.ph_lo = 0; a.ph_hi = NPH; hipLaunchKernelGGL(fwd, dim3(grid), dim3(NTHR), LDS_BYTES, stream, a);
#endif
}
```

```cpp
#include <hip/hip_runtime.h>
#include <cstdio>
#include <cstdint>

#define GAS __attribute__((address_space(1)))
#define LAS __attribute__((address_space(3)))
typedef unsigned short bf16;
typedef unsigned v4u __attribute__((ext_vector_type(4)));
typedef unsigned v2u __attribute__((ext_vector_type(2)));
typedef float f32x4 __attribute__((ext_vector_type(4)));
typedef float f32x2 __attribute__((ext_vector_type(2)));
typedef short bf16x8 __attribute__((ext_vector_type(8)));
typedef int i32x4 __attribute__((ext_vector_type(4)));
#define RLX_AGENT __ATOMIC_RELAXED, __HIP_MEMORY_SCOPE_AGENT
#define LDS_WAIT() asm volatile("s_waitcnt lgkmcnt(0)" ::: "memory")
#define VM_WAIT() asm volatile("s_waitcnt vmcnt(0)" ::: "memory")

constexpr int T = 16384, D = 2048, DIN = 5120, FW = 1024, RW = 1024, NH = 4, HD = 256, NE = 32, TOPK = 4, DFF = 2048;
constexpr int C2 = 256, NCH = T / C2;
constexpr int CAT = 768;
constexpr float LN_EPS = 1e-5f, GN_EPS = 1e-6f, ALPHA = 1.189207115002721f;
constexpr int RT_MAX = (T * TOPK) / 256 + NE;
constexpr int NWAVES = 8, NTHR = 512;

constexpr size_t MiB = 1u << 20;
constexpr size_t WS_CTL = 0, CTL_BYTES = 1 * MiB;
constexpr size_t WS_TAB = 1 * MiB;
constexpr size_t WS_WIN = 2 * MiB;
constexpr size_t WS_WOUT = WS_WIN + 20 * MiB;
constexpr size_t WS_WUP = WS_WOUT + 8 * MiB;
constexpr size_t WS_WDN = WS_WUP + 512 * MiB;
constexpr size_t WS_H0B = WS_WDN + 256 * MiB;
constexpr size_t WS_ST0 = WS_H0B + 64 * MiB;
constexpr size_t WS_UTT = WS_ST0 + 1 * MiB;
constexpr size_t WS_A1 = WS_UTT + 32 * MiB;
constexpr size_t WS_ZT = WS_A1 + 64 * MiB;
constexpr size_t WS_QS = WS_ZT + 64 * MiB;
constexpr size_t WS_KK = WS_QS + 32 * MiB;
constexpr size_t WS_GS = WS_KK + 32 * MiB;
constexpr size_t WS_ACAT = WS_GS + 32 * MiB;
constexpr size_t WS_BCAT = WS_ACAT + 96 * MiB;
constexpr size_t WS_KTW = WS_BCAT + 96 * MiB;
constexpr size_t WS_KVT = WS_KTW + 64 * MiB;
constexpr size_t WS_Y = WS_KVT + 128 * MiB;
constexpr size_t WS_Z1 = WS_Y + 64 * MiB;
constexpr size_t WS_H1B = WS_Z1 + 128 * MiB;
constexpr size_t WS_RT = WS_H1B + 64 * MiB;
constexpr size_t WS_ACT = WS_RT + 4 * MiB;
constexpr size_t WS_YR = WS_ACT + 288 * MiB;
constexpr size_t WS_END = WS_YR + 288 * MiB;
constexpr size_t WS_SWUP = WS_TAB + 512 * 1024;
constexpr size_t WS_H1Q = WS_H1B;
constexpr size_t WS_SX = WS_H1B + 32 * MiB, WS_RSC = WS_H1B + 40 * MiB, WS_SA = WS_H1B + 44 * MiB;
constexpr size_t WS_SWDN = WS_ST0 + 512 * 1024;
constexpr size_t WS_SWIN = WS_ST0 + 768 * 1024;
constexpr size_t WS_SX0 = WS_H0B + 40 * MiB;
constexpr size_t WS_ACTQ = WS_END;
constexpr size_t WS_END2 = WS_ACTQ + 144 * MiB;
constexpr int CW_RMAX = 16384;
constexpr int CW_BAR = 1024;
constexpr int CW_CNT = 8192;

constexpr int LDS_STAGE = 131072, LDS_SCR = 16384, LDS_CTL_OFF = LDS_STAGE + LDS_SCR, LDS_BYTES = LDS_CTL_OFF + 2048;

__device__ __forceinline__ unsigned cvt_pk_bf16(float lo, float hi) { unsigned r; asm volatile("v_cvt_pk_bf16_f32 %0, %1, %2" : "=v"(r) : "v"(lo), "v"(hi)); return r; }
__device__ __forceinline__ float bf_lo(unsigned u) { return __builtin_bit_cast(float, u << 16); }
__device__ __forceinline__ float bf_hi(unsigned u) { return __builtin_bit_cast(float, u & 0xffff0000u); }
__device__ __forceinline__ v4u pack8(const f32x4 a, const f32x4 b) { v4u w; w.x = cvt_pk_bf16(a[0], a[1]); w.y = cvt_pk_bf16(a[2], a[3]); w.z = cvt_pk_bf16(b[0], b[1]); w.w = cvt_pk_bf16(b[2], b[3]); return w; }
__device__ __forceinline__ float wave_sum(float v) {
#pragma unroll
    for (int o = 1; o < 64; o <<= 1) v += __shfl_xor(v, o);
    return v;
}
__device__ __forceinline__ float fexp(float x) { return __builtin_amdgcn_exp2f(x * 1.4426950408889634f); }
__device__ __forceinline__ void cs_rev(float rev, float& c, float& s) { const float f = __builtin_amdgcn_fractf(rev); c = __builtin_amdgcn_cosf(f); s = __builtin_amdgcn_sinf(f); }

#define XB_TMO      128
#define XB_XCNT(j)  (256  + 64 * (j))
#define XB_XSUB(j)  (1280 + 64 * (j))
#define XB_XGEN(j)  (2304 + 64 * (j))
#define XB_TOP      3328
#define XB_TOPGEN   3392
#define XCD_BAR_WORDS 3456
#define XB_SPIN_CAP (1u << 18)
__device__ __forceinline__ unsigned xb_ld(unsigned* p)              { return __hip_atomic_load(p, __ATOMIC_RELAXED, __HIP_MEMORY_SCOPE_AGENT); }
__device__ __forceinline__ unsigned xb_add(unsigned* p, unsigned v) { return __hip_atomic_fetch_add(p, v, __ATOMIC_RELAXED, __HIP_MEMORY_SCOPE_AGENT); }
__device__ __forceinline__ unsigned xb_xcc_id() { return (unsigned)__builtin_amdgcn_s_getreg((3 << 11) | 20) & 0xFu; }
#define XB_SPIN(cond, bar) do { unsigned _sp = 0; while (cond) { __builtin_amdgcn_s_sleep(1); \
    if ((++_sp & 255u) == 0u) { if (xb_ld(&(bar)[XB_TMO])) break; if (_sp > XB_SPIN_CAP) { atomicAdd(&(bar)[XB_TMO], 1u); break; } } } } while (0)
struct XcdBarrier { unsigned* bar; unsigned x; volatile LAS unsigned* st; };
__device__ __forceinline__ XcdBarrier xcd_barrier_post(unsigned* bar, volatile LAS unsigned* st) {
    XcdBarrier b; b.bar = bar; b.x = xb_xcc_id(); b.st = st;
    if (threadIdx.x == 0) (void)xb_add(&bar[XB_XCNT(b.x)], 1u);
    return b;
}
__device__ __forceinline__ void xcd_barrier_complete(unsigned* bar, unsigned x, unsigned& nloc, unsigned& nx) {
    const unsigned G = gridDim.x * gridDim.y * gridDim.z;
    unsigned sum, cnt, mine, sp = 0u;
    for (;;) {
        sum = 0u; cnt = 0u; mine = 0u;
#pragma unroll
        for (unsigned j = 0; j < 16; ++j) { const unsigned c = xb_ld(&bar[XB_XCNT(j)]); sum += c; cnt += (c > 0u) ? 1u : 0u; mine = (j == x) ? c : mine; }
        if (sum == G) break;
        __builtin_amdgcn_s_sleep(1);
        if ((++sp & 255u) == 0u) { if (xb_ld(&bar[XB_TMO])) break; if (sp > XB_SPIN_CAP) { atomicAdd(&bar[XB_TMO], 1u); break; } }
    }
    nloc = mine > 0u ? mine : 1u; nx = cnt > 0u ? cnt : 1u;
}
__device__ __forceinline__ void xcd_barrier(const XcdBarrier& b) {
    asm volatile("s_waitcnt vmcnt(0)" ::: "memory");
    __syncthreads();
    if (threadIdx.x == 0) {
        unsigned* bar = b.bar;
        __builtin_amdgcn_s_waitcnt(0);
        unsigned nloc = b.st[0], nx = b.st[1];
        if (nloc == 0u) { xcd_barrier_complete(bar, b.x, nloc, nx); b.st[0] = nloc; b.st[1] = nx; }
        const unsigned old = xb_add(&bar[XB_XSUB(b.x)], 1u);
        const unsigned gen = old / nloc;
        if (old + 1u == (gen + 1u) * nloc) {
            __builtin_amdgcn_fence(__ATOMIC_RELEASE, "agent");
            asm volatile("s_waitcnt vmcnt(0)" ::: "memory");
            const unsigned og = xb_add(&bar[XB_TOP], 1u);
            const unsigned tg = og / nx;
            if (og + 1u == (tg + 1u) * nx) xb_add(&bar[XB_TOPGEN], 1u);
            else XB_SPIN(xb_ld(&bar[XB_TOPGEN]) == tg, bar);
            __builtin_amdgcn_fence(__ATOMIC_ACQUIRE, "agent");
            xb_add(&bar[XB_XGEN(b.x)], 1u);
            asm volatile("s_waitcnt vmcnt(0)" ::: "memory");
        } else {
            XB_SPIN(xb_ld(&bar[XB_XGEN(b.x)]) == gen, bar);
            __builtin_amdgcn_fence(__ATOMIC_ACQUIRE, "agent");
            asm volatile("s_waitcnt vmcnt(0)" ::: "memory");
        }
    }
    __syncthreads();
}

namespace gm {
constexpr int BM = 256, BK = 64, HALF = 128, HTB = HALF * BK * 2, STAGE_BYTES = 8 * HTB;
__device__ __forceinline__ int lds_byte(int r, int c) { const int st = (r >> 4) * 2 + (c >> 5), rr = r & 15, cc = c & 31, ob = rr * 64 + cc * 2; return st * 1024 + (ob ^ (((ob >> 9) & 1) << 5)); }
__device__ __forceinline__ void stage_rc(int b, int& R, int& C) { const int st = b / 1024, sb = b % 1024, swz = sb ^ (((sb >> 9) & 1) << 5); R = (st >> 1) * 16 + swz / 64; C = (st & 1) * 32 + (swz % 64) / 2; }
__device__ __forceinline__ int perm32(int rho) { const int n = rho >> 4, i = rho & 15; return 8 * (i >> 2) + 4 * n + (i & 3); }

struct Unit { const char* a0; const char* a1; const char* b0; const char* b1; int p0, p1, p2, p3, q; };

__device__ __forceinline__ void tile_order(int L, int nM, int nN, int& pm, int& pn) {
    const int nwg = nM * nN; int wgid = L;
    { const int q = nwg / 8, r = nwg % 8, xcd = wgid % 8, off = wgid / 8; wgid = (xcd < r ? xcd * (q + 1) : r * (q + 1) + (xcd - r) * q) + off; }
    const int nig = 8 * nN, gid = wgid / nig, fm = gid * 8, gsz = (nM - fm) < 8 ? (nM - fm) : 8;
    pm = fm + ((wgid % nig) % gsz); pn = (wgid % nig) / gsz;
}

template <bool I8> struct AccSel { typedef f32x4 type; };
template <> struct AccSel<true> { typedef i32x4 type; };
template <class Epi, class Sched, bool GATHER, bool I8 = false, bool PREF = false>
__device__ __forceinline__ void gemm_run(LAS unsigned char* lds, const Sched& S, const Epi& E) {
    const int tid = threadIdx.x, wid = __builtin_amdgcn_readfirstlane(tid >> 6), lane = tid & 63, wr = wid >> 2, wc = wid & 3, fr = lane & 15, fq = lane >> 4;
    int nt = S.nt; asm volatile("" : "+s"(nt));
    unsigned voffA[2], voffB[2], colA[2]; int rowA[2];
#pragma unroll
    for (int i = 0; i < 2; ++i) { int R, C; stage_rc(tid * 16 + i * 8192, R, C); const int Rb = Epi::PERM ? ((R & ~31) + perm32(R & 31)) : R;
        voffA[i] = (unsigned)(R * S.multA * S.pitchA + C) * 2u; voffB[i] = (unsigned)(Rb * S.multB * S.pitchB + C) * 2u; colA[i] = (unsigned)C * 2u; rowA[i] = R; }
    const size_t kstep = (size_t)(BK * 2);
    const unsigned ldsw = (unsigned)wid * 1024u;
    const int aoff = lds_byte(wr * 64 + fr, fq * 8), boff = lds_byte(wc * 32 + fr, fq * 8);
#define G_SA(b, h) (((b) * 2 + (h)) * HTB)
#define G_SB(b, h) ((4 + (b) * 2 + (h)) * HTB)
#define G_STAGE(bufoff, gbase, voff) do { _Pragma("unroll") for (int _i = 0; _i < 2; ++_i) \
        __builtin_amdgcn_global_load_lds((const unsigned*)((const char*)(gbase) + (voff)[_i]), (LAS unsigned*)(lds + (bufoff) + ldsw + _i * 8192), 16, 0, 0); } while (0)
#define G_LDA(dst, b, h) do { _Pragma("unroll") for (int m = 0; m < 4; ++m) _Pragma("unroll") for (int k = 0; k < 2; ++k) dst[m][k] = *(const LAS bf16x8*)(lds + G_SA(b, h) + aoff + m * 2048 + k * 1024); } while (0)
#define G_LDB(dst, b, h) do { _Pragma("unroll") for (int n = 0; n < 2; ++n) _Pragma("unroll") for (int k = 0; k < 2; ++k) dst[n][k] = *(const LAS bf16x8*)(lds + G_SB(b, h) + boff + n * 2048 + k * 1024); } while (0)
#define G_MMA(ai, bj, At, Bt) do { __builtin_amdgcn_s_setprio(1); _Pragma("unroll") for (int m = 0; m < 4; ++m) _Pragma("unroll") for (int n = 0; n < 2; ++n) _Pragma("unroll") for (int k = 0; k < 2; ++k) \
        { if constexpr (I8) acc[ai][bj][m][n] = __builtin_amdgcn_mfma_i32_16x16x64_i8(__builtin_bit_cast(i32x4, Bt[n][k]), __builtin_bit_cast(i32x4, At[m][k]), acc[ai][bj][m][n], 0, 0, 0); \
          else acc[ai][bj][m][n] = __builtin_amdgcn_mfma_f32_16x16x32_bf16(Bt[n][k], At[m][k], acc[ai][bj][m][n], 0, 0, 0); } __builtin_amdgcn_s_setprio(0); } while (0)
#define G_WAIT_V(n) asm volatile("s_waitcnt vmcnt(" #n ")" ::: "memory")
#define G_WAIT_L(n) asm volatile("s_waitcnt lgkmcnt(" #n ")" ::: "memory")
#define G_BAR __builtin_amdgcn_s_barrier()
#define G_SCHED __builtin_amdgcn_sched_barrier(0)
    Unit cur, nxt; int ui = 0;
    if (!S.next(0, cur)) return;
    cur.q = 0;
    if constexpr (PREF) { S.prefetch(cur, lds); G_WAIT_V(0); G_BAR; }
    typedef typename AccSel<I8>::type acc_t;
    acc_t acc[2][2][4][2];
#pragma unroll
    for (int a = 0; a < 2; ++a)
#pragma unroll
        for (int b = 0; b < 2; ++b)
#pragma unroll
            for (int m = 0; m < 4; ++m)
#pragma unroll
                for (int n = 0; n < 2; ++n) acc[a][b][m][n] = (acc_t){0, 0, 0, 0};
    bf16x8 At[4][2], B0[2][2], B1[2][2];
    unsigned gc0[2], gc1[2];
    if constexpr (GATHER) {
#pragma unroll
        for (int i = 0; i < 2; ++i) { gc0[i] = S.row_off(cur, rowA[i], lds) + colA[i]; gc1[i] = S.row_off(cur, 128 + rowA[i], lds) + colA[i]; }
    }
#define vA0 (GATHER ? gc0 : voffA)
#define vA1 (GATHER ? gc1 : voffA)
    G_STAGE(G_SB(0, 0), cur.b0, voffB); G_STAGE(G_SB(0, 1), cur.b1, voffB); G_STAGE(G_SA(0, 0), cur.a0, vA0); G_STAGE(G_SA(0, 1), cur.a1, vA1);
    if (wr == 1) G_BAR;
    G_WAIT_V(2); G_BAR;
    G_STAGE(G_SB(1, 0), cur.b0 + kstep, voffB); G_STAGE(G_SA(1, 0), cur.a0 + kstep, vA0); G_STAGE(G_SB(1, 1), cur.b1 + kstep, voffB);
    G_WAIT_V(6); G_BAR;
    for (;;) {
        const bool has_next = S.next(ui + 1, nxt);
        if (!has_next) nxt = cur;
        nxt.q = (ui + 1) & 1;
        for (int t = 0; t < nt; t += 2) {
            const bool last = (t == nt - 2);
            if constexpr (PREF) { if (t == nt - 4) S.prefetch(nxt, lds); }
            const char* a11 = cur.a1 + (size_t)(t + 1) * kstep;
            const char* a02 = last ? nxt.a0 : cur.a0 + (size_t)(t + 2) * kstep; const char* a12 = last ? nxt.a1 : cur.a1 + (size_t)(t + 2) * kstep;
            const char* b02 = last ? nxt.b0 : cur.b0 + (size_t)(t + 2) * kstep; const char* b12 = last ? nxt.b1 : cur.b1 + (size_t)(t + 2) * kstep;
            G_LDB(B0, 0, 0); G_LDB(B1, 0, 1); G_SCHED; G_LDA(At, 0, 0); G_STAGE(G_SA(1, 1), a11, vA1);
            if constexpr (GATHER) { if (last) { int tz = tid; asm volatile("" : "+v"(tz));
#pragma unroll
                for (int i = 0; i < 2; ++i) { int R, C; stage_rc(tz * 16 + i * 8192, R, C); gc0[i] = S.row_off(nxt, R, lds) + (unsigned)C * 2u; gc1[i] = S.row_off(nxt, 128 + R, lds) + (unsigned)C * 2u; } } }
            G_WAIT_V(8); G_WAIT_L(0); G_BAR; G_MMA(0, 0, At, B0); G_MMA(0, 1, At, B1); G_BAR; G_SCHED;
            G_LDA(At, 0, 1); G_STAGE(G_SB(0, 0), b02, voffB); G_STAGE(G_SB(0, 1), b12, voffB); G_STAGE(G_SA(0, 0), a02, vA0);
            G_WAIT_V(8); G_WAIT_L(0); G_BAR; G_MMA(1, 0, At, B0); G_MMA(1, 1, At, B1); G_BAR; G_SCHED;
            G_LDB(B0, 1, 0); G_LDB(B1, 1, 1); G_SCHED; G_LDA(At, 1, 0); G_STAGE(G_SA(0, 1), a12, vA1);
            G_WAIT_V(8); G_WAIT_L(0); G_BAR; G_MMA(0, 0, At, B0); G_MMA(0, 1, At, B1); G_BAR; G_SCHED;
            G_LDA(At, 1, 1); G_STAGE(G_SB(1, 0), b02 + kstep, voffB); G_STAGE(G_SB(1, 1), b12 + kstep, voffB); G_STAGE(G_SA(1, 0), a02 + kstep, vA0);
            G_WAIT_V(8); G_WAIT_L(0); G_BAR; G_MMA(1, 0, At, B0); G_MMA(1, 1, At, B1); G_BAR; G_SCHED;
        }
        if (wr == 0) G_BAR;
        { int fr2 = fr, fq2 = fq; asm volatile("" : "+v"(fr2), "+v"(fq2));
          E(acc, cur, lds, wr, wc, fr2, fq2); }
        if (!has_next) break;
#pragma unroll
        for (int a = 0; a < 2; ++a)
#pragma unroll
            for (int b = 0; b < 2; ++b)
#pragma unroll
                for (int m = 0; m < 4; ++m)
#pragma unroll
                    for (int n = 0; n < 2; ++n) acc[a][b][m][n] = (acc_t){0, 0, 0, 0};
        cur = nxt; ++ui;
        if (wr == 1) G_BAR;
    }
    G_WAIT_V(0);
    G_BAR;
#undef G_SA
#undef G_SB
#undef G_STAGE
#undef G_LDA
#undef G_LDB
#undef G_MMA
#undef G_WAIT_V
#undef G_WAIT_L
#undef G_BAR
#undef G_SCHED
#undef vA0
#undef vA1
}
}
using gm::Unit;
typedef f32x4 Acc[2][2][4][2];
typedef i32x4 AccI[2][2][4][2];

struct Args { const float* in[18]; float* out; unsigned char* ws; int ph_lo, ph_hi; };
struct Frame {
    LAS unsigned char* lds; unsigned char* ws; unsigned* ctl;
    int tid, lane, wave, vcu, G;
    const float *x, *ln0_g, *ln0_b, *w_in, *dec_f, *dec_b, *gn_g, *w_out, *ln1_g, *ln1_b, *w_r, *b_r, *w_up, *b_up, *w_dn, *b_dn, *ln2_g, *ln2_b;
    float* out;
};
#define WSP(T_, off) ((T_*)(F.ws + (off)))

template <class ColMap>
__device__ __forceinline__ void transpose_item(const float* W, int K, int N, bf16* WT, LAS float* scr, int item, int lane, const ColMap& cm) {
    const int nblk = N / 64, kb = item / nblk, nb = item % nblk, k0 = 64 * kb, n0 = 64 * nb;
    const int s0 = cm(n0);
#pragma unroll 4
    for (int i = 0; i < 16; ++i) { const int kk = 4 * i + (lane >> 4), c4 = (lane & 15) * 4;
        const f32x4 v = *(const GAS f32x4*)(W + (size_t)(k0 + kk) * N + s0 + c4);
        LAS float* d = scr + kk * 65 + c4; d[0] = v[0]; d[1] = v[1]; d[2] = v[2]; d[3] = v[3]; }
    LDS_WAIT(); asm volatile("" ::: "memory");
    const int c = lane & 7;
#pragma unroll
    for (int j = 0; j < 8; ++j) { const int n = (lane >> 3) + 8 * j; const LAS float* s = scr + (8 * c) * 65 + n;
        v4u o; o.x = cvt_pk_bf16(s[0 * 65], s[1 * 65]); o.y = cvt_pk_bf16(s[2 * 65], s[3 * 65]); o.z = cvt_pk_bf16(s[4 * 65], s[5 * 65]); o.w = cvt_pk_bf16(s[6 * 65], s[7 * 65]);
        *(GAS v4u*)(WT + (size_t)(n0 + n) * K + k0 + 8 * c) = o; }
    LDS_WAIT(); asm volatile("" ::: "memory");
}
struct ColId { __device__ __forceinline__ int operator()(int n) const { return n; } };
struct ColUp { __device__ __forceinline__ int operator()(int n) const { return ((n >> 8) * 128 + (n & 127)) + ((n >> 7) & 1) * 2048; } };

__device__ __forceinline__ void p0_prologue(Frame& F) {
    const int gw = F.vcu * NWAVES + F.wave, NGW = F.G * NWAVES;
    {
        unsigned* h0q = WSP(unsigned, WS_H0B); float* st0 = WSP(float, WS_ST0); float* sx0 = WSP(float, WS_SX0);
        for (int m = gw; m < T; m += NGW) {
            const GAS f32x4* xr = (const GAS f32x4*)(F.x + (size_t)m * D) + F.lane;
            f32x4 v[8]; float s = 0.f;
#pragma unroll
            for (int j = 0; j < 8; ++j) { v[j] = xr[64 * j]; s += (v[j][0] + v[j][1]) + (v[j][2] + v[j][3]); }
            const float mean = wave_sum(s) * (1.f / D); float s2 = 0.f;
#pragma unroll
            for (int j = 0; j < 8; ++j) { v[j] = v[j] - mean; s2 += (v[j][0] * v[j][0] + v[j][1] * v[j][1]) + (v[j][2] * v[j][2] + v[j][3] * v[j][3]); }
            const float rstd = 1.f / sqrtf(wave_sum(s2) * (1.f / D) + LN_EPS); float am = 0.f;
#pragma unroll
            for (int j = 0; j < 8; ++j) { const f32x4 g = *((const GAS f32x4*)F.ln0_g + F.lane + 64 * j), b = *((const GAS f32x4*)F.ln0_b + F.lane + 64 * j);
                v[j] = v[j] * rstd * g + b; am = fmaxf(am, fmaxf(fmaxf(fabsf(v[j][0]), fabsf(v[j][1])), fmaxf(fabsf(v[j][2]), fabsf(v[j][3])))); }
#pragma unroll
            for (int o = 1; o < 64; o <<= 1) am = fmaxf(am, __shfl_xor(am, o));
            const float sc = am > 0.f ? am * (1.f / 127.f) : 1.f, inv = 1.f / sc;
#pragma unroll
            for (int j = 0; j < 8; ++j) { const int q0 = (int)__builtin_rintf(v[j][0] * inv), q1 = (int)__builtin_rintf(v[j][1] * inv), q2 = (int)__builtin_rintf(v[j][2] * inv), q3 = (int)__builtin_rintf(v[j][3] * inv);
                h0q[(size_t)m * (D / 4) + F.lane + 64 * j] = (unsigned)(q0 & 0xff) | ((unsigned)(q1 & 0xff) << 8) | ((unsigned)(q2 & 0xff) << 16) | ((unsigned)(q3 & 0xff) << 24); }
            if (F.lane == 0) { st0[2 * m] = mean; st0[2 * m + 1] = rstd; sx0[m] = sc; }
        }
    }
    {
        bf16* tab = WSP(bf16, WS_TAB);
        for (int i = (F.vcu * NTHR + F.tid); i < 32768 + 65536 + 65536; i += F.G * NTHR) {
            float v;
            if (i < 32768) { const int r = i >> 7, a = i & 127, ri = r >> 7, k1 = r & 127; float c, s; cs_rev((float)((k1 * a) & 127) * (1.f / 128.f), c, s); v = ri ? -s : c; }
            else if (i < 32768 + 65536) { const int e = i - 32768, r = e >> 8, q = e & 255, ri = r >> 7, k2 = r & 127, rj = q >> 7, b = q & 127; float c, s; cs_rev((float)((k2 * b) & 127) * (1.f / 128.f), c, s);
                v = (ri == 0) ? (rj == 0 ? c : s) : (rj == 0 ? -s : c); }
            else { const int e = i - 32768 - 65536, l = e >> 8, q = e & 255, rj = q >> 7, cg = q & 127; float c, s; cs_rev((float)((l * cg) & 127) * (1.f / 128.f), c, s); v = (l < 128) ? (rj == 0 ? c : s) : 0.f; }
            tab[i] = (bf16)(cvt_pk_bf16(v, 0.f) & 0xffffu);
        }
    }
    {
        LAS float* scr = (LAS float*)(F.lds + F.wave * 18432);
        constexpr int I_IN = 32 * (DIN / 64), I_OUT = 32 * (D / 64), I_UP = 32 * (2 * DFF / 64), I_DN = 32 * (D / 64);
        constexpr int NIT = I_OUT;
        for (int it = gw; it < NIT; it += NGW) {
            int r = it;
            { transpose_item(F.w_out, D, D, WSP(bf16, WS_WOUT), scr, r, F.lane, ColId()); }
        }
    }
}

struct SlabDesc { const float* W; signed char* WQ; float* sw; int NS, e, n0, valid; };
struct QF { unsigned char* ws; const float* w_up; const float* w_dn; const float* w_in; int vcu, G; };
__device__ __forceinline__ SlabDesc slab_desc(const QF& F, int j) {
    const int nU = (NE * 128 + F.G - 1) / F.G; SlabDesc d;
    if (j < 0) { const int sl = F.vcu + (-1 - j) * F.G; d.valid = sl < DIN / 32; d.NS = DIN; d.e = 0; d.n0 = sl * 32; d.W = F.w_in + d.n0; d.WQ = (signed char*)WSP(char, WS_WIN); d.sw = WSP(float, WS_SWIN); }
    else if (j < nU) { const int sl = F.vcu + j * F.G; d.valid = sl < NE * 128; d.NS = 2 * DFF; d.e = sl >> 7; d.n0 = (sl & 127) * 32; d.W = F.w_up + (size_t)d.e * D * 2 * DFF + ColUp()(d.n0); d.WQ = (signed char*)WSP(char, WS_WUP); d.sw = WSP(float, WS_SWUP); }
    else { const int sl = F.vcu + (j - nU) * F.G; d.valid = sl < NE * 64; d.NS = D; d.e = sl >> 6; d.n0 = (sl & 63) * 32; d.W = F.w_dn + (size_t)d.e * DFF * D + d.n0; d.WQ = (signed char*)WSP(char, WS_WDN); d.sw = WSP(float, WS_SWDN); }
    return d;
}
#define SLAB_LOAD(dsc, v) do { if ((dsc).valid) { const GAS char* b_ = (const GAS char*)(dsc).W; unsigned o_ = (unsigned)((wave * 256 + kq) * (dsc).NS + c4) * 4u; const unsigned st_ = (unsigned)(dsc).NS * 32u; \
    _Pragma("unroll") for (int i_ = 0; i_ < 32; ++i_) { v[i_] = __builtin_nontemporal_load((const GAS f32x4*)(b_ + o_)); o_ += st_; } } } while (0)
__device__ __forceinline__ void do_slabs_impl(LAS unsigned char* lds, unsigned char* ws, const float* w_up, const float* w_dn, const float* w_in, int vcu, int G, int j0, int j1) {
    if (j0 >= j1) return;
    QF F; F.ws = ws; F.w_up = w_up; F.w_dn = w_dn; F.w_in = w_in; F.vcu = vcu; F.G = G;
    const int tid = threadIdx.x, lane = tid & 63, wave = __builtin_amdgcn_readfirstlane(tid >> 6);
    constexpr int PITCH = 2056;
    LAS bf16* slab = (LAS bf16*)lds;
    LAS float* red = (LAS float*)(lds + 32 * PITCH * 2);
    const int kq = lane >> 3, c4 = (lane & 7) * 4;
    f32x4 v[32];
    SlabDesc cur = slab_desc(F, j0);
    SLAB_LOAD(cur, v);
    for (int j = j0; j < j1; ++j) {
        if (cur.valid) {
            f32x4 mx = (f32x4){0.f, 0.f, 0.f, 0.f};
#pragma unroll
            for (int i = 0; i < 32; ++i) { const int k = wave * 256 + i * 8 + kq; const f32x4 x = v[i];
                mx[0] = fmaxf(mx[0], fabsf(x[0])); mx[1] = fmaxf(mx[1], fabsf(x[1])); mx[2] = fmaxf(mx[2], fabsf(x[2])); mx[3] = fmaxf(mx[3], fabsf(x[3]));
                const unsigned p01 = cvt_pk_bf16(x[0], x[1]), p23 = cvt_pk_bf16(x[2], x[3]);
                const int ks = k ^ (((c4 >> 3) & 3) << 3);
                slab[(c4 + 0) * PITCH + ks] = (bf16)(p01 & 0xffffu); slab[(c4 + 1) * PITCH + ks] = (bf16)(p01 >> 16); slab[(c4 + 2) * PITCH + ks] = (bf16)(p23 & 0xffffu); slab[(c4 + 3) * PITCH + ks] = (bf16)(p23 >> 16); }
#pragma unroll
            for (int q = 0; q < 4; ++q) { float m = mx[q]; m = fmaxf(m, __shfl_xor(m, 8)); m = fmaxf(m, __shfl_xor(m, 16)); m = fmaxf(m, __shfl_xor(m, 32)); mx[q] = m; }
            if (lane < 8) { LAS float* d = red + wave * 32 + c4; d[0] = mx[0]; d[1] = mx[1]; d[2] = mx[2]; d[3] = mx[3]; }
        }
        const SlabDesc done = cur;
        if (j + 1 < j1) { cur = slab_desc(F, j + 1); SLAB_LOAD(cur, v); }
        __syncthreads();
        if (done.valid && tid < 32) { float m = 0.f;
#pragma unroll
            for (int w = 0; w < 8; ++w) m = fmaxf(m, red[w * 32 + tid]);
            const float sc = m > 0.f ? m * (1.f / 127.f) : 1.f; done.sw[(size_t)done.e * done.NS + done.n0 + tid] = sc; red[256 + tid] = 1.f / sc; }
        __syncthreads();
        if (done.valid) {
#pragma unroll 2
            for (int i = 0; i < 8; ++i) { const int q = tid + NTHR * i, n = q >> 7, kc = q & 127; const float inv = red[256 + n];
                const int sx_ = ((n >> 3) & 3) << 3;
                const v4u a = *(const LAS v4u*)(slab + n * PITCH + ((kc * 16) ^ sx_)), b = *(const LAS v4u*)(slab + n * PITCH + ((kc * 16 + 8) ^ sx_));
                const unsigned src[8] = {a.x, a.y, a.z, a.w, b.x, b.y, b.z, b.w}; unsigned o[4];
#pragma unroll
                for (int d = 0; d < 4; ++d) { unsigned w = 0u;
#pragma unroll
                    for (int h2 = 0; h2 < 2; ++h2) { const unsigned u2 = src[2 * d + h2]; const int q0 = (int)__builtin_rintf(bf_lo(u2) * inv), q1 = (int)__builtin_rintf(bf_hi(u2) * inv);
                        w |= ((unsigned)(q0 & 0xff) << (16 * h2)) | ((unsigned)(q1 & 0xff) << (16 * h2 + 8)); }
                    o[d] = w; }
                *(GAS v4u*)(done.WQ + ((size_t)done.e * done.NS + done.n0 + n) * D + kc * 16) = (v4u){o[0], o[1], o[2], o[3]}; }
        }
        __syncthreads();
    }
}

__device__ __forceinline__ void do_slabs(Frame& F, int j0, int j1) { do_slabs_impl(F.lds, F.ws, F.w_up, F.w_dn, F.w_in, F.vcu, F.G, j0, j1); }

struct SchedBase { int nt, pitchA, pitchB, multA, multB, G, c; };
struct SchedG1N : SchedBase {
    const char* A; const char* Bt;
    __device__ __forceinline__ bool next(int i, Unit& u) const { const int L = i * G + c; if (L >= 64 * 12) return false; int pm, pn; gm::tile_order(L, 64, 12, pm, pn);
        const int cb = pn < 4 ? 1024 + 256 * pn : (pn < 8 ? 2048 + 256 * (pn - 4) : 4096 + 256 * (pn - 8));
        u.a0 = A + (size_t)pm * 256 * D; u.a1 = u.a0 + (size_t)128 * D; u.b0 = Bt + (size_t)cb * D; u.b1 = u.b0 + (size_t)128 * D; u.p0 = pm; u.p1 = pn; u.p2 = cb; u.p3 = 0; return true; }
};
struct SchedG1SF : SchedBase {
    const char* A; const char* Bt;
    __device__ __forceinline__ bool next(int i, Unit& u) const { const int L = i * G + c; if (L >= 4 * 64) return false; int pm, pn; gm::tile_order(L, 4, 64, pm, pn);
        u.a0 = A + (size_t)pm * 256 * D; u.a1 = u.a0 + (size_t)128 * D; u.b0 = Bt + (size_t)(2 * pn) * D; u.b1 = u.b0 + (size_t)D; u.p0 = pm; u.p1 = pn; u.p2 = 0; u.p3 = 0; return true; }
};
struct SchedG1SKV : SchedBase {
    const char* A; const char* Bt;
    __device__ __forceinline__ bool next(int i, Unit& u) const { const int L = i * G + c; if (L >= 8 * 64) return false; int pm, pn; gm::tile_order(L, 8, 64, pm, pn);
        const int rb = pm < 4 ? 2048 + 256 * pm : 3072 + 256 * (pm - 4);
        u.a0 = A + (size_t)rb * D; u.a1 = u.a0 + (size_t)128 * D; u.b0 = Bt + (size_t)pn * 256 * D; u.b1 = u.b0 + (size_t)128 * D; u.p0 = pm; u.p1 = pn; u.p2 = rb; u.p3 = 0; return true; }
};
struct SchedFixA : SchedBase {
    const char* A; const char* Bt; int ncol;
    __device__ __forceinline__ bool next(int i, Unit& u) const { const int L = i * G + c; if (L >= ncol) return false;
        u.a0 = A; u.a1 = A + (size_t)128 * pitchA * 2; u.b0 = Bt + (size_t)L * 256 * pitchB * 2; u.b1 = u.b0 + (size_t)128 * pitchB * 2; u.p0 = 0; u.p1 = L; u.p2 = 0; u.p3 = 0; return true; }
};
struct SchedFixB : SchedBase {
    const char* A; const char* Bt; int nrow;
    __device__ __forceinline__ bool next(int i, Unit& u) const { const int L = i * G + c; if (L >= nrow) return false;
        u.a0 = A + (size_t)L * 256 * pitchA * 2; u.a1 = u.a0 + (size_t)128 * pitchA * 2; u.b0 = Bt; u.b1 = Bt + (size_t)128 * pitchB * 2; u.p0 = L; u.p1 = 0; u.p2 = 0; u.p3 = 0; return true; }
};
struct SchedScores : SchedBase {
    const char* Q; const char* Kk;
    __device__ __forceinline__ bool next(int i, Unit& u) const { const int L = i * G + c; if (L >= NH * NCH) return false; const int h = L & 3, n = L >> 2;
        u.a0 = Q + ((size_t)n * 256 * RW + h * HD) * 2; u.a1 = u.a0 + (size_t)128 * RW * 2; u.b0 = Kk + ((size_t)n * 256 * RW + h * HD) * 2; u.b1 = u.b0 + (size_t)128 * RW * 2; u.p0 = h; u.p1 = n; u.p2 = 0; u.p3 = 0; return true; }
};
struct SchedKV : SchedBase {
    const char* Bcat; const char* kTw;
    __device__ __forceinline__ bool next(int i, Unit& u) const { const int L = i * G + c; if (L >= 2 * NH * NCH) return false; const int dh = L & 7, n = L >> 3, dir = dh >> 2, h = dh & 3;
        u.a0 = Bcat + ((size_t)(h * NCH + n) * 256 * CAT) * 2; u.a1 = u.a0 + (size_t)128 * CAT * 2;
        u.b0 = kTw + (((size_t)dir * RW + h * HD) * T + (size_t)n * 256) * 2; u.b1 = u.b0 + (size_t)128 * T * 2; u.p0 = dh; u.p1 = n; u.p2 = 0; u.p3 = 0; return true; }
};
struct SchedOut : SchedBase {
    const char* Acat; const char* Bcat;
    __device__ __forceinline__ bool next(int i, Unit& u) const { const int L = i * G + c; if (L >= NH * NCH) return false; const int h = L & 3, n = L >> 2;
        u.a0 = Acat + ((size_t)h * T + (size_t)n * 256) * CAT * 2; u.a1 = u.a0 + (size_t)128 * CAT * 2; u.b0 = Bcat + ((size_t)(h * NCH + n) * 256 * CAT) * 2; u.b1 = u.b0 + (size_t)128 * CAT * 2; u.p0 = h; u.p1 = n; u.p2 = 0; u.p3 = 0; return true; }
};
struct Sched2D : SchedBase {
    const char* A; const char* Bt; int nM, nN;
    __device__ __forceinline__ bool next(int i, Unit& u) const { const int L = i * G + c; if (L >= nM * nN) return false; int pm, pn; gm::tile_order(L, nM, nN, pm, pn);
        u.a0 = A + (size_t)pm * 256 * pitchA * 2; u.a1 = u.a0 + (size_t)128 * pitchA * 2; u.b0 = Bt + (size_t)pn * 256 * pitchB * 2; u.b1 = u.b0 + (size_t)128 * pitchB * 2; u.p0 = pm; u.p1 = pn; u.p2 = 0; u.p3 = 0; return true; }
};
struct SchedMoE : SchedBase {
    const char* A; const char* Bt; const LAS int* tstart; const int* row_tok; const unsigned* cnt; int nN, rowbytes; size_t estride;
    __device__ __forceinline__ bool next(int i, Unit& u) const { const int RT = __builtin_amdgcn_readfirstlane(tstart[NE]); const int L = i * G + c; if (L >= RT * nN) return false; int rt, pn; gm::tile_order(L, RT, nN, rt, pn);
        const int e = __builtin_amdgcn_readfirstlane(tstart[40 + rt]);
        u.b0 = Bt + (size_t)e * estride + (size_t)pn * 256 * rowbytes; u.b1 = u.b0 + (size_t)128 * rowbytes;
        u.a0 = A; u.a1 = A;
        u.p0 = rt; u.p1 = pn; u.p2 = e; u.p3 = (rt - __builtin_amdgcn_readfirstlane(tstart[e])) * 256; return true; }
    __device__ __forceinline__ bool next_tab(int i, Unit& u) const { const int w = (i < 64) ? __builtin_amdgcn_readfirstlane(tstart[400 + i]) : -1; if (w < 0) return false;
        const int rt = w & 1023, pn = (w >> 10) & 31, e = (w >> 15) & 31;
        u.b0 = Bt + (size_t)e * estride + (size_t)pn * 256 * rowbytes; u.b1 = u.b0 + (size_t)128 * rowbytes; u.a0 = A; u.a1 = A;
        u.p0 = rt; u.p1 = pn; u.p2 = e; u.p3 = (rt - __builtin_amdgcn_readfirstlane(tstart[e])) * 256; return true; }
    const float *rsc, *swup, *b_up;
    __device__ __forceinline__ void prefetch(const Unit& u, LAS unsigned char* lds) const {
        LAS unsigned char* blk = lds + LDS_STAGE + u.q * 4096;
        const int wid = __builtin_amdgcn_readfirstlane(threadIdx.x >> 6), lane = threadIdx.x & 63, e = u.p2;
        const int n = (int)cnt[64 * e]; int pos = u.p3 + (wid & 3) * 64 + lane; pos = pos < n ? pos : n - 1;
        if (wid < 4) __builtin_amdgcn_global_load_lds((const unsigned*)(row_tok + (size_t)e * T + pos), (LAS unsigned*)(blk + wid * 256), 4, 0, 0);
        else __builtin_amdgcn_global_load_lds((const unsigned*)(rsc + (size_t)e * T + pos), (LAS unsigned*)(blk + 1024 + (wid - 4) * 256), 4, 0, 0);
        if (wid == 0) __builtin_amdgcn_global_load_lds((const unsigned*)(swup + (size_t)e * 2 * DFF + u.p1 * 256 + lane * 4), (LAS unsigned*)(blk + 2048), 16, 0, 0);
        if (wid == 1) __builtin_amdgcn_global_load_lds((const unsigned*)(b_up + (size_t)e * 2 * DFF + u.p1 * 128 + (lane & 31) * 4 + (lane >> 5) * DFF), (LAS unsigned*)(blk + 3072), 16, 0, 0);
    }
    __device__ __forceinline__ unsigned row_off(const Unit& u, int r, LAS unsigned char* lds) const { return (unsigned)((const LAS int*)(lds + LDS_STAGE + u.q * 4096))[r] * (unsigned)rowbytes; }
};
struct SchedMoEUpT : SchedMoE { __device__ __forceinline__ bool next(int i, Unit& u) const { return next_tab(i, u); } };
struct SchedMoEDown : SchedMoE {
    const float *sa, *swdn, *b_dn;
    __device__ __forceinline__ bool next(int i, Unit& u) const { if (!SchedMoE::next_tab(i, u)) return false; u.a0 = A + (size_t)u.p0 * 256 * rowbytes; u.a1 = u.a0 + (size_t)128 * rowbytes; return true; }
    __device__ __forceinline__ void prefetch(const Unit& u, LAS unsigned char* lds) const {
        LAS unsigned char* blk = lds + LDS_STAGE + u.q * 4096;
        const int wid = __builtin_amdgcn_readfirstlane(threadIdx.x >> 6), lane = threadIdx.x & 63, e = u.p2;
        if (wid == 0) __builtin_amdgcn_global_load_lds((const unsigned*)(sa + (size_t)u.p0 * 256 + lane * 4), (LAS unsigned*)(blk), 16, 0, 0);
        if (wid == 1) __builtin_amdgcn_global_load_lds((const unsigned*)(swdn + (size_t)e * D + u.p1 * 256 + lane * 4), (LAS unsigned*)(blk + 1024), 16, 0, 0);
        if (wid == 2) __builtin_amdgcn_global_load_lds((const unsigned*)(b_dn + (size_t)e * D + u.p1 * 256 + lane * 4), (LAS unsigned*)(blk + 2048), 16, 0, 0);
    }
};

#define EPI_LOOP_AM for (int ai = 0; ai < 2; ++ai) _Pragma("unroll") for (int m = 0; m < 4; ++m)
#define EPI_FENCE __builtin_amdgcn_sched_barrier(0)
struct EpiG1N {
    static constexpr bool PERM = true;
    bf16 *qs, *kk, *gs, *Acat; const float *dec_f, *dec_b, *sx0, *swin;
    __device__ __forceinline__ void operator()(AccI& acci, const Unit& u, LAS unsigned char*, int wr, int wc, int fr, int fq) const {
        const int pm = u.p0, pn = u.p1, c0 = wc * 32 + 8 * fq;
        f32x4 swc[2][2];
#pragma unroll
        for (int bj = 0; bj < 2; ++bj)
#pragma unroll
            for (int n = 0; n < 2; ++n) swc[bj][n] = *(const GAS f32x4*)(swin + u.p2 + 128 * bj + c0 + 4 * n);
#define ACCF(ai_, bj_, m_, n_, j_) ((float)acci[ai_][bj_][m_][n_][j_] * (sxr * swc[bj_][n_][j_]))
        if (pn < 8) {
            const int h = pn & 3; const bool isq = pn < 4;
            float inv[8];
#pragma unroll
            for (int e = 0; e < 8; ++e) inv[e] = __builtin_amdgcn_exp2f(-(float)(c0 + e) * (13.287712379549449f / 128.f)) * 0.15915494309189535f;
            const float lgf = -fexp(dec_f[h]), lgb = -fexp(dec_b[h]);
#pragma unroll
            EPI_LOOP_AM {
                const int r = 128 * ai + 64 * wr + 16 * m + fr, tok = pm * 256 + r; const float pos = (float)tok; const float sxr = sx0[tok];
                f32x4 o1[2], o2[2];
#pragma unroll
                for (int n = 0; n < 2; ++n)
#pragma unroll
                    for (int j = 0; j < 4; ++j) { float c, s; cs_rev(pos * inv[4 * n + j], c, s); const float x1 = ACCF(ai, 0, m, n, j), x2 = ACCF(ai, 1, m, n, j); o1[n][j] = x1 * c - x2 * s; o2[n][j] = x2 * c + x1 * s; }
                if (isq) {
                    bf16* q = qs + (size_t)tok * RW + h * HD + c0; *(GAS v4u*)q = pack8(o1[0], o1[1]); *(GAS v4u*)(q + 128) = pack8(o2[0], o2[1]);
                    const int il = r; const float wf = fexp(lgf * (float)(il + 1)), wb = fexp(lgb * (float)(255 - il));
                    bf16* a = Acat + ((size_t)h * T + tok) * CAT + c0;
                    *(GAS v4u*)(a + 256) = pack8(o1[0] * wf, o1[1] * wf); *(GAS v4u*)(a + 384) = pack8(o2[0] * wf, o2[1] * wf);
                    *(GAS v4u*)(a + 512) = pack8(o1[0] * wb, o1[1] * wb); *(GAS v4u*)(a + 640) = pack8(o2[0] * wb, o2[1] * wb);
                } else {
                    bf16* k = kk + (size_t)tok * RW + h * HD + c0; *(GAS v4u*)k = pack8(o1[0] * 0.0625f, o1[1] * 0.0625f); *(GAS v4u*)(k + 128) = pack8(o2[0] * 0.0625f, o2[1] * 0.0625f);
                }
            }
        } else {
#pragma unroll
            EPI_LOOP_AM {
                const int r = 128 * ai + 64 * wr + 16 * m + fr, tok = pm * 256 + r; const float sxr = sx0[tok];
#pragma unroll
                for (int bj = 0; bj < 2; ++bj) { f32x4 v[2];
#pragma unroll
                    for (int n = 0; n < 2; ++n)
#pragma unroll
                        for (int j = 0; j < 4; ++j) { const float g = ACCF(ai, bj, m, n, j); v[n][j] = g * __builtin_amdgcn_rcpf(1.f + fexp(-g)); }
                    *(GAS v4u*)(gs + (size_t)tok * RW + (pn - 8) * 256 + bj * 128 + c0) = pack8(v[0], v[1]); }
            }
        }
    }
};
#undef ACCF
struct EpiG1SF {
    static constexpr bool PERM = true;
    bf16* uTT; const float *sx0, *swin;
    __device__ __forceinline__ void operator()(AccI& acc, const Unit& u, LAS unsigned char*, int wr, int wc, int fr, int fq) const {
        const int a0 = wc * 32 + 8 * fq;
        float sxc[2][8];
#pragma unroll
        for (int bj = 0; bj < 2; ++bj)
#pragma unroll
            for (int e = 0; e < 8; ++e) sxc[bj][e] = sx0[128 * (a0 + e) + 2 * u.p1 + bj];
#pragma unroll
        EPI_LOOP_AM { const int cch = u.p0 * 256 + 128 * ai + 64 * wr + 16 * m + fr; const float swr = swin[cch];
#pragma unroll
            for (int bj = 0; bj < 2; ++bj) { f32x4 v0, v1;
#pragma unroll
                for (int j = 0; j < 4; ++j) { v0[j] = (float)acc[ai][bj][m][0][j] * (swr * sxc[bj][j]); v1[j] = (float)acc[ai][bj][m][1][j] * (swr * sxc[bj][4 + j]); }
                *(GAS v4u*)(uTT + ((size_t)cch * 128 + (2 * u.p1 + bj)) * 128 + a0) = pack8(v0, v1); } }
    }
};
struct EpiG1SKV {
    static constexpr bool PERM = true;
    bf16 *kTw, *Bcat; const float *dec_f, *dec_b, *sx0, *swin;
    __device__ __forceinline__ void operator()(AccI& acc, const Unit& u, LAS unsigned char*, int wr, int wc, int fr, int fq) const {
        const int pm = u.p0, n_ch = u.p1, c0 = wc * 32 + 8 * fq;
        f32x4 sxc[2][2];
#pragma unroll
        for (int bj = 0; bj < 2; ++bj)
#pragma unroll
            for (int n = 0; n < 2; ++n) sxc[bj][n] = *(const GAS f32x4*)(sx0 + n_ch * 256 + 128 * bj + c0 + 4 * n);
        if (pm < 4) {
            const int h = pm; const float lgf = -fexp(dec_f[h]), lgb = -fexp(dec_b[h]);
#pragma unroll
            for (int m = 0; m < 4; ++m) {
                const int d = 64 * wr + 16 * m + fr;
                const float sw1 = swin[u.p2 + d], sw2 = swin[u.p2 + 128 + d];
                const float inv = __builtin_amdgcn_exp2f(-(float)d * (13.287712379549449f / 128.f)) * 0.15915494309189535f;
#pragma unroll
                for (int bj = 0; bj < 2; ++bj) {
                    f32x4 f1[2], f2[2], b1[2], b2[2];
#pragma unroll
                    for (int n = 0; n < 2; ++n)
#pragma unroll
                        for (int j = 0; j < 4; ++j) { const int il = 128 * bj + c0 + 4 * n + j; const float pos = (float)(n_ch * 256 + il); float c, s; cs_rev(pos * inv, c, s);
                            const float x1 = (float)acc[0][bj][m][n][j] * (sw1 * sxc[bj][n][j]), x2 = (float)acc[1][bj][m][n][j] * (sw2 * sxc[bj][n][j]); const float o1 = (x1 * c - x2 * s) * 0.0625f, o2 = (x2 * c + x1 * s) * 0.0625f;
                            const float wf = fexp(lgf * (float)(255 - il)), wb = fexp(lgb * (float)(il + 1));
                            f1[n][j] = o1 * wf; f2[n][j] = o2 * wf; b1[n][j] = o1 * wb; b2[n][j] = o2 * wb; }
                    const size_t tcol = (size_t)n_ch * 256 + 128 * bj + c0;
                    bf16* pf = kTw + ((size_t)(h * HD + d)) * T + tcol; bf16* pb = pf + (size_t)RW * T;
                    *(GAS v4u*)pf = pack8(f1[0], f1[1]); *(GAS v4u*)(pf + (size_t)128 * T) = pack8(f2[0], f2[1]);
                    *(GAS v4u*)pb = pack8(b1[0], b1[1]); *(GAS v4u*)(pb + (size_t)128 * T) = pack8(b2[0], b2[1]);
                }
            }
        } else {
            const int h = pm - 4;
#pragma unroll
            EPI_LOOP_AM { const int dv = 128 * ai + 64 * wr + 16 * m + fr; const float swr = swin[u.p2 + dv];
#pragma unroll
                for (int bj = 0; bj < 2; ++bj) { f32x4 v0, v1;
#pragma unroll
                    for (int j = 0; j < 4; ++j) { v0[j] = (float)acc[ai][bj][m][0][j] * (swr * sxc[bj][0][j]); v1[j] = (float)acc[ai][bj][m][1][j] * (swr * sxc[bj][1][j]); }
                    *(GAS v4u*)(Bcat + ((size_t)(h * NCH + n_ch) * 256 + dv) * CAT + 128 * bj + c0) = pack8(v0, v1); } }
        }
    }
};
struct EpiS1 {
    static constexpr bool PERM = true;
    bf16* A1;
    __device__ __forceinline__ void operator()(Acc& acc, const Unit& u, LAS unsigned char*, int wr, int wc, int fr, int fq) const {
        const int b0 = wc * 32 + 8 * fq;
#pragma unroll
        for (int m = 0; m < 4; ++m) { const int k1 = 64 * wr + 16 * m + fr;
#pragma unroll
            for (int bj = 0; bj < 2; ++bj) { const int cch = 2 * u.p1 + bj; f32x4 re[2], im[2];
#pragma unroll
                for (int n = 0; n < 2; ++n)
#pragma unroll
                    for (int j = 0; j < 4; ++j) { const int b = b0 + 4 * n + j; float c, s; cs_rev((float)(k1 * b) * (1.f / 16384.f), c, s);
                        const float xr = acc[0][bj][m][n][j], xi = acc[1][bj][m][n][j]; re[n][j] = xr * c + xi * s; im[n][j] = xi * c - xr * s; }
                bf16* p = A1 + (((size_t)k1 * 1024 + cch) * 2) * 128 + b0;
                *(GAS v4u*)p = pack8(re[0], re[1]); *(GAS v4u*)(p + 128) = pack8(im[0], im[1]); EPI_FENCE; } }
    }
};
struct EpiS2 {
    static constexpr bool PERM = true;
    bf16* Zt;
    __device__ __forceinline__ void operator()(Acc& acc, const Unit& u, LAS unsigned char*, int wr, int wc, int fr, int fq) const {
        const int k1 = u.p1 >> 2, cb = (u.p1 & 3) * 256, c0 = wc * 32 + 8 * fq;
#pragma unroll
        EPI_LOOP_AM { const int k2 = 64 * wr + 16 * m + fr, k = k1 + 128 * k2;
#pragma unroll
            for (int bj = 0; bj < 2; ++bj) { const int cch = cb + 128 * bj + c0, g = cch >> 7, cg = cch & 127;
                *(GAS v4u*)(Zt + (size_t)k * 2048 + g * 256 + ai * 128 + cg) = pack8(acc[ai][bj][m][0], acc[ai][bj][m][1]); } }
    }
};
struct EpiChan {
    static constexpr bool PERM = true;
    bf16* y;
    __device__ __forceinline__ void operator()(Acc& acc, const Unit& u, LAS unsigned char*, int wr, int wc, int fr, int fq) const {
        const int l0 = wc * 32 + 8 * fq; const float norm = 6.9053396600248786e-4f;
#pragma unroll
        EPI_LOOP_AM { const int R = u.p0 * 256 + 128 * ai + 64 * wr + 16 * m + fr, k = R >> 3, g = R & 7;
            *(GAS v4u*)(y + (size_t)k * D + g * 128 + l0) = pack8(acc[ai][0][m][0] * norm, acc[ai][0][m][1] * norm); }
    }
};
struct EpiScores {
    static constexpr bool PERM = true;
    bf16* Acat; const float *dec_f, *dec_b;
    __device__ __forceinline__ void operator()(Acc& acc, const Unit& u, LAS unsigned char*, int wr, int wc, int fr, int fq) const {
        const int h = u.p0, n_ch = u.p1, c0 = wc * 32 + 8 * fq; const float lgf = -fexp(dec_f[h]), lgb = -fexp(dec_b[h]);
#pragma unroll
        EPI_LOOP_AM { const int i = 128 * ai + 64 * wr + 16 * m + fr;
#pragma unroll
            for (int bj = 0; bj < 2; ++bj) { f32x4 v[2];
#pragma unroll
                for (int n = 0; n < 2; ++n)
#pragma unroll
                    for (int j = 0; j < 4; ++j) { const int jc = 128 * bj + c0 + 4 * n + j; const float dd = (float)(i - jc); const float w = (jc <= i) ? fexp(lgf * dd) : fexp(-lgb * dd); v[n][j] = acc[ai][bj][m][n][j] * w; }
                *(GAS v4u*)(Acat + ((size_t)h * T + n_ch * 256 + i) * CAT + 128 * bj + c0) = pack8(v[0], v[1]); EPI_FENCE; } }
    }
};
struct EpiKV {
    static constexpr bool PERM = true;
    bf16* kvT;
    __device__ __forceinline__ void operator()(Acc& acc, const Unit& u, LAS unsigned char*, int wr, int wc, int fr, int fq) const {
#pragma unroll
        EPI_LOOP_AM { const int dv = 128 * ai + 64 * wr + 16 * m + fr; bf16* rowp = kvT + (((size_t)u.p0 * NCH + u.p1) * 256 + dv) * 256 + wc * 32 + 8 * fq;
#pragma unroll
            for (int bj = 0; bj < 2; ++bj) *(GAS v4u*)(rowp + bj * 128) = pack8(acc[ai][bj][m][0], acc[ai][bj][m][1]); }
    }
};
struct EpiOut {
    static constexpr bool PERM = true;
    bf16* y; const bf16* gs; const float* gn_g;
    __device__ __forceinline__ void operator()(Acc& acc, const Unit& u, LAS unsigned char* lds, int wr, int wc, int fr, int fq) const {
        const int h = u.p0, n_ch = u.p1, c0 = wc * 32 + 8 * fq;
        LAS f32x2* P = (LAS f32x2*)(lds + LDS_STAGE);
#pragma unroll
        EPI_LOOP_AM {
            float s = 0.f;
#pragma unroll
            for (int bj = 0; bj < 2; ++bj)
#pragma unroll
                for (int n = 0; n < 2; ++n) { const f32x4 x = acc[ai][bj][m][n]; s += (x[0] + x[1]) + (x[2] + x[3]); }
            s += __shfl_xor(s, 16); s += __shfl_xor(s, 32);
            const float mw = s * (1.f / 64.f); float q = 0.f;
#pragma unroll
            for (int bj = 0; bj < 2; ++bj)
#pragma unroll
                for (int n = 0; n < 2; ++n) { const f32x4 d = acc[ai][bj][m][n] - mw; q += (d[0] * d[0] + d[1] * d[1]) + (d[2] * d[2] + d[3] * d[3]); }
            q += __shfl_xor(q, 16); q += __shfl_xor(q, 32);
            if (fq == 0) P[(128 * ai + 64 * wr + 16 * m + fr) * 4 + wc] = (f32x2){mw, q};
        }
        LDS_WAIT(); __builtin_amdgcn_s_barrier(); asm volatile("" ::: "memory");
#pragma unroll
        EPI_LOOP_AM {
            const int r = 128 * ai + 64 * wr + 16 * m + fr, tok = n_ch * 256 + r;
            const f32x2 a = P[r * 4 + 0], b = P[r * 4 + 1], c = P[r * 4 + 2], d = P[r * 4 + 3];
            const float mt = (a.x + b.x + c.x + d.x) * 0.25f; const float da = a.x - mt, db = b.x - mt, dc = c.x - mt, dd = d.x - mt;
            const float m2 = (a.y + b.y) + (c.y + d.y) + 64.f * ((da * da + db * db) + (dc * dc + dd * dd));
            const float rstd = 1.f / sqrtf(m2 * (1.f / 256.f) + GN_EPS);
#pragma unroll
            for (int bj = 0; bj < 2; ++bj) {
                const int col = h * HD + 128 * bj + c0; const v4u gv = *(const GAS v4u*)(gs + (size_t)tok * RW + col);
                const f32x4 g0 = *(const GAS f32x4*)(gn_g + col), g1 = *(const GAS f32x4*)(gn_g + col + 4);
                f32x4 o0 = (acc[ai][bj][m][0] - mt) * rstd * g0, o1 = (acc[ai][bj][m][1] - mt) * rstd * g1;
                o0[0] *= bf_lo(gv.x); o0[1] *= bf_hi(gv.x); o0[2] *= bf_lo(gv.y); o0[3] *= bf_hi(gv.y); o1[0] *= bf_lo(gv.z); o1[1] *= bf_hi(gv.z); o1[2] *= bf_lo(gv.w); o1[3] *= bf_hi(gv.w);
                *(GAS v4u*)(y + (size_t)tok * D + FW + col) = pack8(o0, o1); }
        }
        LDS_WAIT(); __builtin_amdgcn_s_barrier(); asm volatile("" ::: "memory");
    }
};
struct EpiWout {
    static constexpr bool PERM = true;
    bf16* z1; const float *x, *st0, *g0, *b0;
    __device__ __forceinline__ void operator()(Acc& acc, const Unit& u, LAS unsigned char*, int wr, int wc, int fr, int fq) const {
        const int colb = u.p1 * 256 + wc * 32 + 8 * fq;
#pragma unroll
        for (int bj = 0; bj < 2; ++bj) { const int col = colb + bj * 128;
            const f32x4 ga = *(const GAS f32x4*)(g0 + col), gb = *(const GAS f32x4*)(g0 + col + 4), ba = *(const GAS f32x4*)(b0 + col), bb = *(const GAS f32x4*)(b0 + col + 4);
#pragma unroll
            EPI_LOOP_AM { const int row = u.p0 * 256 + 128 * ai + 64 * wr + 16 * m + fr; const f32x2 st = *(const GAS f32x2*)(st0 + 2 * row); const size_t off = (size_t)row * D + col;
                const f32x4 xa = *(const GAS f32x4*)(x + off), xb = *(const GAS f32x4*)(x + off + 4);
                *(GAS v4u*)(z1 + off) = pack8(((xa - st.x) * st.y * ga + ba) * ALPHA + acc[ai][bj][m][0], ((xb - st.x) * st.y * gb + bb) * ALPHA + acc[ai][bj][m][1]); } }
    }
};
struct EpiUp {
    static constexpr bool PERM = true;
    bf16* act; unsigned* rmax;
    __device__ __forceinline__ void operator()(AccI& acc, const Unit& u, LAS unsigned char* lds, int wr, int wc, int fr, int fq) const {
        const int rt = u.p0, pn = u.p1, c0 = pn * 128 + wc * 32 + 8 * fq;
        const LAS float* blk = (const LAS float*)(lds + LDS_STAGE + u.q * 4096);
        float sx[2][4], rm[2][4];
#pragma unroll
        EPI_LOOP_AM { sx[ai][m] = blk[256 + 128 * ai + 64 * wr + 16 * m + fr]; rm[ai][m] = 0.f; }
#pragma unroll
        for (int n = 0; n < 2; ++n) {
            const int cc = wc * 32 + 8 * fq + 4 * n;
            const f32x4 sg = *(const LAS f32x4*)(blk + 512 + cc), sl = *(const LAS f32x4*)(blk + 512 + 128 + cc), bg = *(const LAS f32x4*)(blk + 768 + cc), bl = *(const LAS f32x4*)(blk + 768 + 128 + cc);
#pragma unroll
            EPI_LOOP_AM { const int r = 128 * ai + 64 * wr + 16 * m + fr; f32x4 v;
#pragma unroll
                for (int j = 0; j < 4; ++j) { float gl = (float)acc[ai][0][m][n][j] * (sx[ai][m] * sg[j]) + bg[j], li = (float)acc[ai][1][m][n][j] * (sx[ai][m] * sl[j]) + bl[j];
                    gl = fminf(gl, 7.f); li = fminf(fmaxf(li, -7.f), 7.f); v[j] = gl * __builtin_amdgcn_rcpf(1.f + fexp(-1.702f * gl)) * (li + 1.f); }
                rm[ai][m] = fmaxf(rm[ai][m], fmaxf(fmaxf(fabsf(v[0]), fabsf(v[1])), fmaxf(fabsf(v[2]), fabsf(v[3]))));
                v2u w; w.x = cvt_pk_bf16(v[0], v[1]); w.y = cvt_pk_bf16(v[2], v[3]);
                *(GAS v2u*)(act + ((size_t)rt * 256 + r) * DFF + c0 + 4 * n) = w; }
        }
#pragma unroll
        EPI_LOOP_AM { float q = rm[ai][m]; q = fmaxf(q, __shfl_xor(q, 16)); q = fmaxf(q, __shfl_xor(q, 32));
            if (fq == 0) __hip_atomic_fetch_max(rmax + rt * 256 + 128 * ai + 64 * wr + 16 * m + fr, __float_as_uint(q), RLX_AGENT); }
    }
};
struct EpiDown {
    static constexpr bool PERM = true;
    bf16* yr;
    __device__ __forceinline__ void operator()(AccI& acc, const Unit& u, LAS unsigned char* lds, int wr, int wc, int fr, int fq) const {
        const int rt = u.p0, pn = u.p1, c0 = pn * 256 + wc * 32 + 8 * fq;
        const LAS float* blk = (const LAS float*)(lds + LDS_STAGE + u.q * 4096);
        float sr[2][4];
#pragma unroll
        EPI_LOOP_AM sr[ai][m] = blk[128 * ai + 64 * wr + 16 * m + fr];
#pragma unroll
        for (int bj = 0; bj < 2; ++bj) { const int cc = 128 * bj + wc * 32 + 8 * fq;
            const f32x4 w0 = *(const LAS f32x4*)(blk + 256 + cc), w1 = *(const LAS f32x4*)(blk + 256 + cc + 4), b0 = *(const LAS f32x4*)(blk + 512 + cc), b1 = *(const LAS f32x4*)(blk + 512 + cc + 4);
#pragma unroll
            EPI_LOOP_AM { const int r = 128 * ai + 64 * wr + 16 * m + fr; f32x4 o0, o1;
#pragma unroll
                for (int j = 0; j < 4; ++j) { o0[j] = (float)acc[ai][bj][m][0][j] * (sr[ai][m] * w0[j]) + b0[j]; o1[j] = (float)acc[ai][bj][m][1][j] * (sr[ai][m] * w1[j]) + b1[j]; }
                *(GAS v4u*)(yr + ((size_t)rt * 256 + r) * D + c0 + 128 * bj) = pack8(o0, o1); } }
    }
};

__device__ __forceinline__ void p3_scan(Frame& F) {
    const bf16* kvT = WSP(bf16, WS_KVT); bf16* Bcat = WSP(bf16, WS_BCAT);
    const int NQ = 2 * NH * 256 * 64;
    for (int q = F.vcu * NTHR + F.tid; q < NQ; q += F.G * NTHR) {
        const int dk4 = q & 63, dv = (q >> 6) & 255, dh = q >> 14, dir = dh >> 2, h = dh & 3;
        const float lg = -fexp((dir ? F.dec_b : F.dec_f)[h]); const float cd = fexp(lg * (float)C2);
        f32x4 S = (f32x4){0.f, 0.f, 0.f, 0.f};
        for (int s = 0; s < NCH; ++s) { const int n = dir ? (NCH - 1 - s) : s;
            const v2u kw = *(const GAS v2u*)(kvT + (((size_t)dh * NCH + n) * 256 + dv) * 256 + dk4 * 4); const f32x4 kv = (f32x4){bf_lo(kw.x), bf_hi(kw.x), bf_lo(kw.y), bf_hi(kw.y)};
            v2u w; w.x = cvt_pk_bf16(S[0], S[1]); w.y = cvt_pk_bf16(S[2], S[3]);
            *(GAS v2u*)(Bcat + ((size_t)(h * NCH + n) * 256 + dv) * CAT + 256 + dir * 256 + dk4 * 4) = w;
            S = S * cd + kv; }
    }
}

__device__ __forceinline__ void p6_router(Frame& F) {
    const bf16* z1 = WSP(bf16, WS_Z1); unsigned* h1q = WSP(unsigned, WS_H1Q); float* sxg = WSP(float, WS_SX); float* rsc = WSP(float, WS_RSC); float* st1 = WSP(float, WS_ST0) + 2 * T;
    int* topi = WSP(int, WS_RT); float* gate = (float*)(topi + 4 * T); int* posb = (int*)(gate + 4 * T); int* row_tok = posb + 4 * T;
    LAS float* hc = (LAS float*)F.lds;
    LAS float* wrc = hc + 64 * 257;
    LAS float* stl = wrc + 256 * 32;
    LAS float* lg = stl + 128;
    LAS int* hist = (LAS int*)(lg + 64 * 33);
    LAS float* sxl = (LAS float*)(hist + 64);
    for (int blk = F.vcu; blk < T / 64; blk += F.G) {
        const int t0 = blk * 64;
#pragma unroll 1
        for (int bt = 0; bt < 2; ++bt) {
            v2u raw[4][8];
#pragma unroll
            for (int rr = 0; rr < 4; ++rr) { const GAS v2u* xr = (const GAS v2u*)(z1 + (size_t)(t0 + F.wave * 8 + bt * 4 + rr) * D) + F.lane;
#pragma unroll
                for (int j = 0; j < 8; ++j) raw[rr][j] = xr[64 * j]; }
#pragma unroll
            for (int rr = 0; rr < 4; ++rr) { const int row = F.wave * 8 + bt * 4 + rr, m = t0 + row;
                f32x4 v[8]; float s = 0.f;
#pragma unroll
                for (int j = 0; j < 8; ++j) { const v2u w = raw[rr][j]; v[j] = (f32x4){bf_lo(w.x), bf_hi(w.x), bf_lo(w.y), bf_hi(w.y)}; s += (v[j][0] + v[j][1]) + (v[j][2] + v[j][3]); }
                const float mean = wave_sum(s) * (1.f / D); float s2 = 0.f;
#pragma unroll
                for (int j = 0; j < 8; ++j) { v[j] = v[j] - mean; s2 += (v[j][0] * v[j][0] + v[j][1] * v[j][1]) + (v[j][2] * v[j][2] + v[j][3] * v[j][3]); }
                const float rstd = 1.f / sqrtf(wave_sum(s2) * (1.f / D) + LN_EPS);
                float am = 0.f;
#pragma unroll
                for (int j = 0; j < 8; ++j) { const f32x4 g = *((const GAS f32x4*)F.ln1_g + F.lane + 64 * j), b = *((const GAS f32x4*)F.ln1_b + F.lane + 64 * j);
                    v[j] = v[j] * rstd * g + b; am = fmaxf(am, fmaxf(fmaxf(fabsf(v[j][0]), fabsf(v[j][1])), fmaxf(fabsf(v[j][2]), fabsf(v[j][3])))); }
#pragma unroll
                for (int o = 1; o < 64; o <<= 1) am = fmaxf(am, __shfl_xor(am, o));
                const float sc = am > 0.f ? am * (1.f / 127.f) : 1.f, inv = 1.f / sc;
#pragma unroll
                for (int j = 0; j < 8; ++j) { const int q0 = (int)__builtin_rintf(v[j][0] * inv), q1 = (int)__builtin_rintf(v[j][1] * inv), q2 = (int)__builtin_rintf(v[j][2] * inv), q3 = (int)__builtin_rintf(v[j][3] * inv);
                    h1q[(size_t)m * (D / 4) + F.lane + 64 * j] = (unsigned)(q0 & 0xff) | ((unsigned)(q1 & 0xff) << 8) | ((unsigned)(q2 & 0xff) << 16) | ((unsigned)(q3 & 0xff) << 24); }
                if (F.lane == 0) { st1[2 * m] = mean; st1[2 * m + 1] = rstd; stl[2 * row] = mean; stl[2 * row + 1] = rstd; sxg[m] = sc; sxl[row] = sc; }
            }
        }
        if (F.tid < 64) hist[F.tid] = 0;
        __syncthreads();
        const int row = F.tid >> 3, e0 = (F.tid & 7) * 4; f32x4 accl = (f32x4){0.f, 0.f, 0.f, 0.f};
        v2u zp[8]; f32x4 wp[4];
#define P6_LOAD(kc_) do { _Pragma("unroll") for (int i_ = 0; i_ < 8; ++i_) { const int q_ = F.tid + NTHR * i_, r_ = q_ >> 6, c4_ = (q_ & 63) * 4; zp[i_] = *(const GAS v2u*)(z1 + (size_t)(t0 + r_) * D + (kc_) * 256 + c4_); } \
        _Pragma("unroll") for (int i_ = 0; i_ < 4; ++i_) { const int q_ = F.tid + NTHR * i_, k_ = q_ >> 3, c4_ = (q_ & 7) * 4; wp[i_] = *(const GAS f32x4*)(F.w_r + (size_t)((kc_) * 256 + k_) * NE + c4_); } } while (0)
        P6_LOAD(0);
        for (int kc = 0; kc < 8; ++kc) {
#pragma unroll
            for (int i = 0; i < 8; ++i) { const int q = F.tid + NTHR * i, r = q >> 6, c4 = (q & 63) * 4, col = kc * 256 + c4; const v2u zw = zp[i];
                const f32x4 zv = (f32x4){bf_lo(zw.x), bf_hi(zw.x), bf_lo(zw.y), bf_hi(zw.y)}, g = *(const GAS f32x4*)(F.ln1_g + col), b = *(const GAS f32x4*)(F.ln1_b + col);
                const f32x4 hh = (zv - stl[2 * r]) * stl[2 * r + 1] * g + b; LAS float* d = hc + r * 257 + c4; d[0] = hh[0]; d[1] = hh[1]; d[2] = hh[2]; d[3] = hh[3]; }
#pragma unroll
            for (int i = 0; i < 4; ++i) { const int q = F.tid + NTHR * i, k = q >> 3, c4 = (q & 7) * 4; *(LAS f32x4*)(wrc + k * 32 + c4) = wp[i]; }
            __syncthreads();
            if (kc + 1 < 8) P6_LOAD(kc + 1);
#pragma unroll 8
            for (int k = 0; k < 256; ++k) { const float hv = hc[row * 257 + k]; const f32x4 w = *(const LAS f32x4*)(wrc + k * 32 + e0); accl = accl + w * hv; }
            __syncthreads();
        }
#undef P6_LOAD
        { const f32x4 br = *(const GAS f32x4*)(F.b_r + e0); LAS float* d = lg + row * 33 + e0; d[0] = accl[0] + br[0]; d[1] = accl[1] + br[1]; d[2] = accl[2] + br[2]; d[3] = accl[3] + br[3]; }
        __syncthreads();
        int ek[4] = {0, 0, 0, 0}, lp[4] = {0, 0, 0, 0}; float gk[4] = {0.f, 0.f, 0.f, 0.f};
        if (F.tid < 64) {
            float lv[4]; unsigned used = 0u;
#pragma unroll
            for (int k = 0; k < 4; ++k) { float best = -3.0e38f; int bi = 0;
                for (int e = 0; e < NE; ++e) { const float v = lg[F.tid * 33 + e]; const bool ok = !((used >> e) & 1u) && (v > best); best = ok ? v : best; bi = ok ? e : bi; }
                used |= 1u << bi; ek[k] = bi; lv[k] = best; }
            const float mx = lv[0]; float den = 0.f;
#pragma unroll
            for (int k = 0; k < 4; ++k) { gk[k] = fexp(lv[k] - mx); den += gk[k]; }
            const float rd = 1.f / den;
#pragma unroll
            for (int k = 0; k < 4; ++k) { gk[k] *= rd; lp[k] = __hip_atomic_fetch_add(&hist[ek[k]], 1, __ATOMIC_RELAXED, __HIP_MEMORY_SCOPE_WORKGROUP); }
        }
        __syncthreads();
        if (F.tid < NE) hist[32 + F.tid] = (int)__hip_atomic_fetch_add(F.ctl + CW_CNT + 64 * F.tid, (unsigned)hist[F.tid], RLX_AGENT);
        __syncthreads();
        if (F.tid < 64) { const int tok = t0 + F.tid;
#pragma unroll
            for (int k = 0; k < 4; ++k) { const int pos = hist[32 + ek[k]] + lp[k]; row_tok[(size_t)ek[k] * T + pos] = tok; rsc[(size_t)ek[k] * T + pos] = sxl[F.tid]; topi[4 * tok + k] = ek[k]; gate[4 * tok + k] = gk[k]; posb[4 * tok + k] = pos; } }
        __syncthreads();
    }
}

__device__ __forceinline__ void build_units(Frame& F, LAS int* tstart, int nN, int c) {
    __syncthreads();
    if (F.tid < 64) { const int RT = tstart[NE], L = F.tid * F.G + c; int w = -1;
        if (L < RT * nN) { int rt, pn; gm::tile_order(L, RT, nN, rt, pn); w = rt | (pn << 10) | (tstart[40 + rt] << 15); }
        tstart[400 + F.tid] = w; }
    __syncthreads();
}

__device__ __forceinline__ void p8_requant(Frame& F, const LAS int* tstart) {
    const bf16* act = WSP(bf16, WS_ACT); unsigned* aq = WSP(unsigned, WS_ACTQ); float* sa = WSP(float, WS_SA); const unsigned* rmax = F.ctl + CW_RMAX;
    const int R = tstart[NE] * 256, gw = F.vcu * NWAVES + F.wave, NGW = F.G * NWAVES;
    for (int row = gw; row < R; row += NGW) {
        const float mx = __uint_as_float(rmax[row]); const float sc = mx > 0.f ? mx * (1.f / 127.f) : 1.f, inv = 1.f / sc;
#pragma unroll
        for (int j = 0; j < 2; ++j) { const int col = 16 * F.lane + 1024 * j;
            const v4u a = *(const GAS v4u*)(act + (size_t)row * DFF + col), b = *(const GAS v4u*)(act + (size_t)row * DFF + col + 8);
            const unsigned src[8] = {a.x, a.y, a.z, a.w, b.x, b.y, b.z, b.w}; unsigned o[4];
#pragma unroll
            for (int d = 0; d < 4; ++d) { unsigned w = 0u;
#pragma unroll
                for (int h2 = 0; h2 < 2; ++h2) { const unsigned u2 = src[2 * d + h2]; int q0 = (int)__builtin_rintf(bf_lo(u2) * inv), q1 = (int)__builtin_rintf(bf_hi(u2) * inv);
                    q0 = q0 > 127 ? 127 : (q0 < -127 ? -127 : q0); q1 = q1 > 127 ? 127 : (q1 < -127 ? -127 : q1);
                    w |= ((unsigned)(q0 & 0xff) << (16 * h2)) | ((unsigned)(q1 & 0xff) << (16 * h2 + 8)); }
                o[d] = w; }
            *(GAS v4u*)(aq + ((size_t)row * DFF + col) / 4) = (v4u){o[0], o[1], o[2], o[3]}; }
        if (F.lane == 0) sa[row] = sc;
    }
}

__device__ __forceinline__ void build_tstart(Frame& F, LAS int* tstart) {
    if (F.tid == 0) { int s = 0; for (int e = 0; e < NE; ++e) { tstart[e] = s; const unsigned n = __hip_atomic_load(F.ctl + CW_CNT + 64 * e, RLX_AGENT); s += (int)((n + 255u) >> 8); } tstart[NE] = s; }
    __syncthreads();
    for (int rt = F.tid; rt < RT_MAX; rt += NTHR) { int e = 0; for (int j = 1; j < NE; ++j) e += (tstart[j] <= rt) ? 1 : 0; tstart[40 + rt] = e; }
    __syncthreads();
}

__device__ __forceinline__ void p9_combine(Frame& F, const LAS int* tstart) {
    const bf16* z1 = WSP(bf16, WS_Z1); const float* st1 = WSP(float, WS_ST0) + 2 * T; const bf16* yr = WSP(bf16, WS_YR);
    const int* topi = WSP(int, WS_RT); const float* gate = (const float*)(topi + 4 * T); const int* posb = (const int*)(gate + 4 * T);
    const int gw = F.vcu * NWAVES + F.wave, NGW = F.G * NWAVES;
    for (int m = gw; m < T; m += NGW) {
        const float mean1 = st1[2 * m], rstd1 = st1[2 * m + 1];
        size_t ro[4]; float gk[4];
#pragma unroll
        for (int k = 0; k < 4; ++k) { const int e = topi[4 * m + k]; ro[k] = ((size_t)tstart[e] * 256 + posb[4 * m + k]) * D; gk[k] = gate[4 * m + k]; }
        f32x4 v[8]; float s = 0.f;
#pragma unroll
        for (int j = 0; j < 8; ++j) { const int col = 4 * F.lane + 256 * j;
            const v2u zw = *(const GAS v2u*)(z1 + (size_t)m * D + col); const f32x4 zv = (f32x4){bf_lo(zw.x), bf_hi(zw.x), bf_lo(zw.y), bf_hi(zw.y)}, g = *(const GAS f32x4*)(F.ln1_g + col), b = *(const GAS f32x4*)(F.ln1_b + col);
            f32x4 a = ((zv - mean1) * rstd1 * g + b) * ALPHA;
#pragma unroll
            for (int k = 0; k < 4; ++k) { const v2u w = *(const GAS v2u*)(yr + ro[k] + col); a[0] += gk[k] * bf_lo(w.x); a[1] += gk[k] * bf_hi(w.x); a[2] += gk[k] * bf_lo(w.y); a[3] += gk[k] * bf_hi(w.y); }
            v[j] = a; s += (a[0] + a[1]) + (a[2] + a[3]); }
        const float mean = wave_sum(s) * (1.f / D); float s2 = 0.f;
#pragma unroll
        for (int j = 0; j < 8; ++j) { v[j] = v[j] - mean; s2 += (v[j][0] * v[j][0] + v[j][1] * v[j][1]) + (v[j][2] * v[j][2] + v[j][3] * v[j][3]); }
        const float rstd = 1.f / sqrtf(wave_sum(s2) * (1.f / D) + LN_EPS);
#pragma unroll
        for (int j = 0; j < 8; ++j) { const int col = 4 * F.lane + 256 * j; const f32x4 g = *(const GAS f32x4*)(F.ln2_g + col), b = *(const GAS f32x4*)(F.ln2_b + col);
            *(GAS f32x4*)(F.out + (size_t)m * D + col) = v[j] * rstd * g + b; }
    }
}

constexpr int NPH = 11;
__global__ void __launch_bounds__(NTHR, 2) fwd(Args args) {
    extern __shared__ __attribute__((aligned(16))) unsigned char lds_raw[];
    Frame F;
    F.lds = (LAS unsigned char*)lds_raw; F.ws = args.ws; F.ctl = (unsigned*)(args.ws + WS_CTL);
    F.tid = threadIdx.x; F.lane = F.tid & 63; F.wave = __builtin_amdgcn_readfirstlane(F.tid >> 6);
    F.G = gridDim.x; { const int bx = blockIdx.x; F.vcu = (F.G % 8 == 0) ? (bx % 8) * (F.G / 8) + bx / 8 : bx; }
    F.x = args.in[0]; F.ln0_g = args.in[1]; F.ln0_b = args.in[2]; F.w_in = args.in[3]; F.dec_f = args.in[4]; F.dec_b = args.in[5]; F.gn_g = args.in[6]; F.w_out = args.in[7];
    F.ln1_g = args.in[8]; F.ln1_b = args.in[9]; F.w_r = args.in[10]; F.b_r = args.in[11]; F.w_up = args.in[12]; F.b_up = args.in[13]; F.w_dn = args.in[14]; F.b_dn = args.in[15];
    F.ln2_g = args.in[16]; F.ln2_b = args.in[17]; F.out = args.out;
    volatile LAS unsigned* lctl = (volatile LAS unsigned*)(F.lds + LDS_CTL_OFF);
    LAS int* tstart = (LAS int*)(F.lds + LDS_CTL_OFF + 64);
    for (int u = F.tid; u < 128; u += NTHR) lctl[u] = 0u;
    __syncthreads();
    const int lo = args.ph_lo, hi = args.ph_hi;
    const bool single = (hi - lo) > 1;
    XcdBarrier bar; bar.bar = F.ctl + CW_BAR; bar.x = 0; bar.st = lctl;
    if (single) bar = xcd_barrier_post(F.ctl + CW_BAR, lctl);
#ifndef PH_MASK
#define PH_MASK 0x7ff
#endif
#define IN(k) (((PH_MASK >> (k)) & 1) && lo <= (k) && (k) < hi)
#ifndef SUB_MASK
#define SUB_MASK 0xff
#endif
#define SUB(n) ((SUB_MASK >> (n)) & 1)
#define SEAM(k) do { if (IN(k) && IN((k) + 1)) xcd_barrier(bar); } while (0)
    const int bc = (int)blockIdx.x;

    const int nS = (NE * 128 + F.G - 1) / F.G + (NE * 64 + F.G - 1) / F.G; int sdone = 0; const int qgrp = (int)(blockIdx.x >> 3);
#define QSLOT(k24) do { const int e_ = sdone + (nS * (k24) + 23) / 24; do_slabs(F, sdone, e_ < nS ? e_ : nS); sdone = e_; } while (0)
#define QG(slot, nslots, k24) do { if (qgrp % (nslots) == (slot)) QSLOT(k24); } while (0)
    if (IN(0)) { p0_prologue(F); __syncthreads(); { const int nW = (DIN / 32 + F.G - 1) / F.G; do_slabs(F, -nW, 0); } }
    SEAM(0);
    if (IN(1)) {
        QG(0, 4, 9);
        if (SUB(0)) { SchedG1N S; S.nt = D / 128; S.pitchA = D / 2; S.pitchB = D / 2; S.multA = 1; S.multB = 1; S.G = F.G; S.c = bc; S.A = (const char*)WSP(bf16, WS_H0B); S.Bt = (const char*)WSP(bf16, WS_WIN);
          EpiG1N E{WSP(bf16, WS_QS), WSP(bf16, WS_KK), WSP(bf16, WS_GS), WSP(bf16, WS_ACAT), F.dec_f, F.dec_b, WSP(float, WS_SX0), WSP(float, WS_SWIN)};
          gm::gemm_run<EpiG1N, SchedG1N, false, true>(F.lds, S, E); }
        QG(1, 4, 9);
        if (SUB(1)) { SchedG1SF S; S.nt = D / 128; S.pitchA = D / 2; S.pitchB = D / 2; S.multA = 1; S.multB = 128; S.G = F.G; S.c = bc; S.A = (const char*)WSP(bf16, WS_WIN); S.Bt = (const char*)WSP(bf16, WS_H0B);
          EpiG1SF E{WSP(bf16, WS_UTT), WSP(float, WS_SX0), WSP(float, WS_SWIN)};
          gm::gemm_run<EpiG1SF, SchedG1SF, false, true>(F.lds, S, E); }
        QG(2, 4, 9);
        if (SUB(2)) { SchedG1SKV S; S.nt = D / 128; S.pitchA = D / 2; S.pitchB = D / 2; S.multA = 1; S.multB = 1; S.G = F.G; S.c = bc; S.A = (const char*)WSP(bf16, WS_WIN); S.Bt = (const char*)WSP(bf16, WS_H0B);
          EpiG1SKV E{WSP(bf16, WS_KTW), WSP(bf16, WS_BCAT), F.dec_f, F.dec_b, WSP(float, WS_SX0), WSP(float, WS_SWIN)};
          gm::gemm_run<EpiG1SKV, SchedG1SKV, false, true>(F.lds, S, E); }
        QG(3, 4, 9);
    }
    SEAM(1);
    if (IN(2)) {
        QG(0, 4, 6);
        if (SUB(3)) { SchedFixA S; S.nt = 2; S.pitchA = 128; S.pitchB = 128; S.multA = 1; S.multB = 1; S.G = F.G; S.c = bc; S.A = (const char*)WSP(bf16, WS_TAB); S.Bt = (const char*)WSP(bf16, WS_UTT); S.ncol = 512;
          EpiS1 E{WSP(bf16, WS_A1)};
          gm::gemm_run<EpiS1, SchedFixA, false>(F.lds, S, E); }
        QG(1, 4, 6);
        if (SUB(4)) { SchedScores S; S.nt = 4; S.pitchA = RW; S.pitchB = RW; S.multA = 1; S.multB = 1; S.G = F.G; S.c = bc; S.Q = (const char*)WSP(bf16, WS_QS); S.Kk = (const char*)WSP(bf16, WS_KK);
          EpiScores E{WSP(bf16, WS_ACAT), F.dec_f, F.dec_b};
          gm::gemm_run<EpiScores, SchedScores, false>(F.lds, S, E); }
        QG(2, 4, 6);
        if (SUB(5)) { SchedKV S; S.nt = 4; S.pitchA = CAT; S.pitchB = T; S.multA = 1; S.multB = 1; S.G = F.G; S.c = bc; S.Bcat = (const char*)WSP(bf16, WS_BCAT); S.kTw = (const char*)WSP(bf16, WS_KTW);
          EpiKV E{WSP(bf16, WS_KVT)};
          gm::gemm_run<EpiKV, SchedKV, false>(F.lds, S, E); }
        QG(3, 4, 6);
    }
    SEAM(2);
    if (IN(3)) {
        QG(0, 3, 2);
        { SchedFixA S; S.nt = 4; S.pitchA = 256; S.pitchB = 256; S.multA = 1; S.multB = 1; S.G = F.G; S.c = bc; S.A = (const char*)(WSP(bf16, WS_TAB) + 32768); S.Bt = (const char*)WSP(bf16, WS_A1); S.ncol = 512;
          EpiS2 E{WSP(bf16, WS_ZT)};
          gm::gemm_run<EpiS2, SchedFixA, false>(F.lds, S, E); }
        QG(1, 3, 2);
        p3_scan(F);
        QG(2, 3, 2);
    }
    SEAM(3);
    if (IN(4)) {
        QG(0, 3, 4);
        { SchedFixB S; S.nt = 4; S.pitchA = 256; S.pitchB = 256; S.multA = 1; S.multB = 1; S.G = F.G; S.c = bc; S.A = (const char*)WSP(bf16, WS_ZT); S.Bt = (const char*)(WSP(bf16, WS_TAB) + 32768 + 65536); S.nrow = 512;
          EpiChan E{WSP(bf16, WS_Y)};
          gm::gemm_run<EpiChan, SchedFixB, false>(F.lds, S, E); }
        QG(1, 3, 4);
        { SchedOut S; S.nt = CAT / 64; S.pitchA = CAT; S.pitchB = CAT; S.multA = 1; S.multB = 1; S.G = F.G; S.c = bc; S.Acat = (const char*)WSP(bf16, WS_ACAT); S.Bcat = (const char*)WSP(bf16, WS_BCAT);
          EpiOut E{WSP(bf16, WS_Y), WSP(bf16, WS_GS), F.gn_g};
          gm::gemm_run<EpiOut, SchedOut, false>(F.lds, S, E); }
        QG(2, 3, 4);

    }
    SEAM(4);
    if (IN(5)) {
        QG(0, 2, 3);
        Sched2D S; S.nt = D / 64; S.pitchA = D; S.pitchB = D; S.multA = 1; S.multB = 1; S.G = F.G; S.c = bc; S.A = (const char*)WSP(bf16, WS_Y); S.Bt = (const char*)WSP(bf16, WS_WOUT); S.nM = 64; S.nN = 8;
        EpiWout E{WSP(bf16, WS_Z1), F.x, WSP(float, WS_ST0), F.ln0_g, F.ln0_b};
        gm::gemm_run<EpiWout, Sched2D, false>(F.lds, S, E);
        QG(1, 2, 3);
        do_slabs(F, sdone < nS ? sdone : nS, nS);
    }
    SEAM(5);
    if (IN(6)) { p6_router(F); }
    SEAM(6);
    if (IN(7) || IN(8) || IN(9) || IN(10)) build_tstart(F, tstart);
    if (IN(7)) {
        build_units(F, tstart, 16, bc);
        SchedMoEUpT S; S.nt = D / 128; S.pitchA = D / 2; S.pitchB = D / 2; S.multA = 1; S.multB = 1; S.G = F.G; S.c = bc; S.A = (const char*)WSP(char, WS_H1Q); S.Bt = (const char*)WSP(char, WS_WUP);
        S.tstart = tstart; S.row_tok = WSP(int, WS_RT) + 12 * T; S.cnt = F.ctl + CW_CNT; S.nN = 16; S.rowbytes = D; S.estride = (size_t)2 * DFF * D;
        S.rsc = WSP(float, WS_RSC); S.swup = WSP(float, WS_SWUP); S.b_up = F.b_up;
        EpiUp E{WSP(bf16, WS_ACT), F.ctl + CW_RMAX};
        gm::gemm_run<EpiUp, SchedMoEUpT, true, true, true>(F.lds, S, E);
    }
    SEAM(7);
    if (IN(8)) { p8_requant(F, tstart); }
    SEAM(8);
    if (IN(9)) {
        build_units(F, tstart, 8, bc);
        SchedMoEDown S; S.nt = DFF / 128; S.pitchA = DFF / 2; S.pitchB = DFF / 2; S.multA = 1; S.multB = 1; S.G = F.G; S.c = bc; S.A = (const char*)WSP(char, WS_ACTQ); S.Bt = (const char*)WSP(char, WS_WDN);
        S.tstart = tstart; S.row_tok = nullptr; S.cnt = F.ctl + CW_CNT; S.nN = 8; S.rowbytes = DFF; S.estride = (size_t)D * DFF;
        S.sa = WSP(float, WS_SA); S.swdn = WSP(float, WS_SWDN); S.b_dn = F.b_dn; S.rsc = nullptr; S.swup = nullptr; S.b_up = nullptr;
        EpiDown E{WSP(bf16, WS_YR)};
        gm::gemm_run<EpiDown, SchedMoEDown, false, true, true>(F.lds, S, E);
    }
    SEAM(9);
    if (IN(10)) { p9_combine(F, tstart); }
#undef IN
#undef SEAM
}

#ifndef MK_SPLIT
#define MK_SPLIT 0
#endif
extern "C" void kernel_launch(void* const* d_in, const int* in_sizes, int n_in, void* d_out, int out_size, void* d_ws, size_t ws_size, hipStream_t stream) {
    static int grid = 0;
    if (grid == 0) {
        if (n_in != 18 || out_size != T * D || ws_size < WS_END2) { fprintf(stderr, "kernel_launch: unexpected problem: n_in %d out %d ws %zu (need %zu)\n", n_in, out_size, ws_size, (size_t)WS_END2); grid = -1; return; }
        int dev = 0, cus = 0, per_cu = 0;
        if (hipGetDevice(&dev) != hipSuccess || hipDeviceGetAttribute(&cus, hipDeviceAttributeMultiprocessorCount, dev) != hipSuccess) { grid = -1; return; }
        if (hipFuncSetAttribute((const void*)fwd, hipFuncAttributeMaxDynamicSharedMemorySize, LDS_BYTES) != hipSuccess) { fprintf(stderr, "kernel_launch: hipFuncSetAttribute failed\n"); grid = -1; return; }
        if (hipOccupancyMaxActiveBlocksPerMultiprocessor(&per_cu, (const void*)fwd, NTHR, LDS_BYTES) != hipSuccess || per_cu < 1) { fprintf(stderr, "kernel_launch: occupancy query reports %d\n", per_cu); }
        (void)hipGetLastError();
        grid = cus;
    }
    if (grid < 0) return;
    (void)hipMemsetAsync((char*)d_ws + WS_CTL, 0, CTL_BYTES, stream);
    Args a{};
    for (int i = 0; i < 18; ++i) a.in[i] = (const float*)d_in[i];
    a.out = (float*)d_out; a.ws = (unsigned char*)d_ws;
#if MK_SPLIT
    for (int p = 0; p < NPH; ++p) { a.ph_lo = p; a.ph_hi = p + 1; hipLaunchKernelGGL(fwd, dim3(grid), dim3(NTHR), LDS_BYTES, stream, a); }
#else
    a.ph_lo = 0; a.ph_hi = NPH; hipLaunchKernelGGL(fwd, dim3(grid), dim3(NTHR), LDS_BYTES, stream, a);
#endif
}
```

```cpp
#include <hip/hip_runtime.h>
#include <cstdio>
#include <cstdint>

#define GAS __attribute__((address_space(1)))
#define LAS __attribute__((address_space(3)))
typedef unsigned short bf16;
typedef unsigned v4u __attribute__((ext_vector_type(4)));
typedef unsigned v2u __attribute__((ext_vector_type(2)));
typedef float f32x4 __attribute__((ext_vector_type(4)));
typedef float f32x2 __attribute__((ext_vector_type(2)));
typedef short bf16x8 __attribute__((ext_vector_type(8)));
typedef int i32x4 __attribute__((ext_vector_type(4)));
#define RLX_AGENT __ATOMIC_RELAXED, __HIP_MEMORY_SCOPE_AGENT
#define LDS_WAIT() asm volatile("s_waitcnt lgkmcnt(0)" ::: "memory")
#define VM_WAIT() asm volatile("s_waitcnt vmcnt(0)" ::: "memory")

constexpr int T = 16384, D = 2048, DIN = 5120, FW = 1024, RW = 1024, NH = 4, HD = 256, NE = 32, TOPK = 4, DFF = 2048;
constexpr int C2 = 256, NCH = T / C2;
constexpr int CAT = 768;
constexpr float LN_EPS = 1e-5f, GN_EPS = 1e-6f, ALPHA = 1.189207115002721f;
constexpr int RT_MAX = (T * TOPK) / 256 + NE;
constexpr int NWAVES = 8, NTHR = 512;

constexpr size_t MiB = 1u << 20;
constexpr size_t WS_CTL = 0, CTL_BYTES = 1 * MiB;
constexpr size_t WS_TAB = 1 * MiB;
constexpr size_t WS_WIN = 2 * MiB;
constexpr size_t WS_WOUT = WS_WIN + 20 * MiB;
constexpr size_t WS_WUP = WS_WOUT + 8 * MiB;
constexpr size_t WS_WDN = WS_WUP + 512 * MiB;
constexpr size_t WS_H0B = WS_WDN + 256 * MiB;
constexpr size_t WS_ST0 = WS_H0B + 64 * MiB;
constexpr size_t WS_UTT = WS_ST0 + 1 * MiB;
constexpr size_t WS_A1 = WS_UTT + 32 * MiB;
constexpr size_t WS_ZT = WS_A1 + 64 * MiB;
constexpr size_t WS_QS = WS_ZT + 64 * MiB;
constexpr size_t WS_KK = WS_QS + 32 * MiB;
constexpr size_t WS_GS = WS_KK + 32 * MiB;
constexpr size_t WS_ACAT = WS_GS + 32 * MiB;
constexpr size_t WS_BCAT = WS_ACAT + 96 * MiB;
constexpr size_t WS_KTW = WS_BCAT + 96 * MiB;
constexpr size_t WS_KVT = WS_KTW + 64 * MiB;
constexpr size_t WS_Y = WS_KVT + 128 * MiB;
constexpr size_t WS_Z1 = WS_Y + 64 * MiB;
constexpr size_t WS_H1B = WS_Z1 + 128 * MiB;
constexpr size_t WS_RT = WS_H1B + 64 * MiB;
constexpr size_t WS_ACT = WS_RT + 4 * MiB;
constexpr size_t WS_YR = WS_ACT + 288 * MiB;
constexpr size_t WS_END = WS_YR + 288 * MiB;
constexpr size_t WS_SWUP = WS_TAB + 512 * 1024;
constexpr size_t WS_H1Q = WS_H1B;
constexpr size_t WS_SX = WS_H1B + 32 * MiB, WS_RSC = WS_H1B + 40 * MiB, WS_SA = WS_H1B + 44 * MiB;
constexpr size_t WS_SWDN = WS_ST0 + 512 * 1024;
constexpr size_t WS_SWIN = WS_ST0 + 768 * 1024;
constexpr size_t WS_SX0 = WS_H0B + 40 * MiB;
constexpr size_t WS_ACTQ = WS_END;
constexpr size_t WS_END2 = WS_ACTQ + 144 * MiB;
constexpr int CW_RMAX = 16384;
constexpr int CW_BAR = 1024;
constexpr int CW_CNT = 8192;

constexpr int LDS_STAGE = 131072, LDS_SCR = 16384, LDS_CTL_OFF = LDS_STAGE + LDS_SCR, LDS_BYTES = LDS_CTL_OFF + 2048;

__device__ __forceinline__ unsigned cvt_pk_bf16(float lo, float hi) { unsigned r; asm volatile("v_cvt_pk_bf16_f32 %0, %1, %2" : "=v"(r) : "v"(lo), "v"(hi)); return r; }
__device__ __forceinline__ float bf_lo(unsigned u) { return __builtin_bit_cast(float, u << 16); }
__device__ __forceinline__ float bf_hi(unsigned u) { return __builtin_bit_cast(float, u & 0xffff0000u); }
__device__ __forceinline__ v4u pack8(const f32x4 a, const f32x4 b) { v4u w; w.x = cvt_pk_bf16(a[0], a[1]); w.y = cvt_pk_bf16(a[2], a[3]); w.z = cvt_pk_bf16(b[0], b[1]); w.w = cvt_pk_bf16(b[2], b[3]); return w; }
__device__ __forceinline__ float wave_sum(float v) {
#pragma unroll
    for (int o = 1; o < 64; o <<= 1) v += __shfl_xor(v, o);
    return v;
}
__device__ __forceinline__ float fexp(float x) { return __builtin_amdgcn_exp2f(x * 1.4426950408889634f); }
__device__ __forceinline__ void cs_rev(float rev, float& c, float& s) { const float f = __builtin_amdgcn_fractf(rev); c = __builtin_amdgcn_cosf(f); s = __builtin_amdgcn_sinf(f); }

#define XB_TMO      128
#define XB_XCNT(j)  (256  + 64 * (j))
#define XB_XSUB(j)  (1280 + 64 * (j))
#define XB_XGEN(j)  (2304 + 64 * (j))
#define XB_TOP      3328
#define XB_TOPGEN   3392
#define XCD_BAR_WORDS 3456
#define XB_SPIN_CAP (1u << 18)
__device__ __forceinline__ unsigned xb_ld(unsigned* p)              { return __hip_atomic_load(p, __ATOMIC_RELAXED, __HIP_MEMORY_SCOPE_AGENT); }
__device__ __forceinline__ unsigned xb_add(unsigned* p, unsigned v) { return __hip_atomic_fetch_add(p, v, __ATOMIC_RELAXED, __HIP_MEMORY_SCOPE_AGENT); }
__device__ __forceinline__ unsigned xb_xcc_id() { return (unsigned)__builtin_amdgcn_s_getreg((3 << 11) | 20) & 0xFu; }
#define XB_SPIN(cond, bar) do { unsigned _sp = 0; while (cond) { __builtin_amdgcn_s_sleep(1); \
    if ((++_sp & 255u) == 0u) { if (xb_ld(&(bar)[XB_TMO])) break; if (_sp > XB_SPIN_CAP) { atomicAdd(&(bar)[XB_TMO], 1u); break; } } } } while (0)
struct XcdBarrier { unsigned* bar; unsigned x; volatile LAS unsigned* st; };
__device__ __forceinline__ XcdBarrier xcd_barrier_post(unsigned* bar, volatile LAS unsigned* st) {
    XcdBarrier b; b.bar = bar; b.x = xb_xcc_id(); b.st = st;
    if (threadIdx.x == 0) (void)xb_add(&bar[XB_XCNT(b.x)], 1u);
    return b;
}
__device__ __forceinline__ void xcd_barrier_complete(unsigned* bar, unsigned x, unsigned& nloc, unsigned& nx) {
    const unsigned G = gridDim.x * gridDim.y * gridDim.z;
    unsigned sum, cnt, mine, sp = 0u;
    for (;;) {
        sum = 0u; cnt = 0u; mine = 0u;
#pragma unroll
        for (unsigned j = 0; j < 16; ++j) { const unsigned c = xb_ld(&bar[XB_XCNT(j)]); sum += c; cnt += (c > 0u) ? 1u : 0u; mine = (j == x) ? c : mine; }
        if (sum == G) break;
        __builtin_amdgcn_s_sleep(1);
        if ((++sp & 255u) == 0u) { if (xb_ld(&bar[XB_TMO])) break; if (sp > XB_SPIN_CAP) { atomicAdd(&bar[XB_TMO], 1u); break; } }
    }
    nloc = mine > 0u ? mine : 1u; nx = cnt > 0u ? cnt : 1u;
}
__device__ __forceinline__ void xcd_barrier(const XcdBarrier& b) {
    asm volatile("s_waitcnt vmcnt(0)" ::: "memory");
    __syncthreads();
    if (threadIdx.x == 0) {
        unsigned* bar = b.bar;
        __builtin_amdgcn_s_waitcnt(0);
        unsigned nloc = b.st[0], nx = b.st[1];
        if (nloc == 0u) { xcd_barrier_complete(bar, b.x, nloc, nx); b.st[0] = nloc; b.st[1] = nx; }
        const unsigned old = xb_add(&bar[XB_XSUB(b.x)], 1u);
        const unsigned gen = old / nloc;
        if (old + 1u == (gen + 1u) * nloc) {
            __builtin_amdgcn_fence(__ATOMIC_RELEASE, "agent");
            asm volatile("s_waitcnt vmcnt(0)" ::: "memory");
            const unsigned og = xb_add(&bar[XB_TOP], 1u);
            const unsigned tg = og / nx;
            if (og + 1u == (tg + 1u) * nx) xb_add(&bar[XB_TOPGEN], 1u);
            else XB_SPIN(xb_ld(&bar[XB_TOPGEN]) == tg, bar);
            __builtin_amdgcn_fence(__ATOMIC_ACQUIRE, "agent");
            xb_add(&bar[XB_XGEN(b.x)], 1u);
            asm volatile("s_waitcnt vmcnt(0)" ::: "memory");
        } else {
            XB_SPIN(xb_ld(&bar[XB_XGEN(b.x)]) == gen, bar);
            __builtin_amdgcn_fence(__ATOMIC_ACQUIRE, "agent");
            asm volatile("s_waitcnt vmcnt(0)" ::: "memory");
        }
    }
    __syncthreads();
}

namespace gm {
constexpr int BM = 256, BK = 64, HALF = 128, HTB = HALF * BK * 2, STAGE_BYTES = 8 * HTB;
__device__ __forceinline__ int lds_byte(int r, int c) { const int st = (r >> 4) * 2 + (c >> 5), rr = r & 15, cc = c & 31, ob = rr * 64 + cc * 2; return st * 1024 + (ob ^ (((ob >> 9) & 1) << 5)); }
__device__ __forceinline__ void stage_rc(int b, int& R, int& C) { const int st = b / 1024, sb = b % 1024, swz = sb ^ (((sb >> 9) & 1) << 5); R = (st >> 1) * 16 + swz / 64; C = (st & 1) * 32 + (swz % 64) / 2; }
__device__ __forceinline__ int perm32(int rho) { const int n = rho >> 4, i = rho & 15; return 8 * (i >> 2) + 4 * n + (i & 3); }

struct Unit { const char* a0; const char* a1; const char* b0; const char* b1; int p0, p1, p2, p3, q; };

__device__ __forceinline__ void tile_order(int L, int nM, int nN, int& pm, int& pn) {
    const int nwg = nM * nN; int wgid = L;
    { const int q = nwg / 8, r = nwg % 8, xcd = wgid % 8, off = wgid / 8; wgid = (xcd < r ? xcd * (q + 1) : r * (q + 1) + (xcd - r) * q) + off; }
    const int nig = 8 * nN, gid = wgid / nig, fm = gid * 8, gsz = (nM - fm) < 8 ? (nM - fm) : 8;
    pm = fm + ((wgid % nig) % gsz); pn = (wgid % nig) / gsz;
}

template <bool I8> struct AccSel { typedef f32x4 type; };
template <> struct AccSel<true> { typedef i32x4 type; };
template <class Epi, class Sched, bool GATHER, bool I8 = false, bool PREF = false>
__device__ __forceinline__ void gemm_run(LAS unsigned char* lds, const Sched& S, const Epi& E) {
    const int tid = threadIdx.x, wid = __builtin_amdgcn_readfirstlane(tid >> 6), lane = tid & 63, wr = wid >> 2, wc = wid & 3, fr = lane & 15, fq = lane >> 4;
    int nt = S.nt; asm volatile("" : "+s"(nt));
    unsigned voffA[2], voffB[2], colA[2]; int rowA[2];
#pragma unroll
    for (int i = 0; i < 2; ++i) { int R, C; stage_rc(tid * 16 + i * 8192, R, C); const int Rb = Epi::PERM ? ((R & ~31) + perm32(R & 31)) : R;
        voffA[i] = (unsigned)(R * S.multA * S.pitchA + C) * 2u; voffB[i] = (unsigned)(Rb * S.multB * S.pitchB + C) * 2u; colA[i] = (unsigned)C * 2u; rowA[i] = R; }
    const size_t kstep = (size_t)(BK * 2);
    const unsigned ldsw = (unsigned)wid * 1024u;
    const int aoff = lds_byte(wr * 64 + fr, fq * 8), boff = lds_byte(wc * 32 + fr, fq * 8);
#define G_SA(b, h) (((b) * 2 + (h)) * HTB)
#define G_SB(b, h) ((4 + (b) * 2 + (h)) * HTB)
#define G_STAGE(bufoff, gbase, voff) do { _Pragma("unroll") for (int _i = 0; _i < 2; ++_i) \
        __builtin_amdgcn_global_load_lds((const unsigned*)((const char*)(gbase) + (voff)[_i]), (LAS unsigned*)(lds + (bufoff) + ldsw + _i * 8192), 16, 0, 0); } while (0)
#define G_LDA(dst, b, h) do { _Pragma("unroll") for (int m = 0; m < 4; ++m) _Pragma("unroll") for (int k = 0; k < 2; ++k) dst[m][k] = *(const LAS bf16x8*)(lds + G_SA(b, h) + aoff + m * 2048 + k * 1024); } while (0)
#define G_LDB(dst, b, h) do { _Pragma("unroll") for (int n = 0; n < 2; ++n) _Pragma("unroll") for (int k = 0; k < 2; ++k) dst[n][k] = *(const LAS bf16x8*)(lds + G_SB(b, h) + boff + n * 2048 + k * 1024); } while (0)
#define G_MMA(ai, bj, At, Bt) do { __builtin_amdgcn_s_setprio(1); _Pragma("unroll") for (int m = 0; m < 4; ++m) _Pragma("unroll") for (int n = 0; n < 2; ++n) _Pragma("unroll") for (int k = 0; k < 2; ++k) \
        { if constexpr (I8) acc[ai][bj][m][n] = __builtin_amdgcn_mfma_i32_16x16x64_i8(__builtin_bit_cast(i32x4, Bt[n][k]), __builtin_bit_cast(i32x4, At[m][k]), acc[ai][bj][m][n], 0, 0, 0); \
          else acc[ai][bj][m][n] = __builtin_amdgcn_mfma_f32_16x16x32_bf16(Bt[n][k], At[m][k], acc[ai][bj][m][n], 0, 0, 0); } __builtin_amdgcn_s_setprio(0); } while (0)
#define G_WAIT_V(n) asm volatile("s_waitcnt vmcnt(" #n ")" ::: "memory")
#define G_WAIT_L(n) asm volatile("s_waitcnt lgkmcnt(" #n ")" ::: "memory")
#define G_BAR __builtin_amdgcn_s_barrier()
#define G_SCHED __builtin_amdgcn_sched_barrier(0)
    Unit cur, nxt; int ui = 0;
    if (!S.next(0, cur)) return;
    cur.q = 0;
    if constexpr (PREF) { S.prefetch(cur, lds); G_WAIT_V(0); G_BAR; }
    typedef typename AccSel<I8>::type acc_t;
    acc_t acc[2][2][4][2];
#pragma unroll
    for (int a = 0; a < 2; ++a)
#pragma unroll
        for (int b = 0; b < 2; ++b)
#pragma unroll
            for (int m = 0; m < 4; ++m)
#pragma unroll
                for (int n = 0; n < 2; ++n) acc[a][b][m][n] = (acc_t){0, 0, 0, 0};
    bf16x8 At[4][2], B0[2][2], B1[2][2];
    unsigned gc0[2], gc1[2];
    if constexpr (GATHER) {
#pragma unroll
        for (int i = 0; i < 2; ++i) { gc0[i] = S.row_off(cur, rowA[i], lds) + colA[i]; gc1[i] = S.row_off(cur, 128 + rowA[i], lds) + colA[i]; }
    }
#define vA0 (GATHER ? gc0 : voffA)
#define vA1 (GATHER ? gc1 : voffA)
    G_STAGE(G_SB(0, 0), cur.b0, voffB); G_STAGE(G_SB(0, 1), cur.b1, voffB); G_STAGE(G_SA(0, 0), cur.a0, vA0); G_STAGE(G_SA(0, 1), cur.a1, vA1);
    if (wr == 1) G_BAR;
    G_WAIT_V(2); G_BAR;
    G_STAGE(G_SB(1, 0), cur.b0 + kstep, voffB); G_STAGE(G_SA(1, 0), cur.a0 + kstep, vA0); G_STAGE(G_SB(1, 1), cur.b1 + kstep, voffB);
    G_WAIT_V(6); G_BAR;
    for (;;) {
        const bool has_next = S.next(ui + 1, nxt);
        if (!has_next) nxt = cur;
        nxt.q = (ui + 1) & 1;
        for (int t = 0; t < nt; t += 2) {
            const bool last = (t == nt - 2);
            if constexpr (PREF) { if (t == nt - 4) S.prefetch(nxt, lds); }
            const char* a11 = cur.a1 + (size_t)(t + 1) * kstep;
            const char* a02 = last ? nxt.a0 : cur.a0 + (size_t)(t + 2) * kstep; const char* a12 = last ? nxt.a1 : cur.a1 + (size_t)(t + 2) * kstep;
            const char* b02 = last ? nxt.b0 : cur.b0 + (size_t)(t + 2) * kstep; const char* b12 = last ? nxt.b1 : cur.b1 + (size_t)(t + 2) * kstep;
            G_LDB(B0, 0, 0); G_LDB(B1, 0, 1); G_SCHED; G_LDA(At, 0, 0); G_STAGE(G_SA(1, 1), a11, vA1);
            if constexpr (GATHER) { if (last) { int tz = tid; asm volatile("" : "+v"(tz));
#pragma unroll
                for (int i = 0; i < 2; ++i) { int R, C; stage_rc(tz * 16 + i * 8192, R, C); gc0[i] = S.row_off(nxt, R, lds) + (unsigned)C * 2u; gc1[i] = S.row_off(nxt, 128 + R, lds) + (unsigned)C * 2u; } } }
            G_WAIT_V(8); G_WAIT_L(0); G_BAR; G_MMA(0, 0, At, B0); G_MMA(0, 1, At, B1); G_BAR; G_SCHED;
            G_LDA(At, 0, 1); G_STAGE(G_SB(0, 0), b02, voffB); G_STAGE(G_SB(0, 1), b12, voffB); G_STAGE(G_SA(0, 0), a02, vA0);
            G_WAIT_V(8); G_WAIT_L(0); G_BAR; G_MMA(1, 0, At, B0); G_MMA(1, 1, At, B1); G_BAR; G_SCHED;
            G_LDB(B0, 1, 0); G_LDB(B1, 1, 1); G_SCHED; G_LDA(At, 1, 0); G_STAGE(G_SA(0, 1), a12, vA1);
            G_WAIT_V(8); G_WAIT_L(0); G_BAR; G_MMA(0, 0, At, B0); G_MMA(0, 1, At, B1); G_BAR; G_SCHED;
            G_LDA(At, 1, 1); G_STAGE(G_SB(1, 0), b02 + kstep, voffB); G_STAGE(G_SB(1, 1), b12 + kstep, voffB); G_STAGE(G_SA(1, 0), a02 + kstep, vA0);
            G_WAIT_V(8); G_WAIT_L(0); G_BAR; G_MMA(1, 0, At, B0); G_MMA(1, 1, At, B1); G_BAR; G_SCHED;
        }
        if (wr == 0) G_BAR;
        { int fr2 = fr, fq2 = fq; asm volatile("" : "+v"(fr2), "+v"(fq2));
          E(acc, cur, lds, wr, wc, fr2, fq2); }
        if (!has_next) break;
#pragma unroll
        for (int a = 0; a < 2; ++a)
#pragma unroll
            for (int b = 0; b < 2; ++b)
#pragma unroll
                for (int m = 0; m < 4; ++m)
#pragma unroll
                    for (int n = 0; n < 2; ++n) acc[a][b][m][n] = (acc_t){0, 0, 0, 0};
        cur = nxt; ++ui;
        if (wr == 1) G_BAR;
    }
    G_WAIT_V(0);
    G_BAR;
#undef G_SA
#undef G_SB
#undef G_STAGE
#undef G_LDA
#undef G_LDB
#undef G_MMA
#undef G_WAIT_V
#undef G_WAIT_L
#undef G_BAR
#undef G_SCHED
#undef vA0
#undef vA1
}
}
using gm::Unit;
typedef f32x4 Acc[2][2][4][2];
typedef i32x4 AccI[2][2][4][2];

struct Args { const float* in[18]; float* out; unsigned char* ws; int ph_lo, ph_hi; };
struct Frame {
    LAS unsigned char* lds; unsigned char* ws; unsigned* ctl;
    int tid, lane, wave, vcu, G;
    const float *x, *ln0_g, *ln0_b, *w_in, *dec_f, *dec_b, *gn_g, *w_out, *ln1_g, *ln1_b, *w_r, *b_r, *w_up, *b_up, *w_dn, *b_dn, *ln2_g, *ln2_b;
    float* out;
};
#define WSP(T_, off) ((T_*)(F.ws + (off)))

template <class ColMap>
__device__ __forceinline__ void transpose_item(const float* W, int K, int N, bf16* WT, LAS float* scr, int item, int lane, const ColMap& cm) {
    const int nblk = N / 64, kb = item / nblk, nb = item % nblk, k0 = 64 * kb, n0 = 64 * nb;
    const int s0 = cm(n0);
#pragma unroll 4
    for (int i = 0; i < 16; ++i) { const int kk = 4 * i + (lane >> 4), c4 = (lane & 15) * 4;
        const f32x4 v = *(const GAS f32x4*)(W + (size_t)(k0 + kk) * N + s0 + c4);
        LAS float* d = scr + kk * 65 + c4; d[0] = v[0]; d[1] = v[1]; d[2] = v[2]; d[3] = v[3]; }
    LDS_WAIT(); asm volatile("" ::: "memory");
    const int c = lane & 7;
#pragma unroll
    for (int j = 0; j < 8; ++j) { const int n = (lane >> 3) + 8 * j; const LAS float* s = scr + (8 * c) * 65 + n;
        v4u o; o.x = cvt_pk_bf16(s[0 * 65], s[1 * 65]); o.y = cvt_pk_bf16(s[2 * 65], s[3 * 65]); o.z = cvt_pk_bf16(s[4 * 65], s[5 * 65]); o.w = cvt_pk_bf16(s[6 * 65], s[7 * 65]);
        *(GAS v4u*)(WT + (size_t)(n0 + n) * K + k0 + 8 * c) = o; }
    LDS_WAIT(); asm volatile("" ::: "memory");
}
struct ColId { __device__ __forceinline__ int operator()(int n) const { return n; } };
struct ColUp { __device__ __forceinline__ int operator()(int n) const { return ((n >> 8) * 128 + (n & 127)) + ((n >> 7) & 1) * 2048; } };

__device__ __forceinline__ void p0_prologue(Frame& F) {
    const int gw = F.vcu * NWAVES + F.wave, NGW = F.G * NWAVES;
    {
        unsigned* h0q = WSP(unsigned, WS_H0B); float* st0 = WSP(float, WS_ST0); float* sx0 = WSP(float, WS_SX0);
        for (int m = gw; m < T; m += NGW) {
            const GAS f32x4* xr = (const GAS f32x4*)(F.x + (size_t)m * D) + F.lane;
            f32x4 v[8]; float s = 0.f;
#pragma unroll
            for (int j = 0; j < 8; ++j) { v[j] = xr[64 * j]; s += (v[j][0] + v[j][1]) + (v[j][2] + v[j][3]); }
            const float mean = wave_sum(s) * (1.f / D); float s2 = 0.f;
#pragma unroll
            for (int j = 0; j < 8; ++j) { v[j] = v[j] - mean; s2 += (v[j][0] * v[j][0] + v[j][1] * v[j][1]) + (v[j][2] * v[j][2] + v[j][3] * v[j][3]); }
            const float rstd = 1.f / sqrtf(wave_sum(s2) * (1.f / D) + LN_EPS); float am = 0.f;
#pragma unroll
            for (int j = 0; j < 8; ++j) { const f32x4 g = *((const GAS f32x4*)F.ln0_g + F.lane + 64 * j), b = *((const GAS f32x4*)F.ln0_b + F.lane + 64 * j);
                v[j] = v[j] * rstd * g + b; am = fmaxf(am, fmaxf(fmaxf(fabsf(v[j][0]), fabsf(v[j][1])), fmaxf(fabsf(v[j][2]), fabsf(v[j][3])))); }
#pragma unroll
            for (int o = 1; o < 64; o <<= 1) am = fmaxf(am, __shfl_xor(am, o));
            const float sc = am > 0.f ? am * (1.f / 127.f) : 1.f, inv = 1.f / sc;
#pragma unroll
            for (int j = 0; j < 8; ++j) { const int q0 = (int)__builtin_rintf(v[j][0] * inv), q1 = (int)__builtin_rintf(v[j][1] * inv), q2 = (int)__builtin_rintf(v[j][2] * inv), q3 = (int)__builtin_rintf(v[j][3] * inv);
                h0q[(size_t)m * (D / 4) + F.lane + 64 * j] = (unsigned)(q0 & 0xff) | ((unsigned)(q1 & 0xff) << 8) | ((unsigned)(q2 & 0xff) << 16) | ((unsigned)(q3 & 0xff) << 24); }
            if (F.lane == 0) { st0[2 * m] = mean; st0[2 * m + 1] = rstd; sx0[m] = sc; }
        }
    }
    {
        bf16* tab = WSP(bf16, WS_TAB);
        for (int i = (F.vcu * NTHR + F.tid); i < 32768 + 65536 + 65536; i += F.G * NTHR) {
            float v;
            if (i < 32768) { const int r = i >> 7, a = i & 127, ri = r >> 7, k1 = r & 127; float c, s; cs_rev((float)((k1 * a) & 127) * (1.f / 128.f), c, s); v = ri ? -s : c; }
            else if (i < 32768 + 65536) { const int e = i - 32768, r = e >> 8, q = e & 255, ri = r >> 7, k2 = r & 127, rj = q >> 7, b = q & 127; float c, s; cs_rev((float)((k2 * b) & 127) * (1.f / 128.f), c, s);
                v = (ri == 0) ? (rj == 0 ? c : s) : (rj == 0 ? -s : c); }
            else { const int e = i - 32768 - 65536, l = e >> 8, q = e & 255, rj = q >> 7, cg = q & 127; float c, s; cs_rev((float)((l * cg) & 127) * (1.f / 128.f), c, s); v = (l < 128) ? (rj == 0 ? c : s) : 0.f; }
            tab[i] = (bf16)(cvt_pk_bf16(v, 0.f) & 0xffffu);
        }
    }
    {
        LAS float* scr = (LAS float*)(F.lds + F.wave * 18432);
        constexpr int I_IN = 32 * (DIN / 64), I_OUT = 32 * (D / 64), I_UP = 32 * (2 * DFF / 64), I_DN = 32 * (D / 64);
        constexpr int NIT = I_OUT;
        for (int it = gw; it < NIT; it += NGW) {
            int r = it;
            { transpose_item(F.w_out, D, D, WSP(bf16, WS_WOUT), scr, r, F.lane, ColId()); }
        }
    }
}

struct SlabDesc { const float* W; signed char* WQ; float* sw; int NS, e, n0, valid; };
struct QF { unsigned char* ws; const float* w_up; const float* w_dn; const float* w_in; int vcu, G; };
__device__ __forceinline__ SlabDesc slab_desc(const QF& F, int j) {
    const int nD = (NE * 64 + F.G - 1) / F.G; SlabDesc d;
    if (j < 0) { const int sl = F.vcu + (-1 - j) * F.G; d.valid = sl < DIN / 32; d.NS = DIN; d.e = 0; d.n0 = sl * 32; d.W = F.w_in + d.n0; d.WQ = (signed char*)WSP(char, WS_WIN); d.sw = WSP(float, WS_SWIN); }
    else if (j >= nD) { const int sl = F.vcu + (j - nD) * F.G; d.valid = sl < NE * 128; d.NS = 2 * DFF; d.e = sl >> 7; d.n0 = (sl & 127) * 32; d.W = F.w_up + (size_t)d.e * D * 2 * DFF + ColUp()(d.n0); d.WQ = (signed char*)WSP(char, WS_WUP); d.sw = WSP(float, WS_SWUP); }
    else { const int sl = F.vcu + j * F.G; d.valid = sl < NE * 64; d.NS = D; d.e = sl >> 6; d.n0 = (sl & 63) * 32; d.W = F.w_dn + (size_t)d.e * DFF * D + d.n0; d.WQ = (signed char*)WSP(char, WS_WDN); d.sw = WSP(float, WS_SWDN); }
    return d;
}
#define SLAB_LOAD(dsc, v) do { if ((dsc).valid) { const GAS char* b_ = (const GAS char*)(dsc).W; unsigned o_ = (unsigned)((wave * 256 + kq) * (dsc).NS + c4) * 4u; const unsigned st_ = (unsigned)(dsc).NS * 32u; \
    _Pragma("unroll") for (int i_ = 0; i_ < 32; ++i_) { v[i_] = __builtin_nontemporal_load((const GAS f32x4*)(b_ + o_)); o_ += st_; } } } while (0)
__device__ __forceinline__ void do_slabs_impl(LAS unsigned char* lds, unsigned char* ws, const float* w_up, const float* w_dn, const float* w_in, int vcu, int G, int j0, int j1) {
    if (j0 >= j1) return;
    QF F; F.ws = ws; F.w_up = w_up; F.w_dn = w_dn; F.w_in = w_in; F.vcu = vcu; F.G = G;
    const int tid = threadIdx.x, lane = tid & 63, wave = __builtin_amdgcn_readfirstlane(tid >> 6);
    constexpr int PITCH = 2056;
    LAS bf16* slab = (LAS bf16*)lds;
    LAS float* red = (LAS float*)(lds + 32 * PITCH * 2);
    const int kq = lane >> 3, c4 = (lane & 7) * 4;
    f32x4 v[32];
    SlabDesc cur = slab_desc(F, j0);
    SLAB_LOAD(cur, v);
    for (int j = j0; j < j1; ++j) {
        if (cur.valid) {
            f32x4 mx = (f32x4){0.f, 0.f, 0.f, 0.f};
#pragma unroll
            for (int i = 0; i < 32; ++i) { const int k = wave * 256 + i * 8 + kq; const f32x4 x = v[i];
                mx[0] = fmaxf(mx[0], fabsf(x[0])); mx[1] = fmaxf(mx[1], fabsf(x[1])); mx[2] = fmaxf(mx[2], fabsf(x[2])); mx[3] = fmaxf(mx[3], fabsf(x[3]));
                const unsigned p01 = cvt_pk_bf16(x[0], x[1]), p23 = cvt_pk_bf16(x[2], x[3]);
                const int ks = k ^ (((c4 >> 3) & 3) << 3);
                slab[(c4 + 0) * PITCH + ks] = (bf16)(p01 & 0xffffu); slab[(c4 + 1) * PITCH + ks] = (bf16)(p01 >> 16); slab[(c4 + 2) * PITCH + ks] = (bf16)(p23 & 0xffffu); slab[(c4 + 3) * PITCH + ks] = (bf16)(p23 >> 16); }
#pragma unroll
            for (int q = 0; q < 4; ++q) { float m = mx[q]; m = fmaxf(m, __shfl_xor(m, 8)); m = fmaxf(m, __shfl_xor(m, 16)); m = fmaxf(m, __shfl_xor(m, 32)); mx[q] = m; }
            if (lane < 8) { LAS float* d = red + wave * 32 + c4; d[0] = mx[0]; d[1] = mx[1]; d[2] = mx[2]; d[3] = mx[3]; }
        }
        const SlabDesc done = cur;
        if (j + 1 < j1) { cur = slab_desc(F, j + 1); SLAB_LOAD(cur, v); }
        __syncthreads();
        if (done.valid && tid < 32) { float m = 0.f;
#pragma unroll
            for (int w = 0; w < 8; ++w) m = fmaxf(m, red[w * 32 + tid]);
            const float sc = m > 0.f ? m * (1.f / 127.f) : 1.f; done.sw[(size_t)done.e * done.NS + done.n0 + tid] = sc; red[256 + tid] = 1.f / sc; }
        __syncthreads();
        if (done.valid) {
#pragma unroll 2
            for (int i = 0; i < 8; ++i) { const int q = tid + NTHR * i, n = q >> 7, kc = q & 127; const float inv = red[256 + n];
                const int sx_ = ((n >> 3) & 3) << 3;
                const v4u a = *(const LAS v4u*)(slab + n * PITCH + ((kc * 16) ^ sx_)), b = *(const LAS v4u*)(slab + n * PITCH + ((kc * 16 + 8) ^ sx_));
                const unsigned src[8] = {a.x, a.y, a.z, a.w, b.x, b.y, b.z, b.w}; unsigned o[4];
#pragma unroll
                for (int d = 0; d < 4; ++d) { unsigned w = 0u;
#pragma unroll
                    for (int h2 = 0; h2 < 2; ++h2) { const unsigned u2 = src[2 * d + h2]; const int q0 = (int)__builtin_rintf(bf_lo(u2) * inv), q1 = (int)__builtin_rintf(bf_hi(u2) * inv);
                        w |= ((unsigned)(q0 & 0xff) << (16 * h2)) | ((unsigned)(q1 & 0xff) << (16 * h2 + 8)); }
                    o[d] = w; }
                *(GAS v4u*)(done.WQ + ((size_t)done.e * done.NS + done.n0 + n) * D + kc * 16) = (v4u){o[0], o[1], o[2], o[3]}; }
        }
        __syncthreads();
    }
}

__device__ __forceinline__ void do_slabs(Frame& F, int j0, int j1) { do_slabs_impl(F.lds, F.ws, F.w_up, F.w_dn, F.w_in, F.vcu, F.G, j0, j1); }

struct SchedBase { int nt, pitchA, pitchB, multA, multB, G, c; };
struct SchedG1N : SchedBase {
    const char* A; const char* Bt;
    __device__ __forceinline__ bool next(int i, Unit& u) const { const int L = i * G + c; if (L >= 64 * 12) return false; int pm, pn; gm::tile_order(L, 64, 12, pm, pn);
        const int cb = pn < 4 ? 1024 + 256 * pn : (pn < 8 ? 2048 + 256 * (pn - 4) : 4096 + 256 * (pn - 8));
        u.a0 = A + (size_t)pm * 256 * D; u.a1 = u.a0 + (size_t)128 * D; u.b0 = Bt + (size_t)cb * D; u.b1 = u.b0 + (size_t)128 * D; u.p0 = pm; u.p1 = pn; u.p2 = cb; u.p3 = 0; return true; }
};
struct SchedG1SF : SchedBase {
    const char* A; const char* Bt;
    __device__ __forceinline__ bool next(int i, Unit& u) const { const int L = i * G + c; if (L >= 4 * 64) return false; int pm, pn; gm::tile_order(L, 4, 64, pm, pn);
        u.a0 = A + (size_t)pm * 256 * D; u.a1 = u.a0 + (size_t)128 * D; u.b0 = Bt + (size_t)(2 * pn) * D; u.b1 = u.b0 + (size_t)D; u.p0 = pm; u.p1 = pn; u.p2 = 0; u.p3 = 0; return true; }
};
struct SchedG1SKV : SchedBase {
    const char* A; const char* Bt;
    __device__ __forceinline__ bool next(int i, Unit& u) const { const int L = i * G + c; if (L >= 8 * 64) return false; int pm, pn; gm::tile_order(L, 8, 64, pm, pn);
        const int rb = pm < 4 ? 2048 + 256 * pm : 3072 + 256 * (pm - 4);
        u.a0 = A + (size_t)rb * D; u.a1 = u.a0 + (size_t)128 * D; u.b0 = Bt + (size_t)pn * 256 * D; u.b1 = u.b0 + (size_t)128 * D; u.p0 = pm; u.p1 = pn; u.p2 = rb; u.p3 = 0; return true; }
};
struct SchedFixA : SchedBase {
    const char* A; const char* Bt; int ncol;
    __device__ __forceinline__ bool next(int i, Unit& u) const { const int L = i * G + c; if (L >= ncol) return false;
        u.a0 = A; u.a1 = A + (size_t)128 * pitchA * 2; u.b0 = Bt + (size_t)L * 256 * pitchB * 2; u.b1 = u.b0 + (size_t)128 * pitchB * 2; u.p0 = 0; u.p1 = L; u.p2 = 0; u.p3 = 0; return true; }
};
struct SchedFixB : SchedBase {
    const char* A; const char* Bt; int nrow;
    __device__ __forceinline__ bool next(int i, Unit& u) const { const int L = i * G + c; if (L >= nrow) return false;
        u.a0 = A + (size_t)L * 256 * pitchA * 2; u.a1 = u.a0 + (size_t)128 * pitchA * 2; u.b0 = Bt; u.b1 = Bt + (size_t)128 * pitchB * 2; u.p0 = L; u.p1 = 0; u.p2 = 0; u.p3 = 0; return true; }
};
struct SchedScores : SchedBase {
    const char* Q; const char* Kk;
    __device__ __forceinline__ bool next(int i, Unit& u) const { const int L = i * G + c; if (L >= NH * NCH) return false; const int h = L & 3, n = L >> 2;
        u.a0 = Q + ((size_t)n * 256 * RW + h * HD) * 2; u.a1 = u.a0 + (size_t)128 * RW * 2; u.b0 = Kk + ((size_t)n * 256 * RW + h * HD) * 2; u.b1 = u.b0 + (size_t)128 * RW * 2; u.p0 = h; u.p1 = n; u.p2 = 0; u.p3 = 0; return true; }
};
struct SchedKV : SchedBase {
    const char* Bcat; const char* kTw;
    __device__ __forceinline__ bool next(int i, Unit& u) const { const int L = i * G + c; if (L >= 2 * NH * NCH) return false; const int dh = L & 7, n = L >> 3, dir = dh >> 2, h = dh & 3;
        u.a0 = Bcat + ((size_t)(h * NCH + n) * 256 * CAT) * 2; u.a1 = u.a0 + (size_t)128 * CAT * 2;
        u.b0 = kTw + (((size_t)dir * RW + h * HD) * T + (size_t)n * 256) * 2; u.b1 = u.b0 + (size_t)128 * T * 2; u.p0 = dh; u.p1 = n; u.p2 = 0; u.p3 = 0; return true; }
};
struct SchedOut : SchedBase {
    const char* Acat; const char* Bcat;
    __device__ __forceinline__ bool next(int i, Unit& u) const { const int L = i * G + c; if (L >= NH * NCH) return false; const int h = L & 3, n = L >> 2;
        u.a0 = Acat + ((size_t)h * T + (size_t)n * 256) * CAT * 2; u.a1 = u.a0 + (size_t)128 * CAT * 2; u.b0 = Bcat + ((size_t)(h * NCH + n) * 256 * CAT) * 2; u.b1 = u.b0 + (size_t)128 * CAT * 2; u.p0 = h; u.p1 = n; u.p2 = 0; u.p3 = 0; return true; }
};
struct Sched2D : SchedBase {
    const char* A; const char* Bt; int nM, nN;
    __device__ __forceinline__ bool next(int i, Unit& u) const { const int L = i * G + c; if (L >= nM * nN) return false; int pm, pn; gm::tile_order(L, nM, nN, pm, pn);
        u.a0 = A + (size_t)pm * 256 * pitchA * 2; u.a1 = u.a0 + (size_t)128 * pitchA * 2; u.b0 = Bt + (size_t)pn * 256 * pitchB * 2; u.b1 = u.b0 + (size_t)128 * pitchB * 2; u.p0 = pm; u.p1 = pn; u.p2 = 0; u.p3 = 0; return true; }
};
struct SchedMoE : SchedBase {
    const char* A; const char* Bt; const LAS int* tstart; const int* row_tok; const unsigned* cnt; int nN, rowbytes; size_t estride;
    __device__ __forceinline__ bool next(int i, Unit& u) const { const int RT = __builtin_amdgcn_readfirstlane(tstart[NE]); const int L = i * G + c; if (L >= RT * nN) return false; int rt, pn; gm::tile_order(L, RT, nN, rt, pn);
        const int e = __builtin_amdgcn_readfirstlane(tstart[40 + rt]);
        u.b0 = Bt + (size_t)e * estride + (size_t)pn * 256 * rowbytes; u.b1 = u.b0 + (size_t)128 * rowbytes;
        u.a0 = A; u.a1 = A;
        u.p0 = rt; u.p1 = pn; u.p2 = e; u.p3 = (rt - __builtin_amdgcn_readfirstlane(tstart[e])) * 256; return true; }
    __device__ __forceinline__ bool next_tab(int i, Unit& u) const { const int w = (i < 64) ? __builtin_amdgcn_readfirstlane(tstart[400 + i]) : -1; if (w < 0) return false;
        const int rt = w & 1023, pn = (w >> 10) & 31, e = (w >> 15) & 31;
        u.b0 = Bt + (size_t)e * estride + (size_t)pn * 256 * rowbytes; u.b1 = u.b0 + (size_t)128 * rowbytes; u.a0 = A; u.a1 = A;
        u.p0 = rt; u.p1 = pn; u.p2 = e; u.p3 = (rt - __builtin_amdgcn_readfirstlane(tstart[e])) * 256; return true; }
    const float *rsc, *swup, *b_up;
    __device__ __forceinline__ void prefetch(const Unit& u, LAS unsigned char* lds) const {
        LAS unsigned char* blk = lds + LDS_STAGE + u.q * 4096;
        const int wid = __builtin_amdgcn_readfirstlane(threadIdx.x >> 6), lane = threadIdx.x & 63, e = u.p2;
        const int n = (int)cnt[64 * e]; int pos = u.p3 + (wid & 3) * 64 + lane; pos = pos < n ? pos : n - 1;
        if (wid < 4) __builtin_amdgcn_global_load_lds((const unsigned*)(row_tok + (size_t)e * T + pos), (LAS unsigned*)(blk + wid * 256), 4, 0, 0);
        else __builtin_amdgcn_global_load_lds((const unsigned*)(rsc + (size_t)e * T + pos), (LAS unsigned*)(blk + 1024 + (wid - 4) * 256), 4, 0, 0);
        if (wid == 0) __builtin_amdgcn_global_load_lds((const unsigned*)(swup + (size_t)e * 2 * DFF + u.p1 * 256 + lane * 4), (LAS unsigned*)(blk + 2048), 16, 0, 0);
        if (wid == 1) __builtin_amdgcn_global_load_lds((const unsigned*)(b_up + (size_t)e * 2 * DFF + u.p1 * 128 + (lane & 31) * 4 + (lane >> 5) * DFF), (LAS unsigned*)(blk + 3072), 16, 0, 0);
    }
    __device__ __forceinline__ unsigned row_off(const Unit& u, int r, LAS unsigned char* lds) const { return (unsigned)((const LAS int*)(lds + LDS_STAGE + u.q * 4096))[r] * (unsigned)rowbytes; }
};
struct SchedMoEUpT : SchedMoE { __device__ __forceinline__ bool next(int i, Unit& u) const { return next_tab(i, u); } };
struct SchedMoEDown : SchedMoE {
    const float *sa, *swdn, *b_dn;
    __device__ __forceinline__ bool next(int i, Unit& u) const { if (!SchedMoE::next_tab(i, u)) return false; u.a0 = A + (size_t)u.p0 * 256 * rowbytes; u.a1 = u.a0 + (size_t)128 * rowbytes; return true; }
    __device__ __forceinline__ void prefetch(const Unit& u, LAS unsigned char* lds) const {
        LAS unsigned char* blk = lds + LDS_STAGE + u.q * 4096;
        const int wid = __builtin_amdgcn_readfirstlane(threadIdx.x >> 6), lane = threadIdx.x & 63, e = u.p2;
        if (wid == 0) __builtin_amdgcn_global_load_lds((const unsigned*)(sa + (size_t)u.p0 * 256 + lane * 4), (LAS unsigned*)(blk), 16, 0, 0);
        if (wid == 1) __builtin_amdgcn_global_load_lds((const unsigned*)(swdn + (size_t)e * D + u.p1 * 256 + lane * 4), (LAS unsigned*)(blk + 1024), 16, 0, 0);
        if (wid == 2) __builtin_amdgcn_global_load_lds((const unsigned*)(b_dn + (size_t)e * D + u.p1 * 256 + lane * 4), (LAS unsigned*)(blk + 2048), 16, 0, 0);
    }
};

#define EPI_LOOP_AM for (int ai = 0; ai < 2; ++ai) _Pragma("unroll") for (int m = 0; m < 4; ++m)
#define EPI_FENCE __builtin_amdgcn_sched_barrier(0)
struct EpiG1N {
    static constexpr bool PERM = true;
    bf16 *qs, *kk, *gs, *Acat; const float *dec_f, *dec_b, *sx0, *swin;
    __device__ __forceinline__ void operator()(AccI& acci, const Unit& u, LAS unsigned char*, int wr, int wc, int fr, int fq) const {
        const int pm = u.p0, pn = u.p1, c0 = wc * 32 + 8 * fq;
        f32x4 swc[2][2];
#pragma unroll
        for (int bj = 0; bj < 2; ++bj)
#pragma unroll
            for (int n = 0; n < 2; ++n) swc[bj][n] = *(const GAS f32x4*)(swin + u.p2 + 128 * bj + c0 + 4 * n);
#define ACCF(ai_, bj_, m_, n_, j_) ((float)acci[ai_][bj_][m_][n_][j_] * (sxr * swc[bj_][n_][j_]))
        if (pn < 8) {
            const int h = pn & 3; const bool isq = pn < 4;
            float inv[8];
#pragma unroll
            for (int e = 0; e < 8; ++e) inv[e] = __builtin_amdgcn_exp2f(-(float)(c0 + e) * (13.287712379549449f / 128.f)) * 0.15915494309189535f;
            const float lgf = -fexp(dec_f[h]), lgb = -fexp(dec_b[h]);
#pragma unroll
            EPI_LOOP_AM {
                const int r = 128 * ai + 64 * wr + 16 * m + fr, tok = pm * 256 + r; const float pos = (float)tok; const float sxr = sx0[tok];
                f32x4 o1[2], o2[2];
#pragma unroll
                for (int n = 0; n < 2; ++n)
#pragma unroll
                    for (int j = 0; j < 4; ++j) { float c, s; cs_rev(pos * inv[4 * n + j], c, s); const float x1 = ACCF(ai, 0, m, n, j), x2 = ACCF(ai, 1, m, n, j); o1[n][j] = x1 * c - x2 * s; o2[n][j] = x2 * c + x1 * s; }
                if (isq) {
                    bf16* q = qs + (size_t)tok * RW + h * HD + c0; *(GAS v4u*)q = pack8(o1[0], o1[1]); *(GAS v4u*)(q + 128) = pack8(o2[0], o2[1]);
                    const int il = r; const float wf = fexp(lgf * (float)(il + 1)), wb = fexp(lgb * (float)(255 - il));
                    bf16* a = Acat + ((size_t)h * T + tok) * CAT + c0;
                    *(GAS v4u*)(a + 256) = pack8(o1[0] * wf, o1[1] * wf); *(GAS v4u*)(a + 384) = pack8(o2[0] * wf, o2[1] * wf);
                    *(GAS v4u*)(a + 512) = pack8(o1[0] * wb, o1[1] * wb); *(GAS v4u*)(a + 640) = pack8(o2[0] * wb, o2[1] * wb);
                } else {
                    bf16* k = kk + (size_t)tok * RW + h * HD + c0; *(GAS v4u*)k = pack8(o1[0] * 0.0625f, o1[1] * 0.0625f); *(GAS v4u*)(k + 128) = pack8(o2[0] * 0.0625f, o2[1] * 0.0625f);
                }
            }
        } else {
#pragma unroll
            EPI_LOOP_AM {
                const int r = 128 * ai + 64 * wr + 16 * m + fr, tok = pm * 256 + r; const float sxr = sx0[tok];
#pragma unroll
                for (int bj = 0; bj < 2; ++bj) { f32x4 v[2];
#pragma unroll
                    for (int n = 0; n < 2; ++n)
#pragma unroll
                        for (int j = 0; j < 4; ++j) { const float g = ACCF(ai, bj, m, n, j); v[n][j] = g * __builtin_amdgcn_rcpf(1.f + fexp(-g)); }
                    *(GAS v4u*)(gs + (size_t)tok * RW + (pn - 8) * 256 + bj * 128 + c0) = pack8(v[0], v[1]); }
            }
        }
    }
};
#undef ACCF
struct EpiG1SF {
    static constexpr bool PERM = true;
    bf16* uTT; const float *sx0, *swin;
    __device__ __forceinline__ void operator()(AccI& acc, const Unit& u, LAS unsigned char*, int wr, int wc, int fr, int fq) const {
        const int a0 = wc * 32 + 8 * fq;
        float sxc[2][8];
#pragma unroll
        for (int bj = 0; bj < 2; ++bj)
#pragma unroll
            for (int e = 0; e < 8; ++e) sxc[bj][e] = sx0[128 * (a0 + e) + 2 * u.p1 + bj];
#pragma unroll
        EPI_LOOP_AM { const int cch = u.p0 * 256 + 128 * ai + 64 * wr + 16 * m + fr; const float swr = swin[cch];
#pragma unroll
            for (int bj = 0; bj < 2; ++bj) { f32x4 v0, v1;
#pragma unroll
                for (int j = 0; j < 4; ++j) { v0[j] = (float)acc[ai][bj][m][0][j] * (swr * sxc[bj][j]); v1[j] = (float)acc[ai][bj][m][1][j] * (swr * sxc[bj][4 + j]); }
                *(GAS v4u*)(uTT + ((size_t)cch * 128 + (2 * u.p1 + bj)) * 128 + a0) = pack8(v0, v1); } }
    }
};
struct EpiG1SKV {
    static constexpr bool PERM = true;
    bf16 *kTw, *Bcat; const float *dec_f, *dec_b, *sx0, *swin;
    __device__ __forceinline__ void operator()(AccI& acc, const Unit& u, LAS unsigned char*, int wr, int wc, int fr, int fq) const {
        const int pm = u.p0, n_ch = u.p1, c0 = wc * 32 + 8 * fq;
        f32x4 sxc[2][2];
#pragma unroll
        for (int bj = 0; bj < 2; ++bj)
#pragma unroll
            for (int n = 0; n < 2; ++n) sxc[bj][n] = *(const GAS f32x4*)(sx0 + n_ch * 256 + 128 * bj + c0 + 4 * n);
        if (pm < 4) {
            const int h = pm; const float lgf = -fexp(dec_f[h]), lgb = -fexp(dec_b[h]);
#pragma unroll
            for (int m = 0; m < 4; ++m) {
                const int d = 64 * wr + 16 * m + fr;
                const float sw1 = swin[u.p2 + d], sw2 = swin[u.p2 + 128 + d];
                const float inv = __builtin_amdgcn_exp2f(-(float)d * (13.287712379549449f / 128.f)) * 0.15915494309189535f;
#pragma unroll
                for (int bj = 0; bj < 2; ++bj) {
                    f32x4 f1[2], f2[2], b1[2], b2[2];
#pragma unroll
                    for (int n = 0; n < 2; ++n)
#pragma unroll
                        for (int j = 0; j < 4; ++j) { const int il = 128 * bj + c0 + 4 * n + j; const float pos = (float)(n_ch * 256 + il); float c, s; cs_rev(pos * inv, c, s);
                            const float x1 = (float)acc[0][bj][m][n][j] * (sw1 * sxc[bj][n][j]), x2 = (float)acc[1][bj][m][n][j] * (sw2 * sxc[bj][n][j]); const float o1 = (x1 * c - x2 * s) * 0.0625f, o2 = (x2 * c + x1 * s) * 0.0625f;
                            const float wf = fexp(lgf * (float)(255 - il)), wb = fexp(lgb * (float)(il + 1));
                            f1[n][j] = o1 * wf; f2[n][j] = o2 * wf; b1[n][j] = o1 * wb; b2[n][j] = o2 * wb; }
                    const size_t tcol = (size_t)n_ch * 256 + 128 * bj + c0;
                    bf16* pf = kTw + ((size_t)(h * HD + d)) * T + tcol; bf16* pb = pf + (size_t)RW * T;
                    *(GAS v4u*)pf = pack8(f1[0], f1[1]); *(GAS v4u*)(pf + (size_t)128 * T) = pack8(f2[0], f2[1]);
                    *(GAS v4u*)pb = pack8(b1[0], b1[1]); *(GAS v4u*)(pb + (size_t)128 * T) = pack8(b2[0], b2[1]);
                }
            }
        } else {
            const int h = pm - 4;
#pragma unroll
            EPI_LOOP_AM { const int dv = 128 * ai + 64 * wr + 16 * m + fr; const float swr = swin[u.p2 + dv];
#pragma unroll
                for (int bj = 0; bj < 2; ++bj) { f32x4 v0, v1;
#pragma unroll
                    for (int j = 0; j < 4; ++j) { v0[j] = (float)acc[ai][bj][m][0][j] * (swr * sxc[bj][0][j]); v1[j] = (float)acc[ai][bj][m][1][j] * (swr * sxc[bj][1][j]); }
                    *(GAS v4u*)(Bcat + ((size_t)(h * NCH + n_ch) * 256 + dv) * CAT + 128 * bj + c0) = pack8(v0, v1); } }
        }
    }
};
struct EpiS1 {
    static constexpr bool PERM = true;
    bf16* A1;
    __device__ __forceinline__ void operator()(Acc& acc, const Unit& u, LAS unsigned char*, int wr, int wc, int fr, int fq) const {
        const int b0 = wc * 32 + 8 * fq;
#pragma unroll
        for (int m = 0; m < 4; ++m) { const int k1 = 64 * wr + 16 * m + fr;
#pragma unroll
            for (int bj = 0; bj < 2; ++bj) { const int cch = 2 * u.p1 + bj; f32x4 re[2], im[2];
#pragma unroll
                for (int n = 0; n < 2; ++n)
#pragma unroll
                    for (int j = 0; j < 4; ++j) { const int b = b0 + 4 * n + j; float c, s; cs_rev((float)(k1 * b) * (1.f / 16384.f), c, s);
                        const float xr = acc[0][bj][m][n][j], xi = acc[1][bj][m][n][j]; re[n][j] = xr * c + xi * s; im[n][j] = xi * c - xr * s; }
                bf16* p = A1 + (((size_t)k1 * 1024 + cch) * 2) * 128 + b0;
                *(GAS v4u*)p = pack8(re[0], re[1]); *(GAS v4u*)(p + 128) = pack8(im[0], im[1]); EPI_FENCE; } }
    }
};
struct EpiS2 {
    static constexpr bool PERM = true;
    bf16* Zt;
    __device__ __forceinline__ void operator()(Acc& acc, const Unit& u, LAS unsigned char*, int wr, int wc, int fr, int fq) const {
        const int k1 = u.p1 >> 2, cb = (u.p1 & 3) * 256, c0 = wc * 32 + 8 * fq;
#pragma unroll
        EPI_LOOP_AM { const int k2 = 64 * wr + 16 * m + fr, k = k1 + 128 * k2;
#pragma unroll
            for (int bj = 0; bj < 2; ++bj) { const int cch = cb + 128 * bj + c0, g = cch >> 7, cg = cch & 127;
                *(GAS v4u*)(Zt + (size_t)k * 2048 + g * 256 + ai * 128 + cg) = pack8(acc[ai][bj][m][0], acc[ai][bj][m][1]); } }
    }
};
struct EpiChan {
    static constexpr bool PERM = true;
    bf16* y;
    __device__ __forceinline__ void operator()(Acc& acc, const Unit& u, LAS unsigned char*, int wr, int wc, int fr, int fq) const {
        const int l0 = wc * 32 + 8 * fq; const float norm = 6.9053396600248786e-4f;
#pragma unroll
        EPI_LOOP_AM { const int R = u.p0 * 256 + 128 * ai + 64 * wr + 16 * m + fr, k = R >> 3, g = R & 7;
            *(GAS v4u*)(y + (size_t)k * D + g * 128 + l0) = pack8(acc[ai][0][m][0] * norm, acc[ai][0][m][1] * norm); }
    }
};
struct EpiScores {
    static constexpr bool PERM = true;
    bf16* Acat; const float *dec_f, *dec_b;
    __device__ __forceinline__ void operator()(Acc& acc, const Unit& u, LAS unsigned char*, int wr, int wc, int fr, int fq) const {
        const int h = u.p0, n_ch = u.p1, c0 = wc * 32 + 8 * fq; const float lgf = -fexp(dec_f[h]), lgb = -fexp(dec_b[h]);
#pragma unroll
        EPI_LOOP_AM { const int i = 128 * ai + 64 * wr + 16 * m + fr;
#pragma unroll
            for (int bj = 0; bj < 2; ++bj) { f32x4 v[2];
#pragma unroll
                for (int n = 0; n < 2; ++n)
#pragma unroll
                    for (int j = 0; j < 4; ++j) { const int jc = 128 * bj + c0 + 4 * n + j; const float dd = (float)(i - jc); const float w = (jc <= i) ? fexp(lgf * dd) : fexp(-lgb * dd); v[n][j] = acc[ai][bj][m][n][j] * w; }
                *(GAS v4u*)(Acat + ((size_t)h * T + n_ch * 256 + i) * CAT + 128 * bj + c0) = pack8(v[0], v[1]); EPI_FENCE; } }
    }
};
struct EpiKV {
    static constexpr bool PERM = true;
    bf16* kvT;
    __device__ __forceinline__ void operator()(Acc& acc, const Unit& u, LAS unsigned char*, int wr, int wc, int fr, int fq) const {
#pragma unroll
        EPI_LOOP_AM { const int dv = 128 * ai + 64 * wr + 16 * m + fr; bf16* rowp = kvT + (((size_t)u.p0 * NCH + u.p1) * 256 + dv) * 256 + wc * 32 + 8 * fq;
#pragma unroll
            for (int bj = 0; bj < 2; ++bj) *(GAS v4u*)(rowp + bj * 128) = pack8(acc[ai][bj][m][0], acc[ai][bj][m][1]); }
    }
};
struct EpiOut {
    static constexpr bool PERM = true;
    bf16* y; const bf16* gs; const float* gn_g;
    __device__ __forceinline__ void operator()(Acc& acc, const Unit& u, LAS unsigned char* lds, int wr, int wc, int fr, int fq) const {
        const int h = u.p0, n_ch = u.p1, c0 = wc * 32 + 8 * fq;
        LAS f32x2* P = (LAS f32x2*)(lds + LDS_STAGE);
#pragma unroll
        EPI_LOOP_AM {
            float s = 0.f;
#pragma unroll
            for (int bj = 0; bj < 2; ++bj)
#pragma unroll
                for (int n = 0; n < 2; ++n) { const f32x4 x = acc[ai][bj][m][n]; s += (x[0] + x[1]) + (x[2] + x[3]); }
            s += __shfl_xor(s, 16); s += __shfl_xor(s, 32);
            const float mw = s * (1.f / 64.f); float q = 0.f;
#pragma unroll
            for (int bj = 0; bj < 2; ++bj)
#pragma unroll
                for (int n = 0; n < 2; ++n) { const f32x4 d = acc[ai][bj][m][n] - mw; q += (d[0] * d[0] + d[1] * d[1]) + (d[2] * d[2] + d[3] * d[3]); }
            q += __shfl_xor(q, 16); q += __shfl_xor(q, 32);
            if (fq == 0) P[(128 * ai + 64 * wr + 16 * m + fr) * 4 + wc] = (f32x2){mw, q};
        }
        LDS_WAIT(); __builtin_amdgcn_s_barrier(); asm volatile("" ::: "memory");
#pragma unroll
        EPI_LOOP_AM {
            const int r = 128 * ai + 64 * wr + 16 * m + fr, tok = n_ch * 256 + r;
            const f32x2 a = P[r * 4 + 0], b = P[r * 4 + 1], c = P[r * 4 + 2], d = P[r * 4 + 3];
            const float mt = (a.x + b.x + c.x + d.x) * 0.25f; const float da = a.x - mt, db = b.x - mt, dc = c.x - mt, dd = d.x - mt;
            const float m2 = (a.y + b.y) + (c.y + d.y) + 64.f * ((da * da + db * db) + (dc * dc + dd * dd));
            const float rstd = 1.f / sqrtf(m2 * (1.f / 256.f) + GN_EPS);
#pragma unroll
            for (int bj = 0; bj < 2; ++bj) {
                const int col = h * HD + 128 * bj + c0; const v4u gv = *(const GAS v4u*)(gs + (size_t)tok * RW + col);
                const f32x4 g0 = *(const GAS f32x4*)(gn_g + col), g1 = *(const GAS f32x4*)(gn_g + col + 4);
                f32x4 o0 = (acc[ai][bj][m][0] - mt) * rstd * g0, o1 = (acc[ai][bj][m][1] - mt) * rstd * g1;
                o0[0] *= bf_lo(gv.x); o0[1] *= bf_hi(gv.x); o0[2] *= bf_lo(gv.y); o0[3] *= bf_hi(gv.y); o1[0] *= bf_lo(gv.z); o1[1] *= bf_hi(gv.z); o1[2] *= bf_lo(gv.w); o1[3] *= bf_hi(gv.w);
                *(GAS v4u*)(y + (size_t)tok * D + FW + col) = pack8(o0, o1); }
        }
        LDS_WAIT(); __builtin_amdgcn_s_barrier(); asm volatile("" ::: "memory");
    }
};
struct EpiWout {
    static constexpr bool PERM = true;
    bf16* z1; const float *x, *st0, *g0, *b0;
    __device__ __forceinline__ void operator()(Acc& acc, const Unit& u, LAS unsigned char*, int wr, int wc, int fr, int fq) const {
        const int colb = u.p1 * 256 + wc * 32 + 8 * fq;
#pragma unroll
        for (int bj = 0; bj < 2; ++bj) { const int col = colb + bj * 128;
            const f32x4 ga = *(const GAS f32x4*)(g0 + col), gb = *(const GAS f32x4*)(g0 + col + 4), ba = *(const GAS f32x4*)(b0 + col), bb = *(const GAS f32x4*)(b0 + col + 4);
#pragma unroll
            EPI_LOOP_AM { const int row = u.p0 * 256 + 128 * ai + 64 * wr + 16 * m + fr; const f32x2 st = *(const GAS f32x2*)(st0 + 2 * row); const size_t off = (size_t)row * D + col;
                const f32x4 xa = *(const GAS f32x4*)(x + off), xb = *(const GAS f32x4*)(x + off + 4);
                *(GAS v4u*)(z1 + off) = pack8(((xa - st.x) * st.y * ga + ba) * ALPHA + acc[ai][bj][m][0], ((xb - st.x) * st.y * gb + bb) * ALPHA + acc[ai][bj][m][1]); } }
    }
};
struct EpiUp {
    static constexpr bool PERM = true;
    bf16* act; unsigned* rmax;
    __device__ __forceinline__ void operator()(AccI& acc, const Unit& u, LAS unsigned char* lds, int wr, int wc, int fr, int fq) const {
        const int rt = u.p0, pn = u.p1, c0 = pn * 128 + wc * 32 + 8 * fq;
        const LAS float* blk = (const LAS float*)(lds + LDS_STAGE + u.q * 4096);
        float sx[2][4], rm[2][4];
#pragma unroll
        EPI_LOOP_AM { sx[ai][m] = blk[256 + 128 * ai + 64 * wr + 16 * m + fr]; rm[ai][m] = 0.f; }
#pragma unroll
        for (int n = 0; n < 2; ++n) {
            const int cc = wc * 32 + 8 * fq + 4 * n;
            const f32x4 sg = *(const LAS f32x4*)(blk + 512 + cc), sl = *(const LAS f32x4*)(blk + 512 + 128 + cc), bg = *(const LAS f32x4*)(blk + 768 + cc), bl = *(const LAS f32x4*)(blk + 768 + 128 + cc);
#pragma unroll
            EPI_LOOP_AM { const int r = 128 * ai + 64 * wr + 16 * m + fr; f32x2 v2[2];
#pragma unroll
                for (int jp = 0; jp < 2; ++jp) {
                    const f32x2 sx2 = (f32x2){sx[ai][m], sx[ai][m]};
                    f32x2 gl = (f32x2){(float)acc[ai][0][m][n][2 * jp], (float)acc[ai][0][m][n][2 * jp + 1]} * (sx2 * (f32x2){sg[2 * jp], sg[2 * jp + 1]}) + (f32x2){bg[2 * jp], bg[2 * jp + 1]};
                    f32x2 li = (f32x2){(float)acc[ai][1][m][n][2 * jp], (float)acc[ai][1][m][n][2 * jp + 1]} * (sx2 * (f32x2){sl[2 * jp], sl[2 * jp + 1]}) + (f32x2){bl[2 * jp], bl[2 * jp + 1]};
                    gl = __builtin_elementwise_min(gl, (f32x2){7.f, 7.f}); li = __builtin_elementwise_min(__builtin_elementwise_max(li, (f32x2){-7.f, -7.f}), (f32x2){7.f, 7.f});
                    const f32x2 ea = gl * (-1.702f * 1.4426950408889634f); f32x2 den; den.x = __builtin_amdgcn_exp2f(ea.x); den.y = __builtin_amdgcn_exp2f(ea.y); den = den + 1.0f;
                    f32x2 rc; rc.x = __builtin_amdgcn_rcpf(den.x); rc.y = __builtin_amdgcn_rcpf(den.y);
                    v2[jp] = (gl * rc) * (li + 1.0f); }
                rm[ai][m] = fmaxf(rm[ai][m], fmaxf(fmaxf(fabsf(v2[0].x), fabsf(v2[0].y)), fmaxf(fabsf(v2[1].x), fabsf(v2[1].y))));
                v2u w; w.x = cvt_pk_bf16(v2[0].x, v2[0].y); w.y = cvt_pk_bf16(v2[1].x, v2[1].y);
                *(GAS v2u*)(act + ((size_t)rt * 256 + r) * DFF + c0 + 4 * n) = w; }
        }
#pragma unroll
        EPI_LOOP_AM { float q = rm[ai][m]; q = fmaxf(q, __shfl_xor(q, 16)); q = fmaxf(q, __shfl_xor(q, 32));
            if (fq == 0) __hip_atomic_fetch_max(rmax + rt * 256 + 128 * ai + 64 * wr + 16 * m + fr, __float_as_uint(q), RLX_AGENT); }
    }
};
struct EpiDown {
    static constexpr bool PERM = true;
    bf16* yr;
    __device__ __forceinline__ void operator()(AccI& acc, const Unit& u, LAS unsigned char* lds, int wr, int wc, int fr, int fq) const {
        const int rt = u.p0, pn = u.p1, c0 = pn * 256 + wc * 32 + 8 * fq;
        const LAS float* blk = (const LAS float*)(lds + LDS_STAGE + u.q * 4096);
        float sr[2][4];
#pragma unroll
        EPI_LOOP_AM sr[ai][m] = blk[128 * ai + 64 * wr + 16 * m + fr];
#pragma unroll
        for (int bj = 0; bj < 2; ++bj) { const int cc = 128 * bj + wc * 32 + 8 * fq;
            const f32x4 w0 = *(const LAS f32x4*)(blk + 256 + cc), w1 = *(const LAS f32x4*)(blk + 256 + cc + 4), b0 = *(const LAS f32x4*)(blk + 512 + cc), b1 = *(const LAS f32x4*)(blk + 512 + cc + 4);
#pragma unroll
            EPI_LOOP_AM { const int r = 128 * ai + 64 * wr + 16 * m + fr; f32x4 o0, o1;
#pragma unroll
                for (int jp = 0; jp < 2; ++jp) { const f32x2 s2 = (f32x2){sr[ai][m], sr[ai][m]};
                    const f32x2 a = (f32x2){(float)acc[ai][bj][m][0][2 * jp], (float)acc[ai][bj][m][0][2 * jp + 1]} * (s2 * (f32x2){w0[2 * jp], w0[2 * jp + 1]}) + (f32x2){b0[2 * jp], b0[2 * jp + 1]};
                    const f32x2 b = (f32x2){(float)acc[ai][bj][m][1][2 * jp], (float)acc[ai][bj][m][1][2 * jp + 1]} * (s2 * (f32x2){w1[2 * jp], w1[2 * jp + 1]}) + (f32x2){b1[2 * jp], b1[2 * jp + 1]};
                    o0[2 * jp] = a.x; o0[2 * jp + 1] = a.y; o1[2 * jp] = b.x; o1[2 * jp + 1] = b.y; }
                *(GAS v4u*)(yr + ((size_t)rt * 256 + r) * D + c0 + 128 * bj) = pack8(o0, o1); } }
    }
};

__device__ __forceinline__ void p3_scan(Frame& F) {
    const bf16* kvT = WSP(bf16, WS_KVT); bf16* Bcat = WSP(bf16, WS_BCAT);
    const int NQ = 2 * NH * 256 * 64;
    for (int q = F.vcu * NTHR + F.tid; q < NQ; q += F.G * NTHR) {
        const int dk4 = q & 63, dv = (q >> 6) & 255, dh = q >> 14, dir = dh >> 2, h = dh & 3;
        const float lg = -fexp((dir ? F.dec_b : F.dec_f)[h]); const float cd = fexp(lg * (float)C2);
        f32x4 S = (f32x4){0.f, 0.f, 0.f, 0.f};
        for (int s = 0; s < NCH; ++s) { const int n = dir ? (NCH - 1 - s) : s;
            const v2u kw = *(const GAS v2u*)(kvT + (((size_t)dh * NCH + n) * 256 + dv) * 256 + dk4 * 4); const f32x4 kv = (f32x4){bf_lo(kw.x), bf_hi(kw.x), bf_lo(kw.y), bf_hi(kw.y)};
            v2u w; w.x = cvt_pk_bf16(S[0], S[1]); w.y = cvt_pk_bf16(S[2], S[3]);
            *(GAS v2u*)(Bcat + ((size_t)(h * NCH + n) * 256 + dv) * CAT + 256 + dir * 256 + dk4 * 4) = w;
            S = S * cd + kv; }
    }
}

__device__ __forceinline__ void p6_router(Frame& F) {
    const bf16* z1 = WSP(bf16, WS_Z1); unsigned* h1q = WSP(unsigned, WS_H1Q); float* sxg = WSP(float, WS_SX); float* rsc = WSP(float, WS_RSC); float* st1 = WSP(float, WS_ST0) + 2 * T;
    int* topi = WSP(int, WS_RT); float* gate = (float*)(topi + 4 * T); int* posb = (int*)(gate + 4 * T); int* row_tok = posb + 4 * T;
    LAS float* hc = (LAS float*)F.lds;
    LAS float* wrc = hc + 64 * 257;
    LAS float* stl = wrc + 256 * 32;
    LAS float* lg = stl + 128;
    LAS int* hist = (LAS int*)(lg + 64 * 33);
    LAS float* sxl = (LAS float*)(hist + 64);
    for (int blk = F.vcu; blk < T / 64; blk += F.G) {
        const int t0 = blk * 64;
#pragma unroll 1
        for (int bt = 0; bt < 2; ++bt) {
            v2u raw[4][8];
#pragma unroll
            for (int rr = 0; rr < 4; ++rr) { const GAS v2u* xr = (const GAS v2u*)(z1 + (size_t)(t0 + F.wave * 8 + bt * 4 + rr) * D) + F.lane;
#pragma unroll
                for (int j = 0; j < 8; ++j) raw[rr][j] = xr[64 * j]; }
#pragma unroll
            for (int rr = 0; rr < 4; ++rr) { const int row = F.wave * 8 + bt * 4 + rr, m = t0 + row;
                f32x4 v[8]; float s = 0.f;
#pragma unroll
                for (int j = 0; j < 8; ++j) { const v2u w = raw[rr][j]; v[j] = (f32x4){bf_lo(w.x), bf_hi(w.x), bf_lo(w.y), bf_hi(w.y)}; s += (v[j][0] + v[j][1]) + (v[j][2] + v[j][3]); }
                const float mean = wave_sum(s) * (1.f / D); float s2 = 0.f;
#pragma unroll
                for (int j = 0; j < 8; ++j) { v[j] = v[j] - mean; s2 += (v[j][0] * v[j][0] + v[j][1] * v[j][1]) + (v[j][2] * v[j][2] + v[j][3] * v[j][3]); }
                const float rstd = 1.f / sqrtf(wave_sum(s2) * (1.f / D) + LN_EPS);
                float am = 0.f;
#pragma unroll
                for (int j = 0; j < 8; ++j) { const f32x4 g = *((const GAS f32x4*)F.ln1_g + F.lane + 64 * j), b = *((const GAS f32x4*)F.ln1_b + F.lane + 64 * j);
                    v[j] = v[j] * rstd * g + b; am = fmaxf(am, fmaxf(fmaxf(fabsf(v[j][0]), fabsf(v[j][1])), fmaxf(fabsf(v[j][2]), fabsf(v[j][3])))); }
#pragma unroll
                for (int o = 1; o < 64; o <<= 1) am = fmaxf(am, __shfl_xor(am, o));
                const float sc = am > 0.f ? am * (1.f / 127.f) : 1.f, inv = 1.f / sc;
#pragma unroll
                for (int j = 0; j < 8; ++j) { const int q0 = (int)__builtin_rintf(v[j][0] * inv), q1 = (int)__builtin_rintf(v[j][1] * inv), q2 = (int)__builtin_rintf(v[j][2] * inv), q3 = (int)__builtin_rintf(v[j][3] * inv);
                    h1q[(size_t)m * (D / 4) + F.lane + 64 * j] = (unsigned)(q0 & 0xff) | ((unsigned)(q1 & 0xff) << 8) | ((unsigned)(q2 & 0xff) << 16) | ((unsigned)(q3 & 0xff) << 24); }
                if (F.lane == 0) { st1[2 * m] = mean; st1[2 * m + 1] = rstd; stl[2 * row] = mean; stl[2 * row + 1] = rstd; sxg[m] = sc; sxl[row] = sc; }
            }
        }
        if (F.tid < 64) hist[F.tid] = 0;
        __syncthreads();
        const int row = F.tid >> 3, e0 = (F.tid & 7) * 4; f32x4 accl = (f32x4){0.f, 0.f, 0.f, 0.f};
        v2u zp[8]; f32x4 wp[4];
#define P6_LOAD(kc_) do { _Pragma("unroll") for (int i_ = 0; i_ < 8; ++i_) { const int q_ = F.tid + NTHR * i_, r_ = q_ >> 6, c4_ = (q_ & 63) * 4; zp[i_] = *(const GAS v2u*)(z1 + (size_t)(t0 + r_) * D + (kc_) * 256 + c4_); } \
        _Pragma("unroll") for (int i_ = 0; i_ < 4; ++i_) { const int q_ = F.tid + NTHR * i_, k_ = q_ >> 3, c4_ = (q_ & 7) * 4; wp[i_] = *(const GAS f32x4*)(F.w_r + (size_t)((kc_) * 256 + k_) * NE + c4_); } } while (0)
        P6_LOAD(0);
        for (int kc = 0; kc < 8; ++kc) {
#pragma unroll
            for (int i = 0; i < 8; ++i) { const int q = F.tid + NTHR * i, r = q >> 6, c4 = (q & 63) * 4, col = kc * 256 + c4; const v2u zw = zp[i];
                const f32x4 zv = (f32x4){bf_lo(zw.x), bf_hi(zw.x), bf_lo(zw.y), bf_hi(zw.y)}, g = *(const GAS f32x4*)(F.ln1_g + col), b = *(const GAS f32x4*)(F.ln1_b + col);
                const f32x4 hh = (zv - stl[2 * r]) * stl[2 * r + 1] * g + b; LAS float* d = hc + r * 257 + c4; d[0] = hh[0]; d[1] = hh[1]; d[2] = hh[2]; d[3] = hh[3]; }
#pragma unroll
            for (int i = 0; i < 4; ++i) { const int q = F.tid + NTHR * i, k = q >> 3, c4 = (q & 7) * 4; *(LAS f32x4*)(wrc + k * 32 + c4) = wp[i]; }
            __syncthreads();
            if (kc + 1 < 8) P6_LOAD(kc + 1);
#pragma unroll 8
            for (int k = 0; k < 256; ++k) { const float hv = hc[row * 257 + k]; const f32x4 w = *(const LAS f32x4*)(wrc + k * 32 + e0); accl = accl + w * hv; }
            __syncthreads();
        }
#undef P6_LOAD
        { const f32x4 br = *(const GAS f32x4*)(F.b_r + e0); LAS float* d = lg + row * 33 + e0; d[0] = accl[0] + br[0]; d[1] = accl[1] + br[1]; d[2] = accl[2] + br[2]; d[3] = accl[3] + br[3]; }
        __syncthreads();
        int ek[4] = {0, 0, 0, 0}, lp[4] = {0, 0, 0, 0}; float gk[4] = {0.f, 0.f, 0.f, 0.f};
        if (F.tid < 64) {
            float lv[4]; unsigned used = 0u;
#pragma unroll
            for (int k = 0; k < 4; ++k) { float best = -3.0e38f; int bi = 0;
                for (int e = 0; e < NE; ++e) { const float v = lg[F.tid * 33 + e]; const bool ok = !((used >> e) & 1u) && (v > best); best = ok ? v : best; bi = ok ? e : bi; }
                used |= 1u << bi; ek[k] = bi; lv[k] = best; }
            const float mx = lv[0]; float den = 0.f;
#pragma unroll
            for (int k = 0; k < 4; ++k) { gk[k] = fexp(lv[k] - mx); den += gk[k]; }
            const float rd = 1.f / den;
#pragma unroll
            for (int k = 0; k < 4; ++k) { gk[k] *= rd; lp[k] = __hip_atomic_fetch_add(&hist[ek[k]], 1, __ATOMIC_RELAXED, __HIP_MEMORY_SCOPE_WORKGROUP); }
        }
        __syncthreads();
        if (F.tid < NE) hist[32 + F.tid] = (int)__hip_atomic_fetch_add(F.ctl + CW_CNT + 64 * F.tid, (unsigned)hist[F.tid], RLX_AGENT);
        __syncthreads();
        if (F.tid < 64) { const int tok = t0 + F.tid;
#pragma unroll
            for (int k = 0; k < 4; ++k) { const int pos = hist[32 + ek[k]] + lp[k]; row_tok[(size_t)ek[k] * T + pos] = tok; rsc[(size_t)ek[k] * T + pos] = sxl[F.tid]; topi[4 * tok + k] = ek[k]; gate[4 * tok + k] = gk[k]; posb[4 * tok + k] = pos; } }
        __syncthreads();
    }
}

__device__ __forceinline__ void build_units(Frame& F, LAS int* tstart, int nN, int c) {
    __syncthreads();
    if (F.tid < 64) { const int RT = tstart[NE], L = F.tid * F.G + c; int w = -1;
        if (L < RT * nN) { int rt, pn; gm::tile_order(L, RT, nN, rt, pn); w = rt | (pn << 10) | (tstart[40 + rt] << 15); }
        tstart[400 + F.tid] = w; }
    __syncthreads();
}

__device__ __forceinline__ void p8_requant(Frame& F, const LAS int* tstart) {
    const bf16* act = WSP(bf16, WS_ACT); unsigned* aq = WSP(unsigned, WS_ACTQ); float* sa = WSP(float, WS_SA); const unsigned* rmax = F.ctl + CW_RMAX;
    const int R = tstart[NE] * 256, gw = F.vcu * NWAVES + F.wave, NGW = F.G * NWAVES;
    for (int row = gw; row < R; row += NGW) {
        const float mx = __uint_as_float(rmax[row]); const float sc = mx > 0.f ? mx * (1.f / 127.f) : 1.f, inv = 1.f / sc;
#pragma unroll
        for (int j = 0; j < 2; ++j) { const int col = 16 * F.lane + 1024 * j;
            const v4u a = *(const GAS v4u*)(act + (size_t)row * DFF + col), b = *(const GAS v4u*)(act + (size_t)row * DFF + col + 8);
            const unsigned src[8] = {a.x, a.y, a.z, a.w, b.x, b.y, b.z, b.w}; unsigned o[4];
#pragma unroll
            for (int d = 0; d < 4; ++d) { unsigned w = 0u;
#pragma unroll
                for (int h2 = 0; h2 < 2; ++h2) { const unsigned u2 = src[2 * d + h2]; int q0 = (int)__builtin_rintf(bf_lo(u2) * inv), q1 = (int)__builtin_rintf(bf_hi(u2) * inv);
                    q0 = q0 > 127 ? 127 : (q0 < -127 ? -127 : q0); q1 = q1 > 127 ? 127 : (q1 < -127 ? -127 : q1);
                    w |= ((unsigned)(q0 & 0xff) << (16 * h2)) | ((unsigned)(q1 & 0xff) << (16 * h2 + 8)); }
                o[d] = w; }
            *(GAS v4u*)(aq + ((size_t)row * DFF + col) / 4) = (v4u){o[0], o[1], o[2], o[3]}; }
        if (F.lane == 0) sa[row] = sc;
    }
}

__device__ __forceinline__ void build_tstart(Frame& F, LAS int* tstart) {
    if (F.tid == 0) { int s = 0; for (int e = 0; e < NE; ++e) { tstart[e] = s; const unsigned n = __hip_atomic_load(F.ctl + CW_CNT + 64 * e, RLX_AGENT); s += (int)((n + 255u) >> 8); } tstart[NE] = s; }
    __syncthreads();
    for (int rt = F.tid; rt < RT_MAX; rt += NTHR) { int e = 0; for (int j = 1; j < NE; ++j) e += (tstart[j] <= rt) ? 1 : 0; tstart[40 + rt] = e; }
    __syncthreads();
}

__device__ __forceinline__ void p9_combine(Frame& F, const LAS int* tstart) {
    const bf16* z1 = WSP(bf16, WS_Z1); const float* st1 = WSP(float, WS_ST0) + 2 * T; const bf16* yr = WSP(bf16, WS_YR);
    const int* topi = WSP(int, WS_RT); const float* gate = (const float*)(topi + 4 * T); const int* posb = (const int*)(gate + 4 * T);
    const int gw = F.vcu * NWAVES + F.wave, NGW = F.G * NWAVES;
    for (int m = gw; m < T; m += NGW) {
        const float mean1 = st1[2 * m], rstd1 = st1[2 * m + 1];
        size_t ro[4]; float gk[4];
#pragma unroll
        for (int k = 0; k < 4; ++k) { const int e = topi[4 * m + k]; ro[k] = ((size_t)tstart[e] * 256 + posb[4 * m + k]) * D; gk[k] = gate[4 * m + k]; }
        f32x4 v[8]; float s = 0.f;
#pragma unroll
        for (int j = 0; j < 8; ++j) { const int col = 4 * F.lane + 256 * j;
            const v2u zw = *(const GAS v2u*)(z1 + (size_t)m * D + col); const f32x4 zv = (f32x4){bf_lo(zw.x), bf_hi(zw.x), bf_lo(zw.y), bf_hi(zw.y)}, g = *(const GAS f32x4*)(F.ln1_g + col), b = *(const GAS f32x4*)(F.ln1_b + col);
            f32x4 a = ((zv - mean1) * rstd1 * g + b) * ALPHA;
#pragma unroll
            for (int k = 0; k < 4; ++k) { const v2u w = *(const GAS v2u*)(yr + ro[k] + col); a[0] += gk[k] * bf_lo(w.x); a[1] += gk[k] * bf_hi(w.x); a[2] += gk[k] * bf_lo(w.y); a[3] += gk[k] * bf_hi(w.y); }
            v[j] = a; s += (a[0] + a[1]) + (a[2] + a[3]); }
        const float mean = wave_sum(s) * (1.f / D); float s2 = 0.f;
#pragma unroll
        for (int j = 0; j < 8; ++j) { v[j] = v[j] - mean; s2 += (v[j][0] * v[j][0] + v[j][1] * v[j][1]) + (v[j][2] * v[j][2] + v[j][3] * v[j][3]); }
        const float rstd = 1.f / sqrtf(wave_sum(s2) * (1.f / D) + LN_EPS);
#pragma unroll
        for (int j = 0; j < 8; ++j) { const int col = 4 * F.lane + 256 * j; const f32x4 g = *(const GAS f32x4*)(F.ln2_g + col), b = *(const GAS f32x4*)(F.ln2_b + col);
            *(GAS f32x4*)(F.out + (size_t)m * D + col) = v[j] * rstd * g + b; }
    }
}

constexpr int NPH = 11;
__global__ void __launch_bounds__(NTHR, 2) fwd(Args args) {
    extern __shared__ __attribute__((aligned(16))) unsigned char lds_raw[];
    Frame F;
    F.lds = (LAS unsigned char*)lds_raw; F.ws = args.ws; F.ctl = (unsigned*)(args.ws + WS_CTL);
    F.tid = threadIdx.x; F.lane = F.tid & 63; F.wave = __builtin_amdgcn_readfirstlane(F.tid >> 6);
    F.G = gridDim.x; { const int bx = blockIdx.x; F.vcu = (F.G % 8 == 0) ? (bx % 8) * (F.G / 8) + bx / 8 : bx; }
    F.x = args.in[0]; F.ln0_g = args.in[1]; F.ln0_b = args.in[2]; F.w_in = args.in[3]; F.dec_f = args.in[4]; F.dec_b = args.in[5]; F.gn_g = args.in[6]; F.w_out = args.in[7];
    F.ln1_g = args.in[8]; F.ln1_b = args.in[9]; F.w_r = args.in[10]; F.b_r = args.in[11]; F.w_up = args.in[12]; F.b_up = args.in[13]; F.w_dn = args.in[14]; F.b_dn = args.in[15];
    F.ln2_g = args.in[16]; F.ln2_b = args.in[17]; F.out = args.out;
    volatile LAS unsigned* lctl = (volatile LAS unsigned*)(F.lds + LDS_CTL_OFF);
    LAS int* tstart = (LAS int*)(F.lds + LDS_CTL_OFF + 64);
    for (int u = F.tid; u < 128; u += NTHR) lctl[u] = 0u;
    __syncthreads();
    const int lo = args.ph_lo, hi = args.ph_hi;
    const bool single = (hi - lo) > 1;
    XcdBarrier bar; bar.bar = F.ctl + CW_BAR; bar.x = 0; bar.st = lctl;
    if (single) bar = xcd_barrier_post(F.ctl + CW_BAR, lctl);
#ifndef PH_MASK
#define PH_MASK 0x7ff
#endif
#define IN(k) (((PH_MASK >> (k)) & 1) && lo <= (k) && (k) < hi)
#ifndef SUB_MASK
#define SUB_MASK 0xff
#endif
#define SUB(n) ((SUB_MASK >> (n)) & 1)
#define SEAM(k) do { if (IN(k) && IN((k) + 1)) xcd_barrier(bar); } while (0)
    const int bc = (int)blockIdx.x;

    const int nS = (NE * 128 + F.G - 1) / F.G + (NE * 64 + F.G - 1) / F.G; int sdone = 0; const int qgrp = (int)(blockIdx.x >> 3);
#define QSLOT(k24) do { const int e_ = sdone + (nS * (k24) + 23) / 24; do_slabs(F, sdone, e_ < nS ? e_ : nS); sdone = e_; } while (0)
#define QG(slot, nslots, k24) do { if (qgrp % (nslots) == (slot)) QSLOT(k24); } while (0)
    if (IN(0)) { p0_prologue(F); __syncthreads(); { const int nW = (DIN / 32 + F.G - 1) / F.G; do_slabs(F, -nW, 0); } }
    SEAM(0);
    if (IN(1)) {
        QG(0, 4, 9);
        if (SUB(0)) { SchedG1N S; S.nt = D / 128; S.pitchA = D / 2; S.pitchB = D / 2; S.multA = 1; S.multB = 1; S.G = F.G; S.c = bc; S.A = (const char*)WSP(bf16, WS_H0B); S.Bt = (const char*)WSP(bf16, WS_WIN);
          EpiG1N E{WSP(bf16, WS_QS), WSP(bf16, WS_KK), WSP(bf16, WS_GS), WSP(bf16, WS_ACAT), F.dec_f, F.dec_b, WSP(float, WS_SX0), WSP(float, WS_SWIN)};
          gm::gemm_run<EpiG1N, SchedG1N, false, true>(F.lds, S, E); }
        QG(1, 4, 9);
        if (SUB(1)) { SchedG1SF S; S.nt = D / 128; S.pitchA = D / 2; S.pitchB = D / 2; S.multA = 1; S.multB = 128; S.G = F.G; S.c = bc; S.A = (const char*)WSP(bf16, WS_WIN); S.Bt = (const char*)WSP(bf16, WS_H0B);
          EpiG1SF E{WSP(bf16, WS_UTT), WSP(float, WS_SX0), WSP(float, WS_SWIN)};
          gm::gemm_run<EpiG1SF, SchedG1SF, false, true>(F.lds, S, E); }
        QG(2, 4, 9);
        if (SUB(2)) { SchedG1SKV S; S.nt = D / 128; S.pitchA = D / 2; S.pitchB = D / 2; S.multA = 1; S.multB = 1; S.G = F.G; S.c = bc; S.A = (const char*)WSP(bf16, WS_WIN); S.Bt = (const char*)WSP(bf16, WS_H0B);
          EpiG1SKV E{WSP(bf16, WS_KTW), WSP(bf16, WS_BCAT), F.dec_f, F.dec_b, WSP(float, WS_SX0), WSP(float, WS_SWIN)};
          gm::gemm_run<EpiG1SKV, SchedG1SKV, false, true>(F.lds, S, E); }
        QG(3, 4, 9);
    }
    SEAM(1);
    if (IN(2)) {
        QG(0, 4, 6);
        if (SUB(3)) { SchedFixA S; S.nt = 2; S.pitchA = 128; S.pitchB = 128; S.multA = 1; S.multB = 1; S.G = F.G; S.c = bc; S.A = (const char*)WSP(bf16, WS_TAB); S.Bt = (const char*)WSP(bf16, WS_UTT); S.ncol = 512;
          EpiS1 E{WSP(bf16, WS_A1)};
          gm::gemm_run<EpiS1, SchedFixA, false>(F.lds, S, E); }
        QG(1, 4, 6);
        if (SUB(4)) { SchedScores S; S.nt = 4; S.pitchA = RW; S.pitchB = RW; S.multA = 1; S.multB = 1; S.G = F.G; S.c = bc; S.Q = (const char*)WSP(bf16, WS_QS); S.Kk = (const char*)WSP(bf16, WS_KK);
          EpiScores E{WSP(bf16, WS_ACAT), F.dec_f, F.dec_b};
          gm::gemm_run<EpiScores, SchedScores, false>(F.lds, S, E); }
        QG(2, 4, 6);
        if (SUB(5)) { SchedKV S; S.nt = 4; S.pitchA = CAT; S.pitchB = T; S.multA = 1; S.multB = 1; S.G = F.G; S.c = bc; S.Bcat = (const char*)WSP(bf16, WS_BCAT); S.kTw = (const char*)WSP(bf16, WS_KTW);
          EpiKV E{WSP(bf16, WS_KVT)};
          gm::gemm_run<EpiKV, SchedKV, false>(F.lds, S, E); }
        QG(3, 4, 6);
    }
    SEAM(2);
    if (IN(3)) {
        QG(0, 3, 2);
        { SchedFixA S; S.nt = 4; S.pitchA = 256; S.pitchB = 256; S.multA = 1; S.multB = 1; S.G = F.G; S.c = bc; S.A = (const char*)(WSP(bf16, WS_TAB) + 32768); S.Bt = (const char*)WSP(bf16, WS_A1); S.ncol = 512;
          EpiS2 E{WSP(bf16, WS_ZT)};
          gm::gemm_run<EpiS2, SchedFixA, false>(F.lds, S, E); }
        QG(1, 3, 2);
        p3_scan(F);
        QG(2, 3, 2);
    }
    SEAM(3);
    if (IN(4)) {
        QG(0, 3, 4);
        { SchedFixB S; S.nt = 4; S.pitchA = 256; S.pitchB = 256; S.multA = 1; S.multB = 1; S.G = F.G; S.c = bc; S.A = (const char*)WSP(bf16, WS_ZT); S.Bt = (const char*)(WSP(bf16, WS_TAB) + 32768 + 65536); S.nrow = 512;
          EpiChan E{WSP(bf16, WS_Y)};
          gm::gemm_run<EpiChan, SchedFixB, false>(F.lds, S, E); }
        QG(1, 3, 4);
        { SchedOut S; S.nt = CAT / 64; S.pitchA = CAT; S.pitchB = CAT; S.multA = 1; S.multB = 1; S.G = F.G; S.c = bc; S.Acat = (const char*)WSP(bf16, WS_ACAT); S.Bcat = (const char*)WSP(bf16, WS_BCAT);
          EpiOut E{WSP(bf16, WS_Y), WSP(bf16, WS_GS), F.gn_g};
          gm::gemm_run<EpiOut, SchedOut, false>(F.lds, S, E); }
        QG(2, 3, 4);

    }
    SEAM(4);
    if (IN(5)) {
        QG(0, 2, 3);
        Sched2D S; S.nt = D / 64; S.pitchA = D; S.pitchB = D; S.multA = 1; S.multB = 1; S.G = F.G; S.c = bc; S.A = (const char*)WSP(bf16, WS_Y); S.Bt = (const char*)WSP(bf16, WS_WOUT); S.nM = 64; S.nN = 8;
        EpiWout E{WSP(bf16, WS_Z1), F.x, WSP(float, WS_ST0), F.ln0_g, F.ln0_b};
        gm::gemm_run<EpiWout, Sched2D, false>(F.lds, S, E);
        QG(1, 2, 3);
        do_slabs(F, sdone < nS ? sdone : nS, nS);
    }
    SEAM(5);
    if (IN(6)) { p6_router(F); }
    SEAM(6);
    if (IN(7) || IN(8) || IN(9) || IN(10)) build_tstart(F, tstart);
    if (IN(7)) {
        build_units(F, tstart, 16, bc);
        SchedMoEUpT S; S.nt = D / 128; S.pitchA = D / 2; S.pitchB = D / 2; S.multA = 1; S.multB = 1; S.G = F.G; S.c = bc; S.A = (const char*)WSP(char, WS_H1Q); S.Bt = (const char*)WSP(char, WS_WUP);
        S.tstart = tstart; S.row_tok = WSP(int, WS_RT) + 12 * T; S.cnt = F.ctl + CW_CNT; S.nN = 16; S.rowbytes = D; S.estride = (size_t)2 * DFF * D;
        S.rsc = WSP(float, WS_RSC); S.swup = WSP(float, WS_SWUP); S.b_up = F.b_up;
        EpiUp E{WSP(bf16, WS_ACT), F.ctl + CW_RMAX};
        gm::gemm_run<EpiUp, SchedMoEUpT, true, true, true>(F.lds, S, E);
    }
    SEAM(7);
    if (IN(8)) { p8_requant(F, tstart); }
    SEAM(8);
    if (IN(9)) {
        build_units(F, tstart, 8, bc);
        SchedMoEDown S; S.nt = DFF / 128; S.pitchA = DFF / 2; S.pitchB = DFF / 2; S.multA = 1; S.multB = 1; S.G = F.G; S.c = bc; S.A = (const char*)WSP(char, WS_ACTQ); S.Bt = (const char*)WSP(char, WS_WDN);
        S.tstart = tstart; S.row_tok = nullptr; S.cnt = F.ctl + CW_CNT; S.nN = 8; S.rowbytes = DFF; S.estride = (size_t)D * DFF;
        S.sa = WSP(float, WS_SA); S.swdn = WSP(float, WS_SWDN); S.b_dn = F.b_dn; S.rsc = nullptr; S.swup = nullptr; S.b_up = nullptr;
        EpiDown E{WSP(bf16, WS_YR)};
        gm::gemm_run<EpiDown, SchedMoEDown, false, true, true>(F.lds, S, E);
    }
    SEAM(9);
    if (IN(10)) { p9_combine(F, tstart); }
#undef IN
#undef SEAM
}

#ifndef MK_SPLIT
#define MK_SPLIT 0
#endif
extern "C" void kernel_launch(void* const* d_in, const int* in_sizes, int n_in, void* d_out, int out_size, void* d_ws, size_t ws_size, hipStream_t stream) {
    static int grid = 0;
    if (grid == 0) {
        if (n_in != 18 || out_size != T * D || ws_size < WS_END2) { fprintf(stderr, "kernel_launch: unexpected problem: n_in %d out %d ws %zu (need %zu)\n", n_in, out_size, ws_size, (size_t)WS_END2); grid = -1; return; }
        int dev = 0, cus = 0, per_cu = 0;
        if (hipGetDevice(&dev) != hipSuccess || hipDeviceGetAttribute(&cus, hipDeviceAttributeMultiprocessorCount, dev) != hipSuccess) { grid = -1; return; }
        if (hipFuncSetAttribute((const void*)fwd, hipFuncAttributeMaxDynamicSharedMemorySize, LDS_BYTES) != hipSuccess) { fprintf(stderr, "kernel_launch: hipFuncSetAttribute failed\n"); grid = -1; return; }
        if (hipOccupancyMaxActiveBlocksPerMultiprocessor(&per_cu, (const void*)fwd, NTHR, LDS_BYTES) != hipSuccess || per_cu < 1) { fprintf(stderr, "kernel_launch: occupancy query reports %d\n", per_cu); }
        (void)hipGetLastError();
        grid = cus;
    }
    if (grid < 0) return;
    (void)hipMemsetAsync((char*)d_ws + WS_CTL, 0, CTL_BYTES, stream);
    Args a{};
    for (int i = 0; i < 18; ++i) a.in[i] = (const float*)d_in[i];
    a.out = (float*)d_out; a.ws = (unsigned char*)d_ws;
#if MK_SPLIT
    for (int p = 0; p < NPH; ++p) { a.ph_lo = p; a.ph_hi = p + 1; hipLaunchKernelGGL(fwd, dim3(grid), dim3(NTHR), LDS_BYTES, stream, a); }
#else
    a.ph_lo = 0; a.ph_hi = NPH; hipLaunchKernelGGL(fwd, dim3(grid), dim3(NTHR), LDS_BYTES, stream, a);
#endif
}
```

```cpp
#include <hip/hip_runtime.h>
#include <cstdio>
#include <cstdint>

#define GAS __attribute__((address_space(1)))
#define LAS __attribute__((address_space(3)))
typedef unsigned short bf16;
typedef unsigned v4u __attribute__((ext_vector_type(4)));
typedef unsigned v2u __attribute__((ext_vector_type(2)));
typedef float f32x4 __attribute__((ext_vector_type(4)));
typedef float f32x2 __attribute__((ext_vector_type(2)));
typedef short bf16x8 __attribute__((ext_vector_type(8)));
typedef int i32x4 __attribute__((ext_vector_type(4)));
#define RLX_AGENT __ATOMIC_RELAXED, __HIP_MEMORY_SCOPE_AGENT
#define LDS_WAIT() asm volatile("s_waitcnt lgkmcnt(0)" ::: "memory")
#define VM_WAIT() asm volatile("s_waitcnt vmcnt(0)" ::: "memory")

constexpr int T = 16384, D = 2048, DIN = 5120, FW = 1024, RW = 1024, NH = 4, HD = 256, NE = 32, TOPK = 4, DFF = 2048;
constexpr int C2 = 256, NCH = T / C2;
constexpr int CAT = 768;
constexpr float LN_EPS = 1e-5f, GN_EPS = 1e-6f, ALPHA = 1.189207115002721f;
constexpr int RT_MAX = (T * TOPK) / 256 + NE;
constexpr int NWAVES = 8, NTHR = 512;

constexpr size_t MiB = 1u << 20;
constexpr size_t WS_CTL = 0, CTL_BYTES = 1 * MiB;
constexpr size_t WS_TAB = 1 * MiB;
constexpr size_t WS_WIN = 2 * MiB;
constexpr size_t WS_WOUT = WS_WIN + 20 * MiB;
constexpr size_t WS_WUP = WS_WOUT + 8 * MiB;
constexpr size_t WS_WDN = WS_WUP + 512 * MiB;
constexpr size_t WS_H0B = WS_WDN + 256 * MiB;
constexpr size_t WS_ST0 = WS_H0B + 64 * MiB;
constexpr size_t WS_UTT = WS_ST0 + 1 * MiB;
constexpr size_t WS_A1 = WS_UTT + 32 * MiB;
constexpr size_t WS_ZT = WS_A1 + 64 * MiB;
constexpr size_t WS_QS = WS_ZT + 64 * MiB;
constexpr size_t WS_KK = WS_QS + 32 * MiB;
constexpr size_t WS_GS = WS_KK + 32 * MiB;
constexpr size_t WS_ACAT = WS_GS + 32 * MiB;
constexpr size_t WS_BCAT = WS_ACAT + 96 * MiB;
constexpr size_t WS_KTW = WS_BCAT + 96 * MiB;
constexpr size_t WS_KVT = WS_KTW + 64 * MiB;
constexpr size_t WS_Y = WS_KVT + 128 * MiB;
constexpr size_t WS_Z1 = WS_Y + 64 * MiB;
constexpr size_t WS_H1B = WS_Z1 + 128 * MiB;
constexpr size_t WS_RT = WS_H1B + 64 * MiB;
constexpr size_t WS_ACT = WS_RT + 4 * MiB;
constexpr size_t WS_YR = WS_ACT + 288 * MiB;
constexpr size_t WS_END = WS_YR + 288 * MiB;
constexpr size_t WS_SWUP = WS_TAB + 512 * 1024;
constexpr size_t WS_H1Q = WS_H1B;
constexpr size_t WS_SX = WS_H1B + 32 * MiB, WS_RSC = WS_H1B + 40 * MiB, WS_SA = WS_H1B + 44 * MiB;
constexpr size_t WS_SWDN = WS_ST0 + 512 * 1024;
constexpr size_t WS_SWIN = WS_ST0 + 768 * 1024;
constexpr size_t WS_SX0 = WS_H0B + 40 * MiB;
constexpr size_t WS_ACTQ = WS_END;
constexpr size_t WS_END2 = WS_ACTQ + 144 * MiB;
constexpr int CW_RMAX = 16384;
constexpr int CW_BAR = 1024;
constexpr int CW_CNT = 8192;

constexpr int LDS_STAGE = 131072, LDS_SCR = 16384, LDS_CTL_OFF = LDS_STAGE + LDS_SCR, LDS_BYTES = LDS_CTL_OFF + 2048;

__device__ __forceinline__ unsigned cvt_pk_bf16(float lo, float hi) { unsigned r; asm volatile("v_cvt_pk_bf16_f32 %0, %1, %2" : "=v"(r) : "v"(lo), "v"(hi)); return r; }
__device__ __forceinline__ float bf_lo(unsigned u) { return __builtin_bit_cast(float, u << 16); }
__device__ __forceinline__ float bf_hi(unsigned u) { return __builtin_bit_cast(float, u & 0xffff0000u); }
__device__ __forceinline__ v4u pack8(const f32x4 a, const f32x4 b) { v4u w; w.x = cvt_pk_bf16(a[0], a[1]); w.y = cvt_pk_bf16(a[2], a[3]); w.z = cvt_pk_bf16(b[0], b[1]); w.w = cvt_pk_bf16(b[2], b[3]); return w; }
__device__ __forceinline__ float wave_sum(float v) {
#pragma unroll
    for (int o = 1; o < 64; o <<= 1) v += __shfl_xor(v, o);
    return v;
}
__device__ __forceinline__ float fexp(float x) { return __builtin_amdgcn_exp2f(x * 1.4426950408889634f); }
__device__ __forceinline__ void cs_rev(float rev, float& c, float& s) { const float f = __builtin_amdgcn_fractf(rev); c = __builtin_amdgcn_cosf(f); s = __builtin_amdgcn_sinf(f); }

#define XB_TMO      128
#define XB_XCNT(j)  (256  + 64 * (j))
#define XB_XSUB(j)  (1280 + 64 * (j))
#define XB_XGEN(j)  (2304 + 64 * (j))
#define XB_TOP      3328
#define XB_TOPGEN   3392
#define XCD_BAR_WORDS 3456
#define XB_SPIN_CAP (1u << 18)
__device__ __forceinline__ unsigned xb_ld(unsigned* p)              { return __hip_atomic_load(p, __ATOMIC_RELAXED, __HIP_MEMORY_SCOPE_AGENT); }
__device__ __forceinline__ unsigned xb_add(unsigned* p, unsigned v) { return __hip_atomic_fetch_add(p, v, __ATOMIC_RELAXED, __HIP_MEMORY_SCOPE_AGENT); }
__device__ __forceinline__ unsigned xb_xcc_id() { return (unsigned)__builtin_amdgcn_s_getreg((3 << 11) | 20) & 0xFu; }
#define XB_SPIN(cond, bar) do { unsigned _sp = 0; while (cond) { __builtin_amdgcn_s_sleep(1); \
    if ((++_sp & 255u) == 0u) { if (xb_ld(&(bar)[XB_TMO])) break; if (_sp > XB_SPIN_CAP) { atomicAdd(&(bar)[XB_TMO], 1u); break; } } } } while (0)
struct XcdBarrier { unsigned* bar; unsigned x; volatile LAS unsigned* st; };
__device__ __forceinline__ XcdBarrier xcd_barrier_post(unsigned* bar, volatile LAS unsigned* st) {
    XcdBarrier b; b.bar = bar; b.x = xb_xcc_id(); b.st = st;
    if (threadIdx.x == 0) (void)xb_add(&bar[XB_XCNT(b.x)], 1u);
    return b;
}
__device__ __forceinline__ void xcd_barrier_complete(unsigned* bar, unsigned x, unsigned& nloc, unsigned& nx) {
    const unsigned G = gridDim.x * gridDim.y * gridDim.z;
    unsigned sum, cnt, mine, sp = 0u;
    for (;;) {
        sum = 0u; cnt = 0u; mine = 0u;
#pragma unroll
        for (unsigned j = 0; j < 16; ++j) { const unsigned c = xb_ld(&bar[XB_XCNT(j)]); sum += c; cnt += (c > 0u) ? 1u : 0u; mine = (j == x) ? c : mine; }
        if (sum == G) break;
        __builtin_amdgcn_s_sleep(1);
        if ((++sp & 255u) == 0u) { if (xb_ld(&bar[XB_TMO])) break; if (sp > XB_SPIN_CAP) { atomicAdd(&bar[XB_TMO], 1u); break; } }
    }
    nloc = mine > 0u ? mine : 1u; nx = cnt > 0u ? cnt : 1u;
}
__device__ __forceinline__ void xcd_barrier(const XcdBarrier& b) {
    asm volatile("s_waitcnt vmcnt(0)" ::: "memory");
    __syncthreads();
    if (threadIdx.x == 0) {
        unsigned* bar = b.bar;
        __builtin_amdgcn_s_waitcnt(0);
        unsigned nloc = b.st[0], nx = b.st[1];
        if (nloc == 0u) { xcd_barrier_complete(bar, b.x, nloc, nx); b.st[0] = nloc; b.st[1] = nx; }
        const unsigned old = xb_add(&bar[XB_XSUB(b.x)], 1u);
        const unsigned gen = old / nloc;
        if (old + 1u == (gen + 1u) * nloc) {
            __builtin_amdgcn_fence(__ATOMIC_RELEASE, "agent");
            asm volatile("s_waitcnt vmcnt(0)" ::: "memory");
            const unsigned og = xb_add(&bar[XB_TOP], 1u);
            const unsigned tg = og / nx;
            if (og + 1u == (tg + 1u) * nx) xb_add(&bar[XB_TOPGEN], 1u);
            else XB_SPIN(xb_ld(&bar[XB_TOPGEN]) == tg, bar);
            __builtin_amdgcn_fence(__ATOMIC_ACQUIRE, "agent");
            xb_add(&bar[XB_XGEN(b.x)], 1u);
            asm volatile("s_waitcnt vmcnt(0)" ::: "memory");
        } else {
            XB_SPIN(xb_ld(&bar[XB_XGEN(b.x)]) == gen, bar);
            __builtin_amdgcn_fence(__ATOMIC_ACQUIRE, "agent");
            asm volatile("s_waitcnt vmcnt(0)" ::: "memory");
        }
    }
    __syncthreads();
}

namespace gm {
constexpr int BM = 256, BK = 64, HALF = 128, HTB = HALF * BK * 2, STAGE_BYTES = 8 * HTB;
__device__ __forceinline__ int lds_byte(int r, int c) { const int st = (r >> 4) * 2 + (c >> 5), rr = r & 15, cc = c & 31, ob = rr * 64 + cc * 2; return st * 1024 + (ob ^ (((ob >> 9) & 1) << 5)); }
__device__ __forceinline__ void stage_rc(int b, int& R, int& C) { const int st = b / 1024, sb = b % 1024, swz = sb ^ (((sb >> 9) & 1) << 5); R = (st >> 1) * 16 + swz / 64; C = (st & 1) * 32 + (swz % 64) / 2; }
__device__ __forceinline__ int perm32(int rho) { const int n = rho >> 4, i = rho & 15; return 8 * (i >> 2) + 4 * n + (i & 3); }

struct Unit { const char* a0; const char* a1; const char* b0; const char* b1; int p0, p1, p2, p3, q; };

__device__ __forceinline__ void tile_order(int L, int nM, int nN, int& pm, int& pn) {
    const int nwg = nM * nN; int wgid = L;
    { const int q = nwg / 8, r = nwg % 8, xcd = wgid % 8, off = wgid / 8; wgid = (xcd < r ? xcd * (q + 1) : r * (q + 1) + (xcd - r) * q) + off; }
    const int nig = 8 * nN, gid = wgid / nig, fm = gid * 8, gsz = (nM - fm) < 8 ? (nM - fm) : 8;
    pm = fm + ((wgid % nig) % gsz); pn = (wgid % nig) / gsz;
}

template <bool I8> struct AccSel { typedef f32x4 type; };
template <> struct AccSel<true> { typedef i32x4 type; };
template <class Epi, class Sched, bool GATHER, bool I8 = false, bool PREF = false>
__device__ __forceinline__ void gemm_run(LAS unsigned char* lds, const Sched& S, const Epi& E) {
    const int tid = threadIdx.x, wid = __builtin_amdgcn_readfirstlane(tid >> 6), lane = tid & 63, wr = wid >> 2, wc = wid & 3, fr = lane & 15, fq = lane >> 4;
    int nt = S.nt; asm volatile("" : "+s"(nt));
    unsigned voffA[2], voffB[2], colA[2]; int rowA[2];
#pragma unroll
    for (int i = 0; i < 2; ++i) { int R, C; stage_rc(tid * 16 + i * 8192, R, C); const int Rb = Epi::PERM ? ((R & ~31) + perm32(R & 31)) : R;
        voffA[i] = (unsigned)(R * S.multA * S.pitchA + C) * 2u; voffB[i] = (unsigned)(Rb * S.multB * S.pitchB + C) * 2u; colA[i] = (unsigned)C * 2u; rowA[i] = R; }
    const size_t kstep = (size_t)(BK * 2);
    const unsigned ldsw = (unsigned)wid * 1024u;
    const int aoff = lds_byte(wr * 64 + fr, fq * 8), boff = lds_byte(wc * 32 + fr, fq * 8);
#define G_SA(b, h) (((b) * 2 + (h)) * HTB)
#define G_SB(b, h) ((4 + (b) * 2 + (h)) * HTB)
#define G_STAGE(bufoff, gbase, voff) do { _Pragma("unroll") for (int _i = 0; _i < 2; ++_i) \
        __builtin_amdgcn_global_load_lds((const unsigned*)((const char*)(gbase) + (voff)[_i]), (LAS unsigned*)(lds + (bufoff) + ldsw + _i * 8192), 16, 0, 0); } while (0)
#define G_LDA(dst, b, h) do { _Pragma("unroll") for (int m = 0; m < 4; ++m) _Pragma("unroll") for (int k = 0; k < 2; ++k) dst[m][k] = *(const LAS bf16x8*)(lds + G_SA(b, h) + aoff + m * 2048 + k * 1024); } while (0)
#define G_LDB(dst, b, h) do { _Pragma("unroll") for (int n = 0; n < 2; ++n) _Pragma("unroll") for (int k = 0; k < 2; ++k) dst[n][k] = *(const LAS bf16x8*)(lds + G_SB(b, h) + boff + n * 2048 + k * 1024); } while (0)
#define G_MMA(ai, bj, At, Bt) do { __builtin_amdgcn_s_setprio(1); _Pragma("unroll") for (int m = 0; m < 4; ++m) _Pragma("unroll") for (int n = 0; n < 2; ++n) _Pragma("unroll") for (int k = 0; k < 2; ++k) \
        { if constexpr (I8) acc[ai][bj][m][n] = __builtin_amdgcn_mfma_i32_16x16x64_i8(__builtin_bit_cast(i32x4, Bt[n][k]), __builtin_bit_cast(i32x4, At[m][k]), acc[ai][bj][m][n], 0, 0, 0); \
          else acc[ai][bj][m][n] = __builtin_amdgcn_mfma_f32_16x16x32_bf16(Bt[n][k], At[m][k], acc[ai][bj][m][n], 0, 0, 0); } __builtin_amdgcn_s_setprio(0); } while (0)
#define G_WAIT_V(n) asm volatile("s_waitcnt vmcnt(" #n ")" ::: "memory")
#define G_WAIT_L(n) asm volatile("s_waitcnt lgkmcnt(" #n ")" ::: "memory")
#define G_BAR __builtin_amdgcn_s_barrier()
#define G_SCHED __builtin_amdgcn_sched_barrier(0)
    Unit cur, nxt; int ui = 0;
    if (!S.next(0, cur)) return;
    cur.q = 0;
    if constexpr (PREF) { S.prefetch(cur, lds); G_WAIT_V(0); G_BAR; }
    typedef typename AccSel<I8>::type acc_t;
    acc_t acc[2][2][4][2];
#pragma unroll
    for (int a = 0; a < 2; ++a)
#pragma unroll
        for (int b = 0; b < 2; ++b)
#pragma unroll
            for (int m = 0; m < 4; ++m)
#pragma unroll
                for (int n = 0; n < 2; ++n) acc[a][b][m][n] = (acc_t){0, 0, 0, 0};
    bf16x8 At[4][2], B0[2][2], B1[2][2];
    unsigned gc0[2], gc1[2];
    if constexpr (GATHER) {
#pragma unroll
        for (int i = 0; i < 2; ++i) { gc0[i] = S.row_off(cur, rowA[i], lds) + colA[i]; gc1[i] = S.row_off(cur, 128 + rowA[i], lds) + colA[i]; }
    }
#define vA0 (GATHER ? gc0 : voffA)
#define vA1 (GATHER ? gc1 : voffA)
    G_STAGE(G_SB(0, 0), cur.b0, voffB); G_STAGE(G_SB(0, 1), cur.b1, voffB); G_STAGE(G_SA(0, 0), cur.a0, vA0); G_STAGE(G_SA(0, 1), cur.a1, vA1);
    if (wr == 1) G_BAR;
    G_WAIT_V(2); G_BAR;
    G_STAGE(G_SB(1, 0), cur.b0 + kstep, voffB); G_STAGE(G_SA(1, 0), cur.a0 + kstep, vA0); G_STAGE(G_SB(1, 1), cur.b1 + kstep, voffB);
    G_WAIT_V(6); G_BAR;
    for (;;) {
        const bool has_next = S.next(ui + 1, nxt);
        if (!has_next) nxt = cur;
        nxt.q = (ui + 1) & 1;
        for (int t = 0; t < nt; t += 2) {
            const bool last = (t == nt - 2);
            if constexpr (PREF) { if (t == nt - 4) S.prefetch(nxt, lds); }
            const char* a11 = cur.a1 + (size_t)(t + 1) * kstep;
            const char* a02 = last ? nxt.a0 : cur.a0 + (size_t)(t + 2) * kstep; const char* a12 = last ? nxt.a1 : cur.a1 + (size_t)(t + 2) * kstep;
            const char* b02 = last ? nxt.b0 : cur.b0 + (size_t)(t + 2) * kstep; const char* b12 = last ? nxt.b1 : cur.b1 + (size_t)(t + 2) * kstep;
            G_LDB(B0, 0, 0); G_LDB(B1, 0, 1); G_SCHED; G_LDA(At, 0, 0); G_STAGE(G_SA(1, 1), a11, vA1);
            if constexpr (GATHER) { if (last) { int tz = tid; asm volatile("" : "+v"(tz));
#pragma unroll
                for (int i = 0; i < 2; ++i) { int R, C; stage_rc(tz * 16 + i * 8192, R, C); gc0[i] = S.row_off(nxt, R, lds) + (unsigned)C * 2u; gc1[i] = S.row_off(nxt, 128 + R, lds) + (unsigned)C * 2u; } } }
            G_WAIT_V(8); G_WAIT_L(0); G_BAR; G_MMA(0, 0, At, B0); G_MMA(0, 1, At, B1); G_BAR; G_SCHED;
            G_LDA(At, 0, 1); G_STAGE(G_SB(0, 0), b02, voffB); G_STAGE(G_SB(0, 1), b12, voffB); G_STAGE(G_SA(0, 0), a02, vA0);
            G_WAIT_V(8); G_WAIT_L(0); G_BAR; G_MMA(1, 0, At, B0); G_MMA(1, 1, At, B1); G_BAR; G_SCHED;
            G_LDB(B0, 1, 0); G_LDB(B1, 1, 1); G_SCHED; G_LDA(At, 1, 0); G_STAGE(G_SA(0, 1), a12, vA1);
            G_WAIT_V(8); G_WAIT_L(0); G_BAR; G_MMA(0, 0, At, B0); G_MMA(0, 1, At, B1); G_BAR; G_SCHED;
            G_LDA(At, 1, 1); G_STAGE(G_SB(1, 0), b02 + kstep, voffB); G_STAGE(G_SB(1, 1), b12 + kstep, voffB); G_STAGE(G_SA(1, 0), a02 + kstep, vA0);
            G_WAIT_V(8); G_WAIT_L(0); G_BAR; G_MMA(1, 0, At, B0); G_MMA(1, 1, At, B1); G_BAR; G_SCHED;
        }
        if (wr == 0) G_BAR;
        { int fr2 = fr, fq2 = fq; asm volatile("" : "+v"(fr2), "+v"(fq2));
          E(acc, cur, lds, wr, wc, fr2, fq2); }
        if (!has_next) break;
#pragma unroll
        for (int a = 0; a < 2; ++a)
#pragma unroll
            for (int b = 0; b < 2; ++b)
#pragma unroll
                for (int m = 0; m < 4; ++m)
#pragma unroll
                    for (int n = 0; n < 2; ++n) acc[a][b][m][n] = (acc_t){0, 0, 0, 0};
        cur = nxt; ++ui;
        if (wr == 1) G_BAR;
    }
    G_WAIT_V(0);
    G_BAR;
#undef G_SA
#undef G_SB
#undef G_STAGE
#undef G_LDA
#undef G_LDB
#undef G_MMA
#undef G_WAIT_V
#undef G_WAIT_L
#undef G_BAR
#undef G_SCHED
#undef vA0
#undef vA1
}
}
using gm::Unit;
typedef f32x4 Acc[2][2][4][2];
typedef i32x4 AccI[2][2][4][2];

struct Args { const float* in[18]; float* out; unsigned char* ws; int ph_lo, ph_hi; };
struct Frame {
    LAS unsigned char* lds; unsigned char* ws; unsigned* ctl;
    int tid, lane, wave, vcu, G;
    const float *x, *ln0_g, *ln0_b, *w_in, *dec_f, *dec_b, *gn_g, *w_out, *ln1_g, *ln1_b, *w_r, *b_r, *w_up, *b_up, *w_dn, *b_dn, *ln2_g, *ln2_b;
    float* out;
};
#define WSP(T_, off) ((T_*)(F.ws + (off)))

template <class ColMap>
__device__ __forceinline__ void transpose_item(const float* W, int K, int N, bf16* WT, LAS float* scr, int item, int lane, const ColMap& cm) {
    const int nblk = N / 64, kb = item / nblk, nb = item % nblk, k0 = 64 * kb, n0 = 64 * nb;
    const int s0 = cm(n0);
#pragma unroll 4
    for (int i = 0; i < 16; ++i) { const int kk = 4 * i + (lane >> 4), c4 = (lane & 15) * 4;
        const f32x4 v = *(const GAS f32x4*)(W + (size_t)(k0 + kk) * N + s0 + c4);
        LAS float* d = scr + kk * 65 + c4; d[0] = v[0]; d[1] = v[1]; d[2] = v[2]; d[3] = v[3]; }
    LDS_WAIT(); asm volatile("" ::: "memory");
    const int c = lane & 7;
#pragma unroll
    for (int j = 0; j < 8; ++j) { const int n = (lane >> 3) + 8 * j; const LAS float* s = scr + (8 * c) * 65 + n;
        v4u o; o.x = cvt_pk_bf16(s[0 * 65], s[1 * 65]); o.y = cvt_pk_bf16(s[2 * 65], s[3 * 65]); o.z = cvt_pk_bf16(s[4 * 65], s[5 * 65]); o.w = cvt_pk_bf16(s[6 * 65], s[7 * 65]);
        *(GAS v4u*)(WT + (size_t)(n0 + n) * K + k0 + 8 * c) = o; }
    LDS_WAIT(); asm volatile("" ::: "memory");
}
struct ColId { __device__ __forceinline__ int operator()(int n) const { return n; } };
struct ColUp { __device__ __forceinline__ int operator()(int n) const { return ((n >> 8) * 128 + (n & 127)) + ((n >> 7) & 1) * 2048; } };

__device__ __forceinline__ void p0_prologue(Frame& F) {
    const int gw = F.vcu * NWAVES + F.wave, NGW = F.G * NWAVES;
    {
        unsigned* h0q = WSP(unsigned, WS_H0B); float* st0 = WSP(float, WS_ST0); float* sx0 = WSP(float, WS_SX0);
        for (int m = gw; m < T; m += NGW) {
            const GAS f32x4* xr = (const GAS f32x4*)(F.x + (size_t)m * D) + F.lane;
            f32x4 v[8]; float s = 0.f;
#pragma unroll
            for (int j = 0; j < 8; ++j) { v[j] = xr[64 * j]; s += (v[j][0] + v[j][1]) + (v[j][2] + v[j][3]); }
            const float mean = wave_sum(s) * (1.f / D); float s2 = 0.f;
#pragma unroll
            for (int j = 0; j < 8; ++j) { v[j] = v[j] - mean; s2 += (v[j][0] * v[j][0] + v[j][1] * v[j][1]) + (v[j][2] * v[j][2] + v[j][3] * v[j][3]); }
            const float rstd = 1.f / sqrtf(wave_sum(s2) * (1.f / D) + LN_EPS); float am = 0.f;
#pragma unroll
            for (int j = 0; j < 8; ++j) { const f32x4 g = *((const GAS f32x4*)F.ln0_g + F.lane + 64 * j), b = *((const GAS f32x4*)F.ln0_b + F.lane + 64 * j);
                v[j] = v[j] * rstd * g + b; am = fmaxf(am, fmaxf(fmaxf(fabsf(v[j][0]), fabsf(v[j][1])), fmaxf(fabsf(v[j][2]), fabsf(v[j][3])))); }
#pragma unroll
            for (int o = 1; o < 64; o <<= 1) am = fmaxf(am, __shfl_xor(am, o));
            const float sc = am > 0.f ? am * (1.f / 127.f) : 1.f, inv = 1.f / sc;
#pragma unroll
            for (int j = 0; j < 8; ++j) { const int q0 = (int)__builtin_rintf(v[j][0] * inv), q1 = (int)__builtin_rintf(v[j][1] * inv), q2 = (int)__builtin_rintf(v[j][2] * inv), q3 = (int)__builtin_rintf(v[j][3] * inv);
                h0q[(size_t)m * (D / 4) + F.lane + 64 * j] = (unsigned)(q0 & 0xff) | ((unsigned)(q1 & 0xff) << 8) | ((unsigned)(q2 & 0xff) << 16) | ((unsigned)(q3 & 0xff) << 24); }
            if (F.lane == 0) { st0[2 * m] = mean; st0[2 * m + 1] = rstd; sx0[m] = sc; }
        }
    }
    {
        bf16* tab = WSP(bf16, WS_TAB);
        for (int i = (F.vcu * NTHR + F.tid); i < 32768 + 65536 + 65536; i += F.G * NTHR) {
            float v;
            if (i < 32768) { const int r = i >> 7, a = i & 127, ri = r >> 7, k1 = r & 127; float c, s; cs_rev((float)((k1 * a) & 127) * (1.f / 128.f), c, s); v = ri ? -s : c; }
            else if (i < 32768 + 65536) { const int e = i - 32768, r = e >> 8, q = e & 255, ri = r >> 7, k2 = r & 127, rj = q >> 7, b = q & 127; float c, s; cs_rev((float)((k2 * b) & 127) * (1.f / 128.f), c, s);
                v = (ri == 0) ? (rj == 0 ? c : s) : (rj == 0 ? -s : c); }
            else { const int e = i - 32768 - 65536, l = e >> 8, q = e & 255, rj = q >> 7, cg = q & 127; float c, s; cs_rev((float)((l * cg) & 127) * (1.f / 128.f), c, s); v = (l < 128) ? (rj == 0 ? c : s) : 0.f; }
            tab[i] = (bf16)(cvt_pk_bf16(v, 0.f) & 0xffffu);
        }
    }
    {
        LAS float* scr = (LAS float*)(F.lds + F.wave * 18432);
        constexpr int I_IN = 32 * (DIN / 64), I_OUT = 32 * (D / 64), I_UP = 32 * (2 * DFF / 64), I_DN = 32 * (D / 64);
        constexpr int NIT = I_OUT;
        for (int it = gw; it < NIT; it += NGW) {
            int r = it;
            { transpose_item(F.w_out, D, D, WSP(bf16, WS_WOUT), scr, r, F.lane, ColId()); }
        }
    }
}

struct SlabDesc { const float* W; signed char* WQ; float* sw; int NS, e, n0, valid; };
struct QF { unsigned char* ws; const float* w_up; const float* w_dn; const float* w_in; int vcu, G; };
__device__ __forceinline__ SlabDesc slab_desc(const QF& F, int j) {
    const int nD = (NE * 64 + F.G - 1) / F.G; SlabDesc d;
    if (j < 0) { const int sl = F.vcu + (-1 - j) * F.G; d.valid = sl < DIN / 32; d.NS = DIN; d.e = 0; d.n0 = sl * 32; d.W = F.w_in + d.n0; d.WQ = (signed char*)WSP(char, WS_WIN); d.sw = WSP(float, WS_SWIN); }
    else if (j >= nD) { const int sl = F.vcu + (j - nD) * F.G; d.valid = sl < NE * 128; d.NS = 2 * DFF; d.e = sl >> 7; d.n0 = (sl & 127) * 32; d.W = F.w_up + (size_t)d.e * D * 2 * DFF + ColUp()(d.n0); d.WQ = (signed char*)WSP(char, WS_WUP); d.sw = WSP(float, WS_SWUP); }
    else { const int sl = F.vcu + j * F.G; d.valid = sl < NE * 64; d.NS = D; d.e = sl >> 6; d.n0 = (sl & 63) * 32; d.W = F.w_dn + (size_t)d.e * DFF * D + d.n0; d.WQ = (signed char*)WSP(char, WS_WDN); d.sw = WSP(float, WS_SWDN); }
    return d;
}
#define SLAB_LOAD(dsc, v) do { if ((dsc).valid) { const GAS char* b_ = (const GAS char*)(dsc).W; unsigned o_ = (unsigned)((wave * 256 + kq) * (dsc).NS + c4) * 4u; const unsigned st_ = (unsigned)(dsc).NS * 32u; \
    _Pragma("unroll") for (int i_ = 0; i_ < 32; ++i_) { v[i_] = __builtin_nontemporal_load((const GAS f32x4*)(b_ + o_)); o_ += st_; } } } while (0)
__device__ __forceinline__ void do_slabs_impl(LAS unsigned char* lds, unsigned char* ws, const float* w_up, const float* w_dn, const float* w_in, int vcu, int G, int j0, int j1) {
    if (j0 >= j1) return;
    QF F; F.ws = ws; F.w_up = w_up; F.w_dn = w_dn; F.w_in = w_in; F.vcu = vcu; F.G = G;
    const int tid = threadIdx.x, lane = tid & 63, wave = __builtin_amdgcn_readfirstlane(tid >> 6);
    constexpr int PITCH = 2056;
    LAS bf16* slab = (LAS bf16*)lds;
    LAS float* red = (LAS float*)(lds + 32 * PITCH * 2);
    const int kq = lane >> 3, c4 = (lane & 7) * 4;
    f32x4 v[32];
    SlabDesc cur = slab_desc(F, j0);
    SLAB_LOAD(cur, v);
    for (int j = j0; j < j1; ++j) {
        if (cur.valid) {
            f32x4 mx = (f32x4){0.f, 0.f, 0.f, 0.f};
#pragma unroll
            for (int i = 0; i < 32; ++i) { const int k = wave * 256 + i * 8 + kq; const f32x4 x = v[i];
                mx[0] = fmaxf(mx[0], fabsf(x[0])); mx[1] = fmaxf(mx[1], fabsf(x[1])); mx[2] = fmaxf(mx[2], fabsf(x[2])); mx[3] = fmaxf(mx[3], fabsf(x[3]));
                const unsigned p01 = cvt_pk_bf16(x[0], x[1]), p23 = cvt_pk_bf16(x[2], x[3]);
                const int ks = k ^ (((c4 >> 3) & 3) << 3);
                slab[(c4 + 0) * PITCH + ks] = (bf16)(p01 & 0xffffu); slab[(c4 + 1) * PITCH + ks] = (bf16)(p01 >> 16); slab[(c4 + 2) * PITCH + ks] = (bf16)(p23 & 0xffffu); slab[(c4 + 3) * PITCH + ks] = (bf16)(p23 >> 16); }
#pragma unroll
            for (int q = 0; q < 4; ++q) { float m = mx[q]; m = fmaxf(m, __shfl_xor(m, 8)); m = fmaxf(m, __shfl_xor(m, 16)); m = fmaxf(m, __shfl_xor(m, 32)); mx[q] = m; }
            if (lane < 8) { LAS float* d = red + wave * 32 + c4; d[0] = mx[0]; d[1] = mx[1]; d[2] = mx[2]; d[3] = mx[3]; }
        }
        const SlabDesc done = cur;
        if (j + 1 < j1) { cur = slab_desc(F, j + 1); SLAB_LOAD(cur, v); }
        __syncthreads();
        if (done.valid && tid < 32) { float m = 0.f;
#pragma unroll
            for (int w = 0; w < 8; ++w) m = fmaxf(m, red[w * 32 + tid]);
            const float sc = m > 0.f ? m * (1.f / 127.f) : 1.f; done.sw[(size_t)done.e * done.NS + done.n0 + tid] = sc; red[256 + tid] = 1.f / sc; }
        __syncthreads();
        if (done.valid) {
#pragma unroll 2
            for (int i = 0; i < 8; ++i) { const int q = tid + NTHR * i, n = q >> 7, kc = q & 127; const float inv = red[256 + n];
                const int sx_ = ((n >> 3) & 3) << 3;
                const v4u a = *(const LAS v4u*)(slab + n * PITCH + ((kc * 16) ^ sx_)), b = *(const LAS v4u*)(slab + n * PITCH + ((kc * 16 + 8) ^ sx_));
                const unsigned src[8] = {a.x, a.y, a.z, a.w, b.x, b.y, b.z, b.w}; unsigned o[4];
#pragma unroll
                for (int d = 0; d < 4; ++d) { unsigned w = 0u;
#pragma unroll
                    for (int h2 = 0; h2 < 2; ++h2) { const unsigned u2 = src[2 * d + h2]; const int q0 = (int)__builtin_rintf(bf_lo(u2) * inv), q1 = (int)__builtin_rintf(bf_hi(u2) * inv);
                        w |= ((unsigned)(q0 & 0xff) << (16 * h2)) | ((unsigned)(q1 & 0xff) << (16 * h2 + 8)); }
                    o[d] = w; }
                *(GAS v4u*)(done.WQ + ((size_t)done.e * done.NS + done.n0 + n) * D + kc * 16) = (v4u){o[0], o[1], o[2], o[3]}; }
        }
        __syncthreads();
    }
}

__device__ __forceinline__ void do_slabs(Frame& F, int j0, int j1) { do_slabs_impl(F.lds, F.ws, F.w_up, F.w_dn, F.w_in, F.vcu, F.G, j0, j1); }

struct SchedBase { int nt, pitchA, pitchB, multA, multB, G, c; };
struct SchedG1N : SchedBase {
    const char* A; const char* Bt;
    __device__ __forceinline__ bool next(int i, Unit& u) const { const int L = i * G + c; if (L >= 64 * 12) return false; int pm, pn; gm::tile_order(L, 64, 12, pm, pn);
        const int cb = pn < 4 ? 1024 + 256 * pn : (pn < 8 ? 2048 + 256 * (pn - 4) : 4096 + 256 * (pn - 8));
        u.a0 = A + (size_t)pm * 256 * D; u.a1 = u.a0 + (size_t)128 * D; u.b0 = Bt + (size_t)cb * D; u.b1 = u.b0 + (size_t)128 * D; u.p0 = pm; u.p1 = pn; u.p2 = cb; u.p3 = 0; return true; }
};
struct SchedG1SF : SchedBase {
    const char* A; const char* Bt;
    __device__ __forceinline__ bool next(int i, Unit& u) const { const int L = i * G + c; if (L >= 4 * 64) return false; int pm, pn; gm::tile_order(L, 4, 64, pm, pn);
        u.a0 = A + (size_t)pm * 256 * D; u.a1 = u.a0 + (size_t)128 * D; u.b0 = Bt + (size_t)(2 * pn) * D; u.b1 = u.b0 + (size_t)D; u.p0 = pm; u.p1 = pn; u.p2 = 0; u.p3 = 0; return true; }
};
struct SchedG1SKV : SchedBase {
    const char* A; const char* Bt;
    __device__ __forceinline__ bool next(int i, Unit& u) const { const int L = i * G + c; if (L >= 8 * 64) return false; int pm, pn; gm::tile_order(L, 8, 64, pm, pn);
        const int rb = pm < 4 ? 2048 + 256 * pm : 3072 + 256 * (pm - 4);
        u.a0 = A + (size_t)rb * D; u.a1 = u.a0 + (size_t)128 * D; u.b0 = Bt + (size_t)pn * 256 * D; u.b1 = u.b0 + (size_t)128 * D; u.p0 = pm; u.p1 = pn; u.p2 = rb; u.p3 = 0; return true; }
};
struct SchedFixA : SchedBase {
    const char* A; const char* Bt; int ncol;
    __device__ __forceinline__ bool next(int i, Unit& u) const { const int L = i * G + c; if (L >= ncol) return false;
        u.a0 = A; u.a1 = A + (size_t)128 * pitchA * 2; u.b0 = Bt + (size_t)L * 256 * pitchB * 2; u.b1 = u.b0 + (size_t)128 * pitchB * 2; u.p0 = 0; u.p1 = L; u.p2 = 0; u.p3 = 0; return true; }
};
struct SchedFixB : SchedBase {
    const char* A; const char* Bt; int nrow;
    __device__ __forceinline__ bool next(int i, Unit& u) const { const int L = i * G + c; if (L >= nrow) return false;
        u.a0 = A + (size_t)L * 256 * pitchA * 2; u.a1 = u.a0 + (size_t)128 * pitchA * 2; u.b0 = Bt; u.b1 = Bt + (size_t)128 * pitchB * 2; u.p0 = L; u.p1 = 0; u.p2 = 0; u.p3 = 0; return true; }
};
struct SchedScores : SchedBase {
    const char* Q; const char* Kk;
    __device__ __forceinline__ bool next(int i, Unit& u) const { const int L = i * G + c; if (L >= NH * NCH) return false; const int h = L & 3, n = L >> 2;
        u.a0 = Q + ((size_t)n * 256 * RW + h * HD) * 2; u.a1 = u.a0 + (size_t)128 * RW * 2; u.b0 = Kk + ((size_t)n * 256 * RW + h * HD) * 2; u.b1 = u.b0 + (size_t)128 * RW * 2; u.p0 = h; u.p1 = n; u.p2 = 0; u.p3 = 0; return true; }
};
struct SchedKV : SchedBase {
    const char* Bcat; const char* kTw;
    __device__ __forceinline__ bool next(int i, Unit& u) const { const int L = i * G + c; if (L >= 2 * NH * NCH) return false; const int dh = L & 7, n = L >> 3, dir = dh >> 2, h = dh & 3;
        u.a0 = Bcat + ((size_t)(h * NCH + n) * 256 * CAT) * 2; u.a1 = u.a0 + (size_t)128 * CAT * 2;
        u.b0 = kTw + (((size_t)dir * RW + h * HD) * T + (size_t)n * 256) * 2; u.b1 = u.b0 + (size_t)128 * T * 2; u.p0 = dh; u.p1 = n; u.p2 = 0; u.p3 = 0; return true; }
};
struct SchedOut : SchedBase {
    const char* Acat; const char* Bcat;
    __device__ __forceinline__ bool next(int i, Unit& u) const { const int L = i * G + c; if (L >= NH * NCH) return false; const int h = L & 3, n = L >> 2;
        u.a0 = Acat + ((size_t)h * T + (size_t)n * 256) * CAT * 2; u.a1 = u.a0 + (size_t)128 * CAT * 2; u.b0 = Bcat + ((size_t)(h * NCH + n) * 256 * CAT) * 2; u.b1 = u.b0 + (size_t)128 * CAT * 2; u.p0 = h; u.p1 = n; u.p2 = 0; u.p3 = 0; return true; }
};
struct Sched2D : SchedBase {
    const char* A; const char* Bt; int nM, nN;
    __device__ __forceinline__ bool next(int i, Unit& u) const { const int L = i * G + c; if (L >= nM * nN) return false; int pm, pn; gm::tile_order(L, nM, nN, pm, pn);
        u.a0 = A + (size_t)pm * 256 * pitchA * 2; u.a1 = u.a0 + (size_t)128 * pitchA * 2; u.b0 = Bt + (size_t)pn * 256 * pitchB * 2; u.b1 = u.b0 + (size_t)128 * pitchB * 2; u.p0 = pm; u.p1 = pn; u.p2 = 0; u.p3 = 0; return true; }
};
struct SchedMoE : SchedBase {
    const char* A; const char* Bt; const LAS int* tstart; const int* row_tok; const unsigned* cnt; int nN, rowbytes; size_t estride;
    __device__ __forceinline__ bool next(int i, Unit& u) const { const int RT = __builtin_amdgcn_readfirstlane(tstart[NE]); const int L = i * G + c; if (L >= RT * nN) return false; int rt, pn; gm::tile_order(L, RT, nN, rt, pn);
        const int e = __builtin_amdgcn_readfirstlane(tstart[40 + rt]);
        u.b0 = Bt + (size_t)e * estride + (size_t)pn * 256 * rowbytes; u.b1 = u.b0 + (size_t)128 * rowbytes;
        u.a0 = A; u.a1 = A;
        u.p0 = rt; u.p1 = pn; u.p2 = e; u.p3 = (rt - __builtin_amdgcn_readfirstlane(tstart[e])) * 256; return true; }
    __device__ __forceinline__ bool next_tab(int i, Unit& u) const { const int w = (i < 64) ? __builtin_amdgcn_readfirstlane(tstart[400 + i]) : -1; if (w < 0) return false;
        const int rt = w & 1023, pn = (w >> 10) & 31, e = (w >> 15) & 31;
        u.b0 = Bt + (size_t)e * estride + (size_t)pn * 256 * rowbytes; u.b1 = u.b0 + (size_t)128 * rowbytes; u.a0 = A; u.a1 = A;
        u.p0 = rt; u.p1 = pn; u.p2 = e; u.p3 = (rt - __builtin_amdgcn_readfirstlane(tstart[e])) * 256; return true; }
    const float *rsc, *swup, *b_up;
    __device__ __forceinline__ void prefetch(const Unit& u, LAS unsigned char* lds) const {
        LAS unsigned char* blk = lds + LDS_STAGE + u.q * 4096;
        const int wid = __builtin_amdgcn_readfirstlane(threadIdx.x >> 6), lane = threadIdx.x & 63, e = u.p2;
        const int n = (int)cnt[64 * e]; int pos = u.p3 + (wid & 3) * 64 + lane; pos = pos < n ? pos : n - 1;
        if (wid < 4) __builtin_amdgcn_global_load_lds((const unsigned*)(row_tok + (size_t)e * T + pos), (LAS unsigned*)(blk + wid * 256), 4, 0, 0);
        else __builtin_amdgcn_global_load_lds((const unsigned*)(rsc + (size_t)e * T + pos), (LAS unsigned*)(blk + 1024 + (wid - 4) * 256), 4, 0, 0);
        if (wid == 0) __builtin_amdgcn_global_load_lds((const unsigned*)(swup + (size_t)e * 2 * DFF + u.p1 * 256 + lane * 4), (LAS unsigned*)(blk + 2048), 16, 0, 0);
        if (wid == 1) __builtin_amdgcn_global_load_lds((const unsigned*)(b_up + (size_t)e * 2 * DFF + u.p1 * 128 + (lane & 31) * 4 + (lane >> 5) * DFF), (LAS unsigned*)(blk + 3072), 16, 0, 0);
    }
    __device__ __forceinline__ unsigned row_off(const Unit& u, int r, LAS unsigned char* lds) const { return (unsigned)((const LAS int*)(lds + LDS_STAGE + u.q * 4096))[r] * (unsigned)rowbytes; }
};
struct SchedMoEUpT : SchedMoE { __device__ __forceinline__ bool next(int i, Unit& u) const { return next_tab(i, u); } };
struct SchedMoEDown : SchedMoE {
    const float *sa, *swdn, *b_dn;
    __device__ __forceinline__ bool next(int i, Unit& u) const { if (!SchedMoE::next_tab(i, u)) return false; u.a0 = A + (size_t)u.p0 * 256 * rowbytes; u.a1 = u.a0 + (size_t)128 * rowbytes; return true; }
    __device__ __forceinline__ void prefetch(const Unit& u, LAS unsigned char* lds) const {
        LAS unsigned char* blk = lds + LDS_STAGE + u.q * 4096;
        const int wid = __builtin_amdgcn_readfirstlane(threadIdx.x >> 6), lane = threadIdx.x & 63, e = u.p2;
        if (wid == 0) __builtin_amdgcn_global_load_lds((const unsigned*)(sa + (size_t)u.p0 * 256 + lane * 4), (LAS unsigned*)(blk), 16, 0, 0);
        if (wid == 1) __builtin_amdgcn_global_load_lds((const unsigned*)(swdn + (size_t)e * D + u.p1 * 256 + lane * 4), (LAS unsigned*)(blk + 1024), 16, 0, 0);
        if (wid == 2) __builtin_amdgcn_global_load_lds((const unsigned*)(b_dn + (size_t)e * D + u.p1 * 256 + lane * 4), (LAS unsigned*)(blk + 2048), 16, 0, 0);
    }
};

#define EPI_LOOP_AM for (int ai = 0; ai < 2; ++ai) _Pragma("unroll") for (int m = 0; m < 4; ++m)
#define EPI_FENCE __builtin_amdgcn_sched_barrier(0)
struct EpiG1N {
    static constexpr bool PERM = true;
    bf16 *qs, *kk, *gs, *Acat; const float *dec_f, *dec_b, *sx0, *swin;
    __device__ __forceinline__ void operator()(AccI& acci, const Unit& u, LAS unsigned char*, int wr, int wc, int fr, int fq) const {
        const int pm = u.p0, pn = u.p1, c0 = wc * 32 + 8 * fq;
        f32x4 swc[2][2];
#pragma unroll
        for (int bj = 0; bj < 2; ++bj)
#pragma unroll
            for (int n = 0; n < 2; ++n) swc[bj][n] = *(const GAS f32x4*)(swin + u.p2 + 128 * bj + c0 + 4 * n);
#define ACCF(ai_, bj_, m_, n_, j_) ((float)acci[ai_][bj_][m_][n_][j_] * (sxr * swc[bj_][n_][j_]))
        if (pn < 8) {
            const int h = pn & 3; const bool isq = pn < 4;
            float inv[8];
#pragma unroll
            for (int e = 0; e < 8; ++e) inv[e] = __builtin_amdgcn_exp2f(-(float)(c0 + e) * (13.287712379549449f / 128.f)) * 0.15915494309189535f;
            const float lgf = -fexp(dec_f[h]), lgb = -fexp(dec_b[h]);
#pragma unroll
            EPI_LOOP_AM {
                const int r = 128 * ai + 64 * wr + 16 * m + fr, tok = pm * 256 + r; const float pos = (float)tok; const float sxr = sx0[tok];
                f32x4 o1[2], o2[2];
#pragma unroll
                for (int n = 0; n < 2; ++n)
#pragma unroll
                    for (int j = 0; j < 4; ++j) { float c, s; cs_rev(pos * inv[4 * n + j], c, s); const float x1 = ACCF(ai, 0, m, n, j), x2 = ACCF(ai, 1, m, n, j); o1[n][j] = x1 * c - x2 * s; o2[n][j] = x2 * c + x1 * s; }
                if (isq) {
                    bf16* q = qs + (size_t)tok * RW + h * HD + c0; *(GAS v4u*)q = pack8(o1[0], o1[1]); *(GAS v4u*)(q + 128) = pack8(o2[0], o2[1]);
                    const int il = r; const float wf = fexp(lgf * (float)(il + 1)), wb = fexp(lgb * (float)(255 - il));
                    bf16* a = Acat + ((size_t)h * T + tok) * CAT + c0;
                    *(GAS v4u*)(a + 256) = pack8(o1[0] * wf, o1[1] * wf); *(GAS v4u*)(a + 384) = pack8(o2[0] * wf, o2[1] * wf);
                    *(GAS v4u*)(a + 512) = pack8(o1[0] * wb, o1[1] * wb); *(GAS v4u*)(a + 640) = pack8(o2[0] * wb, o2[1] * wb);
                } else {
                    bf16* k = kk + (size_t)tok * RW + h * HD + c0; *(GAS v4u*)k = pack8(o1[0] * 0.0625f, o1[1] * 0.0625f); *(GAS v4u*)(k + 128) = pack8(o2[0] * 0.0625f, o2[1] * 0.0625f);
                }
            }
        } else {
#pragma unroll
            EPI_LOOP_AM {
                const int r = 128 * ai + 64 * wr + 16 * m + fr, tok = pm * 256 + r; const float sxr = sx0[tok];
#pragma unroll
                for (int bj = 0; bj < 2; ++bj) { f32x4 v[2];
#pragma unroll
                    for (int n = 0; n < 2; ++n)
#pragma unroll
                        for (int j = 0; j < 4; ++j) { const float g = ACCF(ai, bj, m, n, j); v[n][j] = g * __builtin_amdgcn_rcpf(1.f + fexp(-g)); }
                    *(GAS v4u*)(gs + (size_t)tok * RW + (pn - 8) * 256 + bj * 128 + c0) = pack8(v[0], v[1]); }
            }
        }
    }
};
#undef ACCF
struct EpiG1SF {
    static constexpr bool PERM = true;
    bf16* uTT; const float *sx0, *swin;
    __device__ __forceinline__ void operator()(AccI& acc, const Unit& u, LAS unsigned char*, int wr, int wc, int fr, int fq) const {
        const int a0 = wc * 32 + 8 * fq;
        float sxc[2][8];
#pragma unroll
        for (int bj = 0; bj < 2; ++bj)
#pragma unroll
            for (int e = 0; e < 8; ++e) sxc[bj][e] = sx0[128 * (a0 + e) + 2 * u.p1 + bj];
#pragma unroll
        EPI_LOOP_AM { const int cch = u.p0 * 256 + 128 * ai + 64 * wr + 16 * m + fr; const float swr = swin[cch];
#pragma unroll
            for (int bj = 0; bj < 2; ++bj) { f32x4 v0, v1;
#pragma unroll
                for (int j = 0; j < 4; ++j) { v0[j] = (float)acc[ai][bj][m][0][j] * (swr * sxc[bj][j]); v1[j] = (float)acc[ai][bj][m][1][j] * (swr * sxc[bj][4 + j]); }
                *(GAS v4u*)(uTT + ((size_t)cch * 128 + (2 * u.p1 + bj)) * 128 + a0) = pack8(v0, v1); } }
    }
};
struct EpiG1SKV {
    static constexpr bool PERM = true;
    bf16 *kTw, *Bcat; const float *dec_f, *dec_b, *sx0, *swin;
    __device__ __forceinline__ void operator()(AccI& acc, const Unit& u, LAS unsigned char*, int wr, int wc, int fr, int fq) const {
        const int pm = u.p0, n_ch = u.p1, c0 = wc * 32 + 8 * fq;
        f32x4 sxc[2][2];
#pragma unroll
        for (int bj = 0; bj < 2; ++bj)
#pragma unroll
            for (int n = 0; n < 2; ++n) sxc[bj][n] = *(const GAS f32x4*)(sx0 + n_ch * 256 + 128 * bj + c0 + 4 * n);
        if (pm < 4) {
            const int h = pm; const float lgf = -fexp(dec_f[h]), lgb = -fexp(dec_b[h]);
#pragma unroll
            for (int m = 0; m < 4; ++m) {
                const int d = 64 * wr + 16 * m + fr;
                const float sw1 = swin[u.p2 + d], sw2 = swin[u.p2 + 128 + d];
                const float inv = __builtin_amdgcn_exp2f(-(float)d * (13.287712379549449f / 128.f)) * 0.15915494309189535f;
#pragma unroll
                for (int bj = 0; bj < 2; ++bj) {
                    f32x4 f1[2], f2[2], b1[2], b2[2];
#pragma unroll
                    for (int n = 0; n < 2; ++n)
#pragma unroll
                        for (int j = 0; j < 4; ++j) { const int il = 128 * bj + c0 + 4 * n + j; const float pos = (float)(n_ch * 256 + il); float c, s; cs_rev(pos * inv, c, s);
                            const float x1 = (float)acc[0][bj][m][n][j] * (sw1 * sxc[bj][n][j]), x2 = (float)acc[1][bj][m][n][j] * (sw2 * sxc[bj][n][j]); const float o1 = (x1 * c - x2 * s) * 0.0625f, o2 = (x2 * c + x1 * s) * 0.0625f;
                            const float wf = fexp(lgf * (float)(255 - il)), wb = fexp(lgb * (float)(il + 1));
                            f1[n][j] = o1 * wf; f2[n][j] = o2 * wf; b1[n][j] = o1 * wb; b2[n][j] = o2 * wb; }
                    const size_t tcol = (size_t)n_ch * 256 + 128 * bj + c0;
                    bf16* pf = kTw + ((size_t)(h * HD + d)) * T + tcol; bf16* pb = pf + (size_t)RW * T;
                    *(GAS v4u*)pf = pack8(f1[0], f1[1]); *(GAS v4u*)(pf + (size_t)128 * T) = pack8(f2[0], f2[1]);
                    *(GAS v4u*)pb = pack8(b1[0], b1[1]); *(GAS v4u*)(pb + (size_t)128 * T) = pack8(b2[0], b2[1]);
                }
            }
        } else {
            const int h = pm - 4;
#pragma unroll
            EPI_LOOP_AM { const int dv = 128 * ai + 64 * wr + 16 * m + fr; const float swr = swin[u.p2 + dv];
#pragma unroll
                for (int bj = 0; bj < 2; ++bj) { f32x4 v0, v1;
#pragma unroll
                    for (int j = 0; j < 4; ++j) { v0[j] = (float)acc[ai][bj][m][0][j] * (swr * sxc[bj][0][j]); v1[j] = (float)acc[ai][bj][m][1][j] * (swr * sxc[bj][1][j]); }
                    *(GAS v4u*)(Bcat + ((size_t)(h * NCH + n_ch) * 256 + dv) * CAT + 128 * bj + c0) = pack8(v0, v1); } }
        }
    }
};
struct EpiS1 {
    static constexpr bool PERM = true;
    bf16* A1;
    __device__ __forceinline__ void operator()(Acc& acc, const Unit& u, LAS unsigned char*, int wr, int wc, int fr, int fq) const {
        const int b0 = wc * 32 + 8 * fq;
#pragma unroll
        for (int m = 0; m < 4; ++m) { const int k1 = 64 * wr + 16 * m + fr;
#pragma unroll
            for (int bj = 0; bj < 2; ++bj) { const int cch = 2 * u.p1 + bj; f32x4 re[2], im[2];
#pragma unroll
                for (int n = 0; n < 2; ++n)
#pragma unroll
                    for (int j = 0; j < 4; ++j) { const int b = b0 + 4 * n + j; float c, s; cs_rev((float)(k1 * b) * (1.f / 16384.f), c, s);
                        const float xr = acc[0][bj][m][n][j], xi = acc[1][bj][m][n][j]; re[n][j] = xr * c + xi * s; im[n][j] = xi * c - xr * s; }
                bf16* p = A1 + (((size_t)k1 * 1024 + cch) * 2) * 128 + b0;
                *(GAS v4u*)p = pack8(re[0], re[1]); *(GAS v4u*)(p + 128) = pack8(im[0], im[1]); EPI_FENCE; } }
    }
};
struct EpiS2 {
    static constexpr bool PERM = true;
    bf16* Zt;
    __device__ __forceinline__ void operator()(Acc& acc, const Unit& u, LAS unsigned char*, int wr, int wc, int fr, int fq) const {
        const int k1 = u.p1 >> 2, cb = (u.p1 & 3) * 256, c0 = wc * 32 + 8 * fq;
#pragma unroll
        EPI_LOOP_AM { const int k2 = 64 * wr + 16 * m + fr, k = k1 + 128 * k2;
#pragma unroll
            for (int bj = 0; bj < 2; ++bj) { const int cch = cb + 128 * bj + c0, g = cch >> 7, cg = cch & 127;
                *(GAS v4u*)(Zt + (size_t)k * 2048 + g * 256 + ai * 128 + cg) = pack8(acc[ai][bj][m][0], acc[ai][bj][m][1]); } }
    }
};
struct EpiChan {
    static constexpr bool PERM = true;
    bf16* y;
    __device__ __forceinline__ void operator()(Acc& acc, const Unit& u, LAS unsigned char*, int wr, int wc, int fr, int fq) const {
        const int l0 = wc * 32 + 8 * fq; const float norm = 6.9053396600248786e-4f;
#pragma unroll
        EPI_LOOP_AM { const int R = u.p0 * 256 + 128 * ai + 64 * wr + 16 * m + fr, k = R >> 3, g = R & 7;
            *(GAS v4u*)(y + (size_t)k * D + g * 128 + l0) = pack8(acc[ai][0][m][0] * norm, acc[ai][0][m][1] * norm); }
    }
};
struct EpiScores {
    static constexpr bool PERM = true;
    bf16* Acat; const float *dec_f, *dec_b;
    __device__ __forceinline__ void operator()(Acc& acc, const Unit& u, LAS unsigned char*, int wr, int wc, int fr, int fq) const {
        const int h = u.p0, n_ch = u.p1, c0 = wc * 32 + 8 * fq; const float lgf = -fexp(dec_f[h]), lgb = -fexp(dec_b[h]);
#pragma unroll
        EPI_LOOP_AM { const int i = 128 * ai + 64 * wr + 16 * m + fr;
#pragma unroll
            for (int bj = 0; bj < 2; ++bj) { f32x4 v[2];
#pragma unroll
                for (int n = 0; n < 2; ++n)
#pragma unroll
                    for (int j = 0; j < 4; ++j) { const int jc = 128 * bj + c0 + 4 * n + j; const float dd = (float)(i - jc); const float w = (jc <= i) ? fexp(lgf * dd) : fexp(-lgb * dd); v[n][j] = acc[ai][bj][m][n][j] * w; }
                *(GAS v4u*)(Acat + ((size_t)h * T + n_ch * 256 + i) * CAT + 128 * bj + c0) = pack8(v[0], v[1]); EPI_FENCE; } }
    }
};
struct EpiKV {
    static constexpr bool PERM = true;
    bf16* kvT;
    __device__ __forceinline__ void operator()(Acc& acc, const Unit& u, LAS unsigned char*, int wr, int wc, int fr, int fq) const {
#pragma unroll
        EPI_LOOP_AM { const int dv = 128 * ai + 64 * wr + 16 * m + fr; bf16* rowp = kvT + (((size_t)u.p0 * NCH + u.p1) * 256 + dv) * 256 + wc * 32 + 8 * fq;
#pragma unroll
            for (int bj = 0; bj < 2; ++bj) *(GAS v4u*)(rowp + bj * 128) = pack8(acc[ai][bj][m][0], acc[ai][bj][m][1]); }
    }
};
struct EpiOut {
    static constexpr bool PERM = true;
    bf16* y; const bf16* gs; const float* gn_g;
    __device__ __forceinline__ void operator()(Acc& acc, const Unit& u, LAS unsigned char* lds, int wr, int wc, int fr, int fq) const {
        const int h = u.p0, n_ch = u.p1, c0 = wc * 32 + 8 * fq;
        LAS f32x2* P = (LAS f32x2*)(lds + LDS_STAGE);
#pragma unroll
        EPI_LOOP_AM {
            float s = 0.f;
#pragma unroll
            for (int bj = 0; bj < 2; ++bj)
#pragma unroll
                for (int n = 0; n < 2; ++n) { const f32x4 x = acc[ai][bj][m][n]; s += (x[0] + x[1]) + (x[2] + x[3]); }
            s += __shfl_xor(s, 16); s += __shfl_xor(s, 32);
            const float mw = s * (1.f / 64.f); float q = 0.f;
#pragma unroll
            for (int bj = 0; bj < 2; ++bj)
#pragma unroll
                for (int n = 0; n < 2; ++n) { const f32x4 d = acc[ai][bj][m][n] - mw; q += (d[0] * d[0] + d[1] * d[1]) + (d[2] * d[2] + d[3] * d[3]); }
            q += __shfl_xor(q, 16); q += __shfl_xor(q, 32);
            if (fq == 0) P[(128 * ai + 64 * wr + 16 * m + fr) * 4 + wc] = (f32x2){mw, q};
        }
        LDS_WAIT(); __builtin_amdgcn_s_barrier(); asm volatile("" ::: "memory");
#pragma unroll
        EPI_LOOP_AM {
            const int r = 128 * ai + 64 * wr + 16 * m + fr, tok = n_ch * 256 + r;
            const f32x2 a = P[r * 4 + 0], b = P[r * 4 + 1], c = P[r * 4 + 2], d = P[r * 4 + 3];
            const float mt = (a.x + b.x + c.x + d.x) * 0.25f; const float da = a.x - mt, db = b.x - mt, dc = c.x - mt, dd = d.x - mt;
            const float m2 = (a.y + b.y) + (c.y + d.y) + 64.f * ((da * da + db * db) + (dc * dc + dd * dd));
            const float rstd = 1.f / sqrtf(m2 * (1.f / 256.f) + GN_EPS);
#pragma unroll
            for (int bj = 0; bj < 2; ++bj) {
                const int col = h * HD + 128 * bj + c0; const v4u gv = *(const GAS v4u*)(gs + (size_t)tok * RW + col);
                const f32x4 g0 = *(const GAS f32x4*)(gn_g + col), g1 = *(const GAS f32x4*)(gn_g + col + 4);
                f32x4 o0 = (acc[ai][bj][m][0] - mt) * rstd * g0, o1 = (acc[ai][bj][m][1] - mt) * rstd * g1;
                o0[0] *= bf_lo(gv.x); o0[1] *= bf_hi(gv.x); o0[2] *= bf_lo(gv.y); o0[3] *= bf_hi(gv.y); o1[0] *= bf_lo(gv.z); o1[1] *= bf_hi(gv.z); o1[2] *= bf_lo(gv.w); o1[3] *= bf_hi(gv.w);
                *(GAS v4u*)(y + (size_t)tok * D + FW + col) = pack8(o0, o1); }
        }
        LDS_WAIT(); __builtin_amdgcn_s_barrier(); asm volatile("" ::: "memory");
    }
};
struct EpiWout {
    static constexpr bool PERM = true;
    bf16* z1; const float *x, *st0, *g0, *b0;
    __device__ __forceinline__ void operator()(Acc& acc, const Unit& u, LAS unsigned char*, int wr, int wc, int fr, int fq) const {
        const int colb = u.p1 * 256 + wc * 32 + 8 * fq;
#pragma unroll
        for (int bj = 0; bj < 2; ++bj) { const int col = colb + bj * 128;
            const f32x4 ga = *(const GAS f32x4*)(g0 + col), gb = *(const GAS f32x4*)(g0 + col + 4), ba = *(const GAS f32x4*)(b0 + col), bb = *(const GAS f32x4*)(b0 + col + 4);
#pragma unroll
            EPI_LOOP_AM { const int row = u.p0 * 256 + 128 * ai + 64 * wr + 16 * m + fr; const f32x2 st = *(const GAS f32x2*)(st0 + 2 * row); const size_t off = (size_t)row * D + col;
                const f32x4 xa = *(const GAS f32x4*)(x + off), xb = *(const GAS f32x4*)(x + off + 4);
                *(GAS v4u*)(z1 + off) = pack8(((xa - st.x) * st.y * ga + ba) * ALPHA + acc[ai][bj][m][0], ((xb - st.x) * st.y * gb + bb) * ALPHA + acc[ai][bj][m][1]); } }
    }
};
struct EpiUp {
    static constexpr bool PERM = true;
    bf16* act; unsigned* rmax;
    __device__ __forceinline__ void operator()(AccI& acc, const Unit& u, LAS unsigned char* lds, int wr, int wc, int fr, int fq) const {
        const int rt = u.p0, pn = u.p1, c0 = pn * 128 + wc * 32 + 8 * fq;
        const LAS float* blk = (const LAS float*)(lds + LDS_STAGE + u.q * 4096);
        float sx[2][4], rm[2][4];
#pragma unroll
        EPI_LOOP_AM { sx[ai][m] = blk[256 + 128 * ai + 64 * wr + 16 * m + fr]; rm[ai][m] = 0.f; }
#pragma unroll
        for (int n = 0; n < 2; ++n) {
            const int cc = wc * 32 + 8 * fq + 4 * n;
            const f32x4 sg = *(const LAS f32x4*)(blk + 512 + cc), sl = *(const LAS f32x4*)(blk + 512 + 128 + cc), bg = *(const LAS f32x4*)(blk + 768 + cc), bl = *(const LAS f32x4*)(blk + 768 + 128 + cc);
#pragma unroll
            EPI_LOOP_AM { const int r = 128 * ai + 64 * wr + 16 * m + fr; f32x2 v2[2];
#pragma unroll
                for (int jp = 0; jp < 2; ++jp) {
                    const f32x2 sx2 = (f32x2){sx[ai][m], sx[ai][m]};
                    f32x2 gl = (f32x2){(float)acc[ai][0][m][n][2 * jp], (float)acc[ai][0][m][n][2 * jp + 1]} * (sx2 * (f32x2){sg[2 * jp], sg[2 * jp + 1]}) + (f32x2){bg[2 * jp], bg[2 * jp + 1]};
                    f32x2 li = (f32x2){(float)acc[ai][1][m][n][2 * jp], (float)acc[ai][1][m][n][2 * jp + 1]} * (sx2 * (f32x2){sl[2 * jp], sl[2 * jp + 1]}) + (f32x2){bl[2 * jp], bl[2 * jp + 1]};
                    gl = __builtin_elementwise_min(gl, (f32x2){7.f, 7.f}); li = __builtin_elementwise_min(__builtin_elementwise_max(li, (f32x2){-7.f, -7.f}), (f32x2){7.f, 7.f});
                    const f32x2 ea = gl * (-1.702f * 1.4426950408889634f); f32x2 den; den.x = __builtin_amdgcn_exp2f(ea.x); den.y = __builtin_amdgcn_exp2f(ea.y); den = den + 1.0f;
                    f32x2 rc; rc.x = __builtin_amdgcn_rcpf(den.x); rc.y = __builtin_amdgcn_rcpf(den.y);
                    v2[jp] = (gl * rc) * (li + 1.0f); }
                rm[ai][m] = fmaxf(rm[ai][m], fmaxf(fmaxf(fabsf(v2[0].x), fabsf(v2[0].y)), fmaxf(fabsf(v2[1].x), fabsf(v2[1].y))));
                v2u w; w.x = cvt_pk_bf16(v2[0].x, v2[0].y); w.y = cvt_pk_bf16(v2[1].x, v2[1].y);
                *(GAS v2u*)(act + ((size_t)rt * 256 + r) * DFF + c0 + 4 * n) = w; }
        }
#pragma unroll
        EPI_LOOP_AM { float q = rm[ai][m]; q = fmaxf(q, __shfl_xor(q, 16)); q = fmaxf(q, __shfl_xor(q, 32));
            if (fq == 0) __hip_atomic_fetch_max(rmax + rt * 256 + 128 * ai + 64 * wr + 16 * m + fr, __float_as_uint(q), RLX_AGENT); }
    }
};
struct EpiDown {
    static constexpr bool PERM = true;
    bf16* yr;
    __device__ __forceinline__ void operator()(AccI& acc, const Unit& u, LAS unsigned char* lds, int wr, int wc, int fr, int fq) const {
        const int rt = u.p0, pn = u.p1, c0 = pn * 256 + wc * 32 + 8 * fq;
        const LAS float* blk = (const LAS float*)(lds + LDS_STAGE + u.q * 4096);
        float sr[2][4];
#pragma unroll
        EPI_LOOP_AM sr[ai][m] = blk[128 * ai + 64 * wr + 16 * m + fr];
#pragma unroll
        for (int bj = 0; bj < 2; ++bj) { const int cc = 128 * bj + wc * 32 + 8 * fq;
            const f32x4 w0 = *(const LAS f32x4*)(blk + 256 + cc), w1 = *(const LAS f32x4*)(blk + 256 + cc + 4), b0 = *(const LAS f32x4*)(blk + 512 + cc), b1 = *(const LAS f32x4*)(blk + 512 + cc + 4);
#pragma unroll
            EPI_LOOP_AM { const int r = 128 * ai + 64 * wr + 16 * m + fr; f32x4 o0, o1;
#pragma unroll
                for (int jp = 0; jp < 2; ++jp) { const f32x2 s2 = (f32x2){sr[ai][m], sr[ai][m]};
                    const f32x2 a = (f32x2){(float)acc[ai][bj][m][0][2 * jp], (float)acc[ai][bj][m][0][2 * jp + 1]} * (s2 * (f32x2){w0[2 * jp], w0[2 * jp + 1]}) + (f32x2){b0[2 * jp], b0[2 * jp + 1]};
                    const f32x2 b = (f32x2){(float)acc[ai][bj][m][1][2 * jp], (float)acc[ai][bj][m][1][2 * jp + 1]} * (s2 * (f32x2){w1[2 * jp], w1[2 * jp + 1]}) + (f32x2){b1[2 * jp], b1[2 * jp + 1]};
                    o0[2 * jp] = a.x; o0[2 * jp + 1] = a.y; o1[2 * jp] = b.x; o1[2 * jp + 1] = b.y; }
                *(GAS v4u*)(yr + ((size_t)rt * 256 + r) * D + c0 + 128 * bj) = pack8(o0, o1); } }
    }
};

__device__ __forceinline__ void p3_scan(Frame& F) {
    const bf16* kvT = WSP(bf16, WS_KVT); bf16* Bcat = WSP(bf16, WS_BCAT);
    const int NQ = 2 * NH * 256 * 64;
    for (int q = F.vcu * NTHR + F.tid; q < NQ; q += F.G * NTHR) {
        const int dk4 = q & 63, dv = (q >> 6) & 255, dh = q >> 14, dir = dh >> 2, h = dh & 3;
        const float lg = -fexp((dir ? F.dec_b : F.dec_f)[h]); const float cd = fexp(lg * (float)C2);
        f32x4 S = (f32x4){0.f, 0.f, 0.f, 0.f};
        for (int s = 0; s < NCH; ++s) { const int n = dir ? (NCH - 1 - s) : s;
            const v2u kw = *(const GAS v2u*)(kvT + (((size_t)dh * NCH + n) * 256 + dv) * 256 + dk4 * 4); const f32x4 kv = (f32x4){bf_lo(kw.x), bf_hi(kw.x), bf_lo(kw.y), bf_hi(kw.y)};
            v2u w; w.x = cvt_pk_bf16(S[0], S[1]); w.y = cvt_pk_bf16(S[2], S[3]);
            *(GAS v2u*)(Bcat + ((size_t)(h * NCH + n) * 256 + dv) * CAT + 256 + dir * 256 + dk4 * 4) = w;
            S = S * cd + kv; }
    }
}

__device__ __forceinline__ void p6_router(Frame& F) {
    const bf16* z1 = WSP(bf16, WS_Z1); unsigned* h1q = WSP(unsigned, WS_H1Q); float* sxg = WSP(float, WS_SX); float* rsc = WSP(float, WS_RSC); float* st1 = WSP(float, WS_ST0) + 2 * T;
    int* topi = WSP(int, WS_RT); float* gate = (float*)(topi + 4 * T); int* posb = (int*)(gate + 4 * T); int* row_tok = posb + 4 * T;
    LAS float* hc = (LAS float*)F.lds;
    LAS float* wrc = hc + 64 * 257;
    LAS float* stl = wrc + 256 * 32;
    LAS float* lg = stl + 128;
    LAS int* hist = (LAS int*)(lg + 64 * 33);
    LAS float* sxl = (LAS float*)(hist + 64);
    for (int blk = F.vcu; blk < T / 64; blk += F.G) {
        const int t0 = blk * 64;
#pragma unroll 1
        for (int bt = 0; bt < 2; ++bt) {
            v2u raw[4][8];
#pragma unroll
            for (int rr = 0; rr < 4; ++rr) { const GAS v2u* xr = (const GAS v2u*)(z1 + (size_t)(t0 + F.wave * 8 + bt * 4 + rr) * D) + F.lane;
#pragma unroll
                for (int j = 0; j < 8; ++j) raw[rr][j] = xr[64 * j]; }
#pragma unroll
            for (int rr = 0; rr < 4; ++rr) { const int row = F.wave * 8 + bt * 4 + rr, m = t0 + row;
                f32x4 v[8]; float s = 0.f;
#pragma unroll
                for (int j = 0; j < 8; ++j) { const v2u w = raw[rr][j]; v[j] = (f32x4){bf_lo(w.x), bf_hi(w.x), bf_lo(w.y), bf_hi(w.y)}; s += (v[j][0] + v[j][1]) + (v[j][2] + v[j][3]); }
                const float mean = wave_sum(s) * (1.f / D); float s2 = 0.f;
#pragma unroll
                for (int j = 0; j < 8; ++j) { v[j] = v[j] - mean; s2 += (v[j][0] * v[j][0] + v[j][1] * v[j][1]) + (v[j][2] * v[j][2] + v[j][3] * v[j][3]); }
                const float rstd = 1.f / sqrtf(wave_sum(s2) * (1.f / D) + LN_EPS);
                float am = 0.f;
#pragma unroll
                for (int j = 0; j < 8; ++j) { const f32x4 g = *((const GAS f32x4*)F.ln1_g + F.lane + 64 * j), b = *((const GAS f32x4*)F.ln1_b + F.lane + 64 * j);
                    v[j] = v[j] * rstd * g + b; am = fmaxf(am, fmaxf(fmaxf(fabsf(v[j][0]), fabsf(v[j][1])), fmaxf(fabsf(v[j][2]), fabsf(v[j][3])))); }
#pragma unroll
                for (int o = 1; o < 64; o <<= 1) am = fmaxf(am, __shfl_xor(am, o));
                const float sc = am > 0.f ? am * (1.f / 127.f) : 1.f, inv = 1.f / sc;
#pragma unroll
                for (int j = 0; j < 8; ++j) { const int q0 = (int)__builtin_rintf(v[j][0] * inv), q1 = (int)__builtin_rintf(v[j][1] * inv), q2 = (int)__builtin_rintf(v[j][2] * inv), q3 = (int)__builtin_rintf(v[j][3] * inv);
                    h1q[(size_t)m * (D / 4) + F.lane + 64 * j] = (unsigned)(q0 & 0xff) | ((unsigned)(q1 & 0xff) << 8) | ((unsigned)(q2 & 0xff) << 16) | ((unsigned)(q3 & 0xff) << 24); }
                if (F.lane == 0) { st1[2 * m] = mean; st1[2 * m + 1] = rstd; stl[2 * row] = mean; stl[2 * row + 1] = rstd; sxg[m] = sc; sxl[row] = sc; }
            }
        }
        if (F.tid < 64) hist[F.tid] = 0;
        __syncthreads();
        const int kq = F.tid >> 7, rg = (F.tid >> 3) & 15, eq = F.tid & 7; f32x4 ac[4];
#pragma unroll
        for (int i = 0; i < 4; ++i) ac[i] = (f32x4){0.f, 0.f, 0.f, 0.f};
        LAS float* hcT = hc;
        v2u zp[8]; f32x4 wp[4];
#define P6_LOAD(kc_) do { _Pragma("unroll") for (int i_ = 0; i_ < 8; ++i_) { const int q_ = F.tid + NTHR * i_, r_ = q_ & 63, c4_ = (q_ >> 6) * 4; zp[i_] = *(const GAS v2u*)(z1 + (size_t)(t0 + r_) * D + (kc_) * 256 + c4_); } \
        _Pragma("unroll") for (int i_ = 0; i_ < 4; ++i_) { const int q_ = F.tid + NTHR * i_, k_ = q_ >> 3, c4_ = (q_ & 7) * 4; wp[i_] = *(const GAS f32x4*)(F.w_r + (size_t)((kc_) * 256 + k_) * NE + c4_); } } while (0)
        P6_LOAD(0);
        for (int kc = 0; kc < 8; ++kc) {
#pragma unroll
            for (int i = 0; i < 8; ++i) { const int q = F.tid + NTHR * i, r = q & 63, c4 = (q >> 6) * 4, col = kc * 256 + c4; const v2u zw = zp[i];
                const f32x4 zv = (f32x4){bf_lo(zw.x), bf_hi(zw.x), bf_lo(zw.y), bf_hi(zw.y)}, g = *(const GAS f32x4*)(F.ln1_g + col), b = *(const GAS f32x4*)(F.ln1_b + col);
                const f32x4 hh = (zv - stl[2 * r]) * stl[2 * r + 1] * g + b; LAS float* d = hcT + c4 * 64 + r; d[0] = hh[0]; d[64] = hh[1]; d[128] = hh[2]; d[192] = hh[3]; }
#pragma unroll
            for (int i = 0; i < 4; ++i) { const int q = F.tid + NTHR * i, k = q >> 3, c4 = (q & 7) * 4; *(LAS f32x4*)(wrc + k * 32 + c4) = wp[i]; }
            __syncthreads();
            if (kc + 1 < 8) P6_LOAD(kc + 1);
#pragma unroll 8
            for (int k = kq * 64; k < kq * 64 + 64; ++k) { const f32x4 h4 = *(const LAS f32x4*)(hcT + k * 64 + rg * 4), w4 = *(const LAS f32x4*)(wrc + k * 32 + eq * 4);
                ac[0] = ac[0] + w4 * h4[0]; ac[1] = ac[1] + w4 * h4[1]; ac[2] = ac[2] + w4 * h4[2]; ac[3] = ac[3] + w4 * h4[3]; }
            __syncthreads();
        }
#undef P6_LOAD
        { LAS float* part = hc;
#pragma unroll
          for (int i = 0; i < 4; ++i) *(LAS f32x4*)(part + (kq * 64 + rg * 4 + i) * 32 + eq * 4) = ac[i];
          __syncthreads();
          if (F.tid < 512) { const int r = F.tid >> 3, e0 = (F.tid & 7) * 4;
              const f32x4 a = *(const LAS f32x4*)(part + (0 * 64 + r) * 32 + e0), b = *(const LAS f32x4*)(part + (1 * 64 + r) * 32 + e0), c = *(const LAS f32x4*)(part + (2 * 64 + r) * 32 + e0), d4 = *(const LAS f32x4*)(part + (3 * 64 + r) * 32 + e0);
              const f32x4 br = *(const GAS f32x4*)(F.b_r + e0), sum = ((a + b) + (c + d4)) + br; LAS float* d = lg + r * 33 + e0; d[0] = sum[0]; d[1] = sum[1]; d[2] = sum[2]; d[3] = sum[3]; } }
        __syncthreads();
        int ek[4] = {0, 0, 0, 0}, lp[4] = {0, 0, 0, 0}; float gk[4] = {0.f, 0.f, 0.f, 0.f};
        if (F.tid < 64) {
            float lv[4]; unsigned used = 0u;
#pragma unroll
            for (int k = 0; k < 4; ++k) { float best = -3.0e38f; int bi = 0;
                for (int e = 0; e < NE; ++e) { const float v = lg[F.tid * 33 + e]; const bool ok = !((used >> e) & 1u) && (v > best); best = ok ? v : best; bi = ok ? e : bi; }
                used |= 1u << bi; ek[k] = bi; lv[k] = best; }
            const float mx = lv[0]; float den = 0.f;
#pragma unroll
            for (int k = 0; k < 4; ++k) { gk[k] = fexp(lv[k] - mx); den += gk[k]; }
            const float rd = 1.f / den;
#pragma unroll
            for (int k = 0; k < 4; ++k) { gk[k] *= rd; lp[k] = __hip_atomic_fetch_add(&hist[ek[k]], 1, __ATOMIC_RELAXED, __HIP_MEMORY_SCOPE_WORKGROUP); }
        }
        __syncthreads();
        if (F.tid < NE) hist[32 + F.tid] = (int)__hip_atomic_fetch_add(F.ctl + CW_CNT + 64 * F.tid, (unsigned)hist[F.tid], RLX_AGENT);
        __syncthreads();
        if (F.tid < 64) { const int tok = t0 + F.tid;
#pragma unroll
            for (int k = 0; k < 4; ++k) { const int pos = hist[32 + ek[k]] + lp[k]; row_tok[(size_t)ek[k] * T + pos] = tok; rsc[(size_t)ek[k] * T + pos] = sxl[F.tid]; topi[4 * tok + k] = ek[k]; gate[4 * tok + k] = gk[k]; posb[4 * tok + k] = pos; } }
        __syncthreads();
    }
}

__device__ __forceinline__ void build_units(Frame& F, LAS int* tstart, int nN, int c) {
    __syncthreads();
    if (F.tid < 64) { const int RT = tstart[NE], L = F.tid * F.G + c; int w = -1;
        if (L < RT * nN) { int rt, pn; gm::tile_order(L, RT, nN, rt, pn); w = rt | (pn << 10) | (tstart[40 + rt] << 15); }
        tstart[400 + F.tid] = w; }
    __syncthreads();
}

__device__ __forceinline__ void p8_requant(Frame& F, const LAS int* tstart) {
    const bf16* act = WSP(bf16, WS_ACT); unsigned* aq = WSP(unsigned, WS_ACTQ); float* sa = WSP(float, WS_SA); const unsigned* rmax = F.ctl + CW_RMAX;
    const int R = tstart[NE] * 256, gw = F.vcu * NWAVES + F.wave, NGW = F.G * NWAVES;
    for (int row = gw; row < R; row += NGW) {
        const float mx = __uint_as_float(rmax[row]); const float sc = mx > 0.f ? mx * (1.f / 127.f) : 1.f, inv = 1.f / sc;
#pragma unroll
        for (int j = 0; j < 2; ++j) { const int col = 16 * F.lane + 1024 * j;
            const v4u a = *(const GAS v4u*)(act + (size_t)row * DFF + col), b = *(const GAS v4u*)(act + (size_t)row * DFF + col + 8);
            const unsigned src[8] = {a.x, a.y, a.z, a.w, b.x, b.y, b.z, b.w}; unsigned o[4];
#pragma unroll
            for (int d = 0; d < 4; ++d) { unsigned w = 0u;
#pragma unroll
                for (int h2 = 0; h2 < 2; ++h2) { const unsigned u2 = src[2 * d + h2]; int q0 = (int)__builtin_rintf(bf_lo(u2) * inv), q1 = (int)__builtin_rintf(bf_hi(u2) * inv);
                    q0 = q0 > 127 ? 127 : (q0 < -127 ? -127 : q0); q1 = q1 > 127 ? 127 : (q1 < -127 ? -127 : q1);
                    w |= ((unsigned)(q0 & 0xff) << (16 * h2)) | ((unsigned)(q1 & 0xff) << (16 * h2 + 8)); }
                o[d] = w; }
            *(GAS v4u*)(aq + ((size_t)row * DFF + col) / 4) = (v4u){o[0], o[1], o[2], o[3]}; }
        if (F.lane == 0) sa[row] = sc;
    }
}

__device__ __forceinline__ void build_tstart(Frame& F, LAS int* tstart) {
    if (F.tid == 0) { int s = 0; for (int e = 0; e < NE; ++e) { tstart[e] = s; const unsigned n = __hip_atomic_load(F.ctl + CW_CNT + 64 * e, RLX_AGENT); s += (int)((n + 255u) >> 8); } tstart[NE] = s; }
    __syncthreads();
    for (int rt = F.tid; rt < RT_MAX; rt += NTHR) { int e = 0; for (int j = 1; j < NE; ++j) e += (tstart[j] <= rt) ? 1 : 0; tstart[40 + rt] = e; }
    __syncthreads();
}

__device__ __forceinline__ void p9_combine(Frame& F, const LAS int* tstart) {
    const bf16* z1 = WSP(bf16, WS_Z1); const float* st1 = WSP(float, WS_ST0) + 2 * T; const bf16* yr = WSP(bf16, WS_YR);
    const int* topi = WSP(int, WS_RT); const float* gate = (const float*)(topi + 4 * T); const int* posb = (const int*)(gate + 4 * T);
    const int gw = F.vcu * NWAVES + F.wave, NGW = F.G * NWAVES;
    for (int m = gw; m < T; m += NGW) {
        const float mean1 = st1[2 * m], rstd1 = st1[2 * m + 1];
        size_t ro[4]; float gk[4];
#pragma unroll
        for (int k = 0; k < 4; ++k) { const int e = topi[4 * m + k]; ro[k] = ((size_t)tstart[e] * 256 + posb[4 * m + k]) * D; gk[k] = gate[4 * m + k]; }
        f32x4 v[8]; float s = 0.f;
#pragma unroll
        for (int j = 0; j < 8; ++j) { const int col = 4 * F.lane + 256 * j;
            const v2u zw = *(const GAS v2u*)(z1 + (size_t)m * D + col); const f32x4 zv = (f32x4){bf_lo(zw.x), bf_hi(zw.x), bf_lo(zw.y), bf_hi(zw.y)}, g = *(const GAS f32x4*)(F.ln1_g + col), b = *(const GAS f32x4*)(F.ln1_b + col);
            f32x4 a = ((zv - mean1) * rstd1 * g + b) * ALPHA;
#pragma unroll
            for (int k = 0; k < 4; ++k) { const v2u w = *(const GAS v2u*)(yr + ro[k] + col); a[0] += gk[k] * bf_lo(w.x); a[1] += gk[k] * bf_hi(w.x); a[2] += gk[k] * bf_lo(w.y); a[3] += gk[k] * bf_hi(w.y); }
            v[j] = a; s += (a[0] + a[1]) + (a[2] + a[3]); }
        const float mean = wave_sum(s) * (1.f / D); float s2 = 0.f;
#pragma unroll
        for (int j = 0; j < 8; ++j) { v[j] = v[j] - mean; s2 += (v[j][0] * v[j][0] + v[j][1] * v[j][1]) + (v[j][2] * v[j][2] + v[j][3] * v[j][3]); }
        const float rstd = 1.f / sqrtf(wave_sum(s2) * (1.f / D) + LN_EPS);
#pragma unroll
        for (int j = 0; j < 8; ++j) { const int col = 4 * F.lane + 256 * j; const f32x4 g = *(const GAS f32x4*)(F.ln2_g + col), b = *(const GAS f32x4*)(F.ln2_b + col);
            *(GAS f32x4*)(F.out + (size_t)m * D + col) = v[j] * rstd * g + b; }
    }
}

constexpr int NPH = 11;
__global__ void __launch_bounds__(NTHR, 2) fwd(Args args) {
    extern __shared__ __attribute__((aligned(16))) unsigned char lds_raw[];
    Frame F;
    F.lds = (LAS unsigned char*)lds_raw; F.ws = args.ws; F.ctl = (unsigned*)(args.ws + WS_CTL);
    F.tid = threadIdx.x; F.lane = F.tid & 63; F.wave = __builtin_amdgcn_readfirstlane(F.tid >> 6);
    F.G = gridDim.x; { const int bx = blockIdx.x; F.vcu = (F.G % 8 == 0) ? (bx % 8) * (F.G / 8) + bx / 8 : bx; }
    F.x = args.in[0]; F.ln0_g = args.in[1]; F.ln0_b = args.in[2]; F.w_in = args.in[3]; F.dec_f = args.in[4]; F.dec_b = args.in[5]; F.gn_g = args.in[6]; F.w_out = args.in[7];
    F.ln1_g = args.in[8]; F.ln1_b = args.in[9]; F.w_r = args.in[10]; F.b_r = args.in[11]; F.w_up = args.in[12]; F.b_up = args.in[13]; F.w_dn = args.in[14]; F.b_dn = args.in[15];
    F.ln2_g = args.in[16]; F.ln2_b = args.in[17]; F.out = args.out;
    volatile LAS unsigned* lctl = (volatile LAS unsigned*)(F.lds + LDS_CTL_OFF);
    LAS int* tstart = (LAS int*)(F.lds + LDS_CTL_OFF + 64);
    for (int u = F.tid; u < 128; u += NTHR) lctl[u] = 0u;
    __syncthreads();
    const int lo = args.ph_lo, hi = args.ph_hi;
    const bool single = (hi - lo) > 1;
    XcdBarrier bar; bar.bar = F.ctl + CW_BAR; bar.x = 0; bar.st = lctl;
    if (single) bar = xcd_barrier_post(F.ctl + CW_BAR, lctl);
#ifndef PH_MASK
#define PH_MASK 0x7ff
#endif
#define IN(k) (((PH_MASK >> (k)) & 1) && lo <= (k) && (k) < hi)
#ifndef SUB_MASK
#define SUB_MASK 0xff
#endif
#define SUB(n) ((SUB_MASK >> (n)) & 1)
#define SEAM(k) do { if (IN(k) && IN((k) + 1)) xcd_barrier(bar); } while (0)
    const int bc = (int)blockIdx.x;

    const int nS = (NE * 128 + F.G - 1) / F.G + (NE * 64 + F.G - 1) / F.G; int sdone = 0; const int qgrp = (int)(blockIdx.x >> 3);
#define QSLOT(k24) do { const int e_ = sdone + (nS * (k24) + 23) / 24; do_slabs(F, sdone, e_ < nS ? e_ : nS); sdone = e_; } while (0)
#define QG(slot, nslots, k24) do { if (qgrp % (nslots) == (slot)) QSLOT(k24); } while (0)
    if (IN(0)) { p0_prologue(F); __syncthreads(); { const int nW = (DIN / 32 + F.G - 1) / F.G; do_slabs(F, -nW, 0); } }
    SEAM(0);
    if (IN(1)) {
        QG(0, 4, 9);
        if (SUB(0)) { SchedG1N S; S.nt = D / 128; S.pitchA = D / 2; S.pitchB = D / 2; S.multA = 1; S.multB = 1; S.G = F.G; S.c = bc; S.A = (const char*)WSP(bf16, WS_H0B); S.Bt = (const char*)WSP(bf16, WS_WIN);
          EpiG1N E{WSP(bf16, WS_QS), WSP(bf16, WS_KK), WSP(bf16, WS_GS), WSP(bf16, WS_ACAT), F.dec_f, F.dec_b, WSP(float, WS_SX0), WSP(float, WS_SWIN)};
          gm::gemm_run<EpiG1N, SchedG1N, false, true>(F.lds, S, E); }
        QG(1, 4, 9);
        if (SUB(1)) { SchedG1SF S; S.nt = D / 128; S.pitchA = D / 2; S.pitchB = D / 2; S.multA = 1; S.multB = 128; S.G = F.G; S.c = bc; S.A = (const char*)WSP(bf16, WS_WIN); S.Bt = (const char*)WSP(bf16, WS_H0B);
          EpiG1SF E{WSP(bf16, WS_UTT), WSP(float, WS_SX0), WSP(float, WS_SWIN)};
          gm::gemm_run<EpiG1SF, SchedG1SF, false, true>(F.lds, S, E); }
        QG(2, 4, 9);
        if (SUB(2)) { SchedG1SKV S; S.nt = D / 128; S.pitchA = D / 2; S.pitchB = D / 2; S.multA = 1; S.multB = 1; S.G = F.G; S.c = bc; S.A = (const char*)WSP(bf16, WS_WIN); S.Bt = (const char*)WSP(bf16, WS_H0B);
          EpiG1SKV E{WSP(bf16, WS_KTW), WSP(bf16, WS_BCAT), F.dec_f, F.dec_b, WSP(float, WS_SX0), WSP(float, WS_SWIN)};
          gm::gemm_run<EpiG1SKV, SchedG1SKV, false, true>(F.lds, S, E); }
        QG(3, 4, 9);
    }
    SEAM(1);
    if (IN(2)) {
        QG(0, 4, 6);
        if (SUB(3)) { SchedFixA S; S.nt = 2; S.pitchA = 128; S.pitchB = 128; S.multA = 1; S.multB = 1; S.G = F.G; S.c = bc; S.A = (const char*)WSP(bf16, WS_TAB); S.Bt = (const char*)WSP(bf16, WS_UTT); S.ncol = 512;
          EpiS1 E{WSP(bf16, WS_A1)};
          gm::gemm_run<EpiS1, SchedFixA, false>(F.lds, S, E); }
        QG(1, 4, 6);
        if (SUB(4)) { SchedScores S; S.nt = 4; S.pitchA = RW; S.pitchB = RW; S.multA = 1; S.multB = 1; S.G = F.G; S.c = bc; S.Q = (const char*)WSP(bf16, WS_QS); S.Kk = (const char*)WSP(bf16, WS_KK);
          EpiScores E{WSP(bf16, WS_ACAT), F.dec_f, F.dec_b};
          gm::gemm_run<EpiScores, SchedScores, false>(F.lds, S, E); }
        QG(2, 4, 6);
        if (SUB(5)) { SchedKV S; S.nt = 4; S.pitchA = CAT; S.pitchB = T; S.multA = 1; S.multB = 1; S.G = F.G; S.c = bc; S.Bcat = (const char*)WSP(bf16, WS_BCAT); S.kTw = (const char*)WSP(bf16, WS_KTW);
          EpiKV E{WSP(bf16, WS_KVT)};
          gm::gemm_run<EpiKV, SchedKV, false>(F.lds, S, E); }
        QG(3, 4, 6);
    }
    SEAM(2);
    if (IN(3)) {
        QG(0, 3, 2);
        { SchedFixA S; S.nt = 4; S.pitchA = 256; S.pitchB = 256; S.multA = 1; S.multB = 1; S.G = F.G; S.c = bc; S.A = (const char*)(WSP(bf16, WS_TAB) + 32768); S.Bt = (const char*)WSP(bf16, WS_A1); S.ncol = 512;
          EpiS2 E{WSP(bf16, WS_ZT)};
          gm::gemm_run<EpiS2, SchedFixA, false>(F.lds, S, E); }
        QG(1, 3, 2);
        p3_scan(F);
        QG(2, 3, 2);
    }
    SEAM(3);
    if (IN(4)) {
        QG(0, 3, 4);
        { SchedFixB S; S.nt = 4; S.pitchA = 256; S.pitchB = 256; S.multA = 1; S.multB = 1; S.G = F.G; S.c = bc; S.A = (const char*)WSP(bf16, WS_ZT); S.Bt = (const char*)(WSP(bf16, WS_TAB) + 32768 + 65536); S.nrow = 512;
          EpiChan E{WSP(bf16, WS_Y)};
          gm::gemm_run<EpiChan, SchedFixB, false>(F.lds, S, E); }
        QG(1, 3, 4);
        { SchedOut S; S.nt = CAT / 64; S.pitchA = CAT; S.pitchB = CAT; S.multA = 1; S.multB = 1; S.G = F.G; S.c = bc; S.Acat = (const char*)WSP(bf16, WS_ACAT); S.Bcat = (const char*)WSP(bf16, WS_BCAT);
          EpiOut E{WSP(bf16, WS_Y), WSP(bf16, WS_GS), F.gn_g};
          gm::gemm_run<EpiOut, SchedOut, false>(F.lds, S, E); }
        QG(2, 3, 4);

    }
    SEAM(4);
    if (IN(5)) {
        QG(0, 2, 3);
        Sched2D S; S.nt = D / 64; S.pitchA = D; S.pitchB = D; S.multA = 1; S.multB = 1; S.G = F.G; S.c = bc; S.A = (const char*)WSP(bf16, WS_Y); S.Bt = (const char*)WSP(bf16, WS_WOUT); S.nM = 64; S.nN = 8;
        EpiWout E{WSP(bf16, WS_Z1), F.x, WSP(float, WS_ST0), F.ln0_g, F.ln0_b};
        gm::gemm_run<EpiWout, Sched2D, false>(F.lds, S, E);
        QG(1, 2, 3);
        do_slabs(F, sdone < nS ? sdone : nS, nS);
    }
    SEAM(5);
    if (IN(6)) { p6_router(F); }
    SEAM(6);
    if (IN(7) || IN(8) || IN(9) || IN(10)) build_tstart(F, tstart);
    if (IN(7)) {
        build_units(F, tstart, 16, bc);
        SchedMoEUpT S; S.nt = D / 128; S.pitchA = D / 2; S.pitchB = D / 2; S.multA = 1; S.multB = 1; S.G = F.G; S.c = bc; S.A = (const char*)WSP(char, WS_H1Q); S.Bt = (const char*)WSP(char, WS_WUP);
        S.tstart = tstart; S.row_tok = WSP(int, WS_RT) + 12 * T; S.cnt = F.ctl + CW_CNT; S.nN = 16; S.rowbytes = D; S.estride = (size_t)2 * DFF * D;
        S.rsc = WSP(float, WS_RSC); S.swup = WSP(float, WS_SWUP); S.b_up = F.b_up;
        EpiUp E{WSP(bf16, WS_ACT), F.ctl + CW_RMAX};
        gm::gemm_run<EpiUp, SchedMoEUpT, true, true, true>(F.lds, S, E);
    }
    SEAM(7);
    if (IN(8)) { p8_requant(F, tstart); }
    SEAM(8);
    if (IN(9)) {
        build_units(F, tstart, 8, bc);
        SchedMoEDown S; S.nt = DFF / 128; S.pitchA = DFF / 2; S.pitchB = DFF / 2; S.multA = 1; S.multB = 1; S.G = F.G; S.c = bc; S.A = (const char*)WSP(char, WS_ACTQ); S.Bt = (const char*)WSP(char, WS_WDN);
        S.tstart = tstart; S.row_tok = nullptr; S.cnt = F.ctl + CW_CNT; S.nN = 8; S.rowbytes = DFF; S.estride = (size_t)D * DFF;
        S.sa = WSP(float, WS_SA); S.swdn = WSP(float, WS_SWDN); S.b_dn = F.b_dn; S.rsc = nullptr; S.swup = nullptr; S.b_up = nullptr;
        EpiDown E{WSP(bf16, WS_YR)};
        gm::gemm_run<EpiDown, SchedMoEDown, false, true, true>(F.lds, S, E);
    }
    SEAM(9);
    if (IN(10)) { p9_combine(F, tstart); }
#undef IN
#undef SEAM
}

#ifndef MK_SPLIT
#define MK_SPLIT 0
#endif
extern "C" void kernel_launch(void* const* d_in, const int* in_sizes, int n_in, void* d_out, int out_size, void* d_ws, size_t ws_size, hipStream_t stream) {
    static int grid = 0;
    if (grid == 0) {
        if (n_in != 18 || out_size != T * D || ws_size < WS_END2) { fprintf(stderr, "kernel_launch: unexpected problem: n_in %d out %d ws %zu (need %zu)\n", n_in, out_size, ws_size, (size_t)WS_END2); grid = -1; return; }
        int dev = 0, cus = 0, per_cu = 0;
        if (hipGetDevice(&dev) != hipSuccess || hipDeviceGetAttribute(&cus, hipDeviceAttributeMultiprocessorCount, dev) != hipSuccess) { grid = -1; return; }
        if (hipFuncSetAttribute((const void*)fwd, hipFuncAttributeMaxDynamicSharedMemorySize, LDS_BYTES) != hipSuccess) { fprintf(stderr, "kernel_launch: hipFuncSetAttribute failed\n"); grid = -1; return; }
        if (hipOccupancyMaxActiveBlocksPerMultiprocessor(&per_cu, (const void*)fwd, NTHR, LDS_BYTES) != hipSuccess || per_cu < 1) { fprintf(stderr, "kernel_launch: occupancy query reports %d\n", per_cu); }
        (void)hipGetLastError();
        grid = cus;
    }
    if (grid < 0) return;
    (void)hipMemsetAsync((char*)d_ws + WS_CTL, 0, CTL_BYTES, stream);
    Args a{};
    for (int i = 0; i < 18; ++i) a.in[i] = (const float*)d_in[i];
    a.out = (float*)d_out; a.ws = (unsigned char*)d_ws;
#if MK_SPLIT
    for (int p = 0; p < NPH; ++p) { a.ph_lo = p; a.ph_hi = p + 1; hipLaunchKernelGGL(fwd, dim3(grid), dim3(NTHR), LDS_BYTES, stream, a); }
#else
    a.ph_lo = 0; a.ph_hi = NPH; hipLaunchKernelGGL(fwd, dim3(grid), dim3(NTHR), LDS_BYTES, stream, a);
#endif
}
```

```cpp
#include <hip/hip_runtime.h>
#include <cstdio>
#include <cstdint>

#define GAS __attribute__((address_space(1)))
#define LAS __attribute__((address_space(3)))
typedef unsigned short bf16;
typedef unsigned v4u __attribute__((ext_vector_type(4)));
typedef unsigned v2u __attribute__((ext_vector_type(2)));
typedef float f32x4 __attribute__((ext_vector_type(4)));
typedef float f32x2 __attribute__((ext_vector_type(2)));
typedef short bf16x8 __attribute__((ext_vector_type(8)));
typedef int i32x4 __attribute__((ext_vector_type(4)));
typedef int i32x8 __attribute__((ext_vector_type(8)));
#define RLX_AGENT __ATOMIC_RELAXED, __HIP_MEMORY_SCOPE_AGENT
#define LDS_WAIT() asm volatile("s_waitcnt lgkmcnt(0)" ::: "memory")
#define VM_WAIT() asm volatile("s_waitcnt vmcnt(0)" ::: "memory")

constexpr int T = 16384, D = 2048, DIN = 5120, FW = 1024, RW = 1024, NH = 4, HD = 256, NE = 32, TOPK = 4, DFF = 2048;
constexpr int C2 = 256, NCH = T / C2;
constexpr int CAT = 768;
constexpr float LN_EPS = 1e-5f, GN_EPS = 1e-6f, ALPHA = 1.189207115002721f;
constexpr int RT_MAX = (T * TOPK) / 256 + NE;
constexpr int NWAVES = 8, NTHR = 512;

constexpr size_t MiB = 1u << 20;
constexpr size_t WS_CTL = 0, CTL_BYTES = 1 * MiB;
constexpr size_t WS_TAB = 1 * MiB;
constexpr size_t WS_WIN = 2 * MiB;
constexpr size_t WS_WOUT = WS_WIN + 20 * MiB;
constexpr size_t WS_WUP = WS_WOUT + 8 * MiB;
constexpr size_t WS_WDN = WS_WUP + 512 * MiB;
constexpr size_t WS_H0B = WS_WDN + 256 * MiB;
constexpr size_t WS_ST0 = WS_H0B + 64 * MiB;
constexpr size_t WS_UTT = WS_ST0 + 1 * MiB;
constexpr size_t WS_A1 = WS_UTT + 32 * MiB;
constexpr size_t WS_ZT = WS_A1 + 64 * MiB;
constexpr size_t WS_QS = WS_ZT + 64 * MiB;
constexpr size_t WS_KK = WS_QS + 32 * MiB;
constexpr size_t WS_GS = WS_KK + 32 * MiB;
constexpr size_t WS_ACAT = WS_GS + 32 * MiB;
constexpr size_t WS_BCAT = WS_ACAT + 96 * MiB;
constexpr size_t WS_KTW = WS_BCAT + 96 * MiB;
constexpr size_t WS_KVT = WS_KTW + 64 * MiB;
constexpr size_t WS_Y = WS_KVT + 128 * MiB;
constexpr size_t WS_Z1 = WS_Y + 64 * MiB;
constexpr size_t WS_H1B = WS_Z1 + 128 * MiB;
constexpr size_t WS_RT = WS_H1B + 64 * MiB;
constexpr size_t WS_ACT = WS_RT + 4 * MiB;
constexpr size_t WS_YR = WS_ACT + 288 * MiB;
constexpr size_t WS_END = WS_YR + 288 * MiB;
constexpr size_t WS_SWUP = WS_TAB + 512 * 1024;
constexpr size_t WS_H1Q = WS_H1B;
constexpr size_t WS_SX = WS_H1B + 32 * MiB, WS_RSC = WS_H1B + 40 * MiB, WS_SA = WS_H1B + 44 * MiB;
constexpr size_t WS_SWDN = WS_ST0 + 512 * 1024;
constexpr size_t WS_SWIN = WS_ST0 + 768 * 1024;
constexpr size_t WS_SX0 = WS_H0B + 40 * MiB;
constexpr size_t WS_ACTQ = WS_END;
constexpr size_t WS_END2 = WS_ACTQ + 144 * MiB;
constexpr int CW_RMAX = 16384;
constexpr int CW_BAR = 1024;
constexpr int CW_CNT = 8192;

constexpr int LDS_STAGE = 131072, LDS_SCR = 16384, LDS_CTL_OFF = LDS_STAGE + LDS_SCR, LDS_BYTES = LDS_CTL_OFF + 2048;

__device__ __forceinline__ unsigned cvt_pk_bf16(float lo, float hi) { unsigned r; asm volatile("v_cvt_pk_bf16_f32 %0, %1, %2" : "=v"(r) : "v"(lo), "v"(hi)); return r; }
__device__ __forceinline__ float bf_lo(unsigned u) { return __builtin_bit_cast(float, u << 16); }
__device__ __forceinline__ float bf_hi(unsigned u) { return __builtin_bit_cast(float, u & 0xffff0000u); }
__device__ __forceinline__ v4u pack8(const f32x4 a, const f32x4 b) { v4u w; w.x = cvt_pk_bf16(a[0], a[1]); w.y = cvt_pk_bf16(a[2], a[3]); w.z = cvt_pk_bf16(b[0], b[1]); w.w = cvt_pk_bf16(b[2], b[3]); return w; }
__device__ __forceinline__ float wave_sum(float v) {
#pragma unroll
    for (int o = 1; o < 64; o <<= 1) v += __shfl_xor(v, o);
    return v;
}
__device__ __forceinline__ int lane_id() { int l; asm volatile("v_mbcnt_lo_u32_b32 %0, -1, 0\n\tv_mbcnt_hi_u32_b32 %0, -1, %0" : "=v"(l)); return l; }
__device__ __forceinline__ float fexp(float x) { return __builtin_amdgcn_exp2f(x * 1.4426950408889634f); }
__device__ __forceinline__ void cs_rev(float rev, float& c, float& s) { const float f = __builtin_amdgcn_fractf(rev); c = __builtin_amdgcn_cosf(f); s = __builtin_amdgcn_sinf(f); }

#define XB_TMO      128
#define XB_XCNT(j)  (256  + 64 * (j))
#define XB_XSUB(j)  (1280 + 64 * (j))
#define XB_XGEN(j)  (2304 + 64 * (j))
#define XB_TOP      3328
#define XB_TOPGEN   3392
#define XCD_BAR_WORDS 3456
#define XB_SPIN_CAP (1u << 18)
__device__ __forceinline__ unsigned xb_ld(unsigned* p)              { return __hip_atomic_load(p, __ATOMIC_RELAXED, __HIP_MEMORY_SCOPE_AGENT); }
__device__ __forceinline__ unsigned xb_add(unsigned* p, unsigned v) { return __hip_atomic_fetch_add(p, v, __ATOMIC_RELAXED, __HIP_MEMORY_SCOPE_AGENT); }
__device__ __forceinline__ unsigned xb_xcc_id() { return (unsigned)__builtin_amdgcn_s_getreg((3 << 11) | 20) & 0xFu; }
#define XB_SPIN(cond, bar) do { unsigned _sp = 0; while (cond) { __builtin_amdgcn_s_sleep(1); \
    if ((++_sp & 255u) == 0u) { if (xb_ld(&(bar)[XB_TMO])) break; if (_sp > XB_SPIN_CAP) { atomicAdd(&(bar)[XB_TMO], 1u); break; } } } } while (0)
struct XcdBarrier { unsigned* bar; unsigned x; volatile LAS unsigned* st; int wave; };
__device__ __forceinline__ XcdBarrier xcd_barrier_post(unsigned* bar, volatile LAS unsigned* st) {
    XcdBarrier b; b.bar = bar; b.x = xb_xcc_id(); b.st = st;
    if (threadIdx.x == 0) (void)xb_add(&bar[XB_XCNT(b.x)], 1u);
    return b;
}
__device__ __forceinline__ void xcd_barrier_complete(unsigned* bar, unsigned x, unsigned& nloc, unsigned& nx) {
    const unsigned G = gridDim.x * gridDim.y * gridDim.z;
    unsigned sum, cnt, mine, sp = 0u;
    for (;;) {
        sum = 0u; cnt = 0u; mine = 0u;
#pragma unroll
        for (unsigned j = 0; j < 16; ++j) { const unsigned c = xb_ld(&bar[XB_XCNT(j)]); sum += c; cnt += (c > 0u) ? 1u : 0u; mine = (j == x) ? c : mine; }
        if (sum == G) break;
        __builtin_amdgcn_s_sleep(1);
        if ((++sp & 255u) == 0u) { if (xb_ld(&bar[XB_TMO])) break; if (sp > XB_SPIN_CAP) { atomicAdd(&bar[XB_TMO], 1u); break; } }
    }
    nloc = mine > 0u ? mine : 1u; nx = cnt > 0u ? cnt : 1u;
}
__device__ __forceinline__ void xcd_barrier(const XcdBarrier& b) {
    asm volatile("s_waitcnt vmcnt(0)" ::: "memory");
    __syncthreads();
    if (b.wave == 0 && lane_id() == 0) {
        unsigned* bar = b.bar;
        __builtin_amdgcn_s_waitcnt(0);
        unsigned nloc = b.st[0], nx = b.st[1];
        if (nloc == 0u) { xcd_barrier_complete(bar, b.x, nloc, nx); b.st[0] = nloc; b.st[1] = nx; }
        const unsigned old = xb_add(&bar[XB_XSUB(b.x)], 1u);
        const unsigned gen = old / nloc;
        if (old + 1u == (gen + 1u) * nloc) {
            __builtin_amdgcn_fence(__ATOMIC_RELEASE, "agent");
            asm volatile("s_waitcnt vmcnt(0)" ::: "memory");
            const unsigned og = xb_add(&bar[XB_TOP], 1u);
            const unsigned tg = og / nx;
            if (og + 1u == (tg + 1u) * nx) xb_add(&bar[XB_TOPGEN], 1u);
            else XB_SPIN(xb_ld(&bar[XB_TOPGEN]) == tg, bar);
            __builtin_amdgcn_fence(__ATOMIC_ACQUIRE, "agent");
            xb_add(&bar[XB_XGEN(b.x)], 1u);
            asm volatile("s_waitcnt vmcnt(0)" ::: "memory");
        } else {
            XB_SPIN(xb_ld(&bar[XB_XGEN(b.x)]) == gen, bar);
            __builtin_amdgcn_fence(__ATOMIC_ACQUIRE, "agent");
            asm volatile("s_waitcnt vmcnt(0)" ::: "memory");
        }
    }
    __syncthreads();
}

namespace gm {
constexpr int BM = 256, BK = 64, HALF = 128, HTB = HALF * BK * 2, STAGE_BYTES = 8 * HTB;
__device__ __forceinline__ int lds_byte(int r, int c) { const int st = (r >> 4) * 2 + (c >> 5), rr = r & 15, cc = c & 31, ob = rr * 64 + cc * 2; return st * 1024 + (ob ^ (((ob >> 9) & 1) << 5)); }
__device__ __forceinline__ void stage_rc(int b, int& R, int& C) { const int st = b / 1024, sb = b % 1024, swz = sb ^ (((sb >> 9) & 1) << 5); R = (st >> 1) * 16 + swz / 64; C = (st & 1) * 32 + (swz % 64) / 2; }
__device__ __forceinline__ int perm32(int rho) { const int n = rho >> 4, i = rho & 15; return 8 * (i >> 2) + 4 * n + (i & 3); }

struct Unit { const char* a0; const char* a1; const char* b0; const char* b1; int p0, p1, p2, p3, q; };

__device__ __forceinline__ void tile_order(int L, int nM, int nN, int& pm, int& pn) {
    const int nwg = nM * nN; int wgid = L;
    { const int q = nwg / 8, r = nwg % 8, xcd = wgid % 8, off = wgid / 8; wgid = (xcd < r ? xcd * (q + 1) : r * (q + 1) + (xcd - r) * q) + off; }
    const int nig = 8 * nN, gid = wgid / nig, fm = gid * 8, gsz = (nM - fm) < 8 ? (nM - fm) : 8;
    pm = fm + ((wgid % nig) % gsz); pn = (wgid % nig) / gsz;
}

template <int I8> struct AccSel { typedef f32x4 type; };
template <> struct AccSel<1> { typedef i32x4 type; };
template <class Epi, class Sched, bool GATHER, int I8 = 0, bool PREF = false>
__device__ __forceinline__ void gemm_run(LAS unsigned char* lds, const Sched& S, const Epi& E) {
    const int wid = S.wv, lane = lane_id(), tid = wid * 64 + lane, wr = wid >> 2, wc = wid & 3, fr = lane & 15, fq = lane >> 4;
    int nt = S.nt; asm volatile("" : "+s"(nt));
    unsigned voffA[2], voffB[2], colA[2]; int rowA[2];
#pragma unroll
    for (int i = 0; i < 2; ++i) { int R, C; stage_rc(tid * 16 + i * 8192, R, C); const int Rb = Epi::PERM ? ((R & ~31) + perm32(R & 31)) : R;
        voffA[i] = (unsigned)(R * S.multA * S.pitchA + C) * 2u; voffB[i] = (unsigned)(Rb * S.multB * S.pitchB + C) * 2u; colA[i] = (unsigned)C * 2u; rowA[i] = R; }
    const size_t kstep = (size_t)(BK * 2);
    const unsigned ldsw = (unsigned)wid * 1024u;
    const int aoff = lds_byte(wr * 64 + fr, fq * 8), boff = lds_byte(wc * 32 + fr, fq * 8);
#define G_SA(b, h) (((b) * 2 + (h)) * HTB)
#define G_SB(b, h) ((4 + (b) * 2 + (h)) * HTB)
#define G_STAGE(bufoff, gbase, voff) do { _Pragma("unroll") for (int _i = 0; _i < 2; ++_i) \
        __builtin_amdgcn_global_load_lds((const unsigned*)((const char*)(gbase) + (voff)[_i]), (LAS unsigned*)(lds + (bufoff) + ldsw + _i * 8192), 16, 0, 0); } while (0)
#define G_LD8(dst, addr) do { const i32x4 lo_ = *(const LAS i32x4*)(addr), hi_ = *(const LAS i32x4*)((addr) + 1024); dst = __builtin_shufflevector(lo_, hi_, 0, 1, 2, 3, 4, 5, 6, 7); } while (0)
#define G_LDA(dst, b, h) do { _Pragma("unroll") for (int m = 0; m < 4; ++m) G_LD8(dst[m], lds + G_SA(b, h) + aoff + m * 2048); } while (0)
#define G_LDB(dst, b, h) do { _Pragma("unroll") for (int n = 0; n < 2; ++n) G_LD8(dst[n], lds + G_SB(b, h) + boff + n * 2048); } while (0)
#define G_H4(x, k) ((k) ? __builtin_shufflevector(x, x, 4, 5, 6, 7) : __builtin_shufflevector(x, x, 0, 1, 2, 3))
#define G_MMA(ai, bj, At, Bt) do { __builtin_amdgcn_s_setprio(1); _Pragma("unroll") for (int m = 0; m < 4; ++m) _Pragma("unroll") for (int n = 0; n < 2; ++n) { \
        if constexpr (I8 == 2) acc[ai][bj][m][n] = __builtin_amdgcn_mfma_scale_f32_16x16x128_f8f6f4(Bt[n], At[m], acc[ai][bj][m][n], 0, 0, 0, 0x7F7F7F7F, 0, 0x7F7F7F7F); \
        else { _Pragma("unroll") for (int k = 0; k < 2; ++k) { \
            if constexpr (I8 == 1) acc[ai][bj][m][n] = __builtin_amdgcn_mfma_i32_16x16x64_i8(G_H4(Bt[n], k), G_H4(At[m], k), acc[ai][bj][m][n], 0, 0, 0); \
            else acc[ai][bj][m][n] = __builtin_amdgcn_mfma_f32_16x16x32_bf16(__builtin_bit_cast(bf16x8, G_H4(Bt[n], k)), __builtin_bit_cast(bf16x8, G_H4(At[m], k)), acc[ai][bj][m][n], 0, 0, 0); } } } \
        __builtin_amdgcn_s_setprio(0); } while (0)
#define G_WAIT_V(n) asm volatile("s_waitcnt vmcnt(" #n ")" ::: "memory")
#define G_WAIT_L(n) asm volatile("s_waitcnt lgkmcnt(" #n ")" ::: "memory")
#define G_BAR __builtin_amdgcn_s_barrier()
#define G_SCHED __builtin_amdgcn_sched_barrier(0)
    Unit cur, nxt; int ui = 0;
    if (!S.next(0, cur)) return;
    cur.q = 0;
    if constexpr (PREF) { S.prefetch(cur, lds); G_WAIT_V(0); G_BAR; }
    typedef typename AccSel<I8>::type acc_t;
    acc_t acc[2][2][4][2];
#pragma unroll
    for (int a = 0; a < 2; ++a)
#pragma unroll
        for (int b = 0; b < 2; ++b)
#pragma unroll
            for (int m = 0; m < 4; ++m)
#pragma unroll
                for (int n = 0; n < 2; ++n) acc[a][b][m][n] = (acc_t){0, 0, 0, 0};
    i32x8 At[4], B0[2], B1[2];
    unsigned gc0[2], gc1[2];
    if constexpr (GATHER) {
#pragma unroll
        for (int i = 0; i < 2; ++i) { gc0[i] = S.row_off(cur, rowA[i], lds) + colA[i]; gc1[i] = S.row_off(cur, 128 + rowA[i], lds) + colA[i]; }
    }
#define vA0 (GATHER ? gc0 : voffA)
#define vA1 (GATHER ? gc1 : voffA)
    G_STAGE(G_SB(0, 0), cur.b0, voffB); G_STAGE(G_SB(0, 1), cur.b1, voffB); G_STAGE(G_SA(0, 0), cur.a0, vA0); G_STAGE(G_SA(0, 1), cur.a1, vA1);
    if (wr == 1) G_BAR;
    G_WAIT_V(2); G_BAR;
    G_STAGE(G_SB(1, 0), cur.b0 + kstep, voffB); G_STAGE(G_SA(1, 0), cur.a0 + kstep, vA0); G_STAGE(G_SB(1, 1), cur.b1 + kstep, voffB);
    G_WAIT_V(6); G_BAR;
    for (;;) {
        const bool has_next = S.next(ui + 1, nxt);
        if (!has_next) nxt = cur;
        nxt.q = (ui + 1) & 1;
        for (int t = 0; t < nt; t += 2) {
            const bool last = (t == nt - 2);
            { const int tz_ = wid * 64 + lane_id();
#pragma unroll
              for (int i = 0; i < 2; ++i) { int R, C; stage_rc(tz_ * 16 + i * 8192, R, C); const int Rb = Epi::PERM ? ((R & ~31) + perm32(R & 31)) : R;
                  voffA[i] = (unsigned)(R * S.multA * S.pitchA + C) * 2u; voffB[i] = (unsigned)(Rb * S.multB * S.pitchB + C) * 2u; } }
            if constexpr (GATHER) asm volatile("" : "+v"(gc0[0]), "+v"(gc0[1]), "+v"(gc1[0]), "+v"(gc1[1]));
            if constexpr (PREF) { if (t == nt - 4) S.prefetch(nxt, lds); }
            const char* a11 = cur.a1 + (size_t)(t + 1) * kstep;
            const char* a02 = last ? nxt.a0 : cur.a0 + (size_t)(t + 2) * kstep; const char* a12 = last ? nxt.a1 : cur.a1 + (size_t)(t + 2) * kstep;
            const char* b02 = last ? nxt.b0 : cur.b0 + (size_t)(t + 2) * kstep; const char* b12 = last ? nxt.b1 : cur.b1 + (size_t)(t + 2) * kstep;
            G_LDB(B0, 0, 0); G_LDB(B1, 0, 1); G_SCHED; G_LDA(At, 0, 0); G_STAGE(G_SA(1, 1), a11, vA1);
            if constexpr (GATHER) { if (last) { int tz = tid; asm volatile("" : "+v"(tz));
#pragma unroll
                for (int i = 0; i < 2; ++i) { int R, C; stage_rc(tz * 16 + i * 8192, R, C); gc0[i] = S.row_off(nxt, R, lds) + (unsigned)C * 2u; gc1[i] = S.row_off(nxt, 128 + R, lds) + (unsigned)C * 2u; } } }
            G_WAIT_V(8); G_WAIT_L(0); G_BAR; G_MMA(0, 0, At, B0); G_MMA(0, 1, At, B1); G_BAR; G_SCHED;
            G_LDA(At, 0, 1); G_STAGE(G_SB(0, 0), b02, voffB); G_STAGE(G_SB(0, 1), b12, voffB); G_STAGE(G_SA(0, 0), a02, vA0);
            G_WAIT_V(8); G_WAIT_L(0); G_BAR; G_MMA(1, 0, At, B0); G_MMA(1, 1, At, B1); G_BAR; G_SCHED;
            G_LDB(B0, 1, 0); G_LDB(B1, 1, 1); G_SCHED; G_LDA(At, 1, 0); G_STAGE(G_SA(0, 1), a12, vA1);
            G_WAIT_V(8); G_WAIT_L(0); G_BAR; G_MMA(0, 0, At, B0); G_MMA(0, 1, At, B1); G_BAR; G_SCHED;
            G_LDA(At, 1, 1); G_STAGE(G_SB(1, 0), b02 + kstep, voffB); G_STAGE(G_SB(1, 1), b12 + kstep, voffB); G_STAGE(G_SA(1, 0), a02 + kstep, vA0);
            G_WAIT_V(8); G_WAIT_L(0); G_BAR; G_MMA(1, 0, At, B0); G_MMA(1, 1, At, B1); G_BAR; G_SCHED;
        }
        if (wr == 0) G_BAR;
        { int fr2 = fr, fq2 = fq; asm volatile("" : "+v"(fr2), "+v"(fq2));
          E(acc, cur, lds, wr, wc, fr2, fq2); }
        if (!has_next) break;
#pragma unroll
        for (int a = 0; a < 2; ++a)
#pragma unroll
            for (int b = 0; b < 2; ++b)
#pragma unroll
                for (int m = 0; m < 4; ++m)
#pragma unroll
                    for (int n = 0; n < 2; ++n) acc[a][b][m][n] = (acc_t){0, 0, 0, 0};
        cur = nxt; ++ui;
        if (wr == 1) G_BAR;
    }
    G_WAIT_V(0);
    G_BAR;
#undef G_SA
#undef G_SB
#undef G_STAGE
#undef G_LDA
#undef G_LD8
#undef G_H4
#undef G_LDB
#undef G_MMA
#undef G_WAIT_V
#undef G_WAIT_L
#undef G_BAR
#undef G_SCHED
#undef vA0
#undef vA1
}
}
using gm::Unit;
typedef f32x4 Acc[2][2][4][2];
typedef i32x4 AccI[2][2][4][2];

struct Args { const float* in[18]; float* out; unsigned char* ws; int ph_lo, ph_hi; };
struct Frame {
    LAS unsigned char* lds; unsigned char* ws; unsigned* ctl;
    int wave, vcu, G;
    const float *x, *ln0_g, *ln0_b, *w_in, *dec_f, *dec_b, *gn_g, *w_out, *ln1_g, *ln1_b, *w_r, *b_r, *w_up, *b_up, *w_dn, *b_dn, *ln2_g, *ln2_b;
    float* out;
};
#define WSP(T_, off) ((T_*)(F.ws + (off)))
#define FLANE lane_id()
#define FTID (F.wave * 64 + lane_id())

template <class ColMap>
__device__ __forceinline__ void transpose_item(const float* W, int K, int N, bf16* WT, LAS float* scr, int item, int lane, const ColMap& cm) {
    const int nblk = N / 64, kb = item / nblk, nb = item % nblk, k0 = 64 * kb, n0 = 64 * nb;
    const int s0 = cm(n0);
#pragma unroll 4
    for (int i = 0; i < 16; ++i) { const int kk = 4 * i + (lane >> 4), c4 = (lane & 15) * 4;
        const f32x4 v = *(const GAS f32x4*)(W + (size_t)(k0 + kk) * N + s0 + c4);
        LAS float* d = scr + kk * 65 + c4; d[0] = v[0]; d[1] = v[1]; d[2] = v[2]; d[3] = v[3]; }
    LDS_WAIT(); asm volatile("" ::: "memory");
    const int c = lane & 7;
#pragma unroll
    for (int j = 0; j < 8; ++j) { const int n = (lane >> 3) + 8 * j; const LAS float* s = scr + (8 * c) * 65 + n;
        v4u o; o.x = cvt_pk_bf16(s[0 * 65], s[1 * 65]); o.y = cvt_pk_bf16(s[2 * 65], s[3 * 65]); o.z = cvt_pk_bf16(s[4 * 65], s[5 * 65]); o.w = cvt_pk_bf16(s[6 * 65], s[7 * 65]);
        *(GAS v4u*)(WT + (size_t)(n0 + n) * K + k0 + 8 * c) = o; }
    LDS_WAIT(); asm volatile("" ::: "memory");
}
struct ColId { __device__ __forceinline__ int operator()(int n) const { return n; } };
struct ColUp { __device__ __forceinline__ int operator()(int n) const { return ((n >> 8) * 128 + (n & 127)) + ((n >> 7) & 1) * 2048; } };

__device__ __forceinline__ void p0_prologue(Frame& F) {
    const int gw = F.vcu * NWAVES + F.wave, NGW = F.G * NWAVES;
    {
        unsigned* h0q = WSP(unsigned, WS_H0B); float* st0 = WSP(float, WS_ST0); float* sx0 = WSP(float, WS_SX0);
        for (int m = gw; m < T; m += NGW) {
            const GAS f32x4* xr = (const GAS f32x4*)(F.x + (size_t)m * D) + FLANE;
            f32x4 v[8]; float s = 0.f;
#pragma unroll
            for (int j = 0; j < 8; ++j) { v[j] = xr[64 * j]; s += (v[j][0] + v[j][1]) + (v[j][2] + v[j][3]); }
            const float mean = wave_sum(s) * (1.f / D); float s2 = 0.f;
#pragma unroll
            for (int j = 0; j < 8; ++j) { v[j] = v[j] - mean; s2 += (v[j][0] * v[j][0] + v[j][1] * v[j][1]) + (v[j][2] * v[j][2] + v[j][3] * v[j][3]); }
            const float rstd = 1.f / sqrtf(wave_sum(s2) * (1.f / D) + LN_EPS); float am = 0.f;
#pragma unroll
            for (int j = 0; j < 8; ++j) { const f32x4 g = *((const GAS f32x4*)F.ln0_g + FLANE + 64 * j), b = *((const GAS f32x4*)F.ln0_b + FLANE + 64 * j);
                v[j] = v[j] * rstd * g + b; am = fmaxf(am, fmaxf(fmaxf(fabsf(v[j][0]), fabsf(v[j][1])), fmaxf(fabsf(v[j][2]), fabsf(v[j][3])))); }
#pragma unroll
            for (int o = 1; o < 64; o <<= 1) am = fmaxf(am, __shfl_xor(am, o));
            const float sc = am > 0.f ? am * (1.f / 127.f) : 1.f, inv = 1.f / sc;
#pragma unroll
            for (int j = 0; j < 8; ++j) { const int q0 = (int)__builtin_rintf(v[j][0] * inv), q1 = (int)__builtin_rintf(v[j][1] * inv), q2 = (int)__builtin_rintf(v[j][2] * inv), q3 = (int)__builtin_rintf(v[j][3] * inv);
                h0q[(size_t)m * (D / 4) + FLANE + 64 * j] = (unsigned)(q0 & 0xff) | ((unsigned)(q1 & 0xff) << 8) | ((unsigned)(q2 & 0xff) << 16) | ((unsigned)(q3 & 0xff) << 24); }
            if (FLANE == 0) { st0[2 * m] = mean; st0[2 * m + 1] = rstd; sx0[m] = sc; }
        }
    }
    {
        bf16* tab = WSP(bf16, WS_TAB);
        for (int i = (F.vcu * NTHR + FTID); i < 32768 + 65536 + 65536; i += F.G * NTHR) {
            float v;
            if (i < 32768) { const int r = i >> 7, a = i & 127, ri = r >> 7, k1 = r & 127; float c, s; cs_rev((float)((k1 * a) & 127) * (1.f / 128.f), c, s); v = ri ? -s : c; }
            else if (i < 32768 + 65536) { const int e = i - 32768, r = e >> 8, q = e & 255, ri = r >> 7, k2 = r & 127, rj = q >> 7, b = q & 127; float c, s; cs_rev((float)((k2 * b) & 127) * (1.f / 128.f), c, s);
                v = (ri == 0) ? (rj == 0 ? c : s) : (rj == 0 ? -s : c); }
            else { const int e = i - 32768 - 65536, l = e >> 8, q = e & 255, rj = q >> 7, cg = q & 127; float c, s; cs_rev((float)((l * cg) & 127) * (1.f / 128.f), c, s); v = (l < 128) ? (rj == 0 ? c : s) : 0.f; }
            tab[i] = (bf16)(cvt_pk_bf16(v, 0.f) & 0xffffu);
        }
    }
    {
        LAS float* scr = (LAS float*)(F.lds + F.wave * 18432);
        constexpr int I_IN = 32 * (DIN / 64), I_OUT = 32 * (D / 64), I_UP = 32 * (2 * DFF / 64), I_DN = 32 * (D / 64);
        constexpr int NIT = I_OUT;
        for (int it = gw; it < NIT; it += NGW) {
            int r = it;
            { transpose_item(F.w_out, D, D, WSP(bf16, WS_WOUT), scr, r, FLANE, ColId()); }
        }
    }
}

struct SlabDesc { const float* W; signed char* WQ; float* sw; int NS, e, n0, valid, fp8; };
struct QF { unsigned char* ws; const float* w_up; const float* w_dn; const float* w_in; int vcu, G; };
__device__ __forceinline__ SlabDesc slab_desc(const QF& F, int j) {
    const int nD = (NE * 64 + F.G - 1) / F.G; SlabDesc d;
    if (j < 0) { const int sl = F.vcu + (-1 - j) * F.G; d.valid = sl < DIN / 32; d.NS = DIN; d.e = 0; d.n0 = sl * 32; d.W = F.w_in + d.n0; d.WQ = (signed char*)WSP(char, WS_WIN); d.sw = WSP(float, WS_SWIN); d.fp8 = 0; }
    else if (j >= nD) { const int sl = F.vcu + (j - nD) * F.G; d.valid = sl < NE * 128; d.NS = 2 * DFF; d.e = sl >> 7; d.n0 = (sl & 127) * 32; d.W = F.w_up + (size_t)d.e * D * 2 * DFF + ColUp()(d.n0); d.WQ = (signed char*)WSP(char, WS_WUP); d.sw = WSP(float, WS_SWUP); d.fp8 = 0; }
    else { const int sl = F.vcu + j * F.G; d.valid = sl < NE * 64; d.NS = D; d.e = sl >> 6; d.n0 = (sl & 63) * 32; d.W = F.w_dn + (size_t)d.e * DFF * D + d.n0; d.WQ = (signed char*)WSP(char, WS_WDN); d.sw = WSP(float, WS_SWDN); d.fp8 = 1; }
    return d;
}
#define SLAB_LOAD(dsc, v) do { if ((dsc).valid) { const GAS char* b_ = (const GAS char*)(dsc).W; unsigned o_ = (unsigned)((wave * 256 + kq) * (dsc).NS + c4) * 4u; const unsigned st_ = (unsigned)(dsc).NS * 32u; \
    _Pragma("unroll") for (int i_ = 0; i_ < 32; ++i_) { v[i_] = __builtin_nontemporal_load((const GAS f32x4*)(b_ + o_)); o_ += st_; } } } while (0)
__device__ __forceinline__ void do_slabs_impl(LAS unsigned char* lds, unsigned char* ws, const float* w_up, const float* w_dn, const float* w_in, int vcu, int G, int wave, int j0, int j1) {
    if (j0 >= j1) return;
    QF F; F.ws = ws; F.w_up = w_up; F.w_dn = w_dn; F.w_in = w_in; F.vcu = vcu; F.G = G;
    const int lane = lane_id(), tid = wave * 64 + lane;
    constexpr int PITCH = 2056;
    LAS bf16* slab = (LAS bf16*)lds;
    LAS float* red = (LAS float*)(lds + 32 * PITCH * 2);
    const int kq = lane >> 3, c4 = (lane & 7) * 4;
    f32x4 v[32];
    SlabDesc cur = slab_desc(F, j0);
    SLAB_LOAD(cur, v);
    for (int j = j0; j < j1; ++j) {
        if (cur.valid) {
            f32x4 mx = (f32x4){0.f, 0.f, 0.f, 0.f};
#pragma unroll
            for (int i = 0; i < 32; ++i) { const int k = wave * 256 + i * 8 + kq; const f32x4 x = v[i];
                mx[0] = fmaxf(mx[0], fabsf(x[0])); mx[1] = fmaxf(mx[1], fabsf(x[1])); mx[2] = fmaxf(mx[2], fabsf(x[2])); mx[3] = fmaxf(mx[3], fabsf(x[3]));
                const unsigned p01 = cvt_pk_bf16(x[0], x[1]), p23 = cvt_pk_bf16(x[2], x[3]);
                const int ks = k ^ (((c4 >> 3) & 3) << 3);
                slab[(c4 + 0) * PITCH + ks] = (bf16)(p01 & 0xffffu); slab[(c4 + 1) * PITCH + ks] = (bf16)(p01 >> 16); slab[(c4 + 2) * PITCH + ks] = (bf16)(p23 & 0xffffu); slab[(c4 + 3) * PITCH + ks] = (bf16)(p23 >> 16); }
#pragma unroll
            for (int q = 0; q < 4; ++q) { float m = mx[q]; m = fmaxf(m, __shfl_xor(m, 8)); m = fmaxf(m, __shfl_xor(m, 16)); m = fmaxf(m, __shfl_xor(m, 32)); mx[q] = m; }
            if (lane < 8) { LAS float* d = red + wave * 32 + c4; d[0] = mx[0]; d[1] = mx[1]; d[2] = mx[2]; d[3] = mx[3]; }
        }
        const SlabDesc done = cur;
        if (j + 1 < j1) { cur = slab_desc(F, j + 1); SLAB_LOAD(cur, v); }
        __syncthreads();
        if (done.valid && tid < 32) { float m = 0.f;
#pragma unroll
            for (int w = 0; w < 8; ++w) m = fmaxf(m, red[w * 32 + tid]);
            const float sc = m > 0.f ? m * (done.fp8 ? (1.f / 448.f) : (1.f / 127.f)) : 1.f; done.sw[(size_t)done.e * done.NS + done.n0 + tid] = sc; red[256 + tid] = 1.f / sc; }
        __syncthreads();
        if (done.valid) {
#pragma unroll 2
            for (int i = 0; i < 8; ++i) { const int q = tid + NTHR * i, n = q >> 7, kc = q & 127; const float inv = red[256 + n];
                const int sx_ = ((n >> 3) & 3) << 3;
                const v4u a = *(const LAS v4u*)(slab + n * PITCH + ((kc * 16) ^ sx_)), b = *(const LAS v4u*)(slab + n * PITCH + ((kc * 16 + 8) ^ sx_));
                const unsigned src[8] = {a.x, a.y, a.z, a.w, b.x, b.y, b.z, b.w}; unsigned o[4];
                if (done.fp8) {
#pragma unroll
                    for (int d = 0; d < 4; ++d) { int w = __builtin_amdgcn_cvt_pk_fp8_f32(bf_lo(src[2 * d]) * inv, bf_hi(src[2 * d]) * inv, 0, false);
                        w = __builtin_amdgcn_cvt_pk_fp8_f32(bf_lo(src[2 * d + 1]) * inv, bf_hi(src[2 * d + 1]) * inv, w, true); o[d] = (unsigned)w; }
                } else {
#pragma unroll
                for (int d = 0; d < 4; ++d) { unsigned w = 0u;
#pragma unroll
                    for (int h2 = 0; h2 < 2; ++h2) { const unsigned u2 = src[2 * d + h2]; const int q0 = (int)__builtin_rintf(bf_lo(u2) * inv), q1 = (int)__builtin_rintf(bf_hi(u2) * inv);
                        w |= ((unsigned)(q0 & 0xff) << (16 * h2)) | ((unsigned)(q1 & 0xff) << (16 * h2 + 8)); }
                    o[d] = w; }
                }
                *(GAS v4u*)(done.WQ + ((size_t)done.e * done.NS + done.n0 + n) * D + kc * 16) = (v4u){o[0], o[1], o[2], o[3]}; }
        }
        __syncthreads();
    }
}

__device__ __forceinline__ void do_slabs(Frame& F, int j0, int j1) { do_slabs_impl(F.lds, F.ws, F.w_up, F.w_dn, F.w_in, F.vcu, F.G, F.wave, j0, j1); }

struct SchedBase { int nt, pitchA, pitchB, multA, multB, G, c, wv; };
struct SchedG1N : SchedBase {
    const char* A; const char* Bt;
    __device__ __forceinline__ bool next(int i, Unit& u) const { const int L = i * G + c; if (L >= 64 * 12) return false; int pm, pn; gm::tile_order(L, 64, 12, pm, pn);
        const int cb = pn < 4 ? 1024 + 256 * pn : (pn < 8 ? 2048 + 256 * (pn - 4) : 4096 + 256 * (pn - 8));
        u.a0 = A + (size_t)pm * 256 * D; u.a1 = u.a0 + (size_t)128 * D; u.b0 = Bt + (size_t)cb * D; u.b1 = u.b0 + (size_t)128 * D; u.p0 = pm; u.p1 = pn; u.p2 = cb; u.p3 = 0; return true; }
};
struct SchedG1SF : SchedBase {
    const char* A; const char* Bt;
    __device__ __forceinline__ bool next(int i, Unit& u) const { const int L = i * G + c; if (L >= 4 * 64) return false; int pm, pn; gm::tile_order(L, 4, 64, pm, pn);
        u.a0 = A + (size_t)pm * 256 * D; u.a1 = u.a0 + (size_t)128 * D; u.b0 = Bt + (size_t)(2 * pn) * D; u.b1 = u.b0 + (size_t)D; u.p0 = pm; u.p1 = pn; u.p2 = 0; u.p3 = 0; return true; }
};
struct SchedG1SKV : SchedBase {
    const char* A; const char* Bt;
    __device__ __forceinline__ bool next(int i, Unit& u) const { const int L = i * G + c; if (L >= 8 * 64) return false; int pm, pn; gm::tile_order(L, 8, 64, pm, pn);
        const int rb = pm < 4 ? 2048 + 256 * pm : 3072 + 256 * (pm - 4);
        u.a0 = A + (size_t)rb * D; u.a1 = u.a0 + (size_t)128 * D; u.b0 = Bt + (size_t)pn * 256 * D; u.b1 = u.b0 + (size_t)128 * D; u.p0 = pm; u.p1 = pn; u.p2 = rb; u.p3 = 0; return true; }
};
struct SchedFixA : SchedBase {
    const char* A; const char* Bt; int ncol;
    __device__ __forceinline__ bool next(int i, Unit& u) const { const int L = i * G + c; if (L >= ncol) return false;
        u.a0 = A; u.a1 = A + (size_t)128 * pitchA * 2; u.b0 = Bt + (size_t)L * 256 * pitchB * 2; u.b1 = u.b0 + (size_t)128 * pitchB * 2; u.p0 = 0; u.p1 = L; u.p2 = 0; u.p3 = 0; return true; }
};
struct SchedFixB : SchedBase {
    const char* A; const char* Bt; int nrow;
    __device__ __forceinline__ bool next(int i, Unit& u) const { const int L = i * G + c; if (L >= nrow) return false;
        u.a0 = A + (size_t)L * 256 * pitchA * 2; u.a1 = u.a0 + (size_t)128 * pitchA * 2; u.b0 = Bt; u.b1 = Bt + (size_t)128 * pitchB * 2; u.p0 = L; u.p1 = 0; u.p2 = 0; u.p3 = 0; return true; }
};
struct SchedScores : SchedBase {
    const char* Q; const char* Kk;
    __device__ __forceinline__ bool next(int i, Unit& u) const { const int L = i * G + c; if (L >= NH * NCH) return false; const int h = L & 3, n = L >> 2;
        u.a0 = Q + ((size_t)n * 256 * RW + h * HD) * 2; u.a1 = u.a0 + (size_t)128 * RW * 2; u.b0 = Kk + ((size_t)n * 256 * RW + h * HD) * 2; u.b1 = u.b0 + (size_t)128 * RW * 2; u.p0 = h; u.p1 = n; u.p2 = 0; u.p3 = 0; return true; }
};
struct SchedKV : SchedBase {
    const char* Bcat; const char* kTw;
    __device__ __forceinline__ bool next(int i, Unit& u) const { const int L = i * G + c; if (L >= 2 * NH * NCH) return false; const int dh = L & 7, n = L >> 3, dir = dh >> 2, h = dh & 3;
        u.a0 = Bcat + ((size_t)(h * NCH + n) * 256 * CAT) * 2; u.a1 = u.a0 + (size_t)128 * CAT * 2;
        u.b0 = kTw + (((size_t)dir * RW + h * HD) * T + (size_t)n * 256) * 2; u.b1 = u.b0 + (size_t)128 * T * 2; u.p0 = dh; u.p1 = n; u.p2 = 0; u.p3 = 0; return true; }
};
struct SchedOut : SchedBase {
    const char* Acat; const char* Bcat;
    __device__ __forceinline__ bool next(int i, Unit& u) const { const int L = i * G + c; if (L >= NH * NCH) return false; const int h = L & 3, n = L >> 2;
        u.a0 = Acat + ((size_t)h * T + (size_t)n * 256) * CAT * 2; u.a1 = u.a0 + (size_t)128 * CAT * 2; u.b0 = Bcat + ((size_t)(h * NCH + n) * 256 * CAT) * 2; u.b1 = u.b0 + (size_t)128 * CAT * 2; u.p0 = h; u.p1 = n; u.p2 = 0; u.p3 = 0; return true; }
};
struct Sched2D : SchedBase {
    const char* A; const char* Bt; int nM, nN;
    __device__ __forceinline__ bool next(int i, Unit& u) const { const int L = i * G + c; if (L >= nM * nN) return false; int pm, pn; gm::tile_order(L, nM, nN, pm, pn);
        u.a0 = A + (size_t)pm * 256 * pitchA * 2; u.a1 = u.a0 + (size_t)128 * pitchA * 2; u.b0 = Bt + (size_t)pn * 256 * pitchB * 2; u.b1 = u.b0 + (size_t)128 * pitchB * 2; u.p0 = pm; u.p1 = pn; u.p2 = 0; u.p3 = 0; return true; }
};
struct SchedMoE : SchedBase {
    const char* A; const char* Bt; const LAS int* tstart; const int* row_tok; const unsigned* cnt; int nN, rowbytes; size_t estride;
    __device__ __forceinline__ bool next(int i, Unit& u) const { const int RT = __builtin_amdgcn_readfirstlane(tstart[NE]); const int L = i * G + c; if (L >= RT * nN) return false; int rt, pn; gm::tile_order(L, RT, nN, rt, pn);
        const int e = __builtin_amdgcn_readfirstlane(tstart[40 + rt]);
        u.b0 = Bt + (size_t)e * estride + (size_t)pn * 256 * rowbytes; u.b1 = u.b0 + (size_t)128 * rowbytes;
        u.a0 = A; u.a1 = A;
        u.p0 = rt; u.p1 = pn; u.p2 = e; u.p3 = (rt - __builtin_amdgcn_readfirstlane(tstart[e])) * 256; return true; }
    __device__ __forceinline__ bool next_tab(int i, Unit& u) const { const int w = (i < 64) ? __builtin_amdgcn_readfirstlane(tstart[400 + i]) : -1; if (w < 0) return false;
        const int rt = w & 1023, pn = (w >> 10) & 31, e = (w >> 15) & 31;
        u.b0 = Bt + (size_t)e * estride + (size_t)pn * 256 * rowbytes; u.b1 = u.b0 + (size_t)128 * rowbytes; u.a0 = A; u.a1 = A;
        u.p0 = rt; u.p1 = pn; u.p2 = e; u.p3 = (rt - __builtin_amdgcn_readfirstlane(tstart[e])) * 256; return true; }
    const float *rsc, *swup, *b_up;
    __device__ __forceinline__ void prefetch(const Unit& u, LAS unsigned char* lds) const {
        LAS unsigned char* blk = lds + LDS_STAGE + u.q * 4096;
        const int wid = wv, e = u.p2; int lane = lane_id(); asm volatile("" : "+v"(lane));
        const int n = (int)cnt[64 * e]; int pos = u.p3 + (wid & 3) * 64 + lane; pos = pos < n ? pos : n - 1;
        if (wid < 4) __builtin_amdgcn_global_load_lds((const unsigned*)(row_tok + (size_t)e * T + pos), (LAS unsigned*)(blk + wid * 256), 4, 0, 0);
        else __builtin_amdgcn_global_load_lds((const unsigned*)(rsc + (size_t)e * T + pos), (LAS unsigned*)(blk + 1024 + (wid - 4) * 256), 4, 0, 0);
        if (wid == 0) __builtin_amdgcn_global_load_lds((const unsigned*)(swup + (size_t)e * 2 * DFF + u.p1 * 256 + lane * 4), (LAS unsigned*)(blk + 2048), 16, 0, 0);
        if (wid == 1) __builtin_amdgcn_global_load_lds((const unsigned*)(b_up + (size_t)e * 2 * DFF + u.p1 * 128 + (lane & 31) * 4 + (lane >> 5) * DFF), (LAS unsigned*)(blk + 3072), 16, 0, 0);
    }
    __device__ __forceinline__ unsigned row_off(const Unit& u, int r, LAS unsigned char* lds) const { return (unsigned)((const LAS int*)(lds + LDS_STAGE + u.q * 4096))[r] * (unsigned)rowbytes; }
};
struct SchedMoEUpT : SchedMoE { __device__ __forceinline__ bool next(int i, Unit& u) const { return next_tab(i, u); } };
struct SchedMoEDown : SchedMoE {
    const float *sa, *swdn, *b_dn;
    __device__ __forceinline__ bool next(int i, Unit& u) const { if (!SchedMoE::next_tab(i, u)) return false; u.a0 = A + (size_t)u.p0 * 256 * rowbytes; u.a1 = u.a0 + (size_t)128 * rowbytes; return true; }
    __device__ __forceinline__ void prefetch(const Unit& u, LAS unsigned char* lds) const {
        LAS unsigned char* blk = lds + LDS_STAGE + u.q * 4096;
        const int wid = wv, e = u.p2; int lane = lane_id(); asm volatile("" : "+v"(lane));
        if (wid == 1) __builtin_amdgcn_global_load_lds((const unsigned*)(swdn + (size_t)e * D + u.p1 * 256 + lane * 4), (LAS unsigned*)(blk + 1024), 16, 0, 0);
        if (wid == 2) __builtin_amdgcn_global_load_lds((const unsigned*)(b_dn + (size_t)e * D + u.p1 * 256 + lane * 4), (LAS unsigned*)(blk + 2048), 16, 0, 0);
    }
};

#define EPI_LOOP_AM for (int ai = 0; ai < 2; ++ai) _Pragma("unroll") for (int m = 0; m < 4; ++m)
#define EPI_FENCE __builtin_amdgcn_sched_barrier(0)
struct EpiG1N {
    static constexpr bool PERM = true;
    bf16 *qs, *kk, *gs, *Acat; const float *dec_f, *dec_b, *sx0, *swin;
    __device__ __forceinline__ void operator()(AccI& acci, const Unit& u, LAS unsigned char*, int wr, int wc, int fr, int fq) const {
        const int pm = u.p0, pn = u.p1, c0 = wc * 32 + 8 * fq;
        f32x4 swc[2][2];
#pragma unroll
        for (int bj = 0; bj < 2; ++bj)
#pragma unroll
            for (int n = 0; n < 2; ++n) swc[bj][n] = *(const GAS f32x4*)(swin + u.p2 + 128 * bj + c0 + 4 * n);
#define ACCF(ai_, bj_, m_, n_, j_) ((float)acci[ai_][bj_][m_][n_][j_] * (sxr * swc[bj_][n_][j_]))
        if (pn < 8) {
            const int h = pn & 3; const bool isq = pn < 4;
            float inv[8];
#pragma unroll
            for (int e = 0; e < 8; ++e) inv[e] = __builtin_amdgcn_exp2f(-(float)(c0 + e) * (13.287712379549449f / 128.f)) * 0.15915494309189535f;
            const float lgf = -fexp(dec_f[h]), lgb = -fexp(dec_b[h]);
#pragma unroll
            EPI_LOOP_AM {
                const int r = 128 * ai + 64 * wr + 16 * m + fr, tok = pm * 256 + r; const float pos = (float)tok; const float sxr = sx0[tok];
                f32x4 o1[2], o2[2];
#pragma unroll
                for (int n = 0; n < 2; ++n)
#pragma unroll
                    for (int j = 0; j < 4; ++j) { float c, s; cs_rev(pos * inv[4 * n + j], c, s); const float x1 = ACCF(ai, 0, m, n, j), x2 = ACCF(ai, 1, m, n, j); o1[n][j] = x1 * c - x2 * s; o2[n][j] = x2 * c + x1 * s; }
                if (isq) {
                    bf16* q = qs + (size_t)tok * RW + h * HD + c0; *(GAS v4u*)q = pack8(o1[0], o1[1]); *(GAS v4u*)(q + 128) = pack8(o2[0], o2[1]);
                    const int il = r; const float wf = fexp(lgf * (float)(il + 1)), wb = fexp(lgb * (float)(255 - il));
                    bf16* a = Acat + ((size_t)h * T + tok) * CAT + c0;
                    *(GAS v4u*)(a + 256) = pack8(o1[0] * wf, o1[1] * wf); *(GAS v4u*)(a + 384) = pack8(o2[0] * wf, o2[1] * wf);
                    *(GAS v4u*)(a + 512) = pack8(o1[0] * wb, o1[1] * wb); *(GAS v4u*)(a + 640) = pack8(o2[0] * wb, o2[1] * wb);
                } else {
                    bf16* k = kk + (size_t)tok * RW + h * HD + c0; *(GAS v4u*)k = pack8(o1[0] * 0.0625f, o1[1] * 0.0625f); *(GAS v4u*)(k + 128) = pack8(o2[0] * 0.0625f, o2[1] * 0.0625f);
                }
            }
        } else {
#pragma unroll
            EPI_LOOP_AM {
                const int r = 128 * ai + 64 * wr + 16 * m + fr, tok = pm * 256 + r; const float sxr = sx0[tok];
#pragma unroll
                for (int bj = 0; bj < 2; ++bj) { f32x4 v[2];
#pragma unroll
                    for (int n = 0; n < 2; ++n)
#pragma unroll
                        for (int j = 0; j < 4; ++j) { const float g = ACCF(ai, bj, m, n, j); v[n][j] = g * __builtin_amdgcn_rcpf(1.f + fexp(-g)); }
                    *(GAS v4u*)(gs + (size_t)tok * RW + (pn - 8) * 256 + bj * 128 + c0) = pack8(v[0], v[1]); }
            }
        }
    }
};
#undef ACCF
struct EpiG1SF {
    static constexpr bool PERM = true;
    bf16* uTT; const float *sx0, *swin;
    __device__ __forceinline__ void operator()(AccI& acc, const Unit& u, LAS unsigned char*, int wr, int wc, int fr, int fq) const {
        const int a0 = wc * 32 + 8 * fq;
        float sxc[2][8];
#pragma unroll
        for (int bj = 0; bj < 2; ++bj)
#pragma unroll
            for (int e = 0; e < 8; ++e) sxc[bj][e] = sx0[128 * (a0 + e) + 2 * u.p1 + bj];
#pragma unroll
        EPI_LOOP_AM { const int cch = u.p0 * 256 + 128 * ai + 64 * wr + 16 * m + fr; const float swr = swin[cch];
#pragma unroll
            for (int bj = 0; bj < 2; ++bj) { f32x4 v0, v1;
#pragma unroll
                for (int j = 0; j < 4; ++j) { v0[j] = (float)acc[ai][bj][m][0][j] * (swr * sxc[bj][j]); v1[j] = (float)acc[ai][bj][m][1][j] * (swr * sxc[bj][4 + j]); }
                *(GAS v4u*)(uTT + ((size_t)cch * 128 + (2 * u.p1 + bj)) * 128 + a0) = pack8(v0, v1); } }
    }
};
struct EpiG1SKV {
    static constexpr bool PERM = true;
    bf16 *kTw, *Bcat; const float *dec_f, *dec_b, *sx0, *swin;
    __device__ __forceinline__ void operator()(AccI& acc, const Unit& u, LAS unsigned char*, int wr, int wc, int fr, int fq) const {
        const int pm = u.p0, n_ch = u.p1, c0 = wc * 32 + 8 * fq;
        f32x4 sxc[2][2];
#pragma unroll
        for (int bj = 0; bj < 2; ++bj)
#pragma unroll
            for (int n = 0; n < 2; ++n) sxc[bj][n] = *(const GAS f32x4*)(sx0 + n_ch * 256 + 128 * bj + c0 + 4 * n);
        if (pm < 4) {
            const int h = pm; const float lgf = -fexp(dec_f[h]), lgb = -fexp(dec_b[h]);
#pragma unroll
            for (int m = 0; m < 4; ++m) {
                const int d = 64 * wr + 16 * m + fr;
                const float sw1 = swin[u.p2 + d], sw2 = swin[u.p2 + 128 + d];
                const float inv = __builtin_amdgcn_exp2f(-(float)d * (13.287712379549449f / 128.f)) * 0.15915494309189535f;
#pragma unroll
                for (int bj = 0; bj < 2; ++bj) {
                    f32x4 f1[2], f2[2], b1[2], b2[2];
#pragma unroll
                    for (int n = 0; n < 2; ++n)
#pragma unroll
                        for (int j = 0; j < 4; ++j) { const int il = 128 * bj + c0 + 4 * n + j; const float pos = (float)(n_ch * 256 + il); float c, s; cs_rev(pos * inv, c, s);
                            const float x1 = (float)acc[0][bj][m][n][j] * (sw1 * sxc[bj][n][j]), x2 = (float)acc[1][bj][m][n][j] * (sw2 * sxc[bj][n][j]); const float o1 = (x1 * c - x2 * s) * 0.0625f, o2 = (x2 * c + x1 * s) * 0.0625f;
                            const float wf = fexp(lgf * (float)(255 - il)), wb = fexp(lgb * (float)(il + 1));
                            f1[n][j] = o1 * wf; f2[n][j] = o2 * wf; b1[n][j] = o1 * wb; b2[n][j] = o2 * wb; }
                    const size_t tcol = (size_t)n_ch * 256 + 128 * bj + c0;
                    bf16* pf = kTw + ((size_t)(h * HD + d)) * T + tcol; bf16* pb = pf + (size_t)RW * T;
                    *(GAS v4u*)pf = pack8(f1[0], f1[1]); *(GAS v4u*)(pf + (size_t)128 * T) = pack8(f2[0], f2[1]);
                    *(GAS v4u*)pb = pack8(b1[0], b1[1]); *(GAS v4u*)(pb + (size_t)128 * T) = pack8(b2[0], b2[1]);
                }
            }
        } else {
            const int h = pm - 4;
#pragma unroll
            EPI_LOOP_AM { const int dv = 128 * ai + 64 * wr + 16 * m + fr; const float swr = swin[u.p2 + dv];
#pragma unroll
                for (int bj = 0; bj < 2; ++bj) { f32x4 v0, v1;
#pragma unroll
                    for (int j = 0; j < 4; ++j) { v0[j] = (float)acc[ai][bj][m][0][j] * (swr * sxc[bj][0][j]); v1[j] = (float)acc[ai][bj][m][1][j] * (swr * sxc[bj][1][j]); }
                    *(GAS v4u*)(Bcat + ((size_t)(h * NCH + n_ch) * 256 + dv) * CAT + 128 * bj + c0) = pack8(v0, v1); } }
        }
    }
};
struct EpiS1 {
    static constexpr bool PERM = true;
    bf16* A1;
    __device__ __forceinline__ void operator()(Acc& acc, const Unit& u, LAS unsigned char*, int wr, int wc, int fr, int fq) const {
        const int b0 = wc * 32 + 8 * fq;
#pragma unroll
        for (int m = 0; m < 4; ++m) { const int k1 = 64 * wr + 16 * m + fr;
#pragma unroll
            for (int bj = 0; bj < 2; ++bj) { const int cch = 2 * u.p1 + bj; f32x4 re[2], im[2];
#pragma unroll
                for (int n = 0; n < 2; ++n)
#pragma unroll
                    for (int j = 0; j < 4; ++j) { const int b = b0 + 4 * n + j; float c, s; cs_rev((float)(k1 * b) * (1.f / 16384.f), c, s);
                        const float xr = acc[0][bj][m][n][j], xi = acc[1][bj][m][n][j]; re[n][j] = xr * c + xi * s; im[n][j] = xi * c - xr * s; }
                bf16* p = A1 + (((size_t)k1 * 1024 + cch) * 2) * 128 + b0;
                *(GAS v4u*)p = pack8(re[0], re[1]); *(GAS v4u*)(p + 128) = pack8(im[0], im[1]); EPI_FENCE; } }
    }
};
struct EpiS2 {
    static constexpr bool PERM = true;
    bf16* Zt;
    __device__ __forceinline__ void operator()(Acc& acc, const Unit& u, LAS unsigned char*, int wr, int wc, int fr, int fq) const {
        const int k1 = u.p1 >> 2, cb = (u.p1 & 3) * 256, c0 = wc * 32 + 8 * fq;
#pragma unroll
        EPI_LOOP_AM { const int k2 = 64 * wr + 16 * m + fr, k = k1 + 128 * k2;
#pragma unroll
            for (int bj = 0; bj < 2; ++bj) { const int cch = cb + 128 * bj + c0, g = cch >> 7, cg = cch & 127;
                *(GAS v4u*)(Zt + (size_t)k * 2048 + g * 256 + ai * 128 + cg) = pack8(acc[ai][bj][m][0], acc[ai][bj][m][1]); } }
    }
};
struct EpiChan {
    static constexpr bool PERM = true;
    bf16* y;
    __device__ __forceinline__ void operator()(Acc& acc, const Unit& u, LAS unsigned char*, int wr, int wc, int fr, int fq) const {
        const int l0 = wc * 32 + 8 * fq; const float norm = 6.9053396600248786e-4f;
#pragma unroll
        EPI_LOOP_AM { const int R = u.p0 * 256 + 128 * ai + 64 * wr + 16 * m + fr, k = R >> 3, g = R & 7;
            *(GAS v4u*)(y + (size_t)k * D + g * 128 + l0) = pack8(acc[ai][0][m][0] * norm, acc[ai][0][m][1] * norm); }
    }
};
struct EpiScores {
    static constexpr bool PERM = true;
    bf16* Acat; const float *dec_f, *dec_b;
    __device__ __forceinline__ void operator()(Acc& acc, const Unit& u, LAS unsigned char*, int wr, int wc, int fr, int fq) const {
        const int h = u.p0, n_ch = u.p1, c0 = wc * 32 + 8 * fq; const float lgf = -fexp(dec_f[h]), lgb = -fexp(dec_b[h]);
#pragma unroll
        EPI_LOOP_AM { const int i = 128 * ai + 64 * wr + 16 * m + fr;
#pragma unroll
            for (int bj = 0; bj < 2; ++bj) { f32x4 v[2];
#pragma unroll
                for (int n = 0; n < 2; ++n)
#pragma unroll
                    for (int j = 0; j < 4; ++j) { const int jc = 128 * bj + c0 + 4 * n + j; const float dd = (float)(i - jc); const float w = (jc <= i) ? fexp(lgf * dd) : fexp(-lgb * dd); v[n][j] = acc[ai][bj][m][n][j] * w; }
                *(GAS v4u*)(Acat + ((size_t)h * T + n_ch * 256 + i) * CAT + 128 * bj + c0) = pack8(v[0], v[1]); EPI_FENCE; } }
    }
};
struct EpiKV {
    static constexpr bool PERM = true;
    bf16* kvT;
    __device__ __forceinline__ void operator()(Acc& acc, const Unit& u, LAS unsigned char*, int wr, int wc, int fr, int fq) const {
#pragma unroll
        EPI_LOOP_AM { const int dv = 128 * ai + 64 * wr + 16 * m + fr; bf16* rowp = kvT + (((size_t)u.p0 * NCH + u.p1) * 256 + dv) * 256 + wc * 32 + 8 * fq;
#pragma unroll
            for (int bj = 0; bj < 2; ++bj) *(GAS v4u*)(rowp + bj * 128) = pack8(acc[ai][bj][m][0], acc[ai][bj][m][1]); }
    }
};
struct EpiOut {
    static constexpr bool PERM = true;
    bf16* y; const bf16* gs; const float* gn_g;
    __device__ __forceinline__ void operator()(Acc& acc, const Unit& u, LAS unsigned char* lds, int wr, int wc, int fr, int fq) const {
        const int h = u.p0, n_ch = u.p1, c0 = wc * 32 + 8 * fq;
        LAS f32x2* P = (LAS f32x2*)(lds + LDS_STAGE);
#pragma unroll
        EPI_LOOP_AM {
            float s = 0.f;
#pragma unroll
            for (int bj = 0; bj < 2; ++bj)
#pragma unroll
                for (int n = 0; n < 2; ++n) { const f32x4 x = acc[ai][bj][m][n]; s += (x[0] + x[1]) + (x[2] + x[3]); }
            s += __shfl_xor(s, 16); s += __shfl_xor(s, 32);
            const float mw = s * (1.f / 64.f); float q = 0.f;
#pragma unroll
            for (int bj = 0; bj < 2; ++bj)
#pragma unroll
                for (int n = 0; n < 2; ++n) { const f32x4 d = acc[ai][bj][m][n] - mw; q += (d[0] * d[0] + d[1] * d[1]) + (d[2] * d[2] + d[3] * d[3]); }
            q += __shfl_xor(q, 16); q += __shfl_xor(q, 32);
            if (fq == 0) P[(128 * ai + 64 * wr + 16 * m + fr) * 4 + wc] = (f32x2){mw, q};
        }
        LDS_WAIT(); __builtin_amdgcn_s_barrier(); asm volatile("" ::: "memory");
#pragma unroll
        EPI_LOOP_AM {
            const int r = 128 * ai + 64 * wr + 16 * m + fr, tok = n_ch * 256 + r;
            const f32x2 a = P[r * 4 + 0], b = P[r * 4 + 1], c = P[r * 4 + 2], d = P[r * 4 + 3];
            const float mt = (a.x + b.x + c.x + d.x) * 0.25f; const float da = a.x - mt, db = b.x - mt, dc = c.x - mt, dd = d.x - mt;
            const float m2 = (a.y + b.y) + (c.y + d.y) + 64.f * ((da * da + db * db) + (dc * dc + dd * dd));
            const float rstd = 1.f / sqrtf(m2 * (1.f / 256.f) + GN_EPS);
#pragma unroll
            for (int bj = 0; bj < 2; ++bj) {
                const int col = h * HD + 128 * bj + c0; const v4u gv = *(const GAS v4u*)(gs + (size_t)tok * RW + col);
                const f32x4 g0 = *(const GAS f32x4*)(gn_g + col), g1 = *(const GAS f32x4*)(gn_g + col + 4);
                f32x4 o0 = (acc[ai][bj][m][0] - mt) * rstd * g0, o1 = (acc[ai][bj][m][1] - mt) * rstd * g1;
                o0[0] *= bf_lo(gv.x); o0[1] *= bf_hi(gv.x); o0[2] *= bf_lo(gv.y); o0[3] *= bf_hi(gv.y); o1[0] *= bf_lo(gv.z); o1[1] *= bf_hi(gv.z); o1[2] *= bf_lo(gv.w); o1[3] *= bf_hi(gv.w);
                *(GAS v4u*)(y + (size_t)tok * D + FW + col) = pack8(o0, o1); }
        }
        LDS_WAIT(); __builtin_amdgcn_s_barrier(); asm volatile("" ::: "memory");
    }
};
struct EpiWout {
    static constexpr bool PERM = true;
    bf16* z1; const float *x, *st0, *g0, *b0;
    __device__ __forceinline__ void operator()(Acc& acc, const Unit& u, LAS unsigned char*, int wr, int wc, int fr, int fq) const {
        const int colb = u.p1 * 256 + wc * 32 + 8 * fq;
#pragma unroll
        for (int bj = 0; bj < 2; ++bj) { const int col = colb + bj * 128;
            const f32x4 ga = *(const GAS f32x4*)(g0 + col), gb = *(const GAS f32x4*)(g0 + col + 4), ba = *(const GAS f32x4*)(b0 + col), bb = *(const GAS f32x4*)(b0 + col + 4);
#pragma unroll
            EPI_LOOP_AM { const int row = u.p0 * 256 + 128 * ai + 64 * wr + 16 * m + fr; const f32x2 st = *(const GAS f32x2*)(st0 + 2 * row); const size_t off = (size_t)row * D + col;
                const f32x4 xa = *(const GAS f32x4*)(x + off), xb = *(const GAS f32x4*)(x + off + 4);
                *(GAS v4u*)(z1 + off) = pack8(((xa - st.x) * st.y * ga + ba) * ALPHA + acc[ai][bj][m][0], ((xb - st.x) * st.y * gb + bb) * ALPHA + acc[ai][bj][m][1]); } }
    }
};
struct EpiUp {
    static constexpr bool PERM = true;
    unsigned char* act8;
    __device__ __forceinline__ void operator()(AccI& acc, const Unit& u, LAS unsigned char* lds, int wr, int wc, int fr, int fq) const {
        const int rt = u.p0, pn = u.p1, c0 = pn * 128 + wc * 32 + 8 * fq;
        const LAS float* blk = (const LAS float*)(lds + LDS_STAGE + u.q * 4096);
        float sx[2][4];
#pragma unroll
        EPI_LOOP_AM sx[ai][m] = blk[256 + 128 * ai + 64 * wr + 16 * m + fr];
#pragma unroll
        for (int n = 0; n < 2; ++n) {
            const int cc = wc * 32 + 8 * fq + 4 * n;
            const f32x4 sg = *(const LAS f32x4*)(blk + 512 + cc), sl = *(const LAS f32x4*)(blk + 512 + 128 + cc), bg = *(const LAS f32x4*)(blk + 768 + cc), bl = *(const LAS f32x4*)(blk + 768 + 128 + cc);
#pragma unroll
            EPI_LOOP_AM { const int r = 128 * ai + 64 * wr + 16 * m + fr; f32x2 v2[2];
#pragma unroll
                for (int jp = 0; jp < 2; ++jp) {
                    const f32x2 sx2 = (f32x2){sx[ai][m], sx[ai][m]};
                    f32x2 gl = (f32x2){(float)acc[ai][0][m][n][2 * jp], (float)acc[ai][0][m][n][2 * jp + 1]} * (sx2 * (f32x2){sg[2 * jp], sg[2 * jp + 1]}) + (f32x2){bg[2 * jp], bg[2 * jp + 1]};
                    f32x2 li = (f32x2){(float)acc[ai][1][m][n][2 * jp], (float)acc[ai][1][m][n][2 * jp + 1]} * (sx2 * (f32x2){sl[2 * jp], sl[2 * jp + 1]}) + (f32x2){bl[2 * jp], bl[2 * jp + 1]};
                    gl = __builtin_elementwise_min(gl, (f32x2){7.f, 7.f}); li = __builtin_elementwise_min(__builtin_elementwise_max(li, (f32x2){-7.f, -7.f}), (f32x2){7.f, 7.f});
                    const f32x2 ea = gl * (-1.702f * 1.4426950408889634f); f32x2 den; den.x = __builtin_amdgcn_exp2f(ea.x); den.y = __builtin_amdgcn_exp2f(ea.y); den = den + 1.0f;
                    f32x2 rc; rc.x = __builtin_amdgcn_rcpf(den.x); rc.y = __builtin_amdgcn_rcpf(den.y);
                    v2[jp] = (gl * rc) * (li * 4.0f + 4.0f); }
                int p = __builtin_amdgcn_cvt_pk_fp8_f32(v2[0].x, v2[0].y, 0, false); p = __builtin_amdgcn_cvt_pk_fp8_f32(v2[1].x, v2[1].y, p, true);
                *(GAS int*)(act8 + ((size_t)rt * 256 + r) * DFF + c0 + 4 * n) = p; }
        }
    }
};
struct EpiDown {
    static constexpr bool PERM = true;
    bf16* yr;
    __device__ __forceinline__ void operator()(Acc& acc, const Unit& u, LAS unsigned char* lds, int wr, int wc, int fr, int fq) const {
        const int rt = u.p0, pn = u.p1, c0 = pn * 256 + wc * 32 + 8 * fq;
        const LAS float* blk = (const LAS float*)(lds + LDS_STAGE + u.q * 4096);
#pragma unroll
        for (int bj = 0; bj < 2; ++bj) { const int cc = 128 * bj + wc * 32 + 8 * fq;
#pragma unroll
            EPI_LOOP_AM { const int r = 128 * ai + 64 * wr + 16 * m + fr;
                const f32x4 w0 = *(const LAS f32x4*)(blk + 256 + cc) * 0.25f, w1 = *(const LAS f32x4*)(blk + 256 + cc + 4) * 0.25f, b0 = *(const LAS f32x4*)(blk + 512 + cc), b1 = *(const LAS f32x4*)(blk + 512 + cc + 4);
                *(GAS v4u*)(yr + ((size_t)rt * 256 + r) * D + c0 + 128 * bj) = pack8(acc[ai][bj][m][0] * w0 + b0, acc[ai][bj][m][1] * w1 + b1); EPI_FENCE; } }
    }
};

__device__ __forceinline__ void p3_scan(Frame& F) {
    const bf16* kvT = WSP(bf16, WS_KVT); bf16* Bcat = WSP(bf16, WS_BCAT);
    const int NQ = 2 * NH * 256 * 64;
    for (int q = F.vcu * NTHR + FTID; q < NQ; q += F.G * NTHR) {
        const int dk4 = q & 63, dv = (q >> 6) & 255, dh = q >> 14, dir = dh >> 2, h = dh & 3;
        const float lg = -fexp((dir ? F.dec_b : F.dec_f)[h]); const float cd = fexp(lg * (float)C2);
        f32x4 S = (f32x4){0.f, 0.f, 0.f, 0.f};
        for (int s = 0; s < NCH; ++s) { const int n = dir ? (NCH - 1 - s) : s;
            const v2u kw = *(const GAS v2u*)(kvT + (((size_t)dh * NCH + n) * 256 + dv) * 256 + dk4 * 4); const f32x4 kv = (f32x4){bf_lo(kw.x), bf_hi(kw.x), bf_lo(kw.y), bf_hi(kw.y)};
            v2u w; w.x = cvt_pk_bf16(S[0], S[1]); w.y = cvt_pk_bf16(S[2], S[3]);
            *(GAS v2u*)(Bcat + ((size_t)(h * NCH + n) * 256 + dv) * CAT + 256 + dir * 256 + dk4 * 4) = w;
            S = S * cd + kv; }
    }
}

__device__ __forceinline__ void p6_router(Frame& F) {
    const bf16* z1 = WSP(bf16, WS_Z1); unsigned* h1q = WSP(unsigned, WS_H1Q); float* sxg = WSP(float, WS_SX); float* rsc = WSP(float, WS_RSC); float* st1 = WSP(float, WS_ST0) + 2 * T;
    int* topi = WSP(int, WS_RT); float* gate = (float*)(topi + 4 * T); int* posb = (int*)(gate + 4 * T); int* row_tok = posb + 4 * T;
    LAS float* hc = (LAS float*)F.lds;
    LAS float* wrc = hc + 64 * 257;
    LAS float* stl = wrc + 256 * 32;
    LAS float* lg = stl + 128;
    LAS int* hist = (LAS int*)(lg + 64 * 33);
    LAS float* sxl = (LAS float*)(hist + 64);
    for (int blk = F.vcu; blk < T / 64; blk += F.G) {
        const int t0 = blk * 64;
#pragma unroll 1
        for (int bt = 0; bt < 2; ++bt) {
            v2u raw[4][8];
#pragma unroll
            for (int rr = 0; rr < 4; ++rr) { const GAS v2u* xr = (const GAS v2u*)(z1 + (size_t)(t0 + F.wave * 8 + bt * 4 + rr) * D) + FLANE;
#pragma unroll
                for (int j = 0; j < 8; ++j) raw[rr][j] = xr[64 * j]; }
#pragma unroll
            for (int rr = 0; rr < 4; ++rr) { const int row = F.wave * 8 + bt * 4 + rr, m = t0 + row;
                f32x4 v[8]; float s = 0.f;
#pragma unroll
                for (int j = 0; j < 8; ++j) { const v2u w = raw[rr][j]; v[j] = (f32x4){bf_lo(w.x), bf_hi(w.x), bf_lo(w.y), bf_hi(w.y)}; s += (v[j][0] + v[j][1]) + (v[j][2] + v[j][3]); }
                const float mean = wave_sum(s) * (1.f / D); float s2 = 0.f;
#pragma unroll
                for (int j = 0; j < 8; ++j) { v[j] = v[j] - mean; s2 += (v[j][0] * v[j][0] + v[j][1] * v[j][1]) + (v[j][2] * v[j][2] + v[j][3] * v[j][3]); }
                const float rstd = 1.f / sqrtf(wave_sum(s2) * (1.f / D) + LN_EPS);
                float am = 0.f;
#pragma unroll
                for (int j = 0; j < 8; ++j) { const f32x4 g = *((const GAS f32x4*)F.ln1_g + FLANE + 64 * j), b = *((const GAS f32x4*)F.ln1_b + FLANE + 64 * j);
                    v[j] = v[j] * rstd * g + b; am = fmaxf(am, fmaxf(fmaxf(fabsf(v[j][0]), fabsf(v[j][1])), fmaxf(fabsf(v[j][2]), fabsf(v[j][3])))); }
#pragma unroll
                for (int o = 1; o < 64; o <<= 1) am = fmaxf(am, __shfl_xor(am, o));
                const float sc = am > 0.f ? am * (1.f / 127.f) : 1.f, inv = 1.f / sc;
#pragma unroll
                for (int j = 0; j < 8; ++j) { const int q0 = (int)__builtin_rintf(v[j][0] * inv), q1 = (int)__builtin_rintf(v[j][1] * inv), q2 = (int)__builtin_rintf(v[j][2] * inv), q3 = (int)__builtin_rintf(v[j][3] * inv);
                    h1q[(size_t)m * (D / 4) + FLANE + 64 * j] = (unsigned)(q0 & 0xff) | ((unsigned)(q1 & 0xff) << 8) | ((unsigned)(q2 & 0xff) << 16) | ((unsigned)(q3 & 0xff) << 24); }
                if (FLANE == 0) { st1[2 * m] = mean; st1[2 * m + 1] = rstd; stl[2 * row] = mean; stl[2 * row + 1] = rstd; sxg[m] = sc; sxl[row] = sc; }
            }
        }
        if (FTID < 64) hist[FTID] = 0;
        __syncthreads();
        const int kq = FTID >> 7, rg = (FTID >> 3) & 15, eq = FTID & 7; f32x4 ac[4];
#pragma unroll
        for (int i = 0; i < 4; ++i) ac[i] = (f32x4){0.f, 0.f, 0.f, 0.f};
        LAS float* hcT = hc;
        v2u zp[8]; f32x4 wp[4];
#define P6_LOAD(kc_) do { _Pragma("unroll") for (int i_ = 0; i_ < 8; ++i_) { const int q_ = FTID + NTHR * i_, r_ = q_ & 63, c4_ = (q_ >> 6) * 4; zp[i_] = *(const GAS v2u*)(z1 + (size_t)(t0 + r_) * D + (kc_) * 256 + c4_); } \
        _Pragma("unroll") for (int i_ = 0; i_ < 4; ++i_) { const int q_ = FTID + NTHR * i_, k_ = q_ >> 3, c4_ = (q_ & 7) * 4; wp[i_] = *(const GAS f32x4*)(F.w_r + (size_t)((kc_) * 256 + k_) * NE + c4_); } } while (0)
        P6_LOAD(0);
        for (int kc = 0; kc < 8; ++kc) {
#pragma unroll
            for (int i = 0; i < 8; ++i) { const int q = FTID + NTHR * i, r = q & 63, c4 = (q >> 6) * 4, col = kc * 256 + c4; const v2u zw = zp[i];
                const f32x4 zv = (f32x4){bf_lo(zw.x), bf_hi(zw.x), bf_lo(zw.y), bf_hi(zw.y)}, g = *(const GAS f32x4*)(F.ln1_g + col), b = *(const GAS f32x4*)(F.ln1_b + col);
                const f32x4 hh = (zv - stl[2 * r]) * stl[2 * r + 1] * g + b; LAS float* d = hcT + c4 * 64 + r; d[0] = hh[0]; d[64] = hh[1]; d[128] = hh[2]; d[192] = hh[3]; }
#pragma unroll
            for (int i = 0; i < 4; ++i) { const int q = FTID + NTHR * i, k = q >> 3, c4 = (q & 7) * 4; *(LAS f32x4*)(wrc + k * 32 + c4) = wp[i]; }
            __syncthreads();
            if (kc + 1 < 8) P6_LOAD(kc + 1);
#pragma unroll 8
            for (int k = kq * 64; k < kq * 64 + 64; ++k) { const f32x4 h4 = *(const LAS f32x4*)(hcT + k * 64 + rg * 4), w4 = *(const LAS f32x4*)(wrc + k * 32 + eq * 4);
                ac[0] = ac[0] + w4 * h4[0]; ac[1] = ac[1] + w4 * h4[1]; ac[2] = ac[2] + w4 * h4[2]; ac[3] = ac[3] + w4 * h4[3]; }
            __syncthreads();
        }
#undef P6_LOAD
        { LAS float* part = hc;
#pragma unroll
          for (int i = 0; i < 4; ++i) *(LAS f32x4*)(part + (kq * 64 + rg * 4 + i) * 32 + eq * 4) = ac[i];
          __syncthreads();
          if (FTID < 512) { const int r = FTID >> 3, e0 = (FTID & 7) * 4;
              const f32x4 a = *(const LAS f32x4*)(part + (0 * 64 + r) * 32 + e0), b = *(const LAS f32x4*)(part + (1 * 64 + r) * 32 + e0), c = *(const LAS f32x4*)(part + (2 * 64 + r) * 32 + e0), d4 = *(const LAS f32x4*)(part + (3 * 64 + r) * 32 + e0);
              const f32x4 br = *(const GAS f32x4*)(F.b_r + e0), sum = ((a + b) + (c + d4)) + br; LAS float* d = lg + r * 33 + e0; d[0] = sum[0]; d[1] = sum[1]; d[2] = sum[2]; d[3] = sum[3]; } }
        __syncthreads();
        int ek[4] = {0, 0, 0, 0}, lp[4] = {0, 0, 0, 0}; float gk[4] = {0.f, 0.f, 0.f, 0.f};
        if (FTID < 64) {
            float lv[4]; unsigned used = 0u;
#pragma unroll
            for (int k = 0; k < 4; ++k) { float best = -3.0e38f; int bi = 0;
                for (int e = 0; e < NE; ++e) { const float v = lg[FTID * 33 + e]; const bool ok = !((used >> e) & 1u) && (v > best); best = ok ? v : best; bi = ok ? e : bi; }
                used |= 1u << bi; ek[k] = bi; lv[k] = best; }
            const float mx = lv[0]; float den = 0.f;
#pragma unroll
            for (int k = 0; k < 4; ++k) { gk[k] = fexp(lv[k] - mx); den += gk[k]; }
            const float rd = 1.f / den;
#pragma unroll
            for (int k = 0; k < 4; ++k) { gk[k] *= rd; lp[k] = __hip_atomic_fetch_add(&hist[ek[k]], 1, __ATOMIC_RELAXED, __HIP_MEMORY_SCOPE_WORKGROUP); }
        }
        __syncthreads();
        if (FTID < NE) hist[32 + FTID] = (int)__hip_atomic_fetch_add(F.ctl + CW_CNT + 64 * FTID, (unsigned)hist[FTID], RLX_AGENT);
        __syncthreads();
        if (FTID < 64) { const int tok = t0 + FTID;
#pragma unroll
            for (int k = 0; k < 4; ++k) { const int pos = hist[32 + ek[k]] + lp[k]; row_tok[(size_t)ek[k] * T + pos] = tok; rsc[(size_t)ek[k] * T + pos] = sxl[FTID]; topi[4 * tok + k] = ek[k]; gate[4 * tok + k] = gk[k]; posb[4 * tok + k] = pos; } }
        __syncthreads();
    }
}

__device__ __forceinline__ void build_units(Frame& F, LAS int* tstart, int nN, int c) {
    __syncthreads();
    if (FTID < 64) { const int RT = tstart[NE], L = FTID * F.G + c; int w = -1;
        if (L < RT * nN) { int rt, pn; gm::tile_order(L, RT, nN, rt, pn); w = rt | (pn << 10) | (tstart[40 + rt] << 15); }
        tstart[400 + FTID] = w; }
    __syncthreads();
}

__device__ __forceinline__ void p8_requant(Frame& F, const LAS int* tstart) {
    const bf16* act = WSP(bf16, WS_ACT); unsigned* aq = WSP(unsigned, WS_ACTQ); float* sa = WSP(float, WS_SA); const unsigned* rmax = F.ctl + CW_RMAX;
    const int R = tstart[NE] * 256, gw = F.vcu * NWAVES + F.wave, NGW = F.G * NWAVES;
    for (int row = gw; row < R; row += NGW) {
        const float mx = __uint_as_float(rmax[row]); const float sc = mx > 0.f ? mx * (1.f / 127.f) : 1.f, inv = 1.f / sc;
#pragma unroll
        for (int j = 0; j < 2; ++j) { const int col = 16 * FLANE + 1024 * j;
            const v4u a = *(const GAS v4u*)(act + (size_t)row * DFF + col), b = *(const GAS v4u*)(act + (size_t)row * DFF + col + 8);
            const unsigned src[8] = {a.x, a.y, a.z, a.w, b.x, b.y, b.z, b.w}; unsigned o[4];
#pragma unroll
            for (int d = 0; d < 4; ++d) { unsigned w = 0u;
#pragma unroll
                for (int h2 = 0; h2 < 2; ++h2) { const unsigned u2 = src[2 * d + h2]; int q0 = (int)__builtin_rintf(bf_lo(u2) * inv), q1 = (int)__builtin_rintf(bf_hi(u2) * inv);
                    q0 = q0 > 127 ? 127 : (q0 < -127 ? -127 : q0); q1 = q1 > 127 ? 127 : (q1 < -127 ? -127 : q1);
                    w |= ((unsigned)(q0 & 0xff) << (16 * h2)) | ((unsigned)(q1 & 0xff) << (16 * h2 + 8)); }
                o[d] = w; }
            *(GAS v4u*)(aq + ((size_t)row * DFF + col) / 4) = (v4u){o[0], o[1], o[2], o[3]}; }
        if (FLANE == 0) sa[row] = sc;
    }
}

__device__ __forceinline__ void build_tstart(Frame& F, LAS int* tstart) {
    if (FTID == 0) { int s = 0; for (int e = 0; e < NE; ++e) { tstart[e] = s; const unsigned n = __hip_atomic_load(F.ctl + CW_CNT + 64 * e, RLX_AGENT); s += (int)((n + 255u) >> 8); } tstart[NE] = s; }
    __syncthreads();
    for (int rt = FTID; rt < RT_MAX; rt += NTHR) { int e = 0; for (int j = 1; j < NE; ++j) e += (tstart[j] <= rt) ? 1 : 0; tstart[40 + rt] = e; }
    __syncthreads();
}

__device__ __forceinline__ void p9_combine(Frame& F, const LAS int* tstart) {
    const bf16* z1 = WSP(bf16, WS_Z1); const float* st1 = WSP(float, WS_ST0) + 2 * T; const bf16* yr = WSP(bf16, WS_YR);
    const int* topi = WSP(int, WS_RT); const float* gate = (const float*)(topi + 4 * T); const int* posb = (const int*)(gate + 4 * T);
    const int gw = F.vcu * NWAVES + F.wave, NGW = F.G * NWAVES; const int lane = lane_id();
    for (int m = gw; m < T; m += NGW) {
        const float mean1 = st1[2 * m], rstd1 = st1[2 * m + 1];
        size_t ro[4]; float gk[4];
#pragma unroll
        for (int k = 0; k < 4; ++k) { const int e = topi[4 * m + k]; ro[k] = ((size_t)tstart[e] * 256 + posb[4 * m + k]) * D; gk[k] = gate[4 * m + k]; }
        f32x4 v[8]; float s = 0.f;
#pragma unroll
        for (int j = 0; j < 8; ++j) { const int col = 4 * lane + 256 * j;
            const v2u zw = *(const GAS v2u*)(z1 + (size_t)m * D + col); const f32x4 zv = (f32x4){bf_lo(zw.x), bf_hi(zw.x), bf_lo(zw.y), bf_hi(zw.y)}, g = *(const GAS f32x4*)(F.ln1_g + col), b = *(const GAS f32x4*)(F.ln1_b + col);
            f32x4 a = ((zv - mean1) * rstd1 * g + b) * ALPHA;
#pragma unroll
            for (int k = 0; k < 4; ++k) { const v2u w = *(const GAS v2u*)(yr + ro[k] + col); a[0] += gk[k] * bf_lo(w.x); a[1] += gk[k] * bf_hi(w.x); a[2] += gk[k] * bf_lo(w.y); a[3] += gk[k] * bf_hi(w.y); }
            v[j] = a; s += (a[0] + a[1]) + (a[2] + a[3]); }
        const float mean = wave_sum(s) * (1.f / D); float s2 = 0.f;
#pragma unroll
        for (int j = 0; j < 8; ++j) { v[j] = v[j] - mean; s2 += (v[j][0] * v[j][0] + v[j][1] * v[j][1]) + (v[j][2] * v[j][2] + v[j][3] * v[j][3]); }
        const float rstd = 1.f / sqrtf(wave_sum(s2) * (1.f / D) + LN_EPS);
#pragma unroll
        for (int j = 0; j < 8; ++j) { const int col = 4 * lane + 256 * j; const f32x4 g = *(const GAS f32x4*)(F.ln2_g + col), b = *(const GAS f32x4*)(F.ln2_b + col);
            *(GAS f32x4*)(F.out + (size_t)m * D + col) = v[j] * rstd * g + b; }
    }
}

constexpr int NPH = 10;
__global__ void __launch_bounds__(NTHR, 2) fwd(Args args) {
    extern __shared__ __attribute__((aligned(16))) unsigned char lds_raw[];
    Frame F;
    F.lds = (LAS unsigned char*)lds_raw; F.ws = args.ws; F.ctl = (unsigned*)(args.ws + WS_CTL);
    F.wave = __builtin_amdgcn_readfirstlane((int)threadIdx.x >> 6);
    F.G = gridDim.x; { const int bx = blockIdx.x; F.vcu = (F.G % 8 == 0) ? (bx % 8) * (F.G / 8) + bx / 8 : bx; }
#define CAS __attribute__((address_space(4)))
#define FRAME_RELOAD() do { const CAS char* kp_ = (const CAS char*)__builtin_amdgcn_kernarg_segment_ptr(); asm volatile("" : "+s"(kp_)); const CAS Args* ap_ = (const CAS Args*)kp_; \
    F.x = ap_->in[0]; F.ln0_g = ap_->in[1]; F.ln0_b = ap_->in[2]; F.w_in = ap_->in[3]; F.dec_f = ap_->in[4]; F.dec_b = ap_->in[5]; F.gn_g = ap_->in[6]; F.w_out = ap_->in[7]; \
    F.ln1_g = ap_->in[8]; F.ln1_b = ap_->in[9]; F.w_r = ap_->in[10]; F.b_r = ap_->in[11]; F.w_up = ap_->in[12]; F.b_up = ap_->in[13]; F.w_dn = ap_->in[14]; F.b_dn = ap_->in[15]; \
    F.ln2_g = ap_->in[16]; F.ln2_b = ap_->in[17]; F.out = ap_->out; F.ws = ap_->ws; F.ctl = (unsigned*)(F.ws + WS_CTL); } while (0)
    FRAME_RELOAD();
    volatile LAS unsigned* lctl = (volatile LAS unsigned*)(F.lds + LDS_CTL_OFF);
    LAS int* tstart = (LAS int*)(F.lds + LDS_CTL_OFF + 64);
    for (int u = FTID; u < 128; u += NTHR) lctl[u] = 0u;
    __syncthreads();
    const int lo = args.ph_lo, hi = args.ph_hi;
    const bool single = (hi - lo) > 1;
    XcdBarrier bar; bar.bar = F.ctl + CW_BAR; bar.x = 0; bar.st = lctl; bar.wave = F.wave;
    if (single) { bar = xcd_barrier_post(F.ctl + CW_BAR, lctl); bar.wave = F.wave; }
#ifndef PH_MASK
#define PH_MASK 0x3ff
#endif
#define IN(k) (((PH_MASK >> (k)) & 1) && lo <= (k) && (k) < hi)
#ifndef SUB_MASK
#define SUB_MASK 0xff
#endif
#define SUB(n) ((SUB_MASK >> (n)) & 1)
#define SEAM(k) do { if (IN(k) && IN((k) + 1)) xcd_barrier(bar); } while (0)
    const int bc = (int)blockIdx.x;

    const int nS = (NE * 128 + F.G - 1) / F.G + (NE * 64 + F.G - 1) / F.G; int sdone = 0; const int qgrp = (int)(blockIdx.x >> 3);
#define QSLOT(k24) do { const int e_ = sdone + (nS * (k24) + 23) / 24; do_slabs(F, sdone, e_ < nS ? e_ : nS); sdone = e_; } while (0)
#define QG(slot, nslots, k24) do { if (qgrp % (nslots) == (slot)) QSLOT(k24); } while (0)
    if (IN(0)) { FRAME_RELOAD(); p0_prologue(F); __syncthreads(); { const int nW = (DIN / 32 + F.G - 1) / F.G; do_slabs(F, -nW, 0); } }
    SEAM(0);
    if (IN(1)) { FRAME_RELOAD();
        QG(0, 4, 9);
        if (SUB(0)) { SchedG1N S; S.nt = D / 128; S.pitchA = D / 2; S.pitchB = D / 2; S.multA = 1; S.multB = 1; S.G = F.G; S.c = bc; S.wv = F.wave; S.A = (const char*)WSP(bf16, WS_H0B); S.Bt = (const char*)WSP(bf16, WS_WIN);
          EpiG1N E{WSP(bf16, WS_QS), WSP(bf16, WS_KK), WSP(bf16, WS_GS), WSP(bf16, WS_ACAT), F.dec_f, F.dec_b, WSP(float, WS_SX0), WSP(float, WS_SWIN)};
          gm::gemm_run<EpiG1N, SchedG1N, false, true>(F.lds, S, E); }
        QG(1, 4, 9);
        if (SUB(1)) { SchedG1SF S; S.nt = D / 128; S.pitchA = D / 2; S.pitchB = D / 2; S.multA = 1; S.multB = 128; S.G = F.G; S.c = bc; S.wv = F.wave; S.A = (const char*)WSP(bf16, WS_WIN); S.Bt = (const char*)WSP(bf16, WS_H0B);
          EpiG1SF E{WSP(bf16, WS_UTT), WSP(float, WS_SX0), WSP(float, WS_SWIN)};
          gm::gemm_run<EpiG1SF, SchedG1SF, false, true>(F.lds, S, E); }
        QG(2, 4, 9);
        if (SUB(2)) { SchedG1SKV S; S.nt = D / 128; S.pitchA = D / 2; S.pitchB = D / 2; S.multA = 1; S.multB = 1; S.G = F.G; S.c = bc; S.wv = F.wave; S.A = (const char*)WSP(bf16, WS_WIN); S.Bt = (const char*)WSP(bf16, WS_H0B);
          EpiG1SKV E{WSP(bf16, WS_KTW), WSP(bf16, WS_BCAT), F.dec_f, F.dec_b, WSP(float, WS_SX0), WSP(float, WS_SWIN)};
          gm::gemm_run<EpiG1SKV, SchedG1SKV, false, true>(F.lds, S, E); }
        QG(3, 4, 9);
    }
    SEAM(1);
    if (IN(2)) { FRAME_RELOAD();
        QG(0, 4, 6);
        if (SUB(3)) { SchedFixA S; S.nt = 2; S.pitchA = 128; S.pitchB = 128; S.multA = 1; S.multB = 1; S.G = F.G; S.c = bc; S.wv = F.wave; S.A = (const char*)WSP(bf16, WS_TAB); S.Bt = (const char*)WSP(bf16, WS_UTT); S.ncol = 512;
          EpiS1 E{WSP(bf16, WS_A1)};
          gm::gemm_run<EpiS1, SchedFixA, false>(F.lds, S, E); }
        QG(1, 4, 6);
        if (SUB(4)) { SchedScores S; S.nt = 4; S.pitchA = RW; S.pitchB = RW; S.multA = 1; S.multB = 1; S.G = F.G; S.c = bc; S.wv = F.wave; S.Q = (const char*)WSP(bf16, WS_QS); S.Kk = (const char*)WSP(bf16, WS_KK);
          EpiScores E{WSP(bf16, WS_ACAT), F.dec_f, F.dec_b};
          gm::gemm_run<EpiScores, SchedScores, false>(F.lds, S, E); }
        QG(2, 4, 6);
        if (SUB(5)) { SchedKV S; S.nt = 4; S.pitchA = CAT; S.pitchB = T; S.multA = 1; S.multB = 1; S.G = F.G; S.c = bc; S.wv = F.wave; S.Bcat = (const char*)WSP(bf16, WS_BCAT); S.kTw = (const char*)WSP(bf16, WS_KTW);
          EpiKV E{WSP(bf16, WS_KVT)};
          gm::gemm_run<EpiKV, SchedKV, false>(F.lds, S, E); }
        QG(3, 4, 6);
    }
    SEAM(2);
    if (IN(3)) { FRAME_RELOAD();
        QG(0, 3, 2);
        { SchedFixA S; S.nt = 4; S.pitchA = 256; S.pitchB = 256; S.multA = 1; S.multB = 1; S.G = F.G; S.c = bc; S.wv = F.wave; S.A = (const char*)(WSP(bf16, WS_TAB) + 32768); S.Bt = (const char*)WSP(bf16, WS_A1); S.ncol = 512;
          EpiS2 E{WSP(bf16, WS_ZT)};
          gm::gemm_run<EpiS2, SchedFixA, false>(F.lds, S, E); }
        QG(1, 3, 2);
        p3_scan(F);
        QG(2, 3, 2);
    }
    SEAM(3);
    if (IN(4)) { FRAME_RELOAD();
        QG(0, 3, 4);
        { SchedFixB S; S.nt = 4; S.pitchA = 256; S.pitchB = 256; S.multA = 1; S.multB = 1; S.G = F.G; S.c = bc; S.wv = F.wave; S.A = (const char*)WSP(bf16, WS_ZT); S.Bt = (const char*)(WSP(bf16, WS_TAB) + 32768 + 65536); S.nrow = 512;
          EpiChan E{WSP(bf16, WS_Y)};
          gm::gemm_run<EpiChan, SchedFixB, false>(F.lds, S, E); }
        QG(1, 3, 4);
        { SchedOut S; S.nt = CAT / 64; S.pitchA = CAT; S.pitchB = CAT; S.multA = 1; S.multB = 1; S.G = F.G; S.c = bc; S.wv = F.wave; S.Acat = (const char*)WSP(bf16, WS_ACAT); S.Bcat = (const char*)WSP(bf16, WS_BCAT);
          EpiOut E{WSP(bf16, WS_Y), WSP(bf16, WS_GS), F.gn_g};
          gm::gemm_run<EpiOut, SchedOut, false>(F.lds, S, E); }
        QG(2, 3, 4);

    }
    SEAM(4);
    if (IN(5)) { FRAME_RELOAD();
        QG(0, 2, 3);
        Sched2D S; S.nt = D / 64; S.pitchA = D; S.pitchB = D; S.multA = 1; S.multB = 1; S.G = F.G; S.c = bc; S.wv = F.wave; S.A = (const char*)WSP(bf16, WS_Y); S.Bt = (const char*)WSP(bf16, WS_WOUT); S.nM = 64; S.nN = 8;
        EpiWout E{WSP(bf16, WS_Z1), F.x, WSP(float, WS_ST0), F.ln0_g, F.ln0_b};
        gm::gemm_run<EpiWout, Sched2D, false>(F.lds, S, E);
        QG(1, 2, 3);
        do_slabs(F, sdone < nS ? sdone : nS, nS);
    }
    SEAM(5);
    if (IN(6)) { FRAME_RELOAD(); p6_router(F); }
    SEAM(6);
    if (IN(7) || IN(8) || IN(9)) build_tstart(F, tstart);
    if (IN(7)) { FRAME_RELOAD();
        build_units(F, tstart, 16, bc);
        SchedMoEUpT S; S.nt = D / 128; S.pitchA = D / 2; S.pitchB = D / 2; S.multA = 1; S.multB = 1; S.G = F.G; S.c = bc; S.wv = F.wave; S.A = (const char*)WSP(char, WS_H1Q); S.Bt = (const char*)WSP(char, WS_WUP);
        S.tstart = tstart; S.row_tok = WSP(int, WS_RT) + 12 * T; S.cnt = F.ctl + CW_CNT; S.nN = 16; S.rowbytes = D; S.estride = (size_t)2 * DFF * D;
        S.rsc = WSP(float, WS_RSC); S.swup = WSP(float, WS_SWUP); S.b_up = F.b_up;
        EpiUp E{(unsigned char*)(F.ws + WS_ACTQ)};
        gm::gemm_run<EpiUp, SchedMoEUpT, true, true, true>(F.lds, S, E);
    }
    SEAM(7);
    if (IN(8)) { FRAME_RELOAD();
        build_units(F, tstart, 8, bc);
        SchedMoEDown S; S.nt = DFF / 128; S.pitchA = DFF / 2; S.pitchB = DFF / 2; S.multA = 1; S.multB = 1; S.G = F.G; S.c = bc; S.wv = F.wave; S.A = (const char*)WSP(char, WS_ACTQ); S.Bt = (const char*)WSP(char, WS_WDN);
        S.tstart = tstart; S.row_tok = nullptr; S.cnt = F.ctl + CW_CNT; S.nN = 8; S.rowbytes = DFF; S.estride = (size_t)D * DFF;
        S.sa = nullptr; S.swdn = WSP(float, WS_SWDN); S.b_dn = F.b_dn; S.rsc = nullptr; S.swup = nullptr; S.b_up = nullptr;
        EpiDown E{WSP(bf16, WS_YR)};
        gm::gemm_run<EpiDown, SchedMoEDown, false, 2, true>(F.lds, S, E);
    }
    SEAM(8);
    if (IN(9)) { FRAME_RELOAD(); p9_combine(F, tstart); }
#undef IN
#undef SEAM
}

#ifndef MK_SPLIT
#define MK_SPLIT 0
#endif
extern "C" void kernel_launch(void* const* d_in, const int* in_sizes, int n_in, void* d_out, int out_size, void* d_ws, size_t ws_size, hipStream_t stream) {
    static int grid = 0;
    if (grid == 0) {
        if (n_in != 18 || out_size != T * D || ws_size < WS_END2) { fprintf(stderr, "kernel_launch: unexpected problem: n_in %d out %d ws %zu (need %zu)\n", n_in, out_size, ws_size, (size_t)WS_END2); grid = -1; return; }
        int dev = 0, cus = 0, per_cu = 0;
        if (hipGetDevice(&dev) != hipSuccess || hipDeviceGetAttribute(&cus, hipDeviceAttributeMultiprocessorCount, dev) != hipSuccess) { grid = -1; return; }
        if (hipFuncSetAttribute((const void*)fwd, hipFuncAttributeMaxDynamicSharedMemorySize, LDS_BYTES) != hipSuccess) { fprintf(stderr, "kernel_launch: hipFuncSetAttribute failed\n"); grid = -1; return; }
        if (hipOccupancyMaxActiveBlocksPerMultiprocessor(&per_cu, (const void*)fwd, NTHR, LDS_BYTES) != hipSuccess || per_cu < 1) { fprintf(stderr, "kernel_launch: occupancy query reports %d\n", per_cu); }
        (void)hipGetLastError();
        grid = cus;
    }
    if (grid < 0) return;
    (void)hipMemsetAsync((char*)d_ws + WS_CTL, 0, CTL_BYTES, stream);
    Args a{};
    for (int i = 0; i < 18; ++i) a.in[i] = (const float*)d_in[i];
    a.out = (float*)d_out; a.ws = (unsigned char*)d_ws;
#if MK_SPLIT
    for (int p = 0; p < NPH; ++p) { a.ph_lo = p; a.ph_hi = p + 1; hipLaunchKernelGGL(fwd, dim3(grid), dim3(NTHR), LDS_BYTES, stream, a); }
#else
    a.ph_lo = 0; a.ph_hi = NPH; hipLaunchKernelGGL(fwd, dim3(grid), dim3(NTHR), LDS_BYTES, stream, a);
#endif
}
```

```cpp
#include <hip/hip_runtime.h>
#include <cstdio>
#include <cstdint>

#define GAS __attribute__((address_space(1)))
#define LAS __attribute__((address_space(3)))
typedef unsigned short bf16;
typedef unsigned v4u __attribute__((ext_vector_type(4)));
typedef unsigned v2u __attribute__((ext_vector_type(2)));
typedef float f32x4 __attribute__((ext_vector_type(4)));
typedef float f32x2 __attribute__((ext_vector_type(2)));
typedef short bf16x8 __attribute__((ext_vector_type(8)));
typedef int i32x4 __attribute__((ext_vector_type(4)));
typedef int i32x8 __attribute__((ext_vector_type(8)));
#define RLX_AGENT __ATOMIC_RELAXED, __HIP_MEMORY_SCOPE_AGENT
#define LDS_WAIT() asm volatile("s_waitcnt lgkmcnt(0)" ::: "memory")
#define VM_WAIT() asm volatile("s_waitcnt vmcnt(0)" ::: "memory")

constexpr int T = 16384, D = 2048, DIN = 5120, FW = 1024, RW = 1024, NH = 4, HD = 256, NE = 32, TOPK = 4, DFF = 2048;
constexpr int C2 = 256, NCH = T / C2;
constexpr int CAT = 768;
constexpr float LN_EPS = 1e-5f, GN_EPS = 1e-6f, ALPHA = 1.189207115002721f;
constexpr int RT_MAX = (T * TOPK) / 256 + NE;
constexpr int NWAVES = 8, NTHR = 512;

constexpr size_t MiB = 1u << 20;
constexpr size_t WS_CTL = 0, CTL_BYTES = 1 * MiB;
constexpr size_t WS_TAB = 1 * MiB;
constexpr size_t WS_WIN = 2 * MiB;
constexpr size_t WS_WOUT = WS_WIN + 20 * MiB;
constexpr size_t WS_WUP = WS_WOUT + 8 * MiB;
constexpr size_t WS_WDN = WS_WUP + 512 * MiB;
constexpr size_t WS_H0B = WS_WDN + 256 * MiB;
constexpr size_t WS_ST0 = WS_H0B + 64 * MiB;
constexpr size_t WS_UTT = WS_ST0 + 1 * MiB;
constexpr size_t WS_A1 = WS_UTT + 32 * MiB;
constexpr size_t WS_ZT = WS_A1 + 64 * MiB;
constexpr size_t WS_QS = WS_ZT + 64 * MiB;
constexpr size_t WS_KK = WS_QS + 32 * MiB;
constexpr size_t WS_GS = WS_KK + 32 * MiB;
constexpr size_t WS_ACAT = WS_GS + 32 * MiB;
constexpr size_t WS_BCAT = WS_ACAT + 96 * MiB;
constexpr size_t WS_KTW = WS_BCAT + 96 * MiB;
constexpr size_t WS_KVT = WS_KTW + 64 * MiB;
constexpr size_t WS_Y = WS_KVT + 128 * MiB;
constexpr size_t WS_Z1 = WS_Y + 64 * MiB;
constexpr size_t WS_H1B = WS_Z1 + 128 * MiB;
constexpr size_t WS_RT = WS_H1B + 64 * MiB;
constexpr size_t WS_ACT = WS_RT + 4 * MiB;
constexpr size_t WS_YR = WS_ACT + 288 * MiB;
constexpr size_t WS_END = WS_YR + 288 * MiB;
constexpr size_t WS_SWUP = WS_TAB + 512 * 1024;
constexpr size_t WS_H1Q = WS_H1B;
constexpr size_t WS_SX = WS_H1B + 32 * MiB, WS_RSC = WS_H1B + 40 * MiB, WS_SA = WS_H1B + 44 * MiB;
constexpr size_t WS_SWDN = WS_ST0 + 512 * 1024;
constexpr size_t WS_SWIN = WS_ST0 + 768 * 1024;
constexpr size_t WS_SX0 = WS_H0B + 40 * MiB;
constexpr size_t WS_ACTQ = WS_END;
constexpr size_t WS_END2 = WS_ACTQ + 144 * MiB;
constexpr int CW_RMAX = 16384;
constexpr int CW_BAR = 1024;
constexpr int CW_CNT = 8192;

constexpr int LDS_STAGE = 131072, LDS_SCR = 16384, LDS_CTL_OFF = LDS_STAGE + LDS_SCR, LDS_BYTES = LDS_CTL_OFF + 2048;

__device__ __forceinline__ unsigned cvt_pk_bf16(float lo, float hi) { unsigned r; asm volatile("v_cvt_pk_bf16_f32 %0, %1, %2" : "=v"(r) : "v"(lo), "v"(hi)); return r; }
__device__ __forceinline__ float bf_lo(unsigned u) { return __builtin_bit_cast(float, u << 16); }
__device__ __forceinline__ float bf_hi(unsigned u) { return __builtin_bit_cast(float, u & 0xffff0000u); }
__device__ __forceinline__ v4u pack8(const f32x4 a, const f32x4 b) { v4u w; w.x = cvt_pk_bf16(a[0], a[1]); w.y = cvt_pk_bf16(a[2], a[3]); w.z = cvt_pk_bf16(b[0], b[1]); w.w = cvt_pk_bf16(b[2], b[3]); return w; }
__device__ __forceinline__ float wave_sum(float v) {
#pragma unroll
    for (int o = 1; o < 64; o <<= 1) v += __shfl_xor(v, o);
    return v;
}
__device__ __forceinline__ int lane_id() { int l; asm volatile("v_mbcnt_lo_u32_b32 %0, -1, 0\n\tv_mbcnt_hi_u32_b32 %0, -1, %0" : "=v"(l)); return l; }
__device__ __forceinline__ float fexp(float x) { return __builtin_amdgcn_exp2f(x * 1.4426950408889634f); }
__device__ __forceinline__ void cs_rev(float rev, float& c, float& s) { const float f = __builtin_amdgcn_fractf(rev); c = __builtin_amdgcn_cosf(f); s = __builtin_amdgcn_sinf(f); }

#define XB_TMO      128
#define XB_XCNT(j)  (256  + 64 * (j))
#define XB_XSUB(j)  (1280 + 64 * (j))
#define XB_XGEN(j)  (2304 + 64 * (j))
#define XB_TOP      3328
#define XB_TOPGEN   3392
#define XCD_BAR_WORDS 3456
#define XB_SPIN_CAP (1u << 18)
__device__ __forceinline__ unsigned xb_ld(unsigned* p)              { return __hip_atomic_load(p, __ATOMIC_RELAXED, __HIP_MEMORY_SCOPE_AGENT); }
__device__ __forceinline__ unsigned xb_add(unsigned* p, unsigned v) { return __hip_atomic_fetch_add(p, v, __ATOMIC_RELAXED, __HIP_MEMORY_SCOPE_AGENT); }
__device__ __forceinline__ unsigned xb_xcc_id() { return (unsigned)__builtin_amdgcn_s_getreg((3 << 11) | 20) & 0xFu; }
#define XB_SPIN(cond, bar) do { unsigned _sp = 0; while (cond) { __builtin_amdgcn_s_sleep(1); \
    if ((++_sp & 255u) == 0u) { if (xb_ld(&(bar)[XB_TMO])) break; if (_sp > XB_SPIN_CAP) { atomicAdd(&(bar)[XB_TMO], 1u); break; } } } } while (0)
struct XcdBarrier { unsigned* bar; unsigned x; volatile LAS unsigned* st; int wave; };
__device__ __forceinline__ XcdBarrier xcd_barrier_post(unsigned* bar, volatile LAS unsigned* st) {
    XcdBarrier b; b.bar = bar; b.x = xb_xcc_id(); b.st = st;
    if (threadIdx.x == 0) (void)xb_add(&bar[XB_XCNT(b.x)], 1u);
    return b;
}
__device__ __forceinline__ void xcd_barrier_complete(unsigned* bar, unsigned x, unsigned& nloc, unsigned& nx) {
    const unsigned G = gridDim.x * gridDim.y * gridDim.z;
    unsigned sum, cnt, mine, sp = 0u;
    for (;;) {
        sum = 0u; cnt = 0u; mine = 0u;
#pragma unroll
        for (unsigned j = 0; j < 16; ++j) { const unsigned c = xb_ld(&bar[XB_XCNT(j)]); sum += c; cnt += (c > 0u) ? 1u : 0u; mine = (j == x) ? c : mine; }
        if (sum == G) break;
        __builtin_amdgcn_s_sleep(1);
        if ((++sp & 255u) == 0u) { if (xb_ld(&bar[XB_TMO])) break; if (sp > XB_SPIN_CAP) { atomicAdd(&bar[XB_TMO], 1u); break; } }
    }
    nloc = mine > 0u ? mine : 1u; nx = cnt > 0u ? cnt : 1u;
}
__device__ __forceinline__ void xcd_barrier(const XcdBarrier& b) {
    asm volatile("s_waitcnt vmcnt(0)" ::: "memory");
    __syncthreads();
    if (b.wave == 0 && lane_id() == 0) {
        unsigned* bar = b.bar;
        __builtin_amdgcn_s_waitcnt(0);
        unsigned nloc = b.st[0], nx = b.st[1];
        if (nloc == 0u) { xcd_barrier_complete(bar, b.x, nloc, nx); b.st[0] = nloc; b.st[1] = nx; }
        const unsigned old = xb_add(&bar[XB_XSUB(b.x)], 1u);
        const unsigned gen = old / nloc;
        if (old + 1u == (gen + 1u) * nloc) {
            __builtin_amdgcn_fence(__ATOMIC_RELEASE, "agent");
            asm volatile("s_waitcnt vmcnt(0)" ::: "memory");
            const unsigned og = xb_add(&bar[XB_TOP], 1u);
            const unsigned tg = og / nx;
            if (og + 1u == (tg + 1u) * nx) xb_add(&bar[XB_TOPGEN], 1u);
            else XB_SPIN(xb_ld(&bar[XB_TOPGEN]) == tg, bar);
            __builtin_amdgcn_fence(__ATOMIC_ACQUIRE, "agent");
            xb_add(&bar[XB_XGEN(b.x)], 1u);
            asm volatile("s_waitcnt vmcnt(0)" ::: "memory");
        } else {
            XB_SPIN(xb_ld(&bar[XB_XGEN(b.x)]) == gen, bar);
            __builtin_amdgcn_fence(__ATOMIC_ACQUIRE, "agent");
            asm volatile("s_waitcnt vmcnt(0)" ::: "memory");
        }
    }
    __syncthreads();
}

namespace gm {
constexpr int BM = 256, BK = 64, HALF = 128, HTB = HALF * BK * 2, STAGE_BYTES = 8 * HTB;
__device__ __forceinline__ int lds_byte(int r, int c) { const int st = (r >> 4) * 2 + (c >> 5), rr = r & 15, cc = c & 31, ob = rr * 64 + cc * 2; return st * 1024 + (ob ^ (((ob >> 9) & 1) << 5)); }
__device__ __forceinline__ void stage_rc(int b, int& R, int& C) { const int st = b / 1024, sb = b % 1024, swz = sb ^ (((sb >> 9) & 1) << 5); R = (st >> 1) * 16 + swz / 64; C = (st & 1) * 32 + (swz % 64) / 2; }
__device__ __forceinline__ int perm32(int rho) { const int n = rho >> 4, i = rho & 15; return 8 * (i >> 2) + 4 * n + (i & 3); }

struct Unit { const char* a0; const char* a1; const char* b0; const char* b1; int p0, p1, p2, p3, q; };

__device__ __forceinline__ void tile_order(int L, int nM, int nN, int& pm, int& pn) {
    const int nwg = nM * nN; int wgid = L;
    { const int q = nwg / 8, r = nwg % 8, xcd = wgid % 8, off = wgid / 8; wgid = (xcd < r ? xcd * (q + 1) : r * (q + 1) + (xcd - r) * q) + off; }
    const int nig = 8 * nN, gid = wgid / nig, fm = gid * 8, gsz = (nM - fm) < 8 ? (nM - fm) : 8;
    pm = fm + ((wgid % nig) % gsz); pn = (wgid % nig) / gsz;
}

template <int I8> struct AccSel { typedef f32x4 type; };
template <> struct AccSel<1> { typedef i32x4 type; };
template <class Epi, class Sched, bool GATHER, int I8 = 0, bool PREF = false>
__device__ __forceinline__ void gemm_run(LAS unsigned char* lds, const Sched& S, const Epi& E) {
    const int wid = S.wv, lane = lane_id(), tid = wid * 64 + lane, wr = wid >> 2, wc = wid & 3, fr = lane & 15, fq = lane >> 4;
    int nt = S.nt; asm volatile("" : "+s"(nt));
    unsigned voffA[2], voffB[2], colA[2]; int rowA[2];
#pragma unroll
    for (int i = 0; i < 2; ++i) { int R, C; stage_rc(tid * 16 + i * 8192, R, C); const int Rb = Epi::PERM ? ((R & ~31) + perm32(R & 31)) : R;
        voffA[i] = (unsigned)(R * S.multA * S.pitchA + C) * 2u; voffB[i] = (unsigned)(Rb * S.multB * S.pitchB + C) * 2u; colA[i] = (unsigned)C * 2u; rowA[i] = R; }
    const size_t kstep = (size_t)(BK * 2);
    const unsigned ldsw = (unsigned)wid * 1024u;
    const int aoff = lds_byte(wr * 64 + fr, fq * 8), boff = lds_byte(wc * 32 + fr, fq * 8);
#define G_SA(b, h) (((b) * 2 + (h)) * HTB)
#define G_SB(b, h) ((4 + (b) * 2 + (h)) * HTB)
#define G_STAGE(bufoff, gbase, voff) do { _Pragma("unroll") for (int _i = 0; _i < 2; ++_i) \
        __builtin_amdgcn_global_load_lds((const unsigned*)((const char*)(gbase) + (voff)[_i]), (LAS unsigned*)(lds + (bufoff) + ldsw + _i * 8192), 16, 0, 0); } while (0)
#define G_LD8(dst, addr) do { const i32x4 lo_ = *(const LAS i32x4*)(addr), hi_ = *(const LAS i32x4*)((addr) + 1024); dst = __builtin_shufflevector(lo_, hi_, 0, 1, 2, 3, 4, 5, 6, 7); } while (0)
#define G_LDA(dst, b, h) do { _Pragma("unroll") for (int m = 0; m < 4; ++m) G_LD8(dst[m], lds + G_SA(b, h) + aoff + m * 2048); } while (0)
#define G_LDB(dst, b, h) do { _Pragma("unroll") for (int n = 0; n < 2; ++n) G_LD8(dst[n], lds + G_SB(b, h) + boff + n * 2048); } while (0)
#define G_H4(x, k) ((k) ? __builtin_shufflevector(x, x, 4, 5, 6, 7) : __builtin_shufflevector(x, x, 0, 1, 2, 3))
#define G_MMA(ai, bj, At, Bt) do { __builtin_amdgcn_s_setprio(1); _Pragma("unroll") for (int m = 0; m < 4; ++m) _Pragma("unroll") for (int n = 0; n < 2; ++n) { \
        if constexpr (I8 == 2) acc[ai][bj][m][n] = __builtin_amdgcn_mfma_scale_f32_16x16x128_f8f6f4(Bt[n], At[m], acc[ai][bj][m][n], 0, 0, 0, 0x7F7F7F7F, 0, 0x7F7F7F7F); \
        else { _Pragma("unroll") for (int k = 0; k < 2; ++k) { \
            if constexpr (I8 == 1) acc[ai][bj][m][n] = __builtin_amdgcn_mfma_i32_16x16x64_i8(G_H4(Bt[n], k), G_H4(At[m], k), acc[ai][bj][m][n], 0, 0, 0); \
            else acc[ai][bj][m][n] = __builtin_amdgcn_mfma_f32_16x16x32_bf16(__builtin_bit_cast(bf16x8, G_H4(Bt[n], k)), __builtin_bit_cast(bf16x8, G_H4(At[m], k)), acc[ai][bj][m][n], 0, 0, 0); } } } \
        __builtin_amdgcn_s_setprio(0); } while (0)
#define G_WAIT_V(n) asm volatile("s_waitcnt vmcnt(" #n ")" ::: "memory")
#define G_WAIT_L(n) asm volatile("s_waitcnt lgkmcnt(" #n ")" ::: "memory")
#define G_BAR __builtin_amdgcn_s_barrier()
#define G_SCHED __builtin_amdgcn_sched_barrier(0)
    Unit cur, nxt; int ui = 0;
    if (!S.next(0, cur)) return;
    cur.q = 0;
    if constexpr (PREF) { S.prefetch(cur, lds); G_WAIT_V(0); G_BAR; }
    typedef typename AccSel<I8>::type acc_t;
    acc_t acc[2][2][4][2];
#pragma unroll
    for (int a = 0; a < 2; ++a)
#pragma unroll
        for (int b = 0; b < 2; ++b)
#pragma unroll
            for (int m = 0; m < 4; ++m)
#pragma unroll
                for (int n = 0; n < 2; ++n) acc[a][b][m][n] = (acc_t){0, 0, 0, 0};
    i32x8 At[4], B0[2], B1[2];
    unsigned gc0[2], gc1[2];
    if constexpr (GATHER) {
#pragma unroll
        for (int i = 0; i < 2; ++i) { gc0[i] = S.row_off(cur, rowA[i], lds) + colA[i]; gc1[i] = S.row_off(cur, 128 + rowA[i], lds) + colA[i]; }
    }
#define vA0 (GATHER ? gc0 : voffA)
#define vA1 (GATHER ? gc1 : voffA)
    G_STAGE(G_SB(0, 0), cur.b0, voffB); G_STAGE(G_SB(0, 1), cur.b1, voffB); G_STAGE(G_SA(0, 0), cur.a0, vA0); G_STAGE(G_SA(0, 1), cur.a1, vA1);
    if (wr == 1) G_BAR;
    G_WAIT_V(2); G_BAR;
    G_STAGE(G_SB(1, 0), cur.b0 + kstep, voffB); G_STAGE(G_SA(1, 0), cur.a0 + kstep, vA0); G_STAGE(G_SB(1, 1), cur.b1 + kstep, voffB);
    G_WAIT_V(6); G_BAR;
    for (;;) {
        const bool has_next = S.next(ui + 1, nxt);
        if (!has_next) nxt = cur;
        nxt.q = (ui + 1) & 1;
        for (int t = 0; t < nt; t += 2) {
            const bool last = (t == nt - 2);
            { const int tz_ = wid * 64 + lane_id();
#pragma unroll
              for (int i = 0; i < 2; ++i) { int R, C; stage_rc(tz_ * 16 + i * 8192, R, C); const int Rb = Epi::PERM ? ((R & ~31) + perm32(R & 31)) : R;
                  voffA[i] = (unsigned)(R * S.multA * S.pitchA + C) * 2u; voffB[i] = (unsigned)(Rb * S.multB * S.pitchB + C) * 2u; } }
            if constexpr (GATHER) asm volatile("" : "+v"(gc0[0]), "+v"(gc0[1]), "+v"(gc1[0]), "+v"(gc1[1]));
            if constexpr (PREF) { if (t == nt - 4) S.prefetch(nxt, lds); }
            const char* a11 = cur.a1 + (size_t)(t + 1) * kstep;
            const char* a02 = last ? nxt.a0 : cur.a0 + (size_t)(t + 2) * kstep; const char* a12 = last ? nxt.a1 : cur.a1 + (size_t)(t + 2) * kstep;
            const char* b02 = last ? nxt.b0 : cur.b0 + (size_t)(t + 2) * kstep; const char* b12 = last ? nxt.b1 : cur.b1 + (size_t)(t + 2) * kstep;
            G_LDB(B0, 0, 0); G_LDB(B1, 0, 1); G_SCHED; G_LDA(At, 0, 0); G_STAGE(G_SA(1, 1), a11, vA1);
            if constexpr (GATHER) { if (last) { int tz = tid; asm volatile("" : "+v"(tz));
#pragma unroll
                for (int i = 0; i < 2; ++i) { int R, C; stage_rc(tz * 16 + i * 8192, R, C); gc0[i] = S.row_off(nxt, R, lds) + (unsigned)C * 2u; gc1[i] = S.row_off(nxt, 128 + R, lds) + (unsigned)C * 2u; } } }
            G_WAIT_V(8); G_WAIT_L(0); G_BAR; G_MMA(0, 0, At, B0); G_MMA(0, 1, At, B1); G_BAR; G_SCHED;
            G_LDA(At, 0, 1); G_STAGE(G_SB(0, 0), b02, voffB); G_STAGE(G_SB(0, 1), b12, voffB); G_STAGE(G_SA(0, 0), a02, vA0);
            G_WAIT_V(8); G_WAIT_L(0); G_BAR; G_MMA(1, 0, At, B0); G_MMA(1, 1, At, B1); G_BAR; G_SCHED;
            G_LDB(B0, 1, 0); G_LDB(B1, 1, 1); G_SCHED; G_LDA(At, 1, 0); G_STAGE(G_SA(0, 1), a12, vA1);
            G_WAIT_V(8); G_WAIT_L(0); G_BAR; G_MMA(0, 0, At, B0); G_MMA(0, 1, At, B1); G_BAR; G_SCHED;
            G_LDA(At, 1, 1); G_STAGE(G_SB(1, 0), b02 + kstep, voffB); G_STAGE(G_SB(1, 1), b12 + kstep, voffB); G_STAGE(G_SA(1, 0), a02 + kstep, vA0);
            G_WAIT_V(8); G_WAIT_L(0); G_BAR; G_MMA(1, 0, At, B0); G_MMA(1, 1, At, B1); G_BAR; G_SCHED;
        }
        if (wr == 0) G_BAR;
        { int fr2 = fr, fq2 = fq; asm volatile("" : "+v"(fr2), "+v"(fq2));
          E(acc, cur, lds, wr, wc, fr2, fq2); }
        if (!has_next) break;
#pragma unroll
        for (int a = 0; a < 2; ++a)
#pragma unroll
            for (int b = 0; b < 2; ++b)
#pragma unroll
                for (int m = 0; m < 4; ++m)
#pragma unroll
                    for (int n = 0; n < 2; ++n) acc[a][b][m][n] = (acc_t){0, 0, 0, 0};
        cur = nxt; ++ui;
        if (wr == 1) G_BAR;
    }
    G_WAIT_V(0);
    G_BAR;
#undef G_SA
#undef G_SB
#undef G_STAGE
#undef G_LDA
#undef G_LD8
#undef G_H4
#undef G_LDB
#undef G_MMA
#undef G_WAIT_V
#undef G_WAIT_L
#undef G_BAR
#undef G_SCHED
#undef vA0
#undef vA1
}
}
using gm::Unit;
typedef f32x4 Acc[2][2][4][2];
typedef i32x4 AccI[2][2][4][2];

struct Args { const float* in[18]; float* out; unsigned char* ws; int ph_lo, ph_hi; };
struct Frame {
    LAS unsigned char* lds; unsigned char* ws; unsigned* ctl;
    int wave, vcu, G;
    const float *x, *ln0_g, *ln0_b, *w_in, *dec_f, *dec_b, *gn_g, *w_out, *ln1_g, *ln1_b, *w_r, *b_r, *w_up, *b_up, *w_dn, *b_dn, *ln2_g, *ln2_b;
    float* out;
};
#define WSP(T_, off) ((T_*)(F.ws + (off)))
#define FLANE lane_id()
#define FTID (F.wave * 64 + lane_id())

template <class ColMap>
__device__ __forceinline__ void transpose_item(const float* W, int K, int N, bf16* WT, LAS float* scr, int item, int lane, const ColMap& cm) {
    const int nblk = N / 64, kb = item / nblk, nb = item % nblk, k0 = 64 * kb, n0 = 64 * nb;
    const int s0 = cm(n0);
#pragma unroll 4
    for (int i = 0; i < 16; ++i) { const int kk = 4 * i + (lane >> 4), c4 = (lane & 15) * 4;
        const f32x4 v = *(const GAS f32x4*)(W + (size_t)(k0 + kk) * N + s0 + c4);
        LAS float* d = scr + kk * 65 + c4; d[0] = v[0]; d[1] = v[1]; d[2] = v[2]; d[3] = v[3]; }
    LDS_WAIT(); asm volatile("" ::: "memory");
    const int c = lane & 7;
#pragma unroll
    for (int j = 0; j < 8; ++j) { const int n = (lane >> 3) + 8 * j; const LAS float* s = scr + (8 * c) * 65 + n;
        v4u o; o.x = cvt_pk_bf16(s[0 * 65], s[1 * 65]); o.y = cvt_pk_bf16(s[2 * 65], s[3 * 65]); o.z = cvt_pk_bf16(s[4 * 65], s[5 * 65]); o.w = cvt_pk_bf16(s[6 * 65], s[7 * 65]);
        *(GAS v4u*)(WT + (size_t)(n0 + n) * K + k0 + 8 * c) = o; }
    LDS_WAIT(); asm volatile("" ::: "memory");
}
struct ColId { __device__ __forceinline__ int operator()(int n) const { return n; } };
struct ColUp { __device__ __forceinline__ int operator()(int n) const { return ((n >> 8) * 128 + (n & 127)) + ((n >> 7) & 1) * 2048; } };

__device__ __forceinline__ void p0_prologue(Frame& F) {
    const int gw = F.vcu * NWAVES + F.wave, NGW = F.G * NWAVES;
    {
        unsigned* h0q = WSP(unsigned, WS_H0B); float* st0 = WSP(float, WS_ST0); float* sx0 = WSP(float, WS_SX0);
        for (int m = gw; m < T; m += NGW) {
            const GAS f32x4* xr = (const GAS f32x4*)(F.x + (size_t)m * D) + FLANE;
            f32x4 v[8]; float s = 0.f;
#pragma unroll
            for (int j = 0; j < 8; ++j) { v[j] = xr[64 * j]; s += (v[j][0] + v[j][1]) + (v[j][2] + v[j][3]); }
            const float mean = wave_sum(s) * (1.f / D); float s2 = 0.f;
#pragma unroll
            for (int j = 0; j < 8; ++j) { v[j] = v[j] - mean; s2 += (v[j][0] * v[j][0] + v[j][1] * v[j][1]) + (v[j][2] * v[j][2] + v[j][3] * v[j][3]); }
            const float rstd = 1.f / sqrtf(wave_sum(s2) * (1.f / D) + LN_EPS); float am = 0.f;
#pragma unroll
            for (int j = 0; j < 8; ++j) { const f32x4 g = *((const GAS f32x4*)F.ln0_g + FLANE + 64 * j), b = *((const GAS f32x4*)F.ln0_b + FLANE + 64 * j);
                v[j] = v[j] * rstd * g + b; am = fmaxf(am, fmaxf(fmaxf(fabsf(v[j][0]), fabsf(v[j][1])), fmaxf(fabsf(v[j][2]), fabsf(v[j][3])))); }
#pragma unroll
            for (int o = 1; o < 64; o <<= 1) am = fmaxf(am, __shfl_xor(am, o));
            const float sc = am > 0.f ? am * (1.f / 127.f) : 1.f, inv = 1.f / sc;
#pragma unroll
            for (int j = 0; j < 8; ++j) { const int q0 = (int)__builtin_rintf(v[j][0] * inv), q1 = (int)__builtin_rintf(v[j][1] * inv), q2 = (int)__builtin_rintf(v[j][2] * inv), q3 = (int)__builtin_rintf(v[j][3] * inv);
                h0q[(size_t)m * (D / 4) + FLANE + 64 * j] = (unsigned)(q0 & 0xff) | ((unsigned)(q1 & 0xff) << 8) | ((unsigned)(q2 & 0xff) << 16) | ((unsigned)(q3 & 0xff) << 24); }
            if (FLANE == 0) { st0[2 * m] = mean; st0[2 * m + 1] = rstd; sx0[m] = sc; }
        }
    }
    {
        bf16* tab = WSP(bf16, WS_TAB);
        for (int i = (F.vcu * NTHR + FTID); i < 32768 + 65536 + 65536; i += F.G * NTHR) {
            float v;
            if (i < 32768) { const int r = i >> 7, a = i & 127, ri = r >> 7, k1 = r & 127; float c, s; cs_rev((float)((k1 * a) & 127) * (1.f / 128.f), c, s); v = ri ? -s : c; }
            else if (i < 32768 + 65536) { const int e = i - 32768, r = e >> 8, q = e & 255, ri = r >> 7, k2 = r & 127, rj = q >> 7, b = q & 127; float c, s; cs_rev((float)((k2 * b) & 127) * (1.f / 128.f), c, s);
                v = (ri == 0) ? (rj == 0 ? c : s) : (rj == 0 ? -s : c); }
            else { const int e = i - 32768 - 65536, l = e >> 8, q = e & 255, rj = q >> 7, cg = q & 127; float c, s; cs_rev((float)((l * cg) & 127) * (1.f / 128.f), c, s); v = (l < 128) ? (rj == 0 ? c : s) : 0.f; }
            tab[i] = (bf16)(cvt_pk_bf16(v, 0.f) & 0xffffu);
        }
    }
    {
        LAS float* scr = (LAS float*)(F.lds + F.wave * 18432);
        constexpr int I_IN = 32 * (DIN / 64), I_OUT = 32 * (D / 64), I_UP = 32 * (2 * DFF / 64), I_DN = 32 * (D / 64);
        constexpr int NIT = I_OUT;
        for (int it = gw; it < NIT; it += NGW) {
            int r = it;
            { transpose_item(F.w_out, D, D, WSP(bf16, WS_WOUT), scr, r, FLANE, ColId()); }
        }
    }
}

struct SlabDesc { const float* W; signed char* WQ; float* sw; int NS, e, n0, valid, fp8; };
struct QF { unsigned char* ws; const float* w_up; const float* w_dn; const float* w_in; int vcu, G; };
__device__ __forceinline__ SlabDesc slab_desc(const QF& F, int j) {
    const int nD = (NE * 64 + F.G - 1) / F.G; SlabDesc d;
    if (j < 0) { const int sl = F.vcu + (-1 - j) * F.G; d.valid = sl < DIN / 32; d.NS = DIN; d.e = 0; d.n0 = sl * 32; d.W = F.w_in + d.n0; d.WQ = (signed char*)WSP(char, WS_WIN); d.sw = WSP(float, WS_SWIN); d.fp8 = 0; }
    else if (j >= nD) { const int sl = F.vcu + (j - nD) * F.G; d.valid = sl < NE * 128; d.NS = 2 * DFF; d.e = sl >> 7; d.n0 = (sl & 127) * 32; d.W = F.w_up + (size_t)d.e * D * 2 * DFF + ColUp()(d.n0); d.WQ = (signed char*)WSP(char, WS_WUP); d.sw = WSP(float, WS_SWUP); d.fp8 = 0; }
    else { const int sl = F.vcu + j * F.G; d.valid = sl < NE * 64; d.NS = D; d.e = sl >> 6; d.n0 = (sl & 63) * 32; d.W = F.w_dn + (size_t)d.e * DFF * D + d.n0; d.WQ = (signed char*)WSP(char, WS_WDN); d.sw = WSP(float, WS_SWDN); d.fp8 = 1; }
    return d;
}
#define SLAB_LOAD(dsc, v) do { if ((dsc).valid) { const GAS char* b_ = (const GAS char*)(dsc).W; unsigned o_ = (unsigned)((wave * 256 + kq) * (dsc).NS + c4) * 4u; const unsigned st_ = (unsigned)(dsc).NS * 32u; \
    _Pragma("unroll") for (int i_ = 0; i_ < 32; ++i_) { v[i_] = __builtin_nontemporal_load((const GAS f32x4*)(b_ + o_)); o_ += st_; } } } while (0)
__device__ __forceinline__ void do_slabs_impl(LAS unsigned char* lds, unsigned char* ws, const float* w_up, const float* w_dn, const float* w_in, int vcu, int G, int wave, int j0, int j1) {
    if (j0 >= j1) return;
    QF F; F.ws = ws; F.w_up = w_up; F.w_dn = w_dn; F.w_in = w_in; F.vcu = vcu; F.G = G;
    const int lane = lane_id(), tid = wave * 64 + lane;
    constexpr int PITCH = 2056;
    LAS bf16* slab = (LAS bf16*)lds;
    LAS float* red = (LAS float*)(lds + 32 * PITCH * 2);
    const int kq = lane >> 3, c4 = (lane & 7) * 4;
    f32x4 v[32];
    SlabDesc cur = slab_desc(F, j0);
    SLAB_LOAD(cur, v);
    for (int j = j0; j < j1; ++j) {
        if (cur.valid) {
            f32x4 mx = (f32x4){0.f, 0.f, 0.f, 0.f};
#pragma unroll
            for (int i = 0; i < 32; ++i) { const int k = wave * 256 + i * 8 + kq; const f32x4 x = v[i];
                mx[0] = fmaxf(mx[0], fabsf(x[0])); mx[1] = fmaxf(mx[1], fabsf(x[1])); mx[2] = fmaxf(mx[2], fabsf(x[2])); mx[3] = fmaxf(mx[3], fabsf(x[3]));
                const unsigned p01 = cvt_pk_bf16(x[0], x[1]), p23 = cvt_pk_bf16(x[2], x[3]);
                const int ks = k ^ (((c4 >> 3) & 3) << 3);
                slab[(c4 + 0) * PITCH + ks] = (bf16)(p01 & 0xffffu); slab[(c4 + 1) * PITCH + ks] = (bf16)(p01 >> 16); slab[(c4 + 2) * PITCH + ks] = (bf16)(p23 & 0xffffu); slab[(c4 + 3) * PITCH + ks] = (bf16)(p23 >> 16); }
#pragma unroll
            for (int q = 0; q < 4; ++q) { float m = mx[q]; m = fmaxf(m, __shfl_xor(m, 8)); m = fmaxf(m, __shfl_xor(m, 16)); m = fmaxf(m, __shfl_xor(m, 32)); mx[q] = m; }
            if (lane < 8) { LAS float* d = red + wave * 32 + c4; d[0] = mx[0]; d[1] = mx[1]; d[2] = mx[2]; d[3] = mx[3]; }
        }
        const SlabDesc done = cur;
        if (j + 1 < j1) { cur = slab_desc(F, j + 1); SLAB_LOAD(cur, v); }
        __syncthreads();
        if (done.valid && tid < 32) { float m = 0.f;
#pragma unroll
            for (int w = 0; w < 8; ++w) m = fmaxf(m, red[w * 32 + tid]);
            const float sc = m > 0.f ? m * (done.fp8 ? (1.f / 448.f) : (1.f / 127.f)) : 1.f; done.sw[(size_t)done.e * done.NS + done.n0 + tid] = sc; red[256 + tid] = 1.f / sc; }
        __syncthreads();
        if (done.valid) {
#pragma unroll 2
            for (int i = 0; i < 8; ++i) { const int q = tid + NTHR * i, n = q >> 7, kc = q & 127; const float inv = red[256 + n];
                const int sx_ = ((n >> 3) & 3) << 3;
                const v4u a = *(const LAS v4u*)(slab + n * PITCH + ((kc * 16) ^ sx_)), b = *(const LAS v4u*)(slab + n * PITCH + ((kc * 16 + 8) ^ sx_));
                const unsigned src[8] = {a.x, a.y, a.z, a.w, b.x, b.y, b.z, b.w}; unsigned o[4];
                if (done.fp8) {
#pragma unroll
                    for (int d = 0; d < 4; ++d) { int w = __builtin_amdgcn_cvt_pk_fp8_f32(bf_lo(src[2 * d]) * inv, bf_hi(src[2 * d]) * inv, 0, false);
                        w = __builtin_amdgcn_cvt_pk_fp8_f32(bf_lo(src[2 * d + 1]) * inv, bf_hi(src[2 * d + 1]) * inv, w, true); o[d] = (unsigned)w; }
                } else {
#pragma unroll
                for (int d = 0; d < 4; ++d) { unsigned w = 0u;
#pragma unroll
                    for (int h2 = 0; h2 < 2; ++h2) { const unsigned u2 = src[2 * d + h2]; const int q0 = (int)__builtin_rintf(bf_lo(u2) * inv), q1 = (int)__builtin_rintf(bf_hi(u2) * inv);
                        w |= ((unsigned)(q0 & 0xff) << (16 * h2)) | ((unsigned)(q1 & 0xff) << (16 * h2 + 8)); }
                    o[d] = w; }
                }
                *(GAS v4u*)(done.WQ + ((size_t)done.e * done.NS + done.n0 + n) * D + kc * 16) = (v4u){o[0], o[1], o[2], o[3]}; }
        }
        __syncthreads();
    }
}

__device__ __forceinline__ void do_slabs(Frame& F, int j0, int j1) { do_slabs_impl(F.lds, F.ws, F.w_up, F.w_dn, F.w_in, F.vcu, F.G, F.wave, j0, j1); }

struct SchedBase { int nt, pitchA, pitchB, multA, multB, G, c, wv; };
struct SchedG1N : SchedBase {
    const char* A; const char* Bt;
    __device__ __forceinline__ bool next(int i, Unit& u) const { const int L = i * G + c; if (L >= 64 * 12) return false; int pm, pn; gm::tile_order(L, 64, 12, pm, pn);
        const int cb = pn < 4 ? 1024 + 256 * pn : (pn < 8 ? 2048 + 256 * (pn - 4) : 4096 + 256 * (pn - 8));
        u.a0 = A + (size_t)pm * 256 * D; u.a1 = u.a0 + (size_t)128 * D; u.b0 = Bt + (size_t)cb * D; u.b1 = u.b0 + (size_t)128 * D; u.p0 = pm; u.p1 = pn; u.p2 = cb; u.p3 = 0; return true; }
};
struct SchedG1SF : SchedBase {
    const char* A; const char* Bt;
    __device__ __forceinline__ bool next(int i, Unit& u) const { const int L = i * G + c; if (L >= 4 * 64) return false; int pm, pn; gm::tile_order(L, 4, 64, pm, pn);
        u.a0 = A + (size_t)pm * 256 * D; u.a1 = u.a0 + (size_t)128 * D; u.b0 = Bt + (size_t)(2 * pn) * D; u.b1 = u.b0 + (size_t)D; u.p0 = pm; u.p1 = pn; u.p2 = 0; u.p3 = 0; return true; }
};
struct SchedG1SKV : SchedBase {
    const char* A; const char* Bt;
    __device__ __forceinline__ bool next(int i, Unit& u) const { const int L = i * G + c; if (L >= 8 * 64) return false; int pm, pn; gm::tile_order(L, 8, 64, pm, pn);
        const int rb = pm < 4 ? 2048 + 256 * pm : 3072 + 256 * (pm - 4);
        u.a0 = A + (size_t)rb * D; u.a1 = u.a0 + (size_t)128 * D; u.b0 = Bt + (size_t)pn * 256 * D; u.b1 = u.b0 + (size_t)128 * D; u.p0 = pm; u.p1 = pn; u.p2 = rb; u.p3 = 0; return true; }
};
struct SchedFixA : SchedBase {
    const char* A; const char* Bt; int ncol;
    __device__ __forceinline__ bool next(int i, Unit& u) const { const int L = i * G + c; if (L >= ncol) return false;
        u.a0 = A; u.a1 = A + (size_t)128 * pitchA * 2; u.b0 = Bt + (size_t)L * 256 * pitchB * 2; u.b1 = u.b0 + (size_t)128 * pitchB * 2; u.p0 = 0; u.p1 = L; u.p2 = 0; u.p3 = 0; return true; }
};
struct SchedFixB : SchedBase {
    const char* A; const char* Bt; int nrow;
    __device__ __forceinline__ bool next(int i, Unit& u) const { const int L = i * G + c; if (L >= nrow) return false;
        u.a0 = A + (size_t)L * 256 * pitchA * 2; u.a1 = u.a0 + (size_t)128 * pitchA * 2; u.b0 = Bt; u.b1 = Bt + (size_t)128 * pitchB * 2; u.p0 = L; u.p1 = 0; u.p2 = 0; u.p3 = 0; return true; }
};
struct SchedScores : SchedBase {
    const char* Q; const char* Kk;
    __device__ __forceinline__ bool next(int i, Unit& u) const { const int L = i * G + c; if (L >= NH * NCH) return false; const int h = L & 3, n = L >> 2;
        u.a0 = Q + ((size_t)n * 256 * RW + h * HD) * 2; u.a1 = u.a0 + (size_t)128 * RW * 2; u.b0 = Kk + ((size_t)n * 256 * RW + h * HD) * 2; u.b1 = u.b0 + (size_t)128 * RW * 2; u.p0 = h; u.p1 = n; u.p2 = 0; u.p3 = 0; return true; }
};
struct SchedKV : SchedBase {
    const char* Bcat; const char* kTw;
    __device__ __forceinline__ bool next(int i, Unit& u) const { const int L = i * G + c; if (L >= 2 * NH * NCH) return false; const int dh = L & 7, n = L >> 3, dir = dh >> 2, h = dh & 3;
        u.a0 = Bcat + ((size_t)(h * NCH + n) * 256 * CAT) * 2; u.a1 = u.a0 + (size_t)128 * CAT * 2;
        u.b0 = kTw + (((size_t)dir * RW + h * HD) * T + (size_t)n * 256) * 2; u.b1 = u.b0 + (size_t)128 * T * 2; u.p0 = dh; u.p1 = n; u.p2 = 0; u.p3 = 0; return true; }
};
struct SchedOut : SchedBase {
    const char* Acat; const char* Bcat;
    __device__ __forceinline__ bool next(int i, Unit& u) const { const int L = i * G + c; if (L >= NH * NCH) return false; const int h = L & 3, n = L >> 2;
        u.a0 = Acat + ((size_t)h * T + (size_t)n * 256) * CAT * 2; u.a1 = u.a0 + (size_t)128 * CAT * 2; u.b0 = Bcat + ((size_t)(h * NCH + n) * 256 * CAT) * 2; u.b1 = u.b0 + (size_t)128 * CAT * 2; u.p0 = h; u.p1 = n; u.p2 = 0; u.p3 = 0; return true; }
};
struct Sched2D : SchedBase {
    const char* A; const char* Bt; int nM, nN;
    __device__ __forceinline__ bool next(int i, Unit& u) const { const int L = i * G + c; if (L >= nM * nN) return false; int pm, pn; gm::tile_order(L, nM, nN, pm, pn);
        u.a0 = A + (size_t)pm * 256 * pitchA * 2; u.a1 = u.a0 + (size_t)128 * pitchA * 2; u.b0 = Bt + (size_t)pn * 256 * pitchB * 2; u.b1 = u.b0 + (size_t)128 * pitchB * 2; u.p0 = pm; u.p1 = pn; u.p2 = 0; u.p3 = 0; return true; }
};
struct SchedMoE : SchedBase {
    const char* A; const char* Bt; const LAS int* tstart; const int* row_tok; const unsigned* cnt; int nN, rowbytes; size_t estride;
    __device__ __forceinline__ bool next(int i, Unit& u) const { const int RT = __builtin_amdgcn_readfirstlane(tstart[NE]); const int L = i * G + c; if (L >= RT * nN) return false; int rt, pn; gm::tile_order(L, RT, nN, rt, pn);
        const int e = __builtin_amdgcn_readfirstlane(tstart[40 + rt]);
        u.b0 = Bt + (size_t)e * estride + (size_t)pn * 256 * rowbytes; u.b1 = u.b0 + (size_t)128 * rowbytes;
        u.a0 = A; u.a1 = A;
        u.p0 = rt; u.p1 = pn; u.p2 = e; u.p3 = (rt - __builtin_amdgcn_readfirstlane(tstart[e])) * 256; return true; }
    __device__ __forceinline__ bool next_tab(int i, Unit& u) const { const int w = (i < 64) ? __builtin_amdgcn_readfirstlane(tstart[400 + i]) : -1; if (w < 0) return false;
        const int rt = w & 1023, pn = (w >> 10) & 31, e = (w >> 15) & 31;
        u.b0 = Bt + (size_t)e * estride + (size_t)pn * 256 * rowbytes; u.b1 = u.b0 + (size_t)128 * rowbytes; u.a0 = A; u.a1 = A;
        u.p0 = rt; u.p1 = pn; u.p2 = e; u.p3 = (rt - __builtin_amdgcn_readfirstlane(tstart[e])) * 256; return true; }
    const float *rsc, *swup, *b_up;
    __device__ __forceinline__ void prefetch(const Unit& u, LAS unsigned char* lds) const {
        LAS unsigned char* blk = lds + LDS_STAGE + u.q * 4096;
        const int wid = wv, e = u.p2; int lane = lane_id(); asm volatile("" : "+v"(lane));
        const int n = (int)cnt[64 * e]; int pos = u.p3 + (wid & 3) * 64 + lane; pos = pos < n ? pos : n - 1;
        if (wid < 4) __builtin_amdgcn_global_load_lds((const unsigned*)(row_tok + (size_t)e * T + pos), (LAS unsigned*)(blk + wid * 256), 4, 0, 0);
        else __builtin_amdgcn_global_load_lds((const unsigned*)(rsc + (size_t)e * T + pos), (LAS unsigned*)(blk + 1024 + (wid - 4) * 256), 4, 0, 0);
        if (wid == 0) __builtin_amdgcn_global_load_lds((const unsigned*)(swup + (size_t)e * 2 * DFF + u.p1 * 256 + lane * 4), (LAS unsigned*)(blk + 2048), 16, 0, 0);
        if (wid == 1) __builtin_amdgcn_global_load_lds((const unsigned*)(b_up + (size_t)e * 2 * DFF + u.p1 * 128 + (lane & 31) * 4 + (lane >> 5) * DFF), (LAS unsigned*)(blk + 3072), 16, 0, 0);
    }
    __device__ __forceinline__ unsigned row_off(const Unit& u, int r, LAS unsigned char* lds) const { return (unsigned)((const LAS int*)(lds + LDS_STAGE + u.q * 4096))[r] * (unsigned)rowbytes; }
};
struct SchedMoEUpT : SchedMoE { __device__ __forceinline__ bool next(int i, Unit& u) const { return next_tab(i, u); } };
struct SchedMoEDown : SchedMoE {
    const float *sa, *swdn, *b_dn;
    __device__ __forceinline__ bool next(int i, Unit& u) const { if (!SchedMoE::next_tab(i, u)) return false; u.a0 = A + (size_t)u.p0 * 256 * rowbytes; u.a1 = u.a0 + (size_t)128 * rowbytes; return true; }
    __device__ __forceinline__ void prefetch(const Unit& u, LAS unsigned char* lds) const {
        LAS unsigned char* blk = lds + LDS_STAGE + u.q * 4096;
        const int wid = wv, e = u.p2; int lane = lane_id(); asm volatile("" : "+v"(lane));
        if (wid == 1) __builtin_amdgcn_global_load_lds((const unsigned*)(swdn + (size_t)e * D + u.p1 * 256 + lane * 4), (LAS unsigned*)(blk + 1024), 16, 0, 0);
        if (wid == 2) __builtin_amdgcn_global_load_lds((const unsigned*)(b_dn + (size_t)e * D + u.p1 * 256 + lane * 4), (LAS unsigned*)(blk + 2048), 16, 0, 0);
    }
};

#define EPI_LOOP_AM for (int ai = 0; ai < 2; ++ai) _Pragma("unroll") for (int m = 0; m < 4; ++m)
#define EPI_FENCE __builtin_amdgcn_sched_barrier(0)
struct EpiG1N {
    static constexpr bool PERM = true;
    bf16 *qs, *kk, *gs, *Acat; const float *dec_f, *dec_b, *sx0, *swin;
    __device__ __forceinline__ void operator()(AccI& acci, const Unit& u, LAS unsigned char*, int wr, int wc, int fr, int fq) const {
        const int pm = u.p0, pn = u.p1, c0 = wc * 32 + 8 * fq;
        f32x4 swc[2][2];
#pragma unroll
        for (int bj = 0; bj < 2; ++bj)
#pragma unroll
            for (int n = 0; n < 2; ++n) swc[bj][n] = *(const GAS f32x4*)(swin + u.p2 + 128 * bj + c0 + 4 * n);
#define ACCF(ai_, bj_, m_, n_, j_) ((float)acci[ai_][bj_][m_][n_][j_] * (sxr * swc[bj_][n_][j_]))
        if (pn < 8) {
            const int h = pn & 3; const bool isq = pn < 4;
            float inv[8];
#pragma unroll
            for (int e = 0; e < 8; ++e) inv[e] = __builtin_amdgcn_exp2f(-(float)(c0 + e) * (13.287712379549449f / 128.f)) * 0.15915494309189535f;
            const float lgf = -fexp(dec_f[h]), lgb = -fexp(dec_b[h]);
#pragma unroll
            EPI_LOOP_AM {
                const int r = 128 * ai + 64 * wr + 16 * m + fr, tok = pm * 256 + r; const float pos = (float)tok; const float sxr = sx0[tok];
                f32x4 o1[2], o2[2];
#pragma unroll
                for (int n = 0; n < 2; ++n)
#pragma unroll
                    for (int j = 0; j < 4; ++j) { float c, s; cs_rev(pos * inv[4 * n + j], c, s); const float x1 = ACCF(ai, 0, m, n, j), x2 = ACCF(ai, 1, m, n, j); o1[n][j] = x1 * c - x2 * s; o2[n][j] = x2 * c + x1 * s; }
                if (isq) {
                    bf16* q = qs + (size_t)tok * RW + h * HD + c0; *(GAS v4u*)q = pack8(o1[0], o1[1]); *(GAS v4u*)(q + 128) = pack8(o2[0], o2[1]);
                    const int il = r; const float wf = fexp(lgf * (float)(il + 1)), wb = fexp(lgb * (float)(255 - il));
                    bf16* a = Acat + ((size_t)h * T + tok) * CAT + c0;
                    *(GAS v4u*)(a + 256) = pack8(o1[0] * wf, o1[1] * wf); *(GAS v4u*)(a + 384) = pack8(o2[0] * wf, o2[1] * wf);
                    *(GAS v4u*)(a + 512) = pack8(o1[0] * wb, o1[1] * wb); *(GAS v4u*)(a + 640) = pack8(o2[0] * wb, o2[1] * wb);
                } else {
                    bf16* k = kk + (size_t)tok * RW + h * HD + c0; *(GAS v4u*)k = pack8(o1[0] * 0.0625f, o1[1] * 0.0625f); *(GAS v4u*)(k + 128) = pack8(o2[0] * 0.0625f, o2[1] * 0.0625f);
                }
            }
        } else {
#pragma unroll
            EPI_LOOP_AM {
                const int r = 128 * ai + 64 * wr + 16 * m + fr, tok = pm * 256 + r; const float sxr = sx0[tok];
#pragma unroll
                for (int bj = 0; bj < 2; ++bj) { f32x4 v[2];
#pragma unroll
                    for (int n = 0; n < 2; ++n)
#pragma unroll
                        for (int j = 0; j < 4; ++j) { const float g = ACCF(ai, bj, m, n, j); v[n][j] = g * __builtin_amdgcn_rcpf(1.f + fexp(-g)); }
                    *(GAS v4u*)(gs + (size_t)tok * RW + (pn - 8) * 256 + bj * 128 + c0) = pack8(v[0], v[1]); }
            }
        }
    }
};
#undef ACCF
struct EpiG1SF {
    static constexpr bool PERM = true;
    bf16* uTT; const float *sx0, *swin;
    __device__ __forceinline__ void operator()(AccI& acc, const Unit& u, LAS unsigned char*, int wr, int wc, int fr, int fq) const {
        const int a0 = wc * 32 + 8 * fq;
        float sxc[2][8];
#pragma unroll
        for (int bj = 0; bj < 2; ++bj)
#pragma unroll
            for (int e = 0; e < 8; ++e) sxc[bj][e] = sx0[128 * (a0 + e) + 2 * u.p1 + bj];
#pragma unroll
        EPI_LOOP_AM { const int cch = u.p0 * 256 + 128 * ai + 64 * wr + 16 * m + fr; const float swr = swin[cch];
#pragma unroll
            for (int bj = 0; bj < 2; ++bj) { f32x4 v0, v1;
#pragma unroll
                for (int j = 0; j < 4; ++j) { v0[j] = (float)acc[ai][bj][m][0][j] * (swr * sxc[bj][j]); v1[j] = (float)acc[ai][bj][m][1][j] * (swr * sxc[bj][4 + j]); }
                *(GAS v4u*)(uTT + ((size_t)cch * 128 + (2 * u.p1 + bj)) * 128 + a0) = pack8(v0, v1); } }
    }
};
struct EpiG1SKV {
    static constexpr bool PERM = true;
    bf16 *kTw, *Bcat; const float *dec_f, *dec_b, *sx0, *swin;
    __device__ __forceinline__ void operator()(AccI& acc, const Unit& u, LAS unsigned char*, int wr, int wc, int fr, int fq) const {
        const int pm = u.p0, n_ch = u.p1, c0 = wc * 32 + 8 * fq;
        f32x4 sxc[2][2];
#pragma unroll
        for (int bj = 0; bj < 2; ++bj)
#pragma unroll
            for (int n = 0; n < 2; ++n) sxc[bj][n] = *(const GAS f32x4*)(sx0 + n_ch * 256 + 128 * bj + c0 + 4 * n);
        if (pm < 4) {
            const int h = pm; const float lgf = -fexp(dec_f[h]), lgb = -fexp(dec_b[h]);
#pragma unroll
            for (int m = 0; m < 4; ++m) {
                const int d = 64 * wr + 16 * m + fr;
                const float sw1 = swin[u.p2 + d], sw2 = swin[u.p2 + 128 + d];
                const float inv = __builtin_amdgcn_exp2f(-(float)d * (13.287712379549449f / 128.f)) * 0.15915494309189535f;
#pragma unroll
                for (int bj = 0; bj < 2; ++bj) {
                    f32x4 f1[2], f2[2], b1[2], b2[2];
#pragma unroll
                    for (int n = 0; n < 2; ++n)
#pragma unroll
                        for (int j = 0; j < 4; ++j) { const int il = 128 * bj + c0 + 4 * n + j; const float pos = (float)(n_ch * 256 + il); float c, s; cs_rev(pos * inv, c, s);
                            const float x1 = (float)acc[0][bj][m][n][j] * (sw1 * sxc[bj][n][j]), x2 = (float)acc[1][bj][m][n][j] * (sw2 * sxc[bj][n][j]); const float o1 = (x1 * c - x2 * s) * 0.0625f, o2 = (x2 * c + x1 * s) * 0.0625f;
                            const float wf = fexp(lgf * (float)(255 - il)), wb = fexp(lgb * (float)(il + 1));
                            f1[n][j] = o1 * wf; f2[n][j] = o2 * wf; b1[n][j] = o1 * wb; b2[n][j] = o2 * wb; }
                    const size_t tcol = (size_t)n_ch * 256 + 128 * bj + c0;
                    bf16* pf = kTw + ((size_t)(h * HD + d)) * T + tcol; bf16* pb = pf + (size_t)RW * T;
                    *(GAS v4u*)pf = pack8(f1[0], f1[1]); *(GAS v4u*)(pf + (size_t)128 * T) = pack8(f2[0], f2[1]);
                    *(GAS v4u*)pb = pack8(b1[0], b1[1]); *(GAS v4u*)(pb + (size_t)128 * T) = pack8(b2[0], b2[1]);
                }
            }
        } else {
            const int h = pm - 4;
#pragma unroll
            EPI_LOOP_AM { const int dv = 128 * ai + 64 * wr + 16 * m + fr; const float swr = swin[u.p2 + dv];
#pragma unroll
                for (int bj = 0; bj < 2; ++bj) { f32x4 v0, v1;
#pragma unroll
                    for (int j = 0; j < 4; ++j) { v0[j] = (float)acc[ai][bj][m][0][j] * (swr * sxc[bj][0][j]); v1[j] = (float)acc[ai][bj][m][1][j] * (swr * sxc[bj][1][j]); }
                    *(GAS v4u*)(Bcat + ((size_t)(h * NCH + n_ch) * 256 + dv) * CAT + 128 * bj + c0) = pack8(v0, v1); } }
        }
    }
};
struct EpiS1 {
    static constexpr bool PERM = true;
    bf16* A1;
    __device__ __forceinline__ void operator()(Acc& acc, const Unit& u, LAS unsigned char*, int wr, int wc, int fr, int fq) const {
        const int b0 = wc * 32 + 8 * fq;
#pragma unroll
        for (int m = 0; m < 4; ++m) { const int k1 = 64 * wr + 16 * m + fr;
#pragma unroll
            for (int bj = 0; bj < 2; ++bj) { const int cch = 2 * u.p1 + bj; f32x4 re[2], im[2];
#pragma unroll
                for (int n = 0; n < 2; ++n)
#pragma unroll
                    for (int j = 0; j < 4; ++j) { const int b = b0 + 4 * n + j; float c, s; cs_rev((float)(k1 * b) * (1.f / 16384.f), c, s);
                        const float xr = acc[0][bj][m][n][j], xi = acc[1][bj][m][n][j]; re[n][j] = xr * c + xi * s; im[n][j] = xi * c - xr * s; }
                bf16* p = A1 + (((size_t)k1 * 1024 + cch) * 2) * 128 + b0;
                *(GAS v4u*)p = pack8(re[0], re[1]); *(GAS v4u*)(p + 128) = pack8(im[0], im[1]); EPI_FENCE; } }
    }
};
struct EpiS2 {
    static constexpr bool PERM = true;
    bf16* Zt;
    __device__ __forceinline__ void operator()(Acc& acc, const Unit& u, LAS unsigned char*, int wr, int wc, int fr, int fq) const {
        const int k1 = u.p1 >> 2, cb = (u.p1 & 3) * 256, c0 = wc * 32 + 8 * fq;
#pragma unroll
        EPI_LOOP_AM { const int k2 = 64 * wr + 16 * m + fr, k = k1 + 128 * k2;
#pragma unroll
            for (int bj = 0; bj < 2; ++bj) { const int cch = cb + 128 * bj + c0, g = cch >> 7, cg = cch & 127;
                *(GAS v4u*)(Zt + (size_t)k * 2048 + g * 256 + ai * 128 + cg) = pack8(acc[ai][bj][m][0], acc[ai][bj][m][1]); } }
    }
};
struct EpiChan {
    static constexpr bool PERM = true;
    bf16* y;
    __device__ __forceinline__ void operator()(Acc& acc, const Unit& u, LAS unsigned char*, int wr, int wc, int fr, int fq) const {
        const int l0 = wc * 32 + 8 * fq; const float norm = 6.9053396600248786e-4f;
#pragma unroll
        EPI_LOOP_AM { const int R = u.p0 * 256 + 128 * ai + 64 * wr + 16 * m + fr, k = R >> 3, g = R & 7;
            *(GAS v4u*)(y + (size_t)k * D + g * 128 + l0) = pack8(acc[ai][0][m][0] * norm, acc[ai][0][m][1] * norm); }
    }
};
struct EpiScores {
    static constexpr bool PERM = true;
    bf16* Acat; const float *dec_f, *dec_b;
    __device__ __forceinline__ void operator()(Acc& acc, const Unit& u, LAS unsigned char*, int wr, int wc, int fr, int fq) const {
        const int h = u.p0, n_ch = u.p1, c0 = wc * 32 + 8 * fq; const float lgf = -fexp(dec_f[h]), lgb = -fexp(dec_b[h]);
#pragma unroll
        EPI_LOOP_AM { const int i = 128 * ai + 64 * wr + 16 * m + fr;
#pragma unroll
            for (int bj = 0; bj < 2; ++bj) { f32x4 v[2];
#pragma unroll
                for (int n = 0; n < 2; ++n)
#pragma unroll
                    for (int j = 0; j < 4; ++j) { const int jc = 128 * bj + c0 + 4 * n + j; const float dd = (float)(i - jc); const float w = (jc <= i) ? fexp(lgf * dd) : fexp(-lgb * dd); v[n][j] = acc[ai][bj][m][n][j] * w; }
                *(GAS v4u*)(Acat + ((size_t)h * T + n_ch * 256 + i) * CAT + 128 * bj + c0) = pack8(v[0], v[1]); EPI_FENCE; } }
    }
};
struct EpiKV {
    static constexpr bool PERM = true;
    bf16* kvT;
    __device__ __forceinline__ void operator()(Acc& acc, const Unit& u, LAS unsigned char*, int wr, int wc, int fr, int fq) const {
#pragma unroll
        EPI_LOOP_AM { const int dv = 128 * ai + 64 * wr + 16 * m + fr; bf16* rowp = kvT + (((size_t)u.p0 * NCH + u.p1) * 256 + dv) * 256 + wc * 32 + 8 * fq;
#pragma unroll
            for (int bj = 0; bj < 2; ++bj) *(GAS v4u*)(rowp + bj * 128) = pack8(acc[ai][bj][m][0], acc[ai][bj][m][1]); }
    }
};
struct EpiOut {
    static constexpr bool PERM = true;
    bf16* y; const bf16* gs; const float* gn_g;
    __device__ __forceinline__ void operator()(Acc& acc, const Unit& u, LAS unsigned char* lds, int wr, int wc, int fr, int fq) const {
        const int h = u.p0, n_ch = u.p1, c0 = wc * 32 + 8 * fq;
        LAS f32x2* P = (LAS f32x2*)(lds + LDS_STAGE);
#pragma unroll
        EPI_LOOP_AM {
            float s = 0.f;
#pragma unroll
            for (int bj = 0; bj < 2; ++bj)
#pragma unroll
                for (int n = 0; n < 2; ++n) { const f32x4 x = acc[ai][bj][m][n]; s += (x[0] + x[1]) + (x[2] + x[3]); }
            s += __shfl_xor(s, 16); s += __shfl_xor(s, 32);
            const float mw = s * (1.f / 64.f); float q = 0.f;
#pragma unroll
            for (int bj = 0; bj < 2; ++bj)
#pragma unroll
                for (int n = 0; n < 2; ++n) { const f32x4 d = acc[ai][bj][m][n] - mw; q += (d[0] * d[0] + d[1] * d[1]) + (d[2] * d[2] + d[3] * d[3]); }
            q += __shfl_xor(q, 16); q += __shfl_xor(q, 32);
            if (fq == 0) P[(128 * ai + 64 * wr + 16 * m + fr) * 4 + wc] = (f32x2){mw, q};
        }
        LDS_WAIT(); __builtin_amdgcn_s_barrier(); asm volatile("" ::: "memory");
#pragma unroll
        EPI_LOOP_AM {
            const int r = 128 * ai + 64 * wr + 16 * m + fr, tok = n_ch * 256 + r;
            const f32x2 a = P[r * 4 + 0], b = P[r * 4 + 1], c = P[r * 4 + 2], d = P[r * 4 + 3];
            const float mt = (a.x + b.x + c.x + d.x) * 0.25f; const float da = a.x - mt, db = b.x - mt, dc = c.x - mt, dd = d.x - mt;
            const float m2 = (a.y + b.y) + (c.y + d.y) + 64.f * ((da * da + db * db) + (dc * dc + dd * dd));
            const float rstd = 1.f / sqrtf(m2 * (1.f / 256.f) + GN_EPS);
#pragma unroll
            for (int bj = 0; bj < 2; ++bj) {
                const int col = h * HD + 128 * bj + c0; const v4u gv = *(const GAS v4u*)(gs + (size_t)tok * RW + col);
                const f32x4 g0 = *(const GAS f32x4*)(gn_g + col), g1 = *(const GAS f32x4*)(gn_g + col + 4);
                f32x4 o0 = (acc[ai][bj][m][0] - mt) * rstd * g0, o1 = (acc[ai][bj][m][1] - mt) * rstd * g1;
                o0[0] *= bf_lo(gv.x); o0[1] *= bf_hi(gv.x); o0[2] *= bf_lo(gv.y); o0[3] *= bf_hi(gv.y); o1[0] *= bf_lo(gv.z); o1[1] *= bf_hi(gv.z); o1[2] *= bf_lo(gv.w); o1[3] *= bf_hi(gv.w);
                *(GAS v4u*)(y + (size_t)tok * D + FW + col) = pack8(o0, o1); }
        }
        LDS_WAIT(); __builtin_amdgcn_s_barrier(); asm volatile("" ::: "memory");
    }
};
struct EpiWout {
    static constexpr bool PERM = true;
    bf16* z1; const float *x, *st0, *g0, *b0;
    __device__ __forceinline__ void operator()(Acc& acc, const Unit& u, LAS unsigned char*, int wr, int wc, int fr, int fq) const {
        const int colb = u.p1 * 256 + wc * 32 + 8 * fq;
#pragma unroll
        for (int bj = 0; bj < 2; ++bj) { const int col = colb + bj * 128;
            const f32x4 ga = *(const GAS f32x4*)(g0 + col), gb = *(const GAS f32x4*)(g0 + col + 4), ba = *(const GAS f32x4*)(b0 + col), bb = *(const GAS f32x4*)(b0 + col + 4);
#pragma unroll
            EPI_LOOP_AM { const int row = u.p0 * 256 + 128 * ai + 64 * wr + 16 * m + fr; const f32x2 st = *(const GAS f32x2*)(st0 + 2 * row); const size_t off = (size_t)row * D + col;
                const f32x4 xa = *(const GAS f32x4*)(x + off), xb = *(const GAS f32x4*)(x + off + 4);
                *(GAS v4u*)(z1 + off) = pack8(((xa - st.x) * st.y * ga + ba) * ALPHA + acc[ai][bj][m][0], ((xb - st.x) * st.y * gb + bb) * ALPHA + acc[ai][bj][m][1]); } }
    }
};
struct EpiUp {
    static constexpr bool PERM = true;
    unsigned char* act8;
    __device__ __forceinline__ void operator()(AccI& acc, const Unit& u, LAS unsigned char* lds, int wr, int wc, int fr, int fq) const {
        const int rt = u.p0, pn = u.p1, c0 = pn * 128 + wc * 32 + 8 * fq;
        const LAS float* blk = (const LAS float*)(lds + LDS_STAGE + u.q * 4096);
        float sx[2][4];
#pragma unroll
        EPI_LOOP_AM sx[ai][m] = blk[256 + 128 * ai + 64 * wr + 16 * m + fr];
#pragma unroll
        for (int n = 0; n < 2; ++n) {
            const int cc = wc * 32 + 8 * fq + 4 * n;
            const f32x4 sg = *(const LAS f32x4*)(blk + 512 + cc), sl = *(const LAS f32x4*)(blk + 512 + 128 + cc), bg = *(const LAS f32x4*)(blk + 768 + cc), bl = *(const LAS f32x4*)(blk + 768 + 128 + cc);
#pragma unroll
            EPI_LOOP_AM { const int r = 128 * ai + 64 * wr + 16 * m + fr; f32x2 v2[2];
#pragma unroll
                for (int jp = 0; jp < 2; ++jp) {
                    const f32x2 sx2 = (f32x2){sx[ai][m], sx[ai][m]};
                    f32x2 gl = (f32x2){(float)acc[ai][0][m][n][2 * jp], (float)acc[ai][0][m][n][2 * jp + 1]} * (sx2 * (f32x2){sg[2 * jp], sg[2 * jp + 1]}) + (f32x2){bg[2 * jp], bg[2 * jp + 1]};
                    f32x2 li = (f32x2){(float)acc[ai][1][m][n][2 * jp], (float)acc[ai][1][m][n][2 * jp + 1]} * (sx2 * (f32x2){sl[2 * jp], sl[2 * jp + 1]}) + (f32x2){bl[2 * jp], bl[2 * jp + 1]};
                    gl = __builtin_elementwise_min(gl, (f32x2){7.f, 7.f}); li = __builtin_elementwise_min(__builtin_elementwise_max(li, (f32x2){-7.f, -7.f}), (f32x2){7.f, 7.f});
                    const f32x2 ea = gl * (-1.702f * 1.4426950408889634f); f32x2 den; den.x = __builtin_amdgcn_exp2f(ea.x); den.y = __builtin_amdgcn_exp2f(ea.y); den = den + 1.0f;
                    f32x2 rc; rc.x = __builtin_amdgcn_rcpf(den.x); rc.y = __builtin_amdgcn_rcpf(den.y);
                    v2[jp] = (gl * rc) * (li * 4.0f + 4.0f); }
                int p = __builtin_amdgcn_cvt_pk_fp8_f32(v2[0].x, v2[0].y, 0, false); p = __builtin_amdgcn_cvt_pk_fp8_f32(v2[1].x, v2[1].y, p, true);
                *(GAS int*)(act8 + ((size_t)rt * 256 + r) * DFF + c0 + 4 * n) = p; }
        }
    }
};
struct EpiDown {
    static constexpr bool PERM = true;
    unsigned char* yr8;
    __device__ __forceinline__ void operator()(Acc& acc, const Unit& u, LAS unsigned char* lds, int wr, int wc, int fr, int fq) const {
        const int rt = u.p0, pn = u.p1, c0 = pn * 256 + wc * 32 + 8 * fq;
        const LAS float* blk = (const LAS float*)(lds + LDS_STAGE + u.q * 4096);
#pragma unroll
        for (int bj = 0; bj < 2; ++bj) { const int cc = 128 * bj + wc * 32 + 8 * fq;
#pragma unroll
            EPI_LOOP_AM { const int r = 128 * ai + 64 * wr + 16 * m + fr;
                const f32x4 w0 = *(const LAS f32x4*)(blk + 256 + cc) * 0.25f, w1 = *(const LAS f32x4*)(blk + 256 + cc + 4) * 0.25f, b0 = *(const LAS f32x4*)(blk + 512 + cc), b1 = *(const LAS f32x4*)(blk + 512 + cc + 4);
                f32x4 y0 = (acc[ai][bj][m][0] * w0 + b0) * 32.f, y1 = (acc[ai][bj][m][1] * w1 + b1) * 32.f;
#pragma unroll
                for (int j = 0; j < 4; ++j) { y0[j] = fminf(fmaxf(y0[j], -440.f), 440.f); y1[j] = fminf(fmaxf(y1[j], -440.f), 440.f); }
                int p0 = __builtin_amdgcn_cvt_pk_fp8_f32(y0[0], y0[1], 0, false); p0 = __builtin_amdgcn_cvt_pk_fp8_f32(y0[2], y0[3], p0, true);
                int p1 = __builtin_amdgcn_cvt_pk_fp8_f32(y1[0], y1[1], 0, false); p1 = __builtin_amdgcn_cvt_pk_fp8_f32(y1[2], y1[3], p1, true);
                *(GAS v2u*)(yr8 + ((size_t)rt * 256 + r) * D + c0 + 128 * bj) = (v2u){(unsigned)p0, (unsigned)p1}; EPI_FENCE; } }
    }
};

__device__ __forceinline__ void p3_scan(Frame& F) {
    const bf16* kvT = WSP(bf16, WS_KVT); bf16* Bcat = WSP(bf16, WS_BCAT);
    const int NQ = 2 * NH * 256 * 64;
    for (int q = F.vcu * NTHR + FTID; q < NQ; q += F.G * NTHR) {
        const int dk4 = q & 63, dv = (q >> 6) & 255, dh = q >> 14, dir = dh >> 2, h = dh & 3;
        const float lg = -fexp((dir ? F.dec_b : F.dec_f)[h]); const float cd = fexp(lg * (float)C2);
        f32x4 S = (f32x4){0.f, 0.f, 0.f, 0.f};
        for (int s = 0; s < NCH; ++s) { const int n = dir ? (NCH - 1 - s) : s;
            const v2u kw = *(const GAS v2u*)(kvT + (((size_t)dh * NCH + n) * 256 + dv) * 256 + dk4 * 4); const f32x4 kv = (f32x4){bf_lo(kw.x), bf_hi(kw.x), bf_lo(kw.y), bf_hi(kw.y)};
            v2u w; w.x = cvt_pk_bf16(S[0], S[1]); w.y = cvt_pk_bf16(S[2], S[3]);
            *(GAS v2u*)(Bcat + ((size_t)(h * NCH + n) * 256 + dv) * CAT + 256 + dir * 256 + dk4 * 4) = w;
            S = S * cd + kv; }
    }
}

__device__ __forceinline__ void p6_router(Frame& F) {
    const bf16* z1 = WSP(bf16, WS_Z1); unsigned* h1q = WSP(unsigned, WS_H1Q); float* sxg = WSP(float, WS_SX); float* rsc = WSP(float, WS_RSC); float* st1 = WSP(float, WS_ST0) + 2 * T;
    int* topi = WSP(int, WS_RT); float* gate = (float*)(topi + 4 * T); int* posb = (int*)(gate + 4 * T); int* row_tok = posb + 4 * T;
    LAS float* hc = (LAS float*)F.lds;
    LAS float* wrc = hc + 64 * 257;
    LAS float* stl = wrc + 256 * 32;
    LAS float* lg = stl + 128;
    LAS int* hist = (LAS int*)(lg + 64 * 33);
    LAS float* sxl = (LAS float*)(hist + 64);
    for (int blk = F.vcu; blk < T / 64; blk += F.G) {
        const int t0 = blk * 64;
#pragma unroll 1
        for (int bt = 0; bt < 2; ++bt) {
            v2u raw[4][8];
#pragma unroll
            for (int rr = 0; rr < 4; ++rr) { const GAS v2u* xr = (const GAS v2u*)(z1 + (size_t)(t0 + F.wave * 8 + bt * 4 + rr) * D) + FLANE;
#pragma unroll
                for (int j = 0; j < 8; ++j) raw[rr][j] = xr[64 * j]; }
#pragma unroll
            for (int rr = 0; rr < 4; ++rr) { const int row = F.wave * 8 + bt * 4 + rr, m = t0 + row;
                f32x4 v[8]; float s = 0.f;
#pragma unroll
                for (int j = 0; j < 8; ++j) { const v2u w = raw[rr][j]; v[j] = (f32x4){bf_lo(w.x), bf_hi(w.x), bf_lo(w.y), bf_hi(w.y)}; s += (v[j][0] + v[j][1]) + (v[j][2] + v[j][3]); }
                const float mean = wave_sum(s) * (1.f / D); float s2 = 0.f;
#pragma unroll
                for (int j = 0; j < 8; ++j) { v[j] = v[j] - mean; s2 += (v[j][0] * v[j][0] + v[j][1] * v[j][1]) + (v[j][2] * v[j][2] + v[j][3] * v[j][3]); }
                const float rstd = 1.f / sqrtf(wave_sum(s2) * (1.f / D) + LN_EPS);
                float am = 0.f;
#pragma unroll
                for (int j = 0; j < 8; ++j) { const f32x4 g = *((const GAS f32x4*)F.ln1_g + FLANE + 64 * j), b = *((const GAS f32x4*)F.ln1_b + FLANE + 64 * j);
                    v[j] = v[j] * rstd * g + b; am = fmaxf(am, fmaxf(fmaxf(fabsf(v[j][0]), fabsf(v[j][1])), fmaxf(fabsf(v[j][2]), fabsf(v[j][3])))); }
#pragma unroll
                for (int o = 1; o < 64; o <<= 1) am = fmaxf(am, __shfl_xor(am, o));
                const float sc = am > 0.f ? am * (1.f / 127.f) : 1.f, inv = 1.f / sc;
#pragma unroll
                for (int j = 0; j < 8; ++j) { const int q0 = (int)__builtin_rintf(v[j][0] * inv), q1 = (int)__builtin_rintf(v[j][1] * inv), q2 = (int)__builtin_rintf(v[j][2] * inv), q3 = (int)__builtin_rintf(v[j][3] * inv);
                    h1q[(size_t)m * (D / 4) + FLANE + 64 * j] = (unsigned)(q0 & 0xff) | ((unsigned)(q1 & 0xff) << 8) | ((unsigned)(q2 & 0xff) << 16) | ((unsigned)(q3 & 0xff) << 24); }
                if (FLANE == 0) { st1[2 * m] = mean; st1[2 * m + 1] = rstd; stl[2 * row] = mean; stl[2 * row + 1] = rstd; sxg[m] = sc; sxl[row] = sc; }
            }
        }
        if (FTID < 64) hist[FTID] = 0;
        __syncthreads();
        const int kq = FTID >> 7, rg = (FTID >> 3) & 15, eq = FTID & 7; f32x4 ac[4];
#pragma unroll
        for (int i = 0; i < 4; ++i) ac[i] = (f32x4){0.f, 0.f, 0.f, 0.f};
        LAS float* hcT = hc;
        v2u zp[8]; f32x4 wp[4];
#define P6_LOAD(kc_) do { _Pragma("unroll") for (int i_ = 0; i_ < 8; ++i_) { const int q_ = FTID + NTHR * i_, r_ = q_ & 63, c4_ = (q_ >> 6) * 4; zp[i_] = *(const GAS v2u*)(z1 + (size_t)(t0 + r_) * D + (kc_) * 256 + c4_); } \
        _Pragma("unroll") for (int i_ = 0; i_ < 4; ++i_) { const int q_ = FTID + NTHR * i_, k_ = q_ >> 3, c4_ = (q_ & 7) * 4; wp[i_] = *(const GAS f32x4*)(F.w_r + (size_t)((kc_) * 256 + k_) * NE + c4_); } } while (0)
        P6_LOAD(0);
        for (int kc = 0; kc < 8; ++kc) {
#pragma unroll
            for (int i = 0; i < 8; ++i) { const int q = FTID + NTHR * i, r = q & 63, c4 = (q >> 6) * 4, col = kc * 256 + c4; const v2u zw = zp[i];
                const f32x4 zv = (f32x4){bf_lo(zw.x), bf_hi(zw.x), bf_lo(zw.y), bf_hi(zw.y)}, g = *(const GAS f32x4*)(F.ln1_g + col), b = *(const GAS f32x4*)(F.ln1_b + col);
                const f32x4 hh = (zv - stl[2 * r]) * stl[2 * r + 1] * g + b; LAS float* d = hcT + c4 * 64 + r; d[0] = hh[0]; d[64] = hh[1]; d[128] = hh[2]; d[192] = hh[3]; }
#pragma unroll
            for (int i = 0; i < 4; ++i) { const int q = FTID + NTHR * i, k = q >> 3, c4 = (q & 7) * 4; *(LAS f32x4*)(wrc + k * 32 + c4) = wp[i]; }
            __syncthreads();
            if (kc + 1 < 8) P6_LOAD(kc + 1);
#pragma unroll 8
            for (int k = kq * 64; k < kq * 64 + 64; ++k) { const f32x4 h4 = *(const LAS f32x4*)(hcT + k * 64 + rg * 4), w4 = *(const LAS f32x4*)(wrc + k * 32 + eq * 4);
                ac[0] = ac[0] + w4 * h4[0]; ac[1] = ac[1] + w4 * h4[1]; ac[2] = ac[2] + w4 * h4[2]; ac[3] = ac[3] + w4 * h4[3]; }
            __syncthreads();
        }
#undef P6_LOAD
        { LAS float* part = hc;
#pragma unroll
          for (int i = 0; i < 4; ++i) *(LAS f32x4*)(part + (kq * 64 + rg * 4 + i) * 32 + eq * 4) = ac[i];
          __syncthreads();
          if (FTID < 512) { const int r = FTID >> 3, e0 = (FTID & 7) * 4;
              const f32x4 a = *(const LAS f32x4*)(part + (0 * 64 + r) * 32 + e0), b = *(const LAS f32x4*)(part + (1 * 64 + r) * 32 + e0), c = *(const LAS f32x4*)(part + (2 * 64 + r) * 32 + e0), d4 = *(const LAS f32x4*)(part + (3 * 64 + r) * 32 + e0);
              const f32x4 br = *(const GAS f32x4*)(F.b_r + e0), sum = ((a + b) + (c + d4)) + br; LAS float* d = lg + r * 33 + e0; d[0] = sum[0]; d[1] = sum[1]; d[2] = sum[2]; d[3] = sum[3]; } }
        __syncthreads();
        int ek[4] = {0, 0, 0, 0}, lp[4] = {0, 0, 0, 0}; float gk[4] = {0.f, 0.f, 0.f, 0.f};
        if (FTID < 64) {
            float lv[4]; unsigned used = 0u;
#pragma unroll
            for (int k = 0; k < 4; ++k) { float best = -3.0e38f; int bi = 0;
                for (int e = 0; e < NE; ++e) { const float v = lg[FTID * 33 + e]; const bool ok = !((used >> e) & 1u) && (v > best); best = ok ? v : best; bi = ok ? e : bi; }
                used |= 1u << bi; ek[k] = bi; lv[k] = best; }
            const float mx = lv[0]; float den = 0.f;
#pragma unroll
            for (int k = 0; k < 4; ++k) { gk[k] = fexp(lv[k] - mx); den += gk[k]; }
            const float rd = 1.f / den;
#pragma unroll
            for (int k = 0; k < 4; ++k) { gk[k] *= rd; lp[k] = __hip_atomic_fetch_add(&hist[ek[k]], 1, __ATOMIC_RELAXED, __HIP_MEMORY_SCOPE_WORKGROUP); }
        }
        __syncthreads();
        if (FTID < NE) hist[32 + FTID] = (int)__hip_atomic_fetch_add(F.ctl + CW_CNT + 64 * FTID, (unsigned)hist[FTID], RLX_AGENT);
        __syncthreads();
        if (FTID < 64) { const int tok = t0 + FTID;
#pragma unroll
            for (int k = 0; k < 4; ++k) { const int pos = hist[32 + ek[k]] + lp[k]; row_tok[(size_t)ek[k] * T + pos] = tok; rsc[(size_t)ek[k] * T + pos] = sxl[FTID]; topi[4 * tok + k] = ek[k]; gate[4 * tok + k] = gk[k]; posb[4 * tok + k] = pos; } }
        __syncthreads();
    }
}

__device__ __forceinline__ void build_units(Frame& F, LAS int* tstart, int nN, int c) {
    __syncthreads();
    if (FTID < 64) { const int RT = tstart[NE], L = FTID * F.G + c; int w = -1;
        if (L < RT * nN) { int rt, pn; gm::tile_order(L, RT, nN, rt, pn); w = rt | (pn << 10) | (tstart[40 + rt] << 15); }
        tstart[400 + FTID] = w; }
    __syncthreads();
}

__device__ __forceinline__ void p8_requant(Frame& F, const LAS int* tstart) {
    const bf16* act = WSP(bf16, WS_ACT); unsigned* aq = WSP(unsigned, WS_ACTQ); float* sa = WSP(float, WS_SA); const unsigned* rmax = F.ctl + CW_RMAX;
    const int R = tstart[NE] * 256, gw = F.vcu * NWAVES + F.wave, NGW = F.G * NWAVES;
    for (int row = gw; row < R; row += NGW) {
        const float mx = __uint_as_float(rmax[row]); const float sc = mx > 0.f ? mx * (1.f / 127.f) : 1.f, inv = 1.f / sc;
#pragma unroll
        for (int j = 0; j < 2; ++j) { const int col = 16 * FLANE + 1024 * j;
            const v4u a = *(const GAS v4u*)(act + (size_t)row * DFF + col), b = *(const GAS v4u*)(act + (size_t)row * DFF + col + 8);
            const unsigned src[8] = {a.x, a.y, a.z, a.w, b.x, b.y, b.z, b.w}; unsigned o[4];
#pragma unroll
            for (int d = 0; d < 4; ++d) { unsigned w = 0u;
#pragma unroll
                for (int h2 = 0; h2 < 2; ++h2) { const unsigned u2 = src[2 * d + h2]; int q0 = (int)__builtin_rintf(bf_lo(u2) * inv), q1 = (int)__builtin_rintf(bf_hi(u2) * inv);
                    q0 = q0 > 127 ? 127 : (q0 < -127 ? -127 : q0); q1 = q1 > 127 ? 127 : (q1 < -127 ? -127 : q1);
                    w |= ((unsigned)(q0 & 0xff) << (16 * h2)) | ((unsigned)(q1 & 0xff) << (16 * h2 + 8)); }
                o[d] = w; }
            *(GAS v4u*)(aq + ((size_t)row * DFF + col) / 4) = (v4u){o[0], o[1], o[2], o[3]}; }
        if (FLANE == 0) sa[row] = sc;
    }
}

__device__ __forceinline__ void build_tstart(Frame& F, LAS int* tstart) {
    if (FTID == 0) { int s = 0; for (int e = 0; e < NE; ++e) { tstart[e] = s; const unsigned n = __hip_atomic_load(F.ctl + CW_CNT + 64 * e, RLX_AGENT); s += (int)((n + 255u) >> 8); } tstart[NE] = s; }
    __syncthreads();
    for (int rt = FTID; rt < RT_MAX; rt += NTHR) { int e = 0; for (int j = 1; j < NE; ++j) e += (tstart[j] <= rt) ? 1 : 0; tstart[40 + rt] = e; }
    __syncthreads();
}

__device__ __forceinline__ void p9_combine(Frame& F, const LAS int* tstart) {
    const bf16* z1 = WSP(bf16, WS_Z1); const float* st1 = WSP(float, WS_ST0) + 2 * T; const unsigned char* yr = (const unsigned char*)(F.ws + WS_YR);
    const int* topi = WSP(int, WS_RT); const float* gate = (const float*)(topi + 4 * T); const int* posb = (const int*)(gate + 4 * T);
    const int gw = F.vcu * NWAVES + F.wave, NGW = F.G * NWAVES; const int lane = lane_id();
    for (int m = gw; m < T; m += NGW) {
        const float mean1 = st1[2 * m], rstd1 = st1[2 * m + 1];
        size_t ro[4]; float gk[4];
#pragma unroll
        for (int k = 0; k < 4; ++k) { const int e = topi[4 * m + k]; ro[k] = ((size_t)tstart[e] * 256 + posb[4 * m + k]) * D; gk[k] = gate[4 * m + k]; }
        f32x4 v[8]; float s = 0.f;
#pragma unroll
        for (int j = 0; j < 8; ++j) { const int col = 4 * lane + 256 * j;
            const v2u zw = *(const GAS v2u*)(z1 + (size_t)m * D + col); const f32x4 zv = (f32x4){bf_lo(zw.x), bf_hi(zw.x), bf_lo(zw.y), bf_hi(zw.y)}, g = *(const GAS f32x4*)(F.ln1_g + col), b = *(const GAS f32x4*)(F.ln1_b + col);
            f32x4 a = ((zv - mean1) * rstd1 * g + b) * ALPHA;
#pragma unroll
            for (int k = 0; k < 4; ++k) { const int w = *(const GAS int*)(yr + ro[k] + col); const f32x2 lo = __builtin_amdgcn_cvt_pk_f32_fp8(w, false), hi = __builtin_amdgcn_cvt_pk_f32_fp8(w, true); const float g = gk[k] * (1.f / 32.f);
                a[0] += g * lo.x; a[1] += g * lo.y; a[2] += g * hi.x; a[3] += g * hi.y; }
            v[j] = a; s += (a[0] + a[1]) + (a[2] + a[3]); }
        const float mean = wave_sum(s) * (1.f / D); float s2 = 0.f;
#pragma unroll
        for (int j = 0; j < 8; ++j) { v[j] = v[j] - mean; s2 += (v[j][0] * v[j][0] + v[j][1] * v[j][1]) + (v[j][2] * v[j][2] + v[j][3] * v[j][3]); }
        const float rstd = 1.f / sqrtf(wave_sum(s2) * (1.f / D) + LN_EPS);
#pragma unroll
        for (int j = 0; j < 8; ++j) { const int col = 4 * lane + 256 * j; const f32x4 g = *(const GAS f32x4*)(F.ln2_g + col), b = *(const GAS f32x4*)(F.ln2_b + col);
            *(GAS f32x4*)(F.out + (size_t)m * D + col) = v[j] * rstd * g + b; }
    }
}

constexpr int NPH = 10;
__global__ void __launch_bounds__(NTHR, 2) fwd(Args args) {
    extern __shared__ __attribute__((aligned(16))) unsigned char lds_raw[];
    Frame F;
    F.lds = (LAS unsigned char*)lds_raw; F.ws = args.ws; F.ctl = (unsigned*)(args.ws + WS_CTL);
    F.wave = __builtin_amdgcn_readfirstlane((int)threadIdx.x >> 6);
    F.G = gridDim.x; { const int bx = blockIdx.x; F.vcu = (F.G % 8 == 0) ? (bx % 8) * (F.G / 8) + bx / 8 : bx; }
#define CAS __attribute__((address_space(4)))
#define FRAME_RELOAD() do { const CAS char* kp_ = (const CAS char*)__builtin_amdgcn_kernarg_segment_ptr(); asm volatile("" : "+s"(kp_)); const CAS Args* ap_ = (const CAS Args*)kp_; \
    F.x = ap_->in[0]; F.ln0_g = ap_->in[1]; F.ln0_b = ap_->in[2]; F.w_in = ap_->in[3]; F.dec_f = ap_->in[4]; F.dec_b = ap_->in[5]; F.gn_g = ap_->in[6]; F.w_out = ap_->in[7]; \
    F.ln1_g = ap_->in[8]; F.ln1_b = ap_->in[9]; F.w_r = ap_->in[10]; F.b_r = ap_->in[11]; F.w_up = ap_->in[12]; F.b_up = ap_->in[13]; F.w_dn = ap_->in[14]; F.b_dn = ap_->in[15]; \
    F.ln2_g = ap_->in[16]; F.ln2_b = ap_->in[17]; F.out = ap_->out; F.ws = ap_->ws; F.ctl = (unsigned*)(F.ws + WS_CTL); } while (0)
    FRAME_RELOAD();
    volatile LAS unsigned* lctl = (volatile LAS unsigned*)(F.lds + LDS_CTL_OFF);
    LAS int* tstart = (LAS int*)(F.lds + LDS_CTL_OFF + 64);
    for (int u = FTID; u < 128; u += NTHR) lctl[u] = 0u;
    __syncthreads();
    const int lo = args.ph_lo, hi = args.ph_hi;
    const bool single = (hi - lo) > 1;
    XcdBarrier bar; bar.bar = F.ctl + CW_BAR; bar.x = 0; bar.st = lctl; bar.wave = F.wave;
    if (single) { bar = xcd_barrier_post(F.ctl + CW_BAR, lctl); bar.wave = F.wave; }
#ifndef PH_MASK
#define PH_MASK 0x3ff
#endif
#define IN(k) (((PH_MASK >> (k)) & 1) && lo <= (k) && (k) < hi)
#ifndef SUB_MASK
#define SUB_MASK 0xff
#endif
#define SUB(n) ((SUB_MASK >> (n)) & 1)
#define SEAM(k) do { if (IN(k) && IN((k) + 1)) xcd_barrier(bar); } while (0)
    const int bc = (int)blockIdx.x;

    const int nS = (NE * 128 + F.G - 1) / F.G + (NE * 64 + F.G - 1) / F.G; int sdone = 0; const int qgrp = (int)(blockIdx.x >> 3);
#define QSLOT(k24) do { const int e_ = sdone + (nS * (k24) + 23) / 24; do_slabs(F, sdone, e_ < nS ? e_ : nS); sdone = e_; } while (0)
#define QG(slot, nslots, k24) do { if (qgrp % (nslots) == (slot)) QSLOT(k24); } while (0)
    if (IN(0)) { FRAME_RELOAD(); p0_prologue(F); __syncthreads(); { const int nW = (DIN / 32 + F.G - 1) / F.G; do_slabs(F, -nW, 0); } }
    SEAM(0);
    if (IN(1)) { FRAME_RELOAD();
        QG(0, 4, 9);
        if (SUB(0)) { SchedG1N S; S.nt = D / 128; S.pitchA = D / 2; S.pitchB = D / 2; S.multA = 1; S.multB = 1; S.G = F.G; S.c = bc; S.wv = F.wave; S.A = (const char*)WSP(bf16, WS_H0B); S.Bt = (const char*)WSP(bf16, WS_WIN);
          EpiG1N E{WSP(bf16, WS_QS), WSP(bf16, WS_KK), WSP(bf16, WS_GS), WSP(bf16, WS_ACAT), F.dec_f, F.dec_b, WSP(float, WS_SX0), WSP(float, WS_SWIN)};
          gm::gemm_run<EpiG1N, SchedG1N, false, true>(F.lds, S, E); }
        QG(1, 4, 9);
        if (SUB(1)) { SchedG1SF S; S.nt = D / 128; S.pitchA = D / 2; S.pitchB = D / 2; S.multA = 1; S.multB = 128; S.G = F.G; S.c = bc; S.wv = F.wave; S.A = (const char*)WSP(bf16, WS_WIN); S.Bt = (const char*)WSP(bf16, WS_H0B);
          EpiG1SF E{WSP(bf16, WS_UTT), WSP(float, WS_SX0), WSP(float, WS_SWIN)};
          gm::gemm_run<EpiG1SF, SchedG1SF, false, true>(F.lds, S, E); }
        QG(2, 4, 9);
        if (SUB(2)) { SchedG1SKV S; S.nt = D / 128; S.pitchA = D / 2; S.pitchB = D / 2; S.multA = 1; S.multB = 1; S.G = F.G; S.c = bc; S.wv = F.wave; S.A = (const char*)WSP(bf16, WS_WIN); S.Bt = (const char*)WSP(bf16, WS_H0B);
          EpiG1SKV E{WSP(bf16, WS_KTW), WSP(bf16, WS_BCAT), F.dec_f, F.dec_b, WSP(float, WS_SX0), WSP(float, WS_SWIN)};
          gm::gemm_run<EpiG1SKV, SchedG1SKV, false, true>(F.lds, S, E); }
        QG(3, 4, 9);
    }
    SEAM(1);
    if (IN(2)) { FRAME_RELOAD();
        QG(0, 4, 6);
        if (SUB(3)) { SchedFixA S; S.nt = 2; S.pitchA = 128; S.pitchB = 128; S.multA = 1; S.multB = 1; S.G = F.G; S.c = bc; S.wv = F.wave; S.A = (const char*)WSP(bf16, WS_TAB); S.Bt = (const char*)WSP(bf16, WS_UTT); S.ncol = 512;
          EpiS1 E{WSP(bf16, WS_A1)};
          gm::gemm_run<EpiS1, SchedFixA, false>(F.lds, S, E); }
        QG(1, 4, 6);
        if (SUB(4)) { SchedScores S; S.nt = 4; S.pitchA = RW; S.pitchB = RW; S.multA = 1; S.multB = 1; S.G = F.G; S.c = bc; S.wv = F.wave; S.Q = (const char*)WSP(bf16, WS_QS); S.Kk = (const char*)WSP(bf16, WS_KK);
          EpiScores E{WSP(bf16, WS_ACAT), F.dec_f, F.dec_b};
          gm::gemm_run<EpiScores, SchedScores, false>(F.lds, S, E); }
        QG(2, 4, 6);
        if (SUB(5)) { SchedKV S; S.nt = 4; S.pitchA = CAT; S.pitchB = T; S.multA = 1; S.multB = 1; S.G = F.G; S.c = bc; S.wv = F.wave; S.Bcat = (const char*)WSP(bf16, WS_BCAT); S.kTw = (const char*)WSP(bf16, WS_KTW);
          EpiKV E{WSP(bf16, WS_KVT)};
          gm::gemm_run<EpiKV, SchedKV, false>(F.lds, S, E); }
        QG(3, 4, 6);
    }
    SEAM(2);
    if (IN(3)) { FRAME_RELOAD();
        QG(0, 3, 2);
        { SchedFixA S; S.nt = 4; S.pitchA = 256; S.pitchB = 256; S.multA = 1; S.multB = 1; S.G = F.G; S.c = bc; S.wv = F.wave; S.A = (const char*)(WSP(bf16, WS_TAB) + 32768); S.Bt = (const char*)WSP(bf16, WS_A1); S.ncol = 512;
          EpiS2 E{WSP(bf16, WS_ZT)};
          gm::gemm_run<EpiS2, SchedFixA, false>(F.lds, S, E); }
        QG(1, 3, 2);
        p3_scan(F);
        QG(2, 3, 2);
    }
    SEAM(3);
    if (IN(4)) { FRAME_RELOAD();
        QG(0, 3, 4);
        { SchedFixB S; S.nt = 4; S.pitchA = 256; S.pitchB = 256; S.multA = 1; S.multB = 1; S.G = F.G; S.c = bc; S.wv = F.wave; S.A = (const char*)WSP(bf16, WS_ZT); S.Bt = (const char*)(WSP(bf16, WS_TAB) + 32768 + 65536); S.nrow = 512;
          EpiChan E{WSP(bf16, WS_Y)};
          gm::gemm_run<EpiChan, SchedFixB, false>(F.lds, S, E); }
        QG(1, 3, 4);
        { SchedOut S; S.nt = CAT / 64; S.pitchA = CAT; S.pitchB = CAT; S.multA = 1; S.multB = 1; S.G = F.G; S.c = bc; S.wv = F.wave; S.Acat = (const char*)WSP(bf16, WS_ACAT); S.Bcat = (const char*)WSP(bf16, WS_BCAT);
          EpiOut E{WSP(bf16, WS_Y), WSP(bf16, WS_GS), F.gn_g};
          gm::gemm_run<EpiOut, SchedOut, false>(F.lds, S, E); }
        QG(2, 3, 4);

    }
    SEAM(4);
    if (IN(5)) { FRAME_RELOAD();
        QG(0, 2, 3);
        Sched2D S; S.nt = D / 64; S.pitchA = D; S.pitchB = D; S.multA = 1; S.multB = 1; S.G = F.G; S.c = bc; S.wv = F.wave; S.A = (const char*)WSP(bf16, WS_Y); S.Bt = (const char*)WSP(bf16, WS_WOUT); S.nM = 64; S.nN = 8;
        EpiWout E{WSP(bf16, WS_Z1), F.x, WSP(float, WS_ST0), F.ln0_g, F.ln0_b};
        gm::gemm_run<EpiWout, Sched2D, false>(F.lds, S, E);
        QG(1, 2, 3);
        do_slabs(F, sdone < nS ? sdone : nS, nS);
    }
    SEAM(5);
    if (IN(6)) { FRAME_RELOAD(); p6_router(F); }
    SEAM(6);
    if (IN(7) || IN(8) || IN(9)) build_tstart(F, tstart);
    if (IN(7)) { FRAME_RELOAD();
        build_units(F, tstart, 16, bc);
        SchedMoEUpT S; S.nt = D / 128; S.pitchA = D / 2; S.pitchB = D / 2; S.multA = 1; S.multB = 1; S.G = F.G; S.c = bc; S.wv = F.wave; S.A = (const char*)WSP(char, WS_H1Q); S.Bt = (const char*)WSP(char, WS_WUP);
        S.tstart = tstart; S.row_tok = WSP(int, WS_RT) + 12 * T; S.cnt = F.ctl + CW_CNT; S.nN = 16; S.rowbytes = D; S.estride = (size_t)2 * DFF * D;
        S.rsc = WSP(float, WS_RSC); S.swup = WSP(float, WS_SWUP); S.b_up = F.b_up;
        EpiUp E{(unsigned char*)(F.ws + WS_ACTQ)};
        gm::gemm_run<EpiUp, SchedMoEUpT, true, true, true>(F.lds, S, E);
    }
    SEAM(7);
    if (IN(8)) { FRAME_RELOAD();
        build_units(F, tstart, 8, bc);
        SchedMoEDown S; S.nt = DFF / 128; S.pitchA = DFF / 2; S.pitchB = DFF / 2; S.multA = 1; S.multB = 1; S.G = F.G; S.c = bc; S.wv = F.wave; S.A = (const char*)WSP(char, WS_ACTQ); S.Bt = (const char*)WSP(char, WS_WDN);
        S.tstart = tstart; S.row_tok = nullptr; S.cnt = F.ctl + CW_CNT; S.nN = 8; S.rowbytes = DFF; S.estride = (size_t)D * DFF;
        S.sa = nullptr; S.swdn = WSP(float, WS_SWDN); S.b_dn = F.b_dn; S.rsc = nullptr; S.swup = nullptr; S.b_up = nullptr;
        EpiDown E{(unsigned char*)(F.ws + WS_YR)};
        gm::gemm_run<EpiDown, SchedMoEDown, false, 2, true>(F.lds, S, E);
    }
    SEAM(8);
    if (IN(9)) { FRAME_RELOAD(); p9_combine(F, tstart); }
#undef IN
#undef SEAM
}

#ifndef MK_SPLIT
#define MK_SPLIT 0
#endif
extern "C" void kernel_launch(void* const* d_in, const int* in_sizes, int n_in, void* d_out, int out_size, void* d_ws, size_t ws_size, hipStream_t stream) {
    static int grid = 0;
    if (grid == 0) {
        if (n_in != 18 || out_size != T * D || ws_size < WS_END2) { fprintf(stderr, "kernel_launch: unexpected problem: n_in %d out %d ws %zu (need %zu)\n", n_in, out_size, ws_size, (size_t)WS_END2); grid = -1; return; }
        int dev = 0, cus = 0, per_cu = 0;
        if (hipGetDevice(&dev) != hipSuccess || hipDeviceGetAttribute(&cus, hipDeviceAttributeMultiprocessorCount, dev) != hipSuccess) { grid = -1; return; }
        if (hipFuncSetAttribute((const void*)fwd, hipFuncAttributeMaxDynamicSharedMemorySize, LDS_BYTES) != hipSuccess) { fprintf(stderr, "kernel_launch: hipFuncSetAttribute failed\n"); grid = -1; return; }
        if (hipOccupancyMaxActiveBlocksPerMultiprocessor(&per_cu, (const void*)fwd, NTHR, LDS_BYTES) != hipSuccess || per_cu < 1) { fprintf(stderr, "kernel_launch: occupancy query reports %d\n", per_cu); }
        (void)hipGetLastError();
        grid = cus;
    }
    if (grid < 0) return;
    (void)hipMemsetAsync((char*)d_ws + WS_CTL, 0, CTL_BYTES, stream);
    Args a{};
    for (int i = 0; i < 18; ++i) a.in[i] = (const float*)d_in[i];
    a.out = (float*)d_out; a.ws = (unsigned char*)d_ws;
#if MK_SPLIT
    for (int p = 0; p < NPH; ++p) { a.ph_lo = p; a.ph_hi = p + 1; hipLaunchKernelGGL(fwd, dim3(grid), dim3(NTHR), LDS_BYTES, stream, a); }
#else
    a.ph_lo = 0; a.ph_hi = NPH; hipLaunchKernelGGL(fwd, dim3(grid), dim3(NTHR), LDS_BYTES, stream, a);
#endif
}
```

```cpp
#include <hip/hip_runtime.h>
#include <cstdio>
#include <cstdint>

#define GAS __attribute__((address_space(1)))
#define LAS __attribute__((address_space(3)))
typedef unsigned short bf16;
typedef unsigned v4u __attribute__((ext_vector_type(4)));
typedef unsigned v2u __attribute__((ext_vector_type(2)));
typedef float f32x4 __attribute__((ext_vector_type(4)));
typedef float f32x2 __attribute__((ext_vector_type(2)));
typedef short bf16x8 __attribute__((ext_vector_type(8)));
typedef int i32x4 __attribute__((ext_vector_type(4)));
typedef int i32x8 __attribute__((ext_vector_type(8)));
#define RLX_AGENT __ATOMIC_RELAXED, __HIP_MEMORY_SCOPE_AGENT
#define LDS_WAIT() asm volatile("s_waitcnt lgkmcnt(0)" ::: "memory")
#define VM_WAIT() asm volatile("s_waitcnt vmcnt(0)" ::: "memory")

constexpr int T = 16384, D = 2048, DIN = 5120, FW = 1024, RW = 1024, NH = 4, HD = 256, NE = 32, TOPK = 4, DFF = 2048;
constexpr int C2 = 256, NCH = T / C2;
constexpr int CAT = 768;
constexpr float LN_EPS = 1e-5f, GN_EPS = 1e-6f, ALPHA = 1.189207115002721f;
constexpr int RT_MAX = (T * TOPK) / 256 + NE;
constexpr int NWAVES = 8, NTHR = 512;

constexpr size_t MiB = 1u << 20;
constexpr size_t WS_CTL = 0, CTL_BYTES = 1 * MiB;
constexpr size_t WS_TAB = 1 * MiB;
constexpr size_t WS_WIN = 2 * MiB;
constexpr size_t WS_WOUT = WS_WIN + 20 * MiB;
constexpr size_t WS_WUP = WS_WOUT + 8 * MiB;
constexpr size_t WS_WDN = WS_WUP + 512 * MiB;
constexpr size_t WS_H0B = WS_WDN + 256 * MiB;
constexpr size_t WS_ST0 = WS_H0B + 64 * MiB;
constexpr size_t WS_UTT = WS_ST0 + 1 * MiB;
constexpr size_t WS_A1 = WS_UTT + 32 * MiB;
constexpr size_t WS_ZT = WS_A1 + 64 * MiB;
constexpr size_t WS_QS = WS_ZT + 64 * MiB;
constexpr size_t WS_KK = WS_QS + 32 * MiB;
constexpr size_t WS_GS = WS_KK + 32 * MiB;
constexpr size_t WS_ACAT = WS_GS + 32 * MiB;
constexpr size_t WS_BCAT = WS_ACAT + 96 * MiB;
constexpr size_t WS_KTW = WS_BCAT + 96 * MiB;
constexpr size_t WS_KVT = WS_KTW + 64 * MiB;
constexpr size_t WS_Y = WS_KVT + 128 * MiB;
constexpr size_t WS_Z1 = WS_Y + 64 * MiB;
constexpr size_t WS_H1B = WS_Z1 + 128 * MiB;
constexpr size_t WS_RT = WS_H1B + 64 * MiB;
constexpr size_t WS_ACT = WS_RT + 4 * MiB;
constexpr size_t WS_YR = WS_ACT + 288 * MiB;
constexpr size_t WS_END = WS_YR + 288 * MiB;
constexpr size_t WS_SWUP = WS_TAB + 512 * 1024;
constexpr size_t WS_H1Q = WS_H1B;
constexpr size_t WS_SX = WS_H1B + 32 * MiB, WS_RSC = WS_H1B + 40 * MiB, WS_SA = WS_H1B + 44 * MiB;
constexpr size_t WS_SWDN = WS_ST0 + 512 * 1024;
constexpr size_t WS_SWIN = WS_ST0 + 768 * 1024;
constexpr size_t WS_SX0 = WS_H0B + 40 * MiB;
constexpr size_t WS_ACTQ = WS_END;
constexpr size_t WS_END2 = WS_ACTQ + 144 * MiB;
constexpr int CW_RMAX = 16384;
constexpr int CW_BAR = 1024;
constexpr int CW_CNT = 8192;

constexpr int LDS_STAGE = 131072, LDS_SCR = 16384, LDS_CTL_OFF = LDS_STAGE + LDS_SCR, LDS_BYTES = LDS_CTL_OFF + 2048;

__device__ __forceinline__ unsigned cvt_pk_bf16(float lo, float hi) { unsigned r; asm volatile("v_cvt_pk_bf16_f32 %0, %1, %2" : "=v"(r) : "v"(lo), "v"(hi)); return r; }
__device__ __forceinline__ float bf_lo(unsigned u) { return __builtin_bit_cast(float, u << 16); }
__device__ __forceinline__ float bf_hi(unsigned u) { return __builtin_bit_cast(float, u & 0xffff0000u); }
__device__ __forceinline__ v4u pack8(const f32x4 a, const f32x4 b) { v4u w; w.x = cvt_pk_bf16(a[0], a[1]); w.y = cvt_pk_bf16(a[2], a[3]); w.z = cvt_pk_bf16(b[0], b[1]); w.w = cvt_pk_bf16(b[2], b[3]); return w; }
__device__ __forceinline__ float wave_sum(float v) {
#pragma unroll
    for (int o = 1; o < 64; o <<= 1) v += __shfl_xor(v, o);
    return v;
}
__device__ __forceinline__ int lane_id() { int l; asm volatile("v_mbcnt_lo_u32_b32 %0, -1, 0\n\tv_mbcnt_hi_u32_b32 %0, -1, %0" : "=v"(l)); return l; }
__device__ __forceinline__ float fexp(float x) { return __builtin_amdgcn_exp2f(x * 1.4426950408889634f); }
__device__ __forceinline__ void cs_rev(float rev, float& c, float& s) { const float f = __builtin_amdgcn_fractf(rev); c = __builtin_amdgcn_cosf(f); s = __builtin_amdgcn_sinf(f); }

#define XB_TMO      128
#define XB_XCNT(j)  (256  + 64 * (j))
#define XB_XSUB(j)  (1280 + 64 * (j))
#define XB_XGEN(j)  (2304 + 64 * (j))
#define XB_TOP      3328
#define XB_TOPGEN   3392
#define XCD_BAR_WORDS 3456
#define XB_SPIN_CAP (1u << 18)
__device__ __forceinline__ unsigned xb_ld(unsigned* p)              { return __hip_atomic_load(p, __ATOMIC_RELAXED, __HIP_MEMORY_SCOPE_AGENT); }
__device__ __forceinline__ unsigned xb_add(unsigned* p, unsigned v) { return __hip_atomic_fetch_add(p, v, __ATOMIC_RELAXED, __HIP_MEMORY_SCOPE_AGENT); }
__device__ __forceinline__ unsigned xb_xcc_id() { return (unsigned)__builtin_amdgcn_s_getreg((3 << 11) | 20) & 0xFu; }
#define XB_SPIN(cond, bar) do { unsigned _sp = 0; while (cond) { __builtin_amdgcn_s_sleep(1); \
    if ((++_sp & 255u) == 0u) { if (xb_ld(&(bar)[XB_TMO])) break; if (_sp > XB_SPIN_CAP) { atomicAdd(&(bar)[XB_TMO], 1u); break; } } } } while (0)
struct XcdBarrier { unsigned* bar; unsigned x; volatile LAS unsigned* st; int wave; };
__device__ __forceinline__ XcdBarrier xcd_barrier_post(unsigned* bar, volatile LAS unsigned* st) {
    XcdBarrier b; b.bar = bar; b.x = xb_xcc_id(); b.st = st;
    if (threadIdx.x == 0) (void)xb_add(&bar[XB_XCNT(b.x)], 1u);
    return b;
}
__device__ __forceinline__ void xcd_barrier_complete(unsigned* bar, unsigned x, unsigned& nloc, unsigned& nx) {
    const unsigned G = gridDim.x * gridDim.y * gridDim.z;
    unsigned sum, cnt, mine, sp = 0u;
    for (;;) {
        sum = 0u; cnt = 0u; mine = 0u;
#pragma unroll
        for (unsigned j = 0; j < 16; ++j) { const unsigned c = xb_ld(&bar[XB_XCNT(j)]); sum += c; cnt += (c > 0u) ? 1u : 0u; mine = (j == x) ? c : mine; }
        if (sum == G) break;
        __builtin_amdgcn_s_sleep(1);
        if ((++sp & 255u) == 0u) { if (xb_ld(&bar[XB_TMO])) break; if (sp > XB_SPIN_CAP) { atomicAdd(&bar[XB_TMO], 1u); break; } }
    }
    nloc = mine > 0u ? mine : 1u; nx = cnt > 0u ? cnt : 1u;
}
__device__ __forceinline__ void xcd_barrier(const XcdBarrier& b) {
    asm volatile("s_waitcnt vmcnt(0)" ::: "memory");
    __syncthreads();
    if (b.wave == 0 && lane_id() == 0) {
        unsigned* bar = b.bar;
        __builtin_amdgcn_s_waitcnt(0);
        unsigned nloc = b.st[0], nx = b.st[1];
        if (nloc == 0u) { xcd_barrier_complete(bar, b.x, nloc, nx); b.st[0] = nloc; b.st[1] = nx; }
        const unsigned old = xb_add(&bar[XB_XSUB(b.x)], 1u);
        const unsigned gen = old / nloc;
        if (old + 1u == (gen + 1u) * nloc) {
            __builtin_amdgcn_fence(__ATOMIC_RELEASE, "agent");
            asm volatile("s_waitcnt vmcnt(0)" ::: "memory");
            const unsigned og = xb_add(&bar[XB_TOP], 1u);
            const unsigned tg = og / nx;
            if (og + 1u == (tg + 1u) * nx) xb_add(&bar[XB_TOPGEN], 1u);
            else XB_SPIN(xb_ld(&bar[XB_TOPGEN]) == tg, bar);
            __builtin_amdgcn_fence(__ATOMIC_ACQUIRE, "agent");
            xb_add(&bar[XB_XGEN(b.x)], 1u);
            asm volatile("s_waitcnt vmcnt(0)" ::: "memory");
        } else {
            XB_SPIN(xb_ld(&bar[XB_XGEN(b.x)]) == gen, bar);
            __builtin_amdgcn_fence(__ATOMIC_ACQUIRE, "agent");
            asm volatile("s_waitcnt vmcnt(0)" ::: "memory");
        }
    }
    __syncthreads();
}

namespace gm {
constexpr int BM = 256, BK = 64, HALF = 128, HTB = HALF * BK * 2, STAGE_BYTES = 8 * HTB;
__device__ __forceinline__ int lds_byte(int r, int c) { const int st = (r >> 4) * 2 + (c >> 5), rr = r & 15, cc = c & 31, ob = rr * 64 + cc * 2; return st * 1024 + (ob ^ (((ob >> 9) & 1) << 5)); }
__device__ __forceinline__ void stage_rc(int b, int& R, int& C) { const int st = b / 1024, sb = b % 1024, swz = sb ^ (((sb >> 9) & 1) << 5); R = (st >> 1) * 16 + swz / 64; C = (st & 1) * 32 + (swz % 64) / 2; }
__device__ __forceinline__ int perm32(int rho) { const int n = rho >> 4, i = rho & 15; return 8 * (i >> 2) + 4 * n + (i & 3); }

struct Unit { const char* a0; const char* a1; const char* b0; const char* b1; int p0, p1, p2, p3, q; };

__device__ __forceinline__ void tile_order(int L, int nM, int nN, int& pm, int& pn) {
    const int nwg = nM * nN; int wgid = L;
    { const int q = nwg / 8, r = nwg % 8, xcd = wgid % 8, off = wgid / 8; wgid = (xcd < r ? xcd * (q + 1) : r * (q + 1) + (xcd - r) * q) + off; }
    const int nig = 8 * nN, gid = wgid / nig, fm = gid * 8, gsz = (nM - fm) < 8 ? (nM - fm) : 8;
    pm = fm + ((wgid % nig) % gsz); pn = (wgid % nig) / gsz;
}

template <int I8> struct AccSel { typedef f32x4 type; };
template <> struct AccSel<1> { typedef i32x4 type; };
template <class Epi, class Sched, bool GATHER, int I8 = 0, bool PREF = false>
__device__ __forceinline__ void gemm_run(LAS unsigned char* lds, const Sched& S, const Epi& E) {
    const int wid = S.wv, lane = lane_id(), tid = wid * 64 + lane, wr = wid >> 2, wc = wid & 3, fr = lane & 15, fq = lane >> 4;
    int nt = S.nt; asm volatile("" : "+s"(nt));
    unsigned voffA[2], voffB[2], colA[2]; int rowA[2];
#pragma unroll
    for (int i = 0; i < 2; ++i) { int R, C; stage_rc(tid * 16 + i * 8192, R, C); const int Rb = Epi::PERM ? ((R & ~31) + perm32(R & 31)) : R;
        voffA[i] = (unsigned)(R * S.multA * S.pitchA + C) * 2u; voffB[i] = (unsigned)(Rb * S.multB * S.pitchB + C) * 2u; colA[i] = (unsigned)C * 2u; rowA[i] = R; }
    const size_t kstep = (size_t)(BK * 2);
    const unsigned ldsw = (unsigned)wid * 1024u;
    const int aoff = lds_byte(wr * 64 + fr, fq * 8), boff = lds_byte(wc * 32 + fr, fq * 8);
#define G_SA(b, h) (((b) * 2 + (h)) * HTB)
#define G_SB(b, h) ((4 + (b) * 2 + (h)) * HTB)
#define G_STAGE(bufoff, gbase, voff) do { _Pragma("unroll") for (int _i = 0; _i < 2; ++_i) \
        __builtin_amdgcn_global_load_lds((const unsigned*)((const char*)(gbase) + (voff)[_i]), (LAS unsigned*)(lds + (bufoff) + ldsw + _i * 8192), 16, 0, 0); } while (0)
#define G_LD8(dst, addr) do { const i32x4 lo_ = *(const LAS i32x4*)(addr), hi_ = *(const LAS i32x4*)((addr) + 1024); dst = __builtin_shufflevector(lo_, hi_, 0, 1, 2, 3, 4, 5, 6, 7); } while (0)
#define G_LDA(dst, b, h) do { _Pragma("unroll") for (int m = 0; m < 4; ++m) G_LD8(dst[m], lds + G_SA(b, h) + aoff + m * 2048); } while (0)
#define G_LDB(dst, b, h) do { _Pragma("unroll") for (int n = 0; n < 2; ++n) G_LD8(dst[n], lds + G_SB(b, h) + boff + n * 2048); } while (0)
#define G_H4(x, k) ((k) ? __builtin_shufflevector(x, x, 4, 5, 6, 7) : __builtin_shufflevector(x, x, 0, 1, 2, 3))
#define G_MMA(ai, bj, At, Bt) do { __builtin_amdgcn_s_setprio(1); _Pragma("unroll") for (int m = 0; m < 4; ++m) _Pragma("unroll") for (int n = 0; n < 2; ++n) { \
        if constexpr (I8 == 2) acc[ai][bj][m][n] = __builtin_amdgcn_mfma_scale_f32_16x16x128_f8f6f4(Bt[n], At[m], acc[ai][bj][m][n], 0, 0, 0, 0x7F7F7F7F, 0, 0x7F7F7F7F); \
        else { _Pragma("unroll") for (int k = 0; k < 2; ++k) { \
            if constexpr (I8 == 1) acc[ai][bj][m][n] = __builtin_amdgcn_mfma_i32_16x16x64_i8(G_H4(Bt[n], k), G_H4(At[m], k), acc[ai][bj][m][n], 0, 0, 0); \
            else acc[ai][bj][m][n] = __builtin_amdgcn_mfma_f32_16x16x32_bf16(__builtin_bit_cast(bf16x8, G_H4(Bt[n], k)), __builtin_bit_cast(bf16x8, G_H4(At[m], k)), acc[ai][bj][m][n], 0, 0, 0); } } } \
        __builtin_amdgcn_s_setprio(0); } while (0)
#define G_WAIT_V(n) asm volatile("s_waitcnt vmcnt(" #n ")" ::: "memory")
#define G_WAIT_L(n) asm volatile("s_waitcnt lgkmcnt(" #n ")" ::: "memory")
#define G_BAR __builtin_amdgcn_s_barrier()
#define G_SCHED __builtin_amdgcn_sched_barrier(0)
    Unit cur, nxt; int ui = 0;
    if (!S.next(0, cur)) return;
    cur.q = 0;
    if constexpr (PREF) { S.prefetch(cur, lds); G_WAIT_V(0); G_BAR; }
    typedef typename AccSel<I8>::type acc_t;
    acc_t acc[2][2][4][2];
#pragma unroll
    for (int a = 0; a < 2; ++a)
#pragma unroll
        for (int b = 0; b < 2; ++b)
#pragma unroll
            for (int m = 0; m < 4; ++m)
#pragma unroll
                for (int n = 0; n < 2; ++n) acc[a][b][m][n] = (acc_t){0, 0, 0, 0};
    i32x8 At[4], B0[2], B1[2];
    unsigned gc0[2], gc1[2];
    if constexpr (GATHER) {
#pragma unroll
        for (int i = 0; i < 2; ++i) { gc0[i] = S.row_off(cur, rowA[i], lds) + colA[i]; gc1[i] = S.row_off(cur, 128 + rowA[i], lds) + colA[i]; }
    }
#define vA0 (GATHER ? gc0 : voffA)
#define vA1 (GATHER ? gc1 : voffA)
    G_STAGE(G_SB(0, 0), cur.b0, voffB); G_STAGE(G_SB(0, 1), cur.b1, voffB); G_STAGE(G_SA(0, 0), cur.a0, vA0); G_STAGE(G_SA(0, 1), cur.a1, vA1);
    if (wr == 1) G_BAR;
    G_WAIT_V(2); G_BAR;
    G_STAGE(G_SB(1, 0), cur.b0 + kstep, voffB); G_STAGE(G_SA(1, 0), cur.a0 + kstep, vA0); G_STAGE(G_SB(1, 1), cur.b1 + kstep, voffB);
    G_WAIT_V(6); G_BAR;
    for (;;) {
        const bool has_next = S.next(ui + 1, nxt);
        if (!has_next) nxt = cur;
        nxt.q = (ui + 1) & 1;
        for (int t = 0; t < nt; t += 2) {
            const bool last = (t == nt - 2);
            { const int tz_ = wid * 64 + lane_id();
#pragma unroll
              for (int i = 0; i < 2; ++i) { int R, C; stage_rc(tz_ * 16 + i * 8192, R, C); const int Rb = Epi::PERM ? ((R & ~31) + perm32(R & 31)) : R;
                  voffA[i] = (unsigned)(R * S.multA * S.pitchA + C) * 2u; voffB[i] = (unsigned)(Rb * S.multB * S.pitchB + C) * 2u; } }
            if constexpr (GATHER) asm volatile("" : "+v"(gc0[0]), "+v"(gc0[1]), "+v"(gc1[0]), "+v"(gc1[1]));
            if constexpr (PREF) { if (t == nt - 4) S.prefetch(nxt, lds); }
            const char* a11 = cur.a1 + (size_t)(t + 1) * kstep;
            const char* a02 = last ? nxt.a0 : cur.a0 + (size_t)(t + 2) * kstep; const char* a12 = last ? nxt.a1 : cur.a1 + (size_t)(t + 2) * kstep;
            const char* b02 = last ? nxt.b0 : cur.b0 + (size_t)(t + 2) * kstep; const char* b12 = last ? nxt.b1 : cur.b1 + (size_t)(t + 2) * kstep;
            G_LDB(B0, 0, 0); G_LDB(B1, 0, 1); G_SCHED; G_LDA(At, 0, 0); G_STAGE(G_SA(1, 1), a11, vA1);
            if constexpr (GATHER) { if (last) { int tz = tid; asm volatile("" : "+v"(tz));
#pragma unroll
                for (int i = 0; i < 2; ++i) { int R, C; stage_rc(tz * 16 + i * 8192, R, C); gc0[i] = S.row_off(nxt, R, lds) + (unsigned)C * 2u; gc1[i] = S.row_off(nxt, 128 + R, lds) + (unsigned)C * 2u; } } }
            G_WAIT_V(8); G_WAIT_L(0); G_BAR; G_MMA(0, 0, At, B0); G_MMA(0, 1, At, B1); G_BAR; G_SCHED;
            G_LDA(At, 0, 1); G_STAGE(G_SB(0, 0), b02, voffB); G_STAGE(G_SB(0, 1), b12, voffB); G_STAGE(G_SA(0, 0), a02, vA0);
            G_WAIT_V(8); G_WAIT_L(0); G_BAR; G_MMA(1, 0, At, B0); G_MMA(1, 1, At, B1); G_BAR; G_SCHED;
            G_LDB(B0, 1, 0); G_LDB(B1, 1, 1); G_SCHED; G_LDA(At, 1, 0); G_STAGE(G_SA(0, 1), a12, vA1);
            G_WAIT_V(8); G_WAIT_L(0); G_BAR; G_MMA(0, 0, At, B0); G_MMA(0, 1, At, B1); G_BAR; G_SCHED;
            G_LDA(At, 1, 1); G_STAGE(G_SB(1, 0), b02 + kstep, voffB); G_STAGE(G_SB(1, 1), b12 + kstep, voffB); G_STAGE(G_SA(1, 0), a02 + kstep, vA0);
            G_WAIT_V(8); G_WAIT_L(0); G_BAR; G_MMA(1, 0, At, B0); G_MMA(1, 1, At, B1); G_BAR; G_SCHED;
        }
        if (wr == 0) G_BAR;
        { int fr2 = fr, fq2 = fq; asm volatile("" : "+v"(fr2), "+v"(fq2));
          E(acc, cur, lds, wr, wc, fr2, fq2); }
        if (!has_next) break;
#pragma unroll
        for (int a = 0; a < 2; ++a)
#pragma unroll
            for (int b = 0; b < 2; ++b)
#pragma unroll
                for (int m = 0; m < 4; ++m)
#pragma unroll
                    for (int n = 0; n < 2; ++n) acc[a][b][m][n] = (acc_t){0, 0, 0, 0};
        cur = nxt; ++ui;
        if (wr == 1) G_BAR;
    }
    G_WAIT_V(0);
    G_BAR;
#undef G_SA
#undef G_SB
#undef G_STAGE
#undef G_LDA
#undef G_LD8
#undef G_H4
#undef G_LDB
#undef G_MMA
#undef G_WAIT_V
#undef G_WAIT_L
#undef G_BAR
#undef G_SCHED
#undef vA0
#undef vA1
}
}
using gm::Unit;
typedef f32x4 Acc[2][2][4][2];
typedef i32x4 AccI[2][2][4][2];

struct Args { const float* in[18]; float* out; unsigned char* ws; int ph_lo, ph_hi; };
struct Frame {
    LAS unsigned char* lds; unsigned char* ws; unsigned* ctl;
    int wave, vcu, G;
    const float *x, *ln0_g, *ln0_b, *w_in, *dec_f, *dec_b, *gn_g, *w_out, *ln1_g, *ln1_b, *w_r, *b_r, *w_up, *b_up, *w_dn, *b_dn, *ln2_g, *ln2_b;
    float* out;
};
#define WSP(T_, off) ((T_*)(F.ws + (off)))
#define FLANE lane_id()
#define FTID (F.wave * 64 + lane_id())

template <class ColMap>
__device__ __forceinline__ void transpose_item(const float* W, int K, int N, bf16* WT, LAS float* scr, int item, int lane, const ColMap& cm) {
    const int nblk = N / 64, kb = item / nblk, nb = item % nblk, k0 = 64 * kb, n0 = 64 * nb;
    const int s0 = cm(n0);
#pragma unroll 4
    for (int i = 0; i < 16; ++i) { const int kk = 4 * i + (lane >> 4), c4 = (lane & 15) * 4;
        const f32x4 v = *(const GAS f32x4*)(W + (size_t)(k0 + kk) * N + s0 + c4);
        LAS float* d = scr + kk * 65 + c4; d[0] = v[0]; d[1] = v[1]; d[2] = v[2]; d[3] = v[3]; }
    LDS_WAIT(); asm volatile("" ::: "memory");
    const int c = lane & 7;
#pragma unroll
    for (int j = 0; j < 8; ++j) { const int n = (lane >> 3) + 8 * j; const LAS float* s = scr + (8 * c) * 65 + n;
        v4u o; o.x = cvt_pk_bf16(s[0 * 65], s[1 * 65]); o.y = cvt_pk_bf16(s[2 * 65], s[3 * 65]); o.z = cvt_pk_bf16(s[4 * 65], s[5 * 65]); o.w = cvt_pk_bf16(s[6 * 65], s[7 * 65]);
        *(GAS v4u*)(WT + (size_t)(n0 + n) * K + k0 + 8 * c) = o; }
    LDS_WAIT(); asm volatile("" ::: "memory");
}
struct ColId { __device__ __forceinline__ int operator()(int n) const { return n; } };
struct ColUp { __device__ __forceinline__ int operator()(int n) const { return ((n >> 8) * 128 + (n & 127)) + ((n >> 7) & 1) * 2048; } };

__device__ __forceinline__ void p0_prologue(Frame& F) {
    const int gw = F.vcu * NWAVES + F.wave, NGW = F.G * NWAVES;
    {
        unsigned* h0q = WSP(unsigned, WS_H0B); float* st0 = WSP(float, WS_ST0); float* sx0 = WSP(float, WS_SX0);
        for (int m = gw; m < T; m += NGW) {
            const GAS f32x4* xr = (const GAS f32x4*)(F.x + (size_t)m * D) + FLANE;
            f32x4 v[8]; float s = 0.f;
#pragma unroll
            for (int j = 0; j < 8; ++j) { v[j] = xr[64 * j]; s += (v[j][0] + v[j][1]) + (v[j][2] + v[j][3]); }
            const float mean = wave_sum(s) * (1.f / D); float s2 = 0.f;
#pragma unroll
            for (int j = 0; j < 8; ++j) { v[j] = v[j] - mean; s2 += (v[j][0] * v[j][0] + v[j][1] * v[j][1]) + (v[j][2] * v[j][2] + v[j][3] * v[j][3]); }
            const float rstd = 1.f / sqrtf(wave_sum(s2) * (1.f / D) + LN_EPS); float am = 0.f;
#pragma unroll
            for (int j = 0; j < 8; ++j) { const f32x4 g = *((const GAS f32x4*)F.ln0_g + FLANE + 64 * j), b = *((const GAS f32x4*)F.ln0_b + FLANE + 64 * j);
                v[j] = v[j] * rstd * g + b; am = fmaxf(am, fmaxf(fmaxf(fabsf(v[j][0]), fabsf(v[j][1])), fmaxf(fabsf(v[j][2]), fabsf(v[j][3])))); }
#pragma unroll
            for (int o = 1; o < 64; o <<= 1) am = fmaxf(am, __shfl_xor(am, o));
            const float sc = am > 0.f ? am * (1.f / 127.f) : 1.f, inv = 1.f / sc;
#pragma unroll
            for (int j = 0; j < 8; ++j) { const int q0 = (int)__builtin_rintf(v[j][0] * inv), q1 = (int)__builtin_rintf(v[j][1] * inv), q2 = (int)__builtin_rintf(v[j][2] * inv), q3 = (int)__builtin_rintf(v[j][3] * inv);
                h0q[(size_t)m * (D / 4) + FLANE + 64 * j] = (unsigned)(q0 & 0xff) | ((unsigned)(q1 & 0xff) << 8) | ((unsigned)(q2 & 0xff) << 16) | ((unsigned)(q3 & 0xff) << 24); }
            if (FLANE == 0) { st0[2 * m] = mean; st0[2 * m + 1] = rstd; sx0[m] = sc; }
        }
    }
    {
        bf16* tab = WSP(bf16, WS_TAB);
        for (int i = (F.vcu * NTHR + FTID); i < 32768 + 65536 + 65536; i += F.G * NTHR) {
            float v;
            if (i < 32768) { const int r = i >> 7, a = i & 127, ri = r >> 7, k1 = r & 127; float c, s; cs_rev((float)((k1 * a) & 127) * (1.f / 128.f), c, s); v = ri ? -s : c; }
            else if (i < 32768 + 65536) { const int e = i - 32768, r = e >> 8, q = e & 255, ri = r >> 7, k2 = r & 127, rj = q >> 7, b = q & 127; float c, s; cs_rev((float)((k2 * b) & 127) * (1.f / 128.f), c, s);
                v = (ri == 0) ? (rj == 0 ? c : s) : (rj == 0 ? -s : c); }
            else { const int e = i - 32768 - 65536, l = e >> 8, q = e & 255, rj = q >> 7, cg = q & 127; float c, s; cs_rev((float)((l * cg) & 127) * (1.f / 128.f), c, s); v = (l < 128) ? (rj == 0 ? c : s) : 0.f; }
            tab[i] = (bf16)(cvt_pk_bf16(v, 0.f) & 0xffffu);
        }
    }
    {
        LAS float* scr = (LAS float*)(F.lds + F.wave * 18432);
        constexpr int I_IN = 32 * (DIN / 64), I_OUT = 32 * (D / 64), I_UP = 32 * (2 * DFF / 64), I_DN = 32 * (D / 64);
        constexpr int NIT = I_OUT;
        for (int it = gw; it < NIT; it += NGW) {
            int r = it;
            { transpose_item(F.w_out, D, D, WSP(bf16, WS_WOUT), scr, r, FLANE, ColId()); }
        }
    }
}

struct SlabDesc { const float* W; signed char* WQ; float* sw; int NS, e, n0, valid, fp8; };
struct QF { unsigned char* ws; const float* w_up; const float* w_dn; const float* w_in; int vcu, G; };
__device__ __forceinline__ SlabDesc slab_desc(const QF& F, int j) {
    const int nD = (NE * 64 + F.G - 1) / F.G; SlabDesc d;
    if (j < 0) { const int sl = F.vcu + (-1 - j) * F.G; d.valid = sl < DIN / 32; d.NS = DIN; d.e = 0; d.n0 = sl * 32; d.W = F.w_in + d.n0; d.WQ = (signed char*)WSP(char, WS_WIN); d.sw = WSP(float, WS_SWIN); d.fp8 = 0; }
    else if (j >= nD) { const int sl = F.vcu + (j - nD) * F.G; d.valid = sl < NE * 128; d.NS = 2 * DFF; d.e = sl >> 7; d.n0 = (sl & 127) * 32; d.W = F.w_up + (size_t)d.e * D * 2 * DFF + ColUp()(d.n0); d.WQ = (signed char*)WSP(char, WS_WUP); d.sw = WSP(float, WS_SWUP); d.fp8 = 0; }
    else { const int sl = F.vcu + j * F.G; d.valid = sl < NE * 64; d.NS = D; d.e = sl >> 6; d.n0 = (sl & 63) * 32; d.W = F.w_dn + (size_t)d.e * DFF * D + d.n0; d.WQ = (signed char*)WSP(char, WS_WDN); d.sw = WSP(float, WS_SWDN); d.fp8 = 1; }
    return d;
}
#define SLAB_LOAD(dsc, v) do { if ((dsc).valid) { const GAS char* b_ = (const GAS char*)(dsc).W; unsigned o_ = (unsigned)((wave * 256 + kq) * (dsc).NS + c4) * 4u; const unsigned st_ = (unsigned)(dsc).NS * 32u; \
    _Pragma("unroll") for (int i_ = 0; i_ < 32; ++i_) { v[i_] = __builtin_nontemporal_load((const GAS f32x4*)(b_ + o_)); o_ += st_; } } } while (0)
__device__ __forceinline__ void do_slabs_impl(LAS unsigned char* lds, unsigned char* ws, const float* w_up, const float* w_dn, const float* w_in, int vcu, int G, int wave, int j0, int j1) {
    if (j0 >= j1) return;
    QF F; F.ws = ws; F.w_up = w_up; F.w_dn = w_dn; F.w_in = w_in; F.vcu = vcu; F.G = G;
    const int lane = lane_id(), tid = wave * 64 + lane;
    constexpr int PITCH = 2056;
    LAS bf16* slab = (LAS bf16*)lds;
    LAS float* red = (LAS float*)(lds + 32 * PITCH * 2);
    const int kq = lane >> 3, c4 = (lane & 7) * 4;
    f32x4 v[32];
    SlabDesc cur = slab_desc(F, j0);
    SLAB_LOAD(cur, v);
    for (int j = j0; j < j1; ++j) {
        if (cur.valid) {
            f32x4 mx = (f32x4){0.f, 0.f, 0.f, 0.f};
#pragma unroll
            for (int i = 0; i < 32; ++i) { const int k = wave * 256 + i * 8 + kq; const f32x4 x = v[i];
                mx[0] = fmaxf(mx[0], fabsf(x[0])); mx[1] = fmaxf(mx[1], fabsf(x[1])); mx[2] = fmaxf(mx[2], fabsf(x[2])); mx[3] = fmaxf(mx[3], fabsf(x[3]));
                const unsigned p01 = cvt_pk_bf16(x[0], x[1]), p23 = cvt_pk_bf16(x[2], x[3]);
                const int ks = k ^ (((c4 >> 3) & 3) << 3);
                slab[(c4 + 0) * PITCH + ks] = (bf16)(p01 & 0xffffu); slab[(c4 + 1) * PITCH + ks] = (bf16)(p01 >> 16); slab[(c4 + 2) * PITCH + ks] = (bf16)(p23 & 0xffffu); slab[(c4 + 3) * PITCH + ks] = (bf16)(p23 >> 16); }
#pragma unroll
            for (int q = 0; q < 4; ++q) { float m = mx[q]; m = fmaxf(m, __shfl_xor(m, 8)); m = fmaxf(m, __shfl_xor(m, 16)); m = fmaxf(m, __shfl_xor(m, 32)); mx[q] = m; }
            if (lane < 8) { LAS float* d = red + wave * 32 + c4; d[0] = mx[0]; d[1] = mx[1]; d[2] = mx[2]; d[3] = mx[3]; }
        }
        const SlabDesc done = cur;
        if (j + 1 < j1) { cur = slab_desc(F, j + 1); SLAB_LOAD(cur, v); }
        __syncthreads();
        if (done.valid && tid < 32) { float m = 0.f;
#pragma unroll
            for (int w = 0; w < 8; ++w) m = fmaxf(m, red[w * 32 + tid]);
            const float sc = m > 0.f ? m * (done.fp8 ? (1.f / 448.f) : (1.f / 127.f)) : 1.f; done.sw[(size_t)done.e * done.NS + done.n0 + tid] = sc; red[256 + tid] = 1.f / sc; }
        __syncthreads();
        if (done.valid) {
#pragma unroll 2
            for (int i = 0; i < 8; ++i) { const int q = tid + NTHR * i, n = q >> 7, kc = q & 127; const float inv = red[256 + n];
                const int sx_ = ((n >> 3) & 3) << 3;
                const v4u a = *(const LAS v4u*)(slab + n * PITCH + ((kc * 16) ^ sx_)), b = *(const LAS v4u*)(slab + n * PITCH + ((kc * 16 + 8) ^ sx_));
                const unsigned src[8] = {a.x, a.y, a.z, a.w, b.x, b.y, b.z, b.w}; unsigned o[4];
                if (done.fp8) {
#pragma unroll
                    for (int d = 0; d < 4; ++d) { int w = __builtin_amdgcn_cvt_pk_fp8_f32(bf_lo(src[2 * d]) * inv, bf_hi(src[2 * d]) * inv, 0, false);
                        w = __builtin_amdgcn_cvt_pk_fp8_f32(bf_lo(src[2 * d + 1]) * inv, bf_hi(src[2 * d + 1]) * inv, w, true); o[d] = (unsigned)w; }
                } else {
#pragma unroll
                for (int d = 0; d < 4; ++d) { unsigned w = 0u;
#pragma unroll
                    for (int h2 = 0; h2 < 2; ++h2) { const unsigned u2 = src[2 * d + h2]; const int q0 = (int)__builtin_rintf(bf_lo(u2) * inv), q1 = (int)__builtin_rintf(bf_hi(u2) * inv);
                        w |= ((unsigned)(q0 & 0xff) << (16 * h2)) | ((unsigned)(q1 & 0xff) << (16 * h2 + 8)); }
                    o[d] = w; }
                }
                *(GAS v4u*)(done.WQ + ((size_t)done.e * done.NS + done.n0 + n) * D + kc * 16) = (v4u){o[0], o[1], o[2], o[3]}; }
        }
        __syncthreads();
    }
}

__device__ __forceinline__ void do_slabs(Frame& F, int j0, int j1) { do_slabs_impl(F.lds, F.ws, F.w_up, F.w_dn, F.w_in, F.vcu, F.G, F.wave, j0, j1); }

struct SchedBase { int nt, pitchA, pitchB, multA, multB, G, c, wv; };
struct SchedG1N : SchedBase {
    const char* A; const char* Bt;
    __device__ __forceinline__ bool next(int i, Unit& u) const { const int L = i * G + c; if (L >= 64 * 12) return false; int pm, pn; gm::tile_order(L, 64, 12, pm, pn);
        const int cb = pn < 4 ? 1024 + 256 * pn : (pn < 8 ? 2048 + 256 * (pn - 4) : 4096 + 256 * (pn - 8));
        u.a0 = A + (size_t)pm * 256 * D; u.a1 = u.a0 + (size_t)128 * D; u.b0 = Bt + (size_t)cb * D; u.b1 = u.b0 + (size_t)128 * D; u.p0 = pm; u.p1 = pn; u.p2 = cb; u.p3 = 0; return true; }
};
struct SchedG1SF : SchedBase {
    const char* A; const char* Bt;
    __device__ __forceinline__ bool next(int i, Unit& u) const { const int L = i * G + c; if (L >= 4 * 64) return false; int pm, pn; gm::tile_order(L, 4, 64, pm, pn);
        u.a0 = A + (size_t)pm * 256 * D; u.a1 = u.a0 + (size_t)128 * D; u.b0 = Bt + (size_t)(2 * pn) * D; u.b1 = u.b0 + (size_t)D; u.p0 = pm; u.p1 = pn; u.p2 = 0; u.p3 = 0; return true; }
};
struct SchedG1SKV : SchedBase {
    const char* A; const char* Bt;
    __device__ __forceinline__ bool next(int i, Unit& u) const { const int L = i * G + c; if (L >= 8 * 64) return false; int pm, pn; gm::tile_order(L, 8, 64, pm, pn);
        const int rb = pm < 4 ? 2048 + 256 * pm : 3072 + 256 * (pm - 4);
        u.a0 = A + (size_t)rb * D; u.a1 = u.a0 + (size_t)128 * D; u.b0 = Bt + (size_t)pn * 256 * D; u.b1 = u.b0 + (size_t)128 * D; u.p0 = pm; u.p1 = pn; u.p2 = rb; u.p3 = 0; return true; }
};
struct SchedFixA : SchedBase {
    const char* A; const char* Bt; int ncol;
    __device__ __forceinline__ bool next(int i, Unit& u) const { const int L = i * G + c; if (L >= ncol) return false;
        u.a0 = A; u.a1 = A + (size_t)128 * pitchA * 2; u.b0 = Bt + (size_t)L * 256 * pitchB * 2; u.b1 = u.b0 + (size_t)128 * pitchB * 2; u.p0 = 0; u.p1 = L; u.p2 = 0; u.p3 = 0; return true; }
};
struct SchedFixB : SchedBase {
    const char* A; const char* Bt; int nrow;
    __device__ __forceinline__ bool next(int i, Unit& u) const { const int L = i * G + c; if (L >= nrow) return false;
        u.a0 = A + (size_t)L * 256 * pitchA * 2; u.a1 = u.a0 + (size_t)128 * pitchA * 2; u.b0 = Bt; u.b1 = Bt + (size_t)128 * pitchB * 2; u.p0 = L; u.p1 = 0; u.p2 = 0; u.p3 = 0; return true; }
};
struct SchedScores : SchedBase {
    const char* Q; const char* Kk;
    __device__ __forceinline__ bool next(int i, Unit& u) const { const int L = i * G + c; if (L >= NH * NCH) return false; const int h = L & 3, n = L >> 2;
        u.a0 = Q + ((size_t)n * 256 * RW + h * HD) * 2; u.a1 = u.a0 + (size_t)128 * RW * 2; u.b0 = Kk + ((size_t)n * 256 * RW + h * HD) * 2; u.b1 = u.b0 + (size_t)128 * RW * 2; u.p0 = h; u.p1 = n; u.p2 = 0; u.p3 = 0; return true; }
};
struct SchedKV : SchedBase {
    const char* Bcat; const char* kTw;
    __device__ __forceinline__ bool next(int i, Unit& u) const { const int L = i * G + c; if (L >= 2 * NH * NCH) return false; const int dh = L & 7, n = L >> 3, dir = dh >> 2, h = dh & 3;
        u.a0 = Bcat + ((size_t)(h * NCH + n) * 256 * CAT) * 2; u.a1 = u.a0 + (size_t)128 * CAT * 2;
        u.b0 = kTw + (((size_t)dir * RW + h * HD) * T + (size_t)n * 256) * 2; u.b1 = u.b0 + (size_t)128 * T * 2; u.p0 = dh; u.p1 = n; u.p2 = 0; u.p3 = 0; return true; }
};
struct SchedOut : SchedBase {
    const char* Acat; const char* Bcat;
    __device__ __forceinline__ bool next(int i, Unit& u) const { const int L = i * G + c; if (L >= NH * NCH) return false; const int h = L & 3, n = L >> 2;
        u.a0 = Acat + ((size_t)h * T + (size_t)n * 256) * CAT * 2; u.a1 = u.a0 + (size_t)128 * CAT * 2; u.b0 = Bcat + ((size_t)(h * NCH + n) * 256 * CAT) * 2; u.b1 = u.b0 + (size_t)128 * CAT * 2; u.p0 = h; u.p1 = n; u.p2 = 0; u.p3 = 0; return true; }
};
struct Sched2D : SchedBase {
    const char* A; const char* Bt; int nM, nN;
    __device__ __forceinline__ bool next(int i, Unit& u) const { const int L = i * G + c; if (L >= nM * nN) return false; int pm, pn; gm::tile_order(L, nM, nN, pm, pn);
        u.a0 = A + (size_t)pm * 256 * pitchA * 2; u.a1 = u.a0 + (size_t)128 * pitchA * 2; u.b0 = Bt + (size_t)pn * 256 * pitchB * 2; u.b1 = u.b0 + (size_t)128 * pitchB * 2; u.p0 = pm; u.p1 = pn; u.p2 = 0; u.p3 = 0; return true; }
};
struct SchedMoE : SchedBase {
    const char* A; const char* Bt; const LAS int* tstart; const int* row_tok; const unsigned* cnt; int nN, rowbytes; size_t estride;
    __device__ __forceinline__ bool next(int i, Unit& u) const { const int RT = __builtin_amdgcn_readfirstlane(tstart[NE]); const int L = i * G + c; if (L >= RT * nN) return false; int rt, pn; gm::tile_order(L, RT, nN, rt, pn);
        const int e = __builtin_amdgcn_readfirstlane(tstart[40 + rt]);
        u.b0 = Bt + (size_t)e * estride + (size_t)pn * 256 * rowbytes; u.b1 = u.b0 + (size_t)128 * rowbytes;
        u.a0 = A; u.a1 = A;
        u.p0 = rt; u.p1 = pn; u.p2 = e; u.p3 = (rt - __builtin_amdgcn_readfirstlane(tstart[e])) * 256; return true; }
    __device__ __forceinline__ bool next_tab(int i, Unit& u) const { const int w = (i < 64) ? __builtin_amdgcn_readfirstlane(tstart[400 + i]) : -1; if (w < 0) return false;
        const int rt = w & 1023, pn = (w >> 10) & 31, e = (w >> 15) & 31;
        u.b0 = Bt + (size_t)e * estride + (size_t)pn * 256 * rowbytes; u.b1 = u.b0 + (size_t)128 * rowbytes; u.a0 = A; u.a1 = A;
        u.p0 = rt; u.p1 = pn; u.p2 = e; u.p3 = (rt - __builtin_amdgcn_readfirstlane(tstart[e])) * 256; return true; }
    const float *rsc, *swup, *b_up;
    __device__ __forceinline__ void prefetch(const Unit& u, LAS unsigned char* lds) const {
        LAS unsigned char* blk = lds + LDS_STAGE + u.q * 4096;
        const int wid = wv, e = u.p2; int lane = lane_id(); asm volatile("" : "+v"(lane));
        const int n = (int)cnt[64 * e]; int pos = u.p3 + (wid & 3) * 64 + lane; pos = pos < n ? pos : n - 1;
        if (wid < 4) __builtin_amdgcn_global_load_lds((const unsigned*)(row_tok + (size_t)e * T + pos), (LAS unsigned*)(blk + wid * 256), 4, 0, 0);
        else __builtin_amdgcn_global_load_lds((const unsigned*)(rsc + (size_t)e * T + pos), (LAS unsigned*)(blk + 1024 + (wid - 4) * 256), 4, 0, 0);
        if (wid == 0) __builtin_amdgcn_global_load_lds((const unsigned*)(swup + (size_t)e * 2 * DFF + u.p1 * 256 + lane * 4), (LAS unsigned*)(blk + 2048), 16, 0, 0);
        if (wid == 1) __builtin_amdgcn_global_load_lds((const unsigned*)(b_up + (size_t)e * 2 * DFF + u.p1 * 128 + (lane & 31) * 4 + (lane >> 5) * DFF), (LAS unsigned*)(blk + 3072), 16, 0, 0);
    }
    __device__ __forceinline__ unsigned row_off(const Unit& u, int r, LAS unsigned char* lds) const { return (unsigned)((const LAS int*)(lds + LDS_STAGE + u.q * 4096))[r] * (unsigned)rowbytes; }
};
struct SchedMoEUpT : SchedMoE { __device__ __forceinline__ bool next(int i, Unit& u) const { return next_tab(i, u); } };
struct SchedMoEDown : SchedMoE {
    const float *sa, *swdn, *b_dn;
    __device__ __forceinline__ bool next(int i, Unit& u) const { if (!SchedMoE::next_tab(i, u)) return false; u.a0 = A + (size_t)u.p0 * 256 * rowbytes; u.a1 = u.a0 + (size_t)128 * rowbytes; return true; }
    __device__ __forceinline__ void prefetch(const Unit& u, LAS unsigned char* lds) const {
        LAS unsigned char* blk = lds + LDS_STAGE + u.q * 4096;
        const int wid = wv, e = u.p2; int lane = lane_id(); asm volatile("" : "+v"(lane));
        if (wid == 1) __builtin_amdgcn_global_load_lds((const unsigned*)(swdn + (size_t)e * D + u.p1 * 256 + lane * 4), (LAS unsigned*)(blk + 1024), 16, 0, 0);
        if (wid == 2) __builtin_amdgcn_global_load_lds((const unsigned*)(b_dn + (size_t)e * D + u.p1 * 256 + lane * 4), (LAS unsigned*)(blk + 2048), 16, 0, 0);
    }
};

#define EPI_LOOP_AM for (int ai = 0; ai < 2; ++ai) _Pragma("unroll") for (int m = 0; m < 4; ++m)
#define EPI_FENCE __builtin_amdgcn_sched_barrier(0)
struct EpiG1N {
    static constexpr bool PERM = true;
    bf16 *qs, *kk, *gs, *Acat; const float *dec_f, *dec_b, *sx0, *swin;
    __device__ __forceinline__ void operator()(AccI& acci, const Unit& u, LAS unsigned char*, int wr, int wc, int fr, int fq) const {
        const int pm = u.p0, pn = u.p1, c0 = wc * 32 + 8 * fq;
        f32x4 swc[2][2];
#pragma unroll
        for (int bj = 0; bj < 2; ++bj)
#pragma unroll
            for (int n = 0; n < 2; ++n) swc[bj][n] = *(const GAS f32x4*)(swin + u.p2 + 128 * bj + c0 + 4 * n);
#define ACCF(ai_, bj_, m_, n_, j_) ((float)acci[ai_][bj_][m_][n_][j_] * (sxr * swc[bj_][n_][j_]))
        if (pn < 8) {
            const int h = pn & 3; const bool isq = pn < 4;
            float inv[8];
#pragma unroll
            for (int e = 0; e < 8; ++e) inv[e] = __builtin_amdgcn_exp2f(-(float)(c0 + e) * (13.287712379549449f / 128.f)) * 0.15915494309189535f;
            const float lgf = -fexp(dec_f[h]), lgb = -fexp(dec_b[h]);
#pragma unroll
            EPI_LOOP_AM {
                const int r = 128 * ai + 64 * wr + 16 * m + fr, tok = pm * 256 + r; const float pos = (float)tok; const float sxr = sx0[tok];
                f32x4 o1[2], o2[2];
#pragma unroll
                for (int n = 0; n < 2; ++n)
#pragma unroll
                    for (int j = 0; j < 4; ++j) { float c, s; cs_rev(pos * inv[4 * n + j], c, s); const float x1 = ACCF(ai, 0, m, n, j), x2 = ACCF(ai, 1, m, n, j); o1[n][j] = x1 * c - x2 * s; o2[n][j] = x2 * c + x1 * s; }
                if (isq) {
                    bf16* q = qs + (size_t)tok * RW + h * HD + c0; *(GAS v4u*)q = pack8(o1[0], o1[1]); *(GAS v4u*)(q + 128) = pack8(o2[0], o2[1]);
                    const int il = r; const float wf = fexp(lgf * (float)(il + 1)), wb = fexp(lgb * (float)(255 - il));
                    bf16* a = Acat + ((size_t)h * T + tok) * CAT + c0;
                    *(GAS v4u*)(a + 256) = pack8(o1[0] * wf, o1[1] * wf); *(GAS v4u*)(a + 384) = pack8(o2[0] * wf, o2[1] * wf);
                    *(GAS v4u*)(a + 512) = pack8(o1[0] * wb, o1[1] * wb); *(GAS v4u*)(a + 640) = pack8(o2[0] * wb, o2[1] * wb);
                } else {
                    bf16* k = kk + (size_t)tok * RW + h * HD + c0; *(GAS v4u*)k = pack8(o1[0] * 0.0625f, o1[1] * 0.0625f); *(GAS v4u*)(k + 128) = pack8(o2[0] * 0.0625f, o2[1] * 0.0625f);
                }
            }
        } else {
#pragma unroll
            EPI_LOOP_AM {
                const int r = 128 * ai + 64 * wr + 16 * m + fr, tok = pm * 256 + r; const float sxr = sx0[tok];
#pragma unroll
                for (int bj = 0; bj < 2; ++bj) { f32x4 v[2];
#pragma unroll
                    for (int n = 0; n < 2; ++n)
#pragma unroll
                        for (int j = 0; j < 4; ++j) { const float g = ACCF(ai, bj, m, n, j); v[n][j] = g * __builtin_amdgcn_rcpf(1.f + fexp(-g)); }
                    *(GAS v4u*)(gs + (size_t)tok * RW + (pn - 8) * 256 + bj * 128 + c0) = pack8(v[0], v[1]); }
            }
        }
    }
};
#undef ACCF
struct EpiG1SF {
    static constexpr bool PERM = true;
    bf16* uTT; const float *sx0, *swin;
    __device__ __forceinline__ void operator()(AccI& acc, const Unit& u, LAS unsigned char*, int wr, int wc, int fr, int fq) const {
        const int a0 = wc * 32 + 8 * fq;
        float sxc[2][8];
#pragma unroll
        for (int bj = 0; bj < 2; ++bj)
#pragma unroll
            for (int e = 0; e < 8; ++e) sxc[bj][e] = sx0[128 * (a0 + e) + 2 * u.p1 + bj];
#pragma unroll
        EPI_LOOP_AM { const int cch = u.p0 * 256 + 128 * ai + 64 * wr + 16 * m + fr; const float swr = swin[cch];
#pragma unroll
            for (int bj = 0; bj < 2; ++bj) { f32x4 v0, v1;
#pragma unroll
                for (int j = 0; j < 4; ++j) { v0[j] = (float)acc[ai][bj][m][0][j] * (swr * sxc[bj][j]); v1[j] = (float)acc[ai][bj][m][1][j] * (swr * sxc[bj][4 + j]); }
                *(GAS v4u*)(uTT + ((size_t)cch * 128 + (2 * u.p1 + bj)) * 128 + a0) = pack8(v0, v1); } }
    }
};
struct EpiG1SKV {
    static constexpr bool PERM = true;
    bf16 *kTw, *Bcat; const float *dec_f, *dec_b, *sx0, *swin;
    __device__ __forceinline__ void operator()(AccI& acc, const Unit& u, LAS unsigned char*, int wr, int wc, int fr, int fq) const {
        const int pm = u.p0, n_ch = u.p1, c0 = wc * 32 + 8 * fq;
        f32x4 sxc[2][2];
#pragma unroll
        for (int bj = 0; bj < 2; ++bj)
#pragma unroll
            for (int n = 0; n < 2; ++n) sxc[bj][n] = *(const GAS f32x4*)(sx0 + n_ch * 256 + 128 * bj + c0 + 4 * n);
        if (pm < 4) {
            const int h = pm; const float lgf = -fexp(dec_f[h]), lgb = -fexp(dec_b[h]);
#pragma unroll
            for (int m = 0; m < 4; ++m) {
                const int d = 64 * wr + 16 * m + fr;
                const float sw1 = swin[u.p2 + d], sw2 = swin[u.p2 + 128 + d];
                const float inv = __builtin_amdgcn_exp2f(-(float)d * (13.287712379549449f / 128.f)) * 0.15915494309189535f;
#pragma unroll
                for (int bj = 0; bj < 2; ++bj) {
                    f32x4 f1[2], f2[2], b1[2], b2[2];
#pragma unroll
                    for (int n = 0; n < 2; ++n)
#pragma unroll
                        for (int j = 0; j < 4; ++j) { const int il = 128 * bj + c0 + 4 * n + j; const float pos = (float)(n_ch * 256 + il); float c, s; cs_rev(pos * inv, c, s);
                            const float x1 = (float)acc[0][bj][m][n][j] * (sw1 * sxc[bj][n][j]), x2 = (float)acc[1][bj][m][n][j] * (sw2 * sxc[bj][n][j]); const float o1 = (x1 * c - x2 * s) * 0.0625f, o2 = (x2 * c + x1 * s) * 0.0625f;
                            const float wf = fexp(lgf * (float)(255 - il)), wb = fexp(lgb * (float)(il + 1));
                            f1[n][j] = o1 * wf; f2[n][j] = o2 * wf; b1[n][j] = o1 * wb; b2[n][j] = o2 * wb; }
                    const size_t tcol = (size_t)n_ch * 256 + 128 * bj + c0;
                    bf16* pf = kTw + ((size_t)(h * HD + d)) * T + tcol; bf16* pb = pf + (size_t)RW * T;
                    *(GAS v4u*)pf = pack8(f1[0], f1[1]); *(GAS v4u*)(pf + (size_t)128 * T) = pack8(f2[0], f2[1]);
                    *(GAS v4u*)pb = pack8(b1[0], b1[1]); *(GAS v4u*)(pb + (size_t)128 * T) = pack8(b2[0], b2[1]);
                }
            }
        } else {
            const int h = pm - 4;
#pragma unroll
            EPI_LOOP_AM { const int dv = 128 * ai + 64 * wr + 16 * m + fr; const float swr = swin[u.p2 + dv];
#pragma unroll
                for (int bj = 0; bj < 2; ++bj) { f32x4 v0, v1;
#pragma unroll
                    for (int j = 0; j < 4; ++j) { v0[j] = (float)acc[ai][bj][m][0][j] * (swr * sxc[bj][0][j]); v1[j] = (float)acc[ai][bj][m][1][j] * (swr * sxc[bj][1][j]); }
                    *(GAS v4u*)(Bcat + ((size_t)(h * NCH + n_ch) * 256 + dv) * CAT + 128 * bj + c0) = pack8(v0, v1); } }
        }
    }
};
struct EpiS1 {
    static constexpr bool PERM = true;
    bf16* A1;
    __device__ __forceinline__ void operator()(Acc& acc, const Unit& u, LAS unsigned char*, int wr, int wc, int fr, int fq) const {
        const int b0 = wc * 32 + 8 * fq;
#pragma unroll
        for (int m = 0; m < 4; ++m) { const int k1 = 64 * wr + 16 * m + fr;
#pragma unroll
            for (int bj = 0; bj < 2; ++bj) { const int cch = 2 * u.p1 + bj; f32x4 re[2], im[2];
#pragma unroll
                for (int n = 0; n < 2; ++n)
#pragma unroll
                    for (int j = 0; j < 4; ++j) { const int b = b0 + 4 * n + j; float c, s; cs_rev((float)(k1 * b) * (1.f / 16384.f), c, s);
                        const float xr = acc[0][bj][m][n][j], xi = acc[1][bj][m][n][j]; re[n][j] = xr * c + xi * s; im[n][j] = xi * c - xr * s; }
                bf16* p = A1 + (((size_t)k1 * 1024 + cch) * 2) * 128 + b0;
                *(GAS v4u*)p = pack8(re[0], re[1]); *(GAS v4u*)(p + 128) = pack8(im[0], im[1]); EPI_FENCE; } }
    }
};
struct EpiS2 {
    static constexpr bool PERM = true;
    bf16* Zt;
    __device__ __forceinline__ void operator()(Acc& acc, const Unit& u, LAS unsigned char*, int wr, int wc, int fr, int fq) const {
        const int k1 = u.p1 >> 2, cb = (u.p1 & 3) * 256, c0 = wc * 32 + 8 * fq;
#pragma unroll
        EPI_LOOP_AM { const int k2 = 64 * wr + 16 * m + fr, k = k1 + 128 * k2;
#pragma unroll
            for (int bj = 0; bj < 2; ++bj) { const int cch = cb + 128 * bj + c0, g = cch >> 7, cg = cch & 127;
                *(GAS v4u*)(Zt + (size_t)k * 2048 + g * 256 + ai * 128 + cg) = pack8(acc[ai][bj][m][0], acc[ai][bj][m][1]); } }
    }
};
struct EpiChan {
    static constexpr bool PERM = true;
    bf16* y;
    __device__ __forceinline__ void operator()(Acc& acc, const Unit& u, LAS unsigned char*, int wr, int wc, int fr, int fq) const {
        const int l0 = wc * 32 + 8 * fq; const float norm = 6.9053396600248786e-4f;
#pragma unroll
        EPI_LOOP_AM { const int R = u.p0 * 256 + 128 * ai + 64 * wr + 16 * m + fr, k = R >> 3, g = R & 7;
            *(GAS v4u*)(y + (size_t)k * D + g * 128 + l0) = pack8(acc[ai][0][m][0] * norm, acc[ai][0][m][1] * norm); }
    }
};
struct EpiScores {
    static constexpr bool PERM = true;
    bf16* Acat; const float *dec_f, *dec_b;
    __device__ __forceinline__ void operator()(Acc& acc, const Unit& u, LAS unsigned char*, int wr, int wc, int fr, int fq) const {
        const int h = u.p0, n_ch = u.p1, c0 = wc * 32 + 8 * fq; const float lgf = -fexp(dec_f[h]), lgb = -fexp(dec_b[h]);
#pragma unroll
        EPI_LOOP_AM { const int i = 128 * ai + 64 * wr + 16 * m + fr;
#pragma unroll
            for (int bj = 0; bj < 2; ++bj) { f32x4 v[2];
#pragma unroll
                for (int n = 0; n < 2; ++n)
#pragma unroll
                    for (int j = 0; j < 4; ++j) { const int jc = 128 * bj + c0 + 4 * n + j; const float dd = (float)(i - jc); const float w = (jc <= i) ? fexp(lgf * dd) : fexp(-lgb * dd); v[n][j] = acc[ai][bj][m][n][j] * w; }
                *(GAS v4u*)(Acat + ((size_t)h * T + n_ch * 256 + i) * CAT + 128 * bj + c0) = pack8(v[0], v[1]); EPI_FENCE; } }
    }
};
struct EpiKV {
    static constexpr bool PERM = true;
    bf16* kvT;
    __device__ __forceinline__ void operator()(Acc& acc, const Unit& u, LAS unsigned char*, int wr, int wc, int fr, int fq) const {
#pragma unroll
        EPI_LOOP_AM { const int dv = 128 * ai + 64 * wr + 16 * m + fr; bf16* rowp = kvT + (((size_t)u.p0 * NCH + u.p1) * 256 + dv) * 256 + wc * 32 + 8 * fq;
#pragma unroll
            for (int bj = 0; bj < 2; ++bj) *(GAS v4u*)(rowp + bj * 128) = pack8(acc[ai][bj][m][0], acc[ai][bj][m][1]); }
    }
};
struct EpiOut {
    static constexpr bool PERM = true;
    bf16* y; const bf16* gs; const float* gn_g;
    __device__ __forceinline__ void operator()(Acc& acc, const Unit& u, LAS unsigned char* lds, int wr, int wc, int fr, int fq) const {
        const int h = u.p0, n_ch = u.p1, c0 = wc * 32 + 8 * fq;
        LAS f32x2* P = (LAS f32x2*)(lds + LDS_STAGE);
#pragma unroll
        EPI_LOOP_AM {
            float s = 0.f;
#pragma unroll
            for (int bj = 0; bj < 2; ++bj)
#pragma unroll
                for (int n = 0; n < 2; ++n) { const f32x4 x = acc[ai][bj][m][n]; s += (x[0] + x[1]) + (x[2] + x[3]); }
            s += __shfl_xor(s, 16); s += __shfl_xor(s, 32);
            const float mw = s * (1.f / 64.f); float q = 0.f;
#pragma unroll
            for (int bj = 0; bj < 2; ++bj)
#pragma unroll
                for (int n = 0; n < 2; ++n) { const f32x4 d = acc[ai][bj][m][n] - mw; q += (d[0] * d[0] + d[1] * d[1]) + (d[2] * d[2] + d[3] * d[3]); }
            q += __shfl_xor(q, 16); q += __shfl_xor(q, 32);
            if (fq == 0) P[(128 * ai + 64 * wr + 16 * m + fr) * 4 + wc] = (f32x2){mw, q};
        }
        LDS_WAIT(); __builtin_amdgcn_s_barrier(); asm volatile("" ::: "memory");
#pragma unroll
        EPI_LOOP_AM {
            const int r = 128 * ai + 64 * wr + 16 * m + fr, tok = n_ch * 256 + r;
            const f32x2 a = P[r * 4 + 0], b = P[r * 4 + 1], c = P[r * 4 + 2], d = P[r * 4 + 3];
            const float mt = (a.x + b.x + c.x + d.x) * 0.25f; const float da = a.x - mt, db = b.x - mt, dc = c.x - mt, dd = d.x - mt;
            const float m2 = (a.y + b.y) + (c.y + d.y) + 64.f * ((da * da + db * db) + (dc * dc + dd * dd));
            const float rstd = 1.f / sqrtf(m2 * (1.f / 256.f) + GN_EPS);
#pragma unroll
            for (int bj = 0; bj < 2; ++bj) {
                const int col = h * HD + 128 * bj + c0; const v4u gv = *(const GAS v4u*)(gs + (size_t)tok * RW + col);
                const f32x4 g0 = *(const GAS f32x4*)(gn_g + col), g1 = *(const GAS f32x4*)(gn_g + col + 4);
                f32x4 o0 = (acc[ai][bj][m][0] - mt) * rstd * g0, o1 = (acc[ai][bj][m][1] - mt) * rstd * g1;
                o0[0] *= bf_lo(gv.x); o0[1] *= bf_hi(gv.x); o0[2] *= bf_lo(gv.y); o0[3] *= bf_hi(gv.y); o1[0] *= bf_lo(gv.z); o1[1] *= bf_hi(gv.z); o1[2] *= bf_lo(gv.w); o1[3] *= bf_hi(gv.w);
                *(GAS v4u*)(y + (size_t)tok * D + FW + col) = pack8(o0, o1); }
        }
        LDS_WAIT(); __builtin_amdgcn_s_barrier(); asm volatile("" ::: "memory");
    }
};
struct EpiWout {
    static constexpr bool PERM = true;
    bf16* z1; const float *x, *st0, *g0, *b0;
    __device__ __forceinline__ void operator()(Acc& acc, const Unit& u, LAS unsigned char*, int wr, int wc, int fr, int fq) const {
        const int colb = u.p1 * 256 + wc * 32 + 8 * fq;
#pragma unroll
        for (int bj = 0; bj < 2; ++bj) { const int col = colb + bj * 128;
            const f32x4 ga = *(const GAS f32x4*)(g0 + col), gb = *(const GAS f32x4*)(g0 + col + 4), ba = *(const GAS f32x4*)(b0 + col), bb = *(const GAS f32x4*)(b0 + col + 4);
#pragma unroll
            EPI_LOOP_AM { const int row = u.p0 * 256 + 128 * ai + 64 * wr + 16 * m + fr; const f32x2 st = *(const GAS f32x2*)(st0 + 2 * row); const size_t off = (size_t)row * D + col;
                const f32x4 xa = *(const GAS f32x4*)(x + off), xb = *(const GAS f32x4*)(x + off + 4);
                *(GAS v4u*)(z1 + off) = pack8(((xa - st.x) * st.y * ga + ba) * ALPHA + acc[ai][bj][m][0], ((xb - st.x) * st.y * gb + bb) * ALPHA + acc[ai][bj][m][1]); } }
    }
};
struct EpiUp {
    static constexpr bool PERM = true;
    unsigned char* act8;
    __device__ __forceinline__ void operator()(AccI& acc, const Unit& u, LAS unsigned char* lds, int wr, int wc, int fr, int fq) const {
        const int rt = u.p0, pn = u.p1, c0 = pn * 128 + wc * 32 + 8 * fq;
        const LAS float* blk = (const LAS float*)(lds + LDS_STAGE + u.q * 4096);
        float sx[2][4];
#pragma unroll
        EPI_LOOP_AM sx[ai][m] = blk[256 + 128 * ai + 64 * wr + 16 * m + fr];
#pragma unroll
        for (int n = 0; n < 2; ++n) {
            const int cc = wc * 32 + 8 * fq + 4 * n;
            const f32x4 sg = *(const LAS f32x4*)(blk + 512 + cc), sl = *(const LAS f32x4*)(blk + 512 + 128 + cc), bg = *(const LAS f32x4*)(blk + 768 + cc), bl = *(const LAS f32x4*)(blk + 768 + 128 + cc);
#pragma unroll
            EPI_LOOP_AM { const int r = 128 * ai + 64 * wr + 16 * m + fr; f32x2 v2[2];
#pragma unroll
                for (int jp = 0; jp < 2; ++jp) {
                    const f32x2 sx2 = (f32x2){sx[ai][m], sx[ai][m]};
                    f32x2 gl = (f32x2){(float)acc[ai][0][m][n][2 * jp], (float)acc[ai][0][m][n][2 * jp + 1]} * (sx2 * (f32x2){sg[2 * jp], sg[2 * jp + 1]}) + (f32x2){bg[2 * jp], bg[2 * jp + 1]};
                    f32x2 li = (f32x2){(float)acc[ai][1][m][n][2 * jp], (float)acc[ai][1][m][n][2 * jp + 1]} * (sx2 * (f32x2){sl[2 * jp], sl[2 * jp + 1]}) + (f32x2){bl[2 * jp], bl[2 * jp + 1]};
                    gl = __builtin_elementwise_min(gl, (f32x2){7.f, 7.f}); li = __builtin_elementwise_min(__builtin_elementwise_max(li, (f32x2){-7.f, -7.f}), (f32x2){7.f, 7.f});
                    const f32x2 ea = gl * (-1.702f * 1.4426950408889634f); f32x2 den; den.x = __builtin_amdgcn_exp2f(ea.x); den.y = __builtin_amdgcn_exp2f(ea.y); den = den + 1.0f;
                    f32x2 rc; rc.x = __builtin_amdgcn_rcpf(den.x); rc.y = __builtin_amdgcn_rcpf(den.y);
                    v2[jp] = (gl * rc) * (li * 4.0f + 4.0f); }
                int p = __builtin_amdgcn_cvt_pk_fp8_f32(v2[0].x, v2[0].y, 0, false); p = __builtin_amdgcn_cvt_pk_fp8_f32(v2[1].x, v2[1].y, p, true);
                *(GAS int*)(act8 + ((size_t)rt * 256 + r) * DFF + c0 + 4 * n) = p; }
        }
    }
};
struct EpiDown {
    static constexpr bool PERM = true;
    unsigned char* yr8;
    __device__ __forceinline__ void operator()(Acc& acc, const Unit& u, LAS unsigned char* lds, int wr, int wc, int fr, int fq) const {
        const int rt = u.p0, pn = u.p1, c0 = pn * 256 + wc * 32 + 8 * fq;
        const LAS float* blk = (const LAS float*)(lds + LDS_STAGE + u.q * 4096);
#pragma unroll
        for (int bj = 0; bj < 2; ++bj) { const int cc = 128 * bj + wc * 32 + 8 * fq;
#pragma unroll
            EPI_LOOP_AM { const int r = 128 * ai + 64 * wr + 16 * m + fr;
                const f32x4 w0 = *(const LAS f32x4*)(blk + 256 + cc) * 0.25f, w1 = *(const LAS f32x4*)(blk + 256 + cc + 4) * 0.25f, b0 = *(const LAS f32x4*)(blk + 512 + cc), b1 = *(const LAS f32x4*)(blk + 512 + cc + 4);
                f32x4 y0 = (acc[ai][bj][m][0] * w0 + b0) * 32.f, y1 = (acc[ai][bj][m][1] * w1 + b1) * 32.f;
#pragma unroll
                for (int j = 0; j < 4; ++j) { y0[j] = fminf(fmaxf(y0[j], -440.f), 440.f); y1[j] = fminf(fmaxf(y1[j], -440.f), 440.f); }
                int p0 = __builtin_amdgcn_cvt_pk_fp8_f32(y0[0], y0[1], 0, false); p0 = __builtin_amdgcn_cvt_pk_fp8_f32(y0[2], y0[3], p0, true);
                int p1 = __builtin_amdgcn_cvt_pk_fp8_f32(y1[0], y1[1], 0, false); p1 = __builtin_amdgcn_cvt_pk_fp8_f32(y1[2], y1[3], p1, true);
                *(GAS v2u*)(yr8 + ((size_t)rt * 256 + r) * D + c0 + 128 * bj) = (v2u){(unsigned)p0, (unsigned)p1}; EPI_FENCE; } }
    }
};

__device__ __forceinline__ void p3_scan(Frame& F) {
    const bf16* kvT = WSP(bf16, WS_KVT); bf16* Bcat = WSP(bf16, WS_BCAT);
    const int NQ = 2 * NH * 256 * 64;
    for (int q = F.vcu * NTHR + FTID; q < NQ; q += F.G * NTHR) {
        const int dk4 = q & 63, dv = (q >> 6) & 255, dh = q >> 14, dir = dh >> 2, h = dh & 3;
        const float lg = -fexp((dir ? F.dec_b : F.dec_f)[h]); const float cd = fexp(lg * (float)C2);
        f32x4 S = (f32x4){0.f, 0.f, 0.f, 0.f};
        for (int s = 0; s < NCH; ++s) { const int n = dir ? (NCH - 1 - s) : s;
            const v2u kw = *(const GAS v2u*)(kvT + (((size_t)dh * NCH + n) * 256 + dv) * 256 + dk4 * 4); const f32x4 kv = (f32x4){bf_lo(kw.x), bf_hi(kw.x), bf_lo(kw.y), bf_hi(kw.y)};
            v2u w; w.x = cvt_pk_bf16(S[0], S[1]); w.y = cvt_pk_bf16(S[2], S[3]);
            *(GAS v2u*)(Bcat + ((size_t)(h * NCH + n) * 256 + dv) * CAT + 256 + dir * 256 + dk4 * 4) = w;
            S = S * cd + kv; }
    }
}

__device__ __forceinline__ void p6_router(Frame& F) {
    const bf16* z1 = WSP(bf16, WS_Z1); unsigned* h1q = WSP(unsigned, WS_H1Q); float* sxg = WSP(float, WS_SX); float* rsc = WSP(float, WS_RSC); float* st1 = WSP(float, WS_ST0) + 2 * T;
    int* topi = WSP(int, WS_RT); float* gate = (float*)(topi + 4 * T); int* posb = (int*)(gate + 4 * T); int* row_tok = posb + 4 * T;
    LAS float* hc = (LAS float*)F.lds;
    LAS float* wrc = hc + 64 * 257;
    LAS float* stl = wrc + 256 * 32;
    LAS float* lg = stl + 128;
    LAS int* hist = (LAS int*)(lg + 64 * 33);
    LAS float* sxl = (LAS float*)(hist + 64);
    for (int blk = F.vcu; blk < T / 64; blk += F.G) {
        const int t0 = blk * 64;
        {
            v2u raw[8][8]; const int ln_ = FLANE;
#pragma unroll
            for (int rr = 0; rr < 8; ++rr) { const GAS v2u* xr = (const GAS v2u*)(z1 + (size_t)(t0 + F.wave * 8 + rr) * D) + ln_;
#pragma unroll
                for (int j = 0; j < 8; ++j) raw[rr][j] = xr[64 * j]; }
#pragma unroll
            for (int rr = 0; rr < 8; ++rr) { const int row = F.wave * 8 + rr, m = t0 + row;
                f32x4 v[8]; float s = 0.f;
#pragma unroll
                for (int j = 0; j < 8; ++j) { const v2u w = raw[rr][j]; v[j] = (f32x4){bf_lo(w.x), bf_hi(w.x), bf_lo(w.y), bf_hi(w.y)}; s += (v[j][0] + v[j][1]) + (v[j][2] + v[j][3]); }
                const float mean = wave_sum(s) * (1.f / D); float s2 = 0.f;
#pragma unroll
                for (int j = 0; j < 8; ++j) { v[j] = v[j] - mean; s2 += (v[j][0] * v[j][0] + v[j][1] * v[j][1]) + (v[j][2] * v[j][2] + v[j][3] * v[j][3]); }
                const float rstd = 1.f / sqrtf(wave_sum(s2) * (1.f / D) + LN_EPS);
                float am = 0.f;
#pragma unroll
                for (int j = 0; j < 8; ++j) { const f32x4 g = *((const GAS f32x4*)F.ln1_g + FLANE + 64 * j), b = *((const GAS f32x4*)F.ln1_b + FLANE + 64 * j);
                    v[j] = v[j] * rstd * g + b; am = fmaxf(am, fmaxf(fmaxf(fabsf(v[j][0]), fabsf(v[j][1])), fmaxf(fabsf(v[j][2]), fabsf(v[j][3])))); }
#pragma unroll
                for (int o = 1; o < 64; o <<= 1) am = fmaxf(am, __shfl_xor(am, o));
                const float sc = am > 0.f ? am * (1.f / 127.f) : 1.f, inv = 1.f / sc;
#pragma unroll
                for (int j = 0; j < 8; ++j) { const int q0 = (int)__builtin_rintf(v[j][0] * inv), q1 = (int)__builtin_rintf(v[j][1] * inv), q2 = (int)__builtin_rintf(v[j][2] * inv), q3 = (int)__builtin_rintf(v[j][3] * inv);
                    h1q[(size_t)m * (D / 4) + FLANE + 64 * j] = (unsigned)(q0 & 0xff) | ((unsigned)(q1 & 0xff) << 8) | ((unsigned)(q2 & 0xff) << 16) | ((unsigned)(q3 & 0xff) << 24); }
                if (FLANE == 0) { st1[2 * m] = mean; st1[2 * m + 1] = rstd; stl[2 * row] = mean; stl[2 * row + 1] = rstd; sxg[m] = sc; sxl[row] = sc; }
            }
        }
        if (FTID < 64) hist[FTID] = 0;
        __syncthreads();
        const int kq = FTID >> 7, rg = (FTID >> 3) & 15, eq = FTID & 7; f32x4 ac[4];
#pragma unroll
        for (int i = 0; i < 4; ++i) ac[i] = (f32x4){0.f, 0.f, 0.f, 0.f};
        LAS float* hcT = hc;
        v2u zp[8]; f32x4 wp[4];
#define P6_LOAD(kc_) do { _Pragma("unroll") for (int i_ = 0; i_ < 8; ++i_) { const int q_ = FTID + NTHR * i_, r_ = q_ & 63, c4_ = (q_ >> 6) * 4; zp[i_] = *(const GAS v2u*)(z1 + (size_t)(t0 + r_) * D + (kc_) * 256 + c4_); } \
        _Pragma("unroll") for (int i_ = 0; i_ < 4; ++i_) { const int q_ = FTID + NTHR * i_, k_ = q_ >> 3, c4_ = (q_ & 7) * 4; wp[i_] = *(const GAS f32x4*)(F.w_r + (size_t)((kc_) * 256 + k_) * NE + c4_); } } while (0)
        P6_LOAD(0);
        for (int kc = 0; kc < 8; ++kc) {
#pragma unroll
            for (int i = 0; i < 8; ++i) { const int q = FTID + NTHR * i, r = q & 63, c4 = (q >> 6) * 4, col = kc * 256 + c4; const v2u zw = zp[i];
                const f32x4 zv = (f32x4){bf_lo(zw.x), bf_hi(zw.x), bf_lo(zw.y), bf_hi(zw.y)}, g = *(const GAS f32x4*)(F.ln1_g + col), b = *(const GAS f32x4*)(F.ln1_b + col);
                const f32x4 hh = (zv - stl[2 * r]) * stl[2 * r + 1] * g + b; LAS float* d = hcT + c4 * 64 + r; d[0] = hh[0]; d[64] = hh[1]; d[128] = hh[2]; d[192] = hh[3]; }
#pragma unroll
            for (int i = 0; i < 4; ++i) { const int q = FTID + NTHR * i, k = q >> 3, c4 = (q & 7) * 4; *(LAS f32x4*)(wrc + k * 32 + c4) = wp[i]; }
            __syncthreads();
            if (kc + 1 < 8) P6_LOAD(kc + 1);
#pragma unroll 8
            for (int k = kq * 64; k < kq * 64 + 64; ++k) { const f32x4 h4 = *(const LAS f32x4*)(hcT + k * 64 + rg * 4), w4 = *(const LAS f32x4*)(wrc + k * 32 + eq * 4);
                ac[0] = ac[0] + w4 * h4[0]; ac[1] = ac[1] + w4 * h4[1]; ac[2] = ac[2] + w4 * h4[2]; ac[3] = ac[3] + w4 * h4[3]; }
            __syncthreads();
        }
#undef P6_LOAD
        { LAS float* part = hc;
#pragma unroll
          for (int i = 0; i < 4; ++i) *(LAS f32x4*)(part + (kq * 64 + rg * 4 + i) * 32 + eq * 4) = ac[i];
          __syncthreads();
          if (FTID < 512) { const int r = FTID >> 3, e0 = (FTID & 7) * 4;
              const f32x4 a = *(const LAS f32x4*)(part + (0 * 64 + r) * 32 + e0), b = *(const LAS f32x4*)(part + (1 * 64 + r) * 32 + e0), c = *(const LAS f32x4*)(part + (2 * 64 + r) * 32 + e0), d4 = *(const LAS f32x4*)(part + (3 * 64 + r) * 32 + e0);
              const f32x4 br = *(const GAS f32x4*)(F.b_r + e0), sum = ((a + b) + (c + d4)) + br; LAS float* d = lg + r * 33 + e0; d[0] = sum[0]; d[1] = sum[1]; d[2] = sum[2]; d[3] = sum[3]; } }
        __syncthreads();
        int ek[4] = {0, 0, 0, 0}, lp[4] = {0, 0, 0, 0}; float gk[4] = {0.f, 0.f, 0.f, 0.f};
        if (FTID < 64) {
            float lv[4]; unsigned used = 0u;
#pragma unroll
            for (int k = 0; k < 4; ++k) { float best = -3.0e38f; int bi = 0;
                for (int e = 0; e < NE; ++e) { const float v = lg[FTID * 33 + e]; const bool ok = !((used >> e) & 1u) && (v > best); best = ok ? v : best; bi = ok ? e : bi; }
                used |= 1u << bi; ek[k] = bi; lv[k] = best; }
            const float mx = lv[0]; float den = 0.f;
#pragma unroll
            for (int k = 0; k < 4; ++k) { gk[k] = fexp(lv[k] - mx); den += gk[k]; }
            const float rd = 1.f / den;
#pragma unroll
            for (int k = 0; k < 4; ++k) { gk[k] *= rd; lp[k] = __hip_atomic_fetch_add(&hist[ek[k]], 1, __ATOMIC_RELAXED, __HIP_MEMORY_SCOPE_WORKGROUP); }
        }
        __syncthreads();
        if (FTID < NE) hist[32 + FTID] = (int)__hip_atomic_fetch_add(F.ctl + CW_CNT + 64 * FTID, (unsigned)hist[FTID], RLX_AGENT);
        __syncthreads();
        if (FTID < 64) { const int tok = t0 + FTID;
#pragma unroll
            for (int k = 0; k < 4; ++k) { const int pos = hist[32 + ek[k]] + lp[k]; row_tok[(size_t)ek[k] * T + pos] = tok; rsc[(size_t)ek[k] * T + pos] = sxl[FTID]; topi[4 * tok + k] = ek[k]; gate[4 * tok + k] = gk[k]; posb[4 * tok + k] = pos; } }
        __syncthreads();
    }
}

__device__ __forceinline__ void build_units(Frame& F, LAS int* tstart, int nN, int c) {
    __syncthreads();
    if (FTID < 64) { const int RT = tstart[NE], L = FTID * F.G + c; int w = -1;
        if (L < RT * nN) { int rt, pn; gm::tile_order(L, RT, nN, rt, pn); w = rt | (pn << 10) | (tstart[40 + rt] << 15); }
        tstart[400 + FTID] = w; }
    __syncthreads();
}

__device__ __forceinline__ void p8_requant(Frame& F, const LAS int* tstart) {
    const bf16* act = WSP(bf16, WS_ACT); unsigned* aq = WSP(unsigned, WS_ACTQ); float* sa = WSP(float, WS_SA); const unsigned* rmax = F.ctl + CW_RMAX;
    const int R = tstart[NE] * 256, gw = F.vcu * NWAVES + F.wave, NGW = F.G * NWAVES;
    for (int row = gw; row < R; row += NGW) {
        const float mx = __uint_as_float(rmax[row]); const float sc = mx > 0.f ? mx * (1.f / 127.f) : 1.f, inv = 1.f / sc;
#pragma unroll
        for (int j = 0; j < 2; ++j) { const int col = 16 * FLANE + 1024 * j;
            const v4u a = *(const GAS v4u*)(act + (size_t)row * DFF + col), b = *(const GAS v4u*)(act + (size_t)row * DFF + col + 8);
            const unsigned src[8] = {a.x, a.y, a.z, a.w, b.x, b.y, b.z, b.w}; unsigned o[4];
#pragma unroll
            for (int d = 0; d < 4; ++d) { unsigned w = 0u;
#pragma unroll
                for (int h2 = 0; h2 < 2; ++h2) { const unsigned u2 = src[2 * d + h2]; int q0 = (int)__builtin_rintf(bf_lo(u2) * inv), q1 = (int)__builtin_rintf(bf_hi(u2) * inv);
                    q0 = q0 > 127 ? 127 : (q0 < -127 ? -127 : q0); q1 = q1 > 127 ? 127 : (q1 < -127 ? -127 : q1);
                    w |= ((unsigned)(q0 & 0xff) << (16 * h2)) | ((unsigned)(q1 & 0xff) << (16 * h2 + 8)); }
                o[d] = w; }
            *(GAS v4u*)(aq + ((size_t)row * DFF + col) / 4) = (v4u){o[0], o[1], o[2], o[3]}; }
        if (FLANE == 0) sa[row] = sc;
    }
}

__device__ __forceinline__ void build_tstart(Frame& F, LAS int* tstart) {
    if (FTID == 0) { int s = 0; for (int e = 0; e < NE; ++e) { tstart[e] = s; const unsigned n = __hip_atomic_load(F.ctl + CW_CNT + 64 * e, RLX_AGENT); s += (int)((n + 255u) >> 8); } tstart[NE] = s; }
    __syncthreads();
    for (int rt = FTID; rt < RT_MAX; rt += NTHR) { int e = 0; for (int j = 1; j < NE; ++j) e += (tstart[j] <= rt) ? 1 : 0; tstart[40 + rt] = e; }
    __syncthreads();
}

__device__ __forceinline__ void p9_combine(Frame& F, const LAS int* tstart) {
    const bf16* z1 = WSP(bf16, WS_Z1); const float* st1 = WSP(float, WS_ST0) + 2 * T; const unsigned char* yr = (const unsigned char*)(F.ws + WS_YR);
    const int* topi = WSP(int, WS_RT); const float* gate = (const float*)(topi + 4 * T); const int* posb = (const int*)(gate + 4 * T);
    const int gw = F.vcu * NWAVES + F.wave, NGW = F.G * NWAVES; const int lane = lane_id();
    for (int m = gw; m < T; m += NGW) {
        const float mean1 = st1[2 * m], rstd1 = st1[2 * m + 1];
        size_t ro[4]; float gk[4];
#pragma unroll
        for (int k = 0; k < 4; ++k) { const int e = topi[4 * m + k]; ro[k] = ((size_t)tstart[e] * 256 + posb[4 * m + k]) * D; gk[k] = gate[4 * m + k]; }
        f32x4 v[8]; float s = 0.f;
#pragma unroll
        for (int j = 0; j < 8; ++j) { const int col = 4 * lane + 256 * j;
            const v2u zw = *(const GAS v2u*)(z1 + (size_t)m * D + col); const f32x4 zv = (f32x4){bf_lo(zw.x), bf_hi(zw.x), bf_lo(zw.y), bf_hi(zw.y)}, g = *(const GAS f32x4*)(F.ln1_g + col), b = *(const GAS f32x4*)(F.ln1_b + col);
            f32x4 a = ((zv - mean1) * rstd1 * g + b) * ALPHA;
#pragma unroll
            for (int k = 0; k < 4; ++k) { const int w = *(const GAS int*)(yr + ro[k] + col); const f32x2 lo = __builtin_amdgcn_cvt_pk_f32_fp8(w, false), hi = __builtin_amdgcn_cvt_pk_f32_fp8(w, true); const float g = gk[k] * (1.f / 32.f);
                a[0] += g * lo.x; a[1] += g * lo.y; a[2] += g * hi.x; a[3] += g * hi.y; }
            v[j] = a; s += (a[0] + a[1]) + (a[2] + a[3]); }
        const float mean = wave_sum(s) * (1.f / D); float s2 = 0.f;
#pragma unroll
        for (int j = 0; j < 8; ++j) { v[j] = v[j] - mean; s2 += (v[j][0] * v[j][0] + v[j][1] * v[j][1]) + (v[j][2] * v[j][2] + v[j][3] * v[j][3]); }
        const float rstd = 1.f / sqrtf(wave_sum(s2) * (1.f / D) + LN_EPS);
#pragma unroll
        for (int j = 0; j < 8; ++j) { const int col = 4 * lane + 256 * j; const f32x4 g = *(const GAS f32x4*)(F.ln2_g + col), b = *(const GAS f32x4*)(F.ln2_b + col);
            *(GAS f32x4*)(F.out + (size_t)m * D + col) = v[j] * rstd * g + b; }
    }
}

constexpr int NPH = 10;
__global__ void __launch_bounds__(NTHR, 2) fwd(Args args) {
    extern __shared__ __attribute__((aligned(16))) unsigned char lds_raw[];
    Frame F;
    F.lds = (LAS unsigned char*)lds_raw; F.ws = args.ws; F.ctl = (unsigned*)(args.ws + WS_CTL);
    F.wave = __builtin_amdgcn_readfirstlane((int)threadIdx.x >> 6);
    F.G = gridDim.x; { const int bx = blockIdx.x; F.vcu = (F.G % 8 == 0) ? (bx % 8) * (F.G / 8) + bx / 8 : bx; }
#define CAS __attribute__((address_space(4)))
#define FRAME_RELOAD() do { const CAS char* kp_ = (const CAS char*)__builtin_amdgcn_kernarg_segment_ptr(); asm volatile("" : "+s"(kp_)); const CAS Args* ap_ = (const CAS Args*)kp_; \
    F.x = ap_->in[0]; F.ln0_g = ap_->in[1]; F.ln0_b = ap_->in[2]; F.w_in = ap_->in[3]; F.dec_f = ap_->in[4]; F.dec_b = ap_->in[5]; F.gn_g = ap_->in[6]; F.w_out = ap_->in[7]; \
    F.ln1_g = ap_->in[8]; F.ln1_b = ap_->in[9]; F.w_r = ap_->in[10]; F.b_r = ap_->in[11]; F.w_up = ap_->in[12]; F.b_up = ap_->in[13]; F.w_dn = ap_->in[14]; F.b_dn = ap_->in[15]; \
    F.ln2_g = ap_->in[16]; F.ln2_b = ap_->in[17]; F.out = ap_->out; F.ws = ap_->ws; F.ctl = (unsigned*)(F.ws + WS_CTL); } while (0)
    FRAME_RELOAD();
    volatile LAS unsigned* lctl = (volatile LAS unsigned*)(F.lds + LDS_CTL_OFF);
    LAS int* tstart = (LAS int*)(F.lds + LDS_CTL_OFF + 64);
    for (int u = FTID; u < 128; u += NTHR) lctl[u] = 0u;
    __syncthreads();
    const int lo = args.ph_lo, hi = args.ph_hi;
    const bool single = (hi - lo) > 1;
    XcdBarrier bar; bar.bar = F.ctl + CW_BAR; bar.x = 0; bar.st = lctl; bar.wave = F.wave;
    if (single) { bar = xcd_barrier_post(F.ctl + CW_BAR, lctl); bar.wave = F.wave; }
#ifndef PH_MASK
#define PH_MASK 0x3ff
#endif
#define IN(k) (((PH_MASK >> (k)) & 1) && lo <= (k) && (k) < hi)
#ifndef SUB_MASK
#define SUB_MASK 0xff
#endif
#define SUB(n) ((SUB_MASK >> (n)) & 1)
#define SEAM(k) do { if (IN(k) && IN((k) + 1)) xcd_barrier(bar); } while (0)
    const int bc = (int)blockIdx.x;

    const int nS = (NE * 128 + F.G - 1) / F.G + (NE * 64 + F.G - 1) / F.G; int sdone = 0; const int qgrp = (int)(blockIdx.x >> 3);
#define QSLOT(k24) do { const int e_ = sdone + (nS * (k24) + 23) / 24; do_slabs(F, sdone, e_ < nS ? e_ : nS); sdone = e_; } while (0)
#define QG(slot, nslots, k24) do { if (qgrp % (nslots) == (slot)) QSLOT(k24); } while (0)
    if (IN(0)) { FRAME_RELOAD(); p0_prologue(F); __syncthreads(); { const int nW = (DIN / 32 + F.G - 1) / F.G; do_slabs(F, -nW, 0); } }
    SEAM(0);
    if (IN(1)) { FRAME_RELOAD();
        QG(0, 4, 9);
        if (SUB(0)) { SchedG1N S; S.nt = D / 128; S.pitchA = D / 2; S.pitchB = D / 2; S.multA = 1; S.multB = 1; S.G = F.G; S.c = bc; S.wv = F.wave; S.A = (const char*)WSP(bf16, WS_H0B); S.Bt = (const char*)WSP(bf16, WS_WIN);
          EpiG1N E{WSP(bf16, WS_QS), WSP(bf16, WS_KK), WSP(bf16, WS_GS), WSP(bf16, WS_ACAT), F.dec_f, F.dec_b, WSP(float, WS_SX0), WSP(float, WS_SWIN)};
          gm::gemm_run<EpiG1N, SchedG1N, false, true>(F.lds, S, E); }
        QG(1, 4, 9);
        if (SUB(1)) { SchedG1SF S; S.nt = D / 128; S.pitchA = D / 2; S.pitchB = D / 2; S.multA = 1; S.multB = 128; S.G = F.G; S.c = bc; S.wv = F.wave; S.A = (const char*)WSP(bf16, WS_WIN); S.Bt = (const char*)WSP(bf16, WS_H0B);
          EpiG1SF E{WSP(bf16, WS_UTT), WSP(float, WS_SX0), WSP(float, WS_SWIN)};
          gm::gemm_run<EpiG1SF, SchedG1SF, false, true>(F.lds, S, E); }
        QG(2, 4, 9);
        if (SUB(2)) { SchedG1SKV S; S.nt = D / 128; S.pitchA = D / 2; S.pitchB = D / 2; S.multA = 1; S.multB = 1; S.G = F.G; S.c = bc; S.wv = F.wave; S.A = (const char*)WSP(bf16, WS_WIN); S.Bt = (const char*)WSP(bf16, WS_H0B);
          EpiG1SKV E{WSP(bf16, WS_KTW), WSP(bf16, WS_BCAT), F.dec_f, F.dec_b, WSP(float, WS_SX0), WSP(float, WS_SWIN)};
          gm::gemm_run<EpiG1SKV, SchedG1SKV, false, true>(F.lds, S, E); }
        QG(3, 4, 9);
    }
    SEAM(1);
    if (IN(2)) { FRAME_RELOAD();
        QG(0, 4, 6);
        if (SUB(3)) { SchedFixA S; S.nt = 2; S.pitchA = 128; S.pitchB = 128; S.multA = 1; S.multB = 1; S.G = F.G; S.c = bc; S.wv = F.wave; S.A = (const char*)WSP(bf16, WS_TAB); S.Bt = (const char*)WSP(bf16, WS_UTT); S.ncol = 512;
          EpiS1 E{WSP(bf16, WS_A1)};
          gm::gemm_run<EpiS1, SchedFixA, false>(F.lds, S, E); }
        QG(1, 4, 6);
        if (SUB(4)) { SchedScores S; S.nt = 4; S.pitchA = RW; S.pitchB = RW; S.multA = 1; S.multB = 1; S.G = F.G; S.c = bc; S.wv = F.wave; S.Q = (const char*)WSP(bf16, WS_QS); S.Kk = (const char*)WSP(bf16, WS_KK);
          EpiScores E{WSP(bf16, WS_ACAT), F.dec_f, F.dec_b};
          gm::gemm_run<EpiScores, SchedScores, false>(F.lds, S, E); }
        QG(2, 4, 6);
        if (SUB(5)) { SchedKV S; S.nt = 4; S.pitchA = CAT; S.pitchB = T; S.multA = 1; S.multB = 1; S.G = F.G; S.c = bc; S.wv = F.wave; S.Bcat = (const char*)WSP(bf16, WS_BCAT); S.kTw = (const char*)WSP(bf16, WS_KTW);
          EpiKV E{WSP(bf16, WS_KVT)};
          gm::gemm_run<EpiKV, SchedKV, false>(F.lds, S, E); }
        QG(3, 4, 6);
    }
    SEAM(2);
    if (IN(3)) { FRAME_RELOAD();
        QG(0, 3, 2);
        { SchedFixA S; S.nt = 4; S.pitchA = 256; S.pitchB = 256; S.multA = 1; S.multB = 1; S.G = F.G; S.c = bc; S.wv = F.wave; S.A = (const char*)(WSP(bf16, WS_TAB) + 32768); S.Bt = (const char*)WSP(bf16, WS_A1); S.ncol = 512;
          EpiS2 E{WSP(bf16, WS_ZT)};
          gm::gemm_run<EpiS2, SchedFixA, false>(F.lds, S, E); }
        QG(1, 3, 2);
        p3_scan(F);
        QG(2, 3, 2);
    }
    SEAM(3);
    if (IN(4)) { FRAME_RELOAD();
        QG(0, 3, 4);
        { SchedFixB S; S.nt = 4; S.pitchA = 256; S.pitchB = 256; S.multA = 1; S.multB = 1; S.G = F.G; S.c = bc; S.wv = F.wave; S.A = (const char*)WSP(bf16, WS_ZT); S.Bt = (const char*)(WSP(bf16, WS_TAB) + 32768 + 65536); S.nrow = 512;
          EpiChan E{WSP(bf16, WS_Y)};
          gm::gemm_run<EpiChan, SchedFixB, false>(F.lds, S, E); }
        QG(1, 3, 4);
        { SchedOut S; S.nt = CAT / 64; S.pitchA = CAT; S.pitchB = CAT; S.multA = 1; S.multB = 1; S.G = F.G; S.c = bc; S.wv = F.wave; S.Acat = (const char*)WSP(bf16, WS_ACAT); S.Bcat = (const char*)WSP(bf16, WS_BCAT);
          EpiOut E{WSP(bf16, WS_Y), WSP(bf16, WS_GS), F.gn_g};
          gm::gemm_run<EpiOut, SchedOut, false>(F.lds, S, E); }
        QG(2, 3, 4);

    }
    SEAM(4);
    if (IN(5)) { FRAME_RELOAD();
        QG(0, 2, 3);
        Sched2D S; S.nt = D / 64; S.pitchA = D; S.pitchB = D; S.multA = 1; S.multB = 1; S.G = F.G; S.c = bc; S.wv = F.wave; S.A = (const char*)WSP(bf16, WS_Y); S.Bt = (const char*)WSP(bf16, WS_WOUT); S.nM = 64; S.nN = 8;
        EpiWout E{WSP(bf16, WS_Z1), F.x, WSP(float, WS_ST0), F.ln0_g, F.ln0_b};
        gm::gemm_run<EpiWout, Sched2D, false>(F.lds, S, E);
        QG(1, 2, 3);
        do_slabs(F, sdone < nS ? sdone : nS, nS);
    }
    SEAM(5);
    if (IN(6)) { FRAME_RELOAD(); p6_router(F); }
    SEAM(6);
    if (IN(7) || IN(8) || IN(9)) build_tstart(F, tstart);
    if (IN(7)) { FRAME_RELOAD();
        build_units(F, tstart, 16, bc);
        SchedMoEUpT S; S.nt = D / 128; S.pitchA = D / 2; S.pitchB = D / 2; S.multA = 1; S.multB = 1; S.G = F.G; S.c = bc; S.wv = F.wave; S.A = (const char*)WSP(char, WS_H1Q); S.Bt = (const char*)WSP(char, WS_WUP);
        S.tstart = tstart; S.row_tok = WSP(int, WS_RT) + 12 * T; S.cnt = F.ctl + CW_CNT; S.nN = 16; S.rowbytes = D; S.estride = (size_t)2 * DFF * D;
        S.rsc = WSP(float, WS_RSC); S.swup = WSP(float, WS_SWUP); S.b_up = F.b_up;
        EpiUp E{(unsigned char*)(F.ws + WS_ACTQ)};
        gm::gemm_run<EpiUp, SchedMoEUpT, true, true, true>(F.lds, S, E);
    }
    SEAM(7);
    if (IN(8)) { FRAME_RELOAD();
        build_units(F, tstart, 8, bc);
        SchedMoEDown S; S.nt = DFF / 128; S.pitchA = DFF / 2; S.pitchB = DFF / 2; S.multA = 1; S.multB = 1; S.G = F.G; S.c = bc; S.wv = F.wave; S.A = (const char*)WSP(char, WS_ACTQ); S.Bt = (const char*)WSP(char, WS_WDN);
        S.tstart = tstart; S.row_tok = nullptr; S.cnt = F.ctl + CW_CNT; S.nN = 8; S.rowbytes = DFF; S.estride = (size_t)D * DFF;
        S.sa = nullptr; S.swdn = WSP(float, WS_SWDN); S.b_dn = F.b_dn; S.rsc = nullptr; S.swup = nullptr; S.b_up = nullptr;
        EpiDown E{(unsigned char*)(F.ws + WS_YR)};
        gm::gemm_run<EpiDown, SchedMoEDown, false, 2, true>(F.lds, S, E);
    }
    SEAM(8);
    if (IN(9)) { FRAME_RELOAD(); p9_combine(F, tstart); }
#undef IN
#undef SEAM
}

#ifndef MK_SPLIT
#define MK_SPLIT 0
#endif
extern "C" void kernel_launch(void* const* d_in, const int* in_sizes, int n_in, void* d_out, int out_size, void* d_ws, size_t ws_size, hipStream_t stream) {
    static int grid = 0;
    if (grid == 0) {
        if (n_in != 18 || out_size != T * D || ws_size < WS_END2) { fprintf(stderr, "kernel_launch: unexpected problem: n_in %d out %d ws %zu (need %zu)\n", n_in, out_size, ws_size, (size_t)WS_END2); grid = -1; return; }
        int dev = 0, cus = 0, per_cu = 0;
        if (hipGetDevice(&dev) != hipSuccess || hipDeviceGetAttribute(&cus, hipDeviceAttributeMultiprocessorCount, dev) != hipSuccess) { grid = -1; return; }
        if (hipFuncSetAttribute((const void*)fwd, hipFuncAttributeMaxDynamicSharedMemorySize, LDS_BYTES) != hipSuccess) { fprintf(stderr, "kernel_launch: hipFuncSetAttribute failed\n"); grid = -1; return; }
        if (hipOccupancyMaxActiveBlocksPerMultiprocessor(&per_cu, (const void*)fwd, NTHR, LDS_BYTES) != hipSuccess || per_cu < 1) { fprintf(stderr, "kernel_launch: occupancy query reports %d\n", per_cu); }
        (void)hipGetLastError();
        grid = cus;
    }
    if (grid < 0) return;
    (void)hipMemsetAsync((char*)d_ws + WS_CTL, 0, CTL_BYTES, stream);
    Args a{};
    for (int i = 0; i < 18; ++i) a.in[i] = (const float*)d_in[i];
    a.out = (float*)d_out; a.ws = (unsigned char*)d_ws;
#if MK_SPLIT
    for (int p = 0; p < NPH; ++p) { a.ph_lo = p; a.ph_hi = p + 1; hipLaunchKernelGGL(fwd, dim3(grid), dim3(NTHR), LDS_BYTES, stream, a); }
#else
    a.ph_lo = 0; a.ph_hi = NPH; hipLaunchKernelGGL(fwd, dim3(grid), dim3(NTHR), LDS_BYTES, stream, a);
#endif
}
```

```cpp
#include <hip/hip_runtime.h>
#include <cstdio>
#include <cstdint>

#define GAS __attribute__((address_space(1)))
#define LAS __attribute__((address_space(3)))
typedef unsigned short bf16;
typedef unsigned v4u __attribute__((ext_vector_type(4)));
typedef unsigned v2u __attribute__((ext_vector_type(2)));
typedef float f32x4 __attribute__((ext_vector_type(4)));
typedef float f32x2 __attribute__((ext_vector_type(2)));
typedef short bf16x8 __attribute__((ext_vector_type(8)));
typedef int i32x4 __attribute__((ext_vector_type(4)));
typedef int i32x8 __attribute__((ext_vector_type(8)));
#define RLX_AGENT __ATOMIC_RELAXED, __HIP_MEMORY_SCOPE_AGENT
#define LDS_WAIT() asm volatile("s_waitcnt lgkmcnt(0)" ::: "memory")
#define VM_WAIT() asm volatile("s_waitcnt vmcnt(0)" ::: "memory")

constexpr int T = 16384, D = 2048, DIN = 5120, FW = 1024, RW = 1024, NH = 4, HD = 256, NE = 32, TOPK = 4, DFF = 2048;
constexpr int C2 = 256, NCH = T / C2;
constexpr int CAT = 768;
constexpr float LN_EPS = 1e-5f, GN_EPS = 1e-6f, ALPHA = 1.189207115002721f;
constexpr int RT_MAX = (T * TOPK) / 256 + NE;
constexpr int NWAVES = 8, NTHR = 512;

constexpr size_t MiB = 1u << 20;
constexpr size_t WS_CTL = 0, CTL_BYTES = 1 * MiB;
constexpr size_t WS_TAB = 1 * MiB;
constexpr size_t WS_WIN = 2 * MiB;
constexpr size_t WS_WOUT = WS_WIN + 20 * MiB;
constexpr size_t WS_WUP = WS_WOUT + 8 * MiB;
constexpr size_t WS_WDN = WS_WUP + 512 * MiB;
constexpr size_t WS_H0B = WS_WDN + 256 * MiB;
constexpr size_t WS_ST0 = WS_H0B + 64 * MiB;
constexpr size_t WS_UTT = WS_ST0 + 1 * MiB;
constexpr size_t WS_A1 = WS_UTT + 32 * MiB;
constexpr size_t WS_ZT = WS_A1 + 64 * MiB;
constexpr size_t WS_QS = WS_ZT + 64 * MiB;
constexpr size_t WS_KK = WS_QS + 32 * MiB;
constexpr size_t WS_GS = WS_KK + 32 * MiB;
constexpr size_t WS_ACAT = WS_GS + 32 * MiB;
constexpr size_t WS_BCAT = WS_ACAT + 96 * MiB;
constexpr size_t WS_KTW = WS_BCAT + 96 * MiB;
constexpr size_t WS_KVT = WS_KTW + 64 * MiB;
constexpr size_t WS_Y = WS_KVT + 128 * MiB;
constexpr size_t WS_Z1 = WS_Y + 64 * MiB;
constexpr size_t WS_H1B = WS_Z1 + 128 * MiB;
constexpr size_t WS_RT = WS_H1B + 64 * MiB;
constexpr size_t WS_ACT = WS_RT + 4 * MiB;
constexpr size_t WS_YR = WS_ACT + 288 * MiB;
constexpr size_t WS_END = WS_YR + 288 * MiB;
constexpr size_t WS_SWUP = WS_TAB + 512 * 1024;
constexpr size_t WS_H1Q = WS_H1B;
constexpr size_t WS_SX = WS_H1B + 32 * MiB, WS_RSC = WS_H1B + 40 * MiB, WS_SA = WS_H1B + 44 * MiB;
constexpr size_t WS_SWDN = WS_ST0 + 512 * 1024;
constexpr size_t WS_SWIN = WS_ST0 + 768 * 1024;
constexpr size_t WS_SX0 = WS_H0B + 40 * MiB;
constexpr size_t WS_WRT = WS_ACT;
constexpr size_t WS_ACTQ = WS_END;
constexpr size_t WS_END2 = WS_ACTQ + 144 * MiB;
constexpr int CW_RMAX = 16384;
constexpr int CW_BAR = 1024;
constexpr int CW_CNT = 8192;

constexpr int LDS_STAGE = 131072, LDS_SCR = 16384, LDS_CTL_OFF = LDS_STAGE + LDS_SCR, LDS_BYTES = LDS_CTL_OFF + 2048;

__device__ __forceinline__ unsigned cvt_pk_bf16(float lo, float hi) { unsigned r; asm volatile("v_cvt_pk_bf16_f32 %0, %1, %2" : "=v"(r) : "v"(lo), "v"(hi)); return r; }
__device__ __forceinline__ float bf_lo(unsigned u) { return __builtin_bit_cast(float, u << 16); }
__device__ __forceinline__ float bf_hi(unsigned u) { return __builtin_bit_cast(float, u & 0xffff0000u); }
__device__ __forceinline__ v4u pack8(const f32x4 a, const f32x4 b) { v4u w; w.x = cvt_pk_bf16(a[0], a[1]); w.y = cvt_pk_bf16(a[2], a[3]); w.z = cvt_pk_bf16(b[0], b[1]); w.w = cvt_pk_bf16(b[2], b[3]); return w; }
__device__ __forceinline__ float wave_sum(float v) {
#pragma unroll
    for (int o = 1; o < 64; o <<= 1) v += __shfl_xor(v, o);
    return v;
}
__device__ __forceinline__ int lane_id() { int l; asm volatile("v_mbcnt_lo_u32_b32 %0, -1, 0\n\tv_mbcnt_hi_u32_b32 %0, -1, %0" : "=v"(l)); return l; }
__device__ __forceinline__ float fexp(float x) { return __builtin_amdgcn_exp2f(x * 1.4426950408889634f); }
__device__ __forceinline__ void cs_rev(float rev, float& c, float& s) { const float f = __builtin_amdgcn_fractf(rev); c = __builtin_amdgcn_cosf(f); s = __builtin_amdgcn_sinf(f); }

#define XB_TMO      128
#define XB_XCNT(j)  (256  + 64 * (j))
#define XB_XSUB(j)  (1280 + 64 * (j))
#define XB_XGEN(j)  (2304 + 64 * (j))
#define XB_TOP      3328
#define XB_TOPGEN   3392
#define XCD_BAR_WORDS 3456
#define XB_SPIN_CAP (1u << 18)
__device__ __forceinline__ unsigned xb_ld(unsigned* p)              { return __hip_atomic_load(p, __ATOMIC_RELAXED, __HIP_MEMORY_SCOPE_AGENT); }
__device__ __forceinline__ unsigned xb_add(unsigned* p, unsigned v) { return __hip_atomic_fetch_add(p, v, __ATOMIC_RELAXED, __HIP_MEMORY_SCOPE_AGENT); }
__device__ __forceinline__ unsigned xb_xcc_id() { return (unsigned)__builtin_amdgcn_s_getreg((3 << 11) | 20) & 0xFu; }
#define XB_SPIN(cond, bar) do { unsigned _sp = 0; while (cond) { __builtin_amdgcn_s_sleep(1); \
    if ((++_sp & 255u) == 0u) { if (xb_ld(&(bar)[XB_TMO])) break; if (_sp > XB_SPIN_CAP) { atomicAdd(&(bar)[XB_TMO], 1u); break; } } } } while (0)
struct XcdBarrier { unsigned* bar; unsigned x; volatile LAS unsigned* st; int wave; };
__device__ __forceinline__ XcdBarrier xcd_barrier_post(unsigned* bar, volatile LAS unsigned* st) {
    XcdBarrier b; b.bar = bar; b.x = xb_xcc_id(); b.st = st;
    if (threadIdx.x == 0) (void)xb_add(&bar[XB_XCNT(b.x)], 1u);
    return b;
}
__device__ __forceinline__ void xcd_barrier_complete(unsigned* bar, unsigned x, unsigned& nloc, unsigned& nx) {
    const unsigned G = gridDim.x * gridDim.y * gridDim.z;
    unsigned sum, cnt, mine, sp = 0u;
    for (;;) {
        sum = 0u; cnt = 0u; mine = 0u;
#pragma unroll
        for (unsigned j = 0; j < 16; ++j) { const unsigned c = xb_ld(&bar[XB_XCNT(j)]); sum += c; cnt += (c > 0u) ? 1u : 0u; mine = (j == x) ? c : mine; }
        if (sum == G) break;
        __builtin_amdgcn_s_sleep(1);
        if ((++sp & 255u) == 0u) { if (xb_ld(&bar[XB_TMO])) break; if (sp > XB_SPIN_CAP) { atomicAdd(&bar[XB_TMO], 1u); break; } }
    }
    nloc = mine > 0u ? mine : 1u; nx = cnt > 0u ? cnt : 1u;
}
__device__ __forceinline__ void xcd_barrier(const XcdBarrier& b) {
    asm volatile("s_waitcnt vmcnt(0)" ::: "memory");
    __syncthreads();
    if (b.wave == 0 && lane_id() == 0) {
        unsigned* bar = b.bar;
        __builtin_amdgcn_s_waitcnt(0);
        unsigned nloc = b.st[0], nx = b.st[1];
        if (nloc == 0u) { xcd_barrier_complete(bar, b.x, nloc, nx); b.st[0] = nloc; b.st[1] = nx; }
        const unsigned old = xb_add(&bar[XB_XSUB(b.x)], 1u);
        const unsigned gen = old / nloc;
        if (old + 1u == (gen + 1u) * nloc) {
            __builtin_amdgcn_fence(__ATOMIC_RELEASE, "agent");
            asm volatile("s_waitcnt vmcnt(0)" ::: "memory");
            const unsigned og = xb_add(&bar[XB_TOP], 1u);
            const unsigned tg = og / nx;
            if (og + 1u == (tg + 1u) * nx) xb_add(&bar[XB_TOPGEN], 1u);
            else XB_SPIN(xb_ld(&bar[XB_TOPGEN]) == tg, bar);
            __builtin_amdgcn_fence(__ATOMIC_ACQUIRE, "agent");
            xb_add(&bar[XB_XGEN(b.x)], 1u);
            asm volatile("s_waitcnt vmcnt(0)" ::: "memory");
        } else {
            XB_SPIN(xb_ld(&bar[XB_XGEN(b.x)]) == gen, bar);
            __builtin_amdgcn_fence(__ATOMIC_ACQUIRE, "agent");
            asm volatile("s_waitcnt vmcnt(0)" ::: "memory");
        }
    }
    __syncthreads();
}

namespace gm {
constexpr int BM = 256, BK = 64, HALF = 128, HTB = HALF * BK * 2, STAGE_BYTES = 8 * HTB;
__device__ __forceinline__ int lds_byte(int r, int c) { const int st = (r >> 4) * 2 + (c >> 5), rr = r & 15, cc = c & 31, ob = rr * 64 + cc * 2; return st * 1024 + (ob ^ (((ob >> 9) & 1) << 5)); }
__device__ __forceinline__ void stage_rc(int b, int& R, int& C) { const int st = b / 1024, sb = b % 1024, swz = sb ^ (((sb >> 9) & 1) << 5); R = (st >> 1) * 16 + swz / 64; C = (st & 1) * 32 + (swz % 64) / 2; }
__device__ __forceinline__ int perm32(int rho) { const int n = rho >> 4, i = rho & 15; return 8 * (i >> 2) + 4 * n + (i & 3); }

struct Unit { const char* a0; const char* a1; const char* b0; const char* b1; int p0, p1, p2, p3, q; };

__device__ __forceinline__ void tile_order(int L, int nM, int nN, int& pm, int& pn) {
    const int nwg = nM * nN; int wgid = L;
    { const int q = nwg / 8, r = nwg % 8, xcd = wgid % 8, off = wgid / 8; wgid = (xcd < r ? xcd * (q + 1) : r * (q + 1) + (xcd - r) * q) + off; }
    const int nig = 8 * nN, gid = wgid / nig, fm = gid * 8, gsz = (nM - fm) < 8 ? (nM - fm) : 8;
    pm = fm + ((wgid % nig) % gsz); pn = (wgid % nig) / gsz;
}

template <int I8> struct AccSel { typedef f32x4 type; };
template <> struct AccSel<1> { typedef i32x4 type; };
template <class Epi, class Sched, bool GATHER, int I8 = 0, bool PREF = false>
__device__ __forceinline__ void gemm_run(LAS unsigned char* lds, const Sched& S, const Epi& E) {
    const int wid = S.wv, lane = lane_id(), tid = wid * 64 + lane, wr = wid >> 2, wc = wid & 3, fr = lane & 15, fq = lane >> 4;
    int nt = S.nt; asm volatile("" : "+s"(nt));
    unsigned voffA[2], voffB[2], colA[2]; int rowA[2];
#pragma unroll
    for (int i = 0; i < 2; ++i) { int R, C; stage_rc(tid * 16 + i * 8192, R, C); const int Rb = Epi::PERM ? ((R & ~31) + perm32(R & 31)) : R;
        voffA[i] = (unsigned)(R * S.multA * S.pitchA + C) * 2u; voffB[i] = (unsigned)(Rb * S.multB * S.pitchB + C) * 2u; colA[i] = (unsigned)C * 2u; rowA[i] = R; }
    const size_t kstep = (size_t)(BK * 2);
    const unsigned ldsw = (unsigned)wid * 1024u;
    const int aoff = lds_byte(wr * 64 + fr, fq * 8), boff = lds_byte(wc * 32 + fr, fq * 8);
#define G_SA(b, h) (((b) * 2 + (h)) * HTB)
#define G_SB(b, h) ((4 + (b) * 2 + (h)) * HTB)
#define G_STAGE(bufoff, gbase, voff) do { _Pragma("unroll") for (int _i = 0; _i < 2; ++_i) \
        __builtin_amdgcn_global_load_lds((const unsigned*)((const char*)(gbase) + (voff)[_i]), (LAS unsigned*)(lds + (bufoff) + ldsw + _i * 8192), 16, 0, 0); } while (0)
#define G_LD8(dst, addr) do { const i32x4 lo_ = *(const LAS i32x4*)(addr), hi_ = *(const LAS i32x4*)((addr) + 1024); dst = __builtin_shufflevector(lo_, hi_, 0, 1, 2, 3, 4, 5, 6, 7); } while (0)
#define G_LDA(dst, b, h) do { _Pragma("unroll") for (int m = 0; m < 4; ++m) G_LD8(dst[m], lds + G_SA(b, h) + aoff + m * 2048); } while (0)
#define G_LDB(dst, b, h) do { _Pragma("unroll") for (int n = 0; n < 2; ++n) G_LD8(dst[n], lds + G_SB(b, h) + boff + n * 2048); } while (0)
#define G_H4(x, k) ((k) ? __builtin_shufflevector(x, x, 4, 5, 6, 7) : __builtin_shufflevector(x, x, 0, 1, 2, 3))
#define G_MMA(ai, bj, At, Bt) do { __builtin_amdgcn_s_setprio(1); _Pragma("unroll") for (int m = 0; m < 4; ++m) _Pragma("unroll") for (int n = 0; n < 2; ++n) { \
        if constexpr (I8 == 2) acc[ai][bj][m][n] = __builtin_amdgcn_mfma_scale_f32_16x16x128_f8f6f4(Bt[n], At[m], acc[ai][bj][m][n], 0, 0, 0, 0x7F7F7F7F, 0, 0x7F7F7F7F); \
        else { _Pragma("unroll") for (int k = 0; k < 2; ++k) { \
            if constexpr (I8 == 1) acc[ai][bj][m][n] = __builtin_amdgcn_mfma_i32_16x16x64_i8(G_H4(Bt[n], k), G_H4(At[m], k), acc[ai][bj][m][n], 0, 0, 0); \
            else acc[ai][bj][m][n] = __builtin_amdgcn_mfma_f32_16x16x32_bf16(__builtin_bit_cast(bf16x8, G_H4(Bt[n], k)), __builtin_bit_cast(bf16x8, G_H4(At[m], k)), acc[ai][bj][m][n], 0, 0, 0); } } } \
        __builtin_amdgcn_s_setprio(0); } while (0)
#define G_WAIT_V(n) asm volatile("s_waitcnt vmcnt(" #n ")" ::: "memory")
#define G_WAIT_L(n) asm volatile("s_waitcnt lgkmcnt(" #n ")" ::: "memory")
#define G_BAR __builtin_amdgcn_s_barrier()
#define G_SCHED __builtin_amdgcn_sched_barrier(0)
    Unit cur, nxt; int ui = 0;
    if (!S.next(0, cur)) return;
    cur.q = 0;
    if constexpr (PREF) { S.prefetch(cur, lds); G_WAIT_V(0); G_BAR; }
    typedef typename AccSel<I8>::type acc_t;
    acc_t acc[2][2][4][2];
#pragma unroll
    for (int a = 0; a < 2; ++a)
#pragma unroll
        for (int b = 0; b < 2; ++b)
#pragma unroll
            for (int m = 0; m < 4; ++m)
#pragma unroll
                for (int n = 0; n < 2; ++n) acc[a][b][m][n] = (acc_t){0, 0, 0, 0};
    i32x8 At[4], B0[2], B1[2];
    unsigned gc0[2], gc1[2];
    if constexpr (GATHER) {
#pragma unroll
        for (int i = 0; i < 2; ++i) { gc0[i] = S.row_off(cur, rowA[i], lds) + colA[i]; gc1[i] = S.row_off(cur, 128 + rowA[i], lds) + colA[i]; }
    }
#define vA0 (GATHER ? gc0 : voffA)
#define vA1 (GATHER ? gc1 : voffA)
    G_STAGE(G_SB(0, 0), cur.b0, voffB); G_STAGE(G_SB(0, 1), cur.b1, voffB); G_STAGE(G_SA(0, 0), cur.a0, vA0); G_STAGE(G_SA(0, 1), cur.a1, vA1);
    if (wr == 1) G_BAR;
    G_WAIT_V(2); G_BAR;
    G_STAGE(G_SB(1, 0), cur.b0 + kstep, voffB); G_STAGE(G_SA(1, 0), cur.a0 + kstep, vA0); G_STAGE(G_SB(1, 1), cur.b1 + kstep, voffB);
    G_WAIT_V(6); G_BAR;
    for (;;) {
        const bool has_next = S.next(ui + 1, nxt);
        if (!has_next) nxt = cur;
        nxt.q = (ui + 1) & 1;
        for (int t = 0; t < nt; t += 2) {
            const bool last = (t == nt - 2);
            { const int tz_ = wid * 64 + lane_id();
#pragma unroll
              for (int i = 0; i < 2; ++i) { int R, C; stage_rc(tz_ * 16 + i * 8192, R, C); const int Rb = Epi::PERM ? ((R & ~31) + perm32(R & 31)) : R;
                  voffA[i] = (unsigned)(R * S.multA * S.pitchA + C) * 2u; voffB[i] = (unsigned)(Rb * S.multB * S.pitchB + C) * 2u; } }
            if constexpr (GATHER) asm volatile("" : "+v"(gc0[0]), "+v"(gc0[1]), "+v"(gc1[0]), "+v"(gc1[1]));
            if constexpr (PREF) { if (t == nt - 4) S.prefetch(nxt, lds); }
            const char* a11 = cur.a1 + (size_t)(t + 1) * kstep;
            const char* a02 = last ? nxt.a0 : cur.a0 + (size_t)(t + 2) * kstep; const char* a12 = last ? nxt.a1 : cur.a1 + (size_t)(t + 2) * kstep;
            const char* b02 = last ? nxt.b0 : cur.b0 + (size_t)(t + 2) * kstep; const char* b12 = last ? nxt.b1 : cur.b1 + (size_t)(t + 2) * kstep;
            G_LDB(B0, 0, 0); G_LDB(B1, 0, 1); G_SCHED; G_LDA(At, 0, 0); G_STAGE(G_SA(1, 1), a11, vA1);
            if constexpr (GATHER) { if (last) { int tz = tid; asm volatile("" : "+v"(tz));
#pragma unroll
                for (int i = 0; i < 2; ++i) { int R, C; stage_rc(tz * 16 + i * 8192, R, C); gc0[i] = S.row_off(nxt, R, lds) + (unsigned)C * 2u; gc1[i] = S.row_off(nxt, 128 + R, lds) + (unsigned)C * 2u; } } }
            G_WAIT_V(8); G_WAIT_L(0); G_BAR; G_MMA(0, 0, At, B0); G_MMA(0, 1, At, B1); G_BAR; G_SCHED;
            G_LDA(At, 0, 1); G_STAGE(G_SB(0, 0), b02, voffB); G_STAGE(G_SB(0, 1), b12, voffB); G_STAGE(G_SA(0, 0), a02, vA0);
            G_WAIT_V(8); G_WAIT_L(0); G_BAR; G_MMA(1, 0, At, B0); G_MMA(1, 1, At, B1); G_BAR; G_SCHED;
            G_LDB(B0, 1, 0); G_LDB(B1, 1, 1); G_SCHED; G_LDA(At, 1, 0); G_STAGE(G_SA(0, 1), a12, vA1);
            G_WAIT_V(8); G_WAIT_L(0); G_BAR; G_MMA(0, 0, At, B0); G_MMA(0, 1, At, B1); G_BAR; G_SCHED;
            G_LDA(At, 1, 1); G_STAGE(G_SB(1, 0), b02 + kstep, voffB); G_STAGE(G_SB(1, 1), b12 + kstep, voffB); G_STAGE(G_SA(1, 0), a02 + kstep, vA0);
            G_WAIT_V(8); G_WAIT_L(0); G_BAR; G_MMA(1, 0, At, B0); G_MMA(1, 1, At, B1); G_BAR; G_SCHED;
        }
        if (wr == 0) G_BAR;
        { int fr2 = fr, fq2 = fq; asm volatile("" : "+v"(fr2), "+v"(fq2));
          E(acc, cur, lds, wr, wc, fr2, fq2); }
        if (!has_next) break;
#pragma unroll
        for (int a = 0; a < 2; ++a)
#pragma unroll
            for (int b = 0; b < 2; ++b)
#pragma unroll
                for (int m = 0; m < 4; ++m)
#pragma unroll
                    for (int n = 0; n < 2; ++n) acc[a][b][m][n] = (acc_t){0, 0, 0, 0};
        cur = nxt; ++ui;
        if (wr == 1) G_BAR;
    }
    G_WAIT_V(0);
    G_BAR;
#undef G_SA
#undef G_SB
#undef G_STAGE
#undef G_LDA
#undef G_LD8
#undef G_H4
#undef G_LDB
#undef G_MMA
#undef G_WAIT_V
#undef G_WAIT_L
#undef G_BAR
#undef G_SCHED
#undef vA0
#undef vA1
}
}
using gm::Unit;
typedef f32x4 Acc[2][2][4][2];
typedef i32x4 AccI[2][2][4][2];

struct Args { const float* in[18]; float* out; unsigned char* ws; int ph_lo, ph_hi; };
struct Frame {
    LAS unsigned char* lds; unsigned char* ws; unsigned* ctl;
    int wave, vcu, G;
    const float *x, *ln0_g, *ln0_b, *w_in, *dec_f, *dec_b, *gn_g, *w_out, *ln1_g, *ln1_b, *w_r, *b_r, *w_up, *b_up, *w_dn, *b_dn, *ln2_g, *ln2_b;
    float* out;
};
#define WSP(T_, off) ((T_*)(F.ws + (off)))
#define FLANE lane_id()
#define FTID (F.wave * 64 + lane_id())

template <class ColMap>
__device__ __forceinline__ void transpose_item(const float* W, int K, int N, bf16* WT, LAS float* scr, int item, int lane, const ColMap& cm) {
    const int nblk = N / 64, kb = item / nblk, nb = item % nblk, k0 = 64 * kb, n0 = 64 * nb;
    const int s0 = cm(n0);
#pragma unroll 4
    for (int i = 0; i < 16; ++i) { const int kk = 4 * i + (lane >> 4), c4 = (lane & 15) * 4;
        const f32x4 v = *(const GAS f32x4*)(W + (size_t)(k0 + kk) * N + s0 + c4);
        LAS float* d = scr + kk * 65 + c4; d[0] = v[0]; d[1] = v[1]; d[2] = v[2]; d[3] = v[3]; }
    LDS_WAIT(); asm volatile("" ::: "memory");
    const int c = lane & 7;
#pragma unroll
    for (int j = 0; j < 8; ++j) { const int n = (lane >> 3) + 8 * j; const LAS float* s = scr + (8 * c) * 65 + n;
        v4u o; o.x = cvt_pk_bf16(s[0 * 65], s[1 * 65]); o.y = cvt_pk_bf16(s[2 * 65], s[3 * 65]); o.z = cvt_pk_bf16(s[4 * 65], s[5 * 65]); o.w = cvt_pk_bf16(s[6 * 65], s[7 * 65]);
        *(GAS v4u*)(WT + (size_t)(n0 + n) * K + k0 + 8 * c) = o; }
    LDS_WAIT(); asm volatile("" ::: "memory");
}
struct ColId { __device__ __forceinline__ int operator()(int n) const { return n; } };
struct ColUp { __device__ __forceinline__ int operator()(int n) const { return ((n >> 8) * 128 + (n & 127)) + ((n >> 7) & 1) * 2048; } };

__device__ __forceinline__ void p0_prologue(Frame& F) {
    const int gw = F.vcu * NWAVES + F.wave, NGW = F.G * NWAVES;
    {
        unsigned* h0q = WSP(unsigned, WS_H0B); float* st0 = WSP(float, WS_ST0); float* sx0 = WSP(float, WS_SX0);
        for (int m = gw; m < T; m += NGW) {
            const GAS f32x4* xr = (const GAS f32x4*)(F.x + (size_t)m * D) + FLANE;
            f32x4 v[8]; float s = 0.f;
#pragma unroll
            for (int j = 0; j < 8; ++j) { v[j] = xr[64 * j]; s += (v[j][0] + v[j][1]) + (v[j][2] + v[j][3]); }
            const float mean = wave_sum(s) * (1.f / D); float s2 = 0.f;
#pragma unroll
            for (int j = 0; j < 8; ++j) { v[j] = v[j] - mean; s2 += (v[j][0] * v[j][0] + v[j][1] * v[j][1]) + (v[j][2] * v[j][2] + v[j][3] * v[j][3]); }
            const float rstd = 1.f / sqrtf(wave_sum(s2) * (1.f / D) + LN_EPS); float am = 0.f;
#pragma unroll
            for (int j = 0; j < 8; ++j) { const f32x4 g = *((const GAS f32x4*)F.ln0_g + FLANE + 64 * j), b = *((const GAS f32x4*)F.ln0_b + FLANE + 64 * j);
                v[j] = v[j] * rstd * g + b; am = fmaxf(am, fmaxf(fmaxf(fabsf(v[j][0]), fabsf(v[j][1])), fmaxf(fabsf(v[j][2]), fabsf(v[j][3])))); }
#pragma unroll
            for (int o = 1; o < 64; o <<= 1) am = fmaxf(am, __shfl_xor(am, o));
            const float sc = am > 0.f ? am * (1.f / 127.f) : 1.f, inv = 1.f / sc;
#pragma unroll
            for (int j = 0; j < 8; ++j) { const int q0 = (int)__builtin_rintf(v[j][0] * inv), q1 = (int)__builtin_rintf(v[j][1] * inv), q2 = (int)__builtin_rintf(v[j][2] * inv), q3 = (int)__builtin_rintf(v[j][3] * inv);
                h0q[(size_t)m * (D / 4) + FLANE + 64 * j] = (unsigned)(q0 & 0xff) | ((unsigned)(q1 & 0xff) << 8) | ((unsigned)(q2 & 0xff) << 16) | ((unsigned)(q3 & 0xff) << 24); }
            if (FLANE == 0) { st0[2 * m] = mean; st0[2 * m + 1] = rstd; sx0[m] = sc; }
        }
    }
    {
        bf16* tab = WSP(bf16, WS_TAB);
        for (int i = (F.vcu * NTHR + FTID); i < 32768 + 65536 + 65536; i += F.G * NTHR) {
            float v;
            if (i < 32768) { const int r = i >> 7, a = i & 127, ri = r >> 7, k1 = r & 127; float c, s; cs_rev((float)((k1 * a) & 127) * (1.f / 128.f), c, s); v = ri ? -s : c; }
            else if (i < 32768 + 65536) { const int e = i - 32768, r = e >> 8, q = e & 255, ri = r >> 7, k2 = r & 127, rj = q >> 7, b = q & 127; float c, s; cs_rev((float)((k2 * b) & 127) * (1.f / 128.f), c, s);
                v = (ri == 0) ? (rj == 0 ? c : s) : (rj == 0 ? -s : c); }
            else { const int e = i - 32768 - 65536, l = e >> 8, q = e & 255, rj = q >> 7, cg = q & 127; float c, s; cs_rev((float)((l * cg) & 127) * (1.f / 128.f), c, s); v = (l < 128) ? (rj == 0 ? c : s) : 0.f; }
            tab[i] = (bf16)(cvt_pk_bf16(v, 0.f) & 0xffffu);
        }
        bf16* wrt = WSP(bf16, WS_WRT);
        for (int i = (F.vcu * NTHR + FTID); i < NE * D; i += F.G * NTHR) { const int e = i >> 11, k = i & 2047; const float v = F.w_r[k * NE + e];
            const unsigned hi = cvt_pk_bf16(v, 0.f) & 0xffffu; const unsigned lo = cvt_pk_bf16(v - bf_lo(hi), 0.f) & 0xffffu; wrt[i] = (bf16)hi; wrt[NE * D + i] = (bf16)lo; }
    }
    {
        LAS float* scr = (LAS float*)(F.lds + F.wave * 18432);
        constexpr int I_IN = 32 * (DIN / 64), I_OUT = 32 * (D / 64), I_UP = 32 * (2 * DFF / 64), I_DN = 32 * (D / 64);
        constexpr int NIT = I_OUT;
        for (int it = gw; it < NIT; it += NGW) {
            int r = it;
            { transpose_item(F.w_out, D, D, WSP(bf16, WS_WOUT), scr, r, FLANE, ColId()); }
        }
    }
}

struct SlabDesc { const float* W; signed char* WQ; float* sw; int NS, e, n0, valid, fp8; };
struct QF { unsigned char* ws; const float* w_up; const float* w_dn; const float* w_in; int vcu, G; };
__device__ __forceinline__ SlabDesc slab_desc(const QF& F, int j) {
    const int nD = (NE * 64 + F.G - 1) / F.G; SlabDesc d;
    if (j < 0) { const int sl = F.vcu + (-1 - j) * F.G; d.valid = sl < DIN / 32; d.NS = DIN; d.e = 0; d.n0 = sl * 32; d.W = F.w_in + d.n0; d.WQ = (signed char*)WSP(char, WS_WIN); d.sw = WSP(float, WS_SWIN); d.fp8 = 0; }
    else if (j >= nD) { const int sl = F.vcu + (j - nD) * F.G; d.valid = sl < NE * 128; d.NS = 2 * DFF; d.e = sl >> 7; d.n0 = (sl & 127) * 32; d.W = F.w_up + (size_t)d.e * D * 2 * DFF + ColUp()(d.n0); d.WQ = (signed char*)WSP(char, WS_WUP); d.sw = WSP(float, WS_SWUP); d.fp8 = 0; }
    else { const int sl = F.vcu + j * F.G; d.valid = sl < NE * 64; d.NS = D; d.e = sl >> 6; d.n0 = (sl & 63) * 32; d.W = F.w_dn + (size_t)d.e * DFF * D + d.n0; d.WQ = (signed char*)WSP(char, WS_WDN); d.sw = WSP(float, WS_SWDN); d.fp8 = 1; }
    return d;
}
#define SLAB_LOAD(dsc, v) do { if ((dsc).valid) { const GAS char* b_ = (const GAS char*)(dsc).W; unsigned o_ = (unsigned)((wave * 256 + kq) * (dsc).NS + c4) * 4u; const unsigned st_ = (unsigned)(dsc).NS * 32u; \
    _Pragma("unroll") for (int i_ = 0; i_ < 32; ++i_) { v[i_] = __builtin_nontemporal_load((const GAS f32x4*)(b_ + o_)); o_ += st_; } } } while (0)
__device__ __forceinline__ void do_slabs_impl(LAS unsigned char* lds, unsigned char* ws, const float* w_up, const float* w_dn, const float* w_in, int vcu, int G, int wave, int j0, int j1) {
    if (j0 >= j1) return;
    QF F; F.ws = ws; F.w_up = w_up; F.w_dn = w_dn; F.w_in = w_in; F.vcu = vcu; F.G = G;
    const int lane = lane_id(), tid = wave * 64 + lane;
    constexpr int PITCH = 2056;
    LAS bf16* slab = (LAS bf16*)lds;
    LAS float* red = (LAS float*)(lds + 32 * PITCH * 2);
    const int kq = lane >> 3, c4 = (lane & 7) * 4;
    f32x4 v[32];
    SlabDesc cur = slab_desc(F, j0);
    SLAB_LOAD(cur, v);
    for (int j = j0; j < j1; ++j) {
        if (cur.valid) {
            f32x4 mx = (f32x4){0.f, 0.f, 0.f, 0.f};
#pragma unroll
            for (int i = 0; i < 32; ++i) { const int k = wave * 256 + i * 8 + kq; const f32x4 x = v[i];
                mx[0] = fmaxf(mx[0], fabsf(x[0])); mx[1] = fmaxf(mx[1], fabsf(x[1])); mx[2] = fmaxf(mx[2], fabsf(x[2])); mx[3] = fmaxf(mx[3], fabsf(x[3]));
                const unsigned p01 = cvt_pk_bf16(x[0], x[1]), p23 = cvt_pk_bf16(x[2], x[3]);
                const int ks = k ^ (((c4 >> 3) & 3) << 3);
                slab[(c4 + 0) * PITCH + ks] = (bf16)(p01 & 0xffffu); slab[(c4 + 1) * PITCH + ks] = (bf16)(p01 >> 16); slab[(c4 + 2) * PITCH + ks] = (bf16)(p23 & 0xffffu); slab[(c4 + 3) * PITCH + ks] = (bf16)(p23 >> 16); }
#pragma unroll
            for (int q = 0; q < 4; ++q) { float m = mx[q]; m = fmaxf(m, __shfl_xor(m, 8)); m = fmaxf(m, __shfl_xor(m, 16)); m = fmaxf(m, __shfl_xor(m, 32)); mx[q] = m; }
            if (lane < 8) { LAS float* d = red + wave * 32 + c4; d[0] = mx[0]; d[1] = mx[1]; d[2] = mx[2]; d[3] = mx[3]; }
        }
        const SlabDesc done = cur;
        if (j + 1 < j1) { cur = slab_desc(F, j + 1); SLAB_LOAD(cur, v); }
        __syncthreads();
        if (done.valid && tid < 32) { float m = 0.f;
#pragma unroll
            for (int w = 0; w < 8; ++w) m = fmaxf(m, red[w * 32 + tid]);
            const float sc = m > 0.f ? m * (done.fp8 ? (1.f / 448.f) : (1.f / 127.f)) : 1.f; done.sw[(size_t)done.e * done.NS + done.n0 + tid] = sc; red[256 + tid] = 1.f / sc; }
        __syncthreads();
        if (done.valid) {
#pragma unroll 2
            for (int i = 0; i < 8; ++i) { const int q = tid + NTHR * i, n = q >> 7, kc = q & 127; const float inv = red[256 + n];
                const int sx_ = ((n >> 3) & 3) << 3;
                const v4u a = *(const LAS v4u*)(slab + n * PITCH + ((kc * 16) ^ sx_)), b = *(const LAS v4u*)(slab + n * PITCH + ((kc * 16 + 8) ^ sx_));
                const unsigned src[8] = {a.x, a.y, a.z, a.w, b.x, b.y, b.z, b.w}; unsigned o[4];
                if (done.fp8) {
#pragma unroll
                    for (int d = 0; d < 4; ++d) { int w = __builtin_amdgcn_cvt_pk_fp8_f32(bf_lo(src[2 * d]) * inv, bf_hi(src[2 * d]) * inv, 0, false);
                        w = __builtin_amdgcn_cvt_pk_fp8_f32(bf_lo(src[2 * d + 1]) * inv, bf_hi(src[2 * d + 1]) * inv, w, true); o[d] = (unsigned)w; }
                } else {
#pragma unroll
                for (int d = 0; d < 4; ++d) { unsigned w = 0u;
#pragma unroll
                    for (int h2 = 0; h2 < 2; ++h2) { const unsigned u2 = src[2 * d + h2]; const int q0 = (int)__builtin_rintf(bf_lo(u2) * inv), q1 = (int)__builtin_rintf(bf_hi(u2) * inv);
                        w |= ((unsigned)(q0 & 0xff) << (16 * h2)) | ((unsigned)(q1 & 0xff) << (16 * h2 + 8)); }
                    o[d] = w; }
                }
                *(GAS v4u*)(done.WQ + ((size_t)done.e * done.NS + done.n0 + n) * D + kc * 16) = (v4u){o[0], o[1], o[2], o[3]}; }
        }
        __syncthreads();
    }
}

__device__ __forceinline__ void do_slabs(Frame& F, int j0, int j1) { do_slabs_impl(F.lds, F.ws, F.w_up, F.w_dn, F.w_in, F.vcu, F.G, F.wave, j0, j1); }

struct SchedBase { int nt, pitchA, pitchB, multA, multB, G, c, wv; };
struct SchedG1N : SchedBase {
    const char* A; const char* Bt;
    __device__ __forceinline__ bool next(int i, Unit& u) const { const int L = i * G + c; if (L >= 64 * 12) return false; int pm, pn; gm::tile_order(L, 64, 12, pm, pn);
        const int cb = pn < 4 ? 1024 + 256 * pn : (pn < 8 ? 2048 + 256 * (pn - 4) : 4096 + 256 * (pn - 8));
        u.a0 = A + (size_t)pm * 256 * D; u.a1 = u.a0 + (size_t)128 * D; u.b0 = Bt + (size_t)cb * D; u.b1 = u.b0 + (size_t)128 * D; u.p0 = pm; u.p1 = pn; u.p2 = cb; u.p3 = 0; return true; }
};
struct SchedG1SF : SchedBase {
    const char* A; const char* Bt;
    __device__ __forceinline__ bool next(int i, Unit& u) const { const int L = i * G + c; if (L >= 4 * 64) return false; int pm, pn; gm::tile_order(L, 4, 64, pm, pn);
        u.a0 = A + (size_t)pm * 256 * D; u.a1 = u.a0 + (size_t)128 * D; u.b0 = Bt + (size_t)(2 * pn) * D; u.b1 = u.b0 + (size_t)D; u.p0 = pm; u.p1 = pn; u.p2 = 0; u.p3 = 0; return true; }
};
struct SchedG1SKV : SchedBase {
    const char* A; const char* Bt;
    __device__ __forceinline__ bool next(int i, Unit& u) const { const int L = i * G + c; if (L >= 8 * 64) return false; int pm, pn; gm::tile_order(L, 8, 64, pm, pn);
        const int rb = pm < 4 ? 2048 + 256 * pm : 3072 + 256 * (pm - 4);
        u.a0 = A + (size_t)rb * D; u.a1 = u.a0 + (size_t)128 * D; u.b0 = Bt + (size_t)pn * 256 * D; u.b1 = u.b0 + (size_t)128 * D; u.p0 = pm; u.p1 = pn; u.p2 = rb; u.p3 = 0; return true; }
};
struct SchedFixA : SchedBase {
    const char* A; const char* Bt; int ncol;
    __device__ __forceinline__ bool next(int i, Unit& u) const { const int L = i * G + c; if (L >= ncol) return false;
        u.a0 = A; u.a1 = A + (size_t)128 * pitchA * 2; u.b0 = Bt + (size_t)L * 256 * pitchB * 2; u.b1 = u.b0 + (size_t)128 * pitchB * 2; u.p0 = 0; u.p1 = L; u.p2 = 0; u.p3 = 0; return true; }
};
struct SchedFixB : SchedBase {
    const char* A; const char* Bt; int nrow;
    __device__ __forceinline__ bool next(int i, Unit& u) const { const int L = i * G + c; if (L >= nrow) return false;
        u.a0 = A + (size_t)L * 256 * pitchA * 2; u.a1 = u.a0 + (size_t)128 * pitchA * 2; u.b0 = Bt; u.b1 = Bt + (size_t)128 * pitchB * 2; u.p0 = L; u.p1 = 0; u.p2 = 0; u.p3 = 0; return true; }
};
struct SchedScores : SchedBase {
    const char* Q; const char* Kk;
    __device__ __forceinline__ bool next(int i, Unit& u) const { const int L = i * G + c; if (L >= NH * NCH) return false; const int h = L & 3, n = L >> 2;
        u.a0 = Q + ((size_t)n * 256 * RW + h * HD) * 2; u.a1 = u.a0 + (size_t)128 * RW * 2; u.b0 = Kk + ((size_t)n * 256 * RW + h * HD) * 2; u.b1 = u.b0 + (size_t)128 * RW * 2; u.p0 = h; u.p1 = n; u.p2 = 0; u.p3 = 0; return true; }
};
struct SchedKV : SchedBase {
    const char* Bcat; const char* kTw;
    __device__ __forceinline__ bool next(int i, Unit& u) const { const int L = i * G + c; if (L >= 2 * NH * NCH) return false; const int dh = L & 7, n = L >> 3, dir = dh >> 2, h = dh & 3;
        u.a0 = Bcat + ((size_t)(h * NCH + n) * 256 * CAT) * 2; u.a1 = u.a0 + (size_t)128 * CAT * 2;
        u.b0 = kTw + (((size_t)dir * RW + h * HD) * T + (size_t)n * 256) * 2; u.b1 = u.b0 + (size_t)128 * T * 2; u.p0 = dh; u.p1 = n; u.p2 = 0; u.p3 = 0; return true; }
};
struct SchedOut : SchedBase {
    const char* Acat; const char* Bcat;
    __device__ __forceinline__ bool next(int i, Unit& u) const { const int L = i * G + c; if (L >= NH * NCH) return false; const int h = L & 3, n = L >> 2;
        u.a0 = Acat + ((size_t)h * T + (size_t)n * 256) * CAT * 2; u.a1 = u.a0 + (size_t)128 * CAT * 2; u.b0 = Bcat + ((size_t)(h * NCH + n) * 256 * CAT) * 2; u.b1 = u.b0 + (size_t)128 * CAT * 2; u.p0 = h; u.p1 = n; u.p2 = 0; u.p3 = 0; return true; }
};
struct Sched2D : SchedBase {
    const char* A; const char* Bt; int nM, nN;
    __device__ __forceinline__ bool next(int i, Unit& u) const { const int L = i * G + c; if (L >= nM * nN) return false; int pm, pn; gm::tile_order(L, nM, nN, pm, pn);
        u.a0 = A + (size_t)pm * 256 * pitchA * 2; u.a1 = u.a0 + (size_t)128 * pitchA * 2; u.b0 = Bt + (size_t)pn * 256 * pitchB * 2; u.b1 = u.b0 + (size_t)128 * pitchB * 2; u.p0 = pm; u.p1 = pn; u.p2 = 0; u.p3 = 0; return true; }
};
struct SchedMoE : SchedBase {
    const char* A; const char* Bt; const LAS int* tstart; const int* row_tok; const unsigned* cnt; int nN, rowbytes; size_t estride;
    __device__ __forceinline__ bool next(int i, Unit& u) const { const int RT = __builtin_amdgcn_readfirstlane(tstart[NE]); const int L = i * G + c; if (L >= RT * nN) return false; int rt, pn; gm::tile_order(L, RT, nN, rt, pn);
        const int e = __builtin_amdgcn_readfirstlane(tstart[40 + rt]);
        u.b0 = Bt + (size_t)e * estride + (size_t)pn * 256 * rowbytes; u.b1 = u.b0 + (size_t)128 * rowbytes;
        u.a0 = A; u.a1 = A;
        u.p0 = rt; u.p1 = pn; u.p2 = e; u.p3 = (rt - __builtin_amdgcn_readfirstlane(tstart[e])) * 256; return true; }
    __device__ __forceinline__ bool next_tab(int i, Unit& u) const { const int w = (i < 64) ? __builtin_amdgcn_readfirstlane(tstart[400 + i]) : -1; if (w < 0) return false;
        const int rt = w & 1023, pn = (w >> 10) & 31, e = (w >> 15) & 31;
        u.b0 = Bt + (size_t)e * estride + (size_t)pn * 256 * rowbytes; u.b1 = u.b0 + (size_t)128 * rowbytes; u.a0 = A; u.a1 = A;
        u.p0 = rt; u.p1 = pn; u.p2 = e; u.p3 = (rt - __builtin_amdgcn_readfirstlane(tstart[e])) * 256; return true; }
    const float *rsc, *swup, *b_up;
    __device__ __forceinline__ void prefetch(const Unit& u, LAS unsigned char* lds) const {
        LAS unsigned char* blk = lds + LDS_STAGE + u.q * 4096;
        const int wid = wv, e = u.p2; int lane = lane_id(); asm volatile("" : "+v"(lane));
        const int n = (int)cnt[64 * e]; int pos = u.p3 + (wid & 3) * 64 + lane; pos = pos < n ? pos : n - 1;
        if (wid < 4) __builtin_amdgcn_global_load_lds((const unsigned*)(row_tok + (size_t)e * T + pos), (LAS unsigned*)(blk + wid * 256), 4, 0, 0);
        else __builtin_amdgcn_global_load_lds((const unsigned*)(rsc + (size_t)e * T + pos), (LAS unsigned*)(blk + 1024 + (wid - 4) * 256), 4, 0, 0);
        if (wid == 0) __builtin_amdgcn_global_load_lds((const unsigned*)(swup + (size_t)e * 2 * DFF + u.p1 * 256 + lane * 4), (LAS unsigned*)(blk + 2048), 16, 0, 0);
        if (wid == 1) __builtin_amdgcn_global_load_lds((const unsigned*)(b_up + (size_t)e * 2 * DFF + u.p1 * 128 + (lane & 31) * 4 + (lane >> 5) * DFF), (LAS unsigned*)(blk + 3072), 16, 0, 0);
    }
    __device__ __forceinline__ unsigned row_off(const Unit& u, int r, LAS unsigned char* lds) const { return (unsigned)((const LAS int*)(lds + LDS_STAGE + u.q * 4096))[r] * (unsigned)rowbytes; }
};
struct SchedMoEUpT : SchedMoE { __device__ __forceinline__ bool next(int i, Unit& u) const { return next_tab(i, u); } };
struct SchedMoEDown : SchedMoE {
    const float *sa, *swdn, *b_dn;
    __device__ __forceinline__ bool next(int i, Unit& u) const { if (!SchedMoE::next_tab(i, u)) return false; u.a0 = A + (size_t)u.p0 * 256 * rowbytes; u.a1 = u.a0 + (size_t)128 * rowbytes; return true; }
    __device__ __forceinline__ void prefetch(const Unit& u, LAS unsigned char* lds) const {
        LAS unsigned char* blk = lds + LDS_STAGE + u.q * 4096;
        const int wid = wv, e = u.p2; int lane = lane_id(); asm volatile("" : "+v"(lane));
        if (wid == 1) __builtin_amdgcn_global_load_lds((const unsigned*)(swdn + (size_t)e * D + u.p1 * 256 + lane * 4), (LAS unsigned*)(blk + 1024), 16, 0, 0);
        if (wid == 2) __builtin_amdgcn_global_load_lds((const unsigned*)(b_dn + (size_t)e * D + u.p1 * 256 + lane * 4), (LAS unsigned*)(blk + 2048), 16, 0, 0);
    }
};

#define EPI_LOOP_AM for (int ai = 0; ai < 2; ++ai) _Pragma("unroll") for (int m = 0; m < 4; ++m)
#define EPI_FENCE __builtin_amdgcn_sched_barrier(0)
struct EpiG1N {
    static constexpr bool PERM = true;
    bf16 *qs, *kk, *gs, *Acat; const float *dec_f, *dec_b, *sx0, *swin;
    __device__ __forceinline__ void operator()(AccI& acci, const Unit& u, LAS unsigned char*, int wr, int wc, int fr, int fq) const {
        const int pm = u.p0, pn = u.p1, c0 = wc * 32 + 8 * fq;
        f32x4 swc[2][2];
#pragma unroll
        for (int bj = 0; bj < 2; ++bj)
#pragma unroll
            for (int n = 0; n < 2; ++n) swc[bj][n] = *(const GAS f32x4*)(swin + u.p2 + 128 * bj + c0 + 4 * n);
#define ACCF(ai_, bj_, m_, n_, j_) ((float)acci[ai_][bj_][m_][n_][j_] * (sxr * swc[bj_][n_][j_]))
        if (pn < 8) {
            const int h = pn & 3; const bool isq = pn < 4;
            float inv[8];
#pragma unroll
            for (int e = 0; e < 8; ++e) inv[e] = __builtin_amdgcn_exp2f(-(float)(c0 + e) * (13.287712379549449f / 128.f)) * 0.15915494309189535f;
            const float lgf = -fexp(dec_f[h]), lgb = -fexp(dec_b[h]);
#pragma unroll
            EPI_LOOP_AM {
                const int r = 128 * ai + 64 * wr + 16 * m + fr, tok = pm * 256 + r; const float pos = (float)tok; const float sxr = sx0[tok];
                f32x4 o1[2], o2[2];
#pragma unroll
                for (int n = 0; n < 2; ++n)
#pragma unroll
                    for (int j = 0; j < 4; ++j) { float c, s; cs_rev(pos * inv[4 * n + j], c, s); const float x1 = ACCF(ai, 0, m, n, j), x2 = ACCF(ai, 1, m, n, j); o1[n][j] = x1 * c - x2 * s; o2[n][j] = x2 * c + x1 * s; }
                if (isq) {
                    bf16* q = qs + (size_t)tok * RW + h * HD + c0; *(GAS v4u*)q = pack8(o1[0], o1[1]); *(GAS v4u*)(q + 128) = pack8(o2[0], o2[1]);
                    const int il = r; const float wf = fexp(lgf * (float)(il + 1)), wb = fexp(lgb * (float)(255 - il));
                    bf16* a = Acat + ((size_t)h * T + tok) * CAT + c0;
                    *(GAS v4u*)(a + 256) = pack8(o1[0] * wf, o1[1] * wf); *(GAS v4u*)(a + 384) = pack8(o2[0] * wf, o2[1] * wf);
                    *(GAS v4u*)(a + 512) = pack8(o1[0] * wb, o1[1] * wb); *(GAS v4u*)(a + 640) = pack8(o2[0] * wb, o2[1] * wb);
                } else {
                    bf16* k = kk + (size_t)tok * RW + h * HD + c0; *(GAS v4u*)k = pack8(o1[0] * 0.0625f, o1[1] * 0.0625f); *(GAS v4u*)(k + 128) = pack8(o2[0] * 0.0625f, o2[1] * 0.0625f);
                }
            }
        } else {
#pragma unroll
            EPI_LOOP_AM {
                const int r = 128 * ai + 64 * wr + 16 * m + fr, tok = pm * 256 + r; const float sxr = sx0[tok];
#pragma unroll
                for (int bj = 0; bj < 2; ++bj) { f32x4 v[2];
#pragma unroll
                    for (int n = 0; n < 2; ++n)
#pragma unroll
                        for (int j = 0; j < 4; ++j) { const float g = ACCF(ai, bj, m, n, j); v[n][j] = g * __builtin_amdgcn_rcpf(1.f + fexp(-g)); }
                    *(GAS v4u*)(gs + (size_t)tok * RW + (pn - 8) * 256 + bj * 128 + c0) = pack8(v[0], v[1]); }
            }
        }
    }
};
#undef ACCF
struct EpiG1SF {
    static constexpr bool PERM = true;
    bf16* uTT; const float *sx0, *swin;
    __device__ __forceinline__ void operator()(AccI& acc, const Unit& u, LAS unsigned char*, int wr, int wc, int fr, int fq) const {
        const int a0 = wc * 32 + 8 * fq;
        float sxc[2][8];
#pragma unroll
        for (int bj = 0; bj < 2; ++bj)
#pragma unroll
            for (int e = 0; e < 8; ++e) sxc[bj][e] = sx0[128 * (a0 + e) + 2 * u.p1 + bj];
#pragma unroll
        EPI_LOOP_AM { const int cch = u.p0 * 256 + 128 * ai + 64 * wr + 16 * m + fr; const float swr = swin[cch];
#pragma unroll
            for (int bj = 0; bj < 2; ++bj) { f32x4 v0, v1;
#pragma unroll
                for (int j = 0; j < 4; ++j) { v0[j] = (float)acc[ai][bj][m][0][j] * (swr * sxc[bj][j]); v1[j] = (float)acc[ai][bj][m][1][j] * (swr * sxc[bj][4 + j]); }
                *(GAS v4u*)(uTT + ((size_t)cch * 128 + (2 * u.p1 + bj)) * 128 + a0) = pack8(v0, v1); } }
    }
};
struct EpiG1SKV {
    static constexpr bool PERM = true;
    bf16 *kTw, *Bcat; const float *dec_f, *dec_b, *sx0, *swin;
    __device__ __forceinline__ void operator()(AccI& acc, const Unit& u, LAS unsigned char*, int wr, int wc, int fr, int fq) const {
        const int pm = u.p0, n_ch = u.p1, c0 = wc * 32 + 8 * fq;
        f32x4 sxc[2][2];
#pragma unroll
        for (int bj = 0; bj < 2; ++bj)
#pragma unroll
            for (int n = 0; n < 2; ++n) sxc[bj][n] = *(const GAS f32x4*)(sx0 + n_ch * 256 + 128 * bj + c0 + 4 * n);
        if (pm < 4) {
            const int h = pm; const float lgf = -fexp(dec_f[h]), lgb = -fexp(dec_b[h]);
#pragma unroll
            for (int m = 0; m < 4; ++m) {
                const int d = 64 * wr + 16 * m + fr;
                const float sw1 = swin[u.p2 + d], sw2 = swin[u.p2 + 128 + d];
                const float inv = __builtin_amdgcn_exp2f(-(float)d * (13.287712379549449f / 128.f)) * 0.15915494309189535f;
#pragma unroll
                for (int bj = 0; bj < 2; ++bj) {
                    f32x4 f1[2], f2[2], b1[2], b2[2];
#pragma unroll
                    for (int n = 0; n < 2; ++n)
#pragma unroll
                        for (int j = 0; j < 4; ++j) { const int il = 128 * bj + c0 + 4 * n + j; const float pos = (float)(n_ch * 256 + il); float c, s; cs_rev(pos * inv, c, s);
                            const float x1 = (float)acc[0][bj][m][n][j] * (sw1 * sxc[bj][n][j]), x2 = (float)acc[1][bj][m][n][j] * (sw2 * sxc[bj][n][j]); const float o1 = (x1 * c - x2 * s) * 0.0625f, o2 = (x2 * c + x1 * s) * 0.0625f;
                            const float wf = fexp(lgf * (float)(255 - il)), wb = fexp(lgb * (float)(il + 1));
                            f1[n][j] = o1 * wf; f2[n][j] = o2 * wf; b1[n][j] = o1 * wb; b2[n][j] = o2 * wb; }
                    const size_t tcol = (size_t)n_ch * 256 + 128 * bj + c0;
                    bf16* pf = kTw + ((size_t)(h * HD + d)) * T + tcol; bf16* pb = pf + (size_t)RW * T;
                    *(GAS v4u*)pf = pack8(f1[0], f1[1]); *(GAS v4u*)(pf + (size_t)128 * T) = pack8(f2[0], f2[1]);
                    *(GAS v4u*)pb = pack8(b1[0], b1[1]); *(GAS v4u*)(pb + (size_t)128 * T) = pack8(b2[0], b2[1]);
                }
            }
        } else {
            const int h = pm - 4;
#pragma unroll
            EPI_LOOP_AM { const int dv = 128 * ai + 64 * wr + 16 * m + fr; const float swr = swin[u.p2 + dv];
#pragma unroll
                for (int bj = 0; bj < 2; ++bj) { f32x4 v0, v1;
#pragma unroll
                    for (int j = 0; j < 4; ++j) { v0[j] = (float)acc[ai][bj][m][0][j] * (swr * sxc[bj][0][j]); v1[j] = (float)acc[ai][bj][m][1][j] * (swr * sxc[bj][1][j]); }
                    *(GAS v4u*)(Bcat + ((size_t)(h * NCH + n_ch) * 256 + dv) * CAT + 128 * bj + c0) = pack8(v0, v1); } }
        }
    }
};
struct EpiS1 {
    static constexpr bool PERM = true;
    bf16* A1;
    __device__ __forceinline__ void operator()(Acc& acc, const Unit& u, LAS unsigned char*, int wr, int wc, int fr, int fq) const {
        const int b0 = wc * 32 + 8 * fq;
#pragma unroll
        for (int m = 0; m < 4; ++m) { const int k1 = 64 * wr + 16 * m + fr;
#pragma unroll
            for (int bj = 0; bj < 2; ++bj) { const int cch = 2 * u.p1 + bj; f32x4 re[2], im[2];
#pragma unroll
                for (int n = 0; n < 2; ++n)
#pragma unroll
                    for (int j = 0; j < 4; ++j) { const int b = b0 + 4 * n + j; float c, s; cs_rev((float)(k1 * b) * (1.f / 16384.f), c, s);
                        const float xr = acc[0][bj][m][n][j], xi = acc[1][bj][m][n][j]; re[n][j] = xr * c + xi * s; im[n][j] = xi * c - xr * s; }
                bf16* p = A1 + (((size_t)k1 * 1024 + cch) * 2) * 128 + b0;
                *(GAS v4u*)p = pack8(re[0], re[1]); *(GAS v4u*)(p + 128) = pack8(im[0], im[1]); EPI_FENCE; } }
    }
};
struct EpiS2 {
    static constexpr bool PERM = true;
    bf16* Zt;
    __device__ __forceinline__ void operator()(Acc& acc, const Unit& u, LAS unsigned char*, int wr, int wc, int fr, int fq) const {
        const int k1 = u.p1 >> 2, cb = (u.p1 & 3) * 256, c0 = wc * 32 + 8 * fq;
#pragma unroll
        EPI_LOOP_AM { const int k2 = 64 * wr + 16 * m + fr, k = k1 + 128 * k2;
#pragma unroll
            for (int bj = 0; bj < 2; ++bj) { const int cch = cb + 128 * bj + c0, g = cch >> 7, cg = cch & 127;
                *(GAS v4u*)(Zt + (size_t)k * 2048 + g * 256 + ai * 128 + cg) = pack8(acc[ai][bj][m][0], acc[ai][bj][m][1]); } }
    }
};
struct EpiChan {
    static constexpr bool PERM = true;
    bf16* y;
    __device__ __forceinline__ void operator()(Acc& acc, const Unit& u, LAS unsigned char*, int wr, int wc, int fr, int fq) const {
        const int l0 = wc * 32 + 8 * fq; const float norm = 6.9053396600248786e-4f;
#pragma unroll
        EPI_LOOP_AM { const int R = u.p0 * 256 + 128 * ai + 64 * wr + 16 * m + fr, k = R >> 3, g = R & 7;
            *(GAS v4u*)(y + (size_t)k * D + g * 128 + l0) = pack8(acc[ai][0][m][0] * norm, acc[ai][0][m][1] * norm); }
    }
};
struct EpiScores {
    static constexpr bool PERM = true;
    bf16* Acat; const float *dec_f, *dec_b;
    __device__ __forceinline__ void operator()(Acc& acc, const Unit& u, LAS unsigned char*, int wr, int wc, int fr, int fq) const {
        const int h = u.p0, n_ch = u.p1, c0 = wc * 32 + 8 * fq; const float lgf = -fexp(dec_f[h]), lgb = -fexp(dec_b[h]);
#pragma unroll
        EPI_LOOP_AM { const int i = 128 * ai + 64 * wr + 16 * m + fr;
#pragma unroll
            for (int bj = 0; bj < 2; ++bj) { f32x4 v[2];
#pragma unroll
                for (int n = 0; n < 2; ++n)
#pragma unroll
                    for (int j = 0; j < 4; ++j) { const int jc = 128 * bj + c0 + 4 * n + j; const float dd = (float)(i - jc); const float w = (jc <= i) ? fexp(lgf * dd) : fexp(-lgb * dd); v[n][j] = acc[ai][bj][m][n][j] * w; }
                *(GAS v4u*)(Acat + ((size_t)h * T + n_ch * 256 + i) * CAT + 128 * bj + c0) = pack8(v[0], v[1]); EPI_FENCE; } }
    }
};
struct EpiKV {
    static constexpr bool PERM = true;
    bf16* kvT;
    __device__ __forceinline__ void operator()(Acc& acc, const Unit& u, LAS unsigned char*, int wr, int wc, int fr, int fq) const {
#pragma unroll
        EPI_LOOP_AM { const int dv = 128 * ai + 64 * wr + 16 * m + fr; bf16* rowp = kvT + (((size_t)u.p0 * NCH + u.p1) * 256 + dv) * 256 + wc * 32 + 8 * fq;
#pragma unroll
            for (int bj = 0; bj < 2; ++bj) *(GAS v4u*)(rowp + bj * 128) = pack8(acc[ai][bj][m][0], acc[ai][bj][m][1]); }
    }
};
struct EpiOut {
    static constexpr bool PERM = true;
    bf16* y; const bf16* gs; const float* gn_g;
    __device__ __forceinline__ void operator()(Acc& acc, const Unit& u, LAS unsigned char* lds, int wr, int wc, int fr, int fq) const {
        const int h = u.p0, n_ch = u.p1, c0 = wc * 32 + 8 * fq;
        LAS f32x2* P = (LAS f32x2*)(lds + LDS_STAGE);
#pragma unroll
        EPI_LOOP_AM {
            float s = 0.f;
#pragma unroll
            for (int bj = 0; bj < 2; ++bj)
#pragma unroll
                for (int n = 0; n < 2; ++n) { const f32x4 x = acc[ai][bj][m][n]; s += (x[0] + x[1]) + (x[2] + x[3]); }
            s += __shfl_xor(s, 16); s += __shfl_xor(s, 32);
            const float mw = s * (1.f / 64.f); float q = 0.f;
#pragma unroll
            for (int bj = 0; bj < 2; ++bj)
#pragma unroll
                for (int n = 0; n < 2; ++n) { const f32x4 d = acc[ai][bj][m][n] - mw; q += (d[0] * d[0] + d[1] * d[1]) + (d[2] * d[2] + d[3] * d[3]); }
            q += __shfl_xor(q, 16); q += __shfl_xor(q, 32);
            if (fq == 0) P[(128 * ai + 64 * wr + 16 * m + fr) * 4 + wc] = (f32x2){mw, q};
        }
        LDS_WAIT(); __builtin_amdgcn_s_barrier(); asm volatile("" ::: "memory");
#pragma unroll
        EPI_LOOP_AM {
            const int r = 128 * ai + 64 * wr + 16 * m + fr, tok = n_ch * 256 + r;
            const f32x2 a = P[r * 4 + 0], b = P[r * 4 + 1], c = P[r * 4 + 2], d = P[r * 4 + 3];
            const float mt = (a.x + b.x + c.x + d.x) * 0.25f; const float da = a.x - mt, db = b.x - mt, dc = c.x - mt, dd = d.x - mt;
            const float m2 = (a.y + b.y) + (c.y + d.y) + 64.f * ((da * da + db * db) + (dc * dc + dd * dd));
            const float rstd = 1.f / sqrtf(m2 * (1.f / 256.f) + GN_EPS);
#pragma unroll
            for (int bj = 0; bj < 2; ++bj) {
                const int col = h * HD + 128 * bj + c0; const v4u gv = *(const GAS v4u*)(gs + (size_t)tok * RW + col);
                const f32x4 g0 = *(const GAS f32x4*)(gn_g + col), g1 = *(const GAS f32x4*)(gn_g + col + 4);
                f32x4 o0 = (acc[ai][bj][m][0] - mt) * rstd * g0, o1 = (acc[ai][bj][m][1] - mt) * rstd * g1;
                o0[0] *= bf_lo(gv.x); o0[1] *= bf_hi(gv.x); o0[2] *= bf_lo(gv.y); o0[3] *= bf_hi(gv.y); o1[0] *= bf_lo(gv.z); o1[1] *= bf_hi(gv.z); o1[2] *= bf_lo(gv.w); o1[3] *= bf_hi(gv.w);
                *(GAS v4u*)(y + (size_t)tok * D + FW + col) = pack8(o0, o1); }
        }
        LDS_WAIT(); __builtin_amdgcn_s_barrier(); asm volatile("" ::: "memory");
    }
};
struct EpiWout {
    static constexpr bool PERM = true;
    bf16* z1; const float *x, *st0, *g0, *b0;
    __device__ __forceinline__ void operator()(Acc& acc, const Unit& u, LAS unsigned char*, int wr, int wc, int fr, int fq) const {
        const int colb = u.p1 * 256 + wc * 32 + 8 * fq;
#pragma unroll
        for (int bj = 0; bj < 2; ++bj) { const int col = colb + bj * 128;
            const f32x4 ga = *(const GAS f32x4*)(g0 + col), gb = *(const GAS f32x4*)(g0 + col + 4), ba = *(const GAS f32x4*)(b0 + col), bb = *(const GAS f32x4*)(b0 + col + 4);
#pragma unroll
            EPI_LOOP_AM { const int row = u.p0 * 256 + 128 * ai + 64 * wr + 16 * m + fr; const f32x2 st = *(const GAS f32x2*)(st0 + 2 * row); const size_t off = (size_t)row * D + col;
                const f32x4 xa = *(const GAS f32x4*)(x + off), xb = *(const GAS f32x4*)(x + off + 4);
                *(GAS v4u*)(z1 + off) = pack8(((xa - st.x) * st.y * ga + ba) * ALPHA + acc[ai][bj][m][0], ((xb - st.x) * st.y * gb + bb) * ALPHA + acc[ai][bj][m][1]); } }
    }
};
struct EpiUp {
    static constexpr bool PERM = true;
    unsigned char* act8;
    __device__ __forceinline__ void operator()(AccI& acc, const Unit& u, LAS unsigned char* lds, int wr, int wc, int fr, int fq) const {
        const int rt = u.p0, pn = u.p1, c0 = pn * 128 + wc * 32 + 8 * fq;
        const LAS float* blk = (const LAS float*)(lds + LDS_STAGE + u.q * 4096);
        float sx[2][4];
#pragma unroll
        EPI_LOOP_AM sx[ai][m] = blk[256 + 128 * ai + 64 * wr + 16 * m + fr];
#pragma unroll
        for (int n = 0; n < 2; ++n) {
            const int cc = wc * 32 + 8 * fq + 4 * n;
            const f32x4 sg = *(const LAS f32x4*)(blk + 512 + cc), sl = *(const LAS f32x4*)(blk + 512 + 128 + cc), bg = *(const LAS f32x4*)(blk + 768 + cc), bl = *(const LAS f32x4*)(blk + 768 + 128 + cc);
#pragma unroll
            EPI_LOOP_AM { const int r = 128 * ai + 64 * wr + 16 * m + fr; f32x2 v2[2];
#pragma unroll
                for (int jp = 0; jp < 2; ++jp) {
                    const f32x2 sx2 = (f32x2){sx[ai][m], sx[ai][m]};
                    f32x2 gl = (f32x2){(float)acc[ai][0][m][n][2 * jp], (float)acc[ai][0][m][n][2 * jp + 1]} * (sx2 * (f32x2){sg[2 * jp], sg[2 * jp + 1]}) + (f32x2){bg[2 * jp], bg[2 * jp + 1]};
                    f32x2 li = (f32x2){(float)acc[ai][1][m][n][2 * jp], (float)acc[ai][1][m][n][2 * jp + 1]} * (sx2 * (f32x2){sl[2 * jp], sl[2 * jp + 1]}) + (f32x2){bl[2 * jp], bl[2 * jp + 1]};
                    gl = __builtin_elementwise_min(gl, (f32x2){7.f, 7.f}); li = __builtin_elementwise_min(__builtin_elementwise_max(li, (f32x2){-7.f, -7.f}), (f32x2){7.f, 7.f});
                    const f32x2 ea = gl * (-1.702f * 1.4426950408889634f); f32x2 den; den.x = __builtin_amdgcn_exp2f(ea.x); den.y = __builtin_amdgcn_exp2f(ea.y); den = den + 1.0f;
                    f32x2 rc; rc.x = __builtin_amdgcn_rcpf(den.x); rc.y = __builtin_amdgcn_rcpf(den.y);
                    v2[jp] = (gl * rc) * (li * 4.0f + 4.0f); }
                int p = __builtin_amdgcn_cvt_pk_fp8_f32(v2[0].x, v2[0].y, 0, false); p = __builtin_amdgcn_cvt_pk_fp8_f32(v2[1].x, v2[1].y, p, true);
                *(GAS int*)(act8 + ((size_t)rt * 256 + r) * DFF + c0 + 4 * n) = p; }
        }
    }
};
struct EpiDown {
    static constexpr bool PERM = true;
    unsigned char* yr8;
    __device__ __forceinline__ void operator()(Acc& acc, const Unit& u, LAS unsigned char* lds, int wr, int wc, int fr, int fq) const {
        const int rt = u.p0, pn = u.p1, c0 = pn * 256 + wc * 32 + 8 * fq;
        const LAS float* blk = (const LAS float*)(lds + LDS_STAGE + u.q * 4096);
#pragma unroll
        for (int bj = 0; bj < 2; ++bj) { const int cc = 128 * bj + wc * 32 + 8 * fq;
#pragma unroll
            EPI_LOOP_AM { const int r = 128 * ai + 64 * wr + 16 * m + fr;
                const f32x4 w0 = *(const LAS f32x4*)(blk + 256 + cc) * 0.25f, w1 = *(const LAS f32x4*)(blk + 256 + cc + 4) * 0.25f, b0 = *(const LAS f32x4*)(blk + 512 + cc), b1 = *(const LAS f32x4*)(blk + 512 + cc + 4);
                f32x4 y0 = (acc[ai][bj][m][0] * w0 + b0) * 32.f, y1 = (acc[ai][bj][m][1] * w1 + b1) * 32.f;
#pragma unroll
                for (int j = 0; j < 4; ++j) { y0[j] = fminf(fmaxf(y0[j], -440.f), 440.f); y1[j] = fminf(fmaxf(y1[j], -440.f), 440.f); }
                int p0 = __builtin_amdgcn_cvt_pk_fp8_f32(y0[0], y0[1], 0, false); p0 = __builtin_amdgcn_cvt_pk_fp8_f32(y0[2], y0[3], p0, true);
                int p1 = __builtin_amdgcn_cvt_pk_fp8_f32(y1[0], y1[1], 0, false); p1 = __builtin_amdgcn_cvt_pk_fp8_f32(y1[2], y1[3], p1, true);
                *(GAS v2u*)(yr8 + ((size_t)rt * 256 + r) * D + c0 + 128 * bj) = (v2u){(unsigned)p0, (unsigned)p1}; EPI_FENCE; } }
    }
};

__device__ __forceinline__ void p3_scan(Frame& F) {
    const bf16* kvT = WSP(bf16, WS_KVT); bf16* Bcat = WSP(bf16, WS_BCAT);
    const int NQ = 2 * NH * 256 * 64;
    for (int q = F.vcu * NTHR + FTID; q < NQ; q += F.G * NTHR) {
        const int dk4 = q & 63, dv = (q >> 6) & 255, dh = q >> 14, dir = dh >> 2, h = dh & 3;
        const float lg = -fexp((dir ? F.dec_b : F.dec_f)[h]); const float cd = fexp(lg * (float)C2);
        f32x4 S = (f32x4){0.f, 0.f, 0.f, 0.f};
        for (int s = 0; s < NCH; ++s) { const int n = dir ? (NCH - 1 - s) : s;
            const v2u kw = *(const GAS v2u*)(kvT + (((size_t)dh * NCH + n) * 256 + dv) * 256 + dk4 * 4); const f32x4 kv = (f32x4){bf_lo(kw.x), bf_hi(kw.x), bf_lo(kw.y), bf_hi(kw.y)};
            v2u w; w.x = cvt_pk_bf16(S[0], S[1]); w.y = cvt_pk_bf16(S[2], S[3]);
            *(GAS v2u*)(Bcat + ((size_t)(h * NCH + n) * 256 + dv) * CAT + 256 + dir * 256 + dk4 * 4) = w;
            S = S * cd + kv; }
    }
}

__device__ __forceinline__ void p6_router(Frame& F) {
    const bf16* z1 = WSP(bf16, WS_Z1); unsigned* h1q = WSP(unsigned, WS_H1Q); float* sxg = WSP(float, WS_SX); float* rsc = WSP(float, WS_RSC); float* st1 = WSP(float, WS_ST0) + 2 * T;
    int* topi = WSP(int, WS_RT); float* gate = (float*)(topi + 4 * T); int* posb = (int*)(gate + 4 * T); int* row_tok = posb + 4 * T;
    constexpr int HP = 528;
    LAS unsigned char* Hhi = F.lds;
    LAS unsigned char* Hlo = Hhi + 64 * HP;
    LAS unsigned char* Whi = Hlo + 64 * HP;
    LAS unsigned char* Wlo = Whi + 32 * HP;
    LAS float* stl = (LAS float*)(Wlo + 32 * HP);
    LAS float* lg = stl + 128;
    LAS int* hist = (LAS int*)(lg + 64 * 33);
    LAS float* sxl = (LAS float*)(hist + 64);
    LAS float* part = sxl + 64;
    const bf16* wrt = WSP(bf16, WS_WRT);
    for (int blk = F.vcu; blk < T / 64; blk += F.G) {
        const int t0 = blk * 64;
        {
            v2u raw[8][8]; const int ln_ = FLANE;
#pragma unroll
            for (int rr = 0; rr < 8; ++rr) { const GAS v2u* xr = (const GAS v2u*)(z1 + (size_t)(t0 + F.wave * 8 + rr) * D) + ln_;
#pragma unroll
                for (int j = 0; j < 8; ++j) raw[rr][j] = xr[64 * j]; }
#pragma unroll
            for (int rr = 0; rr < 8; ++rr) { const int row = F.wave * 8 + rr, m = t0 + row;
                f32x4 v[8]; float s = 0.f;
#pragma unroll
                for (int j = 0; j < 8; ++j) { const v2u w = raw[rr][j]; v[j] = (f32x4){bf_lo(w.x), bf_hi(w.x), bf_lo(w.y), bf_hi(w.y)}; s += (v[j][0] + v[j][1]) + (v[j][2] + v[j][3]); }
                const float mean = wave_sum(s) * (1.f / D); float s2 = 0.f;
#pragma unroll
                for (int j = 0; j < 8; ++j) { v[j] = v[j] - mean; s2 += (v[j][0] * v[j][0] + v[j][1] * v[j][1]) + (v[j][2] * v[j][2] + v[j][3] * v[j][3]); }
                const float rstd = 1.f / sqrtf(wave_sum(s2) * (1.f / D) + LN_EPS);
                float am = 0.f;
#pragma unroll
                for (int j = 0; j < 8; ++j) { const f32x4 g = *((const GAS f32x4*)F.ln1_g + FLANE + 64 * j), b = *((const GAS f32x4*)F.ln1_b + FLANE + 64 * j);
                    v[j] = v[j] * rstd * g + b; am = fmaxf(am, fmaxf(fmaxf(fabsf(v[j][0]), fabsf(v[j][1])), fmaxf(fabsf(v[j][2]), fabsf(v[j][3])))); }
#pragma unroll
                for (int o = 1; o < 64; o <<= 1) am = fmaxf(am, __shfl_xor(am, o));
                const float sc = am > 0.f ? am * (1.f / 127.f) : 1.f, inv = 1.f / sc;
#pragma unroll
                for (int j = 0; j < 8; ++j) { const int q0 = (int)__builtin_rintf(v[j][0] * inv), q1 = (int)__builtin_rintf(v[j][1] * inv), q2 = (int)__builtin_rintf(v[j][2] * inv), q3 = (int)__builtin_rintf(v[j][3] * inv);
                    h1q[(size_t)m * (D / 4) + FLANE + 64 * j] = (unsigned)(q0 & 0xff) | ((unsigned)(q1 & 0xff) << 8) | ((unsigned)(q2 & 0xff) << 16) | ((unsigned)(q3 & 0xff) << 24); }
                if (FLANE == 0) { st1[2 * m] = mean; st1[2 * m + 1] = rstd; stl[2 * row] = mean; stl[2 * row + 1] = rstd; sxg[m] = sc; sxl[row] = sc; }
            }
        }
        if (FTID < 64) hist[FTID] = 0;
        __syncthreads();
        const int tt = F.wave & 3, kh = F.wave >> 2; f32x4 ac[2];
        ac[0] = (f32x4){0.f, 0.f, 0.f, 0.f}; ac[1] = (f32x4){0.f, 0.f, 0.f, 0.f};
        v2u zp[8]; v4u wp[4];
#define P6_LOAD(kc_) do { const int ln_ = FLANE; _Pragma("unroll") for (int i_ = 0; i_ < 8; ++i_) zp[i_] = *(const GAS v2u*)(z1 + (size_t)(t0 + F.wave + 8 * i_) * D + (kc_) * 256 + ln_ * 4); \
        _Pragma("unroll") for (int i_ = 0; i_ < 4; ++i_) { const int q_ = F.wave * 64 + ln_ + NTHR * i_; wp[i_] = *(const GAS v4u*)(wrt + (size_t)(q_ >> 5) * D + (kc_) * 256 + (q_ & 31) * 8); } } while (0)
        P6_LOAD(0);
        for (int kc = 0; kc < 8; ++kc) {
            { const int ln = FLANE, col = kc * 256 + ln * 4; const f32x4 g = *(const GAS f32x4*)(F.ln1_g + col), b = *(const GAS f32x4*)(F.ln1_b + col);
#pragma unroll
              for (int i = 0; i < 8; ++i) { const int r = F.wave + 8 * i; const v2u zw = zp[i];
                const f32x4 zv = (f32x4){bf_lo(zw.x), bf_hi(zw.x), bf_lo(zw.y), bf_hi(zw.y)};
                const f32x4 hh = (zv - stl[2 * r]) * stl[2 * r + 1] * g + b;
                v2u hi, lo; hi.x = cvt_pk_bf16(hh[0], hh[1]); hi.y = cvt_pk_bf16(hh[2], hh[3]);
                lo.x = cvt_pk_bf16(hh[0] - bf_lo(hi.x), hh[1] - bf_hi(hi.x)); lo.y = cvt_pk_bf16(hh[2] - bf_lo(hi.y), hh[3] - bf_hi(hi.y));
                *(LAS v2u*)(Hhi + r * HP + ln * 8) = hi; *(LAS v2u*)(Hlo + r * HP + ln * 8) = lo; }
#pragma unroll
              for (int i = 0; i < 4; ++i) { const int q = F.wave * 64 + ln + NTHR * i, e = (q >> 5) & 31, c8 = q & 31; *(LAS v4u*)(((q >> 10) ? Wlo : Whi) + e * HP + c8 * 16) = wp[i]; } }
            __syncthreads();
            if (kc + 1 < 8) P6_LOAD(kc + 1);
            { const int ln = FLANE, fr = ln & 15, fq = ln >> 4;
#pragma unroll
              for (int ks = 0; ks < 4; ++ks) { const int kb = (kh * 128 + ks * 32 + fq * 8) * 2;
                const bf16x8 th = __builtin_bit_cast(bf16x8, *(const LAS i32x4*)(Hhi + (tt * 16 + fr) * HP + kb)), tl = __builtin_bit_cast(bf16x8, *(const LAS i32x4*)(Hlo + (tt * 16 + fr) * HP + kb));
#pragma unroll
                for (int et = 0; et < 2; ++et) { const bf16x8 wh = __builtin_bit_cast(bf16x8, *(const LAS i32x4*)(Whi + (et * 16 + fr) * HP + kb)), wl = __builtin_bit_cast(bf16x8, *(const LAS i32x4*)(Wlo + (et * 16 + fr) * HP + kb));
                    ac[et] = __builtin_amdgcn_mfma_f32_16x16x32_bf16(wh, th, ac[et], 0, 0, 0); ac[et] = __builtin_amdgcn_mfma_f32_16x16x32_bf16(wl, th, ac[et], 0, 0, 0); ac[et] = __builtin_amdgcn_mfma_f32_16x16x32_bf16(wh, tl, ac[et], 0, 0, 0); } } }
            __syncthreads();
        }
#undef P6_LOAD
        { const int ln = FLANE, fr = ln & 15, fq = ln >> 4;
#pragma unroll
          for (int et = 0; et < 2; ++et) *(LAS f32x4*)(part + (kh * 64 + tt * 16 + fr) * 32 + et * 16 + 4 * fq) = ac[et];
          __syncthreads();
          { const int r = FTID >> 3, e0 = (FTID & 7) * 4;
              const f32x4 a = *(const LAS f32x4*)(part + (0 * 64 + r) * 32 + e0), b = *(const LAS f32x4*)(part + (1 * 64 + r) * 32 + e0);
              const f32x4 br = *(const GAS f32x4*)(F.b_r + e0), sum = (a + b) + br; LAS float* d = lg + r * 33 + e0; d[0] = sum[0]; d[1] = sum[1]; d[2] = sum[2]; d[3] = sum[3]; } }
        __syncthreads();
        int ek[4] = {0, 0, 0, 0}, lp[4] = {0, 0, 0, 0}; float gk[4] = {0.f, 0.f, 0.f, 0.f};
        if (FTID < 64) {
            float lv[4]; unsigned used = 0u;
#pragma unroll
            for (int k = 0; k < 4; ++k) { float best = -3.0e38f; int bi = 0;
                for (int e = 0; e < NE; ++e) { const float v = lg[FTID * 33 + e]; const bool ok = !((used >> e) & 1u) && (v > best); best = ok ? v : best; bi = ok ? e : bi; }
                used |= 1u << bi; ek[k] = bi; lv[k] = best; }
            const float mx = lv[0]; float den = 0.f;
#pragma unroll
            for (int k = 0; k < 4; ++k) { gk[k] = fexp(lv[k] - mx); den += gk[k]; }
            const float rd = 1.f / den;
#pragma unroll
            for (int k = 0; k < 4; ++k) { gk[k] *= rd; lp[k] = __hip_atomic_fetch_add(&hist[ek[k]], 1, __ATOMIC_RELAXED, __HIP_MEMORY_SCOPE_WORKGROUP); }
        }
        __syncthreads();
        if (FTID < NE) hist[32 + FTID] = (int)__hip_atomic_fetch_add(F.ctl + CW_CNT + 64 * FTID, (unsigned)hist[FTID], RLX_AGENT);
        __syncthreads();
        if (FTID < 64) { const int tok = t0 + FTID;
#pragma unroll
            for (int k = 0; k < 4; ++k) { const int pos = hist[32 + ek[k]] + lp[k]; row_tok[(size_t)ek[k] * T + pos] = tok; rsc[(size_t)ek[k] * T + pos] = sxl[FTID]; topi[4 * tok + k] = ek[k]; gate[4 * tok + k] = gk[k]; posb[4 * tok + k] = pos; } }
        __syncthreads();
    }
}

__device__ __forceinline__ void build_units(Frame& F, LAS int* tstart, int nN, int c) {
    __syncthreads();
    if (FTID < 64) { const int RT = tstart[NE], L = FTID * F.G + c; int w = -1;
        if (L < RT * nN) { int rt, pn; gm::tile_order(L, RT, nN, rt, pn); w = rt | (pn << 10) | (tstart[40 + rt] << 15); }
        tstart[400 + FTID] = w; }
    __syncthreads();
}

__device__ __forceinline__ void p8_requant(Frame& F, const LAS int* tstart) {
    const bf16* act = WSP(bf16, WS_ACT); unsigned* aq = WSP(unsigned, WS_ACTQ); float* sa = WSP(float, WS_SA); const unsigned* rmax = F.ctl + CW_RMAX;
    const int R = tstart[NE] * 256, gw = F.vcu * NWAVES + F.wave, NGW = F.G * NWAVES;
    for (int row = gw; row < R; row += NGW) {
        const float mx = __uint_as_float(rmax[row]); const float sc = mx > 0.f ? mx * (1.f / 127.f) : 1.f, inv = 1.f / sc;
#pragma unroll
        for (int j = 0; j < 2; ++j) { const int col = 16 * FLANE + 1024 * j;
            const v4u a = *(const GAS v4u*)(act + (size_t)row * DFF + col), b = *(const GAS v4u*)(act + (size_t)row * DFF + col + 8);
            const unsigned src[8] = {a.x, a.y, a.z, a.w, b.x, b.y, b.z, b.w}; unsigned o[4];
#pragma unroll
            for (int d = 0; d < 4; ++d) { unsigned w = 0u;
#pragma unroll
                for (int h2 = 0; h2 < 2; ++h2) { const unsigned u2 = src[2 * d + h2]; int q0 = (int)__builtin_rintf(bf_lo(u2) * inv), q1 = (int)__builtin_rintf(bf_hi(u2) * inv);
                    q0 = q0 > 127 ? 127 : (q0 < -127 ? -127 : q0); q1 = q1 > 127 ? 127 : (q1 < -127 ? -127 : q1);
                    w |= ((unsigned)(q0 & 0xff) << (16 * h2)) | ((unsigned)(q1 & 0xff) << (16 * h2 + 8)); }
                o[d] = w; }
            *(GAS v4u*)(aq + ((size_t)row * DFF + col) / 4) = (v4u){o[0], o[1], o[2], o[3]}; }
        if (FLANE == 0) sa[row] = sc;
    }
}

__device__ __forceinline__ void build_tstart(Frame& F, LAS int* tstart) {
    if (FTID == 0) { int s = 0; for (int e = 0; e < NE; ++e) { tstart[e] = s; const unsigned n = __hip_atomic_load(F.ctl + CW_CNT + 64 * e, RLX_AGENT); s += (int)((n + 255u) >> 8); } tstart[NE] = s; }
    __syncthreads();
    for (int rt = FTID; rt < RT_MAX; rt += NTHR) { int e = 0; for (int j = 1; j < NE; ++j) e += (tstart[j] <= rt) ? 1 : 0; tstart[40 + rt] = e; }
    __syncthreads();
}

__device__ __forceinline__ void p9_combine(Frame& F, const LAS int* tstart) {
    const bf16* z1 = WSP(bf16, WS_Z1); const float* st1 = WSP(float, WS_ST0) + 2 * T; const unsigned char* yr = (const unsigned char*)(F.ws + WS_YR);
    const int* topi = WSP(int, WS_RT); const float* gate = (const float*)(topi + 4 * T); const int* posb = (const int*)(gate + 4 * T);
    const int gw = F.vcu * NWAVES + F.wave, NGW = F.G * NWAVES; const int lane = lane_id();
    for (int m = gw; m < T; m += NGW) {
        const float mean1 = st1[2 * m], rstd1 = st1[2 * m + 1];
        size_t ro[4]; float gk[4];
#pragma unroll
        for (int k = 0; k < 4; ++k) { const int e = topi[4 * m + k]; ro[k] = ((size_t)tstart[e] * 256 + posb[4 * m + k]) * D; gk[k] = gate[4 * m + k]; }
        f32x4 v[8]; float s = 0.f;
#pragma unroll
        for (int j = 0; j < 8; ++j) { const int col = 4 * lane + 256 * j;
            const v2u zw = *(const GAS v2u*)(z1 + (size_t)m * D + col); const f32x4 zv = (f32x4){bf_lo(zw.x), bf_hi(zw.x), bf_lo(zw.y), bf_hi(zw.y)}, g = *(const GAS f32x4*)(F.ln1_g + col), b = *(const GAS f32x4*)(F.ln1_b + col);
            f32x4 a = ((zv - mean1) * rstd1 * g + b) * ALPHA;
#pragma unroll
            for (int k = 0; k < 4; ++k) { const int w = *(const GAS int*)(yr + ro[k] + col); const f32x2 lo = __builtin_amdgcn_cvt_pk_f32_fp8(w, false), hi = __builtin_amdgcn_cvt_pk_f32_fp8(w, true); const float g = gk[k] * (1.f / 32.f);
                a[0] += g * lo.x; a[1] += g * lo.y; a[2] += g * hi.x; a[3] += g * hi.y; }
            v[j] = a; s += (a[0] + a[1]) + (a[2] + a[3]); }
        const float mean = wave_sum(s) * (1.f / D); float s2 = 0.f;
#pragma unroll
        for (int j = 0; j < 8; ++j) { v[j] = v[j] - mean; s2 += (v[j][0] * v[j][0] + v[j][1] * v[j][1]) + (v[j][2] * v[j][2] + v[j][3] * v[j][3]); }
        const float rstd = 1.f / sqrtf(wave_sum(s2) * (1.f / D) + LN_EPS);
#pragma unroll
        for (int j = 0; j < 8; ++j) { const int col = 4 * lane + 256 * j; const f32x4 g = *(const GAS f32x4*)(F.ln2_g + col), b = *(const GAS f32x4*)(F.ln2_b + col);
            *(GAS f32x4*)(F.out + (size_t)m * D + col) = v[j] * rstd * g + b; }
    }
}

constexpr int NPH = 10;
__global__ void __launch_bounds__(NTHR, 2) fwd(Args args) {
    extern __shared__ __attribute__((aligned(16))) unsigned char lds_raw[];
    Frame F;
    F.lds = (LAS unsigned char*)lds_raw; F.ws = args.ws; F.ctl = (unsigned*)(args.ws + WS_CTL);
    F.wave = __builtin_amdgcn_readfirstlane((int)threadIdx.x >> 6);
    F.G = gridDim.x; { const int bx = blockIdx.x; F.vcu = (F.G % 8 == 0) ? (bx % 8) * (F.G / 8) + bx / 8 : bx; }
#define CAS __attribute__((address_space(4)))
#define FRAME_RELOAD() do { const CAS char* kp_ = (const CAS char*)__builtin_amdgcn_kernarg_segment_ptr(); asm volatile("" : "+s"(kp_)); const CAS Args* ap_ = (const CAS Args*)kp_; \
    F.x = ap_->in[0]; F.ln0_g = ap_->in[1]; F.ln0_b = ap_->in[2]; F.w_in = ap_->in[3]; F.dec_f = ap_->in[4]; F.dec_b = ap_->in[5]; F.gn_g = ap_->in[6]; F.w_out = ap_->in[7]; \
    F.ln1_g = ap_->in[8]; F.ln1_b = ap_->in[9]; F.w_r = ap_->in[10]; F.b_r = ap_->in[11]; F.w_up = ap_->in[12]; F.b_up = ap_->in[13]; F.w_dn = ap_->in[14]; F.b_dn = ap_->in[15]; \
    F.ln2_g = ap_->in[16]; F.ln2_b = ap_->in[17]; F.out = ap_->out; F.ws = ap_->ws; F.ctl = (unsigned*)(F.ws + WS_CTL); } while (0)
    FRAME_RELOAD();
    volatile LAS unsigned* lctl = (volatile LAS unsigned*)(F.lds + LDS_CTL_OFF);
    LAS int* tstart = (LAS int*)(F.lds + LDS_CTL_OFF + 64);
    for (int u = FTID; u < 128; u += NTHR) lctl[u] = 0u;
    __syncthreads();
    const int lo = args.ph_lo, hi = args.ph_hi;
    const bool single = (hi - lo) > 1;
    XcdBarrier bar; bar.bar = F.ctl + CW_BAR; bar.x = 0; bar.st = lctl; bar.wave = F.wave;
    if (single) { bar = xcd_barrier_post(F.ctl + CW_BAR, lctl); bar.wave = F.wave; }
#ifndef PH_MASK
#define PH_MASK 0x3ff
#endif
#define IN(k) (((PH_MASK >> (k)) & 1) && lo <= (k) && (k) < hi)
#ifndef SUB_MASK
#define SUB_MASK 0xff
#endif
#define SUB(n) ((SUB_MASK >> (n)) & 1)
#define SEAM(k) do { if (IN(k) && IN((k) + 1)) xcd_barrier(bar); } while (0)
    const int bc = (int)blockIdx.x;

    const int nS = (NE * 128 + F.G - 1) / F.G + (NE * 64 + F.G - 1) / F.G; int sdone = 0; const int qgrp = (int)(blockIdx.x >> 3);
#define QSLOT(k24) do { const int e_ = sdone + (nS * (k24) + 23) / 24; do_slabs(F, sdone, e_ < nS ? e_ : nS); sdone = e_; } while (0)
#define QG(slot, nslots, k24) do { if (qgrp % (nslots) == (slot)) QSLOT(k24); } while (0)
    if (IN(0)) { FRAME_RELOAD(); p0_prologue(F); __syncthreads(); { const int nW = (DIN / 32 + F.G - 1) / F.G; do_slabs(F, -nW, 0); } }
    SEAM(0);
    if (IN(1)) { FRAME_RELOAD();
        QG(0, 4, 9);
        if (SUB(0)) { SchedG1N S; S.nt = D / 128; S.pitchA = D / 2; S.pitchB = D / 2; S.multA = 1; S.multB = 1; S.G = F.G; S.c = bc; S.wv = F.wave; S.A = (const char*)WSP(bf16, WS_H0B); S.Bt = (const char*)WSP(bf16, WS_WIN);
          EpiG1N E{WSP(bf16, WS_QS), WSP(bf16, WS_KK), WSP(bf16, WS_GS), WSP(bf16, WS_ACAT), F.dec_f, F.dec_b, WSP(float, WS_SX0), WSP(float, WS_SWIN)};
          gm::gemm_run<EpiG1N, SchedG1N, false, true>(F.lds, S, E); }
        QG(1, 4, 9);
        if (SUB(1)) { SchedG1SF S; S.nt = D / 128; S.pitchA = D / 2; S.pitchB = D / 2; S.multA = 1; S.multB = 128; S.G = F.G; S.c = bc; S.wv = F.wave; S.A = (const char*)WSP(bf16, WS_WIN); S.Bt = (const char*)WSP(bf16, WS_H0B);
          EpiG1SF E{WSP(bf16, WS_UTT), WSP(float, WS_SX0), WSP(float, WS_SWIN)};
          gm::gemm_run<EpiG1SF, SchedG1SF, false, true>(F.lds, S, E); }
        QG(2, 4, 9);
        if (SUB(2)) { SchedG1SKV S; S.nt = D / 128; S.pitchA = D / 2; S.pitchB = D / 2; S.multA = 1; S.multB = 1; S.G = F.G; S.c = bc; S.wv = F.wave; S.A = (const char*)WSP(bf16, WS_WIN); S.Bt = (const char*)WSP(bf16, WS_H0B);
          EpiG1SKV E{WSP(bf16, WS_KTW), WSP(bf16, WS_BCAT), F.dec_f, F.dec_b, WSP(float, WS_SX0), WSP(float, WS_SWIN)};
          gm::gemm_run<EpiG1SKV, SchedG1SKV, false, true>(F.lds, S, E); }
        QG(3, 4, 9);
    }
    SEAM(1);
    if (IN(2)) { FRAME_RELOAD();
        QG(0, 4, 6);
        if (SUB(3)) { SchedFixA S; S.nt = 2; S.pitchA = 128; S.pitchB = 128; S.multA = 1; S.multB = 1; S.G = F.G; S.c = bc; S.wv = F.wave; S.A = (const char*)WSP(bf16, WS_TAB); S.Bt = (const char*)WSP(bf16, WS_UTT); S.ncol = 512;
          EpiS1 E{WSP(bf16, WS_A1)};
          gm::gemm_run<EpiS1, SchedFixA, false>(F.lds, S, E); }
        QG(1, 4, 6);
        if (SUB(4)) { SchedScores S; S.nt = 4; S.pitchA = RW; S.pitchB = RW; S.multA = 1; S.multB = 1; S.G = F.G; S.c = bc; S.wv = F.wave; S.Q = (const char*)WSP(bf16, WS_QS); S.Kk = (const char*)WSP(bf16, WS_KK);
          EpiScores E{WSP(bf16, WS_ACAT), F.dec_f, F.dec_b};
          gm::gemm_run<EpiScores, SchedScores, false>(F.lds, S, E); }
        QG(2, 4, 6);
        if (SUB(5)) { SchedKV S; S.nt = 4; S.pitchA = CAT; S.pitchB = T; S.multA = 1; S.multB = 1; S.G = F.G; S.c = bc; S.wv = F.wave; S.Bcat = (const char*)WSP(bf16, WS_BCAT); S.kTw = (const char*)WSP(bf16, WS_KTW);
          EpiKV E{WSP(bf16, WS_KVT)};
          gm::gemm_run<EpiKV, SchedKV, false>(F.lds, S, E); }
        QG(3, 4, 6);
    }
    SEAM(2);
    if (IN(3)) { FRAME_RELOAD();
        QG(0, 3, 2);
        { SchedFixA S; S.nt = 4; S.pitchA = 256; S.pitchB = 256; S.multA = 1; S.multB = 1; S.G = F.G; S.c = bc; S.wv = F.wave; S.A = (const char*)(WSP(bf16, WS_TAB) + 32768); S.Bt = (const char*)WSP(bf16, WS_A1); S.ncol = 512;
          EpiS2 E{WSP(bf16, WS_ZT)};
          gm::gemm_run<EpiS2, SchedFixA, false>(F.lds, S, E); }
        QG(1, 3, 2);
        p3_scan(F);
        QG(2, 3, 2);
    }
    SEAM(3);
    if (IN(4)) { FRAME_RELOAD();
        QG(0, 3, 4);
        { SchedFixB S; S.nt = 4; S.pitchA = 256; S.pitchB = 256; S.multA = 1; S.multB = 1; S.G = F.G; S.c = bc; S.wv = F.wave; S.A = (const char*)WSP(bf16, WS_ZT); S.Bt = (const char*)(WSP(bf16, WS_TAB) + 32768 + 65536); S.nrow = 512;
          EpiChan E{WSP(bf16, WS_Y)};
          gm::gemm_run<EpiChan, SchedFixB, false>(F.lds, S, E); }
        QG(1, 3, 4);
        { SchedOut S; S.nt = CAT / 64; S.pitchA = CAT; S.pitchB = CAT; S.multA = 1; S.multB = 1; S.G = F.G; S.c = bc; S.wv = F.wave; S.Acat = (const char*)WSP(bf16, WS_ACAT); S.Bcat = (const char*)WSP(bf16, WS_BCAT);
          EpiOut E{WSP(bf16, WS_Y), WSP(bf16, WS_GS), F.gn_g};
          gm::gemm_run<EpiOut, SchedOut, false>(F.lds, S, E); }
        QG(2, 3, 4);

    }
    SEAM(4);
    if (IN(5)) { FRAME_RELOAD();
        QG(0, 2, 3);
        Sched2D S; S.nt = D / 64; S.pitchA = D; S.pitchB = D; S.multA = 1; S.multB = 1; S.G = F.G; S.c = bc; S.wv = F.wave; S.A = (const char*)WSP(bf16, WS_Y); S.Bt = (const char*)WSP(bf16, WS_WOUT); S.nM = 64; S.nN = 8;
        EpiWout E{WSP(bf16, WS_Z1), F.x, WSP(float, WS_ST0), F.ln0_g, F.ln0_b};
        gm::gemm_run<EpiWout, Sched2D, false>(F.lds, S, E);
        QG(1, 2, 3);
        do_slabs(F, sdone < nS ? sdone : nS, nS);
    }
    SEAM(5);
    if (IN(6)) { FRAME_RELOAD(); p6_router(F); }
    SEAM(6);
    if (IN(7) || IN(8) || IN(9)) build_tstart(F, tstart);
    if (IN(7)) { FRAME_RELOAD();
        build_units(F, tstart, 16, bc);
        SchedMoEUpT S; S.nt = D / 128; S.pitchA = D / 2; S.pitchB = D / 2; S.multA = 1; S.multB = 1; S.G = F.G; S.c = bc; S.wv = F.wave; S.A = (const char*)WSP(char, WS_H1Q); S.Bt = (const char*)WSP(char, WS_WUP);
        S.tstart = tstart; S.row_tok = WSP(int, WS_RT) + 12 * T; S.cnt = F.ctl + CW_CNT; S.nN = 16; S.rowbytes = D; S.estride = (size_t)2 * DFF * D;
        S.rsc = WSP(float, WS_RSC); S.swup = WSP(float, WS_SWUP); S.b_up = F.b_up;
        EpiUp E{(unsigned char*)(F.ws + WS_ACTQ)};
        gm::gemm_run<EpiUp, SchedMoEUpT, true, true, true>(F.lds, S, E);
    }
    SEAM(7);
    if (IN(8)) { FRAME_RELOAD();
        build_units(F, tstart, 8, bc);
        SchedMoEDown S; S.nt = DFF / 128; S.pitchA = DFF / 2; S.pitchB = DFF / 2; S.multA = 1; S.multB = 1; S.G = F.G; S.c = bc; S.wv = F.wave; S.A = (const char*)WSP(char, WS_ACTQ); S.Bt = (const char*)WSP(char, WS_WDN);
        S.tstart = tstart; S.row_tok = nullptr; S.cnt = F.ctl + CW_CNT; S.nN = 8; S.rowbytes = DFF; S.estride = (size_t)D * DFF;
        S.sa = nullptr; S.swdn = WSP(float, WS_SWDN); S.b_dn = F.b_dn; S.rsc = nullptr; S.swup = nullptr; S.b_up = nullptr;
        EpiDown E{(unsigned char*)(F.ws + WS_YR)};
        gm::gemm_run<EpiDown, SchedMoEDown, false, 2, true>(F.lds, S, E);
    }
    SEAM(8);
    if (IN(9)) { FRAME_RELOAD(); p9_combine(F, tstart); }
#undef IN
#undef SEAM
}

#ifndef MK_SPLIT
#define MK_SPLIT 0
#endif
extern "C" void kernel_launch(void* const* d_in, const int* in_sizes, int n_in, void* d_out, int out_size, void* d_ws, size_t ws_size, hipStream_t stream) {
    static int grid = 0;
    if (grid == 0) {
        if (n_in != 18 || out_size != T * D || ws_size < WS_END2) { fprintf(stderr, "kernel_launch: unexpected problem: n_in %d out %d ws %zu (need %zu)\n", n_in, out_size, ws_size, (size_t)WS_END2); grid = -1; return; }
        int dev = 0, cus = 0, per_cu = 0;
        if (hipGetDevice(&dev) != hipSuccess || hipDeviceGetAttribute(&cus, hipDeviceAttributeMultiprocessorCount, dev) != hipSuccess) { grid = -1; return; }
        if (hipFuncSetAttribute((const void*)fwd, hipFuncAttributeMaxDynamicSharedMemorySize, LDS_BYTES) != hipSuccess) { fprintf(stderr, "kernel_launch: hipFuncSetAttribute failed\n"); grid = -1; return; }
        if (hipOccupancyMaxActiveBlocksPerMultiprocessor(&per_cu, (const void*)fwd, NTHR, LDS_BYTES) != hipSuccess || per_cu < 1) { fprintf(stderr, "kernel_launch: occupancy query reports %d\n", per_cu); }
        (void)hipGetLastError();
        grid = cus;
    }
    if (grid < 0) return;
    (void)hipMemsetAsync((char*)d_ws + WS_CTL, 0, CTL_BYTES, stream);
    Args a{};
    for (int i = 0; i < 18; ++i) a.in[i] = (const float*)d_in[i];
    a.out = (float*)d_out; a.ws = (unsigned char*)d_ws;
#if MK_SPLIT
    for (int p = 0; p < NPH; ++p) { a.ph_lo = p; a.ph_hi = p + 1; hipLaunchKernelGGL(fwd, dim3(grid), dim3(NTHR), LDS_BYTES, stream, a); }
#else
    a.ph_lo = 0; a.ph_hi = NPH; hipLaunchKernelGGL(fwd, dim3(grid), dim3(NTHR), LDS_BYTES, stream, a);
#endif
}
```

```cpp
#include <hip/hip_runtime.h>
#include <cstdio>
#include <cstdint>

#define GAS __attribute__((address_space(1)))
#define LAS __attribute__((address_space(3)))
typedef unsigned short bf16;
typedef unsigned v4u __attribute__((ext_vector_type(4)));
typedef unsigned v2u __attribute__((ext_vector_type(2)));
typedef float f32x4 __attribute__((ext_vector_type(4)));
typedef float f32x2 __attribute__((ext_vector_type(2)));
typedef short bf16x8 __attribute__((ext_vector_type(8)));
typedef int i32x4 __attribute__((ext_vector_type(4)));
typedef int i32x8 __attribute__((ext_vector_type(8)));
#define RLX_AGENT __ATOMIC_RELAXED, __HIP_MEMORY_SCOPE_AGENT
#define LDS_WAIT() asm volatile("s_waitcnt lgkmcnt(0)" ::: "memory")
#define VM_WAIT() asm volatile("s_waitcnt vmcnt(0)" ::: "memory")

constexpr int T = 16384, D = 2048, DIN = 5120, FW = 1024, RW = 1024, NH = 4, HD = 256, NE = 32, TOPK = 4, DFF = 2048;
constexpr int C2 = 256, NCH = T / C2;
constexpr int CAT = 768;
constexpr float LN_EPS = 1e-5f, GN_EPS = 1e-6f, ALPHA = 1.189207115002721f;
constexpr int RT_MAX = (T * TOPK) / 256 + NE;
constexpr int NWAVES = 8, NTHR = 512;

constexpr size_t MiB = 1u << 20;
constexpr size_t WS_CTL = 0, CTL_BYTES = 1 * MiB;
constexpr size_t WS_TAB = 1 * MiB;
constexpr size_t WS_WIN = 2 * MiB;
constexpr size_t WS_WOUT = WS_WIN + 20 * MiB;
constexpr size_t WS_WUP = WS_WOUT + 8 * MiB;
constexpr size_t WS_WDN = WS_WUP + 512 * MiB;
constexpr size_t WS_H0B = WS_WDN + 256 * MiB;
constexpr size_t WS_ST0 = WS_H0B + 64 * MiB;
constexpr size_t WS_UTT = WS_ST0 + 1 * MiB;
constexpr size_t WS_A1 = WS_UTT + 32 * MiB;
constexpr size_t WS_ZT = WS_A1 + 64 * MiB;
constexpr size_t WS_QS = WS_ZT + 64 * MiB;
constexpr size_t WS_KK = WS_QS + 32 * MiB;
constexpr size_t WS_GS = WS_KK + 32 * MiB;
constexpr size_t WS_ACAT = WS_GS + 32 * MiB;
constexpr size_t WS_BCAT = WS_ACAT + 96 * MiB;
constexpr size_t WS_KTW = WS_BCAT + 96 * MiB;
constexpr size_t WS_KVT = WS_KTW + 64 * MiB;
constexpr size_t WS_Y = WS_KVT + 128 * MiB;
constexpr size_t WS_Z1 = WS_Y + 64 * MiB;
constexpr size_t WS_H1B = WS_Z1 + 128 * MiB;
constexpr size_t WS_RT = WS_H1B + 64 * MiB;
constexpr size_t WS_ACT = WS_RT + 4 * MiB;
constexpr size_t WS_YR = WS_ACT + 288 * MiB;
constexpr size_t WS_END = WS_YR + 288 * MiB;
constexpr size_t WS_SWUP = WS_TAB + 512 * 1024;
constexpr size_t WS_H1Q = WS_H1B;
constexpr size_t WS_SX = WS_H1B + 32 * MiB, WS_RSC = WS_H1B + 40 * MiB, WS_SA = WS_H1B + 44 * MiB;
constexpr size_t WS_SWDN = WS_ST0 + 512 * 1024;
constexpr size_t WS_SWIN = WS_ST0 + 768 * 1024;
constexpr size_t WS_SX0 = WS_H0B + 40 * MiB;
constexpr size_t WS_WRT = WS_ACT;
constexpr size_t WS_ACTQ = WS_END;
constexpr size_t WS_END2 = WS_ACTQ + 144 * MiB;
constexpr int CW_RMAX = 16384;
constexpr int CW_BAR = 1024;
constexpr int CW_CNT = 8192;

constexpr int LDS_STAGE = 131072, LDS_SCR = 16384, LDS_CTL_OFF = LDS_STAGE + LDS_SCR, LDS_BYTES = LDS_CTL_OFF + 2048;

__device__ __forceinline__ unsigned cvt_pk_bf16(float lo, float hi) { unsigned r; asm volatile("v_cvt_pk_bf16_f32 %0, %1, %2" : "=v"(r) : "v"(lo), "v"(hi)); return r; }
__device__ __forceinline__ float bf_lo(unsigned u) { return __builtin_bit_cast(float, u << 16); }
__device__ __forceinline__ float bf_hi(unsigned u) { return __builtin_bit_cast(float, u & 0xffff0000u); }
__device__ __forceinline__ v4u pack8(const f32x4 a, const f32x4 b) { v4u w; w.x = cvt_pk_bf16(a[0], a[1]); w.y = cvt_pk_bf16(a[2], a[3]); w.z = cvt_pk_bf16(b[0], b[1]); w.w = cvt_pk_bf16(b[2], b[3]); return w; }
__device__ __forceinline__ float wave_sum(float v) {
#pragma unroll
    for (int o = 1; o < 64; o <<= 1) v += __shfl_xor(v, o);
    return v;
}
__device__ __forceinline__ int lane_id() { int l; asm volatile("v_mbcnt_lo_u32_b32 %0, -1, 0\n\tv_mbcnt_hi_u32_b32 %0, -1, %0" : "=v"(l)); return l; }
__device__ __forceinline__ float fexp(float x) { return __builtin_amdgcn_exp2f(x * 1.4426950408889634f); }
__device__ __forceinline__ void cs_rev(float rev, float& c, float& s) { const float f = __builtin_amdgcn_fractf(rev); c = __builtin_amdgcn_cosf(f); s = __builtin_amdgcn_sinf(f); }

#define XB_TMO      128
#define XB_XCNT(j)  (256  + 64 * (j))
#define XB_XSUB(j)  (1280 + 64 * (j))
#define XB_XGEN(j)  (2304 + 64 * (j))
#define XB_TOP      3328
#define XB_TOPGEN   3392
#define XCD_BAR_WORDS 3456
#define XB_SPIN_CAP (1u << 18)
__device__ __forceinline__ unsigned xb_ld(unsigned* p)              { return __hip_atomic_load(p, __ATOMIC_RELAXED, __HIP_MEMORY_SCOPE_AGENT); }
__device__ __forceinline__ unsigned xb_add(unsigned* p, unsigned v) { return __hip_atomic_fetch_add(p, v, __ATOMIC_RELAXED, __HIP_MEMORY_SCOPE_AGENT); }
__device__ __forceinline__ unsigned xb_xcc_id() { return (unsigned)__builtin_amdgcn_s_getreg((3 << 11) | 20) & 0xFu; }
#define XB_SPIN(cond, bar) do { unsigned _sp = 0; while (cond) { __builtin_amdgcn_s_sleep(1); \
    if ((++_sp & 255u) == 0u) { if (xb_ld(&(bar)[XB_TMO])) break; if (_sp > XB_SPIN_CAP) { atomicAdd(&(bar)[XB_TMO], 1u); break; } } } } while (0)
struct XcdBarrier { unsigned* bar; unsigned x; volatile LAS unsigned* st; int wave; };
__device__ __forceinline__ XcdBarrier xcd_barrier_post(unsigned* bar, volatile LAS unsigned* st) {
    XcdBarrier b; b.bar = bar; b.x = xb_xcc_id(); b.st = st;
    if (threadIdx.x == 0) (void)xb_add(&bar[XB_XCNT(b.x)], 1u);
    return b;
}
__device__ __forceinline__ void xcd_barrier_complete(unsigned* bar, unsigned x, unsigned& nloc, unsigned& nx) {
    const unsigned G = gridDim.x * gridDim.y * gridDim.z;
    unsigned sum, cnt, mine, sp = 0u;
    for (;;) {
        sum = 0u; cnt = 0u; mine = 0u;
#pragma unroll
        for (unsigned j = 0; j < 16; ++j) { const unsigned c = xb_ld(&bar[XB_XCNT(j)]); sum += c; cnt += (c > 0u) ? 1u : 0u; mine = (j == x) ? c : mine; }
        if (sum == G) break;
        __builtin_amdgcn_s_sleep(1);
        if ((++sp & 255u) == 0u) { if (xb_ld(&bar[XB_TMO])) break; if (sp > XB_SPIN_CAP) { atomicAdd(&bar[XB_TMO], 1u); break; } }
    }
    nloc = mine > 0u ? mine : 1u; nx = cnt > 0u ? cnt : 1u;
}
__device__ __forceinline__ void xcd_barrier(const XcdBarrier& b) {
    asm volatile("s_waitcnt vmcnt(0)" ::: "memory");
    __syncthreads();
    if (b.wave == 0 && lane_id() == 0) {
        unsigned* bar = b.bar;
        __builtin_amdgcn_s_waitcnt(0);
        unsigned nloc = b.st[0], nx = b.st[1];
        if (nloc == 0u) { xcd_barrier_complete(bar, b.x, nloc, nx); b.st[0] = nloc; b.st[1] = nx; }
        const unsigned old = xb_add(&bar[XB_XSUB(b.x)], 1u);
        const unsigned gen = old / nloc;
        if (old + 1u == (gen + 1u) * nloc) {
            __builtin_amdgcn_fence(__ATOMIC_RELEASE, "agent");
            asm volatile("s_waitcnt vmcnt(0)" ::: "memory");
            const unsigned og = xb_add(&bar[XB_TOP], 1u);
            const unsigned tg = og / nx;
            if (og + 1u == (tg + 1u) * nx) xb_add(&bar[XB_TOPGEN], 1u);
            else XB_SPIN(xb_ld(&bar[XB_TOPGEN]) == tg, bar);
            __builtin_amdgcn_fence(__ATOMIC_ACQUIRE, "agent");
            xb_add(&bar[XB_XGEN(b.x)], 1u);
            asm volatile("s_waitcnt vmcnt(0)" ::: "memory");
        } else {
            XB_SPIN(xb_ld(&bar[XB_XGEN(b.x)]) == gen, bar);
            __builtin_amdgcn_fence(__ATOMIC_ACQUIRE, "agent");
            asm volatile("s_waitcnt vmcnt(0)" ::: "memory");
        }
    }
    __syncthreads();
}

namespace gm {
constexpr int BM = 256, BK = 64, HALF = 128, HTB = HALF * BK * 2, STAGE_BYTES = 8 * HTB;
__device__ __forceinline__ int lds_byte(int r, int c) { const int st = (r >> 4) * 2 + (c >> 5), rr = r & 15, cc = c & 31, ob = rr * 64 + cc * 2; return st * 1024 + (ob ^ (((ob >> 9) & 1) << 5)); }
__device__ __forceinline__ void stage_rc(int b, int& R, int& C) { const int st = b / 1024, sb = b % 1024, swz = sb ^ (((sb >> 9) & 1) << 5); R = (st >> 1) * 16 + swz / 64; C = (st & 1) * 32 + (swz % 64) / 2; }
__device__ __forceinline__ int perm32(int rho) { const int n = rho >> 4, i = rho & 15; return 8 * (i >> 2) + 4 * n + (i & 3); }

struct Unit { const char* a0; const char* a1; const char* b0; const char* b1; int p0, p1, p2, p3, q; };

__device__ __forceinline__ void tile_order(int L, int nM, int nN, int& pm, int& pn) {
    const int nwg = nM * nN; int wgid = L;
    { const int q = nwg / 8, r = nwg % 8, xcd = wgid % 8, off = wgid / 8; wgid = (xcd < r ? xcd * (q + 1) : r * (q + 1) + (xcd - r) * q) + off; }
    const int nig = 8 * nN, gid = wgid / nig, fm = gid * 8, gsz = (nM - fm) < 8 ? (nM - fm) : 8;
    pm = fm + ((wgid % nig) % gsz); pn = (wgid % nig) / gsz;
}

template <int I8> struct AccSel { typedef f32x4 type; };
template <> struct AccSel<1> { typedef i32x4 type; };
template <class Epi, class Sched, bool GATHER, int I8 = 0, bool PREF = false>
__device__ __forceinline__ void gemm_run(LAS unsigned char* lds, const Sched& S, const Epi& E) {
    const int wid = S.wv, lane = lane_id(), tid = wid * 64 + lane, wr = wid >> 2, wc = wid & 3, fr = lane & 15, fq = lane >> 4;
    int nt = S.nt; asm volatile("" : "+s"(nt));
    unsigned voffA[2], voffB[2], colA[2]; int rowA[2];
#pragma unroll
    for (int i = 0; i < 2; ++i) { int R, C; stage_rc(tid * 16 + i * 8192, R, C); const int Rb = Epi::PERM ? ((R & ~31) + perm32(R & 31)) : R;
        voffA[i] = (unsigned)(R * S.multA * S.pitchA + C) * 2u; voffB[i] = (unsigned)(Rb * S.multB * S.pitchB + C) * 2u; colA[i] = (unsigned)C * 2u; rowA[i] = R; }
    const size_t kstep = (size_t)(BK * 2);
    const unsigned ldsw = (unsigned)wid * 1024u;
    const int aoff = lds_byte(wr * 64 + fr, fq * 8), boff = lds_byte(wc * 32 + fr, fq * 8);
#define G_SA(b, h) (((b) * 2 + (h)) * HTB)
#define G_SB(b, h) ((4 + (b) * 2 + (h)) * HTB)
#define G_STAGE(bufoff, gbase, voff) do { _Pragma("unroll") for (int _i = 0; _i < 2; ++_i) \
        __builtin_amdgcn_global_load_lds((const unsigned*)((const char*)(gbase) + (voff)[_i]), (LAS unsigned*)(lds + (bufoff) + ldsw + _i * 8192), 16, 0, 0); } while (0)
#define G_LD8(dst, addr) do { const i32x4 lo_ = *(const LAS i32x4*)(addr), hi_ = *(const LAS i32x4*)((addr) + 1024); dst = __builtin_shufflevector(lo_, hi_, 0, 1, 2, 3, 4, 5, 6, 7); } while (0)
#define G_LDA(dst, b, h) do { _Pragma("unroll") for (int m = 0; m < 4; ++m) G_LD8(dst[m], lds + G_SA(b, h) + aoff + m * 2048); } while (0)
#define G_LDB(dst, b, h) do { _Pragma("unroll") for (int n = 0; n < 2; ++n) G_LD8(dst[n], lds + G_SB(b, h) + boff + n * 2048); } while (0)
#define G_H4(x, k) ((k) ? __builtin_shufflevector(x, x, 4, 5, 6, 7) : __builtin_shufflevector(x, x, 0, 1, 2, 3))
#define G_MMA(ai, bj, At, Bt) do { __builtin_amdgcn_s_setprio(1); _Pragma("unroll") for (int m = 0; m < 4; ++m) _Pragma("unroll") for (int n = 0; n < 2; ++n) { \
        if constexpr (I8 == 2) acc[ai][bj][m][n] = __builtin_amdgcn_mfma_scale_f32_16x16x128_f8f6f4(Bt[n], At[m], acc[ai][bj][m][n], 0, 0, 0, 0x7F7F7F7F, 0, 0x7F7F7F7F); \
        else { _Pragma("unroll") for (int k = 0; k < 2; ++k) { \
            if constexpr (I8 == 1) acc[ai][bj][m][n] = __builtin_amdgcn_mfma_i32_16x16x64_i8(G_H4(Bt[n], k), G_H4(At[m], k), acc[ai][bj][m][n], 0, 0, 0); \
            else acc[ai][bj][m][n] = __builtin_amdgcn_mfma_f32_16x16x32_bf16(__builtin_bit_cast(bf16x8, G_H4(Bt[n], k)), __builtin_bit_cast(bf16x8, G_H4(At[m], k)), acc[ai][bj][m][n], 0, 0, 0); } } } \
        __builtin_amdgcn_s_setprio(0); } while (0)
#define G_WAIT_V(n) asm volatile("s_waitcnt vmcnt(" #n ")" ::: "memory")
#define G_WAIT_L(n) asm volatile("s_waitcnt lgkmcnt(" #n ")" ::: "memory")
#define G_BAR __builtin_amdgcn_s_barrier()
#define G_SCHED __builtin_amdgcn_sched_barrier(0)
    Unit cur, nxt; int ui = 0;
    if (!S.next(0, cur)) return;
    cur.q = 0;
    if constexpr (PREF) { S.prefetch(cur, lds); G_WAIT_V(0); G_BAR; }
    typedef typename AccSel<I8>::type acc_t;
    acc_t acc[2][2][4][2];
#pragma unroll
    for (int a = 0; a < 2; ++a)
#pragma unroll
        for (int b = 0; b < 2; ++b)
#pragma unroll
            for (int m = 0; m < 4; ++m)
#pragma unroll
                for (int n = 0; n < 2; ++n) acc[a][b][m][n] = (acc_t){0, 0, 0, 0};
    i32x8 At[4], B0[2], B1[2];
    unsigned gc0[2], gc1[2];
    if constexpr (GATHER) {
#pragma unroll
        for (int i = 0; i < 2; ++i) { gc0[i] = S.row_off(cur, rowA[i], lds) + colA[i]; gc1[i] = S.row_off(cur, 128 + rowA[i], lds) + colA[i]; }
    }
#define vA0 (GATHER ? gc0 : voffA)
#define vA1 (GATHER ? gc1 : voffA)
    G_STAGE(G_SB(0, 0), cur.b0, voffB); G_STAGE(G_SB(0, 1), cur.b1, voffB); G_STAGE(G_SA(0, 0), cur.a0, vA0); G_STAGE(G_SA(0, 1), cur.a1, vA1);
    if (wr == 1) G_BAR;
    G_WAIT_V(2); G_BAR;
    G_STAGE(G_SB(1, 0), cur.b0 + kstep, voffB); G_STAGE(G_SA(1, 0), cur.a0 + kstep, vA0); G_STAGE(G_SB(1, 1), cur.b1 + kstep, voffB);
    G_WAIT_V(6); G_BAR;
    for (;;) {
        const bool has_next = S.next(ui + 1, nxt);
        if (!has_next) nxt = cur;
        nxt.q = (ui + 1) & 1;
        for (int t = 0; t < nt; t += 2) {
            const bool last = (t == nt - 2);
            { const int tz_ = wid * 64 + lane_id();
#pragma unroll
              for (int i = 0; i < 2; ++i) { int R, C; stage_rc(tz_ * 16 + i * 8192, R, C); const int Rb = Epi::PERM ? ((R & ~31) + perm32(R & 31)) : R;
                  voffA[i] = (unsigned)(R * S.multA * S.pitchA + C) * 2u; voffB[i] = (unsigned)(Rb * S.multB * S.pitchB + C) * 2u; } }
            if constexpr (GATHER) asm volatile("" : "+v"(gc0[0]), "+v"(gc0[1]), "+v"(gc1[0]), "+v"(gc1[1]));
            if constexpr (PREF) { if (t == nt - 4) S.prefetch(nxt, lds); }
            const char* a11 = cur.a1 + (size_t)(t + 1) * kstep;
            const char* a02 = last ? nxt.a0 : cur.a0 + (size_t)(t + 2) * kstep; const char* a12 = last ? nxt.a1 : cur.a1 + (size_t)(t + 2) * kstep;
            const char* b02 = last ? nxt.b0 : cur.b0 + (size_t)(t + 2) * kstep; const char* b12 = last ? nxt.b1 : cur.b1 + (size_t)(t + 2) * kstep;
            G_LDB(B0, 0, 0); G_LDB(B1, 0, 1); G_SCHED; G_LDA(At, 0, 0); G_STAGE(G_SA(1, 1), a11, vA1);
            if constexpr (GATHER) { if (last) { int tz = tid; asm volatile("" : "+v"(tz));
#pragma unroll
                for (int i = 0; i < 2; ++i) { int R, C; stage_rc(tz * 16 + i * 8192, R, C); gc0[i] = S.row_off(nxt, R, lds) + (unsigned)C * 2u; gc1[i] = S.row_off(nxt, 128 + R, lds) + (unsigned)C * 2u; } } }
            G_WAIT_L(0); G_BAR; G_MMA(0, 0, At, B0); G_MMA(0, 1, At, B1); G_WAIT_V(8); G_BAR; G_SCHED;
            G_LDA(At, 0, 1); G_STAGE(G_SB(0, 0), b02, voffB); G_STAGE(G_SB(0, 1), b12, voffB); G_STAGE(G_SA(0, 0), a02, vA0);
            G_WAIT_L(0); G_BAR; G_MMA(1, 0, At, B0); G_MMA(1, 1, At, B1); G_WAIT_V(8); G_BAR; G_SCHED;
            G_LDB(B0, 1, 0); G_LDB(B1, 1, 1); G_SCHED; G_LDA(At, 1, 0); G_STAGE(G_SA(0, 1), a12, vA1);
            G_WAIT_L(0); G_BAR; G_MMA(0, 0, At, B0); G_MMA(0, 1, At, B1); G_WAIT_V(8); G_BAR; G_SCHED;
            G_LDA(At, 1, 1); G_STAGE(G_SB(1, 0), b02 + kstep, voffB); G_STAGE(G_SB(1, 1), b12 + kstep, voffB); G_STAGE(G_SA(1, 0), a02 + kstep, vA0);
            G_WAIT_L(0); G_BAR; G_MMA(1, 0, At, B0); G_MMA(1, 1, At, B1); G_WAIT_V(8); G_BAR; G_SCHED;
        }
        if (wr == 0) G_BAR;
        { int fr2 = fr, fq2 = fq; asm volatile("" : "+v"(fr2), "+v"(fq2));
          E(acc, cur, lds, wr, wc, fr2, fq2); }
        if (!has_next) break;
#pragma unroll
        for (int a = 0; a < 2; ++a)
#pragma unroll
            for (int b = 0; b < 2; ++b)
#pragma unroll
                for (int m = 0; m < 4; ++m)
#pragma unroll
                    for (int n = 0; n < 2; ++n) acc[a][b][m][n] = (acc_t){0, 0, 0, 0};
        cur = nxt; ++ui;
        if (wr == 1) G_BAR;
    }
    G_WAIT_V(0);
    G_BAR;
#undef G_SA
#undef G_SB
#undef G_STAGE
#undef G_LDA
#undef G_LD8
#undef G_H4
#undef G_LDB
#undef G_MMA
#undef G_WAIT_V
#undef G_WAIT_L
#undef G_BAR
#undef G_SCHED
#undef vA0
#undef vA1
}
}
using gm::Unit;
typedef f32x4 Acc[2][2][4][2];
typedef i32x4 AccI[2][2][4][2];

struct Args { const float* in[18]; float* out; unsigned char* ws; int ph_lo, ph_hi; };
struct Frame {
    LAS unsigned char* lds; unsigned char* ws; unsigned* ctl;
    int wave, vcu, G;
    const float *x, *ln0_g, *ln0_b, *w_in, *dec_f, *dec_b, *gn_g, *w_out, *ln1_g, *ln1_b, *w_r, *b_r, *w_up, *b_up, *w_dn, *b_dn, *ln2_g, *ln2_b;
    float* out;
};
#define WSP(T_, off) ((T_*)(F.ws + (off)))
#define FLANE lane_id()
#define FTID (F.wave * 64 + lane_id())

template <class ColMap>
__device__ __forceinline__ void transpose_item(const float* W, int K, int N, bf16* WT, LAS float* scr, int item, int lane, const ColMap& cm) {
    const int nblk = N / 64, kb = item / nblk, nb = item % nblk, k0 = 64 * kb, n0 = 64 * nb;
    const int s0 = cm(n0);
#pragma unroll 4
    for (int i = 0; i < 16; ++i) { const int kk = 4 * i + (lane >> 4), c4 = (lane & 15) * 4;
        const f32x4 v = *(const GAS f32x4*)(W + (size_t)(k0 + kk) * N + s0 + c4);
        LAS float* d = scr + kk * 65 + c4; d[0] = v[0]; d[1] = v[1]; d[2] = v[2]; d[3] = v[3]; }
    LDS_WAIT(); asm volatile("" ::: "memory");
    const int c = lane & 7;
#pragma unroll
    for (int j = 0; j < 8; ++j) { const int n = (lane >> 3) + 8 * j; const LAS float* s = scr + (8 * c) * 65 + n;
        v4u o; o.x = cvt_pk_bf16(s[0 * 65], s[1 * 65]); o.y = cvt_pk_bf16(s[2 * 65], s[3 * 65]); o.z = cvt_pk_bf16(s[4 * 65], s[5 * 65]); o.w = cvt_pk_bf16(s[6 * 65], s[7 * 65]);
        *(GAS v4u*)(WT + (size_t)(n0 + n) * K + k0 + 8 * c) = o; }
    LDS_WAIT(); asm volatile("" ::: "memory");
}
struct ColId { __device__ __forceinline__ int operator()(int n) const { return n; } };
struct ColUp { __device__ __forceinline__ int operator()(int n) const { return ((n >> 8) * 128 + (n & 127)) + ((n >> 7) & 1) * 2048; } };

__device__ __forceinline__ void p0_prologue(Frame& F) {
    const int gw = F.vcu * NWAVES + F.wave, NGW = F.G * NWAVES;
    {
        unsigned* h0q = WSP(unsigned, WS_H0B); float* st0 = WSP(float, WS_ST0); float* sx0 = WSP(float, WS_SX0);
        const int nsl = (DIN / 32 < F.G) ? DIN / 32 : F.G, nA = nsl * NWAVES, nB = NGW - nA, per2 = (2 * T + 8 * nA) / NGW;
        const int TA = (nB == 0) ? T : (per2 > 8 ? (nA * (per2 - 8)) / 2 : 0);
        const bool inA = F.vcu < nsl; const int m0 = inA ? gw : TA + (gw - nA), m1 = inA ? TA : T, mst = inA ? nA : nB;
        for (int m = m0; m < m1; m += mst) {
            const GAS f32x4* xr = (const GAS f32x4*)(F.x + (size_t)m * D) + FLANE;
            f32x4 v[8]; float s = 0.f;
#pragma unroll
            for (int j = 0; j < 8; ++j) { v[j] = xr[64 * j]; s += (v[j][0] + v[j][1]) + (v[j][2] + v[j][3]); }
            const float mean = wave_sum(s) * (1.f / D); float s2 = 0.f;
#pragma unroll
            for (int j = 0; j < 8; ++j) { v[j] = v[j] - mean; s2 += (v[j][0] * v[j][0] + v[j][1] * v[j][1]) + (v[j][2] * v[j][2] + v[j][3] * v[j][3]); }
            const float rstd = 1.f / sqrtf(wave_sum(s2) * (1.f / D) + LN_EPS); float am = 0.f;
#pragma unroll
            for (int j = 0; j < 8; ++j) { const f32x4 g = *((const GAS f32x4*)F.ln0_g + FLANE + 64 * j), b = *((const GAS f32x4*)F.ln0_b + FLANE + 64 * j);
                v[j] = v[j] * rstd * g + b; am = fmaxf(am, fmaxf(fmaxf(fabsf(v[j][0]), fabsf(v[j][1])), fmaxf(fabsf(v[j][2]), fabsf(v[j][3])))); }
#pragma unroll
            for (int o = 1; o < 64; o <<= 1) am = fmaxf(am, __shfl_xor(am, o));
            const float sc = am > 0.f ? am * (1.f / 127.f) : 1.f, inv = 1.f / sc;
#pragma unroll
            for (int j = 0; j < 8; ++j) { const int q0 = (int)__builtin_rintf(v[j][0] * inv), q1 = (int)__builtin_rintf(v[j][1] * inv), q2 = (int)__builtin_rintf(v[j][2] * inv), q3 = (int)__builtin_rintf(v[j][3] * inv);
                h0q[(size_t)m * (D / 4) + FLANE + 64 * j] = (unsigned)(q0 & 0xff) | ((unsigned)(q1 & 0xff) << 8) | ((unsigned)(q2 & 0xff) << 16) | ((unsigned)(q3 & 0xff) << 24); }
            if (FLANE == 0) { st0[2 * m] = mean; st0[2 * m + 1] = rstd; sx0[m] = sc; }
        }
    }
    {
        bf16* tab = WSP(bf16, WS_TAB);
        for (int i = (F.vcu * NTHR + FTID); i < 32768 + 65536 + 65536; i += F.G * NTHR) {
            float v;
            if (i < 32768) { const int r = i >> 7, a = i & 127, ri = r >> 7, k1 = r & 127; float c, s; cs_rev((float)((k1 * a) & 127) * (1.f / 128.f), c, s); v = ri ? -s : c; }
            else if (i < 32768 + 65536) { const int e = i - 32768, r = e >> 8, q = e & 255, ri = r >> 7, k2 = r & 127, rj = q >> 7, b = q & 127; float c, s; cs_rev((float)((k2 * b) & 127) * (1.f / 128.f), c, s);
                v = (ri == 0) ? (rj == 0 ? c : s) : (rj == 0 ? -s : c); }
            else { const int e = i - 32768 - 65536, l = e >> 8, q = e & 255, rj = q >> 7, cg = q & 127; float c, s; cs_rev((float)((l * cg) & 127) * (1.f / 128.f), c, s); v = (l < 128) ? (rj == 0 ? c : s) : 0.f; }
            tab[i] = (bf16)(cvt_pk_bf16(v, 0.f) & 0xffffu);
        }
        bf16* wrt = WSP(bf16, WS_WRT);
        for (int i = (F.vcu * NTHR + FTID); i < NE * D; i += F.G * NTHR) { const int e = i >> 11, k = i & 2047; const float v = F.w_r[k * NE + e];
            const unsigned hi = cvt_pk_bf16(v, 0.f) & 0xffffu; const unsigned lo = cvt_pk_bf16(v - bf_lo(hi), 0.f) & 0xffffu; wrt[i] = (bf16)hi; wrt[NE * D + i] = (bf16)lo; }
    }
    {
        LAS float* scr = (LAS float*)(F.lds + F.wave * 18432);
        constexpr int I_IN = 32 * (DIN / 64), I_OUT = 32 * (D / 64), I_UP = 32 * (2 * DFF / 64), I_DN = 32 * (D / 64);
        constexpr int NIT = I_OUT;
        for (int it = NGW - 1 - gw; it < NIT; it += NGW) {
            int r = it;
            { transpose_item(F.w_out, D, D, WSP(bf16, WS_WOUT), scr, r, FLANE, ColId()); }
        }
    }
}

struct SlabDesc { const float* W; signed char* WQ; float* sw; int NS, e, n0, valid, fp8; };
struct QF { unsigned char* ws; const float* w_up; const float* w_dn; const float* w_in; int vcu, G; };
__device__ __forceinline__ SlabDesc slab_desc(const QF& F, int j) {
    const int nD = (NE * 64 + F.G - 1) / F.G; SlabDesc d;
    if (j < 0) { const int sl = F.vcu + (-1 - j) * F.G; d.valid = sl < DIN / 32; d.NS = DIN; d.e = 0; d.n0 = sl * 32; d.W = F.w_in + d.n0; d.WQ = (signed char*)WSP(char, WS_WIN); d.sw = WSP(float, WS_SWIN); d.fp8 = 0; }
    else if (j >= nD) { const int sl = F.vcu + (j - nD) * F.G; d.valid = sl < NE * 128; d.NS = 2 * DFF; d.e = sl >> 7; d.n0 = (sl & 127) * 32; d.W = F.w_up + (size_t)d.e * D * 2 * DFF + ColUp()(d.n0); d.WQ = (signed char*)WSP(char, WS_WUP); d.sw = WSP(float, WS_SWUP); d.fp8 = 0; }
    else { const int sl = F.vcu + j * F.G; d.valid = sl < NE * 64; d.NS = D; d.e = sl >> 6; d.n0 = (sl & 63) * 32; d.W = F.w_dn + (size_t)d.e * DFF * D + d.n0; d.WQ = (signed char*)WSP(char, WS_WDN); d.sw = WSP(float, WS_SWDN); d.fp8 = 1; }
    return d;
}
#define SLAB_LOAD(dsc, v) do { if ((dsc).valid) { const GAS char* b_ = (const GAS char*)(dsc).W; unsigned o_ = (unsigned)((wave * 256 + kq) * (dsc).NS + c4) * 4u; const unsigned st_ = (unsigned)(dsc).NS * 32u; \
    _Pragma("unroll") for (int i_ = 0; i_ < 32; ++i_) { v[i_] = __builtin_nontemporal_load((const GAS f32x4*)(b_ + o_)); o_ += st_; } } } while (0)
__device__ __forceinline__ void do_slabs_impl(LAS unsigned char* lds, unsigned char* ws, const float* w_up, const float* w_dn, const float* w_in, int vcu, int G, int wave, int j0, int j1) {
    if (j0 >= j1) return;
    QF F; F.ws = ws; F.w_up = w_up; F.w_dn = w_dn; F.w_in = w_in; F.vcu = vcu; F.G = G;
    const int lane = lane_id(), tid = wave * 64 + lane;
    constexpr int PITCH = 2056;
    LAS bf16* slab = (LAS bf16*)lds;
    LAS float* red = (LAS float*)(lds + 32 * PITCH * 2);
    const int kq = lane >> 3, c4 = (lane & 7) * 4;
    f32x4 v[32];
    SlabDesc cur = slab_desc(F, j0);
    SLAB_LOAD(cur, v);
    for (int j = j0; j < j1; ++j) {
        if (cur.valid) {
            f32x4 mx = (f32x4){0.f, 0.f, 0.f, 0.f};
#pragma unroll
            for (int i = 0; i < 32; ++i) { const int k = wave * 256 + i * 8 + kq; const f32x4 x = v[i];
                mx[0] = fmaxf(mx[0], fabsf(x[0])); mx[1] = fmaxf(mx[1], fabsf(x[1])); mx[2] = fmaxf(mx[2], fabsf(x[2])); mx[3] = fmaxf(mx[3], fabsf(x[3]));
                const unsigned p01 = cvt_pk_bf16(x[0], x[1]), p23 = cvt_pk_bf16(x[2], x[3]);
                const int ks = k ^ (((c4 >> 3) & 3) << 3);
                slab[(c4 + 0) * PITCH + ks] = (bf16)(p01 & 0xffffu); slab[(c4 + 1) * PITCH + ks] = (bf16)(p01 >> 16); slab[(c4 + 2) * PITCH + ks] = (bf16)(p23 & 0xffffu); slab[(c4 + 3) * PITCH + ks] = (bf16)(p23 >> 16); }
#pragma unroll
            for (int q = 0; q < 4; ++q) { float m = mx[q]; m = fmaxf(m, __shfl_xor(m, 8)); m = fmaxf(m, __shfl_xor(m, 16)); m = fmaxf(m, __shfl_xor(m, 32)); mx[q] = m; }
            if (lane < 8) { LAS float* d = red + wave * 32 + c4; d[0] = mx[0]; d[1] = mx[1]; d[2] = mx[2]; d[3] = mx[3]; }
        }
        const SlabDesc done = cur;
        if (j + 1 < j1) { cur = slab_desc(F, j + 1); SLAB_LOAD(cur, v); }
        __syncthreads();
        if (done.valid && tid < 32) { float m = 0.f;
#pragma unroll
            for (int w = 0; w < 8; ++w) m = fmaxf(m, red[w * 32 + tid]);
            const float sc = m > 0.f ? m * (done.fp8 ? (1.f / 448.f) : (1.f / 127.f)) : 1.f; done.sw[(size_t)done.e * done.NS + done.n0 + tid] = sc; red[256 + tid] = 1.f / sc; }
        __syncthreads();
        if (done.valid) {
#pragma unroll 2
            for (int i = 0; i < 8; ++i) { const int q = tid + NTHR * i, n = q >> 7, kc = q & 127; const float inv = red[256 + n];
                const int sx_ = ((n >> 3) & 3) << 3;
                const v4u a = *(const LAS v4u*)(slab + n * PITCH + ((kc * 16) ^ sx_)), b = *(const LAS v4u*)(slab + n * PITCH + ((kc * 16 + 8) ^ sx_));
                const unsigned src[8] = {a.x, a.y, a.z, a.w, b.x, b.y, b.z, b.w}; unsigned o[4];
                if (done.fp8) {
#pragma unroll
                    for (int d = 0; d < 4; ++d) { int w = __builtin_amdgcn_cvt_pk_fp8_f32(bf_lo(src[2 * d]) * inv, bf_hi(src[2 * d]) * inv, 0, false);
                        w = __builtin_amdgcn_cvt_pk_fp8_f32(bf_lo(src[2 * d + 1]) * inv, bf_hi(src[2 * d + 1]) * inv, w, true); o[d] = (unsigned)w; }
                } else {
#pragma unroll
                for (int d = 0; d < 4; ++d) { unsigned w = 0u;
#pragma unroll
                    for (int h2 = 0; h2 < 2; ++h2) { const unsigned u2 = src[2 * d + h2]; const int q0 = (int)__builtin_rintf(bf_lo(u2) * inv), q1 = (int)__builtin_rintf(bf_hi(u2) * inv);
                        w |= ((unsigned)(q0 & 0xff) << (16 * h2)) | ((unsigned)(q1 & 0xff) << (16 * h2 + 8)); }
                    o[d] = w; }
                }
                __builtin_nontemporal_store((v4u){o[0], o[1], o[2], o[3]}, (GAS v4u*)(done.WQ + ((size_t)done.e * done.NS + done.n0 + n) * D + kc * 16)); }
        }
        __syncthreads();
    }
}

__device__ __forceinline__ void do_slabs(Frame& F, int j0, int j1) { do_slabs_impl(F.lds, F.ws, F.w_up, F.w_dn, F.w_in, F.vcu, F.G, F.wave, j0, j1); }

struct SchedBase { int nt, pitchA, pitchB, multA, multB, G, c, wv; };
struct SchedG1N : SchedBase {
    const char* A; const char* Bt;
    __device__ __forceinline__ bool next(int i, Unit& u) const { const int L = i * G + c; if (L >= 64 * 12) return false; int pm, pn; gm::tile_order(L, 64, 12, pm, pn);
        const int cb = pn < 4 ? 1024 + 256 * pn : (pn < 8 ? 2048 + 256 * (pn - 4) : 4096 + 256 * (pn - 8));
        u.a0 = A + (size_t)pm * 256 * D; u.a1 = u.a0 + (size_t)128 * D; u.b0 = Bt + (size_t)cb * D; u.b1 = u.b0 + (size_t)128 * D; u.p0 = pm; u.p1 = pn; u.p2 = cb; u.p3 = 0; return true; }
};
struct SchedG1SF : SchedBase {
    const char* A; const char* Bt;
    __device__ __forceinline__ bool next(int i, Unit& u) const { const int L = i * G + c; if (L >= 4 * 64) return false; int pm, pn; gm::tile_order(L, 4, 64, pm, pn);
        u.a0 = A + (size_t)pm * 256 * D; u.a1 = u.a0 + (size_t)128 * D; u.b0 = Bt + (size_t)(2 * pn) * D; u.b1 = u.b0 + (size_t)D; u.p0 = pm; u.p1 = pn; u.p2 = 0; u.p3 = 0; return true; }
};
struct SchedG1SKV : SchedBase {
    const char* A; const char* Bt;
    __device__ __forceinline__ bool next(int i, Unit& u) const { const int L = i * G + c; if (L >= 8 * 64) return false; int pm, pn; gm::tile_order(L, 8, 64, pm, pn);
        const int rb = pm < 4 ? 2048 + 256 * pm : 3072 + 256 * (pm - 4);
        u.a0 = A + (size_t)rb * D; u.a1 = u.a0 + (size_t)128 * D; u.b0 = Bt + (size_t)pn * 256 * D; u.b1 = u.b0 + (size_t)128 * D; u.p0 = pm; u.p1 = pn; u.p2 = rb; u.p3 = 0; return true; }
};
struct SchedFixA : SchedBase {
    const char* A; const char* Bt; int ncol;
    __device__ __forceinline__ bool next(int i, Unit& u) const { const int L = i * G + c; if (L >= ncol) return false;
        u.a0 = A; u.a1 = A + (size_t)128 * pitchA * 2; u.b0 = Bt + (size_t)L * 256 * pitchB * 2; u.b1 = u.b0 + (size_t)128 * pitchB * 2; u.p0 = 0; u.p1 = L; u.p2 = 0; u.p3 = 0; return true; }
};
struct SchedFixB : SchedBase {
    const char* A; const char* Bt; int nrow;
    __device__ __forceinline__ bool next(int i, Unit& u) const { const int L = i * G + c; if (L >= nrow) return false;
        u.a0 = A + (size_t)L * 256 * pitchA * 2; u.a1 = u.a0 + (size_t)128 * pitchA * 2; u.b0 = Bt; u.b1 = Bt + (size_t)128 * pitchB * 2; u.p0 = L; u.p1 = 0; u.p2 = 0; u.p3 = 0; return true; }
};
struct SchedScores : SchedBase {
    const char* Q; const char* Kk;
    __device__ __forceinline__ bool next(int i, Unit& u) const { const int L = i * G + c; if (L >= NH * NCH) return false; const int h = L & 3, n = L >> 2;
        u.a0 = Q + ((size_t)n * 256 * RW + h * HD) * 2; u.a1 = u.a0 + (size_t)128 * RW * 2; u.b0 = Kk + ((size_t)n * 256 * RW + h * HD) * 2; u.b1 = u.b0 + (size_t)128 * RW * 2; u.p0 = h; u.p1 = n; u.p2 = 0; u.p3 = 0; return true; }
};
struct SchedKV : SchedBase {
    const char* Bcat; const char* kTw;
    __device__ __forceinline__ bool next(int i, Unit& u) const { const int L = i * G + c; if (L >= 2 * NH * NCH) return false; const int dh = L & 7, n = L >> 3, dir = dh >> 2, h = dh & 3;
        u.a0 = Bcat + ((size_t)(h * NCH + n) * 256 * CAT) * 2; u.a1 = u.a0 + (size_t)128 * CAT * 2;
        u.b0 = kTw + (((size_t)dir * RW + h * HD) * T + (size_t)n * 256) * 2; u.b1 = u.b0 + (size_t)128 * T * 2; u.p0 = dh; u.p1 = n; u.p2 = 0; u.p3 = 0; return true; }
};
struct SchedOut : SchedBase {
    const char* Acat; const char* Bcat;
    __device__ __forceinline__ bool next(int i, Unit& u) const { const int L = i * G + c; if (L >= NH * NCH) return false; const int h = L & 3, n = L >> 2;
        u.a0 = Acat + ((size_t)h * T + (size_t)n * 256) * CAT * 2; u.a1 = u.a0 + (size_t)128 * CAT * 2; u.b0 = Bcat + ((size_t)(h * NCH + n) * 256 * CAT) * 2; u.b1 = u.b0 + (size_t)128 * CAT * 2; u.p0 = h; u.p1 = n; u.p2 = 0; u.p3 = 0; return true; }
};
struct Sched2D : SchedBase {
    const char* A; const char* Bt; int nM, nN, i0, ni;
    __device__ __forceinline__ bool next(int i, Unit& u) const { if (i >= ni) return false; const int L = (i + i0) * G + c; if (L >= nM * nN) return false; int pm, pn; gm::tile_order(L, nM, nN, pm, pn);
        u.a0 = A + (size_t)pm * 256 * pitchA * 2; u.a1 = u.a0 + (size_t)128 * pitchA * 2; u.b0 = Bt + (size_t)pn * 256 * pitchB * 2; u.b1 = u.b0 + (size_t)128 * pitchB * 2; u.p0 = pm; u.p1 = pn; u.p2 = 0; u.p3 = 0; return true; }
};
struct SchedMoE : SchedBase {
    const char* A; const char* Bt; const LAS int* tstart; const int* row_tok; const unsigned* cnt; int nN, rowbytes; size_t estride;
    __device__ __forceinline__ bool next(int i, Unit& u) const { const int RT = __builtin_amdgcn_readfirstlane(tstart[NE]); const int L = i * G + c; if (L >= RT * nN) return false; int rt, pn; gm::tile_order(L, RT, nN, rt, pn);
        const int e = __builtin_amdgcn_readfirstlane(tstart[40 + rt]);
        u.b0 = Bt + (size_t)e * estride + (size_t)pn * 256 * rowbytes; u.b1 = u.b0 + (size_t)128 * rowbytes;
        u.a0 = A; u.a1 = A;
        u.p0 = rt; u.p1 = pn; u.p2 = e; u.p3 = (rt - __builtin_amdgcn_readfirstlane(tstart[e])) * 256; return true; }
    __device__ __forceinline__ bool next_tab(int i, Unit& u) const { const int w = (i < 64) ? __builtin_amdgcn_readfirstlane(tstart[400 + i]) : -1; if (w < 0) return false;
        const int rt = w & 1023, pn = (w >> 10) & 31, e = (w >> 15) & 31;
        u.b0 = Bt + (size_t)e * estride + (size_t)pn * 256 * rowbytes; u.b1 = u.b0 + (size_t)128 * rowbytes; u.a0 = A; u.a1 = A;
        u.p0 = rt; u.p1 = pn; u.p2 = e; u.p3 = (rt - __builtin_amdgcn_readfirstlane(tstart[e])) * 256; return true; }
    const float *rsc, *swup, *b_up;
    __device__ __forceinline__ void prefetch(const Unit& u, LAS unsigned char* lds) const {
        LAS unsigned char* blk = lds + LDS_STAGE + u.q * 4096;
        const int wid = wv, e = u.p2; int lane = lane_id(); asm volatile("" : "+v"(lane));
        const int n = (int)cnt[64 * e]; int pos = u.p3 + (wid & 3) * 64 + lane; pos = pos < n ? pos : n - 1;
        if (wid < 4) __builtin_amdgcn_global_load_lds((const unsigned*)(row_tok + (size_t)e * T + pos), (LAS unsigned*)(blk + wid * 256), 4, 0, 0);
        else __builtin_amdgcn_global_load_lds((const unsigned*)(rsc + (size_t)e * T + pos), (LAS unsigned*)(blk + 1024 + (wid - 4) * 256), 4, 0, 0);
        if (wid == 0) __builtin_amdgcn_global_load_lds((const unsigned*)(swup + (size_t)e * 2 * DFF + u.p1 * 256 + lane * 4), (LAS unsigned*)(blk + 2048), 16, 0, 0);
        if (wid == 1) __builtin_amdgcn_global_load_lds((const unsigned*)(b_up + (size_t)e * 2 * DFF + u.p1 * 128 + (lane & 31) * 4 + (lane >> 5) * DFF), (LAS unsigned*)(blk + 3072), 16, 0, 0);
    }
    __device__ __forceinline__ unsigned row_off(const Unit& u, int r, LAS unsigned char* lds) const { return (unsigned)((const LAS int*)(lds + LDS_STAGE + u.q * 4096))[r] * (unsigned)rowbytes; }
};
struct SchedMoEUpT : SchedMoE { int u0, u1;
    __device__ __forceinline__ bool next(int i, Unit& u) const { const int ii = i + u0; if (ii >= u1) return false; return next_tab(ii, u); } };
struct SchedMoEDown : SchedMoE {
    const float *sa, *swdn, *b_dn;
    __device__ __forceinline__ bool next(int i, Unit& u) const { if (!SchedMoE::next_tab(i, u)) return false; u.a0 = A + (size_t)u.p0 * 256 * rowbytes; u.a1 = u.a0 + (size_t)128 * rowbytes; return true; }
    __device__ __forceinline__ void prefetch(const Unit& u, LAS unsigned char* lds) const {
        LAS unsigned char* blk = lds + LDS_STAGE + u.q * 4096;
        const int wid = wv, e = u.p2; int lane = lane_id(); asm volatile("" : "+v"(lane));
        if (wid == 1) __builtin_amdgcn_global_load_lds((const unsigned*)(swdn + (size_t)e * D + u.p1 * 256 + lane * 4), (LAS unsigned*)(blk + 1024), 16, 0, 0);
        if (wid == 2) __builtin_amdgcn_global_load_lds((const unsigned*)(b_dn + (size_t)e * D + u.p1 * 256 + lane * 4), (LAS unsigned*)(blk + 2048), 16, 0, 0);
    }
};

#define EPI_LOOP_AM for (int ai = 0; ai < 2; ++ai) _Pragma("unroll") for (int m = 0; m < 4; ++m)
#define EPI_FENCE __builtin_amdgcn_sched_barrier(0)
struct EpiG1N {
    static constexpr bool PERM = true;
    bf16 *qs, *kk, *gs, *Acat; const float *dec_f, *dec_b, *sx0, *swin;
    __device__ __forceinline__ void operator()(AccI& acci, const Unit& u, LAS unsigned char*, int wr, int wc, int fr, int fq) const {
        const int pm = u.p0, pn = u.p1, c0 = wc * 32 + 8 * fq;
        f32x4 swc[2][2];
#pragma unroll
        for (int bj = 0; bj < 2; ++bj)
#pragma unroll
            for (int n = 0; n < 2; ++n) swc[bj][n] = *(const GAS f32x4*)(swin + u.p2 + 128 * bj + c0 + 4 * n);
#define ACCF(ai_, bj_, m_, n_, j_) ((float)acci[ai_][bj_][m_][n_][j_] * (sxr * swc[bj_][n_][j_]))
        if (pn < 8) {
            const int h = pn & 3; const bool isq = pn < 4;
            float inv[8];
#pragma unroll
            for (int e = 0; e < 8; ++e) inv[e] = __builtin_amdgcn_exp2f(-(float)(c0 + e) * (13.287712379549449f / 128.f)) * 0.15915494309189535f;
            const float lgf = -fexp(dec_f[h]), lgb = -fexp(dec_b[h]);
#pragma unroll
            EPI_LOOP_AM {
                const int r = 128 * ai + 64 * wr + 16 * m + fr, tok = pm * 256 + r; const float pos = (float)tok; const float sxr = sx0[tok];
                f32x4 o1[2], o2[2];
#pragma unroll
                for (int n = 0; n < 2; ++n)
#pragma unroll
                    for (int j = 0; j < 4; ++j) { float c, s; cs_rev(pos * inv[4 * n + j], c, s); const float x1 = ACCF(ai, 0, m, n, j), x2 = ACCF(ai, 1, m, n, j); o1[n][j] = x1 * c - x2 * s; o2[n][j] = x2 * c + x1 * s; }
                if (isq) {
                    bf16* q = qs + (size_t)tok * RW + h * HD + c0; *(GAS v4u*)q = pack8(o1[0], o1[1]); *(GAS v4u*)(q + 128) = pack8(o2[0], o2[1]);
                    const int il = r; const float wf = fexp(lgf * (float)(il + 1)), wb = fexp(lgb * (float)(255 - il));
                    bf16* a = Acat + ((size_t)h * T + tok) * CAT + c0;
                    *(GAS v4u*)(a + 256) = pack8(o1[0] * wf, o1[1] * wf); *(GAS v4u*)(a + 384) = pack8(o2[0] * wf, o2[1] * wf);
                    *(GAS v4u*)(a + 512) = pack8(o1[0] * wb, o1[1] * wb); *(GAS v4u*)(a + 640) = pack8(o2[0] * wb, o2[1] * wb);
                } else {
                    bf16* k = kk + (size_t)tok * RW + h * HD + c0; *(GAS v4u*)k = pack8(o1[0] * 0.0625f, o1[1] * 0.0625f); *(GAS v4u*)(k + 128) = pack8(o2[0] * 0.0625f, o2[1] * 0.0625f);
                }
            }
        } else {
#pragma unroll
            EPI_LOOP_AM {
                const int r = 128 * ai + 64 * wr + 16 * m + fr, tok = pm * 256 + r; const float sxr = sx0[tok];
#pragma unroll
                for (int bj = 0; bj < 2; ++bj) { f32x4 v[2];
#pragma unroll
                    for (int n = 0; n < 2; ++n)
#pragma unroll
                        for (int j = 0; j < 4; ++j) { const float g = ACCF(ai, bj, m, n, j); v[n][j] = g * __builtin_amdgcn_rcpf(1.f + fexp(-g)); }
                    *(GAS v4u*)(gs + (size_t)tok * RW + (pn - 8) * 256 + bj * 128 + c0) = pack8(v[0], v[1]); }
            }
        }
    }
};
#undef ACCF
struct EpiG1SF {
    static constexpr bool PERM = true;
    bf16* uTT; const float *sx0, *swin;
    __device__ __forceinline__ void operator()(AccI& acc, const Unit& u, LAS unsigned char*, int wr, int wc, int fr, int fq) const {
        const int a0 = wc * 32 + 8 * fq;
        float sxc[2][8];
#pragma unroll
        for (int bj = 0; bj < 2; ++bj)
#pragma unroll
            for (int e = 0; e < 8; ++e) sxc[bj][e] = sx0[128 * (a0 + e) + 2 * u.p1 + bj];
#pragma unroll
        EPI_LOOP_AM { const int cch = u.p0 * 256 + 128 * ai + 64 * wr + 16 * m + fr; const float swr = swin[cch];
#pragma unroll
            for (int bj = 0; bj < 2; ++bj) { f32x4 v0, v1;
#pragma unroll
                for (int j = 0; j < 4; ++j) { v0[j] = (float)acc[ai][bj][m][0][j] * (swr * sxc[bj][j]); v1[j] = (float)acc[ai][bj][m][1][j] * (swr * sxc[bj][4 + j]); }
                *(GAS v4u*)(uTT + ((size_t)cch * 128 + (2 * u.p1 + bj)) * 128 + a0) = pack8(v0, v1); } }
    }
};
struct EpiG1SKV {
    static constexpr bool PERM = true;
    bf16 *kTw, *Bcat; const float *dec_f, *dec_b, *sx0, *swin;
    __device__ __forceinline__ void operator()(AccI& acc, const Unit& u, LAS unsigned char*, int wr, int wc, int fr, int fq) const {
        const int pm = u.p0, n_ch = u.p1, c0 = wc * 32 + 8 * fq;
        f32x4 sxc[2][2];
#pragma unroll
        for (int bj = 0; bj < 2; ++bj)
#pragma unroll
            for (int n = 0; n < 2; ++n) sxc[bj][n] = *(const GAS f32x4*)(sx0 + n_ch * 256 + 128 * bj + c0 + 4 * n);
        if (pm < 4) {
            const int h = pm; const float lgf = -fexp(dec_f[h]), lgb = -fexp(dec_b[h]);
#pragma unroll
            for (int m = 0; m < 4; ++m) {
                const int d = 64 * wr + 16 * m + fr;
                const float sw1 = swin[u.p2 + d], sw2 = swin[u.p2 + 128 + d];
                const float inv = __builtin_amdgcn_exp2f(-(float)d * (13.287712379549449f / 128.f)) * 0.15915494309189535f;
#pragma unroll
                for (int bj = 0; bj < 2; ++bj) {
                    f32x4 f1[2], f2[2], b1[2], b2[2];
#pragma unroll
                    for (int n = 0; n < 2; ++n)
#pragma unroll
                        for (int j = 0; j < 4; ++j) { const int il = 128 * bj + c0 + 4 * n + j; const float pos = (float)(n_ch * 256 + il); float c, s; cs_rev(pos * inv, c, s);
                            const float x1 = (float)acc[0][bj][m][n][j] * (sw1 * sxc[bj][n][j]), x2 = (float)acc[1][bj][m][n][j] * (sw2 * sxc[bj][n][j]); const float o1 = (x1 * c - x2 * s) * 0.0625f, o2 = (x2 * c + x1 * s) * 0.0625f;
                            const float wf = fexp(lgf * (float)(255 - il)), wb = fexp(lgb * (float)(il + 1));
                            f1[n][j] = o1 * wf; f2[n][j] = o2 * wf; b1[n][j] = o1 * wb; b2[n][j] = o2 * wb; }
                    const size_t tcol = (size_t)n_ch * 256 + 128 * bj + c0;
                    bf16* pf = kTw + ((size_t)(h * HD + d)) * T + tcol; bf16* pb = pf + (size_t)RW * T;
                    *(GAS v4u*)pf = pack8(f1[0], f1[1]); *(GAS v4u*)(pf + (size_t)128 * T) = pack8(f2[0], f2[1]);
                    *(GAS v4u*)pb = pack8(b1[0], b1[1]); *(GAS v4u*)(pb + (size_t)128 * T) = pack8(b2[0], b2[1]);
                }
            }
        } else {
            const int h = pm - 4;
#pragma unroll
            EPI_LOOP_AM { const int dv = 128 * ai + 64 * wr + 16 * m + fr; const float swr = swin[u.p2 + dv];
#pragma unroll
                for (int bj = 0; bj < 2; ++bj) { f32x4 v0, v1;
#pragma unroll
                    for (int j = 0; j < 4; ++j) { v0[j] = (float)acc[ai][bj][m][0][j] * (swr * sxc[bj][0][j]); v1[j] = (float)acc[ai][bj][m][1][j] * (swr * sxc[bj][1][j]); }
                    *(GAS v4u*)(Bcat + ((size_t)(h * NCH + n_ch) * 256 + dv) * CAT + 128 * bj + c0) = pack8(v0, v1); } }
        }
    }
};
struct EpiS1 {
    static constexpr bool PERM = true;
    bf16* A1;
    __device__ __forceinline__ void operator()(Acc& acc, const Unit& u, LAS unsigned char*, int wr, int wc, int fr, int fq) const {
        const int b0 = wc * 32 + 8 * fq;
#pragma unroll
        for (int m = 0; m < 4; ++m) { const int k1 = 64 * wr + 16 * m + fr;
#pragma unroll
            for (int bj = 0; bj < 2; ++bj) { const int cch = 2 * u.p1 + bj; f32x4 re[2], im[2];
#pragma unroll
                for (int n = 0; n < 2; ++n)
#pragma unroll
                    for (int j = 0; j < 4; ++j) { const int b = b0 + 4 * n + j; float c, s; cs_rev((float)(k1 * b) * (1.f / 16384.f), c, s);
                        const float xr = acc[0][bj][m][n][j], xi = acc[1][bj][m][n][j]; re[n][j] = xr * c + xi * s; im[n][j] = xi * c - xr * s; }
                bf16* p = A1 + (((size_t)k1 * 1024 + cch) * 2) * 128 + b0;
                *(GAS v4u*)p = pack8(re[0], re[1]); *(GAS v4u*)(p + 128) = pack8(im[0], im[1]); EPI_FENCE; } }
    }
};
struct EpiS2 {
    static constexpr bool PERM = true;
    bf16* Zt;
    __device__ __forceinline__ void operator()(Acc& acc, const Unit& u, LAS unsigned char*, int wr, int wc, int fr, int fq) const {
        const int k1 = u.p1 >> 2, cb = (u.p1 & 3) * 256, c0 = wc * 32 + 8 * fq;
#pragma unroll
        EPI_LOOP_AM { const int k2 = 64 * wr + 16 * m + fr, k = k1 + 128 * k2;
#pragma unroll
            for (int bj = 0; bj < 2; ++bj) { const int cch = cb + 128 * bj + c0, g = cch >> 7, cg = cch & 127;
                *(GAS v4u*)(Zt + (size_t)k * 2048 + g * 256 + ai * 128 + cg) = pack8(acc[ai][bj][m][0], acc[ai][bj][m][1]); } }
    }
};
struct EpiChan {
    static constexpr bool PERM = true;
    bf16* y;
    __device__ __forceinline__ void operator()(Acc& acc, const Unit& u, LAS unsigned char*, int wr, int wc, int fr, int fq) const {
        const int l0 = wc * 32 + 8 * fq; const float norm = 6.9053396600248786e-4f;
#pragma unroll
        EPI_LOOP_AM { const int R = u.p0 * 256 + 128 * ai + 64 * wr + 16 * m + fr, k = R >> 3, g = R & 7;
            *(GAS v4u*)(y + (size_t)k * D + g * 128 + l0) = pack8(acc[ai][0][m][0] * norm, acc[ai][0][m][1] * norm); }
    }
};
struct EpiScores {
    static constexpr bool PERM = true;
    bf16* Acat; const float *dec_f, *dec_b;
    __device__ __forceinline__ void operator()(Acc& acc, const Unit& u, LAS unsigned char*, int wr, int wc, int fr, int fq) const {
        const int h = u.p0, n_ch = u.p1, c0 = wc * 32 + 8 * fq; const float lgf = -fexp(dec_f[h]), lgb = -fexp(dec_b[h]);
#pragma unroll
        EPI_LOOP_AM { const int i = 128 * ai + 64 * wr + 16 * m + fr;
#pragma unroll
            for (int bj = 0; bj < 2; ++bj) { f32x4 v[2];
#pragma unroll
                for (int n = 0; n < 2; ++n)
#pragma unroll
                    for (int j = 0; j < 4; ++j) { const int jc = 128 * bj + c0 + 4 * n + j; const float dd = (float)(i - jc); const float w = (jc <= i) ? fexp(lgf * dd) : fexp(-lgb * dd); v[n][j] = acc[ai][bj][m][n][j] * w; }
                *(GAS v4u*)(Acat + ((size_t)h * T + n_ch * 256 + i) * CAT + 128 * bj + c0) = pack8(v[0], v[1]); EPI_FENCE; } }
    }
};
struct EpiKV {
    static constexpr bool PERM = true;
    bf16* kvT;
    __device__ __forceinline__ void operator()(Acc& acc, const Unit& u, LAS unsigned char*, int wr, int wc, int fr, int fq) const {
#pragma unroll
        EPI_LOOP_AM { const int dv = 128 * ai + 64 * wr + 16 * m + fr; bf16* rowp = kvT + (((size_t)u.p0 * NCH + u.p1) * 256 + dv) * 256 + wc * 32 + 8 * fq;
#pragma unroll
            for (int bj = 0; bj < 2; ++bj) *(GAS v4u*)(rowp + bj * 128) = pack8(acc[ai][bj][m][0], acc[ai][bj][m][1]); }
    }
};
struct EpiOut {
    static constexpr bool PERM = true;
    bf16* y; const bf16* gs; const float* gn_g;
    __device__ __forceinline__ void operator()(Acc& acc, const Unit& u, LAS unsigned char* lds, int wr, int wc, int fr, int fq) const {
        const int h = u.p0, n_ch = u.p1, c0 = wc * 32 + 8 * fq;
        LAS f32x2* P = (LAS f32x2*)(lds + LDS_STAGE);
#pragma unroll
        EPI_LOOP_AM {
            float s = 0.f;
#pragma unroll
            for (int bj = 0; bj < 2; ++bj)
#pragma unroll
                for (int n = 0; n < 2; ++n) { const f32x4 x = acc[ai][bj][m][n]; s += (x[0] + x[1]) + (x[2] + x[3]); }
            s += __shfl_xor(s, 16); s += __shfl_xor(s, 32);
            const float mw = s * (1.f / 64.f); float q = 0.f;
#pragma unroll
            for (int bj = 0; bj < 2; ++bj)
#pragma unroll
                for (int n = 0; n < 2; ++n) { const f32x4 d = acc[ai][bj][m][n] - mw; q += (d[0] * d[0] + d[1] * d[1]) + (d[2] * d[2] + d[3] * d[3]); }
            q += __shfl_xor(q, 16); q += __shfl_xor(q, 32);
            if (fq == 0) P[(128 * ai + 64 * wr + 16 * m + fr) * 4 + wc] = (f32x2){mw, q};
        }
        LDS_WAIT(); __builtin_amdgcn_s_barrier(); asm volatile("" ::: "memory");
#pragma unroll
        EPI_LOOP_AM {
            const int r = 128 * ai + 64 * wr + 16 * m + fr, tok = n_ch * 256 + r;
            const f32x2 a = P[r * 4 + 0], b = P[r * 4 + 1], c = P[r * 4 + 2], d = P[r * 4 + 3];
            const float mt = (a.x + b.x + c.x + d.x) * 0.25f; const float da = a.x - mt, db = b.x - mt, dc = c.x - mt, dd = d.x - mt;
            const float m2 = (a.y + b.y) + (c.y + d.y) + 64.f * ((da * da + db * db) + (dc * dc + dd * dd));
            const float rstd = 1.f / sqrtf(m2 * (1.f / 256.f) + GN_EPS);
#pragma unroll
            for (int bj = 0; bj < 2; ++bj) {
                const int col = h * HD + 128 * bj + c0; const v4u gv = *(const GAS v4u*)(gs + (size_t)tok * RW + col);
                const f32x4 g0 = *(const GAS f32x4*)(gn_g + col), g1 = *(const GAS f32x4*)(gn_g + col + 4);
                f32x4 o0 = (acc[ai][bj][m][0] - mt) * rstd * g0, o1 = (acc[ai][bj][m][1] - mt) * rstd * g1;
                o0[0] *= bf_lo(gv.x); o0[1] *= bf_hi(gv.x); o0[2] *= bf_lo(gv.y); o0[3] *= bf_hi(gv.y); o1[0] *= bf_lo(gv.z); o1[1] *= bf_hi(gv.z); o1[2] *= bf_lo(gv.w); o1[3] *= bf_hi(gv.w);
                *(GAS v4u*)(y + (size_t)tok * D + FW + col) = pack8(o0, o1); }
        }
        LDS_WAIT(); __builtin_amdgcn_s_barrier(); asm volatile("" ::: "memory");
    }
};
struct EpiWout {
    static constexpr bool PERM = true;
    bf16* z1; const float *x, *st0, *g0, *b0;
    __device__ __forceinline__ void operator()(Acc& acc, const Unit& u, LAS unsigned char*, int wr, int wc, int fr, int fq) const {
        const int colb = u.p1 * 256 + wc * 32 + 8 * fq;
#pragma unroll
        for (int bj = 0; bj < 2; ++bj) { const int col = colb + bj * 128;
            const f32x4 ga = *(const GAS f32x4*)(g0 + col), gb = *(const GAS f32x4*)(g0 + col + 4), ba = *(const GAS f32x4*)(b0 + col), bb = *(const GAS f32x4*)(b0 + col + 4);
#pragma unroll
            EPI_LOOP_AM { const int row = u.p0 * 256 + 128 * ai + 64 * wr + 16 * m + fr; const f32x2 st = *(const GAS f32x2*)(st0 + 2 * row); const size_t off = (size_t)row * D + col;
                const f32x4 xa = *(const GAS f32x4*)(x + off), xb = *(const GAS f32x4*)(x + off + 4);
                *(GAS v4u*)(z1 + off) = pack8(((xa - st.x) * st.y * ga + ba) * ALPHA + acc[ai][bj][m][0], ((xb - st.x) * st.y * gb + bb) * ALPHA + acc[ai][bj][m][1]); } }
    }
};
struct EpiUp {
    static constexpr bool PERM = true;
    unsigned char* act8;
    __device__ __forceinline__ void operator()(AccI& acc, const Unit& u, LAS unsigned char* lds, int wr, int wc, int fr, int fq) const {
        const int rt = u.p0, pn = u.p1, c0 = pn * 128 + wc * 32 + 8 * fq;
        const LAS float* blk = (const LAS float*)(lds + LDS_STAGE + u.q * 4096);
        float sx[2][4];
#pragma unroll
        EPI_LOOP_AM sx[ai][m] = blk[256 + 128 * ai + 64 * wr + 16 * m + fr];
        f32x4 sg[2], sl[2], bg[2], bl[2];
#pragma unroll
        for (int n = 0; n < 2; ++n) { const int cc = wc * 32 + 8 * fq + 4 * n;
            sg[n] = *(const LAS f32x4*)(blk + 512 + cc); sl[n] = *(const LAS f32x4*)(blk + 512 + 128 + cc); bg[n] = *(const LAS f32x4*)(blk + 768 + cc); bl[n] = *(const LAS f32x4*)(blk + 768 + 128 + cc); }
#pragma unroll
        EPI_LOOP_AM { const int r = 128 * ai + 64 * wr + 16 * m + fr; int pk[2];
#pragma unroll
            for (int n = 0; n < 2; ++n) { f32x2 v2[2];
#pragma unroll
                for (int jp = 0; jp < 2; ++jp) {
                    const f32x2 sx2 = (f32x2){sx[ai][m], sx[ai][m]};
                    f32x2 gl = (f32x2){(float)acc[ai][0][m][n][2 * jp], (float)acc[ai][0][m][n][2 * jp + 1]} * (sx2 * (f32x2){sg[n][2 * jp], sg[n][2 * jp + 1]}) + (f32x2){bg[n][2 * jp], bg[n][2 * jp + 1]};
                    f32x2 li = (f32x2){(float)acc[ai][1][m][n][2 * jp], (float)acc[ai][1][m][n][2 * jp + 1]} * (sx2 * (f32x2){sl[n][2 * jp], sl[n][2 * jp + 1]}) + (f32x2){bl[n][2 * jp], bl[n][2 * jp + 1]};
                    gl = __builtin_elementwise_min(gl, (f32x2){7.f, 7.f}); li = __builtin_elementwise_min(__builtin_elementwise_max(li, (f32x2){-7.f, -7.f}), (f32x2){7.f, 7.f});
                    const f32x2 ea = gl * (-1.702f * 1.4426950408889634f); f32x2 den; den.x = __builtin_amdgcn_exp2f(ea.x); den.y = __builtin_amdgcn_exp2f(ea.y); den = den + 1.0f;
                    f32x2 rc; rc.x = __builtin_amdgcn_rcpf(den.x); rc.y = __builtin_amdgcn_rcpf(den.y);
                    v2[jp] = (gl * rc) * (li * 4.0f + 4.0f); }
                int p = __builtin_amdgcn_cvt_pk_fp8_f32(v2[0].x, v2[0].y, 0, false); p = __builtin_amdgcn_cvt_pk_fp8_f32(v2[1].x, v2[1].y, p, true); pk[n] = p; }
            *(GAS v2u*)(act8 + ((size_t)rt * 256 + r) * DFF + c0) = (v2u){(unsigned)pk[0], (unsigned)pk[1]}; }
    }
};
struct EpiDown {
    static constexpr bool PERM = true;
    unsigned char* yr8;
    __device__ __forceinline__ void operator()(Acc& acc, const Unit& u, LAS unsigned char* lds, int wr, int wc, int fr, int fq) const {
        const int rt = u.p0, pn = u.p1, c0 = pn * 256 + wc * 32 + 8 * fq;
        const LAS float* blk = (const LAS float*)(lds + LDS_STAGE + u.q * 4096);
#pragma unroll
        for (int bj = 0; bj < 2; ++bj) { const int cc = 128 * bj + wc * 32 + 8 * fq;
#pragma unroll
            EPI_LOOP_AM { const int r = 128 * ai + 64 * wr + 16 * m + fr;
                const f32x4 w0 = *(const LAS f32x4*)(blk + 256 + cc) * 0.25f, w1 = *(const LAS f32x4*)(blk + 256 + cc + 4) * 0.25f, b0 = *(const LAS f32x4*)(blk + 512 + cc), b1 = *(const LAS f32x4*)(blk + 512 + cc + 4);
                f32x4 y0 = (acc[ai][bj][m][0] * w0 + b0) * 32.f, y1 = (acc[ai][bj][m][1] * w1 + b1) * 32.f;
#pragma unroll
                for (int j = 0; j < 4; ++j) { y0[j] = fminf(fmaxf(y0[j], -440.f), 440.f); y1[j] = fminf(fmaxf(y1[j], -440.f), 440.f); }
                int p0 = __builtin_amdgcn_cvt_pk_fp8_f32(y0[0], y0[1], 0, false); p0 = __builtin_amdgcn_cvt_pk_fp8_f32(y0[2], y0[3], p0, true);
                int p1 = __builtin_amdgcn_cvt_pk_fp8_f32(y1[0], y1[1], 0, false); p1 = __builtin_amdgcn_cvt_pk_fp8_f32(y1[2], y1[3], p1, true);
                *(GAS v2u*)(yr8 + ((size_t)rt * 256 + r) * D + c0 + 128 * bj) = (v2u){(unsigned)p0, (unsigned)p1}; EPI_FENCE; } }
    }
};

__device__ __forceinline__ void p3_scan(Frame& F) {
    const bf16* kvT = WSP(bf16, WS_KVT); bf16* Bcat = WSP(bf16, WS_BCAT);
    const int NQ = 2 * NH * 256 * 64;
    for (int q = F.vcu * NTHR + FTID; q < NQ; q += F.G * NTHR) {
        const int dk4 = q & 63, dv = (q >> 6) & 255, dh = q >> 14, dir = dh >> 2, h = dh & 3;
        const float lg = -fexp((dir ? F.dec_b : F.dec_f)[h]); const float cd = fexp(lg * (float)C2);
        f32x4 S = (f32x4){0.f, 0.f, 0.f, 0.f};
        for (int s = 0; s < NCH; ++s) { const int n = dir ? (NCH - 1 - s) : s;
            const v2u kw = *(const GAS v2u*)(kvT + (((size_t)dh * NCH + n) * 256 + dv) * 256 + dk4 * 4); const f32x4 kv = (f32x4){bf_lo(kw.x), bf_hi(kw.x), bf_lo(kw.y), bf_hi(kw.y)};
            v2u w; w.x = cvt_pk_bf16(S[0], S[1]); w.y = cvt_pk_bf16(S[2], S[3]);
            *(GAS v2u*)(Bcat + ((size_t)(h * NCH + n) * 256 + dv) * CAT + 256 + dir * 256 + dk4 * 4) = w;
            S = S * cd + kv; }
    }
}

__device__ __forceinline__ void p6_router(Frame& F) {
    const bf16* z1 = WSP(bf16, WS_Z1); unsigned* h1q = WSP(unsigned, WS_H1Q); float* sxg = WSP(float, WS_SX); float* rsc = WSP(float, WS_RSC); float* st1 = WSP(float, WS_ST0) + 2 * T;
    int* topi = WSP(int, WS_RT); float* gate = (float*)(topi + 4 * T); int* posb = (int*)(gate + 4 * T); int* row_tok = posb + 4 * T;
    constexpr int HP = 528;
    LAS unsigned char* Hhi = F.lds;
    LAS unsigned char* Hlo = Hhi + 64 * HP;
    LAS unsigned char* Whi = Hlo + 64 * HP;
    LAS unsigned char* Wlo = Whi + 32 * HP;
    LAS float* stl = (LAS float*)(Wlo + 32 * HP);
    LAS float* lg = stl + 128;
    LAS int* hist = (LAS int*)(lg + 64 * 33);
    LAS float* sxl = (LAS float*)(hist + 64);
    LAS float* part = sxl + 64;
    const bf16* wrt = WSP(bf16, WS_WRT);
    for (int blk = F.vcu; blk < T / 64; blk += F.G) {
        const int t0 = blk * 64;
        {
            v2u raw[8][8]; const int ln_ = FLANE;
#pragma unroll
            for (int rr = 0; rr < 8; ++rr) { const GAS v2u* xr = (const GAS v2u*)(z1 + (size_t)(t0 + F.wave * 8 + rr) * D) + ln_;
#pragma unroll
                for (int j = 0; j < 8; ++j) raw[rr][j] = xr[64 * j]; }
#pragma unroll
            for (int rr = 0; rr < 8; ++rr) { const int row = F.wave * 8 + rr, m = t0 + row;
                f32x4 v[8]; float s = 0.f;
#pragma unroll
                for (int j = 0; j < 8; ++j) { const v2u w = raw[rr][j]; v[j] = (f32x4){bf_lo(w.x), bf_hi(w.x), bf_lo(w.y), bf_hi(w.y)}; s += (v[j][0] + v[j][1]) + (v[j][2] + v[j][3]); }
                const float mean = wave_sum(s) * (1.f / D); float s2 = 0.f;
#pragma unroll
                for (int j = 0; j < 8; ++j) { v[j] = v[j] - mean; s2 += (v[j][0] * v[j][0] + v[j][1] * v[j][1]) + (v[j][2] * v[j][2] + v[j][3] * v[j][3]); }
                const float rstd = 1.f / sqrtf(wave_sum(s2) * (1.f / D) + LN_EPS);
                float am = 0.f;
#pragma unroll
                for (int j = 0; j < 8; ++j) { const f32x4 g = *((const GAS f32x4*)F.ln1_g + FLANE + 64 * j), b = *((const GAS f32x4*)F.ln1_b + FLANE + 64 * j);
                    v[j] = v[j] * rstd * g + b; am = fmaxf(am, fmaxf(fmaxf(fabsf(v[j][0]), fabsf(v[j][1])), fmaxf(fabsf(v[j][2]), fabsf(v[j][3])))); }
#pragma unroll
                for (int o = 1; o < 64; o <<= 1) am = fmaxf(am, __shfl_xor(am, o));
                const float sc = am > 0.f ? am * (1.f / 127.f) : 1.f, inv = 1.f / sc;
#pragma unroll
                for (int j = 0; j < 8; ++j) { const int q0 = (int)__builtin_rintf(v[j][0] * inv), q1 = (int)__builtin_rintf(v[j][1] * inv), q2 = (int)__builtin_rintf(v[j][2] * inv), q3 = (int)__builtin_rintf(v[j][3] * inv);
                    h1q[(size_t)m * (D / 4) + FLANE + 64 * j] = (unsigned)(q0 & 0xff) | ((unsigned)(q1 & 0xff) << 8) | ((unsigned)(q2 & 0xff) << 16) | ((unsigned)(q3 & 0xff) << 24); }
                if (FLANE == 0) { st1[2 * m] = mean; st1[2 * m + 1] = rstd; stl[2 * row] = mean; stl[2 * row + 1] = rstd; sxg[m] = sc; sxl[row] = sc; }
            }
        }
        if (FTID < 64) hist[FTID] = 0;
        __syncthreads();
        const int tt = F.wave & 3, kh = F.wave >> 2; f32x4 ac[2];
        ac[0] = (f32x4){0.f, 0.f, 0.f, 0.f}; ac[1] = (f32x4){0.f, 0.f, 0.f, 0.f};
        v2u zp[8]; v4u wp[4];
#define P6_LOAD(kc_) do { const int ln_ = FLANE; _Pragma("unroll") for (int i_ = 0; i_ < 8; ++i_) zp[i_] = *(const GAS v2u*)(z1 + (size_t)(t0 + F.wave + 8 * i_) * D + (kc_) * 256 + ln_ * 4); \
        _Pragma("unroll") for (int i_ = 0; i_ < 4; ++i_) { const int q_ = F.wave * 64 + ln_ + NTHR * i_; wp[i_] = *(const GAS v4u*)(wrt + (size_t)(q_ >> 5) * D + (kc_) * 256 + (q_ & 31) * 8); } } while (0)
        P6_LOAD(0);
        for (int kc = 0; kc < 8; ++kc) {
            { const int ln = FLANE, col = kc * 256 + ln * 4; const f32x4 g = *(const GAS f32x4*)(F.ln1_g + col), b = *(const GAS f32x4*)(F.ln1_b + col);
#pragma unroll
              for (int i = 0; i < 8; ++i) { const int r = F.wave + 8 * i; const v2u zw = zp[i];
                const f32x4 zv = (f32x4){bf_lo(zw.x), bf_hi(zw.x), bf_lo(zw.y), bf_hi(zw.y)};
                const f32x4 hh = (zv - stl[2 * r]) * stl[2 * r + 1] * g + b;
                v2u hi, lo; hi.x = cvt_pk_bf16(hh[0], hh[1]); hi.y = cvt_pk_bf16(hh[2], hh[3]);
                lo.x = cvt_pk_bf16(hh[0] - bf_lo(hi.x), hh[1] - bf_hi(hi.x)); lo.y = cvt_pk_bf16(hh[2] - bf_lo(hi.y), hh[3] - bf_hi(hi.y));
                *(LAS v2u*)(Hhi + r * HP + ln * 8) = hi; *(LAS v2u*)(Hlo + r * HP + ln * 8) = lo; }
#pragma unroll
              for (int i = 0; i < 4; ++i) { const int q = F.wave * 64 + ln + NTHR * i, e = (q >> 5) & 31, c8 = q & 31; *(LAS v4u*)(((q >> 10) ? Wlo : Whi) + e * HP + c8 * 16) = wp[i]; } }
            __syncthreads();
            if (kc + 1 < 8) P6_LOAD(kc + 1);
            { const int ln = FLANE, fr = ln & 15, fq = ln >> 4;
#pragma unroll
              for (int ks = 0; ks < 4; ++ks) { const int kb = (kh * 128 + ks * 32 + fq * 8) * 2;
                const bf16x8 th = __builtin_bit_cast(bf16x8, *(const LAS i32x4*)(Hhi + (tt * 16 + fr) * HP + kb)), tl = __builtin_bit_cast(bf16x8, *(const LAS i32x4*)(Hlo + (tt * 16 + fr) * HP + kb));
#pragma unroll
                for (int et = 0; et < 2; ++et) { const bf16x8 wh = __builtin_bit_cast(bf16x8, *(const LAS i32x4*)(Whi + (et * 16 + fr) * HP + kb)), wl = __builtin_bit_cast(bf16x8, *(const LAS i32x4*)(Wlo + (et * 16 + fr) * HP + kb));
                    ac[et] = __builtin_amdgcn_mfma_f32_16x16x32_bf16(wh, th, ac[et], 0, 0, 0); ac[et] = __builtin_amdgcn_mfma_f32_16x16x32_bf16(wl, th, ac[et], 0, 0, 0); ac[et] = __builtin_amdgcn_mfma_f32_16x16x32_bf16(wh, tl, ac[et], 0, 0, 0); } } }
            __syncthreads();
        }
#undef P6_LOAD
        { const int ln = FLANE, fr = ln & 15, fq = ln >> 4;
#pragma unroll
          for (int et = 0; et < 2; ++et) *(LAS f32x4*)(part + (kh * 64 + tt * 16 + fr) * 32 + et * 16 + 4 * fq) = ac[et];
          __syncthreads();
          { const int r = FTID >> 3, e0 = (FTID & 7) * 4;
              const f32x4 a = *(const LAS f32x4*)(part + (0 * 64 + r) * 32 + e0), b = *(const LAS f32x4*)(part + (1 * 64 + r) * 32 + e0);
              const f32x4 br = *(const GAS f32x4*)(F.b_r + e0), sum = (a + b) + br; LAS float* d = lg + r * 33 + e0; d[0] = sum[0]; d[1] = sum[1]; d[2] = sum[2]; d[3] = sum[3]; } }
        __syncthreads();
        int ek[4] = {0, 0, 0, 0}, lp[4] = {0, 0, 0, 0}; float gk[4] = {0.f, 0.f, 0.f, 0.f};
        if (FTID < 64) {
            float lv[4]; unsigned used = 0u;
#pragma unroll
            for (int k = 0; k < 4; ++k) { float best = -3.0e38f; int bi = 0;
                for (int e = 0; e < NE; ++e) { const float v = lg[FTID * 33 + e]; const bool ok = !((used >> e) & 1u) && (v > best); best = ok ? v : best; bi = ok ? e : bi; }
                used |= 1u << bi; ek[k] = bi; lv[k] = best; }
            const float mx = lv[0]; float den = 0.f;
#pragma unroll
            for (int k = 0; k < 4; ++k) { gk[k] = fexp(lv[k] - mx); den += gk[k]; }
            const float rd = 1.f / den;
#pragma unroll
            for (int k = 0; k < 4; ++k) { gk[k] *= rd; lp[k] = __hip_atomic_fetch_add(&hist[ek[k]], 1, __ATOMIC_RELAXED, __HIP_MEMORY_SCOPE_WORKGROUP); }
        }
        __syncthreads();
        if (FTID < NE) hist[32 + FTID] = (int)__hip_atomic_fetch_add(F.ctl + CW_CNT + 64 * FTID, (unsigned)hist[FTID], RLX_AGENT);
        __syncthreads();
        if (FTID < 64) { const int tok = t0 + FTID;
#pragma unroll
            for (int k = 0; k < 4; ++k) { const int pos = hist[32 + ek[k]] + lp[k]; row_tok[(size_t)ek[k] * T + pos] = tok; rsc[(size_t)ek[k] * T + pos] = sxl[FTID]; topi[4 * tok + k] = ek[k]; gate[4 * tok + k] = gk[k]; posb[4 * tok + k] = pos; } }
        __syncthreads();
    }
}

__device__ __forceinline__ void build_units(Frame& F, LAS int* tstart, int nN, int c) {
    __syncthreads();
    if (FTID < 64) { const int RT = tstart[NE], L = FTID * F.G + c; int w = -1;
        if (L < RT * nN) { int rt, pn; gm::tile_order(L, RT, nN, rt, pn); w = rt | (pn << 10) | (tstart[40 + rt] << 15); }
        tstart[400 + FTID] = w; }
    __syncthreads();
}

__device__ __forceinline__ void p8_requant(Frame& F, const LAS int* tstart) {
    const bf16* act = WSP(bf16, WS_ACT); unsigned* aq = WSP(unsigned, WS_ACTQ); float* sa = WSP(float, WS_SA); const unsigned* rmax = F.ctl + CW_RMAX;
    const int R = tstart[NE] * 256, gw = F.vcu * NWAVES + F.wave, NGW = F.G * NWAVES;
    for (int row = gw; row < R; row += NGW) {
        const float mx = __uint_as_float(rmax[row]); const float sc = mx > 0.f ? mx * (1.f / 127.f) : 1.f, inv = 1.f / sc;
#pragma unroll
        for (int j = 0; j < 2; ++j) { const int col = 16 * FLANE + 1024 * j;
            const v4u a = *(const GAS v4u*)(act + (size_t)row * DFF + col), b = *(const GAS v4u*)(act + (size_t)row * DFF + col + 8);
            const unsigned src[8] = {a.x, a.y, a.z, a.w, b.x, b.y, b.z, b.w}; unsigned o[4];
#pragma unroll
            for (int d = 0; d < 4; ++d) { unsigned w = 0u;
#pragma unroll
                for (int h2 = 0; h2 < 2; ++h2) { const unsigned u2 = src[2 * d + h2]; int q0 = (int)__builtin_rintf(bf_lo(u2) * inv), q1 = (int)__builtin_rintf(bf_hi(u2) * inv);
                    q0 = q0 > 127 ? 127 : (q0 < -127 ? -127 : q0); q1 = q1 > 127 ? 127 : (q1 < -127 ? -127 : q1);
                    w |= ((unsigned)(q0 & 0xff) << (16 * h2)) | ((unsigned)(q1 & 0xff) << (16 * h2 + 8)); }
                o[d] = w; }
            *(GAS v4u*)(aq + ((size_t)row * DFF + col) / 4) = (v4u){o[0], o[1], o[2], o[3]}; }
        if (FLANE == 0) sa[row] = sc;
    }
}

__device__ __forceinline__ void build_tstart(Frame& F, LAS int* tstart) {
    if (FTID == 0) { int s = 0; for (int e = 0; e < NE; ++e) { tstart[e] = s; const unsigned n = __hip_atomic_load(F.ctl + CW_CNT + 64 * e, RLX_AGENT); s += (int)((n + 255u) >> 8); } tstart[NE] = s; }
    __syncthreads();
    for (int rt = FTID; rt < RT_MAX; rt += NTHR) { int e = 0; for (int j = 1; j < NE; ++j) e += (tstart[j] <= rt) ? 1 : 0; tstart[40 + rt] = e; }
    __syncthreads();
}

__device__ __forceinline__ void p9_combine(Frame& F, const LAS int* tstart) {
    const bf16* z1 = WSP(bf16, WS_Z1); const float* st1 = WSP(float, WS_ST0) + 2 * T; const unsigned char* yr = (const unsigned char*)(F.ws + WS_YR);
    const int* topi = WSP(int, WS_RT); const float* gate = (const float*)(topi + 4 * T); const int* posb = (const int*)(gate + 4 * T);
    const int gw = F.vcu * NWAVES + F.wave, NGW = F.G * NWAVES; const int lane = lane_id();
    for (int m = gw; m < T; m += NGW) {
        const float mean1 = st1[2 * m], rstd1 = st1[2 * m + 1];
        size_t ro[4]; float gk[4];
#pragma unroll
        for (int k = 0; k < 4; ++k) { const int e = topi[4 * m + k]; ro[k] = ((size_t)tstart[e] * 256 + posb[4 * m + k]) * D; gk[k] = gate[4 * m + k]; }
        f32x4 v[8]; float s = 0.f;
#pragma unroll
        for (int j = 0; j < 8; ++j) { const int col = 4 * lane + 256 * j;
            const v2u zw = *(const GAS v2u*)(z1 + (size_t)m * D + col); const f32x4 zv = (f32x4){bf_lo(zw.x), bf_hi(zw.x), bf_lo(zw.y), bf_hi(zw.y)}, g = *(const GAS f32x4*)(F.ln1_g + col), b = *(const GAS f32x4*)(F.ln1_b + col);
            f32x4 a = ((zv - mean1) * rstd1 * g + b) * ALPHA;
#pragma unroll
            for (int k = 0; k < 4; ++k) { const int w = *(const GAS int*)(yr + ro[k] + col); const f32x2 lo = __builtin_amdgcn_cvt_pk_f32_fp8(w, false), hi = __builtin_amdgcn_cvt_pk_f32_fp8(w, true); const float g = gk[k] * (1.f / 32.f);
                a[0] += g * lo.x; a[1] += g * lo.y; a[2] += g * hi.x; a[3] += g * hi.y; }
            v[j] = a; s += (a[0] + a[1]) + (a[2] + a[3]); }
        const float mean = wave_sum(s) * (1.f / D); float s2 = 0.f;
#pragma unroll
        for (int j = 0; j < 8; ++j) { v[j] = v[j] - mean; s2 += (v[j][0] * v[j][0] + v[j][1] * v[j][1]) + (v[j][2] * v[j][2] + v[j][3] * v[j][3]); }
        const float rstd = 1.f / sqrtf(wave_sum(s2) * (1.f / D) + LN_EPS);
#pragma unroll
        for (int j = 0; j < 8; ++j) { const int col = 4 * lane + 256 * j; const f32x4 g = *(const GAS f32x4*)(F.ln2_g + col), b = *(const GAS f32x4*)(F.ln2_b + col);
            *(GAS f32x4*)(F.out + (size_t)m * D + col) = v[j] * rstd * g + b; }
    }
}

constexpr int NPH = 10;
__global__ void __launch_bounds__(NTHR, 2) fwd(Args args) {
    extern __shared__ __attribute__((aligned(16))) unsigned char lds_raw[];
    Frame F;
    F.lds = (LAS unsigned char*)lds_raw; F.ws = args.ws; F.ctl = (unsigned*)(args.ws + WS_CTL);
    F.wave = __builtin_amdgcn_readfirstlane((int)threadIdx.x >> 6);
    F.G = gridDim.x; { const int bx = blockIdx.x; F.vcu = (F.G % 8 == 0) ? (bx % 8) * (F.G / 8) + bx / 8 : bx; }
#define CAS __attribute__((address_space(4)))
#define FRAME_RELOAD() do { const CAS char* kp_ = (const CAS char*)__builtin_amdgcn_kernarg_segment_ptr(); asm volatile("" : "+s"(kp_)); const CAS Args* ap_ = (const CAS Args*)kp_; \
    F.x = ap_->in[0]; F.ln0_g = ap_->in[1]; F.ln0_b = ap_->in[2]; F.w_in = ap_->in[3]; F.dec_f = ap_->in[4]; F.dec_b = ap_->in[5]; F.gn_g = ap_->in[6]; F.w_out = ap_->in[7]; \
    F.ln1_g = ap_->in[8]; F.ln1_b = ap_->in[9]; F.w_r = ap_->in[10]; F.b_r = ap_->in[11]; F.w_up = ap_->in[12]; F.b_up = ap_->in[13]; F.w_dn = ap_->in[14]; F.b_dn = ap_->in[15]; \
    F.ln2_g = ap_->in[16]; F.ln2_b = ap_->in[17]; F.out = ap_->out; F.ws = ap_->ws; F.ctl = (unsigned*)(F.ws + WS_CTL); } while (0)
    FRAME_RELOAD();
    volatile LAS unsigned* lctl = (volatile LAS unsigned*)(F.lds + LDS_CTL_OFF);
    LAS int* tstart = (LAS int*)(F.lds + LDS_CTL_OFF + 64);
    for (int u = FTID; u < 128; u += NTHR) lctl[u] = 0u;
    __syncthreads();
    const int lo = args.ph_lo, hi = args.ph_hi;
    const bool single = (hi - lo) > 1;
    XcdBarrier bar; bar.bar = F.ctl + CW_BAR; bar.x = 0; bar.st = lctl; bar.wave = F.wave;
    if (single) { bar = xcd_barrier_post(F.ctl + CW_BAR, lctl); bar.wave = F.wave; }
#ifndef PH_MASK
#define PH_MASK 0x3ff
#endif
#define IN(k) (((PH_MASK >> (k)) & 1) && lo <= (k) && (k) < hi)
#ifndef SUB_MASK
#define SUB_MASK 0xff
#endif
#define SUB(n) ((SUB_MASK >> (n)) & 1)
#define SEAM(k) do { if (IN(k) && IN((k) + 1)) xcd_barrier(bar); } while (0)
    const int bc = (int)blockIdx.x;

    const int nDn = (NE * 64 + F.G - 1) / F.G, nS = (NE * 128 + F.G - 1) / F.G + nDn; int sdone = nDn; const int qgrp = (int)(blockIdx.x >> 3);
#define QSLOT(k24) do { const int e_ = sdone + ((nS - nDn) * (k24) + 23) / 24; do_slabs(F, sdone, e_ < nS ? e_ : nS); sdone = e_; } while (0)
#define QG(slot, nslots, k24) do { if (qgrp % (nslots) == (slot)) QSLOT(k24); } while (0)
    if (IN(0)) { FRAME_RELOAD(); p0_prologue(F); __syncthreads(); { const int nW = (DIN / 32 + F.G - 1) / F.G; do_slabs(F, -nW, 0); } }
    SEAM(0);
    if (IN(1)) { FRAME_RELOAD();
        QG(0, 4, 9);
        if (SUB(0)) { SchedG1N S; S.nt = D / 128; S.pitchA = D / 2; S.pitchB = D / 2; S.multA = 1; S.multB = 1; S.G = F.G; S.c = bc; S.wv = F.wave; S.A = (const char*)WSP(bf16, WS_H0B); S.Bt = (const char*)WSP(bf16, WS_WIN);
          EpiG1N E{WSP(bf16, WS_QS), WSP(bf16, WS_KK), WSP(bf16, WS_GS), WSP(bf16, WS_ACAT), F.dec_f, F.dec_b, WSP(float, WS_SX0), WSP(float, WS_SWIN)};
          gm::gemm_run<EpiG1N, SchedG1N, false, true>(F.lds, S, E); }
        QG(1, 4, 9);
        if (SUB(1)) { SchedG1SF S; S.nt = D / 128; S.pitchA = D / 2; S.pitchB = D / 2; S.multA = 1; S.multB = 128; S.G = F.G; S.c = bc; S.wv = F.wave; S.A = (const char*)WSP(bf16, WS_WIN); S.Bt = (const char*)WSP(bf16, WS_H0B);
          EpiG1SF E{WSP(bf16, WS_UTT), WSP(float, WS_SX0), WSP(float, WS_SWIN)};
          gm::gemm_run<EpiG1SF, SchedG1SF, false, true>(F.lds, S, E); }
        QG(2, 4, 9);
        if (SUB(2)) { SchedG1SKV S; S.nt = D / 128; S.pitchA = D / 2; S.pitchB = D / 2; S.multA = 1; S.multB = 1; S.G = F.G; S.c = bc; S.wv = F.wave; S.A = (const char*)WSP(bf16, WS_WIN); S.Bt = (const char*)WSP(bf16, WS_H0B);
          EpiG1SKV E{WSP(bf16, WS_KTW), WSP(bf16, WS_BCAT), F.dec_f, F.dec_b, WSP(float, WS_SX0), WSP(float, WS_SWIN)};
          gm::gemm_run<EpiG1SKV, SchedG1SKV, false, true>(F.lds, S, E); }
        QG(3, 4, 9);
    }
    SEAM(1);
    if (IN(2)) { FRAME_RELOAD();
        QG(0, 4, 3);
        if (SUB(3)) { SchedFixA S; S.nt = 2; S.pitchA = 128; S.pitchB = 128; S.multA = 1; S.multB = 1; S.G = F.G; S.c = bc; S.wv = F.wave; S.A = (const char*)WSP(bf16, WS_TAB); S.Bt = (const char*)WSP(bf16, WS_UTT); S.ncol = 512;
          EpiS1 E{WSP(bf16, WS_A1)};
          gm::gemm_run<EpiS1, SchedFixA, false>(F.lds, S, E); }
        QG(1, 4, 3);
        if (SUB(4)) { SchedScores S; S.nt = 4; S.pitchA = RW; S.pitchB = RW; S.multA = 1; S.multB = 1; S.G = F.G; S.c = bc; S.wv = F.wave; S.Q = (const char*)WSP(bf16, WS_QS); S.Kk = (const char*)WSP(bf16, WS_KK);
          EpiScores E{WSP(bf16, WS_ACAT), F.dec_f, F.dec_b};
          gm::gemm_run<EpiScores, SchedScores, false>(F.lds, S, E); }
        QG(2, 4, 3);
        if (SUB(5)) { SchedKV S; S.nt = 4; S.pitchA = CAT; S.pitchB = T; S.multA = 1; S.multB = 1; S.G = F.G; S.c = bc; S.wv = F.wave; S.Bcat = (const char*)WSP(bf16, WS_BCAT); S.kTw = (const char*)WSP(bf16, WS_KTW);
          EpiKV E{WSP(bf16, WS_KVT)};
          gm::gemm_run<EpiKV, SchedKV, false>(F.lds, S, E); }
        QG(3, 4, 3);
    }
    SEAM(2);
    if (IN(3)) { FRAME_RELOAD();
        QG(0, 3, 3);
        { SchedFixA S; S.nt = 4; S.pitchA = 256; S.pitchB = 256; S.multA = 1; S.multB = 1; S.G = F.G; S.c = bc; S.wv = F.wave; S.A = (const char*)(WSP(bf16, WS_TAB) + 32768); S.Bt = (const char*)WSP(bf16, WS_A1); S.ncol = 512;
          EpiS2 E{WSP(bf16, WS_ZT)};
          gm::gemm_run<EpiS2, SchedFixA, false>(F.lds, S, E); }
        QG(1, 3, 3);
        p3_scan(F);
        QG(2, 3, 3);
    }
    SEAM(3);
    if (IN(4)) { FRAME_RELOAD();
        QG(0, 3, 2);
        { SchedFixB S; S.nt = 4; S.pitchA = 256; S.pitchB = 256; S.multA = 1; S.multB = 1; S.G = F.G; S.c = bc; S.wv = F.wave; S.A = (const char*)WSP(bf16, WS_ZT); S.Bt = (const char*)(WSP(bf16, WS_TAB) + 32768 + 65536); S.nrow = 512;
          EpiChan E{WSP(bf16, WS_Y)};
          gm::gemm_run<EpiChan, SchedFixB, false>(F.lds, S, E); }
        QG(1, 3, 2);
        { SchedOut S; S.nt = CAT / 64; S.pitchA = CAT; S.pitchB = CAT; S.multA = 1; S.multB = 1; S.G = F.G; S.c = bc; S.wv = F.wave; S.Acat = (const char*)WSP(bf16, WS_ACAT); S.Bcat = (const char*)WSP(bf16, WS_BCAT);
          EpiOut E{WSP(bf16, WS_Y), WSP(bf16, WS_GS), F.gn_g};
          gm::gemm_run<EpiOut, SchedOut, false>(F.lds, S, E); }
        QG(2, 3, 2);

    }
    SEAM(4);
    if (IN(5)) { FRAME_RELOAD();
#pragma unroll 1
        for (int call = 0; call < 2; ++call) {
            QG(call, 3, 4);
            Sched2D S; S.nt = D / 64; S.pitchA = D; S.pitchB = D; S.multA = 1; S.multB = 1; S.G = F.G; S.c = bc; S.wv = F.wave; S.A = (const char*)WSP(bf16, WS_Y); S.Bt = (const char*)WSP(bf16, WS_WOUT); S.nM = 64; S.nN = 8;
            S.i0 = call; S.ni = call == 0 ? 1 : 64;
            EpiWout E{WSP(bf16, WS_Z1), F.x, WSP(float, WS_ST0), F.ln0_g, F.ln0_b};
            gm::gemm_run<EpiWout, Sched2D, false>(F.lds, S, E);
        }
        QG(2, 3, 4);
        do_slabs(F, sdone < nS ? sdone : nS, nS);
    }
    SEAM(5);
    if (IN(6)) { FRAME_RELOAD(); p6_router(F); }
    SEAM(6);
    if (IN(7) || IN(8) || IN(9)) build_tstart(F, tstart);
    if (IN(7)) { FRAME_RELOAD();
        build_units(F, tstart, 16, bc);
#pragma unroll 1
        for (int call = 0; call < 8; ++call) {
            if (qgrp % 9 == call) do_slabs(F, 0, nDn);
            SchedMoEUpT S; S.nt = D / 128; S.pitchA = D / 2; S.pitchB = D / 2; S.multA = 1; S.multB = 1; S.G = F.G; S.c = bc; S.wv = F.wave; S.A = (const char*)WSP(char, WS_H1Q); S.Bt = (const char*)WSP(char, WS_WUP);
            S.tstart = tstart; S.row_tok = WSP(int, WS_RT) + 12 * T; S.cnt = F.ctl + CW_CNT; S.nN = 16; S.rowbytes = D; S.estride = (size_t)2 * DFF * D;
            S.rsc = WSP(float, WS_RSC); S.swup = WSP(float, WS_SWUP); S.b_up = F.b_up;
            S.u0 = call == 0 ? 0 : 1 + 2 * call; S.u1 = call == 7 ? 64 : 3 + 2 * call;
            EpiUp E{(unsigned char*)(F.ws + WS_ACTQ)};
            gm::gemm_run<EpiUp, SchedMoEUpT, true, true, true>(F.lds, S, E);
        }
        if (qgrp % 9 == 8) do_slabs(F, 0, nDn);
    }
    SEAM(7);
    if (IN(8)) { FRAME_RELOAD();
        build_units(F, tstart, 8, bc);
        SchedMoEDown S; S.nt = DFF / 128; S.pitchA = DFF / 2; S.pitchB = DFF / 2; S.multA = 1; S.multB = 1; S.G = F.G; S.c = bc; S.wv = F.wave; S.A = (const char*)WSP(char, WS_ACTQ); S.Bt = (const char*)WSP(char, WS_WDN);
        S.tstart = tstart; S.row_tok = nullptr; S.cnt = F.ctl + CW_CNT; S.nN = 8; S.rowbytes = DFF; S.estride = (size_t)D * DFF;
        S.sa = nullptr; S.swdn = WSP(float, WS_SWDN); S.b_dn = F.b_dn; S.rsc = nullptr; S.swup = nullptr; S.b_up = nullptr;
        EpiDown E{(unsigned char*)(F.ws + WS_YR)};
        gm::gemm_run<EpiDown, SchedMoEDown, false, 2, true>(F.lds, S, E);
    }
    SEAM(8);
    if (IN(9)) { FRAME_RELOAD(); p9_combine(F, tstart); }
#undef IN
#undef SEAM
}

#ifndef MK_SPLIT
#define MK_SPLIT 0
#endif
extern "C" void kernel_launch(void* const* d_in, const int* in_sizes, int n_in, void* d_out, int out_size, void* d_ws, size_t ws_size, hipStream_t stream) {
    static int grid = 0;
    if (grid == 0) {
        if (n_in != 18 || out_size != T * D || ws_size < WS_END2) { fprintf(stderr, "kernel_launch: unexpected problem: n_in %d out %d ws %zu (need %zu)\n", n_in, out_size, ws_size, (size_t)WS_END2); grid = -1; return; }
        int dev = 0, cus = 0, per_cu = 0;
        if (hipGetDevice(&dev) != hipSuccess || hipDeviceGetAttribute(&cus, hipDeviceAttributeMultiprocessorCount, dev) != hipSuccess) { grid = -1; return; }
        if (hipFuncSetAttribute((const void*)fwd, hipFuncAttributeMaxDynamicSharedMemorySize, LDS_BYTES) != hipSuccess) { fprintf(stderr, "kernel_launch: hipFuncSetAttribute failed\n"); grid = -1; return; }
        if (hipOccupancyMaxActiveBlocksPerMultiprocessor(&per_cu, (const void*)fwd, NTHR, LDS_BYTES) != hipSuccess || per_cu < 1) { fprintf(stderr, "kernel_launch: occupancy query reports %d\n", per_cu); }
        (void)hipGetLastError();
        grid = cus;
    }
    if (grid < 0) return;
    (void)hipMemsetAsync((char*)d_ws + WS_CTL, 0, CTL_BYTES, stream);
    Args a{};
    for (int i = 0; i < 18; ++i) a.in[i] = (const float*)d_in[i];
    a.out = (float*)d_out; a.ws = (unsigned char*)d_ws;
#if MK_SPLIT
    for (int p = 0; p < NPH; ++p) { a.ph_lo = p; a.ph_hi = p + 1; hipLaunchKernelGGL(fwd, dim3(grid), dim3(NTHR), LDS_BYTES, stream, a); }
#else
    a.ph_lo = 0; a.ph_hi = NPH; hipLaunchKernelGGL(fwd, dim3(grid), dim3(NTHR), LDS_BYTES, stream, a);
#endif
}
```

```cpp
#include <hip/hip_runtime.h>
#include <cstdio>
#include <cstdint>

#define GAS __attribute__((address_space(1)))
#define LAS __attribute__((address_space(3)))
typedef unsigned short bf16;
typedef unsigned v4u __attribute__((ext_vector_type(4)));
typedef unsigned v2u __attribute__((ext_vector_type(2)));
typedef float f32x4 __attribute__((ext_vector_type(4)));
typedef float f32x2 __attribute__((ext_vector_type(2)));
typedef short bf16x8 __attribute__((ext_vector_type(8)));
typedef int i32x4 __attribute__((ext_vector_type(4)));
typedef int i32x8 __attribute__((ext_vector_type(8)));
#define RLX_AGENT __ATOMIC_RELAXED, __HIP_MEMORY_SCOPE_AGENT
#define LDS_WAIT() asm volatile("s_waitcnt lgkmcnt(0)" ::: "memory")
#define VM_WAIT() asm volatile("s_waitcnt vmcnt(0)" ::: "memory")

constexpr int T = 16384, D = 2048, DIN = 5120, FW = 1024, RW = 1024, NH = 4, HD = 256, NE = 32, TOPK = 4, DFF = 2048;
constexpr int C2 = 256, NCH = T / C2;
constexpr int CAT = 768;
constexpr float LN_EPS = 1e-5f, GN_EPS = 1e-6f, ALPHA = 1.189207115002721f;
constexpr int RT_MAX = (T * TOPK) / 256 + NE;
constexpr int NWAVES = 8, NTHR = 512;

constexpr size_t MiB = 1u << 20;
constexpr size_t WS_CTL = 0, CTL_BYTES = 1 * MiB;
constexpr size_t WS_TAB = 1 * MiB;
constexpr size_t WS_WIN = 2 * MiB;
constexpr size_t WS_WOUT = WS_WIN + 20 * MiB;
constexpr size_t WS_WUP = WS_WOUT + 8 * MiB;
constexpr size_t WS_WDN = WS_WUP + 512 * MiB;
constexpr size_t WS_H0B = WS_WDN + 256 * MiB;
constexpr size_t WS_ST0 = WS_H0B + 64 * MiB;
constexpr size_t WS_UTT = WS_ST0 + 1 * MiB;
constexpr size_t WS_A1 = WS_UTT + 32 * MiB;
constexpr size_t WS_ZT = WS_A1 + 64 * MiB;
constexpr size_t WS_QS = WS_ZT + 64 * MiB;
constexpr size_t WS_KK = WS_QS + 32 * MiB;
constexpr size_t WS_GS = WS_KK + 32 * MiB;
constexpr size_t WS_ACAT = WS_GS + 32 * MiB;
constexpr size_t WS_BCAT = WS_ACAT + 96 * MiB;
constexpr size_t WS_KTW = WS_BCAT + 96 * MiB;
constexpr size_t WS_KVT = WS_KTW + 64 * MiB;
constexpr size_t WS_Y = WS_KVT + 128 * MiB;
constexpr size_t WS_Z1 = WS_Y + 64 * MiB;
constexpr size_t WS_H1B = WS_Z1 + 128 * MiB;
constexpr size_t WS_RT = WS_H1B + 64 * MiB;
constexpr size_t WS_ACT = WS_RT + 4 * MiB;
constexpr size_t WS_YR = WS_ACT + 288 * MiB;
constexpr size_t WS_END = WS_YR + 288 * MiB;
constexpr size_t WS_SWUP = WS_TAB + 512 * 1024;
constexpr size_t WS_H1Q = WS_H1B;
constexpr size_t WS_SX = WS_H1B + 32 * MiB, WS_RSC = WS_H1B + 40 * MiB, WS_SA = WS_H1B + 44 * MiB;
constexpr size_t WS_SWDN = WS_ST0 + 512 * 1024;
constexpr size_t WS_SWIN = WS_ST0 + 768 * 1024;
constexpr size_t WS_SX0 = WS_H0B + 40 * MiB;
constexpr size_t WS_WRT = WS_ACT;
constexpr size_t WS_ACTQ = WS_END;
constexpr size_t WS_END2 = WS_ACTQ + 144 * MiB;
constexpr int CW_RMAX = 16384;
constexpr int CW_BAR = 1024;
constexpr int CW_CNT = 8192;

constexpr int LDS_STAGE = 131072, LDS_SCR = 16384, LDS_CTL_OFF = LDS_STAGE + LDS_SCR, LDS_BYTES = LDS_CTL_OFF + 2048;

__device__ __forceinline__ unsigned cvt_pk_bf16(float lo, float hi) { unsigned r; asm volatile("v_cvt_pk_bf16_f32 %0, %1, %2" : "=v"(r) : "v"(lo), "v"(hi)); return r; }
__device__ __forceinline__ float bf_lo(unsigned u) { return __builtin_bit_cast(float, u << 16); }
__device__ __forceinline__ float bf_hi(unsigned u) { return __builtin_bit_cast(float, u & 0xffff0000u); }
__device__ __forceinline__ v4u pack8(const f32x4 a, const f32x4 b) { v4u w; w.x = cvt_pk_bf16(a[0], a[1]); w.y = cvt_pk_bf16(a[2], a[3]); w.z = cvt_pk_bf16(b[0], b[1]); w.w = cvt_pk_bf16(b[2], b[3]); return w; }
__device__ __forceinline__ float wave_sum(float v) {
#pragma unroll
    for (int o = 1; o < 64; o <<= 1) v += __shfl_xor(v, o);
    return v;
}
__device__ __forceinline__ int lane_id() { int l; asm volatile("v_mbcnt_lo_u32_b32 %0, -1, 0\n\tv_mbcnt_hi_u32_b32 %0, -1, %0" : "=v"(l)); return l; }
__device__ __forceinline__ float fexp(float x) { return __builtin_amdgcn_exp2f(x * 1.4426950408889634f); }
__device__ __forceinline__ void cs_rev(float rev, float& c, float& s) { const float f = __builtin_amdgcn_fractf(rev); c = __builtin_amdgcn_cosf(f); s = __builtin_amdgcn_sinf(f); }

#define XB_TMO      128
#define XB_XCNT(j)  (256  + 64 * (j))
#define XB_XSUB(j)  (1280 + 64 * (j))
#define XB_XGEN(j)  (2304 + 64 * (j))
#define XB_TOP      3328
#define XB_TOPGEN   3392
#define XCD_BAR_WORDS 3456
#define XB_SPIN_CAP (1u << 18)
__device__ __forceinline__ unsigned xb_ld(unsigned* p)              { return __hip_atomic_load(p, __ATOMIC_RELAXED, __HIP_MEMORY_SCOPE_AGENT); }
__device__ __forceinline__ unsigned xb_add(unsigned* p, unsigned v) { return __hip_atomic_fetch_add(p, v, __ATOMIC_RELAXED, __HIP_MEMORY_SCOPE_AGENT); }
__device__ __forceinline__ unsigned xb_xcc_id() { return (unsigned)__builtin_amdgcn_s_getreg((3 << 11) | 20) & 0xFu; }
#define XB_SPIN(cond, bar) do { unsigned _sp = 0; while (cond) { __builtin_amdgcn_s_sleep(1); \
    if ((++_sp & 255u) == 0u) { if (xb_ld(&(bar)[XB_TMO])) break; if (_sp > XB_SPIN_CAP) { atomicAdd(&(bar)[XB_TMO], 1u); break; } } } } while (0)
struct XcdBarrier { unsigned* bar; unsigned x; volatile LAS unsigned* st; int wave; };
__device__ __forceinline__ XcdBarrier xcd_barrier_post(unsigned* bar, volatile LAS unsigned* st) {
    XcdBarrier b; b.bar = bar; b.x = xb_xcc_id(); b.st = st;
    if (threadIdx.x == 0) (void)xb_add(&bar[XB_XCNT(b.x)], 1u);
    return b;
}
__device__ __forceinline__ void xcd_barrier_complete(unsigned* bar, unsigned x, unsigned& nloc, unsigned& nx) {
    const unsigned G = gridDim.x * gridDim.y * gridDim.z;
    unsigned sum, cnt, mine, sp = 0u;
    for (;;) {
        sum = 0u; cnt = 0u; mine = 0u;
#pragma unroll
        for (unsigned j = 0; j < 16; ++j) { const unsigned c = xb_ld(&bar[XB_XCNT(j)]); sum += c; cnt += (c > 0u) ? 1u : 0u; mine = (j == x) ? c : mine; }
        if (sum == G) break;
        __builtin_amdgcn_s_sleep(1);
        if ((++sp & 255u) == 0u) { if (xb_ld(&bar[XB_TMO])) break; if (sp > XB_SPIN_CAP) { atomicAdd(&bar[XB_TMO], 1u); break; } }
    }
    nloc = mine > 0u ? mine : 1u; nx = cnt > 0u ? cnt : 1u;
}
__device__ __forceinline__ void xcd_barrier(const XcdBarrier& b) {
    asm volatile("s_waitcnt vmcnt(0)" ::: "memory");
    __syncthreads();
    if (b.wave == 0 && lane_id() == 0) {
        unsigned* bar = b.bar;
        __builtin_amdgcn_s_waitcnt(0);
        unsigned nloc = b.st[0], nx = b.st[1];
        if (nloc == 0u) { xcd_barrier_complete(bar, b.x, nloc, nx); b.st[0] = nloc; b.st[1] = nx; }
        const unsigned old = xb_add(&bar[XB_XSUB(b.x)], 1u);
        const unsigned gen = old / nloc;
        if (old + 1u == (gen + 1u) * nloc) {
            __builtin_amdgcn_fence(__ATOMIC_RELEASE, "agent");
            asm volatile("s_waitcnt vmcnt(0)" ::: "memory");
            const unsigned og = xb_add(&bar[XB_TOP], 1u);
            const unsigned tg = og / nx;
            if (og + 1u == (tg + 1u) * nx) xb_add(&bar[XB_TOPGEN], 1u);
            else XB_SPIN(xb_ld(&bar[XB_TOPGEN]) == tg, bar);
            __builtin_amdgcn_fence(__ATOMIC_ACQUIRE, "agent");
            xb_add(&bar[XB_XGEN(b.x)], 1u);
            asm volatile("s_waitcnt vmcnt(0)" ::: "memory");
        } else {
            XB_SPIN(xb_ld(&bar[XB_XGEN(b.x)]) == gen, bar);
            __builtin_amdgcn_fence(__ATOMIC_ACQUIRE, "agent");
            asm volatile("s_waitcnt vmcnt(0)" ::: "memory");
        }
    }
    __syncthreads();
}

namespace gm {
constexpr int BM = 256, BK = 64, HALF = 128, HTB = HALF * BK * 2, STAGE_BYTES = 8 * HTB;
__device__ __forceinline__ int lds_byte(int r, int c) { const int st = (r >> 4) * 2 + (c >> 5), rr = r & 15, cc = c & 31, ob = rr * 64 + cc * 2; return st * 1024 + (ob ^ (((ob >> 9) & 1) << 5)); }
__device__ __forceinline__ void stage_rc(int b, int& R, int& C) { const int st = b / 1024, sb = b % 1024, swz = sb ^ (((sb >> 9) & 1) << 5); R = (st >> 1) * 16 + swz / 64; C = (st & 1) * 32 + (swz % 64) / 2; }
__device__ __forceinline__ int perm32(int rho) { const int n = rho >> 4, i = rho & 15; return 8 * (i >> 2) + 4 * n + (i & 3); }

struct Unit { const char* a0; const char* a1; const char* b0; const char* b1; int p0, p1, p2, p3, q; };

__device__ __forceinline__ void tile_order(int L, int nM, int nN, int& pm, int& pn) {
    const int nwg = nM * nN; int wgid = L;
    { const int q = nwg / 8, r = nwg % 8, xcd = wgid % 8, off = wgid / 8; wgid = (xcd < r ? xcd * (q + 1) : r * (q + 1) + (xcd - r) * q) + off; }
    const int nig = 8 * nN, gid = wgid / nig, fm = gid * 8, gsz = (nM - fm) < 8 ? (nM - fm) : 8;
    pm = fm + ((wgid % nig) % gsz); pn = (wgid % nig) / gsz;
}

template <int I8> struct AccSel { typedef f32x4 type; };
template <> struct AccSel<1> { typedef i32x4 type; };
template <class Epi, class Sched, bool GATHER, int I8 = 0, bool PREF = false>
__device__ __forceinline__ void gemm_run(LAS unsigned char* lds, const Sched& S, const Epi& E) {
    const int wid = S.wv, lane = lane_id(), tid = wid * 64 + lane, wr = wid >> 2, wc = wid & 3, fr = lane & 15, fq = lane >> 4;
    int nt = S.nt; asm volatile("" : "+s"(nt));
    unsigned voffA[2], voffB[2], colA[2]; int rowA[2];
#pragma unroll
    for (int i = 0; i < 2; ++i) { int R, C; stage_rc(tid * 16 + i * 8192, R, C); const int Rb = Epi::PERM ? ((R & ~31) + perm32(R & 31)) : R;
        voffA[i] = (unsigned)(R * S.multA * S.pitchA + C) * 2u; voffB[i] = (unsigned)(Rb * S.multB * S.pitchB + C) * 2u; colA[i] = (unsigned)C * 2u; rowA[i] = R; }
    const size_t kstep = (size_t)(BK * 2);
    const unsigned ldsw = (unsigned)wid * 1024u;
    const int aoff = lds_byte(wr * 64 + fr, fq * 8), boff = lds_byte(wc * 32 + fr, fq * 8);
#define G_SA(b, h) (((b) * 2 + (h)) * HTB)
#define G_SB(b, h) ((4 + (b) * 2 + (h)) * HTB)
#define G_STAGE(bufoff, gbase, voff) do { _Pragma("unroll") for (int _i = 0; _i < 2; ++_i) \
        __builtin_amdgcn_global_load_lds((const unsigned*)((const char*)(gbase) + (voff)[_i]), (LAS unsigned*)(lds + (bufoff) + ldsw + _i * 8192), 16, 0, 0); } while (0)
#define G_LD8(dst, addr) do { const i32x4 lo_ = *(const LAS i32x4*)(addr), hi_ = *(const LAS i32x4*)((addr) + 1024); dst = __builtin_shufflevector(lo_, hi_, 0, 1, 2, 3, 4, 5, 6, 7); } while (0)
#define G_LDA(dst, b, h) do { _Pragma("unroll") for (int m = 0; m < 4; ++m) G_LD8(dst[m], lds + G_SA(b, h) + aoff + m * 2048); } while (0)
#define G_LDB(dst, b, h) do { _Pragma("unroll") for (int n = 0; n < 2; ++n) G_LD8(dst[n], lds + G_SB(b, h) + boff + n * 2048); } while (0)
#define G_H4(x, k) ((k) ? __builtin_shufflevector(x, x, 4, 5, 6, 7) : __builtin_shufflevector(x, x, 0, 1, 2, 3))
#define G_MMA(ai, bj, At, Bt) do { __builtin_amdgcn_s_setprio(1); _Pragma("unroll") for (int m = 0; m < 4; ++m) _Pragma("unroll") for (int n = 0; n < 2; ++n) { \
        if constexpr (I8 == 2) acc[ai][bj][m][n] = __builtin_amdgcn_mfma_scale_f32_16x16x128_f8f6f4(Bt[n], At[m], acc[ai][bj][m][n], 0, 0, 0, 0x7F7F7F7F, 0, 0x7F7F7F7F); \
        else { _Pragma("unroll") for (int k = 0; k < 2; ++k) { \
            if constexpr (I8 == 1) acc[ai][bj][m][n] = __builtin_amdgcn_mfma_i32_16x16x64_i8(G_H4(Bt[n], k), G_H4(At[m], k), acc[ai][bj][m][n], 0, 0, 0); \
            else acc[ai][bj][m][n] = __builtin_amdgcn_mfma_f32_16x16x32_bf16(__builtin_bit_cast(bf16x8, G_H4(Bt[n], k)), __builtin_bit_cast(bf16x8, G_H4(At[m], k)), acc[ai][bj][m][n], 0, 0, 0); } } } \
        __builtin_amdgcn_s_setprio(0); } while (0)
#define G_WAIT_V(n) asm volatile("s_waitcnt vmcnt(" #n ")" ::: "memory")
#define G_WAIT_L(n) asm volatile("s_waitcnt lgkmcnt(" #n ")" ::: "memory")
#define G_BAR __builtin_amdgcn_s_barrier()
#define G_SCHED __builtin_amdgcn_sched_barrier(0)
    Unit cur, nxt; int ui = 0;
    if (!S.next(0, cur)) return;
    cur.q = 0;
    if constexpr (PREF) { S.prefetch(cur, lds); G_WAIT_V(0); G_BAR; }
    typedef typename AccSel<I8>::type acc_t;
    acc_t acc[2][2][4][2];
#pragma unroll
    for (int a = 0; a < 2; ++a)
#pragma unroll
        for (int b = 0; b < 2; ++b)
#pragma unroll
            for (int m = 0; m < 4; ++m)
#pragma unroll
                for (int n = 0; n < 2; ++n) acc[a][b][m][n] = (acc_t){0, 0, 0, 0};
    i32x8 At[4], B0[2], B1[2];
    unsigned gc0[2], gc1[2];
    if constexpr (GATHER) {
#pragma unroll
        for (int i = 0; i < 2; ++i) { gc0[i] = S.row_off(cur, rowA[i], lds) + colA[i]; gc1[i] = S.row_off(cur, 128 + rowA[i], lds) + colA[i]; }
    }
#define vA0 (GATHER ? gc0 : voffA)
#define vA1 (GATHER ? gc1 : voffA)
    G_STAGE(G_SB(0, 0), cur.b0, voffB); G_STAGE(G_SB(0, 1), cur.b1, voffB); G_STAGE(G_SA(0, 0), cur.a0, vA0); G_STAGE(G_SA(0, 1), cur.a1, vA1);
    if (wr == 1) G_BAR;
    G_WAIT_V(2); G_BAR;
    G_STAGE(G_SB(1, 0), cur.b0 + kstep, voffB); G_STAGE(G_SA(1, 0), cur.a0 + kstep, vA0); G_STAGE(G_SB(1, 1), cur.b1 + kstep, voffB);
    G_WAIT_V(6); G_BAR;
    for (;;) {
        const bool has_next = S.next(ui + 1, nxt);
        if (!has_next) nxt = cur;
        nxt.q = (ui + 1) & 1;
        for (int t = 0; t < nt; t += 2) {
            const bool last = (t == nt - 2);
            { const int tz_ = wid * 64 + lane_id();
#pragma unroll
              for (int i = 0; i < 2; ++i) { int R, C; stage_rc(tz_ * 16 + i * 8192, R, C); const int Rb = Epi::PERM ? ((R & ~31) + perm32(R & 31)) : R;
                  voffA[i] = (unsigned)(R * S.multA * S.pitchA + C) * 2u; voffB[i] = (unsigned)(Rb * S.multB * S.pitchB + C) * 2u; } }
            if constexpr (GATHER) asm volatile("" : "+v"(gc0[0]), "+v"(gc0[1]), "+v"(gc1[0]), "+v"(gc1[1]));
            if constexpr (PREF) { if (t == nt - 4) S.prefetch(nxt, lds); }
            const char* a11 = cur.a1 + (size_t)(t + 1) * kstep;
            const char* a02 = last ? nxt.a0 : cur.a0 + (size_t)(t + 2) * kstep; const char* a12 = last ? nxt.a1 : cur.a1 + (size_t)(t + 2) * kstep;
            const char* b02 = last ? nxt.b0 : cur.b0 + (size_t)(t + 2) * kstep; const char* b12 = last ? nxt.b1 : cur.b1 + (size_t)(t + 2) * kstep;
            G_LDB(B0, 0, 0); G_LDB(B1, 0, 1); G_SCHED; G_LDA(At, 0, 0); G_STAGE(G_SA(1, 1), a11, vA1);
            if constexpr (GATHER) { if (last) { int tz = tid; asm volatile("" : "+v"(tz));
#pragma unroll
                for (int i = 0; i < 2; ++i) { int R, C; stage_rc(tz * 16 + i * 8192, R, C); gc0[i] = S.row_off(nxt, R, lds) + (unsigned)C * 2u; gc1[i] = S.row_off(nxt, 128 + R, lds) + (unsigned)C * 2u; } } }
            G_WAIT_L(0); G_BAR; G_MMA(0, 0, At, B0); G_MMA(0, 1, At, B1); G_WAIT_V(8); G_BAR; G_SCHED;
            G_LDA(At, 0, 1); G_STAGE(G_SB(0, 0), b02, voffB); G_STAGE(G_SB(0, 1), b12, voffB); G_STAGE(G_SA(0, 0), a02, vA0);
            G_WAIT_L(0); G_BAR; G_MMA(1, 0, At, B0); G_MMA(1, 1, At, B1); G_WAIT_V(8); G_BAR; G_SCHED;
            G_LDB(B0, 1, 0); G_LDB(B1, 1, 1); G_SCHED; G_LDA(At, 1, 0); G_STAGE(G_SA(0, 1), a12, vA1);
            G_WAIT_L(0); G_BAR; G_MMA(0, 0, At, B0); G_MMA(0, 1, At, B1); G_WAIT_V(8); G_BAR; G_SCHED;
            G_LDA(At, 1, 1); G_STAGE(G_SB(1, 0), b02 + kstep, voffB); G_STAGE(G_SB(1, 1), b12 + kstep, voffB); G_STAGE(G_SA(1, 0), a02 + kstep, vA0);
            G_WAIT_L(0); G_BAR; G_MMA(1, 0, At, B0); G_MMA(1, 1, At, B1); G_WAIT_V(8); G_BAR; G_SCHED;
        }
        if (wr == 0) G_BAR;
        { int fr2 = fr, fq2 = fq; asm volatile("" : "+v"(fr2), "+v"(fq2));
          E(acc, cur, lds, wr, wc, fr2, fq2); }
        if (!has_next) break;
#pragma unroll
        for (int a = 0; a < 2; ++a)
#pragma unroll
            for (int b = 0; b < 2; ++b)
#pragma unroll
                for (int m = 0; m < 4; ++m)
#pragma unroll
                    for (int n = 0; n < 2; ++n) acc[a][b][m][n] = (acc_t){0, 0, 0, 0};
        cur = nxt; ++ui;
        if (wr == 1) G_BAR;
    }
    G_WAIT_V(0);
    G_BAR;
#undef G_SA
#undef G_SB
#undef G_STAGE
#undef G_LDA
#undef G_LD8
#undef G_H4
#undef G_LDB
#undef G_MMA
#undef G_WAIT_V
#undef G_WAIT_L
#undef G_BAR
#undef G_SCHED
#undef vA0
#undef vA1
}
}
using gm::Unit;
typedef f32x4 Acc[2][2][4][2];
typedef i32x4 AccI[2][2][4][2];

struct Args { const float* in[18]; float* out; unsigned char* ws; int ph_lo, ph_hi; };
struct Frame {
    LAS unsigned char* lds; unsigned char* ws; unsigned* ctl;
    int wave, vcu, G;
    const float *x, *ln0_g, *ln0_b, *w_in, *dec_f, *dec_b, *gn_g, *w_out, *ln1_g, *ln1_b, *w_r, *b_r, *w_up, *b_up, *w_dn, *b_dn, *ln2_g, *ln2_b;
    float* out;
};
#define WSP(T_, off) ((T_*)(F.ws + (off)))
#define FLANE lane_id()
#define FTID (F.wave * 64 + lane_id())

template <class ColMap>
__device__ __forceinline__ void transpose_item(const float* W, int K, int N, bf16* WT, LAS float* scr, int item, int lane, const ColMap& cm) {
    const int nblk = N / 64, kb = item / nblk, nb = item % nblk, k0 = 64 * kb, n0 = 64 * nb;
    const int s0 = cm(n0);
#pragma unroll 4
    for (int i = 0; i < 16; ++i) { const int kk = 4 * i + (lane >> 4), c4 = (lane & 15) * 4;
        const f32x4 v = *(const GAS f32x4*)(W + (size_t)(k0 + kk) * N + s0 + c4);
        LAS float* d = scr + kk * 65 + c4; d[0] = v[0]; d[1] = v[1]; d[2] = v[2]; d[3] = v[3]; }
    LDS_WAIT(); asm volatile("" ::: "memory");
    const int c = lane & 7;
#pragma unroll
    for (int j = 0; j < 8; ++j) { const int n = (lane >> 3) + 8 * j; const LAS float* s = scr + (8 * c) * 65 + n;
        v4u o; o.x = cvt_pk_bf16(s[0 * 65], s[1 * 65]); o.y = cvt_pk_bf16(s[2 * 65], s[3 * 65]); o.z = cvt_pk_bf16(s[4 * 65], s[5 * 65]); o.w = cvt_pk_bf16(s[6 * 65], s[7 * 65]);
        *(GAS v4u*)(WT + (size_t)(n0 + n) * K + k0 + 8 * c) = o; }
    LDS_WAIT(); asm volatile("" ::: "memory");
}
struct ColId { __device__ __forceinline__ int operator()(int n) const { return n; } };
struct ColUp { __device__ __forceinline__ int operator()(int n) const { return ((n >> 8) * 128 + (n & 127)) + ((n >> 7) & 1) * 2048; } };

__device__ __forceinline__ void p0_prologue(Frame& F) {
    const int gw = F.vcu * NWAVES + F.wave, NGW = F.G * NWAVES;
    {
        unsigned* h0q = WSP(unsigned, WS_H0B); float* st0 = WSP(float, WS_ST0); float* sx0 = WSP(float, WS_SX0);
        const int nsl = (DIN / 32 < F.G) ? DIN / 32 : F.G, nA = nsl * NWAVES, nB = NGW - nA, per2 = (2 * T + 8 * nA) / NGW;
        const int TA = (nB == 0) ? T : (per2 > 8 ? (nA * (per2 - 8)) / 2 : 0);
        const bool inA = F.vcu < nsl; const int m0 = inA ? gw : TA + (gw - nA), m1 = inA ? TA : T, mst = inA ? nA : nB;
        for (int m = m0; m < m1; m += mst) {
            const GAS f32x4* xr = (const GAS f32x4*)(F.x + (size_t)m * D) + FLANE;
            f32x4 v[8]; float s = 0.f;
#pragma unroll
            for (int j = 0; j < 8; ++j) { v[j] = xr[64 * j]; s += (v[j][0] + v[j][1]) + (v[j][2] + v[j][3]); }
            const float mean = wave_sum(s) * (1.f / D); float s2 = 0.f;
#pragma unroll
            for (int j = 0; j < 8; ++j) { v[j] = v[j] - mean; s2 += (v[j][0] * v[j][0] + v[j][1] * v[j][1]) + (v[j][2] * v[j][2] + v[j][3] * v[j][3]); }
            const float rstd = 1.f / sqrtf(wave_sum(s2) * (1.f / D) + LN_EPS); float am = 0.f;
#pragma unroll
            for (int j = 0; j < 8; ++j) { const f32x4 g = *((const GAS f32x4*)F.ln0_g + FLANE + 64 * j), b = *((const GAS f32x4*)F.ln0_b + FLANE + 64 * j);
                v[j] = v[j] * rstd * g + b; am = fmaxf(am, fmaxf(fmaxf(fabsf(v[j][0]), fabsf(v[j][1])), fmaxf(fabsf(v[j][2]), fabsf(v[j][3])))); }
#pragma unroll
            for (int o = 1; o < 64; o <<= 1) am = fmaxf(am, __shfl_xor(am, o));
            const float sc = am > 0.f ? am * (1.f / 127.f) : 1.f, inv = 1.f / sc;
#pragma unroll
            for (int j = 0; j < 8; ++j) { const int q0 = (int)__builtin_rintf(v[j][0] * inv), q1 = (int)__builtin_rintf(v[j][1] * inv), q2 = (int)__builtin_rintf(v[j][2] * inv), q3 = (int)__builtin_rintf(v[j][3] * inv);
                h0q[(size_t)m * (D / 4) + FLANE + 64 * j] = (unsigned)(q0 & 0xff) | ((unsigned)(q1 & 0xff) << 8) | ((unsigned)(q2 & 0xff) << 16) | ((unsigned)(q3 & 0xff) << 24); }
            if (FLANE == 0) { st0[2 * m] = mean; st0[2 * m + 1] = rstd; sx0[m] = sc; }
        }
    }
    {
        bf16* tab = WSP(bf16, WS_TAB);
        for (int i = (F.vcu * NTHR + FTID); i < 32768 + 65536 + 65536; i += F.G * NTHR) {
            float v;
            if (i < 32768) { const int r = i >> 7, a = i & 127, ri = r >> 7, k1 = r & 127; float c, s; cs_rev((float)((k1 * a) & 127) * (1.f / 128.f), c, s); v = ri ? -s : c; }
            else if (i < 32768 + 65536) { const int e = i - 32768, r = e >> 8, q = e & 255, ri = r >> 7, k2 = r & 127, rj = q >> 7, b = q & 127; float c, s; cs_rev((float)((k2 * b) & 127) * (1.f / 128.f), c, s);
                v = (ri == 0) ? (rj == 0 ? c : s) : (rj == 0 ? -s : c); }
            else { const int e = i - 32768 - 65536, l = e >> 8, q = e & 255, rj = q >> 7, cg = q & 127; float c, s; cs_rev((float)((l * cg) & 127) * (1.f / 128.f), c, s); v = (l < 128) ? (rj == 0 ? c : s) : 0.f; }
            tab[i] = (bf16)(cvt_pk_bf16(v, 0.f) & 0xffffu);
        }
        bf16* wrt = WSP(bf16, WS_WRT);
        for (int i = (F.vcu * NTHR + FTID); i < NE * D; i += F.G * NTHR) { const int e = i >> 11, k = i & 2047; const float v = F.w_r[k * NE + e];
            const unsigned hi = cvt_pk_bf16(v, 0.f) & 0xffffu; const unsigned lo = cvt_pk_bf16(v - bf_lo(hi), 0.f) & 0xffffu; wrt[i] = (bf16)hi; wrt[NE * D + i] = (bf16)lo; }
    }
    {
        LAS float* scr = (LAS float*)(F.lds + F.wave * 18432);
        constexpr int I_IN = 32 * (DIN / 64), I_OUT = 32 * (D / 64), I_UP = 32 * (2 * DFF / 64), I_DN = 32 * (D / 64);
        constexpr int NIT = I_OUT;
        for (int it = NGW - 1 - gw; it < NIT; it += NGW) {
            int r = it;
            { transpose_item(F.w_out, D, D, WSP(bf16, WS_WOUT), scr, r, FLANE, ColId()); }
        }
    }
}

struct SlabDesc { const float* W; signed char* WQ; float* sw; int NS, e, n0, valid, fp8; };
struct QF { unsigned char* ws; const float* w_up; const float* w_dn; const float* w_in; int vcu, G; };
__device__ __forceinline__ SlabDesc slab_desc(const QF& F, int j) {
    const int nD = (NE * 64 + F.G - 1) / F.G; SlabDesc d;
    if (j < 0) { const int sl = F.vcu + (-1 - j) * F.G; d.valid = sl < DIN / 32; d.NS = DIN; d.e = 0; d.n0 = sl * 32; d.W = F.w_in + d.n0; d.WQ = (signed char*)WSP(char, WS_WIN); d.sw = WSP(float, WS_SWIN); d.fp8 = 0; }
    else if (j >= nD) { const int sl = F.vcu + (j - nD) * F.G; d.valid = sl < NE * 128; d.NS = 2 * DFF; d.e = sl >> 7; d.n0 = (sl & 127) * 32; d.W = F.w_up + (size_t)d.e * D * 2 * DFF + ColUp()(d.n0); d.WQ = (signed char*)WSP(char, WS_WUP); d.sw = WSP(float, WS_SWUP); d.fp8 = 0; }
    else { const int sl = F.vcu + j * F.G; d.valid = sl < NE * 64; d.NS = D; d.e = sl >> 6; d.n0 = (sl & 63) * 32; d.W = F.w_dn + (size_t)d.e * DFF * D + d.n0; d.WQ = (signed char*)WSP(char, WS_WDN); d.sw = WSP(float, WS_SWDN); d.fp8 = 1; }
    return d;
}
#define SLAB_LOAD(dsc, v) do { if ((dsc).valid) { const GAS char* b_ = (const GAS char*)(dsc).W; unsigned o_ = (unsigned)((wave * 256 + kq) * (dsc).NS + c4) * 4u; const unsigned st_ = (unsigned)(dsc).NS * 32u; \
    _Pragma("unroll") for (int i_ = 0; i_ < 32; ++i_) { v[i_] = __builtin_nontemporal_load((const GAS f32x4*)(b_ + o_)); o_ += st_; } } } while (0)
__device__ __forceinline__ void do_slabs_impl(LAS unsigned char* lds, unsigned char* ws, const float* w_up, const float* w_dn, const float* w_in, int vcu, int G, int wave, int j0, int j1) {
    if (j0 >= j1) return;
    QF F; F.ws = ws; F.w_up = w_up; F.w_dn = w_dn; F.w_in = w_in; F.vcu = vcu; F.G = G;
    const int lane = lane_id(), tid = wave * 64 + lane;
    constexpr int PITCH = 2056;
    LAS bf16* slab = (LAS bf16*)lds;
    LAS float* red = (LAS float*)(lds + 32 * PITCH * 2);
    const int kq = lane >> 3, c4 = (lane & 7) * 4;
    f32x4 v[32];
    SlabDesc cur = slab_desc(F, j0);
    SLAB_LOAD(cur, v);
    for (int j = j0; j < j1; ++j) {
        if (cur.valid) {
            f32x4 mx = (f32x4){0.f, 0.f, 0.f, 0.f};
#pragma unroll
            for (int i = 0; i < 32; ++i) { const int k = wave * 256 + i * 8 + kq; const f32x4 x = v[i];
                mx[0] = fmaxf(mx[0], fabsf(x[0])); mx[1] = fmaxf(mx[1], fabsf(x[1])); mx[2] = fmaxf(mx[2], fabsf(x[2])); mx[3] = fmaxf(mx[3], fabsf(x[3]));
                const unsigned p01 = cvt_pk_bf16(x[0], x[1]), p23 = cvt_pk_bf16(x[2], x[3]);
                const int ks = k ^ (((c4 >> 3) & 3) << 3);
                slab[(c4 + 0) * PITCH + ks] = (bf16)(p01 & 0xffffu); slab[(c4 + 1) * PITCH + ks] = (bf16)(p01 >> 16); slab[(c4 + 2) * PITCH + ks] = (bf16)(p23 & 0xffffu); slab[(c4 + 3) * PITCH + ks] = (bf16)(p23 >> 16); }
#pragma unroll
            for (int q = 0; q < 4; ++q) { float m = mx[q]; m = fmaxf(m, __shfl_xor(m, 8)); m = fmaxf(m, __shfl_xor(m, 16)); m = fmaxf(m, __shfl_xor(m, 32)); mx[q] = m; }
            if (lane < 8) { LAS float* d = red + wave * 32 + c4; d[0] = mx[0]; d[1] = mx[1]; d[2] = mx[2]; d[3] = mx[3]; }
        }
        const SlabDesc done = cur;
        if (j + 1 < j1) { cur = slab_desc(F, j + 1); SLAB_LOAD(cur, v); }
        __syncthreads();
        if (done.valid && tid < 32) { float m = 0.f;
#pragma unroll
            for (int w = 0; w < 8; ++w) m = fmaxf(m, red[w * 32 + tid]);
            const float sc = m > 0.f ? m * (done.fp8 ? (1.f / 448.f) : (1.f / 127.f)) : 1.f; done.sw[(size_t)done.e * done.NS + done.n0 + tid] = sc; red[256 + tid] = 1.f / sc; }
        __syncthreads();
        if (done.valid) {
#pragma unroll 2
            for (int i = 0; i < 8; ++i) { const int q = tid + NTHR * i, n = q >> 7, kc = q & 127; const float inv = red[256 + n];
                const int sx_ = ((n >> 3) & 3) << 3;
                const v4u a = *(const LAS v4u*)(slab + n * PITCH + ((kc * 16) ^ sx_)), b = *(const LAS v4u*)(slab + n * PITCH + ((kc * 16 + 8) ^ sx_));
                const unsigned src[8] = {a.x, a.y, a.z, a.w, b.x, b.y, b.z, b.w}; unsigned o[4];
                if (done.fp8) {
#pragma unroll
                    for (int d = 0; d < 4; ++d) { int w = __builtin_amdgcn_cvt_pk_fp8_f32(bf_lo(src[2 * d]) * inv, bf_hi(src[2 * d]) * inv, 0, false);
                        w = __builtin_amdgcn_cvt_pk_fp8_f32(bf_lo(src[2 * d + 1]) * inv, bf_hi(src[2 * d + 1]) * inv, w, true); o[d] = (unsigned)w; }
                } else {
#pragma unroll
                for (int d = 0; d < 4; ++d) { unsigned w = 0u;
#pragma unroll
                    for (int h2 = 0; h2 < 2; ++h2) { const unsigned u2 = src[2 * d + h2]; const int q0 = (int)__builtin_rintf(bf_lo(u2) * inv), q1 = (int)__builtin_rintf(bf_hi(u2) * inv);
                        w |= ((unsigned)(q0 & 0xff) << (16 * h2)) | ((unsigned)(q1 & 0xff) << (16 * h2 + 8)); }
                    o[d] = w; }
                }
                __builtin_nontemporal_store((v4u){o[0], o[1], o[2], o[3]}, (GAS v4u*)(done.WQ + ((size_t)done.e * done.NS + done.n0 + n) * D + kc * 16)); }
        }
        __syncthreads();
    }
}

__device__ __forceinline__ void do_slabs(Frame& F, int j0, int j1) { do_slabs_impl(F.lds, F.ws, F.w_up, F.w_dn, F.w_in, F.vcu, F.G, F.wave, j0, j1); }

struct SchedBase { int nt, pitchA, pitchB, multA, multB, G, c, wv; };
struct SchedG1N : SchedBase {
    const char* A; const char* Bt;
    __device__ __forceinline__ bool next(int i, Unit& u) const { const int L = i * G + c; if (L >= 64 * 12) return false; int pm, pn; gm::tile_order(L, 64, 12, pm, pn);
        const int cb = pn < 4 ? 1024 + 256 * pn : (pn < 8 ? 2048 + 256 * (pn - 4) : 4096 + 256 * (pn - 8));
        u.a0 = A + (size_t)pm * 256 * D; u.a1 = u.a0 + (size_t)128 * D; u.b0 = Bt + (size_t)cb * D; u.b1 = u.b0 + (size_t)128 * D; u.p0 = pm; u.p1 = pn; u.p2 = cb; u.p3 = 0; return true; }
};
struct SchedG1SF : SchedBase {
    const char* A; const char* Bt;
    __device__ __forceinline__ bool next(int i, Unit& u) const { const int L = i * G + c; if (L >= 4 * 64) return false; int pm, pn; gm::tile_order(L, 4, 64, pm, pn);
        u.a0 = A + (size_t)pm * 256 * D; u.a1 = u.a0 + (size_t)128 * D; u.b0 = Bt + (size_t)(2 * pn) * D; u.b1 = u.b0 + (size_t)D; u.p0 = pm; u.p1 = pn; u.p2 = 0; u.p3 = 0; return true; }
};
struct SchedG1SKV : SchedBase {
    const char* A; const char* Bt;
    __device__ __forceinline__ bool next(int i, Unit& u) const { const int L = i * G + c; if (L >= 8 * 64) return false; int pm, pn; gm::tile_order(L, 8, 64, pm, pn);
        const int rb = pm < 4 ? 2048 + 256 * pm : 3072 + 256 * (pm - 4);
        u.a0 = A + (size_t)rb * D; u.a1 = u.a0 + (size_t)128 * D; u.b0 = Bt + (size_t)pn * 256 * D; u.b1 = u.b0 + (size_t)128 * D; u.p0 = pm; u.p1 = pn; u.p2 = rb; u.p3 = 0; return true; }
};
struct SchedFixA : SchedBase {
    const char* A; const char* Bt; int ncol;
    __device__ __forceinline__ bool next(int i, Unit& u) const { const int L = i * G + c; if (L >= ncol) return false;
        u.a0 = A; u.a1 = A + (size_t)128 * pitchA * 2; u.b0 = Bt + (size_t)L * 256 * pitchB * 2; u.b1 = u.b0 + (size_t)128 * pitchB * 2; u.p0 = 0; u.p1 = L; u.p2 = 0; u.p3 = 0; return true; }
};
struct SchedFixB : SchedBase {
    const char* A; const char* Bt; int nrow;
    __device__ __forceinline__ bool next(int i, Unit& u) const { const int L = i * G + c; if (L >= nrow) return false;
        u.a0 = A + (size_t)L * 256 * pitchA * 2; u.a1 = u.a0 + (size_t)128 * pitchA * 2; u.b0 = Bt; u.b1 = Bt + (size_t)128 * pitchB * 2; u.p0 = L; u.p1 = 0; u.p2 = 0; u.p3 = 0; return true; }
};
struct SchedScores : SchedBase {
    const char* Q; const char* Kk;
    __device__ __forceinline__ bool next(int i, Unit& u) const { const int L = i * G + c; if (L >= NH * NCH) return false; const int h = L & 3, n = L >> 2;
        u.a0 = Q + ((size_t)n * 256 * RW + h * HD) * 2; u.a1 = u.a0 + (size_t)128 * RW * 2; u.b0 = Kk + ((size_t)n * 256 * RW + h * HD) * 2; u.b1 = u.b0 + (size_t)128 * RW * 2; u.p0 = h; u.p1 = n; u.p2 = 0; u.p3 = 0; return true; }
};
struct SchedKV : SchedBase {
    const char* Bcat; const char* kTw;
    __device__ __forceinline__ bool next(int i, Unit& u) const { const int L = i * G + c; if (L >= 2 * NH * NCH) return false; const int dh = L & 7, n = L >> 3, dir = dh >> 2, h = dh & 3;
        u.a0 = Bcat + ((size_t)(h * NCH + n) * 256 * CAT) * 2; u.a1 = u.a0 + (size_t)128 * CAT * 2;
        u.b0 = kTw + (((size_t)dir * RW + h * HD) * T + (size_t)n * 256) * 2; u.b1 = u.b0 + (size_t)128 * T * 2; u.p0 = dh; u.p1 = n; u.p2 = 0; u.p3 = 0; return true; }
};
struct SchedOut : SchedBase {
    const char* Acat; const char* Bcat;
    __device__ __forceinline__ bool next(int i, Unit& u) const { const int L = i * G + c; if (L >= NH * NCH) return false; const int h = L & 3, n = L >> 2;
        u.a0 = Acat + ((size_t)h * T + (size_t)n * 256) * CAT * 2; u.a1 = u.a0 + (size_t)128 * CAT * 2; u.b0 = Bcat + ((size_t)(h * NCH + n) * 256 * CAT) * 2; u.b1 = u.b0 + (size_t)128 * CAT * 2; u.p0 = h; u.p1 = n; u.p2 = 0; u.p3 = 0; return true; }
};
struct Sched2D : SchedBase {
    const char* A; const char* Bt; int nM, nN;
    __device__ __forceinline__ bool next(int i, Unit& u) const { const int L = i * G + c; if (L >= nM * nN) return false; int pm, pn; gm::tile_order(L, nM, nN, pm, pn);
        u.a0 = A + (size_t)pm * 256 * pitchA * 2; u.a1 = u.a0 + (size_t)128 * pitchA * 2; u.b0 = Bt + (size_t)pn * 256 * pitchB * 2; u.b1 = u.b0 + (size_t)128 * pitchB * 2; u.p0 = pm; u.p1 = pn; u.p2 = 0; u.p3 = 0; return true; }
};
struct SchedMoE : SchedBase {
    const char* A; const char* Bt; const LAS int* tstart; const int* row_tok; const unsigned* cnt; int nN, rowbytes; size_t estride;
    __device__ __forceinline__ bool next(int i, Unit& u) const { const int RT = __builtin_amdgcn_readfirstlane(tstart[NE]); const int L = i * G + c; if (L >= RT * nN) return false; int rt, pn; gm::tile_order(L, RT, nN, rt, pn);
        const int e = __builtin_amdgcn_readfirstlane(tstart[40 + rt]);
        u.b0 = Bt + (size_t)e * estride + (size_t)pn * 256 * rowbytes; u.b1 = u.b0 + (size_t)128 * rowbytes;
        u.a0 = A; u.a1 = A;
        u.p0 = rt; u.p1 = pn; u.p2 = e; u.p3 = (rt - __builtin_amdgcn_readfirstlane(tstart[e])) * 256; return true; }
    __device__ __forceinline__ bool next_tab(int i, Unit& u) const { const int w = (i < 64) ? __builtin_amdgcn_readfirstlane(tstart[400 + i]) : -1; if (w < 0) return false;
        const int rt = w & 1023, pn = (w >> 10) & 31, e = (w >> 15) & 31;
        u.b0 = Bt + (size_t)e * estride + (size_t)pn * 256 * rowbytes; u.b1 = u.b0 + (size_t)128 * rowbytes; u.a0 = A; u.a1 = A;
        u.p0 = rt; u.p1 = pn; u.p2 = e; u.p3 = (rt - __builtin_amdgcn_readfirstlane(tstart[e])) * 256; return true; }
    const float *rsc, *swup, *b_up;
    __device__ __forceinline__ void prefetch(const Unit& u, LAS unsigned char* lds) const {
        LAS unsigned char* blk = lds + LDS_STAGE + u.q * 4096;
        const int wid = wv, e = u.p2; int lane = lane_id(); asm volatile("" : "+v"(lane));
        const int n = (int)cnt[64 * e]; int pos = u.p3 + (wid & 3) * 64 + lane; pos = pos < n ? pos : n - 1;
        if (wid < 4) __builtin_amdgcn_global_load_lds((const unsigned*)(row_tok + (size_t)e * T + pos), (LAS unsigned*)(blk + wid * 256), 4, 0, 0);
        else __builtin_amdgcn_global_load_lds((const unsigned*)(rsc + (size_t)e * T + pos), (LAS unsigned*)(blk + 1024 + (wid - 4) * 256), 4, 0, 0);
        if (wid == 0) __builtin_amdgcn_global_load_lds((const unsigned*)(swup + (size_t)e * 2 * DFF + u.p1 * 256 + lane * 4), (LAS unsigned*)(blk + 2048), 16, 0, 0);
        if (wid == 1) __builtin_amdgcn_global_load_lds((const unsigned*)(b_up + (size_t)e * 2 * DFF + u.p1 * 128 + (lane & 31) * 4 + (lane >> 5) * DFF), (LAS unsigned*)(blk + 3072), 16, 0, 0);
    }
    __device__ __forceinline__ unsigned row_off(const Unit& u, int r, LAS unsigned char* lds) const { return (unsigned)((const LAS int*)(lds + LDS_STAGE + u.q * 4096))[r] * (unsigned)rowbytes; }
};
struct SchedMoEUpT : SchedMoE { int u0, u1;
    __device__ __forceinline__ bool next(int i, Unit& u) const { const int ii = i + u0; if (ii >= u1) return false; return next_tab(ii, u); } };
struct SchedMoEDown : SchedMoE {
    const float *sa, *swdn, *b_dn;
    __device__ __forceinline__ bool next(int i, Unit& u) const { if (!SchedMoE::next_tab(i, u)) return false; u.a0 = A + (size_t)u.p0 * 256 * rowbytes; u.a1 = u.a0 + (size_t)128 * rowbytes; return true; }
    __device__ __forceinline__ void prefetch(const Unit& u, LAS unsigned char* lds) const {
        LAS unsigned char* blk = lds + LDS_STAGE + u.q * 4096;
        const int wid = wv, e = u.p2; int lane = lane_id(); asm volatile("" : "+v"(lane));
        if (wid == 1) __builtin_amdgcn_global_load_lds((const unsigned*)(swdn + (size_t)e * D + u.p1 * 256 + lane * 4), (LAS unsigned*)(blk + 1024), 16, 0, 0);
        if (wid == 2) __builtin_amdgcn_global_load_lds((const unsigned*)(b_dn + (size_t)e * D + u.p1 * 256 + lane * 4), (LAS unsigned*)(blk + 2048), 16, 0, 0);
    }
};

#define EPI_LOOP_AM for (int ai = 0; ai < 2; ++ai) _Pragma("unroll") for (int m = 0; m < 4; ++m)
#define EPI_FENCE __builtin_amdgcn_sched_barrier(0)
struct EpiG1N {
    static constexpr bool PERM = true;
    bf16 *qs, *kk, *gs, *Acat; const float *dec_f, *dec_b, *sx0, *swin;
    __device__ __forceinline__ void operator()(AccI& acci, const Unit& u, LAS unsigned char*, int wr, int wc, int fr, int fq) const {
        const int pm = u.p0, pn = u.p1, c0 = wc * 32 + 8 * fq;
        f32x4 swc[2][2];
#pragma unroll
        for (int bj = 0; bj < 2; ++bj)
#pragma unroll
            for (int n = 0; n < 2; ++n) swc[bj][n] = *(const GAS f32x4*)(swin + u.p2 + 128 * bj + c0 + 4 * n);
#define ACCF(ai_, bj_, m_, n_, j_) ((float)acci[ai_][bj_][m_][n_][j_] * (sxr * swc[bj_][n_][j_]))
        if (pn < 8) {
            const int h = pn & 3; const bool isq = pn < 4;
            float inv[8];
#pragma unroll
            for (int e = 0; e < 8; ++e) inv[e] = __builtin_amdgcn_exp2f(-(float)(c0 + e) * (13.287712379549449f / 128.f)) * 0.15915494309189535f;
            const float lgf = -fexp(dec_f[h]), lgb = -fexp(dec_b[h]);
#pragma unroll
            EPI_LOOP_AM {
                const int r = 128 * ai + 64 * wr + 16 * m + fr, tok = pm * 256 + r; const float pos = (float)tok; const float sxr = sx0[tok];
                f32x4 o1[2], o2[2];
#pragma unroll
                for (int n = 0; n < 2; ++n)
#pragma unroll
                    for (int j = 0; j < 4; ++j) { float c, s; cs_rev(pos * inv[4 * n + j], c, s); const float x1 = ACCF(ai, 0, m, n, j), x2 = ACCF(ai, 1, m, n, j); o1[n][j] = x1 * c - x2 * s; o2[n][j] = x2 * c + x1 * s; }
                if (isq) {
                    bf16* q = qs + (size_t)tok * RW + h * HD + c0; *(GAS v4u*)q = pack8(o1[0], o1[1]); *(GAS v4u*)(q + 128) = pack8(o2[0], o2[1]);
                    const int il = r; const float wf = fexp(lgf * (float)(il + 1)), wb = fexp(lgb * (float)(255 - il));
                    bf16* a = Acat + ((size_t)h * T + tok) * CAT + c0;
                    *(GAS v4u*)(a + 256) = pack8(o1[0] * wf, o1[1] * wf); *(GAS v4u*)(a + 384) = pack8(o2[0] * wf, o2[1] * wf);
                    *(GAS v4u*)(a + 512) = pack8(o1[0] * wb, o1[1] * wb); *(GAS v4u*)(a + 640) = pack8(o2[0] * wb, o2[1] * wb);
                } else {
                    bf16* k = kk + (size_t)tok * RW + h * HD + c0; *(GAS v4u*)k = pack8(o1[0] * 0.0625f, o1[1] * 0.0625f); *(GAS v4u*)(k + 128) = pack8(o2[0] * 0.0625f, o2[1] * 0.0625f);
                }
            }
        } else {
#pragma unroll
            EPI_LOOP_AM {
                const int r = 128 * ai + 64 * wr + 16 * m + fr, tok = pm * 256 + r; const float sxr = sx0[tok];
#pragma unroll
                for (int bj = 0; bj < 2; ++bj) { f32x4 v[2];
#pragma unroll
                    for (int n = 0; n < 2; ++n)
#pragma unroll
                        for (int j = 0; j < 4; ++j) { const float g = ACCF(ai, bj, m, n, j); v[n][j] = g * __builtin_amdgcn_rcpf(1.f + fexp(-g)); }
                    *(GAS v4u*)(gs + (size_t)tok * RW + (pn - 8) * 256 + bj * 128 + c0) = pack8(v[0], v[1]); }
            }
        }
    }
};
#undef ACCF
struct EpiG1SF {
    static constexpr bool PERM = true;
    bf16* uTT; const float *sx0, *swin;
    __device__ __forceinline__ void operator()(AccI& acc, const Unit& u, LAS unsigned char*, int wr, int wc, int fr, int fq) const {
        const int a0 = wc * 32 + 8 * fq;
        float sxc[2][8];
#pragma unroll
        for (int bj = 0; bj < 2; ++bj)
#pragma unroll
            for (int e = 0; e < 8; ++e) sxc[bj][e] = sx0[128 * (a0 + e) + 2 * u.p1 + bj];
#pragma unroll
        EPI_LOOP_AM { const int cch = u.p0 * 256 + 128 * ai + 64 * wr + 16 * m + fr; const float swr = swin[cch];
#pragma unroll
            for (int bj = 0; bj < 2; ++bj) { f32x4 v0, v1;
#pragma unroll
                for (int j = 0; j < 4; ++j) { v0[j] = (float)acc[ai][bj][m][0][j] * (swr * sxc[bj][j]); v1[j] = (float)acc[ai][bj][m][1][j] * (swr * sxc[bj][4 + j]); }
                *(GAS v4u*)(uTT + ((size_t)cch * 128 + (2 * u.p1 + bj)) * 128 + a0) = pack8(v0, v1); } }
    }
};
struct EpiG1SKV {
    static constexpr bool PERM = true;
    bf16 *kTw, *Bcat; const float *dec_f, *dec_b, *sx0, *swin;
    __device__ __forceinline__ void operator()(AccI& acc, const Unit& u, LAS unsigned char*, int wr, int wc, int fr, int fq) const {
        const int pm = u.p0, n_ch = u.p1, c0 = wc * 32 + 8 * fq;
        f32x4 sxc[2][2];
#pragma unroll
        for (int bj = 0; bj < 2; ++bj)
#pragma unroll
            for (int n = 0; n < 2; ++n) sxc[bj][n] = *(const GAS f32x4*)(sx0 + n_ch * 256 + 128 * bj + c0 + 4 * n);
        if (pm < 4) {
            const int h = pm; const float lgf = -fexp(dec_f[h]), lgb = -fexp(dec_b[h]);
#pragma unroll
            for (int m = 0; m < 4; ++m) {
                const int d = 64 * wr + 16 * m + fr;
                const float sw1 = swin[u.p2 + d], sw2 = swin[u.p2 + 128 + d];
                const float inv = __builtin_amdgcn_exp2f(-(float)d * (13.287712379549449f / 128.f)) * 0.15915494309189535f;
#pragma unroll
                for (int bj = 0; bj < 2; ++bj) {
                    f32x4 f1[2], f2[2], b1[2], b2[2];
#pragma unroll
                    for (int n = 0; n < 2; ++n)
#pragma unroll
                        for (int j = 0; j < 4; ++j) { const int il = 128 * bj + c0 + 4 * n + j; const float pos = (float)(n_ch * 256 + il); float c, s; cs_rev(pos * inv, c, s);
                            const float x1 = (float)acc[0][bj][m][n][j] * (sw1 * sxc[bj][n][j]), x2 = (float)acc[1][bj][m][n][j] * (sw2 * sxc[bj][n][j]); const float o1 = (x1 * c - x2 * s) * 0.0625f, o2 = (x2 * c + x1 * s) * 0.0625f;
                            const float wf = fexp(lgf * (float)(255 - il)), wb = fexp(lgb * (float)(il + 1));
                            f1[n][j] = o1 * wf; f2[n][j] = o2 * wf; b1[n][j] = o1 * wb; b2[n][j] = o2 * wb; }
                    const size_t tcol = (size_t)n_ch * 256 + 128 * bj + c0;
                    bf16* pf = kTw + ((size_t)(h * HD + d)) * T + tcol; bf16* pb = pf + (size_t)RW * T;
                    *(GAS v4u*)pf = pack8(f1[0], f1[1]); *(GAS v4u*)(pf + (size_t)128 * T) = pack8(f2[0], f2[1]);
                    *(GAS v4u*)pb = pack8(b1[0], b1[1]); *(GAS v4u*)(pb + (size_t)128 * T) = pack8(b2[0], b2[1]);
                }
            }
        } else {
            const int h = pm - 4;
#pragma unroll
            EPI_LOOP_AM { const int dv = 128 * ai + 64 * wr + 16 * m + fr; const float swr = swin[u.p2 + dv];
#pragma unroll
                for (int bj = 0; bj < 2; ++bj) { f32x4 v0, v1;
#pragma unroll
                    for (int j = 0; j < 4; ++j) { v0[j] = (float)acc[ai][bj][m][0][j] * (swr * sxc[bj][0][j]); v1[j] = (float)acc[ai][bj][m][1][j] * (swr * sxc[bj][1][j]); }
                    *(GAS v4u*)(Bcat + ((size_t)(h * NCH + n_ch) * 256 + dv) * CAT + 128 * bj + c0) = pack8(v0, v1); } }
        }
    }
};
struct EpiS1 {
    static constexpr bool PERM = true;
    bf16* A1;
    __device__ __forceinline__ void operator()(Acc& acc, const Unit& u, LAS unsigned char*, int wr, int wc, int fr, int fq) const {
        const int b0 = wc * 32 + 8 * fq;
#pragma unroll
        for (int m = 0; m < 4; ++m) { const int k1 = 64 * wr + 16 * m + fr;
#pragma unroll
            for (int bj = 0; bj < 2; ++bj) { const int cch = 2 * u.p1 + bj; f32x4 re[2], im[2];
#pragma unroll
                for (int n = 0; n < 2; ++n)
#pragma unroll
                    for (int j = 0; j < 4; ++j) { const int b = b0 + 4 * n + j; float c, s; cs_rev((float)(k1 * b) * (1.f / 16384.f), c, s);
                        const float xr = acc[0][bj][m][n][j], xi = acc[1][bj][m][n][j]; re[n][j] = xr * c + xi * s; im[n][j] = xi * c - xr * s; }
                bf16* p = A1 + (((size_t)k1 * 1024 + cch) * 2) * 128 + b0;
                *(GAS v4u*)p = pack8(re[0], re[1]); *(GAS v4u*)(p + 128) = pack8(im[0], im[1]); EPI_FENCE; } }
    }
};
struct EpiS2 {
    static constexpr bool PERM = true;
    bf16* Zt;
    __device__ __forceinline__ void operator()(Acc& acc, const Unit& u, LAS unsigned char*, int wr, int wc, int fr, int fq) const {
        const int k1 = u.p1 >> 2, cb = (u.p1 & 3) * 256, c0 = wc * 32 + 8 * fq;
#pragma unroll
        EPI_LOOP_AM { const int k2 = 64 * wr + 16 * m + fr, k = k1 + 128 * k2;
#pragma unroll
            for (int bj = 0; bj < 2; ++bj) { const int cch = cb + 128 * bj + c0, g = cch >> 7, cg = cch & 127;
                *(GAS v4u*)(Zt + (size_t)k * 2048 + g * 256 + ai * 128 + cg) = pack8(acc[ai][bj][m][0], acc[ai][bj][m][1]); } }
    }
};
struct EpiChan {
    static constexpr bool PERM = true;
    bf16* y;
    __device__ __forceinline__ void operator()(Acc& acc, const Unit& u, LAS unsigned char*, int wr, int wc, int fr, int fq) const {
        const int l0 = wc * 32 + 8 * fq; const float norm = 6.9053396600248786e-4f;
#pragma unroll
        EPI_LOOP_AM { const int R = u.p0 * 256 + 128 * ai + 64 * wr + 16 * m + fr, k = R >> 3, g = R & 7;
            *(GAS v4u*)(y + (size_t)k * D + g * 128 + l0) = pack8(acc[ai][0][m][0] * norm, acc[ai][0][m][1] * norm); }
    }
};
struct EpiScores {
    static constexpr bool PERM = true;
    bf16* Acat; const float *dec_f, *dec_b;
    __device__ __forceinline__ void operator()(Acc& acc, const Unit& u, LAS unsigned char*, int wr, int wc, int fr, int fq) const {
        const int h = u.p0, n_ch = u.p1, c0 = wc * 32 + 8 * fq; const float lgf = -fexp(dec_f[h]), lgb = -fexp(dec_b[h]);
#pragma unroll
        EPI_LOOP_AM { const int i = 128 * ai + 64 * wr + 16 * m + fr;
#pragma unroll
            for (int bj = 0; bj < 2; ++bj) { f32x4 v[2];
#pragma unroll
                for (int n = 0; n < 2; ++n)
#pragma unroll
                    for (int j = 0; j < 4; ++j) { const int jc = 128 * bj + c0 + 4 * n + j; const float dd = (float)(i - jc); const float w = (jc <= i) ? fexp(lgf * dd) : fexp(-lgb * dd); v[n][j] = acc[ai][bj][m][n][j] * w; }
                *(GAS v4u*)(Acat + ((size_t)h * T + n_ch * 256 + i) * CAT + 128 * bj + c0) = pack8(v[0], v[1]); EPI_FENCE; } }
    }
};
struct EpiKV {
    static constexpr bool PERM = true;
    bf16* kvT;
    __device__ __forceinline__ void operator()(Acc& acc, const Unit& u, LAS unsigned char*, int wr, int wc, int fr, int fq) const {
#pragma unroll
        EPI_LOOP_AM { const int dv = 128 * ai + 64 * wr + 16 * m + fr; bf16* rowp = kvT + (((size_t)u.p0 * NCH + u.p1) * 256 + dv) * 256 + wc * 32 + 8 * fq;
#pragma unroll
            for (int bj = 0; bj < 2; ++bj) *(GAS v4u*)(rowp + bj * 128) = pack8(acc[ai][bj][m][0], acc[ai][bj][m][1]); }
    }
};
struct EpiOut {
    static constexpr bool PERM = true;
    bf16* y; const bf16* gs; const float* gn_g;
    __device__ __forceinline__ void operator()(Acc& acc, const Unit& u, LAS unsigned char* lds, int wr, int wc, int fr, int fq) const {
        const int h = u.p0, n_ch = u.p1, c0 = wc * 32 + 8 * fq;
        LAS f32x2* P = (LAS f32x2*)(lds + LDS_STAGE);
#pragma unroll
        EPI_LOOP_AM {
            float s = 0.f;
#pragma unroll
            for (int bj = 0; bj < 2; ++bj)
#pragma unroll
                for (int n = 0; n < 2; ++n) { const f32x4 x = acc[ai][bj][m][n]; s += (x[0] + x[1]) + (x[2] + x[3]); }
            s += __shfl_xor(s, 16); s += __shfl_xor(s, 32);
            const float mw = s * (1.f / 64.f); float q = 0.f;
#pragma unroll
            for (int bj = 0; bj < 2; ++bj)
#pragma unroll
                for (int n = 0; n < 2; ++n) { const f32x4 d = acc[ai][bj][m][n] - mw; q += (d[0] * d[0] + d[1] * d[1]) + (d[2] * d[2] + d[3] * d[3]); }
            q += __shfl_xor(q, 16); q += __shfl_xor(q, 32);
            if (fq == 0) P[(128 * ai + 64 * wr + 16 * m + fr) * 4 + wc] = (f32x2){mw, q};
        }
        LDS_WAIT(); __builtin_amdgcn_s_barrier(); asm volatile("" ::: "memory");
#pragma unroll
        EPI_LOOP_AM {
            const int r = 128 * ai + 64 * wr + 16 * m + fr, tok = n_ch * 256 + r;
            const f32x2 a = P[r * 4 + 0], b = P[r * 4 + 1], c = P[r * 4 + 2], d = P[r * 4 + 3];
            const float mt = (a.x + b.x + c.x + d.x) * 0.25f; const float da = a.x - mt, db = b.x - mt, dc = c.x - mt, dd = d.x - mt;
            const float m2 = (a.y + b.y) + (c.y + d.y) + 64.f * ((da * da + db * db) + (dc * dc + dd * dd));
            const float rstd = 1.f / sqrtf(m2 * (1.f / 256.f) + GN_EPS);
#pragma unroll
            for (int bj = 0; bj < 2; ++bj) {
                const int col = h * HD + 128 * bj + c0; const v4u gv = *(const GAS v4u*)(gs + (size_t)tok * RW + col);
                const f32x4 g0 = *(const GAS f32x4*)(gn_g + col), g1 = *(const GAS f32x4*)(gn_g + col + 4);
                f32x4 o0 = (acc[ai][bj][m][0] - mt) * rstd * g0, o1 = (acc[ai][bj][m][1] - mt) * rstd * g1;
                o0[0] *= bf_lo(gv.x); o0[1] *= bf_hi(gv.x); o0[2] *= bf_lo(gv.y); o0[3] *= bf_hi(gv.y); o1[0] *= bf_lo(gv.z); o1[1] *= bf_hi(gv.z); o1[2] *= bf_lo(gv.w); o1[3] *= bf_hi(gv.w);
                *(GAS v4u*)(y + (size_t)tok * D + FW + col) = pack8(o0, o1); }
        }
        LDS_WAIT(); __builtin_amdgcn_s_barrier(); asm volatile("" ::: "memory");
    }
};
struct EpiWout {
    static constexpr bool PERM = true;
    bf16* z1; const float *x, *st0, *g0, *b0;
    __device__ __forceinline__ void operator()(Acc& acc, const Unit& u, LAS unsigned char*, int wr, int wc, int fr, int fq) const {
        const int colb = u.p1 * 256 + wc * 32 + 8 * fq;
#pragma unroll
        for (int bj = 0; bj < 2; ++bj) { const int col = colb + bj * 128;
            const f32x4 ga = *(const GAS f32x4*)(g0 + col), gb = *(const GAS f32x4*)(g0 + col + 4), ba = *(const GAS f32x4*)(b0 + col), bb = *(const GAS f32x4*)(b0 + col + 4);
#pragma unroll
            EPI_LOOP_AM { const int row = u.p0 * 256 + 128 * ai + 64 * wr + 16 * m + fr; const f32x2 st = *(const GAS f32x2*)(st0 + 2 * row); const size_t off = (size_t)row * D + col;
                const f32x4 xa = *(const GAS f32x4*)(x + off), xb = *(const GAS f32x4*)(x + off + 4);
                *(GAS v4u*)(z1 + off) = pack8(((xa - st.x) * st.y * ga + ba) * ALPHA + acc[ai][bj][m][0], ((xb - st.x) * st.y * gb + bb) * ALPHA + acc[ai][bj][m][1]); } }
    }
};
struct EpiUp {
    static constexpr bool PERM = true;
    unsigned char* act8;
    __device__ __forceinline__ void operator()(AccI& acc, const Unit& u, LAS unsigned char* lds, int wr, int wc, int fr, int fq) const {
        const int rt = u.p0, pn = u.p1, c0 = pn * 128 + wc * 32 + 8 * fq;
        const LAS float* blk = (const LAS float*)(lds + LDS_STAGE + u.q * 4096);
        float sx[2][4];
#pragma unroll
        EPI_LOOP_AM sx[ai][m] = blk[256 + 128 * ai + 64 * wr + 16 * m + fr];
        f32x4 sg[2], sl[2], bg[2], bl[2];
#pragma unroll
        for (int n = 0; n < 2; ++n) { const int cc = wc * 32 + 8 * fq + 4 * n;
            sg[n] = *(const LAS f32x4*)(blk + 512 + cc); sl[n] = *(const LAS f32x4*)(blk + 512 + 128 + cc); bg[n] = *(const LAS f32x4*)(blk + 768 + cc); bl[n] = *(const LAS f32x4*)(blk + 768 + 128 + cc); }
#pragma unroll
        EPI_LOOP_AM { const int r = 128 * ai + 64 * wr + 16 * m + fr; int pk[2];
#pragma unroll
            for (int n = 0; n < 2; ++n) { f32x2 v2[2];
#pragma unroll
                for (int jp = 0; jp < 2; ++jp) {
                    const f32x2 sx2 = (f32x2){sx[ai][m], sx[ai][m]};
                    f32x2 gl = (f32x2){(float)acc[ai][0][m][n][2 * jp], (float)acc[ai][0][m][n][2 * jp + 1]} * (sx2 * (f32x2){sg[n][2 * jp], sg[n][2 * jp + 1]}) + (f32x2){bg[n][2 * jp], bg[n][2 * jp + 1]};
                    f32x2 li = (f32x2){(float)acc[ai][1][m][n][2 * jp], (float)acc[ai][1][m][n][2 * jp + 1]} * (sx2 * (f32x2){sl[n][2 * jp], sl[n][2 * jp + 1]}) + (f32x2){bl[n][2 * jp], bl[n][2 * jp + 1]};
                    gl = __builtin_elementwise_min(gl, (f32x2){7.f, 7.f}); li = __builtin_elementwise_min(__builtin_elementwise_max(li, (f32x2){-7.f, -7.f}), (f32x2){7.f, 7.f});
                    const f32x2 ea = gl * (-1.702f * 1.4426950408889634f); f32x2 den; den.x = __builtin_amdgcn_exp2f(ea.x); den.y = __builtin_amdgcn_exp2f(ea.y); den = den + 1.0f;
                    f32x2 rc; rc.x = __builtin_amdgcn_rcpf(den.x); rc.y = __builtin_amdgcn_rcpf(den.y);
                    v2[jp] = (gl * rc) * (li * 4.0f + 4.0f); }
                int p = __builtin_amdgcn_cvt_pk_fp8_f32(v2[0].x, v2[0].y, 0, false); p = __builtin_amdgcn_cvt_pk_fp8_f32(v2[1].x, v2[1].y, p, true); pk[n] = p; }
            *(GAS v2u*)(act8 + ((size_t)rt * 256 + r) * DFF + c0) = (v2u){(unsigned)pk[0], (unsigned)pk[1]}; }
    }
};
struct EpiDown {
    static constexpr bool PERM = true;
    unsigned char* yr8;
    __device__ __forceinline__ void operator()(Acc& acc, const Unit& u, LAS unsigned char* lds, int wr, int wc, int fr, int fq) const {
        const int rt = u.p0, pn = u.p1, c0 = pn * 256 + wc * 32 + 8 * fq;
        const LAS float* blk = (const LAS float*)(lds + LDS_STAGE + u.q * 4096);
#pragma unroll
        for (int bj = 0; bj < 2; ++bj) { const int cc = 128 * bj + wc * 32 + 8 * fq;
#pragma unroll
            EPI_LOOP_AM { const int r = 128 * ai + 64 * wr + 16 * m + fr;
                const f32x4 w0 = *(const LAS f32x4*)(blk + 256 + cc) * 0.25f, w1 = *(const LAS f32x4*)(blk + 256 + cc + 4) * 0.25f, b0 = *(const LAS f32x4*)(blk + 512 + cc), b1 = *(const LAS f32x4*)(blk + 512 + cc + 4);
                f32x4 y0 = (acc[ai][bj][m][0] * w0 + b0) * 32.f, y1 = (acc[ai][bj][m][1] * w1 + b1) * 32.f;
#pragma unroll
                for (int j = 0; j < 4; ++j) { y0[j] = fminf(fmaxf(y0[j], -440.f), 440.f); y1[j] = fminf(fmaxf(y1[j], -440.f), 440.f); }
                int p0 = __builtin_amdgcn_cvt_pk_fp8_f32(y0[0], y0[1], 0, false); p0 = __builtin_amdgcn_cvt_pk_fp8_f32(y0[2], y0[3], p0, true);
                int p1 = __builtin_amdgcn_cvt_pk_fp8_f32(y1[0], y1[1], 0, false); p1 = __builtin_amdgcn_cvt_pk_fp8_f32(y1[2], y1[3], p1, true);
                *(GAS v2u*)(yr8 + ((size_t)rt * 256 + r) * D + c0 + 128 * bj) = (v2u){(unsigned)p0, (unsigned)p1}; EPI_FENCE; } }
    }
};

__device__ __forceinline__ void p3_scan(Frame& F) {
    const bf16* kvT = WSP(bf16, WS_KVT); bf16* Bcat = WSP(bf16, WS_BCAT);
    const int NQ = 2 * NH * 256 * 64;
    for (int q = F.vcu * NTHR + FTID; q < NQ; q += F.G * NTHR) {
        const int dk4 = q & 63, dv = (q >> 6) & 255, dh = q >> 14, dir = dh >> 2, h = dh & 3;
        const float lg = -fexp((dir ? F.dec_b : F.dec_f)[h]); const float cd = fexp(lg * (float)C2);
        f32x4 S = (f32x4){0.f, 0.f, 0.f, 0.f};
        for (int s = 0; s < NCH; ++s) { const int n = dir ? (NCH - 1 - s) : s;
            const v2u kw = *(const GAS v2u*)(kvT + (((size_t)dh * NCH + n) * 256 + dv) * 256 + dk4 * 4); const f32x4 kv = (f32x4){bf_lo(kw.x), bf_hi(kw.x), bf_lo(kw.y), bf_hi(kw.y)};
            v2u w; w.x = cvt_pk_bf16(S[0], S[1]); w.y = cvt_pk_bf16(S[2], S[3]);
            *(GAS v2u*)(Bcat + ((size_t)(h * NCH + n) * 256 + dv) * CAT + 256 + dir * 256 + dk4 * 4) = w;
            S = S * cd + kv; }
    }
}

__device__ __forceinline__ void p6_router(Frame& F) {
    const bf16* z1 = WSP(bf16, WS_Z1); unsigned* h1q = WSP(unsigned, WS_H1Q); float* sxg = WSP(float, WS_SX); float* rsc = WSP(float, WS_RSC); float* st1 = WSP(float, WS_ST0) + 2 * T;
    int* topi = WSP(int, WS_RT); float* gate = (float*)(topi + 4 * T); int* posb = (int*)(gate + 4 * T); int* row_tok = posb + 4 * T;
    constexpr int HP = 528;
    LAS unsigned char* Hhi = F.lds;
    LAS unsigned char* Hlo = Hhi + 64 * HP;
    LAS unsigned char* Whi = Hlo + 64 * HP;
    LAS unsigned char* Wlo = Whi + 32 * HP;
    LAS float* stl = (LAS float*)(Wlo + 32 * HP);
    LAS float* lg = stl + 128;
    LAS int* hist = (LAS int*)(lg + 64 * 33);
    LAS float* sxl = (LAS float*)(hist + 64);
    LAS float* part = sxl + 64;
    const bf16* wrt = WSP(bf16, WS_WRT);
    for (int blk = F.vcu; blk < T / 64; blk += F.G) {
        const int t0 = blk * 64;
        {
            v2u raw[8][8]; const int ln_ = FLANE;
#pragma unroll
            for (int rr = 0; rr < 8; ++rr) { const GAS v2u* xr = (const GAS v2u*)(z1 + (size_t)(t0 + F.wave * 8 + rr) * D) + ln_;
#pragma unroll
                for (int j = 0; j < 8; ++j) raw[rr][j] = xr[64 * j]; }
#pragma unroll
            for (int rr = 0; rr < 8; ++rr) { const int row = F.wave * 8 + rr, m = t0 + row;
                f32x4 v[8]; float s = 0.f;
#pragma unroll
                for (int j = 0; j < 8; ++j) { const v2u w = raw[rr][j]; v[j] = (f32x4){bf_lo(w.x), bf_hi(w.x), bf_lo(w.y), bf_hi(w.y)}; s += (v[j][0] + v[j][1]) + (v[j][2] + v[j][3]); }
                const float mean = wave_sum(s) * (1.f / D); float s2 = 0.f;
#pragma unroll
                for (int j = 0; j < 8; ++j) { v[j] = v[j] - mean; s2 += (v[j][0] * v[j][0] + v[j][1] * v[j][1]) + (v[j][2] * v[j][2] + v[j][3] * v[j][3]); }
                const float rstd = 1.f / sqrtf(wave_sum(s2) * (1.f / D) + LN_EPS);
                float am = 0.f;
#pragma unroll
                for (int j = 0; j < 8; ++j) { const f32x4 g = *((const GAS f32x4*)F.ln1_g + FLANE + 64 * j), b = *((const GAS f32x4*)F.ln1_b + FLANE + 64 * j);
                    v[j] = v[j] * rstd * g + b; am = fmaxf(am, fmaxf(fmaxf(fabsf(v[j][0]), fabsf(v[j][1])), fmaxf(fabsf(v[j][2]), fabsf(v[j][3])))); }
#pragma unroll
                for (int o = 1; o < 64; o <<= 1) am = fmaxf(am, __shfl_xor(am, o));
                const float sc = am > 0.f ? am * (1.f / 127.f) : 1.f, inv = 1.f / sc;
#pragma unroll
                for (int j = 0; j < 8; ++j) { const int q0 = (int)__builtin_rintf(v[j][0] * inv), q1 = (int)__builtin_rintf(v[j][1] * inv), q2 = (int)__builtin_rintf(v[j][2] * inv), q3 = (int)__builtin_rintf(v[j][3] * inv);
                    h1q[(size_t)m * (D / 4) + FLANE + 64 * j] = (unsigned)(q0 & 0xff) | ((unsigned)(q1 & 0xff) << 8) | ((unsigned)(q2 & 0xff) << 16) | ((unsigned)(q3 & 0xff) << 24); }
                if (FLANE == 0) { st1[2 * m] = mean; st1[2 * m + 1] = rstd; stl[2 * row] = mean; stl[2 * row + 1] = rstd; sxg[m] = sc; sxl[row] = sc; }
            }
        }
        if (FTID < 64) hist[FTID] = 0;
        __syncthreads();
        const int tt = F.wave & 3, kh = F.wave >> 2; f32x4 ac[2];
        ac[0] = (f32x4){0.f, 0.f, 0.f, 0.f}; ac[1] = (f32x4){0.f, 0.f, 0.f, 0.f};
        v2u zp[8]; v4u wp[4];
#define P6_LOAD(kc_) do { const int ln_ = FLANE; _Pragma("unroll") for (int i_ = 0; i_ < 8; ++i_) zp[i_] = *(const GAS v2u*)(z1 + (size_t)(t0 + F.wave + 8 * i_) * D + (kc_) * 256 + ln_ * 4); \
        _Pragma("unroll") for (int i_ = 0; i_ < 4; ++i_) { const int q_ = F.wave * 64 + ln_ + NTHR * i_; wp[i_] = *(const GAS v4u*)(wrt + (size_t)(q_ >> 5) * D + (kc_) * 256 + (q_ & 31) * 8); } } while (0)
        P6_LOAD(0);
        for (int kc = 0; kc < 8; ++kc) {
            { const int ln = FLANE, col = kc * 256 + ln * 4; const f32x4 g = *(const GAS f32x4*)(F.ln1_g + col), b = *(const GAS f32x4*)(F.ln1_b + col);
#pragma unroll
              for (int i = 0; i < 8; ++i) { const int r = F.wave + 8 * i; const v2u zw = zp[i];
                const f32x4 zv = (f32x4){bf_lo(zw.x), bf_hi(zw.x), bf_lo(zw.y), bf_hi(zw.y)};
                const f32x4 hh = (zv - stl[2 * r]) * stl[2 * r + 1] * g + b;
                v2u hi, lo; hi.x = cvt_pk_bf16(hh[0], hh[1]); hi.y = cvt_pk_bf16(hh[2], hh[3]);
                lo.x = cvt_pk_bf16(hh[0] - bf_lo(hi.x), hh[1] - bf_hi(hi.x)); lo.y = cvt_pk_bf16(hh[2] - bf_lo(hi.y), hh[3] - bf_hi(hi.y));
                *(LAS v2u*)(Hhi + r * HP + ln * 8) = hi; *(LAS v2u*)(Hlo + r * HP + ln * 8) = lo; }
#pragma unroll
              for (int i = 0; i < 4; ++i) { const int q = F.wave * 64 + ln + NTHR * i, e = (q >> 5) & 31, c8 = q & 31; *(LAS v4u*)(((q >> 10) ? Wlo : Whi) + e * HP + c8 * 16) = wp[i]; } }
            __syncthreads();
            if (kc + 1 < 8) P6_LOAD(kc + 1);
            { const int ln = FLANE, fr = ln & 15, fq = ln >> 4;
#pragma unroll
              for (int ks = 0; ks < 4; ++ks) { const int kb = (kh * 128 + ks * 32 + fq * 8) * 2;
                const bf16x8 th = __builtin_bit_cast(bf16x8, *(const LAS i32x4*)(Hhi + (tt * 16 + fr) * HP + kb)), tl = __builtin_bit_cast(bf16x8, *(const LAS i32x4*)(Hlo + (tt * 16 + fr) * HP + kb));
#pragma unroll
                for (int et = 0; et < 2; ++et) { const bf16x8 wh = __builtin_bit_cast(bf16x8, *(const LAS i32x4*)(Whi + (et * 16 + fr) * HP + kb)), wl = __builtin_bit_cast(bf16x8, *(const LAS i32x4*)(Wlo + (et * 16 + fr) * HP + kb));
                    ac[et] = __builtin_amdgcn_mfma_f32_16x16x32_bf16(wh, th, ac[et], 0, 0, 0); ac[et] = __builtin_amdgcn_mfma_f32_16x16x32_bf16(wl, th, ac[et], 0, 0, 0); ac[et] = __builtin_amdgcn_mfma_f32_16x16x32_bf16(wh, tl, ac[et], 0, 0, 0); } } }
            __syncthreads();
        }
#undef P6_LOAD
        { const int ln = FLANE, fr = ln & 15, fq = ln >> 4;
#pragma unroll
          for (int et = 0; et < 2; ++et) *(LAS f32x4*)(part + (kh * 64 + tt * 16 + fr) * 32 + et * 16 + 4 * fq) = ac[et];
          __syncthreads();
          { const int r = FTID >> 3, e0 = (FTID & 7) * 4;
              const f32x4 a = *(const LAS f32x4*)(part + (0 * 64 + r) * 32 + e0), b = *(const LAS f32x4*)(part + (1 * 64 + r) * 32 + e0);
              const f32x4 br = *(const GAS f32x4*)(F.b_r + e0), sum = (a + b) + br; LAS float* d = lg + r * 33 + e0; d[0] = sum[0]; d[1] = sum[1]; d[2] = sum[2]; d[3] = sum[3]; } }
        __syncthreads();
        int ek[4] = {0, 0, 0, 0}, lp[4] = {0, 0, 0, 0}; float gk[4] = {0.f, 0.f, 0.f, 0.f};
        if (FTID < 64) {
            float lv[4]; unsigned used = 0u;
#pragma unroll
            for (int k = 0; k < 4; ++k) { float best = -3.0e38f; int bi = 0;
                for (int e = 0; e < NE; ++e) { const float v = lg[FTID * 33 + e]; const bool ok = !((used >> e) & 1u) && (v > best); best = ok ? v : best; bi = ok ? e : bi; }
                used |= 1u << bi; ek[k] = bi; lv[k] = best; }
            const float mx = lv[0]; float den = 0.f;
#pragma unroll
            for (int k = 0; k < 4; ++k) { gk[k] = fexp(lv[k] - mx); den += gk[k]; }
            const float rd = 1.f / den;
#pragma unroll
            for (int k = 0; k < 4; ++k) { gk[k] *= rd; lp[k] = __hip_atomic_fetch_add(&hist[ek[k]], 1, __ATOMIC_RELAXED, __HIP_MEMORY_SCOPE_WORKGROUP); }
        }
        __syncthreads();
        if (FTID < NE) hist[32 + FTID] = (int)__hip_atomic_fetch_add(F.ctl + CW_CNT + 64 * FTID, (unsigned)hist[FTID], RLX_AGENT);
        __syncthreads();
        if (FTID < 64) { const int tok = t0 + FTID;
#pragma unroll
            for (int k = 0; k < 4; ++k) { const int pos = hist[32 + ek[k]] + lp[k]; row_tok[(size_t)ek[k] * T + pos] = tok; rsc[(size_t)ek[k] * T + pos] = sxl[FTID]; topi[4 * tok + k] = ek[k]; gate[4 * tok + k] = gk[k]; posb[4 * tok + k] = pos; } }
        __syncthreads();
    }
}

__device__ __forceinline__ void build_units(Frame& F, LAS int* tstart, int nN, int c) {
    __syncthreads();
    if (FTID < 64) { const int RT = tstart[NE], L = FTID * F.G + c; int w = -1;
        if (L < RT * nN) { int rt, pn; gm::tile_order(L, RT, nN, rt, pn); w = rt | (pn << 10) | (tstart[40 + rt] << 15); }
        tstart[400 + FTID] = w; }
    __syncthreads();
}

__device__ __forceinline__ void p8_requant(Frame& F, const LAS int* tstart) {
    const bf16* act = WSP(bf16, WS_ACT); unsigned* aq = WSP(unsigned, WS_ACTQ); float* sa = WSP(float, WS_SA); const unsigned* rmax = F.ctl + CW_RMAX;
    const int R = tstart[NE] * 256, gw = F.vcu * NWAVES + F.wave, NGW = F.G * NWAVES;
    for (int row = gw; row < R; row += NGW) {
        const float mx = __uint_as_float(rmax[row]); const float sc = mx > 0.f ? mx * (1.f / 127.f) : 1.f, inv = 1.f / sc;
#pragma unroll
        for (int j = 0; j < 2; ++j) { const int col = 16 * FLANE + 1024 * j;
            const v4u a = *(const GAS v4u*)(act + (size_t)row * DFF + col), b = *(const GAS v4u*)(act + (size_t)row * DFF + col + 8);
            const unsigned src[8] = {a.x, a.y, a.z, a.w, b.x, b.y, b.z, b.w}; unsigned o[4];
#pragma unroll
            for (int d = 0; d < 4; ++d) { unsigned w = 0u;
#pragma unroll
                for (int h2 = 0; h2 < 2; ++h2) { const unsigned u2 = src[2 * d + h2]; int q0 = (int)__builtin_rintf(bf_lo(u2) * inv), q1 = (int)__builtin_rintf(bf_hi(u2) * inv);
                    q0 = q0 > 127 ? 127 : (q0 < -127 ? -127 : q0); q1 = q1 > 127 ? 127 : (q1 < -127 ? -127 : q1);
                    w |= ((unsigned)(q0 & 0xff) << (16 * h2)) | ((unsigned)(q1 & 0xff) << (16 * h2 + 8)); }
                o[d] = w; }
            *(GAS v4u*)(aq + ((size_t)row * DFF + col) / 4) = (v4u){o[0], o[1], o[2], o[3]}; }
        if (FLANE == 0) sa[row] = sc;
    }
}

__device__ __forceinline__ void build_tstart(Frame& F, LAS int* tstart) {
    if (FTID == 0) { int s = 0; for (int e = 0; e < NE; ++e) { tstart[e] = s; const unsigned n = __hip_atomic_load(F.ctl + CW_CNT + 64 * e, RLX_AGENT); s += (int)((n + 255u) >> 8); } tstart[NE] = s; }
    __syncthreads();
    for (int rt = FTID; rt < RT_MAX; rt += NTHR) { int e = 0; for (int j = 1; j < NE; ++j) e += (tstart[j] <= rt) ? 1 : 0; tstart[40 + rt] = e; }
    __syncthreads();
}

__device__ __forceinline__ void p9_combine(Frame& F, const LAS int* tstart) {
    const bf16* z1 = WSP(bf16, WS_Z1); const float* st1 = WSP(float, WS_ST0) + 2 * T; const unsigned char* yr = (const unsigned char*)(F.ws + WS_YR);
    const int* topi = WSP(int, WS_RT); const float* gate = (const float*)(topi + 4 * T); const int* posb = (const int*)(gate + 4 * T);
    const int gw = F.vcu * NWAVES + F.wave, NGW = F.G * NWAVES; const int lane = lane_id();
    for (int m = gw; m < T; m += NGW) {
        const float mean1 = st1[2 * m], rstd1 = st1[2 * m + 1];
        size_t ro[4]; float gk[4];
#pragma unroll
        for (int k = 0; k < 4; ++k) { const int e = topi[4 * m + k]; ro[k] = ((size_t)tstart[e] * 256 + posb[4 * m + k]) * D; gk[k] = gate[4 * m + k]; }
        f32x4 v[8]; float s = 0.f;
#pragma unroll
        for (int j = 0; j < 8; ++j) { const int col = 4 * lane + 256 * j;
            const v2u zw = *(const GAS v2u*)(z1 + (size_t)m * D + col); const f32x4 zv = (f32x4){bf_lo(zw.x), bf_hi(zw.x), bf_lo(zw.y), bf_hi(zw.y)}, g = *(const GAS f32x4*)(F.ln1_g + col), b = *(const GAS f32x4*)(F.ln1_b + col);
            f32x4 a = ((zv - mean1) * rstd1 * g + b) * ALPHA;
#pragma unroll
            for (int k = 0; k < 4; ++k) { const int w = *(const GAS int*)(yr + ro[k] + col); const f32x2 lo = __builtin_amdgcn_cvt_pk_f32_fp8(w, false), hi = __builtin_amdgcn_cvt_pk_f32_fp8(w, true); const float g = gk[k] * (1.f / 32.f);
                a[0] += g * lo.x; a[1] += g * lo.y; a[2] += g * hi.x; a[3] += g * hi.y; }
            v[j] = a; s += (a[0] + a[1]) + (a[2] + a[3]); }
        const float mean = wave_sum(s) * (1.f / D); float s2 = 0.f;
#pragma unroll
        for (int j = 0; j < 8; ++j) { v[j] = v[j] - mean; s2 += (v[j][0] * v[j][0] + v[j][1] * v[j][1]) + (v[j][2] * v[j][2] + v[j][3] * v[j][3]); }
        const float rstd = 1.f / sqrtf(wave_sum(s2) * (1.f / D) + LN_EPS);
#pragma unroll
        for (int j = 0; j < 8; ++j) { const int col = 4 * lane + 256 * j; const f32x4 g = *(const GAS f32x4*)(F.ln2_g + col), b = *(const GAS f32x4*)(F.ln2_b + col);
            *(GAS f32x4*)(F.out + (size_t)m * D + col) = v[j] * rstd * g + b; }
    }
}

constexpr int NPH = 10;
__global__ void __launch_bounds__(NTHR, 2) fwd(Args args) {
    extern __shared__ __attribute__((aligned(16))) unsigned char lds_raw[];
    Frame F;
    F.lds = (LAS unsigned char*)lds_raw; F.ws = args.ws; F.ctl = (unsigned*)(args.ws + WS_CTL);
    F.wave = __builtin_amdgcn_readfirstlane((int)threadIdx.x >> 6);
    F.G = gridDim.x; { const int bx = blockIdx.x; F.vcu = (F.G % 8 == 0) ? (bx % 8) * (F.G / 8) + bx / 8 : bx; }
#define CAS __attribute__((address_space(4)))
#define FRAME_RELOAD() do { const CAS char* kp_ = (const CAS char*)__builtin_amdgcn_kernarg_segment_ptr(); asm volatile("" : "+s"(kp_)); const CAS Args* ap_ = (const CAS Args*)kp_; \
    F.x = ap_->in[0]; F.ln0_g = ap_->in[1]; F.ln0_b = ap_->in[2]; F.w_in = ap_->in[3]; F.dec_f = ap_->in[4]; F.dec_b = ap_->in[5]; F.gn_g = ap_->in[6]; F.w_out = ap_->in[7]; \
    F.ln1_g = ap_->in[8]; F.ln1_b = ap_->in[9]; F.w_r = ap_->in[10]; F.b_r = ap_->in[11]; F.w_up = ap_->in[12]; F.b_up = ap_->in[13]; F.w_dn = ap_->in[14]; F.b_dn = ap_->in[15]; \
    F.ln2_g = ap_->in[16]; F.ln2_b = ap_->in[17]; F.out = ap_->out; F.ws = ap_->ws; F.ctl = (unsigned*)(F.ws + WS_CTL); } while (0)
    FRAME_RELOAD();
    volatile LAS unsigned* lctl = (volatile LAS unsigned*)(F.lds + LDS_CTL_OFF);
    LAS int* tstart = (LAS int*)(F.lds + LDS_CTL_OFF + 64);
    for (int u = FTID; u < 128; u += NTHR) lctl[u] = 0u;
    __syncthreads();
    const int lo = args.ph_lo, hi = args.ph_hi;
    const bool single = (hi - lo) > 1;
    XcdBarrier bar; bar.bar = F.ctl + CW_BAR; bar.x = 0; bar.st = lctl; bar.wave = F.wave;
    if (single) { bar = xcd_barrier_post(F.ctl + CW_BAR, lctl); bar.wave = F.wave; }
#ifndef PH_MASK
#define PH_MASK 0x3ff
#endif
#define IN(k) (((PH_MASK >> (k)) & 1) && lo <= (k) && (k) < hi)
#ifndef SUB_MASK
#define SUB_MASK 0xff
#endif
#define SUB(n) ((SUB_MASK >> (n)) & 1)
#define SEAM(k) do { if (IN(k) && IN((k) + 1)) xcd_barrier(bar); } while (0)
    const int bc = (int)blockIdx.x;

    const int nDn = (NE * 64 + F.G - 1) / F.G, nS = (NE * 128 + F.G - 1) / F.G + nDn; int sdone = nDn; const int qgrp = (int)(blockIdx.x >> 3);
#define QSLOT(k24) do { const int e_ = sdone + ((nS - nDn) * (k24) + 23) / 24; do_slabs(F, sdone, e_ < nS ? e_ : nS); sdone = e_; } while (0)
#define QG(slot, nslots, k24) do { if (qgrp % (nslots) == (slot)) QSLOT(k24); } while (0)
    if (IN(0)) { FRAME_RELOAD(); p0_prologue(F); __syncthreads(); { const int nW = (DIN / 32 + F.G - 1) / F.G; do_slabs(F, -nW, 0); } }
    SEAM(0);
    if (IN(1)) { FRAME_RELOAD();
        QG(0, 4, 9);
        if (SUB(0)) { SchedG1N S; S.nt = D / 128; S.pitchA = D / 2; S.pitchB = D / 2; S.multA = 1; S.multB = 1; S.G = F.G; S.c = bc; S.wv = F.wave; S.A = (const char*)WSP(bf16, WS_H0B); S.Bt = (const char*)WSP(bf16, WS_WIN);
          EpiG1N E{WSP(bf16, WS_QS), WSP(bf16, WS_KK), WSP(bf16, WS_GS), WSP(bf16, WS_ACAT), F.dec_f, F.dec_b, WSP(float, WS_SX0), WSP(float, WS_SWIN)};
          gm::gemm_run<EpiG1N, SchedG1N, false, true>(F.lds, S, E); }
        QG(1, 4, 9);
        if (SUB(1)) { SchedG1SF S; S.nt = D / 128; S.pitchA = D / 2; S.pitchB = D / 2; S.multA = 1; S.multB = 128; S.G = F.G; S.c = bc; S.wv = F.wave; S.A = (const char*)WSP(bf16, WS_WIN); S.Bt = (const char*)WSP(bf16, WS_H0B);
          EpiG1SF E{WSP(bf16, WS_UTT), WSP(float, WS_SX0), WSP(float, WS_SWIN)};
          gm::gemm_run<EpiG1SF, SchedG1SF, false, true>(F.lds, S, E); }
        QG(2, 4, 9);
        if (SUB(2)) { SchedG1SKV S; S.nt = D / 128; S.pitchA = D / 2; S.pitchB = D / 2; S.multA = 1; S.multB = 1; S.G = F.G; S.c = bc; S.wv = F.wave; S.A = (const char*)WSP(bf16, WS_WIN); S.Bt = (const char*)WSP(bf16, WS_H0B);
          EpiG1SKV E{WSP(bf16, WS_KTW), WSP(bf16, WS_BCAT), F.dec_f, F.dec_b, WSP(float, WS_SX0), WSP(float, WS_SWIN)};
          gm::gemm_run<EpiG1SKV, SchedG1SKV, false, true>(F.lds, S, E); }
        QG(3, 4, 9);
    }
    SEAM(1);
    if (IN(2)) { FRAME_RELOAD();
        QG(0, 4, 3);
        if (SUB(3)) { SchedFixA S; S.nt = 2; S.pitchA = 128; S.pitchB = 128; S.multA = 1; S.multB = 1; S.G = F.G; S.c = bc; S.wv = F.wave; S.A = (const char*)WSP(bf16, WS_TAB); S.Bt = (const char*)WSP(bf16, WS_UTT); S.ncol = 512;
          EpiS1 E{WSP(bf16, WS_A1)};
          gm::gemm_run<EpiS1, SchedFixA, false>(F.lds, S, E); }
        QG(1, 4, 3);
        if (SUB(4)) { SchedScores S; S.nt = 4; S.pitchA = RW; S.pitchB = RW; S.multA = 1; S.multB = 1; S.G = F.G; S.c = bc; S.wv = F.wave; S.Q = (const char*)WSP(bf16, WS_QS); S.Kk = (const char*)WSP(bf16, WS_KK);
          EpiScores E{WSP(bf16, WS_ACAT), F.dec_f, F.dec_b};
          gm::gemm_run<EpiScores, SchedScores, false>(F.lds, S, E); }
        QG(2, 4, 3);
        if (SUB(5)) { SchedKV S; S.nt = 4; S.pitchA = CAT; S.pitchB = T; S.multA = 1; S.multB = 1; S.G = F.G; S.c = bc; S.wv = F.wave; S.Bcat = (const char*)WSP(bf16, WS_BCAT); S.kTw = (const char*)WSP(bf16, WS_KTW);
          EpiKV E{WSP(bf16, WS_KVT)};
          gm::gemm_run<EpiKV, SchedKV, false>(F.lds, S, E); }
        QG(3, 4, 3);
    }
    SEAM(2);
    if (IN(3)) { FRAME_RELOAD();
        QG(0, 3, 3);
        { SchedFixA S; S.nt = 4; S.pitchA = 256; S.pitchB = 256; S.multA = 1; S.multB = 1; S.G = F.G; S.c = bc; S.wv = F.wave; S.A = (const char*)(WSP(bf16, WS_TAB) + 32768); S.Bt = (const char*)WSP(bf16, WS_A1); S.ncol = 512;
          EpiS2 E{WSP(bf16, WS_ZT)};
          gm::gemm_run<EpiS2, SchedFixA, false>(F.lds, S, E); }
        QG(1, 3, 3);
        p3_scan(F);
        QG(2, 3, 3);
    }
    SEAM(3);
    if (IN(4)) { FRAME_RELOAD();
        QG(0, 3, 2);
        { SchedFixB S; S.nt = 4; S.pitchA = 256; S.pitchB = 256; S.multA = 1; S.multB = 1; S.G = F.G; S.c = bc; S.wv = F.wave; S.A = (const char*)WSP(bf16, WS_ZT); S.Bt = (const char*)(WSP(bf16, WS_TAB) + 32768 + 65536); S.nrow = 512;
          EpiChan E{WSP(bf16, WS_Y)};
          gm::gemm_run<EpiChan, SchedFixB, false>(F.lds, S, E); }
        QG(1, 3, 2);
        { SchedOut S; S.nt = CAT / 64; S.pitchA = CAT; S.pitchB = CAT; S.multA = 1; S.multB = 1; S.G = F.G; S.c = bc; S.wv = F.wave; S.Acat = (const char*)WSP(bf16, WS_ACAT); S.Bcat = (const char*)WSP(bf16, WS_BCAT);
          EpiOut E{WSP(bf16, WS_Y), WSP(bf16, WS_GS), F.gn_g};
          gm::gemm_run<EpiOut, SchedOut, false>(F.lds, S, E); }
        QG(2, 3, 2);

    }
    SEAM(4);
    if (IN(5)) { FRAME_RELOAD();
        QG(0, 2, 5);
        Sched2D S; S.nt = D / 64; S.pitchA = D; S.pitchB = D; S.multA = 1; S.multB = 1; S.G = F.G; S.c = bc; S.wv = F.wave; S.A = (const char*)WSP(bf16, WS_Y); S.Bt = (const char*)WSP(bf16, WS_WOUT); S.nM = 64; S.nN = 8;
        EpiWout E{WSP(bf16, WS_Z1), F.x, WSP(float, WS_ST0), F.ln0_g, F.ln0_b};
        gm::gemm_run<EpiWout, Sched2D, false>(F.lds, S, E);
        QG(1, 2, 5);
        do_slabs(F, sdone < nS ? sdone : nS, nS);
    }
    SEAM(5);
    if (IN(6)) { FRAME_RELOAD(); p6_router(F); }
    SEAM(6);
    if (IN(7) || IN(8) || IN(9)) build_tstart(F, tstart);
    if (IN(7)) { FRAME_RELOAD();
        build_units(F, tstart, 16, bc);
#pragma unroll 1
        for (int call = 0; call < 8; ++call) {
            if (qgrp % 9 == call) do_slabs(F, 0, nDn);
            SchedMoEUpT S; S.nt = D / 128; S.pitchA = D / 2; S.pitchB = D / 2; S.multA = 1; S.multB = 1; S.G = F.G; S.c = bc; S.wv = F.wave; S.A = (const char*)WSP(char, WS_H1Q); S.Bt = (const char*)WSP(char, WS_WUP);
            S.tstart = tstart; S.row_tok = WSP(int, WS_RT) + 12 * T; S.cnt = F.ctl + CW_CNT; S.nN = 16; S.rowbytes = D; S.estride = (size_t)2 * DFF * D;
            S.rsc = WSP(float, WS_RSC); S.swup = WSP(float, WS_SWUP); S.b_up = F.b_up;
            S.u0 = call == 0 ? 0 : 1 + 2 * call; S.u1 = call == 7 ? 64 : 3 + 2 * call;
            EpiUp E{(unsigned char*)(F.ws + WS_ACTQ)};
            gm::gemm_run<EpiUp, SchedMoEUpT, true, true, true>(F.lds, S, E);
        }
        if (qgrp % 9 == 8) do_slabs(F, 0, nDn);
    }
    SEAM(7);
    if (IN(8)) { FRAME_RELOAD();
        build_units(F, tstart, 8, bc);
        SchedMoEDown S; S.nt = DFF / 128; S.pitchA = DFF / 2; S.pitchB = DFF / 2; S.multA = 1; S.multB = 1; S.G = F.G; S.c = bc; S.wv = F.wave; S.A = (const char*)WSP(char, WS_ACTQ); S.Bt = (const char*)WSP(char, WS_WDN);
        S.tstart = tstart; S.row_tok = nullptr; S.cnt = F.ctl + CW_CNT; S.nN = 8; S.rowbytes = DFF; S.estride = (size_t)D * DFF;
        S.sa = nullptr; S.swdn = WSP(float, WS_SWDN); S.b_dn = F.b_dn; S.rsc = nullptr; S.swup = nullptr; S.b_up = nullptr;
        EpiDown E{(unsigned char*)(F.ws + WS_YR)};
        gm::gemm_run<EpiDown, SchedMoEDown, false, 2, true>(F.lds, S, E);
    }
    SEAM(8);
    if (IN(9)) { FRAME_RELOAD(); p9_combine(F, tstart); }
#undef IN
#undef SEAM
}

#ifndef MK_SPLIT
#define MK_SPLIT 0
#endif
extern "C" void kernel_launch(void* const* d_in, const int* in_sizes, int n_in, void* d_out, int out_size, void* d_ws, size_t ws_size, hipStream_t stream) {
    static int grid = 0;
    if (grid == 0) {
        if (n_in != 18 || out_size != T * D || ws_size < WS_END2) { fprintf(stderr, "kernel_launch: unexpected problem: n_in %d out %d ws %zu (need %zu)\n", n_in, out_size, ws_size, (size_t)WS_END2); grid = -1; return; }
        int dev = 0, cus = 0, per_cu = 0;
        if (hipGetDevice(&dev) != hipSuccess || hipDeviceGetAttribute(&cus, hipDeviceAttributeMultiprocessorCount, dev) != hipSuccess) { grid = -1; return; }
        if (hipFuncSetAttribute((const void*)fwd, hipFuncAttributeMaxDynamicSharedMemorySize, LDS_BYTES) != hipSuccess) { fprintf(stderr, "kernel_launch: hipFuncSetAttribute failed\n"); grid = -1; return; }
        if (hipOccupancyMaxActiveBlocksPerMultiprocessor(&per_cu, (const void*)fwd, NTHR, LDS_BYTES) != hipSuccess || per_cu < 1) { fprintf(stderr, "kernel_launch: occupancy query reports %d\n", per_cu); }
        (void)hipGetLastError();
        grid = cus;
    }
    if (grid < 0) return;
    (void)hipMemsetAsync((char*)d_ws + WS_CTL, 0, CTL_BYTES, stream);
    Args a{};
    for (int i = 0; i < 18; ++i) a.in[i] = (const float*)d_in[i];
    a.out = (float*)d_out; a.ws = (unsigned char*)d_ws;
#if MK_SPLIT
    for (int p = 0; p < NPH; ++p) { a.ph_lo = p; a.ph_hi = p + 1; hipLaunchKernelGGL(fwd, dim3(grid), dim3(NTHR), LDS_BYTES, stream, a); }
#else
    a.ph_lo = 0; a.ph_hi = NPH; hipLaunchKernelGGL(fwd, dim3(grid), dim3(NTHR), LDS_BYTES, stream, a);
#endif
}
```

```cpp
#include <hip/hip_runtime.h>
#include <cstdio>
#include <cstdint>

#define GAS __attribute__((address_space(1)))
#define LAS __attribute__((address_space(3)))
typedef unsigned short bf16;
typedef unsigned v4u __attribute__((ext_vector_type(4)));
typedef unsigned v2u __attribute__((ext_vector_type(2)));
typedef float f32x4 __attribute__((ext_vector_type(4)));
typedef float f32x2 __attribute__((ext_vector_type(2)));
typedef short bf16x8 __attribute__((ext_vector_type(8)));
typedef int i32x4 __attribute__((ext_vector_type(4)));
typedef int i32x8 __attribute__((ext_vector_type(8)));
#define RLX_AGENT __ATOMIC_RELAXED, __HIP_MEMORY_SCOPE_AGENT
#define LDS_WAIT() asm volatile("s_waitcnt lgkmcnt(0)" ::: "memory")
#define VM_WAIT() asm volatile("s_waitcnt vmcnt(0)" ::: "memory")

constexpr int T = 16384, D = 2048, DIN = 5120, FW = 1024, RW = 1024, NH = 4, HD = 256, NE = 32, TOPK = 4, DFF = 2048;
constexpr int C2 = 256, NCH = T / C2;
constexpr int CAT = 768;
constexpr float LN_EPS = 1e-5f, GN_EPS = 1e-6f, ALPHA = 1.189207115002721f;
constexpr int RT_MAX = (T * TOPK) / 256 + NE;
constexpr int NWAVES = 8, NTHR = 512;

constexpr size_t MiB = 1u << 20;
constexpr size_t WS_CTL = 0, CTL_BYTES = 1 * MiB;
constexpr size_t WS_TAB = 1 * MiB;
constexpr size_t WS_WIN = 2 * MiB;
constexpr size_t WS_WOUT = WS_WIN + 20 * MiB;
constexpr size_t WS_WUP = WS_WOUT + 8 * MiB;
constexpr size_t WS_WDN = WS_WUP + 512 * MiB;
constexpr size_t WS_H0B = WS_WDN + 256 * MiB;
constexpr size_t WS_ST0 = WS_H0B + 64 * MiB;
constexpr size_t WS_UTT = WS_ST0 + 1 * MiB;
constexpr size_t WS_A1 = WS_UTT + 32 * MiB;
constexpr size_t WS_ZT = WS_A1 + 64 * MiB;
constexpr size_t WS_QS = WS_ZT + 64 * MiB;
constexpr size_t WS_KK = WS_QS + 32 * MiB;
constexpr size_t WS_GS = WS_KK + 32 * MiB;
constexpr size_t WS_ACAT = WS_GS + 32 * MiB;
constexpr size_t WS_BCAT = WS_ACAT + 96 * MiB;
constexpr size_t WS_KTW = WS_BCAT + 96 * MiB;
constexpr size_t WS_KVT = WS_KTW + 64 * MiB;
constexpr size_t WS_Y = WS_KVT + 128 * MiB;
constexpr size_t WS_Z1 = WS_Y + 64 * MiB;
constexpr size_t WS_H1B = WS_Z1 + 128 * MiB;
constexpr size_t WS_RT = WS_H1B + 64 * MiB;
constexpr size_t WS_ACT = WS_RT + 4 * MiB;
constexpr size_t WS_YR = WS_ACT + 288 * MiB;
constexpr size_t WS_END = WS_YR + 288 * MiB;
constexpr size_t WS_SWUP = WS_TAB + 512 * 1024;
constexpr size_t WS_H1Q = WS_H1B;
constexpr size_t WS_SX = WS_H1B + 32 * MiB, WS_RSC = WS_H1B + 40 * MiB, WS_SA = WS_H1B + 44 * MiB;
constexpr size_t WS_SWDN = WS_ST0 + 512 * 1024;
constexpr size_t WS_SWIN = WS_ST0 + 768 * 1024;
constexpr size_t WS_SX0 = WS_H0B + 40 * MiB;
constexpr size_t WS_WRT = WS_ACT;
constexpr size_t WS_ACTQ = WS_END;
constexpr size_t WS_END2 = WS_ACTQ + 144 * MiB;
constexpr int CW_RMAX = 16384;
constexpr int CW_BAR = 1024;
constexpr int CW_CNT = 8192;

constexpr int LDS_STAGE = 131072, LDS_SCR = 16384, LDS_CTL_OFF = LDS_STAGE + LDS_SCR, LDS_BYTES = LDS_CTL_OFF + 2048;

__device__ __forceinline__ unsigned cvt_pk_bf16(float lo, float hi) { unsigned r; asm volatile("v_cvt_pk_bf16_f32 %0, %1, %2" : "=v"(r) : "v"(lo), "v"(hi)); return r; }
__device__ __forceinline__ float bf_lo(unsigned u) { return __builtin_bit_cast(float, u << 16); }
__device__ __forceinline__ float bf_hi(unsigned u) { return __builtin_bit_cast(float, u & 0xffff0000u); }
__device__ __forceinline__ v4u pack8(const f32x4 a, const f32x4 b) { v4u w; w.x = cvt_pk_bf16(a[0], a[1]); w.y = cvt_pk_bf16(a[2], a[3]); w.z = cvt_pk_bf16(b[0], b[1]); w.w = cvt_pk_bf16(b[2], b[3]); return w; }
__device__ __forceinline__ float wave_sum(float v) {
#pragma unroll
    for (int o = 1; o < 64; o <<= 1) v += __shfl_xor(v, o);
    return v;
}
__device__ __forceinline__ int lane_id() { int l; asm volatile("v_mbcnt_lo_u32_b32 %0, -1, 0\n\tv_mbcnt_hi_u32_b32 %0, -1, %0" : "=v"(l)); return l; }
__device__ __forceinline__ float fexp(float x) { return __builtin_amdgcn_exp2f(x * 1.4426950408889634f); }
__device__ __forceinline__ void cs_rev(float rev, float& c, float& s) { const float f = __builtin_amdgcn_fractf(rev); c = __builtin_amdgcn_cosf(f); s = __builtin_amdgcn_sinf(f); }

#define XB_TMO      128
#define XB_XCNT(j)  (256  + 64 * (j))
#define XB_XSUB(j)  (1280 + 64 * (j))
#define XB_XGEN(j)  (2304 + 64 * (j))
#define XB_TOP      3328
#define XB_TOPGEN   3392
#define XCD_BAR_WORDS 3456
#define XB_SPIN_CAP (1u << 18)
__device__ __forceinline__ unsigned xb_ld(unsigned* p)              { return __hip_atomic_load(p, __ATOMIC_RELAXED, __HIP_MEMORY_SCOPE_AGENT); }
__device__ __forceinline__ unsigned xb_add(unsigned* p, unsigned v) { return __hip_atomic_fetch_add(p, v, __ATOMIC_RELAXED, __HIP_MEMORY_SCOPE_AGENT); }
__device__ __forceinline__ unsigned xb_xcc_id() { return (unsigned)__builtin_amdgcn_s_getreg((3 << 11) | 20) & 0xFu; }
#define XB_SPIN(cond, bar) do { unsigned _sp = 0; while (cond) { __builtin_amdgcn_s_sleep(1); \
    if ((++_sp & 255u) == 0u) { if (xb_ld(&(bar)[XB_TMO])) break; if (_sp > XB_SPIN_CAP) { atomicAdd(&(bar)[XB_TMO], 1u); break; } } } } while (0)
struct XcdBarrier { unsigned* bar; unsigned x; volatile LAS unsigned* st; int wave; };
__device__ __forceinline__ XcdBarrier xcd_barrier_post(unsigned* bar, volatile LAS unsigned* st) {
    XcdBarrier b; b.bar = bar; b.x = xb_xcc_id(); b.st = st;
    if (threadIdx.x == 0) (void)xb_add(&bar[XB_XCNT(b.x)], 1u);
    return b;
}
__device__ __forceinline__ void xcd_barrier_complete(unsigned* bar, unsigned x, unsigned& nloc, unsigned& nx) {
    const unsigned G = gridDim.x * gridDim.y * gridDim.z;
    unsigned sum, cnt, mine, sp = 0u;
    for (;;) {
        sum = 0u; cnt = 0u; mine = 0u;
#pragma unroll
        for (unsigned j = 0; j < 16; ++j) { const unsigned c = xb_ld(&bar[XB_XCNT(j)]); sum += c; cnt += (c > 0u) ? 1u : 0u; mine = (j == x) ? c : mine; }
        if (sum == G) break;
        __builtin_amdgcn_s_sleep(1);
        if ((++sp & 255u) == 0u) { if (xb_ld(&bar[XB_TMO])) break; if (sp > XB_SPIN_CAP) { atomicAdd(&bar[XB_TMO], 1u); break; } }
    }
    nloc = mine > 0u ? mine : 1u; nx = cnt > 0u ? cnt : 1u;
}
__device__ __forceinline__ void xcd_barrier(const XcdBarrier& b) {
    asm volatile("s_waitcnt vmcnt(0)" ::: "memory");
    __syncthreads();
    if (b.wave == 0 && lane_id() == 0) {
        unsigned* bar = b.bar;
        __builtin_amdgcn_s_waitcnt(0);
        unsigned nloc = b.st[0], nx = b.st[1];
        if (nloc == 0u) { xcd_barrier_complete(bar, b.x, nloc, nx); b.st[0] = nloc; b.st[1] = nx; }
        const unsigned old = xb_add(&bar[XB_XSUB(b.x)], 1u);
        const unsigned gen = old / nloc;
        if (old + 1u == (gen + 1u) * nloc) {
            __builtin_amdgcn_fence(__ATOMIC_RELEASE, "agent");
            asm volatile("s_waitcnt vmcnt(0)" ::: "memory");
            const unsigned og = xb_add(&bar[XB_TOP], 1u);
            const unsigned tg = og / nx;
            if (og + 1u == (tg + 1u) * nx) xb_add(&bar[XB_TOPGEN], 1u);
            else XB_SPIN(xb_ld(&bar[XB_TOPGEN]) == tg, bar);
            __builtin_amdgcn_fence(__ATOMIC_ACQUIRE, "agent");
            xb_add(&bar[XB_XGEN(b.x)], 1u);
            asm volatile("s_waitcnt vmcnt(0)" ::: "memory");
        } else {
            XB_SPIN(xb_ld(&bar[XB_XGEN(b.x)]) == gen, bar);
            __builtin_amdgcn_fence(__ATOMIC_ACQUIRE, "agent");
            asm volatile("s_waitcnt vmcnt(0)" ::: "memory");
        }
    }
    __syncthreads();
}

namespace gm {
constexpr int BM = 256, BK = 64, HALF = 128, HTB = HALF * BK * 2, STAGE_BYTES = 8 * HTB;
__device__ __forceinline__ int lds_byte(int r, int c) { const int st = (r >> 4) * 2 + (c >> 5), rr = r & 15, cc = c & 31, ob = rr * 64 + cc * 2; return st * 1024 + (ob ^ (((ob >> 9) & 1) << 5)); }
__device__ __forceinline__ void stage_rc(int b, int& R, int& C) { const int st = b / 1024, sb = b % 1024, swz = sb ^ (((sb >> 9) & 1) << 5); R = (st >> 1) * 16 + swz / 64; C = (st & 1) * 32 + (swz % 64) / 2; }
__device__ __forceinline__ int perm32(int rho) { const int n = rho >> 4, i = rho & 15; return 8 * (i >> 2) + 4 * n + (i & 3); }

struct Unit { const char* a0; const char* a1; const char* b0; const char* b1; int p0, p1, p2, p3, q; };

__device__ __forceinline__ void tile_order(int L, int nM, int nN, int& pm, int& pn) {
    const int nwg = nM * nN; int wgid = L;
    { const int q = nwg / 8, r = nwg % 8, xcd = wgid % 8, off = wgid / 8; wgid = (xcd < r ? xcd * (q + 1) : r * (q + 1) + (xcd - r) * q) + off; }
    const int nig = 8 * nN, gid = wgid / nig, fm = gid * 8, gsz = (nM - fm) < 8 ? (nM - fm) : 8;
    pm = fm + ((wgid % nig) % gsz); pn = (wgid % nig) / gsz;
}

template <int I8> struct AccSel { typedef f32x4 type; };
template <> struct AccSel<1> { typedef i32x4 type; };
template <class Epi, class Sched, bool GATHER, int I8 = 0, bool PREF = false>
__device__ __forceinline__ void gemm_run(LAS unsigned char* lds, const Sched& S, const Epi& E) {
    const int wid = S.wv, lane = lane_id(), tid = wid * 64 + lane, wr = wid >> 2, wc = wid & 3, fr = lane & 15, fq = lane >> 4;
    int nt = S.nt; asm volatile("" : "+s"(nt));
    unsigned voffA[2], voffB[2], colA[2]; int rowA[2];
#pragma unroll
    for (int i = 0; i < 2; ++i) { int R, C; stage_rc(tid * 16 + i * 8192, R, C); const int Rb = Epi::PERM ? ((R & ~31) + perm32(R & 31)) : R;
        voffA[i] = (unsigned)(R * S.multA * S.pitchA + C) * 2u; voffB[i] = (unsigned)(Rb * S.multB * S.pitchB + C) * 2u; colA[i] = (unsigned)C * 2u; rowA[i] = R; }
    const size_t kstep = (size_t)(BK * 2);
    const unsigned ldsw = (unsigned)wid * 1024u;
    const int aoff = lds_byte(wr * 64 + fr, fq * 8), boff = lds_byte(wc * 32 + fr, fq * 8);
#define G_SA(b, h) (((b) * 2 + (h)) * HTB)
#define G_SB(b, h) ((4 + (b) * 2 + (h)) * HTB)
#define G_STAGE(bufoff, gbase, voff) do { _Pragma("unroll") for (int _i = 0; _i < 2; ++_i) \
        __builtin_amdgcn_global_load_lds((const unsigned*)((const char*)(gbase) + (voff)[_i]), (LAS unsigned*)(lds + (bufoff) + ldsw + _i * 8192), 16, 0, 0); } while (0)
#define G_LD8(dst, addr) do { const i32x4 lo_ = *(const LAS i32x4*)(addr), hi_ = *(const LAS i32x4*)((addr) + 1024); dst = __builtin_shufflevector(lo_, hi_, 0, 1, 2, 3, 4, 5, 6, 7); } while (0)
#define G_LDA(dst, b, h) do { _Pragma("unroll") for (int m = 0; m < 4; ++m) G_LD8(dst[m], lds + G_SA(b, h) + aoff + m * 2048); } while (0)
#define G_LDB(dst, b, h) do { _Pragma("unroll") for (int n = 0; n < 2; ++n) G_LD8(dst[n], lds + G_SB(b, h) + boff + n * 2048); } while (0)
#define G_H4(x, k) ((k) ? __builtin_shufflevector(x, x, 4, 5, 6, 7) : __builtin_shufflevector(x, x, 0, 1, 2, 3))
#define G_MMA(ai, bj, At, Bt) do { __builtin_amdgcn_s_setprio(1); _Pragma("unroll") for (int m = 0; m < 4; ++m) _Pragma("unroll") for (int n = 0; n < 2; ++n) { \
        if constexpr (I8 == 2) acc[ai][bj][m][n] = __builtin_amdgcn_mfma_scale_f32_16x16x128_f8f6f4(Bt[n], At[m], acc[ai][bj][m][n], 0, 0, 0, 0x7F7F7F7F, 0, 0x7F7F7F7F); \
        else { _Pragma("unroll") for (int k = 0; k < 2; ++k) { \
            if constexpr (I8 == 1) acc[ai][bj][m][n] = __builtin_amdgcn_mfma_i32_16x16x64_i8(G_H4(Bt[n], k), G_H4(At[m], k), acc[ai][bj][m][n], 0, 0, 0); \
            else acc[ai][bj][m][n] = __builtin_amdgcn_mfma_f32_16x16x32_bf16(__builtin_bit_cast(bf16x8, G_H4(Bt[n], k)), __builtin_bit_cast(bf16x8, G_H4(At[m], k)), acc[ai][bj][m][n], 0, 0, 0); } } } \
        __builtin_amdgcn_s_setprio(0); } while (0)
#define G_WAIT_V(n) asm volatile("s_waitcnt vmcnt(" #n ")" ::: "memory")
#define G_WAIT_L(n) asm volatile("s_waitcnt lgkmcnt(" #n ")" ::: "memory")
#define G_BAR __builtin_amdgcn_s_barrier()
#define G_SCHED __builtin_amdgcn_sched_barrier(0)
    Unit cur, nxt; int ui = 0;
    if (!S.next(0, cur)) return;
    cur.q = 0;
    if constexpr (PREF) { S.prefetch(cur, lds); G_WAIT_V(0); G_BAR; }
    typedef typename AccSel<I8>::type acc_t;
    acc_t acc[2][2][4][2];
#pragma unroll
    for (int a = 0; a < 2; ++a)
#pragma unroll
        for (int b = 0; b < 2; ++b)
#pragma unroll
            for (int m = 0; m < 4; ++m)
#pragma unroll
                for (int n = 0; n < 2; ++n) acc[a][b][m][n] = (acc_t){0, 0, 0, 0};
    i32x8 At[4], B0[2], B1[2];
    unsigned gc0[2], gc1[2];
    if constexpr (GATHER) {
#pragma unroll
        for (int i = 0; i < 2; ++i) { gc0[i] = S.row_off(cur, rowA[i], lds) + colA[i]; gc1[i] = S.row_off(cur, 128 + rowA[i], lds) + colA[i]; }
    }
#define vA0 (GATHER ? gc0 : voffA)
#define vA1 (GATHER ? gc1 : voffA)
    G_STAGE(G_SB(0, 0), cur.b0, voffB); G_STAGE(G_SB(0, 1), cur.b1, voffB); G_STAGE(G_SA(0, 0), cur.a0, vA0); G_STAGE(G_SA(0, 1), cur.a1, vA1);
    if (wr == 1) G_BAR;
    G_WAIT_V(2); G_BAR;
    G_STAGE(G_SB(1, 0), cur.b0 + kstep, voffB); G_STAGE(G_SA(1, 0), cur.a0 + kstep, vA0); G_STAGE(G_SB(1, 1), cur.b1 + kstep, voffB);
    G_WAIT_V(6); G_BAR;
    for (;;) {
        const bool has_next = S.next(ui + 1, nxt);
        if (!has_next) nxt = cur;
        nxt.q = (ui + 1) & 1;
        for (int t = 0; t < nt; t += 2) {
            const bool last = (t == nt - 2);
            { const int tz_ = wid * 64 + lane_id();
#pragma unroll
              for (int i = 0; i < 2; ++i) { int R, C; stage_rc(tz_ * 16 + i * 8192, R, C); const int Rb = Epi::PERM ? ((R & ~31) + perm32(R & 31)) : R;
                  voffA[i] = (unsigned)(R * S.multA * S.pitchA + C) * 2u; voffB[i] = (unsigned)(Rb * S.multB * S.pitchB + C) * 2u; } }
            if constexpr (GATHER) asm volatile("" : "+v"(gc0[0]), "+v"(gc0[1]), "+v"(gc1[0]), "+v"(gc1[1]));
            if constexpr (PREF) { if (t == nt - 4) S.prefetch(nxt, lds); }
            const char* a11 = cur.a1 + (size_t)(t + 1) * kstep;
            const char* a02 = last ? nxt.a0 : cur.a0 + (size_t)(t + 2) * kstep; const char* a12 = last ? nxt.a1 : cur.a1 + (size_t)(t + 2) * kstep;
            const char* b02 = last ? nxt.b0 : cur.b0 + (size_t)(t + 2) * kstep; const char* b12 = last ? nxt.b1 : cur.b1 + (size_t)(t + 2) * kstep;
            G_LDB(B0, 0, 0); G_LDB(B1, 0, 1); G_SCHED; G_LDA(At, 0, 0); G_STAGE(G_SA(1, 1), a11, vA1);
            if constexpr (GATHER) { if (last) { int tz = tid; asm volatile("" : "+v"(tz));
#pragma unroll
                for (int i = 0; i < 2; ++i) { int R, C; stage_rc(tz * 16 + i * 8192, R, C); gc0[i] = S.row_off(nxt, R, lds) + (unsigned)C * 2u; gc1[i] = S.row_off(nxt, 128 + R, lds) + (unsigned)C * 2u; } } }
            G_WAIT_L(0); G_BAR; G_MMA(0, 0, At, B0); G_MMA(0, 1, At, B1); G_WAIT_V(8); G_BAR; G_SCHED;
            G_LDA(At, 0, 1); G_STAGE(G_SB(0, 0), b02, voffB); G_STAGE(G_SB(0, 1), b12, voffB); G_STAGE(G_SA(0, 0), a02, vA0);
            G_WAIT_L(0); G_BAR; G_MMA(1, 0, At, B0); G_MMA(1, 1, At, B1); G_WAIT_V(8); G_BAR; G_SCHED;
            G_LDB(B0, 1, 0); G_LDB(B1, 1, 1); G_SCHED; G_LDA(At, 1, 0); G_STAGE(G_SA(0, 1), a12, vA1);
            G_WAIT_L(0); G_BAR; G_MMA(0, 0, At, B0); G_MMA(0, 1, At, B1); G_WAIT_V(8); G_BAR; G_SCHED;
            G_LDA(At, 1, 1); G_STAGE(G_SB(1, 0), b02 + kstep, voffB); G_STAGE(G_SB(1, 1), b12 + kstep, voffB); G_STAGE(G_SA(1, 0), a02 + kstep, vA0);
            G_WAIT_L(0); G_BAR; G_MMA(1, 0, At, B0); G_MMA(1, 1, At, B1); G_WAIT_V(8); G_BAR; G_SCHED;
        }
        if (wr == 0) G_BAR;
        { int fr2 = fr, fq2 = fq; asm volatile("" : "+v"(fr2), "+v"(fq2));
          E(acc, cur, lds, wr, wc, fr2, fq2); }
        if (!has_next) break;
#pragma unroll
        for (int a = 0; a < 2; ++a)
#pragma unroll
            for (int b = 0; b < 2; ++b)
#pragma unroll
                for (int m = 0; m < 4; ++m)
#pragma unroll
                    for (int n = 0; n < 2; ++n) acc[a][b][m][n] = (acc_t){0, 0, 0, 0};
        cur = nxt; ++ui;
        if (wr == 1) G_BAR;
    }
    G_WAIT_V(0);
    G_BAR;
#undef G_SA
#undef G_SB
#undef G_STAGE
#undef G_LDA
#undef G_LD8
#undef G_H4
#undef G_LDB
#undef G_MMA
#undef G_WAIT_V
#undef G_WAIT_L
#undef G_BAR
#undef G_SCHED
#undef vA0
#undef vA1
}
}
using gm::Unit;
typedef f32x4 Acc[2][2][4][2];
typedef i32x4 AccI[2][2][4][2];

struct Args { const float* in[18]; float* out; unsigned char* ws; int ph_lo, ph_hi; };
struct Frame {
    LAS unsigned char* lds; unsigned char* ws; unsigned* ctl;
    int wave, vcu, G;
    const float *x, *ln0_g, *ln0_b, *w_in, *dec_f, *dec_b, *gn_g, *w_out, *ln1_g, *ln1_b, *w_r, *b_r, *w_up, *b_up, *w_dn, *b_dn, *ln2_g, *ln2_b;
    float* out;
};
#define WSP(T_, off) ((T_*)(F.ws + (off)))
#define FLANE lane_id()
#define FTID (F.wave * 64 + lane_id())

template <class ColMap>
__device__ __forceinline__ void transpose_item(const float* W, int K, int N, bf16* WT, LAS float* scr, int item, int lane, const ColMap& cm) {
    const int nblk = N / 64, kb = item / nblk, nb = item % nblk, k0 = 64 * kb, n0 = 64 * nb;
    const int s0 = cm(n0);
#pragma unroll 4
    for (int i = 0; i < 16; ++i) { const int kk = 4 * i + (lane >> 4), c4 = (lane & 15) * 4;
        const f32x4 v = *(const GAS f32x4*)(W + (size_t)(k0 + kk) * N + s0 + c4);
        LAS float* d = scr + kk * 65 + c4; d[0] = v[0]; d[1] = v[1]; d[2] = v[2]; d[3] = v[3]; }
    LDS_WAIT(); asm volatile("" ::: "memory");
    const int c = lane & 7;
#pragma unroll
    for (int j = 0; j < 8; ++j) { const int n = (lane >> 3) + 8 * j; const LAS float* s = scr + (8 * c) * 65 + n;
        v4u o; o.x = cvt_pk_bf16(s[0 * 65], s[1 * 65]); o.y = cvt_pk_bf16(s[2 * 65], s[3 * 65]); o.z = cvt_pk_bf16(s[4 * 65], s[5 * 65]); o.w = cvt_pk_bf16(s[6 * 65], s[7 * 65]);
        *(GAS v4u*)(WT + (size_t)(n0 + n) * K + k0 + 8 * c) = o; }
    LDS_WAIT(); asm volatile("" ::: "memory");
}
struct ColId { __device__ __forceinline__ int operator()(int n) const { return n; } };
struct ColUp { __device__ __forceinline__ int operator()(int n) const { return ((n >> 8) * 128 + (n & 127)) + ((n >> 7) & 1) * 2048; } };

__device__ __forceinline__ void p0_prologue(Frame& F) {
    const int gw = F.vcu * NWAVES + F.wave, NGW = F.G * NWAVES;
    {
        unsigned* h0q = WSP(unsigned, WS_H0B); float* st0 = WSP(float, WS_ST0); float* sx0 = WSP(float, WS_SX0);
        const int nsl = (DIN / 32 < F.G) ? DIN / 32 : F.G, nA = nsl * NWAVES, nB = NGW - nA, per2 = (2 * T + 8 * nA) / NGW;
        const int TA = (nB == 0) ? T : (per2 > 8 ? (nA * (per2 - 8)) / 2 : 0);
        const bool inA = F.vcu < nsl; const int m0 = inA ? gw : TA + (gw - nA), m1 = inA ? TA : T, mst = inA ? nA : nB;
        for (int m = m0; m < m1; m += mst) {
            const GAS f32x4* xr = (const GAS f32x4*)(F.x + (size_t)m * D) + FLANE;
            f32x4 v[8]; float s = 0.f;
#pragma unroll
            for (int j = 0; j < 8; ++j) { v[j] = xr[64 * j]; s += (v[j][0] + v[j][1]) + (v[j][2] + v[j][3]); }
            const float mean = wave_sum(s) * (1.f / D); float s2 = 0.f;
#pragma unroll
            for (int j = 0; j < 8; ++j) { v[j] = v[j] - mean; s2 += (v[j][0] * v[j][0] + v[j][1] * v[j][1]) + (v[j][2] * v[j][2] + v[j][3] * v[j][3]); }
            const float rstd = 1.f / sqrtf(wave_sum(s2) * (1.f / D) + LN_EPS); float am = 0.f;
#pragma unroll
            for (int j = 0; j < 8; ++j) { const f32x4 g = *((const GAS f32x4*)F.ln0_g + FLANE + 64 * j), b = *((const GAS f32x4*)F.ln0_b + FLANE + 64 * j);
                v[j] = v[j] * rstd * g + b; am = fmaxf(am, fmaxf(fmaxf(fabsf(v[j][0]), fabsf(v[j][1])), fmaxf(fabsf(v[j][2]), fabsf(v[j][3])))); }
#pragma unroll
            for (int o = 1; o < 64; o <<= 1) am = fmaxf(am, __shfl_xor(am, o));
            const float sc = am > 0.f ? am * (1.f / 127.f) : 1.f, inv = 1.f / sc;
#pragma unroll
            for (int j = 0; j < 8; ++j) { const int q0 = (int)__builtin_rintf(v[j][0] * inv), q1 = (int)__builtin_rintf(v[j][1] * inv), q2 = (int)__builtin_rintf(v[j][2] * inv), q3 = (int)__builtin_rintf(v[j][3] * inv);
                h0q[(size_t)m * (D / 4) + FLANE + 64 * j] = (unsigned)(q0 & 0xff) | ((unsigned)(q1 & 0xff) << 8) | ((unsigned)(q2 & 0xff) << 16) | ((unsigned)(q3 & 0xff) << 24); }
            if (FLANE == 0) { st0[2 * m] = mean; st0[2 * m + 1] = rstd; sx0[m] = sc; }
        }
    }
    {
        bf16* tab = WSP(bf16, WS_TAB);
        for (int i = (F.vcu * NTHR + FTID); i < 32768 + 65536 + 65536; i += F.G * NTHR) {
            float v;
            if (i < 32768) { const int r = i >> 7, a = i & 127, ri = r >> 7, k1 = r & 127; float c, s; cs_rev((float)((k1 * a) & 127) * (1.f / 128.f), c, s); v = ri ? -s : c; }
            else if (i < 32768 + 65536) { const int e = i - 32768, r = e >> 8, q = e & 255, ri = r >> 7, k2 = r & 127, rj = q >> 7, b = q & 127; float c, s; cs_rev((float)((k2 * b) & 127) * (1.f / 128.f), c, s);
                v = (ri == 0) ? (rj == 0 ? c : s) : (rj == 0 ? -s : c); }
            else { const int e = i - 32768 - 65536, l = e >> 8, q = e & 255, rj = q >> 7, cg = q & 127; float c, s; cs_rev((float)((l * cg) & 127) * (1.f / 128.f), c, s); v = (l < 128) ? (rj == 0 ? c : s) : 0.f; }
            tab[i] = (bf16)(cvt_pk_bf16(v, 0.f) & 0xffffu);
        }
        bf16* wrt = WSP(bf16, WS_WRT);
        for (int i = (F.vcu * NTHR + FTID); i < NE * D; i += F.G * NTHR) { const int e = i >> 11, k = i & 2047; const float v = F.w_r[k * NE + e];
            const unsigned hi = cvt_pk_bf16(v, 0.f) & 0xffffu; const unsigned lo = cvt_pk_bf16(v - bf_lo(hi), 0.f) & 0xffffu; wrt[i] = (bf16)hi; wrt[NE * D + i] = (bf16)lo; }
    }
    {
        LAS float* scr = (LAS float*)(F.lds + F.wave * 18432);
        constexpr int I_IN = 32 * (DIN / 64), I_OUT = 32 * (D / 64), I_UP = 32 * (2 * DFF / 64), I_DN = 32 * (D / 64);
        constexpr int NIT = I_OUT;
        for (int it = NGW - 1 - gw; it < NIT; it += NGW) {
            int r = it;
            { transpose_item(F.w_out, D, D, WSP(bf16, WS_WOUT), scr, r, FLANE, ColId()); }
        }
    }
}

struct SlabDesc { const float* W; signed char* WQ; float* sw; int NS, e, n0, valid, fp8; };
struct QF { unsigned char* ws; const float* w_up; const float* w_dn; const float* w_in; int vcu, G; };
__device__ __forceinline__ SlabDesc slab_desc(const QF& F, int j) {
    const int nD = (NE * 64 + F.G - 1) / F.G; SlabDesc d;
    if (j < 0) { const int sl = F.vcu + (-1 - j) * F.G; d.valid = sl < DIN / 32; d.NS = DIN; d.e = 0; d.n0 = sl * 32; d.W = F.w_in + d.n0; d.WQ = (signed char*)WSP(char, WS_WIN); d.sw = WSP(float, WS_SWIN); d.fp8 = 0; }
    else if (j >= nD) { const int sl = F.vcu + (j - nD) * F.G; d.valid = sl < NE * 128; d.NS = 2 * DFF; d.e = sl >> 7; d.n0 = (sl & 127) * 32; d.W = F.w_up + (size_t)d.e * D * 2 * DFF + ColUp()(d.n0); d.WQ = (signed char*)WSP(char, WS_WUP); d.sw = WSP(float, WS_SWUP); d.fp8 = 0; }
    else { const int sl = F.vcu + j * F.G; d.valid = sl < NE * 64; d.NS = D; d.e = sl >> 6; d.n0 = (sl & 63) * 32; d.W = F.w_dn + (size_t)d.e * DFF * D + d.n0; d.WQ = (signed char*)WSP(char, WS_WDN); d.sw = WSP(float, WS_SWDN); d.fp8 = 1; }
    return d;
}
#define SLAB_LOAD(dsc, v) do { if ((dsc).valid) { const GAS char* b_ = (const GAS char*)(dsc).W; unsigned o_ = (unsigned)((wave * 256 + kq) * (dsc).NS + c4) * 4u; const unsigned st_ = (unsigned)(dsc).NS * 32u; \
    _Pragma("unroll") for (int i_ = 0; i_ < 32; ++i_) { v[i_] = __builtin_nontemporal_load((const GAS f32x4*)(b_ + o_)); o_ += st_; } } } while (0)
__device__ __forceinline__ void do_slabs_impl(LAS unsigned char* lds, unsigned char* ws, const float* w_up, const float* w_dn, const float* w_in, int vcu, int G, int wave, int j0, int j1) {
    if (j0 >= j1) return;
    QF F; F.ws = ws; F.w_up = w_up; F.w_dn = w_dn; F.w_in = w_in; F.vcu = vcu; F.G = G;
    const int lane = lane_id(), tid = wave * 64 + lane;
    constexpr int PITCH = 2056;
    LAS bf16* slab = (LAS bf16*)lds;
    LAS float* red = (LAS float*)(lds + 32 * PITCH * 2);
    const int kq = lane >> 3, c4 = (lane & 7) * 4;
    f32x4 v[32];
    SlabDesc cur = slab_desc(F, j0);
    SLAB_LOAD(cur, v);
    for (int j = j0; j < j1; ++j) {
        if (cur.valid) {
            f32x4 mx = (f32x4){0.f, 0.f, 0.f, 0.f};
#pragma unroll
            for (int i = 0; i < 32; ++i) { const int k = wave * 256 + i * 8 + kq; const f32x4 x = v[i];
                mx[0] = fmaxf(mx[0], fabsf(x[0])); mx[1] = fmaxf(mx[1], fabsf(x[1])); mx[2] = fmaxf(mx[2], fabsf(x[2])); mx[3] = fmaxf(mx[3], fabsf(x[3]));
                const unsigned p01 = cvt_pk_bf16(x[0], x[1]), p23 = cvt_pk_bf16(x[2], x[3]);
                const int ks = k ^ (((c4 >> 3) & 3) << 3);
                slab[(c4 + 0) * PITCH + ks] = (bf16)(p01 & 0xffffu); slab[(c4 + 1) * PITCH + ks] = (bf16)(p01 >> 16); slab[(c4 + 2) * PITCH + ks] = (bf16)(p23 & 0xffffu); slab[(c4 + 3) * PITCH + ks] = (bf16)(p23 >> 16); }
#pragma unroll
            for (int q = 0; q < 4; ++q) { float m = mx[q]; m = fmaxf(m, __shfl_xor(m, 8)); m = fmaxf(m, __shfl_xor(m, 16)); m = fmaxf(m, __shfl_xor(m, 32)); mx[q] = m; }
            if (lane < 8) { LAS float* d = red + wave * 32 + c4; d[0] = mx[0]; d[1] = mx[1]; d[2] = mx[2]; d[3] = mx[3]; }
        }
        const SlabDesc done = cur;
        if (j + 1 < j1) { cur = slab_desc(F, j + 1); SLAB_LOAD(cur, v); }
        __syncthreads();
        if (done.valid && tid < 32) { float m = 0.f;
#pragma unroll
            for (int w = 0; w < 8; ++w) m = fmaxf(m, red[w * 32 + tid]);
            const float sc = m > 0.f ? m * (done.fp8 ? (1.f / 448.f) : (1.f / 127.f)) : 1.f; done.sw[(size_t)done.e * done.NS + done.n0 + tid] = sc; red[256 + tid] = 1.f / sc; }
        __syncthreads();
        if (done.valid) {
#pragma unroll 2
            for (int i = 0; i < 8; ++i) { const int q = tid + NTHR * i, n = q >> 7, kc = q & 127; const float inv = red[256 + n];
                const int sx_ = ((n >> 3) & 3) << 3;
                const v4u a = *(const LAS v4u*)(slab + n * PITCH + ((kc * 16) ^ sx_)), b = *(const LAS v4u*)(slab + n * PITCH + ((kc * 16 + 8) ^ sx_));
                const unsigned src[8] = {a.x, a.y, a.z, a.w, b.x, b.y, b.z, b.w}; unsigned o[4];
                if (done.fp8) {
#pragma unroll
                    for (int d = 0; d < 4; ++d) { int w = __builtin_amdgcn_cvt_pk_fp8_f32(bf_lo(src[2 * d]) * inv, bf_hi(src[2 * d]) * inv, 0, false);
                        w = __builtin_amdgcn_cvt_pk_fp8_f32(bf_lo(src[2 * d + 1]) * inv, bf_hi(src[2 * d + 1]) * inv, w, true); o[d] = (unsigned)w; }
                } else {
#pragma unroll
                for (int d = 0; d < 4; ++d) { unsigned w = 0u;
#pragma unroll
                    for (int h2 = 0; h2 < 2; ++h2) { const unsigned u2 = src[2 * d + h2]; const int q0 = (int)__builtin_rintf(bf_lo(u2) * inv), q1 = (int)__builtin_rintf(bf_hi(u2) * inv);
                        w |= ((unsigned)(q0 & 0xff) << (16 * h2)) | ((unsigned)(q1 & 0xff) << (16 * h2 + 8)); }
                    o[d] = w; }
                }
                __builtin_nontemporal_store((v4u){o[0], o[1], o[2], o[3]}, (GAS v4u*)(done.WQ + ((size_t)done.e * done.NS + done.n0 + n) * D + kc * 16)); }
        }
        __syncthreads();
    }
}

__device__ __forceinline__ void do_slabs(Frame& F, int j0, int j1) { do_slabs_impl(F.lds, F.ws, F.w_up, F.w_dn, F.w_in, F.vcu, F.G, F.wave, j0, j1); }

struct SchedBase { int nt, pitchA, pitchB, multA, multB, G, c, wv; };
struct SchedG1N : SchedBase {
    const char* A; const char* Bt;
    __device__ __forceinline__ bool next(int i, Unit& u) const { const int L = i * G + c; if (L >= 64 * 12) return false; int pm, pn; gm::tile_order(L, 64, 12, pm, pn);
        const int cb = pn < 4 ? 1024 + 256 * pn : (pn < 8 ? 2048 + 256 * (pn - 4) : 4096 + 256 * (pn - 8));
        u.a0 = A + (size_t)pm * 256 * D; u.a1 = u.a0 + (size_t)128 * D; u.b0 = Bt + (size_t)cb * D; u.b1 = u.b0 + (size_t)128 * D; u.p0 = pm; u.p1 = pn; u.p2 = cb; u.p3 = 0; return true; }
};
struct SchedG1SF : SchedBase {
    const char* A; const char* Bt;
    __device__ __forceinline__ bool next(int i, Unit& u) const { const int L = i * G + c; if (L >= 4 * 64) return false; int pm, pn; gm::tile_order(L, 4, 64, pm, pn);
        u.a0 = A + (size_t)pm * 256 * D; u.a1 = u.a0 + (size_t)128 * D; u.b0 = Bt + (size_t)(2 * pn) * D; u.b1 = u.b0 + (size_t)D; u.p0 = pm; u.p1 = pn; u.p2 = 0; u.p3 = 0; return true; }
};
struct SchedG1SKV : SchedBase {
    const char* A; const char* Bt;
    __device__ __forceinline__ bool next(int i, Unit& u) const { const int L = i * G + c; if (L >= 8 * 64) return false; int pm, pn; gm::tile_order(L, 8, 64, pm, pn);
        const int rb = pm < 4 ? 2048 + 256 * pm : 3072 + 256 * (pm - 4);
        u.a0 = A + (size_t)rb * D; u.a1 = u.a0 + (size_t)128 * D; u.b0 = Bt + (size_t)pn * 256 * D; u.b1 = u.b0 + (size_t)128 * D; u.p0 = pm; u.p1 = pn; u.p2 = rb; u.p3 = 0; return true; }
};
struct SchedFixA : SchedBase {
    const char* A; const char* Bt; int ncol;
    __device__ __forceinline__ bool next(int i, Unit& u) const { const int L = i * G + c; if (L >= ncol) return false;
        u.a0 = A; u.a1 = A + (size_t)128 * pitchA * 2; u.b0 = Bt + (size_t)L * 256 * pitchB * 2; u.b1 = u.b0 + (size_t)128 * pitchB * 2; u.p0 = 0; u.p1 = L; u.p2 = 0; u.p3 = 0; return true; }
};
struct SchedFixB : SchedBase {
    const char* A; const char* Bt; int nrow;
    __device__ __forceinline__ bool next(int i, Unit& u) const { const int L = i * G + c; if (L >= nrow) return false;
        u.a0 = A + (size_t)L * 256 * pitchA * 2; u.a1 = u.a0 + (size_t)128 * pitchA * 2; u.b0 = Bt; u.b1 = Bt + (size_t)128 * pitchB * 2; u.p0 = L; u.p1 = 0; u.p2 = 0; u.p3 = 0; return true; }
};
struct SchedScores : SchedBase {
    const char* Q; const char* Kk;
    __device__ __forceinline__ bool next(int i, Unit& u) const { const int L = i * G + c; if (L >= NH * NCH) return false; const int h = L & 3, n = L >> 2;
        u.a0 = Q + ((size_t)n * 256 * RW + h * HD) * 2; u.a1 = u.a0 + (size_t)128 * RW * 2; u.b0 = Kk + ((size_t)n * 256 * RW + h * HD) * 2; u.b1 = u.b0 + (size_t)128 * RW * 2; u.p0 = h; u.p1 = n; u.p2 = 0; u.p3 = 0; return true; }
};
struct SchedKV : SchedBase {
    const char* Bcat; const char* kTw;
    __device__ __forceinline__ bool next(int i, Unit& u) const { const int L = i * G + c; if (L >= 2 * NH * NCH) return false; const int dh = L & 7, n = L >> 3, dir = dh >> 2, h = dh & 3;
        u.a0 = Bcat + ((size_t)(h * NCH + n) * 256 * CAT) * 2; u.a1 = u.a0 + (size_t)128 * CAT * 2;
        u.b0 = kTw + (((size_t)dir * RW + h * HD) * T + (size_t)n * 256) * 2; u.b1 = u.b0 + (size_t)128 * T * 2; u.p0 = dh; u.p1 = n; u.p2 = 0; u.p3 = 0; return true; }
};
struct SchedOut : SchedBase {
    const char* Acat; const char* Bcat;
    __device__ __forceinline__ bool next(int i, Unit& u) const { const int L = i * G + c; if (L >= NH * NCH) return false; const int h = L & 3, n = L >> 2;
        u.a0 = Acat + ((size_t)h * T + (size_t)n * 256) * CAT * 2; u.a1 = u.a0 + (size_t)128 * CAT * 2; u.b0 = Bcat + ((size_t)(h * NCH + n) * 256 * CAT) * 2; u.b1 = u.b0 + (size_t)128 * CAT * 2; u.p0 = h; u.p1 = n; u.p2 = 0; u.p3 = 0; return true; }
};
struct Sched2D : SchedBase {
    const char* A; const char* Bt; int nM, nN;
    __device__ __forceinline__ bool next(int i, Unit& u) const { const int L = i * G + c; if (L >= nM * nN) return false; int pm, pn; gm::tile_order(L, nM, nN, pm, pn);
        u.a0 = A + (size_t)pm * 256 * pitchA * 2; u.a1 = u.a0 + (size_t)128 * pitchA * 2; u.b0 = Bt + (size_t)pn * 256 * pitchB * 2; u.b1 = u.b0 + (size_t)128 * pitchB * 2; u.p0 = pm; u.p1 = pn; u.p2 = 0; u.p3 = 0; return true; }
};
struct SchedMoE : SchedBase {
    const char* A; const char* Bt; const LAS int* tstart; const int* row_tok; const unsigned* cnt; int nN, rowbytes; size_t estride;
    __device__ __forceinline__ bool next(int i, Unit& u) const { const int RT = __builtin_amdgcn_readfirstlane(tstart[NE]); const int L = i * G + c; if (L >= RT * nN) return false; int rt, pn; gm::tile_order(L, RT, nN, rt, pn);
        const int e = __builtin_amdgcn_readfirstlane(tstart[40 + rt]);
        u.b0 = Bt + (size_t)e * estride + (size_t)pn * 256 * rowbytes; u.b1 = u.b0 + (size_t)128 * rowbytes;
        u.a0 = A; u.a1 = A;
        u.p0 = rt; u.p1 = pn; u.p2 = e; u.p3 = (rt - __builtin_amdgcn_readfirstlane(tstart[e])) * 256; return true; }
    __device__ __forceinline__ bool next_tab(int i, Unit& u) const { const int w = (i < 64) ? __builtin_amdgcn_readfirstlane(tstart[400 + i]) : -1; if (w < 0) return false;
        const int rt = w & 1023, pn = (w >> 10) & 31, e = (w >> 15) & 31;
        u.b0 = Bt + (size_t)e * estride + (size_t)pn * 256 * rowbytes; u.b1 = u.b0 + (size_t)128 * rowbytes; u.a0 = A; u.a1 = A;
        u.p0 = rt; u.p1 = pn; u.p2 = e; u.p3 = (rt - __builtin_amdgcn_readfirstlane(tstart[e])) * 256; return true; }
    const float *rsc, *swup, *b_up;
    __device__ __forceinline__ void prefetch(const Unit& u, LAS unsigned char* lds) const {
        LAS unsigned char* blk = lds + LDS_STAGE + u.q * 4096;
        const int wid = wv, e = u.p2; int lane = lane_id(); asm volatile("" : "+v"(lane));
        const int n = (int)cnt[64 * e]; int pos = u.p3 + (wid & 3) * 64 + lane; pos = pos < n ? pos : n - 1;
        if (wid < 4) __builtin_amdgcn_global_load_lds((const unsigned*)(row_tok + (size_t)e * T + pos), (LAS unsigned*)(blk + wid * 256), 4, 0, 0);
        else __builtin_amdgcn_global_load_lds((const unsigned*)(rsc + (size_t)e * T + pos), (LAS unsigned*)(blk + 1024 + (wid - 4) * 256), 4, 0, 0);
        if (wid == 0) __builtin_amdgcn_global_load_lds((const unsigned*)(swup + (size_t)e * 2 * DFF + u.p1 * 256 + lane * 4), (LAS unsigned*)(blk + 2048), 16, 0, 0);
        if (wid == 1) __builtin_amdgcn_global_load_lds((const unsigned*)(b_up + (size_t)e * 2 * DFF + u.p1 * 128 + (lane & 31) * 4 + (lane >> 5) * DFF), (LAS unsigned*)(blk + 3072), 16, 0, 0);
    }
    __device__ __forceinline__ unsigned row_off(const Unit& u, int r, LAS unsigned char* lds) const { return (unsigned)((const LAS int*)(lds + LDS_STAGE + u.q * 4096))[r] * (unsigned)rowbytes; }
};
struct SchedMoEUpT : SchedMoE { int u0, u1;
    __device__ __forceinline__ bool next(int i, Unit& u) const { const int ii = i + u0; if (ii >= u1) return false; return next_tab(ii, u); } };
struct SchedMoEDown : SchedMoE {
    const float *sa, *swdn, *b_dn;
    __device__ __forceinline__ bool next(int i, Unit& u) const { if (!SchedMoE::next_tab(i, u)) return false; u.a0 = A + (size_t)u.p0 * 256 * rowbytes; u.a1 = u.a0 + (size_t)128 * rowbytes; return true; }
    __device__ __forceinline__ void prefetch(const Unit& u, LAS unsigned char* lds) const {
        LAS unsigned char* blk = lds + LDS_STAGE + u.q * 4096;
        const int wid = wv, e = u.p2; int lane = lane_id(); asm volatile("" : "+v"(lane));
        if (wid == 1) __builtin_amdgcn_global_load_lds((const unsigned*)(swdn + (size_t)e * D + u.p1 * 256 + lane * 4), (LAS unsigned*)(blk + 1024), 16, 0, 0);
        if (wid == 2) __builtin_amdgcn_global_load_lds((const unsigned*)(b_dn + (size_t)e * D + u.p1 * 256 + lane * 4), (LAS unsigned*)(blk + 2048), 16, 0, 0);
    }
};

#define EPI_LOOP_AM for (int ai = 0; ai < 2; ++ai) _Pragma("unroll") for (int m = 0; m < 4; ++m)
#define EPI_FENCE __builtin_amdgcn_sched_barrier(0)
struct EpiG1N {
    static constexpr bool PERM = true;
    bf16 *qs, *kk, *gs, *Acat; const float *dec_f, *dec_b, *sx0, *swin;
    __device__ __forceinline__ void operator()(AccI& acci, const Unit& u, LAS unsigned char*, int wr, int wc, int fr, int fq) const {
        const int pm = u.p0, pn = u.p1, c0 = wc * 32 + 8 * fq;
        f32x4 swc[2][2];
#pragma unroll
        for (int bj = 0; bj < 2; ++bj)
#pragma unroll
            for (int n = 0; n < 2; ++n) swc[bj][n] = *(const GAS f32x4*)(swin + u.p2 + 128 * bj + c0 + 4 * n);
#define ACCF(ai_, bj_, m_, n_, j_) ((float)acci[ai_][bj_][m_][n_][j_] * (sxr * swc[bj_][n_][j_]))
        if (pn < 8) {
            const int h = pn & 3; const bool isq = pn < 4;
            float inv[8];
#pragma unroll
            for (int e = 0; e < 8; ++e) inv[e] = __builtin_amdgcn_exp2f(-(float)(c0 + e) * (13.287712379549449f / 128.f)) * 0.15915494309189535f;
            const float lgf = -fexp(dec_f[h]), lgb = -fexp(dec_b[h]);
#pragma unroll
            EPI_LOOP_AM {
                const int r = 128 * ai + 64 * wr + 16 * m + fr, tok = pm * 256 + r; const float pos = (float)tok; const float sxr = sx0[tok];
                f32x4 o1[2], o2[2];
#pragma unroll
                for (int n = 0; n < 2; ++n)
#pragma unroll
                    for (int j = 0; j < 4; ++j) { float c, s; cs_rev(pos * inv[4 * n + j], c, s); const float x1 = ACCF(ai, 0, m, n, j), x2 = ACCF(ai, 1, m, n, j); o1[n][j] = x1 * c - x2 * s; o2[n][j] = x2 * c + x1 * s; }
                if (isq) {
                    bf16* q = qs + (size_t)tok * RW + h * HD + c0; *(GAS v4u*)q = pack8(o1[0], o1[1]); *(GAS v4u*)(q + 128) = pack8(o2[0], o2[1]);
                    const int il = r; const float wf = fexp(lgf * (float)(il + 1)), wb = fexp(lgb * (float)(255 - il));
                    bf16* a = Acat + ((size_t)h * T + tok) * CAT + c0;
                    *(GAS v4u*)(a + 256) = pack8(o1[0] * wf, o1[1] * wf); *(GAS v4u*)(a + 384) = pack8(o2[0] * wf, o2[1] * wf);
                    *(GAS v4u*)(a + 512) = pack8(o1[0] * wb, o1[1] * wb); *(GAS v4u*)(a + 640) = pack8(o2[0] * wb, o2[1] * wb);
                } else {
                    bf16* k = kk + (size_t)tok * RW + h * HD + c0; *(GAS v4u*)k = pack8(o1[0] * 0.0625f, o1[1] * 0.0625f); *(GAS v4u*)(k + 128) = pack8(o2[0] * 0.0625f, o2[1] * 0.0625f);
                }
            }
        } else {
#pragma unroll
            EPI_LOOP_AM {
                const int r = 128 * ai + 64 * wr + 16 * m + fr, tok = pm * 256 + r; const float sxr = sx0[tok];
#pragma unroll
                for (int bj = 0; bj < 2; ++bj) { f32x4 v[2];
#pragma unroll
                    for (int n = 0; n < 2; ++n)
#pragma unroll
                        for (int j = 0; j < 4; ++j) { const float g = ACCF(ai, bj, m, n, j); v[n][j] = g * __builtin_amdgcn_rcpf(1.f + fexp(-g)); }
                    *(GAS v4u*)(gs + (size_t)tok * RW + (pn - 8) * 256 + bj * 128 + c0) = pack8(v[0], v[1]); }
            }
        }
    }
};
#undef ACCF
struct EpiG1SF {
    static constexpr bool PERM = true;
    bf16* uTT; const float *sx0, *swin;
    __device__ __forceinline__ void operator()(AccI& acc, const Unit& u, LAS unsigned char*, int wr, int wc, int fr, int fq) const {
        const int a0 = wc * 32 + 8 * fq;
        float sxc[2][8];
#pragma unroll
        for (int bj = 0; bj < 2; ++bj)
#pragma unroll
            for (int e = 0; e < 8; ++e) sxc[bj][e] = sx0[128 * (a0 + e) + 2 * u.p1 + bj];
#pragma unroll
        EPI_LOOP_AM { const int cch = u.p0 * 256 + 128 * ai + 64 * wr + 16 * m + fr; const float swr = swin[cch];
#pragma unroll
            for (int bj = 0; bj < 2; ++bj) { f32x4 v0, v1;
#pragma unroll
                for (int j = 0; j < 4; ++j) { v0[j] = (float)acc[ai][bj][m][0][j] * (swr * sxc[bj][j]); v1[j] = (float)acc[ai][bj][m][1][j] * (swr * sxc[bj][4 + j]); }
                *(GAS v4u*)(uTT + ((size_t)cch * 128 + (2 * u.p1 + bj)) * 128 + a0) = pack8(v0, v1); } }
    }
};
struct EpiG1SKV {
    static constexpr bool PERM = true;
    bf16 *kTw, *Bcat; const float *dec_f, *dec_b, *sx0, *swin;
    __device__ __forceinline__ void operator()(AccI& acc, const Unit& u, LAS unsigned char*, int wr, int wc, int fr, int fq) const {
        const int pm = u.p0, n_ch = u.p1, c0 = wc * 32 + 8 * fq;
        f32x4 sxc[2][2];
#pragma unroll
        for (int bj = 0; bj < 2; ++bj)
#pragma unroll
            for (int n = 0; n < 2; ++n) sxc[bj][n] = *(const GAS f32x4*)(sx0 + n_ch * 256 + 128 * bj + c0 + 4 * n);
        if (pm < 4) {
            const int h = pm; const float lgf = -fexp(dec_f[h]), lgb = -fexp(dec_b[h]);
#pragma unroll
            for (int m = 0; m < 4; ++m) {
                const int d = 64 * wr + 16 * m + fr;
                const float sw1 = swin[u.p2 + d], sw2 = swin[u.p2 + 128 + d];
                const float inv = __builtin_amdgcn_exp2f(-(float)d * (13.287712379549449f / 128.f)) * 0.15915494309189535f;
#pragma unroll
                for (int bj = 0; bj < 2; ++bj) {
                    f32x4 f1[2], f2[2], b1[2], b2[2];
#pragma unroll
                    for (int n = 0; n < 2; ++n)
#pragma unroll
                        for (int j = 0; j < 4; ++j) { const int il = 128 * bj + c0 + 4 * n + j; const float pos = (float)(n_ch * 256 + il); float c, s; cs_rev(pos * inv, c, s);
                            const float x1 = (float)acc[0][bj][m][n][j] * (sw1 * sxc[bj][n][j]), x2 = (float)acc[1][bj][m][n][j] * (sw2 * sxc[bj][n][j]); const float o1 = (x1 * c - x2 * s) * 0.0625f, o2 = (x2 * c + x1 * s) * 0.0625f;
                            const float wf = fexp(lgf * (float)(255 - il)), wb = fexp(lgb * (float)(il + 1));
                            f1[n][j] = o1 * wf; f2[n][j] = o2 * wf; b1[n][j] = o1 * wb; b2[n][j] = o2 * wb; }
                    const size_t tcol = (size_t)n_ch * 256 + 128 * bj + c0;
                    bf16* pf = kTw + ((size_t)(h * HD + d)) * T + tcol; bf16* pb = pf + (size_t)RW * T;
                    *(GAS v4u*)pf = pack8(f1[0], f1[1]); *(GAS v4u*)(pf + (size_t)128 * T) = pack8(f2[0], f2[1]);
                    *(GAS v4u*)pb = pack8(b1[0], b1[1]); *(GAS v4u*)(pb + (size_t)128 * T) = pack8(b2[0], b2[1]);
                }
            }
        } else {
            const int h = pm - 4;
#pragma unroll
            EPI_LOOP_AM { const int dv = 128 * ai + 64 * wr + 16 * m + fr; const float swr = swin[u.p2 + dv];
#pragma unroll
                for (int bj = 0; bj < 2; ++bj) { f32x4 v0, v1;
#pragma unroll
                    for (int j = 0; j < 4; ++j) { v0[j] = (float)acc[ai][bj][m][0][j] * (swr * sxc[bj][0][j]); v1[j] = (float)acc[ai][bj][m][1][j] * (swr * sxc[bj][1][j]); }
                    *(GAS v4u*)(Bcat + ((size_t)(h * NCH + n_ch) * 256 + dv) * CAT + 128 * bj + c0) = pack8(v0, v1); } }
        }
    }
};
struct EpiS1 {
    static constexpr bool PERM = true;
    bf16* A1;
    __device__ __forceinline__ void operator()(Acc& acc, const Unit& u, LAS unsigned char*, int wr, int wc, int fr, int fq) const {
        const int b0 = wc * 32 + 8 * fq;
#pragma unroll
        for (int m = 0; m < 4; ++m) { const int k1 = 64 * wr + 16 * m + fr;
#pragma unroll
            for (int bj = 0; bj < 2; ++bj) { const int cch = 2 * u.p1 + bj; f32x4 re[2], im[2];
#pragma unroll
                for (int n = 0; n < 2; ++n)
#pragma unroll
                    for (int j = 0; j < 4; ++j) { const int b = b0 + 4 * n + j; float c, s; cs_rev((float)(k1 * b) * (1.f / 16384.f), c, s);
                        const float xr = acc[0][bj][m][n][j], xi = acc[1][bj][m][n][j]; re[n][j] = xr * c + xi * s; im[n][j] = xi * c - xr * s; }
                bf16* p = A1 + (((size_t)k1 * 1024 + cch) * 2) * 128 + b0;
                *(GAS v4u*)p = pack8(re[0], re[1]); *(GAS v4u*)(p + 128) = pack8(im[0], im[1]); EPI_FENCE; } }
    }
};
struct EpiS2 {
    static constexpr bool PERM = true;
    bf16* Zt;
    __device__ __forceinline__ void operator()(Acc& acc, const Unit& u, LAS unsigned char*, int wr, int wc, int fr, int fq) const {
        const int k1 = u.p1 >> 2, cb = (u.p1 & 3) * 256, c0 = wc * 32 + 8 * fq;
#pragma unroll
        EPI_LOOP_AM { const int k2 = 64 * wr + 16 * m + fr, k = k1 + 128 * k2;
#pragma unroll
            for (int bj = 0; bj < 2; ++bj) { const int cch = cb + 128 * bj + c0, g = cch >> 7, cg = cch & 127;
                *(GAS v4u*)(Zt + (size_t)k * 2048 + g * 256 + ai * 128 + cg) = pack8(acc[ai][bj][m][0], acc[ai][bj][m][1]); } }
    }
};
struct EpiChan {
    static constexpr bool PERM = true;
    bf16* y;
    __device__ __forceinline__ void operator()(Acc& acc, const Unit& u, LAS unsigned char*, int wr, int wc, int fr, int fq) const {
        const int l0 = wc * 32 + 8 * fq; const float norm = 6.9053396600248786e-4f;
#pragma unroll
        EPI_LOOP_AM { const int R = u.p0 * 256 + 128 * ai + 64 * wr + 16 * m + fr, k = R >> 3, g = R & 7;
            *(GAS v4u*)(y + (size_t)k * D + g * 128 + l0) = pack8(acc[ai][0][m][0] * norm, acc[ai][0][m][1] * norm); }
    }
};
struct EpiScores {
    static constexpr bool PERM = true;
    bf16* Acat; const float *dec_f, *dec_b;
    __device__ __forceinline__ void operator()(Acc& acc, const Unit& u, LAS unsigned char*, int wr, int wc, int fr, int fq) const {
        const int h = u.p0, n_ch = u.p1, c0 = wc * 32 + 8 * fq; const float lgf = -fexp(dec_f[h]), lgb = -fexp(dec_b[h]);
#pragma unroll
        EPI_LOOP_AM { const int i = 128 * ai + 64 * wr + 16 * m + fr;
#pragma unroll
            for (int bj = 0; bj < 2; ++bj) { f32x4 v[2];
#pragma unroll
                for (int n = 0; n < 2; ++n)
#pragma unroll
                    for (int j = 0; j < 4; ++j) { const int jc = 128 * bj + c0 + 4 * n + j; const float dd = (float)(i - jc); const float w = (jc <= i) ? fexp(lgf * dd) : fexp(-lgb * dd); v[n][j] = acc[ai][bj][m][n][j] * w; }
                *(GAS v4u*)(Acat + ((size_t)h * T + n_ch * 256 + i) * CAT + 128 * bj + c0) = pack8(v[0], v[1]); EPI_FENCE; } }
    }
};
struct EpiKV {
    static constexpr bool PERM = true;
    bf16* kvT;
    __device__ __forceinline__ void operator()(Acc& acc, const Unit& u, LAS unsigned char*, int wr, int wc, int fr, int fq) const {
#pragma unroll
        EPI_LOOP_AM { const int dv = 128 * ai + 64 * wr + 16 * m + fr; bf16* rowp = kvT + (((size_t)u.p0 * NCH + u.p1) * 256 + dv) * 256 + wc * 32 + 8 * fq;
#pragma unroll
            for (int bj = 0; bj < 2; ++bj) *(GAS v4u*)(rowp + bj * 128) = pack8(acc[ai][bj][m][0], acc[ai][bj][m][1]); }
    }
};
struct EpiOut {
    static constexpr bool PERM = true;
    bf16* y; const bf16* gs; const float* gn_g;
    __device__ __forceinline__ void operator()(Acc& acc, const Unit& u, LAS unsigned char* lds, int wr, int wc, int fr, int fq) const {
        const int h = u.p0, n_ch = u.p1, c0 = wc * 32 + 8 * fq;
        LAS f32x2* P = (LAS f32x2*)(lds + LDS_STAGE);
#pragma unroll
        EPI_LOOP_AM {
            float s = 0.f;
#pragma unroll
            for (int bj = 0; bj < 2; ++bj)
#pragma unroll
                for (int n = 0; n < 2; ++n) { const f32x4 x = acc[ai][bj][m][n]; s += (x[0] + x[1]) + (x[2] + x[3]); }
            s += __shfl_xor(s, 16); s += __shfl_xor(s, 32);
            const float mw = s * (1.f / 64.f); float q = 0.f;
#pragma unroll
            for (int bj = 0; bj < 2; ++bj)
#pragma unroll
                for (int n = 0; n < 2; ++n) { const f32x4 d = acc[ai][bj][m][n] - mw; q += (d[0] * d[0] + d[1] * d[1]) + (d[2] * d[2] + d[3] * d[3]); }
            q += __shfl_xor(q, 16); q += __shfl_xor(q, 32);
            if (fq == 0) P[(128 * ai + 64 * wr + 16 * m + fr) * 4 + wc] = (f32x2){mw, q};
        }
        LDS_WAIT(); __builtin_amdgcn_s_barrier(); asm volatile("" ::: "memory");
#pragma unroll
        EPI_LOOP_AM {
            const int r = 128 * ai + 64 * wr + 16 * m + fr, tok = n_ch * 256 + r;
            const f32x2 a = P[r * 4 + 0], b = P[r * 4 + 1], c = P[r * 4 + 2], d = P[r * 4 + 3];
            const float mt = (a.x + b.x + c.x + d.x) * 0.25f; const float da = a.x - mt, db = b.x - mt, dc = c.x - mt, dd = d.x - mt;
            const float m2 = (a.y + b.y) + (c.y + d.y) + 64.f * ((da * da + db * db) + (dc * dc + dd * dd));
            const float rstd = 1.f / sqrtf(m2 * (1.f / 256.f) + GN_EPS);
#pragma unroll
            for (int bj = 0; bj < 2; ++bj) {
                const int col = h * HD + 128 * bj + c0; const v4u gv = *(const GAS v4u*)(gs + (size_t)tok * RW + col);
                const f32x4 g0 = *(const GAS f32x4*)(gn_g + col), g1 = *(const GAS f32x4*)(gn_g + col + 4);
                f32x4 o0 = (acc[ai][bj][m][0] - mt) * rstd * g0, o1 = (acc[ai][bj][m][1] - mt) * rstd * g1;
                o0[0] *= bf_lo(gv.x); o0[1] *= bf_hi(gv.x); o0[2] *= bf_lo(gv.y); o0[3] *= bf_hi(gv.y); o1[0] *= bf_lo(gv.z); o1[1] *= bf_hi(gv.z); o1[2] *= bf_lo(gv.w); o1[3] *= bf_hi(gv.w);
                *(GAS v4u*)(y + (size_t)tok * D + FW + col) = pack8(o0, o1); }
        }
        LDS_WAIT(); __builtin_amdgcn_s_barrier(); asm volatile("" ::: "memory");
    }
};
struct EpiWout {
    static constexpr bool PERM = true;
    bf16* z1; const float *x, *st0, *g0, *b0;
    __device__ __forceinline__ void operator()(Acc& acc, const Unit& u, LAS unsigned char*, int wr, int wc, int fr, int fq) const {
        const int colb = u.p1 * 256 + wc * 32 + 8 * fq;
#pragma unroll
        for (int bj = 0; bj < 2; ++bj) { const int col = colb + bj * 128;
            const f32x4 ga = *(const GAS f32x4*)(g0 + col), gb = *(const GAS f32x4*)(g0 + col + 4), ba = *(const GAS f32x4*)(b0 + col), bb = *(const GAS f32x4*)(b0 + col + 4);
#pragma unroll
            EPI_LOOP_AM { const int row = u.p0 * 256 + 128 * ai + 64 * wr + 16 * m + fr; const f32x2 st = *(const GAS f32x2*)(st0 + 2 * row); const size_t off = (size_t)row * D + col;
                const f32x4 xa = *(const GAS f32x4*)(x + off), xb = *(const GAS f32x4*)(x + off + 4);
                *(GAS v4u*)(z1 + off) = pack8(((xa - st.x) * st.y * ga + ba) * ALPHA + acc[ai][bj][m][0], ((xb - st.x) * st.y * gb + bb) * ALPHA + acc[ai][bj][m][1]); } }
    }
};
struct EpiUp {
    static constexpr bool PERM = true;
    unsigned char* act8;
    __device__ __forceinline__ void operator()(AccI& acc, const Unit& u, LAS unsigned char* lds, int wr, int wc, int fr, int fq) const {
        const int rt = u.p0, pn = u.p1, c0 = pn * 128 + wc * 32 + 8 * fq;
        const LAS float* blk = (const LAS float*)(lds + LDS_STAGE + u.q * 4096);
        float sx[2][4];
#pragma unroll
        EPI_LOOP_AM sx[ai][m] = blk[256 + 128 * ai + 64 * wr + 16 * m + fr];
        f32x4 sg[2], sl[2], bg[2], bl[2];
#pragma unroll
        for (int n = 0; n < 2; ++n) { const int cc = wc * 32 + 8 * fq + 4 * n;
            sg[n] = *(const LAS f32x4*)(blk + 512 + cc); sl[n] = *(const LAS f32x4*)(blk + 512 + 128 + cc); bg[n] = *(const LAS f32x4*)(blk + 768 + cc); bl[n] = *(const LAS f32x4*)(blk + 768 + 128 + cc); }
#pragma unroll
        EPI_LOOP_AM { const int r = 128 * ai + 64 * wr + 16 * m + fr; int pk[2];
#pragma unroll
            for (int n = 0; n < 2; ++n) { f32x2 v2[2];
#pragma unroll
                for (int jp = 0; jp < 2; ++jp) {
                    const f32x2 sx2 = (f32x2){sx[ai][m], sx[ai][m]};
                    f32x2 gl = (f32x2){(float)acc[ai][0][m][n][2 * jp], (float)acc[ai][0][m][n][2 * jp + 1]} * (sx2 * (f32x2){sg[n][2 * jp], sg[n][2 * jp + 1]}) + (f32x2){bg[n][2 * jp], bg[n][2 * jp + 1]};
                    f32x2 li = (f32x2){(float)acc[ai][1][m][n][2 * jp], (float)acc[ai][1][m][n][2 * jp + 1]} * (sx2 * (f32x2){sl[n][2 * jp], sl[n][2 * jp + 1]}) + (f32x2){bl[n][2 * jp], bl[n][2 * jp + 1]};
                    gl = __builtin_elementwise_min(gl, (f32x2){7.f, 7.f}); li = __builtin_elementwise_min(__builtin_elementwise_max(li, (f32x2){-7.f, -7.f}), (f32x2){7.f, 7.f});
                    const f32x2 ea = gl * (-1.702f * 1.4426950408889634f); f32x2 den; den.x = __builtin_amdgcn_exp2f(ea.x); den.y = __builtin_amdgcn_exp2f(ea.y); den = den + 1.0f;
                    f32x2 rc; rc.x = __builtin_amdgcn_rcpf(den.x); rc.y = __builtin_amdgcn_rcpf(den.y);
                    v2[jp] = (gl * rc) * (li * 4.0f + 4.0f); }
                int p = __builtin_amdgcn_cvt_pk_fp8_f32(v2[0].x, v2[0].y, 0, false); p = __builtin_amdgcn_cvt_pk_fp8_f32(v2[1].x, v2[1].y, p, true); pk[n] = p; }
            *(GAS v2u*)(act8 + ((size_t)rt * 256 + r) * DFF + c0) = (v2u){(unsigned)pk[0], (unsigned)pk[1]}; }
    }
};
struct EpiDown {
    static constexpr bool PERM = true;
    unsigned char* yr8;
    __device__ __forceinline__ void operator()(Acc& acc, const Unit& u, LAS unsigned char* lds, int wr, int wc, int fr, int fq) const {
        const int rt = u.p0, pn = u.p1, c0 = pn * 256 + wc * 32 + 8 * fq;
        const LAS float* blk = (const LAS float*)(lds + LDS_STAGE + u.q * 4096);
#pragma unroll
        for (int bj = 0; bj < 2; ++bj) { const int cc = 128 * bj + wc * 32 + 8 * fq;
#pragma unroll
            EPI_LOOP_AM { const int r = 128 * ai + 64 * wr + 16 * m + fr;
                const f32x4 w0 = *(const LAS f32x4*)(blk + 256 + cc) * 0.25f, w1 = *(const LAS f32x4*)(blk + 256 + cc + 4) * 0.25f, b0 = *(const LAS f32x4*)(blk + 512 + cc), b1 = *(const LAS f32x4*)(blk + 512 + cc + 4);
                f32x4 y0 = (acc[ai][bj][m][0] * w0 + b0) * 32.f, y1 = (acc[ai][bj][m][1] * w1 + b1) * 32.f;
#pragma unroll
                for (int j = 0; j < 4; ++j) { y0[j] = fminf(fmaxf(y0[j], -440.f), 440.f); y1[j] = fminf(fmaxf(y1[j], -440.f), 440.f); }
                int p0 = __builtin_amdgcn_cvt_pk_fp8_f32(y0[0], y0[1], 0, false); p0 = __builtin_amdgcn_cvt_pk_fp8_f32(y0[2], y0[3], p0, true);
                int p1 = __builtin_amdgcn_cvt_pk_fp8_f32(y1[0], y1[1], 0, false); p1 = __builtin_amdgcn_cvt_pk_fp8_f32(y1[2], y1[3], p1, true);
                *(GAS v2u*)(yr8 + ((size_t)rt * 256 + r) * D + c0 + 128 * bj) = (v2u){(unsigned)p0, (unsigned)p1}; EPI_FENCE; } }
    }
};

__device__ __forceinline__ void p3_scan(Frame& F) {
    const bf16* kvT = WSP(bf16, WS_KVT); bf16* Bcat = WSP(bf16, WS_BCAT);
    const int NQ = 2 * NH * 256 * 64;
    for (int q = F.vcu * NTHR + FTID; q < NQ; q += F.G * NTHR) {
        const int dk4 = q & 63, dv = (q >> 6) & 255, dh = q >> 14, dir = dh >> 2, h = dh & 3;
        const float lg = -fexp((dir ? F.dec_b : F.dec_f)[h]); const float cd = fexp(lg * (float)C2);
        f32x4 S = (f32x4){0.f, 0.f, 0.f, 0.f};
        for (int s = 0; s < NCH; ++s) { const int n = dir ? (NCH - 1 - s) : s;
            const v2u kw = *(const GAS v2u*)(kvT + (((size_t)dh * NCH + n) * 256 + dv) * 256 + dk4 * 4); const f32x4 kv = (f32x4){bf_lo(kw.x), bf_hi(kw.x), bf_lo(kw.y), bf_hi(kw.y)};
            v2u w; w.x = cvt_pk_bf16(S[0], S[1]); w.y = cvt_pk_bf16(S[2], S[3]);
            *(GAS v2u*)(Bcat + ((size_t)(h * NCH + n) * 256 + dv) * CAT + 256 + dir * 256 + dk4 * 4) = w;
            S = S * cd + kv; }
    }
}

__device__ __forceinline__ void p6_router(Frame& F) {
    const bf16* z1 = WSP(bf16, WS_Z1); unsigned* h1q = WSP(unsigned, WS_H1Q); float* sxg = WSP(float, WS_SX); float* rsc = WSP(float, WS_RSC); float* st1 = WSP(float, WS_ST0) + 2 * T;
    int* topi = WSP(int, WS_RT); float* gate = (float*)(topi + 4 * T); int* posb = (int*)(gate + 4 * T); int* row_tok = posb + 4 * T;
    constexpr int HP = 528;
    LAS unsigned char* Hhi = F.lds;
    LAS unsigned char* Hlo = Hhi + 64 * HP;
    LAS unsigned char* Whi = Hlo + 64 * HP;
    LAS unsigned char* Wlo = Whi + 32 * HP;
    LAS float* stl = (LAS float*)(Wlo + 32 * HP);
    LAS float* lg = stl + 128;
    LAS int* hist = (LAS int*)(lg + 64 * 33);
    LAS float* sxl = (LAS float*)(hist + 64);
    LAS float* part = sxl + 64;
    const bf16* wrt = WSP(bf16, WS_WRT);
    for (int blk = F.vcu; blk < T / 64; blk += F.G) {
        const int t0 = blk * 64;
        {
            v2u raw[8][8]; const int ln_ = FLANE;
#pragma unroll
            for (int rr = 0; rr < 8; ++rr) { const GAS v2u* xr = (const GAS v2u*)(z1 + (size_t)(t0 + F.wave * 8 + rr) * D) + ln_;
#pragma unroll
                for (int j = 0; j < 8; ++j) raw[rr][j] = xr[64 * j]; }
#pragma unroll
            for (int rr = 0; rr < 8; ++rr) { const int row = F.wave * 8 + rr, m = t0 + row;
                f32x4 v[8]; float s = 0.f;
#pragma unroll
                for (int j = 0; j < 8; ++j) { const v2u w = raw[rr][j]; v[j] = (f32x4){bf_lo(w.x), bf_hi(w.x), bf_lo(w.y), bf_hi(w.y)}; s += (v[j][0] + v[j][1]) + (v[j][2] + v[j][3]); }
                const float mean = wave_sum(s) * (1.f / D); float s2 = 0.f;
#pragma unroll
                for (int j = 0; j < 8; ++j) { v[j] = v[j] - mean; s2 += (v[j][0] * v[j][0] + v[j][1] * v[j][1]) + (v[j][2] * v[j][2] + v[j][3] * v[j][3]); }
                const float rstd = 1.f / sqrtf(wave_sum(s2) * (1.f / D) + LN_EPS);
                float am = 0.f;
#pragma unroll
                for (int j = 0; j < 8; ++j) { const f32x4 g = *((const GAS f32x4*)F.ln1_g + FLANE + 64 * j), b = *((const GAS f32x4*)F.ln1_b + FLANE + 64 * j);
                    v[j] = v[j] * rstd * g + b; am = fmaxf(am, fmaxf(fmaxf(fabsf(v[j][0]), fabsf(v[j][1])), fmaxf(fabsf(v[j][2]), fabsf(v[j][3])))); }
#pragma unroll
                for (int o = 1; o < 64; o <<= 1) am = fmaxf(am, __shfl_xor(am, o));
                const float sc = am > 0.f ? am * (1.f / 127.f) : 1.f, inv = 1.f / sc;
#pragma unroll
                for (int j = 0; j < 8; ++j) { const int q0 = (int)__builtin_rintf(v[j][0] * inv), q1 = (int)__builtin_rintf(v[j][1] * inv), q2 = (int)__builtin_rintf(v[j][2] * inv), q3 = (int)__builtin_rintf(v[j][3] * inv);
                    h1q[(size_t)m * (D / 4) + FLANE + 64 * j] = (unsigned)(q0 & 0xff) | ((unsigned)(q1 & 0xff) << 8) | ((unsigned)(q2 & 0xff) << 16) | ((unsigned)(q3 & 0xff) << 24); }
                if (FLANE == 0) { st1[2 * m] = mean; st1[2 * m + 1] = rstd; stl[2 * row] = mean; stl[2 * row + 1] = rstd; sxg[m] = sc; sxl[row] = sc; }
            }
        }
        if (FTID < 64) hist[FTID] = 0;
        __syncthreads();
        const int tt = F.wave & 3, kh = F.wave >> 2; f32x4 ac[2];
        ac[0] = (f32x4){0.f, 0.f, 0.f, 0.f}; ac[1] = (f32x4){0.f, 0.f, 0.f, 0.f};
        v2u zp[8]; v4u wp[4];
#define P6_LOAD(kc_) do { const int ln_ = FLANE; _Pragma("unroll") for (int i_ = 0; i_ < 8; ++i_) zp[i_] = *(const GAS v2u*)(z1 + (size_t)(t0 + F.wave + 8 * i_) * D + (kc_) * 256 + ln_ * 4); \
        _Pragma("unroll") for (int i_ = 0; i_ < 4; ++i_) { const int q_ = F.wave * 64 + ln_ + NTHR * i_; wp[i_] = *(const GAS v4u*)(wrt + (size_t)(q_ >> 5) * D + (kc_) * 256 + (q_ & 31) * 8); } } while (0)
        P6_LOAD(0);
        for (int kc = 0; kc < 8; ++kc) {
            { const int ln = FLANE, col = kc * 256 + ln * 4; const f32x4 g = *(const GAS f32x4*)(F.ln1_g + col), b = *(const GAS f32x4*)(F.ln1_b + col);
#pragma unroll
              for (int i = 0; i < 8; ++i) { const int r = F.wave + 8 * i; const v2u zw = zp[i];
                const f32x4 zv = (f32x4){bf_lo(zw.x), bf_hi(zw.x), bf_lo(zw.y), bf_hi(zw.y)};
                const f32x4 hh = (zv - stl[2 * r]) * stl[2 * r + 1] * g + b;
                v2u hi, lo; hi.x = cvt_pk_bf16(hh[0], hh[1]); hi.y = cvt_pk_bf16(hh[2], hh[3]);
                lo.x = cvt_pk_bf16(hh[0] - bf_lo(hi.x), hh[1] - bf_hi(hi.x)); lo.y = cvt_pk_bf16(hh[2] - bf_lo(hi.y), hh[3] - bf_hi(hi.y));
                *(LAS v2u*)(Hhi + r * HP + ln * 8) = hi; *(LAS v2u*)(Hlo + r * HP + ln * 8) = lo; }
#pragma unroll
              for (int i = 0; i < 4; ++i) { const int q = F.wave * 64 + ln + NTHR * i, e = (q >> 5) & 31, c8 = q & 31; *(LAS v4u*)(((q >> 10) ? Wlo : Whi) + e * HP + c8 * 16) = wp[i]; } }
            __syncthreads();
            if (kc + 1 < 8) P6_LOAD(kc + 1);
            { const int ln = FLANE, fr = ln & 15, fq = ln >> 4;
#pragma unroll
              for (int ks = 0; ks < 4; ++ks) { const int kb = (kh * 128 + ks * 32 + fq * 8) * 2;
                const bf16x8 th = __builtin_bit_cast(bf16x8, *(const LAS i32x4*)(Hhi + (tt * 16 + fr) * HP + kb)), tl = __builtin_bit_cast(bf16x8, *(const LAS i32x4*)(Hlo + (tt * 16 + fr) * HP + kb));
#pragma unroll
                for (int et = 0; et < 2; ++et) { const bf16x8 wh = __builtin_bit_cast(bf16x8, *(const LAS i32x4*)(Whi + (et * 16 + fr) * HP + kb)), wl = __builtin_bit_cast(bf16x8, *(const LAS i32x4*)(Wlo + (et * 16 + fr) * HP + kb));
                    ac[et] = __builtin_amdgcn_mfma_f32_16x16x32_bf16(wh, th, ac[et], 0, 0, 0); ac[et] = __builtin_amdgcn_mfma_f32_16x16x32_bf16(wl, th, ac[et], 0, 0, 0); ac[et] = __builtin_amdgcn_mfma_f32_16x16x32_bf16(wh, tl, ac[et], 0, 0, 0); } } }
            __syncthreads();
        }
#undef P6_LOAD
        { const int ln = FLANE, fr = ln & 15, fq = ln >> 4;
#pragma unroll
          for (int et = 0; et < 2; ++et) *(LAS f32x4*)(part + (kh * 64 + tt * 16 + fr) * 32 + et * 16 + 4 * fq) = ac[et];
          __syncthreads();
          { const int r = FTID >> 3, e0 = (FTID & 7) * 4;
              const f32x4 a = *(const LAS f32x4*)(part + (0 * 64 + r) * 32 + e0), b = *(const LAS f32x4*)(part + (1 * 64 + r) * 32 + e0);
              const f32x4 br = *(const GAS f32x4*)(F.b_r + e0), sum = (a + b) + br; LAS float* d = lg + r * 33 + e0; d[0] = sum[0]; d[1] = sum[1]; d[2] = sum[2]; d[3] = sum[3]; } }
        __syncthreads();
        int ek[4] = {0, 0, 0, 0}, lp[4] = {0, 0, 0, 0}; float gk[4] = {0.f, 0.f, 0.f, 0.f};
        if (FTID < 64) {
            float lv[4]; unsigned used = 0u;
#pragma unroll
            for (int k = 0; k < 4; ++k) { float best = -3.0e38f; int bi = 0;
                for (int e = 0; e < NE; ++e) { const float v = lg[FTID * 33 + e]; const bool ok = !((used >> e) & 1u) && (v > best); best = ok ? v : best; bi = ok ? e : bi; }
                used |= 1u << bi; ek[k] = bi; lv[k] = best; }
            const float mx = lv[0]; float den = 0.f;
#pragma unroll
            for (int k = 0; k < 4; ++k) { gk[k] = fexp(lv[k] - mx); den += gk[k]; }
            const float rd = 1.f / den;
#pragma unroll
            for (int k = 0; k < 4; ++k) { gk[k] *= rd; lp[k] = __hip_atomic_fetch_add(&hist[ek[k]], 1, __ATOMIC_RELAXED, __HIP_MEMORY_SCOPE_WORKGROUP); }
        }
        __syncthreads();
        if (FTID < NE) hist[32 + FTID] = (int)__hip_atomic_fetch_add(F.ctl + CW_CNT + 64 * FTID, (unsigned)hist[FTID], RLX_AGENT);
        __syncthreads();
        if (FTID < 64) { const int tok = t0 + FTID;
#pragma unroll
            for (int k = 0; k < 4; ++k) { const int pos = hist[32 + ek[k]] + lp[k]; row_tok[(size_t)ek[k] * T + pos] = tok; rsc[(size_t)ek[k] * T + pos] = sxl[FTID]; topi[4 * tok + k] = ek[k]; gate[4 * tok + k] = gk[k]; posb[4 * tok + k] = pos; } }
        __syncthreads();
    }
}

__device__ __forceinline__ void build_units(Frame& F, LAS int* tstart, int nN, int c) {
    __syncthreads();
    if (FTID < 64) { const int RT = tstart[NE], L = FTID * F.G + c; int w = -1;
        if (L < RT * nN) { int rt, pn; gm::tile_order(L, RT, nN, rt, pn); w = rt | (pn << 10) | (tstart[40 + rt] << 15); }
        tstart[400 + FTID] = w; }
    __syncthreads();
}

__device__ __forceinline__ void p8_requant(Frame& F, const LAS int* tstart) {
    const bf16* act = WSP(bf16, WS_ACT); unsigned* aq = WSP(unsigned, WS_ACTQ); float* sa = WSP(float, WS_SA); const unsigned* rmax = F.ctl + CW_RMAX;
    const int R = tstart[NE] * 256, gw = F.vcu * NWAVES + F.wave, NGW = F.G * NWAVES;
    for (int row = gw; row < R; row += NGW) {
        const float mx = __uint_as_float(rmax[row]); const float sc = mx > 0.f ? mx * (1.f / 127.f) : 1.f, inv = 1.f / sc;
#pragma unroll
        for (int j = 0; j < 2; ++j) { const int col = 16 * FLANE + 1024 * j;
            const v4u a = *(const GAS v4u*)(act + (size_t)row * DFF + col), b = *(const GAS v4u*)(act + (size_t)row * DFF + col + 8);
            const unsigned src[8] = {a.x, a.y, a.z, a.w, b.x, b.y, b.z, b.w}; unsigned o[4];
#pragma unroll
            for (int d = 0; d < 4; ++d) { unsigned w = 0u;
#pragma unroll
                for (int h2 = 0; h2 < 2; ++h2) { const unsigned u2 = src[2 * d + h2]; int q0 = (int)__builtin_rintf(bf_lo(u2) * inv), q1 = (int)__builtin_rintf(bf_hi(u2) * inv);
                    q0 = q0 > 127 ? 127 : (q0 < -127 ? -127 : q0); q1 = q1 > 127 ? 127 : (q1 < -127 ? -127 : q1);
                    w |= ((unsigned)(q0 & 0xff) << (16 * h2)) | ((unsigned)(q1 & 0xff) << (16 * h2 + 8)); }
                o[d] = w; }
            *(GAS v4u*)(aq + ((size_t)row * DFF + col) / 4) = (v4u){o[0], o[1], o[2], o[3]}; }
        if (FLANE == 0) sa[row] = sc;
    }
}

__device__ __forceinline__ void build_tstart(Frame& F, LAS int* tstart) {
    if (FTID == 0) { int s = 0; for (int e = 0; e < NE; ++e) { tstart[e] = s; const unsigned n = __hip_atomic_load(F.ctl + CW_CNT + 64 * e, RLX_AGENT); s += (int)((n + 255u) >> 8); } tstart[NE] = s; }
    __syncthreads();
    for (int rt = FTID; rt < RT_MAX; rt += NTHR) { int e = 0; for (int j = 1; j < NE; ++j) e += (tstart[j] <= rt) ? 1 : 0; tstart[40 + rt] = e; }
    __syncthreads();
}

__device__ __forceinline__ void p9_combine(Frame& F, const LAS int* tstart) {
    const bf16* z1 = WSP(bf16, WS_Z1); const float* st1 = WSP(float, WS_ST0) + 2 * T; const unsigned char* yr = (const unsigned char*)(F.ws + WS_YR);
    const int* topi = WSP(int, WS_RT); const float* gate = (const float*)(topi + 4 * T); const int* posb = (const int*)(gate + 4 * T);
    const int gw = F.vcu * NWAVES + F.wave, NGW = F.G * NWAVES; const int lane = lane_id();
    for (int m = gw; m < T; m += NGW) {
        const float mean1 = st1[2 * m], rstd1 = st1[2 * m + 1];
        size_t ro[4]; float gk[4];
#pragma unroll
        for (int k = 0; k < 4; ++k) { const int e = topi[4 * m + k]; ro[k] = ((size_t)tstart[e] * 256 + posb[4 * m + k]) * D; gk[k] = gate[4 * m + k]; }
        f32x4 v[8]; float s = 0.f;
#pragma unroll
        for (int j = 0; j < 8; ++j) { const int col = 4 * lane + 256 * j;
            const v2u zw = *(const GAS v2u*)(z1 + (size_t)m * D + col); const f32x4 zv = (f32x4){bf_lo(zw.x), bf_hi(zw.x), bf_lo(zw.y), bf_hi(zw.y)}, g = *(const GAS f32x4*)(F.ln1_g + col), b = *(const GAS f32x4*)(F.ln1_b + col);
            f32x4 a = ((zv - mean1) * rstd1 * g + b) * ALPHA;
#pragma unroll
            for (int k = 0; k < 4; ++k) { const int w = *(const GAS int*)(yr + ro[k] + col); const f32x2 lo = __builtin_amdgcn_cvt_pk_f32_fp8(w, false), hi = __builtin_amdgcn_cvt_pk_f32_fp8(w, true); const float g = gk[k] * (1.f / 32.f);
                a[0] += g * lo.x; a[1] += g * lo.y; a[2] += g * hi.x; a[3] += g * hi.y; }
            v[j] = a; s += (a[0] + a[1]) + (a[2] + a[3]); }
        const float mean = wave_sum(s) * (1.f / D); float s2 = 0.f;
#pragma unroll
        for (int j = 0; j < 8; ++j) { v[j] = v[j] - mean; s2 += (v[j][0] * v[j][0] + v[j][1] * v[j][1]) + (v[j][2] * v[j][2] + v[j][3] * v[j][3]); }
        const float rstd = 1.f / sqrtf(wave_sum(s2) * (1.f / D) + LN_EPS);
#pragma unroll
        for (int j = 0; j < 8; ++j) { const int col = 4 * lane + 256 * j; const f32x4 g = *(const GAS f32x4*)(F.ln2_g + col), b = *(const GAS f32x4*)(F.ln2_b + col);
            *(GAS f32x4*)(F.out + (size_t)m * D + col) = v[j] * rstd * g + b; }
    }
}

constexpr int NPH = 10;
__global__ void __launch_bounds__(NTHR, 2) fwd(Args args) {
    extern __shared__ __attribute__((aligned(16))) unsigned char lds_raw[];
    Frame F;
    F.lds = (LAS unsigned char*)lds_raw; F.ws = args.ws; F.ctl = (unsigned*)(args.ws + WS_CTL);
    F.wave = __builtin_amdgcn_readfirstlane((int)threadIdx.x >> 6);
    F.G = gridDim.x; { const int bx = blockIdx.x; F.vcu = (F.G % 8 == 0) ? (bx % 8) * (F.G / 8) + bx / 8 : bx; }
#define CAS __attribute__((address_space(4)))
#define FRAME_RELOAD() do { const CAS char* kp_ = (const CAS char*)__builtin_amdgcn_kernarg_segment_ptr(); asm volatile("" : "+s"(kp_)); const CAS Args* ap_ = (const CAS Args*)kp_; \
    F.x = ap_->in[0]; F.ln0_g = ap_->in[1]; F.ln0_b = ap_->in[2]; F.w_in = ap_->in[3]; F.dec_f = ap_->in[4]; F.dec_b = ap_->in[5]; F.gn_g = ap_->in[6]; F.w_out = ap_->in[7]; \
    F.ln1_g = ap_->in[8]; F.ln1_b = ap_->in[9]; F.w_r = ap_->in[10]; F.b_r = ap_->in[11]; F.w_up = ap_->in[12]; F.b_up = ap_->in[13]; F.w_dn = ap_->in[14]; F.b_dn = ap_->in[15]; \
    F.ln2_g = ap_->in[16]; F.ln2_b = ap_->in[17]; F.out = ap_->out; F.ws = ap_->ws; F.ctl = (unsigned*)(F.ws + WS_CTL); } while (0)
    FRAME_RELOAD();
    volatile LAS unsigned* lctl = (volatile LAS unsigned*)(F.lds + LDS_CTL_OFF);
    LAS int* tstart = (LAS int*)(F.lds + LDS_CTL_OFF + 64);
    for (int u = FTID; u < 128; u += NTHR) lctl[u] = 0u;
    __syncthreads();
    const int lo = args.ph_lo, hi = args.ph_hi;
    const bool single = (hi - lo) > 1;
    XcdBarrier bar; bar.bar = F.ctl + CW_BAR; bar.x = 0; bar.st = lctl; bar.wave = F.wave;
    if (single) { bar = xcd_barrier_post(F.ctl + CW_BAR, lctl); bar.wave = F.wave; }
#ifndef PH_MASK
#define PH_MASK 0x3ff
#endif
#define IN(k) (((PH_MASK >> (k)) & 1) && lo <= (k) && (k) < hi)
#ifndef SUB_MASK
#define SUB_MASK 0xff
#endif
#define SUB(n) ((SUB_MASK >> (n)) & 1)
#define SEAM(k) do { if (IN(k) && IN((k) + 1)) xcd_barrier(bar); } while (0)
    const int bc = (int)blockIdx.x;

    const int nDn = (NE * 64 + F.G - 1) / F.G, nS = (NE * 128 + F.G - 1) / F.G + nDn; int sdone = nDn; const int qgrp = (int)(blockIdx.x >> 3);
#define QSLOT(k24) do { const int e_ = sdone + ((nS - nDn) * (k24) + 23) / 24; do_slabs(F, sdone, e_ < nS ? e_ : nS); sdone = e_; } while (0)
#define QG(slot, nslots, k24) do { if (qgrp % (nslots) == (slot)) QSLOT(k24); } while (0)
    if (IN(0)) { FRAME_RELOAD(); p0_prologue(F); __syncthreads(); { const int nW = (DIN / 32 + F.G - 1) / F.G; do_slabs(F, -nW, 0); } }
    SEAM(0);
    if (IN(1)) { FRAME_RELOAD();
        QG(0, 4, 9);
        if (SUB(0)) { SchedG1N S; S.nt = D / 128; S.pitchA = D / 2; S.pitchB = D / 2; S.multA = 1; S.multB = 1; S.G = F.G; S.c = bc; S.wv = F.wave; S.A = (const char*)WSP(bf16, WS_H0B); S.Bt = (const char*)WSP(bf16, WS_WIN);
          EpiG1N E{WSP(bf16, WS_QS), WSP(bf16, WS_KK), WSP(bf16, WS_GS), WSP(bf16, WS_ACAT), F.dec_f, F.dec_b, WSP(float, WS_SX0), WSP(float, WS_SWIN)};
          gm::gemm_run<EpiG1N, SchedG1N, false, true>(F.lds, S, E); }
        QG(1, 4, 9);
        if (SUB(1)) { SchedG1SF S; S.nt = D / 128; S.pitchA = D / 2; S.pitchB = D / 2; S.multA = 1; S.multB = 128; S.G = F.G; S.c = bc; S.wv = F.wave; S.A = (const char*)WSP(bf16, WS_WIN); S.Bt = (const char*)WSP(bf16, WS_H0B);
          EpiG1SF E{WSP(bf16, WS_UTT), WSP(float, WS_SX0), WSP(float, WS_SWIN)};
          gm::gemm_run<EpiG1SF, SchedG1SF, false, true>(F.lds, S, E); }
        QG(2, 4, 9);
        if (SUB(2)) { SchedG1SKV S; S.nt = D / 128; S.pitchA = D / 2; S.pitchB = D / 2; S.multA = 1; S.multB = 1; S.G = F.G; S.c = bc; S.wv = F.wave; S.A = (const char*)WSP(bf16, WS_WIN); S.Bt = (const char*)WSP(bf16, WS_H0B);
          EpiG1SKV E{WSP(bf16, WS_KTW), WSP(bf16, WS_BCAT), F.dec_f, F.dec_b, WSP(float, WS_SX0), WSP(float, WS_SWIN)};
          gm::gemm_run<EpiG1SKV, SchedG1SKV, false, true>(F.lds, S, E); }
        QG(3, 4, 9);
    }
    SEAM(1);
    if (IN(2)) { FRAME_RELOAD();
        QG(0, 4, 3);
        if (SUB(3)) { SchedFixA S; S.nt = 2; S.pitchA = 128; S.pitchB = 128; S.multA = 1; S.multB = 1; S.G = F.G; S.c = bc; S.wv = F.wave; S.A = (const char*)WSP(bf16, WS_TAB); S.Bt = (const char*)WSP(bf16, WS_UTT); S.ncol = 512;
          EpiS1 E{WSP(bf16, WS_A1)};
          gm::gemm_run<EpiS1, SchedFixA, false>(F.lds, S, E); }
        QG(1, 4, 3);
        if (SUB(4)) { SchedScores S; S.nt = 4; S.pitchA = RW; S.pitchB = RW; S.multA = 1; S.multB = 1; S.G = F.G; S.c = bc; S.wv = F.wave; S.Q = (const char*)WSP(bf16, WS_QS); S.Kk = (const char*)WSP(bf16, WS_KK);
          EpiScores E{WSP(bf16, WS_ACAT), F.dec_f, F.dec_b};
          gm::gemm_run<EpiScores, SchedScores, false>(F.lds, S, E); }
        QG(2, 4, 3);
        if (SUB(5)) { SchedKV S; S.nt = 4; S.pitchA = CAT; S.pitchB = T; S.multA = 1; S.multB = 1; S.G = F.G; S.c = bc; S.wv = F.wave; S.Bcat = (const char*)WSP(bf16, WS_BCAT); S.kTw = (const char*)WSP(bf16, WS_KTW);
          EpiKV E{WSP(bf16, WS_KVT)};
          gm::gemm_run<EpiKV, SchedKV, false>(F.lds, S, E); }
        QG(3, 4, 3);
    }
    SEAM(2);
    if (IN(3)) { FRAME_RELOAD();
        QG(0, 3, 3);
        { SchedFixA S; S.nt = 4; S.pitchA = 256; S.pitchB = 256; S.multA = 1; S.multB = 1; S.G = F.G; S.c = bc; S.wv = F.wave; S.A = (const char*)(WSP(bf16, WS_TAB) + 32768); S.Bt = (const char*)WSP(bf16, WS_A1); S.ncol = 512;
          EpiS2 E{WSP(bf16, WS_ZT)};
          gm::gemm_run<EpiS2, SchedFixA, false>(F.lds, S, E); }
        QG(1, 3, 3);
        p3_scan(F);
        QG(2, 3, 3);
    }
    SEAM(3);
    if (IN(4)) { FRAME_RELOAD();
        QG(0, 3, 2);
        { SchedFixB S; S.nt = 4; S.pitchA = 256; S.pitchB = 256; S.multA = 1; S.multB = 1; S.G = F.G; S.c = bc; S.wv = F.wave; S.A = (const char*)WSP(bf16, WS_ZT); S.Bt = (const char*)(WSP(bf16, WS_TAB) + 32768 + 65536); S.nrow = 512;
          EpiChan E{WSP(bf16, WS_Y)};
          gm::gemm_run<EpiChan, SchedFixB, false>(F.lds, S, E); }
        QG(1, 3, 2);
        { SchedOut S; S.nt = CAT / 64; S.pitchA = CAT; S.pitchB = CAT; S.multA = 1; S.multB = 1; S.G = F.G; S.c = bc; S.wv = F.wave; S.Acat = (const char*)WSP(bf16, WS_ACAT); S.Bcat = (const char*)WSP(bf16, WS_BCAT);
          EpiOut E{WSP(bf16, WS_Y), WSP(bf16, WS_GS), F.gn_g};
          gm::gemm_run<EpiOut, SchedOut, false>(F.lds, S, E); }
        QG(2, 3, 2);

    }
    SEAM(4);
    if (IN(5)) { FRAME_RELOAD();
        QG(0, 2, 4);
        Sched2D S; S.nt = D / 64; S.pitchA = D; S.pitchB = D; S.multA = 1; S.multB = 1; S.G = F.G; S.c = bc; S.wv = F.wave; S.A = (const char*)WSP(bf16, WS_Y); S.Bt = (const char*)WSP(bf16, WS_WOUT); S.nM = 64; S.nN = 8;
        EpiWout E{WSP(bf16, WS_Z1), F.x, WSP(float, WS_ST0), F.ln0_g, F.ln0_b};
        gm::gemm_run<EpiWout, Sched2D, false>(F.lds, S, E);
        QG(1, 2, 4);
        do_slabs(F, sdone < nS ? sdone : nS, nS);
    }
    SEAM(5);
    if (IN(6)) { FRAME_RELOAD(); p6_router(F); }
    SEAM(6);
    if (IN(7) || IN(8) || IN(9)) build_tstart(F, tstart);
    if (IN(7)) { FRAME_RELOAD();
        build_units(F, tstart, 16, bc);
        const int upos = (int)((blockIdx.x >> 3) & 15);
#pragma unroll 1
        for (int part = 0; part < 2; ++part) {
            if (part == 1) do_slabs(F, 0, nDn);
            SchedMoEUpT S; S.nt = D / 128; S.pitchA = D / 2; S.pitchB = D / 2; S.multA = 1; S.multB = 1; S.G = F.G; S.c = bc; S.wv = F.wave; S.A = (const char*)WSP(char, WS_H1Q); S.Bt = (const char*)WSP(char, WS_WUP);
            S.tstart = tstart; S.row_tok = WSP(int, WS_RT) + 12 * T; S.cnt = F.ctl + CW_CNT; S.nN = 16; S.rowbytes = D; S.estride = (size_t)2 * DFF * D;
            S.rsc = WSP(float, WS_RSC); S.swup = WSP(float, WS_SWUP); S.b_up = F.b_up;
            S.u0 = part ? upos : 0; S.u1 = part ? 64 : upos;
            EpiUp E{(unsigned char*)(F.ws + WS_ACTQ)};
            gm::gemm_run<EpiUp, SchedMoEUpT, true, true, true>(F.lds, S, E);
        }
    }
    SEAM(7);
    if (IN(8)) { FRAME_RELOAD();
        build_units(F, tstart, 8, bc);
        SchedMoEDown S; S.nt = DFF / 128; S.pitchA = DFF / 2; S.pitchB = DFF / 2; S.multA = 1; S.multB = 1; S.G = F.G; S.c = bc; S.wv = F.wave; S.A = (const char*)WSP(char, WS_ACTQ); S.Bt = (const char*)WSP(char, WS_WDN);
        S.tstart = tstart; S.row_tok = nullptr; S.cnt = F.ctl + CW_CNT; S.nN = 8; S.rowbytes = DFF; S.estride = (size_t)D * DFF;
        S.sa = nullptr; S.swdn = WSP(float, WS_SWDN); S.b_dn = F.b_dn; S.rsc = nullptr; S.swup = nullptr; S.b_up = nullptr;
        EpiDown E{(unsigned char*)(F.ws + WS_YR)};
        gm::gemm_run<EpiDown, SchedMoEDown, false, 2, true>(F.lds, S, E);
    }
    SEAM(8);
    if (IN(9)) { FRAME_RELOAD(); p9_combine(F, tstart); }
#undef IN
#undef SEAM
}

#ifndef MK_SPLIT
#define MK_SPLIT 0
#endif
extern "C" void kernel_launch(void* const* d_in, const int* in_sizes, int n_in, void* d_out, int out_size, void* d_ws, size_t ws_size, hipStream_t stream) {
    static int grid = 0;
    if (grid == 0) {
        if (n_in != 18 || out_size != T * D || ws_size < WS_END2) { fprintf(stderr, "kernel_launch: unexpected problem: n_in %d out %d ws %zu (need %zu)\n", n_in, out_size, ws_size, (size_t)WS_END2); grid = -1; return; }
        int dev = 0, cus = 0, per_cu = 0;
        if (hipGetDevice(&dev) != hipSuccess || hipDeviceGetAttribute(&cus, hipDeviceAttributeMultiprocessorCount, dev) != hipSuccess) { grid = -1; return; }
        if (hipFuncSetAttribute((const void*)fwd, hipFuncAttributeMaxDynamicSharedMemorySize, LDS_BYTES) != hipSuccess) { fprintf(stderr, "kernel_launch: hipFuncSetAttribute failed\n"); grid = -1; return; }
        if (hipOccupancyMaxActiveBlocksPerMultiprocessor(&per_cu, (const void*)fwd, NTHR, LDS_BYTES) != hipSuccess || per_cu < 1) { fprintf(stderr, "kernel_launch: occupancy query reports %d\n", per_cu); }
        (void)hipGetLastError();
        grid = cus;
    }
    if (grid < 0) return;
    (void)hipMemsetAsync((char*)d_ws + WS_CTL, 0, CTL_BYTES, stream);
    Args a{};
    for (int i = 0; i < 18; ++i) a.in[i] = (const float*)d_in[i];
    a.out = (float*)d_out; a.ws = (unsigned char*)d_ws;
#if MK_SPLIT
    for (int p = 0; p < NPH; ++p) { a.ph_lo = p; a.ph_hi = p + 1; hipLaunchKernelGGL(fwd, dim3(grid), dim3(NTHR), LDS_BYTES, stream, a); }
#else
    a.ph_lo = 0; a.ph_hi = NPH; hipLaunchKernelGGL(fwd, dim3(grid), dim3(NTHR), LDS_BYTES, stream, a);
#endif
}
```
